# Optimizing an MI355X kernel written in HIP

```python
import jax, jax.numpy as jnp
from jax import lax
import numpy as np

D_MODEL = 1024
BATCH = 8
SEQ = 4096
DEPTH = 2

GRID_W = 64
CTX_LEN = 256

CONV_W = D_MODEL // 4
CONV_TAPS = 3
RET_W = D_MODEL // 2
RET_HEADS = 8
RET_DK = RET_W // RET_HEADS
RET_DV = RET_W // RET_HEADS
RET_CHUNK = 128
SGU_W = D_MODEL // 4
SGU_GROUPS = 4
SGU_CHUNK = 128
MIX_W = CONV_W + RET_W + SGU_W

OFF_CONV_B = 0
OFF_CONV_C = OFF_CONV_B + CONV_W
OFF_CONV_X = OFF_CONV_C + CONV_W
OFF_RET_Q = OFF_CONV_X + CONV_W
OFF_RET_K = OFF_RET_Q + RET_W
OFF_RET_V = OFF_RET_K + RET_W
OFF_RET_G = OFF_RET_V + RET_W
OFF_SGU_U = OFF_RET_G + RET_W
OFF_SGU_V = OFF_SGU_U + SGU_W
IN_COLS = OFF_SGU_V + SGU_W
IN_SPLITS = (OFF_CONV_C, OFF_CONV_X, OFF_RET_Q, OFF_RET_K, OFF_RET_V, OFF_RET_G, OFF_SGU_U, OFF_SGU_V)

N_GROUPS = 4
EXPERTS_PER_GROUP = 8
N_EXPERTS = N_GROUPS * EXPERTS_PER_GROUP
TOP_K_IN_GROUP = 2
EXPERT_HIDDEN = D_MODEL // 2
DISPATCH_BLOCK = 128

N_MOD = 6
LN_EPS = 1e-5
DEEPNORM_ALPHA = (2 * DEPTH) ** 0.25
DEEPNORM_BETA = (8 * DEPTH) ** -0.25

kernel_name = "hybrid_dit_conv_retention_sgu_hmoe"


def _standardize(x):
    xf = x.astype(jnp.float32)
    mu = jnp.mean(xf, axis=-1, keepdims=True)
    var = jnp.mean(jnp.square(xf - mu), axis=-1, keepdims=True)
    return (xf - mu) * lax.rsqrt(var + LN_EPS)


def layer_norm(x, gain, bias):
    return (_standardize(x) * gain + bias).astype(x.dtype)


def conv3(z, w, axis):
    pad = [(0, 0)] * z.ndim
    pad[axis] = (1, 1)
    zp = jnp.pad(z, pad)
    n = z.shape[axis]
    out = w[0] * lax.slice_in_dim(zp, 0, n, axis=axis)
    out = out + w[1] * lax.slice_in_dim(zp, 1, n + 1, axis=axis)
    return out + w[2] * lax.slice_in_dim(zp, 2, n + 2, axis=axis)


def short_conv_grid(z, w):
    bsz, length, cw = z.shape
    rows = length // GRID_W
    zg = z.reshape(bsz, rows, GRID_W, cw)
    half = cw // 2
    yh = conv3(zg[..., :half], w[:, :half], axis=2)
    yv = conv3(zg[..., half:], w[:, half:], axis=1)
    return jnp.concatenate([yh, yv], axis=-1).reshape(bsz, length, cw)


def retention_scan(q, k, v, log_gamma, s0):
    f32 = jnp.float32
    bsz, length = q.shape[:2]
    nc = length // RET_CHUNK
    qc = q.astype(f32).reshape(bsz, nc, RET_CHUNK, RET_HEADS, RET_DK)
    kc = k.astype(f32).reshape(bsz, nc, RET_CHUNK, RET_HEADS, RET_DK)
    vc = v.astype(f32).reshape(bsz, nc, RET_CHUNK, RET_HEADS, RET_DV)
    lg = log_gamma.astype(f32)
    pos = jnp.arange(RET_CHUNK, dtype=f32)
    rel = pos[:, None] - pos[None, :]
    intra_decay = jnp.where(rel >= 0, jnp.exp(lg[:, None, None] * jnp.maximum(rel, 0.0)), 0.0)
    scores = jnp.einsum('bnihd,bnjhd->bnhij', qc, kc) * intra_decay
    intra = jnp.einsum('bnhij,bnjhe->bnihe', scores, vc)
    k_decay = jnp.exp((RET_CHUNK - 1 - pos)[:, None] * lg)
    chunk_kv = jnp.einsum('bnjhd,jh,bnjhe->nbhde', kc, k_decay, vc)
    chunk_decay = jnp.exp(RET_CHUNK * lg)[None, :, None, None]

    def step(state, kv):
        return chunk_decay * state + kv, state

    s_final, s_prev = lax.scan(step, s0.astype(f32), chunk_kv)
    q_decay = jnp.exp((pos + 1.0)[:, None] * lg)
    cross = jnp.einsum('bnihd,ih,nbhde->bnihe', qc, q_decay, s_prev)
    o = (intra + cross).reshape(bsz, length, RET_HEADS, RET_DV)
    return o, s_final


def retention_final_state(k, v, log_gamma):
    f32 = jnp.float32
    length = k.shape[1]
    pos = jnp.arange(length, dtype=f32)
    w = jnp.exp((length - 1 - pos)[:, None] * log_gamma.astype(f32))
    return jnp.einsum('blhd,lh,blhe->bhde', k.astype(f32), w, v.astype(f32))


def spatial_gating(u, v, w_s, b_s):
    bsz, length, width = v.shape
    nc = length // SGU_CHUNK
    vn = _standardize(v).astype(v.dtype)
    vn = vn.reshape(bsz, nc, SGU_CHUNK, SGU_GROUPS, width // SGU_GROUPS)
    mixed = jnp.einsum('gpq,bnqgc->bnpgc', w_s, vn) + b_s.T[:, :, None]
    return u * mixed.reshape(bsz, length, width)


def hybrid_mixer(h, w_in, w_out, conv_w, lg_f, lg_b, sgu_w, sgu_b, s0_f, s0_b, on_grid):
    bsz, length, _ = h.shape
    p = h @ w_in
    cb, cc, cx, q, k, v, g, u, vv = jnp.split(p, IN_SPLITS, axis=-1)
    z = cc * cx
    conv = short_conv_grid(z, conv_w) if on_grid else conv3(z, conv_w, axis=1)
    ya = cb * conv
    q = q.reshape(bsz, length, RET_HEADS, RET_DK)
    k = k.reshape(bsz, length, RET_HEADS, RET_DK) * (RET_DK ** -0.5)
    v = v.reshape(bsz, length, RET_HEADS, RET_DV)
    o_f, s_f = retention_scan(q, k, v, lg_f, s0_f)
    o_b, s_b = retention_scan(q[:, ::-1], k[:, ::-1], v[:, ::-1], lg_b, s0_b)
    o = _standardize(o_f + o_b[:, ::-1]).astype(h.dtype)
    yb = jax.nn.silu(g) * o.reshape(bsz, length, RET_W)
    yc = spatial_gating(u, vv, sgu_w, sgu_b)
    y = jnp.concatenate([ya, yb, yc], axis=-1) @ w_out
    return y, s_f, s_b


def context_retention_states(hc, w_in, lg_f, lg_b):
    bsz, length, _ = hc.shape
    k = (hc @ w_in[:, OFF_RET_K:OFF_RET_V]).reshape(bsz, length, RET_HEADS, RET_DK) * (RET_DK ** -0.5)
    v = (hc @ w_in[:, OFF_RET_V:OFF_RET_G]).reshape(bsz, length, RET_HEADS, RET_DV)
    return retention_final_state(k, v, lg_f), retention_final_state(k[:, ::-1], v[:, ::-1], lg_b)


def grouped_experts(xf, expert, token, gate, w_gate, w_up, w_down):
    n_tok, d = xf.shape
    m = expert.shape[0]
    order = jnp.argsort(expert)
    se = expert[order]
    counts = jnp.bincount(expert, length=N_EXPERTS)
    starts = jnp.cumsum(counts) - counts
    pcounts = (counts + DISPATCH_BLOCK - 1) // DISPATCH_BLOCK * DISPATCH_BLOCK
    pends = jnp.cumsum(pcounts)
    pstarts = pends - pcounts
    dest = pstarts[se] + (jnp.arange(m) - starts[se])
    n_blocks = -(-m // DISPATCH_BLOCK) + N_EXPERTS
    n_slots = n_blocks * DISPATCH_BLOCK
    slot_tok = jnp.full((n_slots,), n_tok, dtype=jnp.int32).at[dest].set(token[order].astype(jnp.int32))
    slot_gate = jnp.zeros((n_slots,), xf.dtype).at[dest].set(gate[order])
    blk_e = jnp.minimum(jnp.searchsorted(pends, jnp.arange(n_blocks) * DISPATCH_BLOCK, side='right'), N_EXPERTS - 1)
    xpad = jnp.concatenate([xf, jnp.zeros((1, d), xf.dtype)], axis=0)
    xb = xpad[slot_tok].reshape(n_blocks, DISPATCH_BLOCK, d)

    def expert_block(args):
        xblk, e = args
        return (jax.nn.silu(xblk @ w_gate[e]) * (xblk @ w_up[e])) @ w_down[e]

    yb = lax.map(expert_block, (xb, blk_e)).reshape(n_slots, d)
    y = jax.ops.segment_sum(yb * slot_gate[:, None], slot_tok, num_segments=n_tok + 1)
    return y[:n_tok]


def hier_moe(h, rg_w, rg_b, re_w, re_b, w_gate, w_up, w_down):
    bsz, length, d = h.shape
    xf = h.reshape(bsz * length, d)
    n_tok = xf.shape[0]
    pg = jax.nn.softmax((xf @ rg_w).astype(jnp.float32) + rg_b.astype(jnp.float32), axis=-1)
    g_idx = jnp.argmax(pg, axis=-1)
    g_prob = jnp.max(pg, axis=-1, keepdims=True)
    le_all = jnp.einsum('nd,gde->nge', xf, re_w).astype(jnp.float32) + re_b.astype(jnp.float32)
    le = le_all[jnp.arange(n_tok), g_idx]
    pe = jax.nn.softmax(le, axis=-1)
    top_p, top_i = lax.top_k(pe, TOP_K_IN_GROUP)
    gate = g_prob * top_p / jnp.sum(top_p, axis=-1, keepdims=True)
    expert = g_idx[:, None] * EXPERTS_PER_GROUP + top_i
    token = jnp.broadcast_to(jnp.arange(n_tok)[:, None], expert.shape)
    y = grouped_experts(xf, expert.reshape(-1), token.reshape(-1), gate.reshape(-1).astype(xf.dtype),
                        w_gate, w_up, w_down)
    return y.reshape(bsz, length, d)


def setup_inputs(seed: int = 0) -> dict:
    key = jax.random.key(seed)
    ks = jax.random.split(key, 32)
    f32 = jnp.float32

    def nrm(k, shape, scale):
        return jax.random.normal(k, shape, f32) * scale

    gamma_logit = jnp.asarray(np.log(2.0 ** (5 + np.arange(RET_HEADS)) - 1.0), f32)
    d = D_MODEL
    return {
        'x': nrm(ks[0], (BATCH, SEQ, d), 1.0),
        'c': nrm(ks[1], (BATCH, d), 1.0),
        'ctx': nrm(ks[2], (BATCH, CTX_LEN, d), 1.0),
        'c_ctx': nrm(ks[3], (d,), 1.0),
        'w_ada': nrm(ks[4], (DEPTH, d, N_MOD * d), 0.5 * d ** -0.5),
        'b_ada': nrm(ks[5], (DEPTH, N_MOD * d), 0.02),
        'w_in': nrm(ks[6], (DEPTH, d, IN_COLS), d ** -0.5),
        'conv_w': nrm(ks[7], (DEPTH, CONV_TAPS, CONV_W), CONV_TAPS ** -0.5),
        'ret_decay_fwd': gamma_logit + nrm(ks[8], (DEPTH, RET_HEADS), 0.1),
        'ret_decay_bwd': gamma_logit + nrm(ks[9], (DEPTH, RET_HEADS), 0.1),
        'sgu_w': nrm(ks[10], (DEPTH, SGU_GROUPS, SGU_CHUNK, SGU_CHUNK), SGU_CHUNK ** -0.5),
        'sgu_b': 1.0 + nrm(ks[11], (DEPTH, SGU_GROUPS, SGU_CHUNK), 0.02),
        'w_out': nrm(ks[12], (DEPTH, MIX_W, d), DEEPNORM_BETA * MIX_W ** -0.5),
        'ln1_g': 1.0 + nrm(ks[13], (DEPTH, d), 0.02),
        'ln1_b': nrm(ks[14], (DEPTH, d), 0.02),
        'router_group_w': nrm(ks[15], (DEPTH, d, N_GROUPS), d ** -0.5),
        'router_group_b': nrm(ks[16], (DEPTH, N_GROUPS), 0.01),
        'router_expert_w': nrm(ks[17], (DEPTH, N_GROUPS, d, EXPERTS_PER_GROUP), d ** -0.5),
        'router_expert_b': nrm(ks[18], (DEPTH, N_GROUPS, EXPERTS_PER_GROUP), 0.01),
        'moe_w_gate': nrm(ks[19], (DEPTH, N_EXPERTS, d, EXPERT_HIDDEN), d ** -0.5),
        'moe_w_up': nrm(ks[20], (DEPTH, N_EXPERTS, d, EXPERT_HIDDEN), d ** -0.5),
        'moe_w_down': nrm(ks[21], (DEPTH, N_EXPERTS, EXPERT_HIDDEN, d), DEEPNORM_BETA * EXPERT_HIDDEN ** -0.5),
        'ln2_g': 1.0 + nrm(ks[22], (DEPTH, d), 0.02),
        'ln2_b': nrm(ks[23], (DEPTH, d), 0.02),
    }


def reference(x, c, ctx, c_ctx, w_ada, b_ada, w_in, conv_w, ret_decay_fwd, ret_decay_bwd, sgu_w, sgu_b,
              w_out, ln1_g, ln1_b, router_group_w, router_group_b, router_expert_w, router_expert_b,
              moe_w_gate, moe_w_up, moe_w_down, ln2_g, ln2_b):
    alpha = DEEPNORM_ALPHA
    bsz = x.shape[0]
    for l in range(DEPTH):
        last = l == DEPTH - 1
        mod = (jax.nn.silu(c) @ w_ada[l] + b_ada[l])[:, None, :]
        sh1, sc1, g1, sh2, sc2, g2 = jnp.split(mod, N_MOD, axis=-1)
        mod_c = jax.nn.silu(c_ctx) @ w_ada[l] + b_ada[l]
        csh1, csc1, cg1, csh2, csc2, cg2 = jnp.split(mod_c, N_MOD)
        lg_f = jax.nn.log_sigmoid(ret_decay_fwd[l].astype(jnp.float32))
        lg_b = jax.nn.log_sigmoid(ret_decay_bwd[l].astype(jnp.float32))

        hc = ctx * (1.0 + csc1) + csh1
        if last:
            s_f, s_b = context_retention_states(hc, w_in[l], lg_f, lg_b)
        else:
            s_zero = jnp.zeros((bsz, RET_HEADS, RET_DK, RET_DV), jnp.float32)
            yc, s_f, s_b = hybrid_mixer(hc, w_in[l], w_out[l], conv_w[l], lg_f, lg_b, sgu_w[l], sgu_b[l],
                                        s_zero, s_zero, on_grid=False)
            ctx = layer_norm(alpha * ctx + cg1 * yc, ln1_g[l], ln1_b[l])
            hm = ctx * (1.0 + csc2) + csh2
            ctx = layer_norm(alpha * ctx + cg2 * hier_moe(hm, router_group_w[l], router_group_b[l],
                                                          router_expert_w[l], router_expert_b[l],
                                                          moe_w_gate[l], moe_w_up[l], moe_w_down[l]),
                             ln2_g[l], ln2_b[l])

        h = x * (1.0 + sc1) + sh1
        y, _, _ = hybrid_mixer(h, w_in[l], w_out[l], conv_w[l], lg_f, lg_b, sgu_w[l], sgu_b[l],
                               s_f, s_b, on_grid=True)
        x = layer_norm(alpha * x + g1 * y, ln1_g[l], ln1_b[l])
        hm = x * (1.0 + sc2) + sh2
        x = layer_norm(alpha * x + g2 * hier_moe(hm, router_group_w[l], router_group_b[l],
                                                 router_expert_w[l], router_expert_b[l],
                                                 moe_w_gate[l], moe_w_up[l], moe_w_down[l]),
                       ln2_g[l], ln2_b[l])
    return x
```

```cpp
#include <hip/hip_runtime.h>
#include <cstdio>
#include <cstdint>
#include <cstddef>
namespace pg8 {
#define PG8_LAS __attribute__((address_space(3)))
typedef unsigned short bf16_t;
typedef short bf16x8 __attribute__((ext_vector_type(8)));
typedef float f32x4 __attribute__((ext_vector_type(4)));
typedef unsigned u32x4 __attribute__((ext_vector_type(4)));
constexpr int BM = 256, BK = 64, HALF = 128, HTB = HALF * BK * 2  , STAGE_BYTES = 8 * HTB, NXCD = 8, WGM = 8;

__host__ __device__ __forceinline__ int lds_byte(int r, int c) { const int st = (r >> 4) * 2 + (c >> 5), rr = r & 15, cc = c & 31, ob = rr * 64 + cc * 2; return st * 1024 + (ob ^ (((ob >> 9) & 1) << 5)); }
__host__ __device__ __forceinline__ void stage_rc(int b, int& R, int& C) { const int st = b / 1024, sb = b % 1024, swz = sb ^ (((sb >> 9) & 1) << 5); R = (st >> 1) * 16 + swz / 64; C = (st & 1) * 32 + (swz % 64) / 2; }
__host__ __device__ __forceinline__ int perm32(int rho) { const int n = rho >> 4, i = rho & 15; return 8 * (i >> 2) + 4 * n + (i & 3); }

struct Unit { int pm, pn; };
struct Gemm { const bf16_t* A; const bf16_t* Bt; int M, N, K; };

struct StaticOrder {
    int nM, nN, nwg, G, c;
    __host__ __device__ void init(int M, int N, int G_, int c_) { nM = M / BM; nN = N / BM; nwg = nM * nN; G = G_; c = c_; }
    __host__ __device__ bool next(int i, Unit& u) const {
        const long L = (long)i * G + c; if (L >= nwg) return false;
        int wgid = (int)L; { const int q = nwg / NXCD, r = nwg % NXCD, xcd = wgid % NXCD, off = wgid / NXCD; wgid = (xcd < r ? xcd * (q + 1) : r * (q + 1) + (xcd - r) * q) + off; }
        const int nig = WGM * nN, gid = wgid / nig, fm = gid * WGM, gsz = (nM - fm) < WGM ? (nM - fm) : WGM;
        u.pm = fm + ((wgid % nig) % gsz); u.pn = (wgid % nig) / gsz; return true;
    }
    __device__ __forceinline__ void a_ready(const Unit&) const {}
    __device__ __forceinline__ void done(const Unit&) const {}
};

__device__ __forceinline__ unsigned cvt_pk_bf16(float lo, float hi) { unsigned r; asm volatile("v_cvt_pk_bf16_f32 %0, %1, %2" : "=v"(r) : "v"(lo), "v"(hi)); return r; }
typedef float f32x2 __attribute__((ext_vector_type(2)));
__device__ __forceinline__ f32x2 gelu_pk(f32x2 v) {
    const f32x2 av = __builtin_elementwise_abs(v), d = av * 0.2316418882f + 1.0f;
    f32x2 t; t.x = __builtin_amdgcn_rcpf(d.x); t.y = __builtin_amdgcn_rcpf(d.y);
    f32x2 q = t * 0.5307027145f + (-0.7265760135f); q = q * t + 0.7107068705f; q = q * t + (-0.142248368f); q = q * t + 0.127414796f; q = q * t;
    const f32x2 s = (v * v) * (-0.72134752044f);
    f32x2 e; e.x = __builtin_amdgcn_exp2f(s.x); e.y = __builtin_amdgcn_exp2f(s.y);
    const f32x2 m = v * (q * e), r = v - m;
    f32x2 o; o.x = v.x < 0.f ? m.x : r.x; o.y = v.y < 0.f ? m.y : r.y; return o;
}

template <int ACT  > struct EpiBf16 {
    static constexpr bool PERM = true, AFTER_DRAIN = false; static_assert(ACT == 0 || ACT == 1, "EpiBf16: ACT is 0 (none) or 1 (gelu_pk)");
    bf16_t* O; int ldc; const float* bias; int split_cols; size_t split_stride; float scale0;
    __device__ __forceinline__ void operator()(const f32x4 (&acc)[2][2][4][2], const Unit& u, int wr, int wc, int fr, int fq) const {
        const int row0 = u.pm * BM + wr * 64 + fr; int colt = u.pn * BM; bf16_t* base = O;
        float sc = 1.f; if (split_cols) { const int t = colt / split_cols; base += (size_t)t * split_stride; colt -= t * split_cols; if (t == 0) sc = scale0; }
        const int col0 = colt + wc * 32 + 8 * fq, bcol0 = u.pn * BM + wc * 32 + 8 * fq;
        f32x4 bv[2][2];
#pragma unroll
        for (int bj = 0; bj < 2; ++bj)
#pragma unroll
            for (int n = 0; n < 2; ++n) bv[bj][n] = bias ? *(const f32x4*)(bias + bcol0 + bj * HALF + 4 * n) : (f32x4){0.f, 0.f, 0.f, 0.f};
#pragma unroll
        for (int ai = 0; ai < 2; ++ai)
#pragma unroll
            for (int m = 0; m < 4; ++m) { bf16_t* rowp = base + (size_t)(row0 + ai * HALF + m * 16) * ldc + col0;
#pragma unroll
                for (int bj = 0; bj < 2; ++bj) { f32x4 v0 = acc[ai][bj][m][0] + bv[bj][0], v1 = acc[ai][bj][m][1] + bv[bj][1];
                    if (ACT == 1) { f32x2 a = gelu_pk((f32x2){v0[0], v0[1]}), b = gelu_pk((f32x2){v0[2], v0[3]}), c = gelu_pk((f32x2){v1[0], v1[1]}), d = gelu_pk((f32x2){v1[2], v1[3]});
                        v0 = (f32x4){a.x, a.y, b.x, b.y}; v1 = (f32x4){c.x, c.y, d.x, d.y}; }
                    v0 = v0 * sc; v1 = v1 * sc; u32x4 w; w.x = cvt_pk_bf16(v0[0], v0[1]); w.y = cvt_pk_bf16(v0[2], v0[3]); w.z = cvt_pk_bf16(v1[0], v1[1]); w.w = cvt_pk_bf16(v1[2], v1[3]);
                    *(u32x4*)(rowp + bj * HALF) = w; } }
    }
};
__device__ __forceinline__ float silu_f(float x) { return x / (1.0f + __expf(-x)); }
struct EpiResid {
    static constexpr bool PERM = false, AFTER_DRAIN = false;
    const float* xin_lat; const float* xin_ctx; float* xo_lat; float* xo_ctx; const float* mod; float alpha;
    __device__ __forceinline__ void operator()(const f32x4 (&acc)[2][2][4][2], const Unit& u, int wr, int wc, int fr, int fq) const {
        const int prow0 = u.pm * BM; const bool isc = prow0 >= 32768;
        const float* xin = isc ? xin_ctx + (size_t)(prow0 - 32768) * 1024 : xin_lat + (size_t)prow0 * 1024;
        float* xo = isc ? xo_ctx + (size_t)(prow0 - 32768) * 1024 : xo_lat + (size_t)prow0 * 1024;
        const float* g1 = mod + (isc ? 8 : (prow0 >> 12)) * 6144 + 2048;
        const int col0 = u.pn * BM + wc * 32 + 4 * fq;
        f32x4 gv[2][2];
#pragma unroll
        for (int bj = 0; bj < 2; ++bj)
#pragma unroll
            for (int n = 0; n < 2; ++n) gv[bj][n] = *(const f32x4*)(g1 + col0 + bj * HALF + n * 16);
#pragma unroll
        for (int ai = 0; ai < 2; ++ai)
#pragma unroll
            for (int m = 0; m < 4; ++m) { const size_t off = (size_t)(ai * HALF + wr * 64 + m * 16 + fr) * 1024 + col0;
#pragma unroll
                for (int bj = 0; bj < 2; ++bj)
#pragma unroll
                    for (int n = 0; n < 2; ++n) { const f32x4 xv = *(const f32x4*)(xin + off + bj * HALF + n * 16);
                        *(f32x4*)(xo + off + bj * HALF + n * 16) = xv * alpha + gv[bj][n] * acc[ai][bj][m][n]; }
                if (m & 1) asm volatile("" ::: "memory"); }
    }
};
struct EpiGLU {
    static constexpr bool PERM = true, AFTER_DRAIN = false;
    bf16_t* Hh;
    __device__ __forceinline__ void operator()(const f32x4 (&acc)[2][2][4][2], const Unit& u, int wr, int wc, int fr, int fq) const {
        const int row0 = u.pm * BM + wr * 64 + fr; const int col0 = (u.pn & 3) * 128 + wc * 32 + 8 * fq;
#pragma unroll
        for (int ai = 0; ai < 2; ++ai)
#pragma unroll
            for (int m = 0; m < 4; ++m) { bf16_t* rowp = Hh + (size_t)(row0 + ai * HALF + m * 16) * 512 + col0;
                const f32x4 g0 = acc[ai][0][m][0], g1 = acc[ai][0][m][1], u0 = acc[ai][1][m][0], u1 = acc[ai][1][m][1];
                u32x4 w; w.x = cvt_pk_bf16(silu_f(g0[0]) * u0[0], silu_f(g0[1]) * u0[1]); w.y = cvt_pk_bf16(silu_f(g0[2]) * u0[2], silu_f(g0[3]) * u0[3]);
                w.z = cvt_pk_bf16(silu_f(g1[0]) * u1[0], silu_f(g1[1]) * u1[1]); w.w = cvt_pk_bf16(silu_f(g1[2]) * u1[2], silu_f(g1[3]) * u1[3]);
                *(u32x4*)rowp = w; }
    }
};
struct EpiY {
    static constexpr bool PERM = true, AFTER_DRAIN = false;
    bf16_t* O;
    __device__ __forceinline__ void operator()(const f32x4 (&acc)[2][2][4][2], const Unit& u, int wr, int wc, int fr, int fq) const {
        const int row0 = u.pm * BM + wr * 64 + fr; const int col0 = (u.pn & 3) * BM + wc * 32 + 8 * fq;
#pragma unroll
        for (int ai = 0; ai < 2; ++ai)
#pragma unroll
            for (int m = 0; m < 4; ++m) { bf16_t* rowp = O + (size_t)(row0 + ai * HALF + m * 16) * 1024 + col0;
#pragma unroll
                for (int bj = 0; bj < 2; ++bj) { const f32x4 v0 = acc[ai][bj][m][0], v1 = acc[ai][bj][m][1];
                    u32x4 w; w.x = cvt_pk_bf16(v0[0], v0[1]); w.y = cvt_pk_bf16(v0[2], v0[3]); w.z = cvt_pk_bf16(v1[0], v1[1]); w.w = cvt_pk_bf16(v1[2], v1[3]);
                    *(u32x4*)(rowp + bj * HALF) = w; } }
    }
};
struct MoeOrder {
    const PG8_LAS unsigned char* p2e; int nunits, G, c;
    __device__ __forceinline__ bool next(int i, Unit& u) const {
        const int L = i * G + c; if (L >= nunits) return false;
        u.pm = L >> 2; u.pn = (int)p2e[L >> 2] * 4 + (L & 3); return true;
    }
    __device__ __forceinline__ void a_ready(const Unit&) const {}
    __device__ __forceinline__ void done(const Unit&) const {}
};
template <class Epi, class Sched, bool ALIGN_EPI = false, bool SP2 = false>
__device__ __forceinline__ void gemm_phase(PG8_LAS unsigned char* lds, const Gemm g, const Sched& S, const Epi& E) {
    int tid_ = threadIdx.x; asm volatile("" : "+v"(tid_));
    const int tid = tid_, wid = __builtin_amdgcn_readfirstlane(tid >> 6), lane = tid & 63, wr = wid >> 2, wc = wid & 3, fr = lane & 15, fq = lane >> 4;
    const int K = g.K, nt = K / BK;
    unsigned voffA[2], voffB[2];
#pragma unroll
    for (int i = 0; i < 2; ++i) { int R, C; stage_rc(tid * 16 + i * 8192, R, C); const int Rb = Epi::PERM ? ((R & ~31) + perm32(R & 31)) : R;
        voffA[i] = (unsigned)(R * K + C) * 2u; voffB[i] = (unsigned)(Rb * K + C) * 2u; }
    const size_t kstep = (size_t)(BK * 2);
    const size_t hstep = (size_t)HALF * K * 2;
    const size_t tstep = 2 * hstep;
    const unsigned ldsw = (unsigned)wid * 1024u;
    const int aoff = lds_byte(wr * 64 + fr, fq * 8), boff = lds_byte(wc * 32 + fr, fq * 8);
#define PG8_SA(b, h) (((b) * 2 + (h)) * HTB)
#define PG8_SB(b, h) ((4 + (b) * 2 + (h)) * HTB)
#define PG8_STAGE(bufoff, gbase, voff) do { _Pragma("unroll") for (int _i = 0; _i < 2; ++_i) \
        __builtin_amdgcn_global_load_lds((const unsigned*)((const char*)(gbase) + (voff)[_i]), (PG8_LAS unsigned*)(lds + (bufoff) + ldsw + _i * 8192), 16, 0, 0); } while (0)
#define PG8_LDA(dst, b, h) do { _Pragma("unroll") for (int m = 0; m < 4; ++m) _Pragma("unroll") for (int k = 0; k < 2; ++k) dst[m][k] = *(const PG8_LAS bf16x8*)(lds + PG8_SA(b, h) + aoff + m * 2048 + k * 1024); } while (0)
#define PG8_LDB(dst, b, h) do { _Pragma("unroll") for (int n = 0; n < 2; ++n) _Pragma("unroll") for (int k = 0; k < 2; ++k) dst[n][k] = *(const PG8_LAS bf16x8*)(lds + PG8_SB(b, h) + boff + n * 2048 + k * 1024); } while (0)
#define PG8_MMA(ai, bj, At, Bt) do { __builtin_amdgcn_s_setprio(1); _Pragma("unroll") for (int m = 0; m < 4; ++m) _Pragma("unroll") for (int n = 0; n < 2; ++n) _Pragma("unroll") for (int k = 0; k < 2; ++k) \
        acc[ai][bj][m][n] = __builtin_amdgcn_mfma_f32_16x16x32_bf16(Bt[n][k], At[m][k], acc[ai][bj][m][n], 0, 0, 0); __builtin_amdgcn_s_setprio(0); } while (0)
#define PG8_WAIT_V(n) asm volatile("s_waitcnt vmcnt(" #n ")" ::: "memory")
#define PG8_WAIT_L(n) asm volatile("s_waitcnt lgkmcnt(" #n ")" ::: "memory")
#define PG8_BAR __builtin_amdgcn_s_barrier()
#define PG8_SCHED __builtin_amdgcn_sched_barrier(0)
    Unit cur, nxt; int ui = 0;
    if (!S.next(0, cur)) return;
    f32x4 acc[2][2][4][2];
#pragma unroll
    for (int a = 0; a < 2; ++a)
#pragma unroll
        for (int b = 0; b < 2; ++b)
#pragma unroll
            for (int m = 0; m < 4; ++m)
#pragma unroll
                for (int n = 0; n < 2; ++n) acc[a][b][m][n] = (f32x4){0.f, 0.f, 0.f, 0.f};
    bf16x8 At[4][2], B0[2][2], B1[2][2];
    const char* cA = (const char*)g.A + (size_t)cur.pm * tstep; const char* cB = (const char*)g.Bt + (size_t)cur.pn * tstep;
    S.a_ready(cur);
    if constexpr (SP2) {
        PG8_STAGE(PG8_SB(0, 0), cB, voffB); PG8_STAGE(PG8_SB(0, 1), cB + hstep, voffB); PG8_STAGE(PG8_SA(0, 0), cA, voffA); PG8_STAGE(PG8_SA(0, 1), cA + hstep, voffA);
        if (wr == 1) PG8_BAR;
        PG8_WAIT_V(2); PG8_BAR;
        PG8_STAGE(PG8_SB(1, 0), cB + kstep, voffB); PG8_STAGE(PG8_SA(1, 0), cA + kstep, voffA); PG8_STAGE(PG8_SB(1, 1), cB + hstep + kstep, voffB);
        PG8_WAIT_V(6); PG8_BAR;
    } else {
        PG8_STAGE(PG8_SB(0, 0), cB, voffB); PG8_STAGE(PG8_SA(0, 0), cA, voffA); PG8_STAGE(PG8_SB(0, 1), cB + hstep, voffB); PG8_STAGE(PG8_SA(0, 1), cA + hstep, voffA);
        if (wr == 1) PG8_BAR;
        PG8_WAIT_V(4); PG8_BAR;
        PG8_STAGE(PG8_SB(1, 0), cB + kstep, voffB); PG8_STAGE(PG8_SA(1, 0), cA + kstep, voffA); PG8_STAGE(PG8_SB(1, 1), cB + hstep + kstep, voffB);
        PG8_WAIT_V(6); PG8_BAR;
    }
    for (;;) {
        const bool has_next = S.next(ui + 1, nxt);
        const char* nA = has_next ? (const char*)g.A + (size_t)nxt.pm * tstep : cA; const char* nB = has_next ? (const char*)g.Bt + (size_t)nxt.pn * tstep : cB;
        for (int t = 0; t < nt; t += 2) {
            const bool last = (t == nt - 2);
            const char* a1 = cA + (size_t)(t + 1) * kstep;
            const char* a2 = last ? nA : cA + (size_t)(t + 2) * kstep; const char* b2 = last ? nB : cB + (size_t)(t + 2) * kstep;
            const char* a3 = a2 + kstep; const char* b3 = b2 + kstep;
            if (last && has_next) S.a_ready(nxt);
            if constexpr (SP2) {
            PG8_LDB(B0, 0, 0); PG8_LDB(B1, 0, 1); PG8_SCHED; PG8_LDA(At, 0, 0); PG8_STAGE(PG8_SA(1, 1), a1 + hstep, voffA);
            PG8_WAIT_V(8); PG8_WAIT_L(0); PG8_BAR; PG8_MMA(0, 0, At, B0); PG8_MMA(0, 1, At, B1); PG8_BAR; PG8_SCHED;
            PG8_LDA(At, 0, 1); PG8_STAGE(PG8_SB(0, 0), b2, voffB); PG8_STAGE(PG8_SB(0, 1), b2 + hstep, voffB); PG8_STAGE(PG8_SA(0, 0), a2, voffA);
            PG8_WAIT_V(8); PG8_WAIT_L(0); PG8_BAR; PG8_MMA(1, 0, At, B0); PG8_MMA(1, 1, At, B1); PG8_BAR; PG8_SCHED;
            PG8_LDB(B0, 1, 0); PG8_LDB(B1, 1, 1); PG8_SCHED; PG8_LDA(At, 1, 0); PG8_STAGE(PG8_SA(0, 1), a2 + hstep, voffA);
            PG8_WAIT_V(8); PG8_WAIT_L(0); PG8_BAR; PG8_MMA(0, 0, At, B0); PG8_MMA(0, 1, At, B1); PG8_BAR; PG8_SCHED;
            PG8_LDA(At, 1, 1); PG8_STAGE(PG8_SB(1, 0), b3, voffB); PG8_STAGE(PG8_SB(1, 1), b3 + hstep, voffB); PG8_STAGE(PG8_SA(1, 0), a3, voffA);
            PG8_WAIT_V(8); PG8_WAIT_L(0); PG8_BAR; PG8_MMA(1, 0, At, B0); PG8_MMA(1, 1, At, B1); PG8_BAR; PG8_SCHED;
            } else {
            PG8_LDB(B0, 0, 0); PG8_SCHED; PG8_LDA(At, 0, 0); PG8_STAGE(PG8_SA(1, 1), a1 + hstep, voffA);
            PG8_WAIT_L(8); PG8_BAR; PG8_WAIT_L(0); PG8_MMA(0, 0, At, B0); PG8_BAR; PG8_SCHED;
            PG8_LDB(B1, 0, 1); PG8_STAGE(PG8_SB(0, 0), b2, voffB);
            PG8_BAR; PG8_WAIT_L(0); PG8_MMA(0, 1, At, B1); PG8_BAR;
            PG8_LDA(At, 0, 1); PG8_STAGE(PG8_SA(0, 0), a2, voffA);
            PG8_BAR; PG8_WAIT_L(0); PG8_MMA(1, 0, At, B0); PG8_BAR; PG8_SCHED;
            PG8_STAGE(PG8_SB(0, 1), b2 + hstep, voffB);
            PG8_WAIT_V(6); PG8_BAR; PG8_MMA(1, 1, At, B1); PG8_BAR;
            PG8_LDB(B0, 1, 0); PG8_SCHED; PG8_LDA(At, 1, 0); PG8_STAGE(PG8_SA(0, 1), a2 + hstep, voffA);
            PG8_WAIT_L(8); PG8_BAR; PG8_WAIT_L(0); PG8_MMA(0, 0, At, B0); PG8_BAR; PG8_SCHED;
            PG8_LDB(B1, 1, 1); PG8_STAGE(PG8_SB(1, 0), b3, voffB);
            PG8_BAR; PG8_WAIT_L(0); PG8_MMA(0, 1, At, B1); PG8_BAR;
            PG8_LDA(At, 1, 1); PG8_STAGE(PG8_SA(1, 0), a3, voffA);
            PG8_BAR; PG8_WAIT_L(0); PG8_MMA(1, 0, At, B0); PG8_BAR; PG8_SCHED;
            PG8_STAGE(PG8_SB(1, 1), b3 + hstep, voffB);
            PG8_WAIT_V(6); PG8_BAR; PG8_MMA(1, 1, At, B1); PG8_BAR;
            }
        }
        if constexpr (ALIGN_EPI) { if (wr == 0) PG8_BAR; }
        if constexpr (!Epi::AFTER_DRAIN) { E(acc, cur, wr, wc, fr, fq); S.done(cur); }
        if (!has_next) break;
#pragma unroll
        for (int a = 0; a < 2; ++a)
#pragma unroll
            for (int b = 0; b < 2; ++b)
#pragma unroll
                for (int m = 0; m < 4; ++m)
#pragma unroll
                    for (int n = 0; n < 2; ++n) acc[a][b][m][n] = (f32x4){0.f, 0.f, 0.f, 0.f};
        cur = nxt; cA = nA; cB = nB; ++ui;
        if constexpr (ALIGN_EPI) { if (wr == 1) PG8_BAR; }
    }
    PG8_WAIT_V(0);
    if constexpr (!ALIGN_EPI) { if (wr == 0) PG8_BAR; }
    PG8_BAR;
    if constexpr (Epi::AFTER_DRAIN) { E.fused(acc, cur, wr, wc, fr, fq, lds, wid, lane); S.done(cur); }
#undef PG8_SA
#undef PG8_SB
#undef PG8_STAGE
#undef PG8_LDA
#undef PG8_LDB
#undef PG8_MMA
#undef PG8_WAIT_V
#undef PG8_WAIT_L
#undef PG8_BAR
#undef PG8_SCHED
}
}
constexpr int NWAVES = 8, NTHR = 512;
constexpr int DM = 1024, NLAT = 32768, NCTX = 2048, NROWS = 34816, INC = 3328;
constexpr int OFF_CB = 0, OFF_CC = 256, OFF_CX = 512, OFF_Q = 768, OFF_K = 1280, OFF_V = 1792, OFF_G = 2304, OFF_U = 2816, OFF_VV = 3072;
constexpr int NCH = 34;
constexpr float LN_EPS = 1e-5f, ALPHA = 1.41421356237309515f;
constexpr size_t MiB = 1u << 20;
constexpr size_t WS_CTL = 0, CTL_ZERO_BYTES = MiB, WS_MOD = 1 * MiB, WS_TOK = 2 * MiB, WS_WIN = 4 * MiB, WS_WOUT = 17 * MiB, WS_WGU = 21 * MiB, WS_WD = 149 * MiB,
                 WS_HB = 213 * MiB, WS_ST = WS_HB, WS_XCTX = 281 * MiB, WS_P = 289 * MiB, WS_YMIX = 510 * MiB, WS_XB = WS_P, WS_Y = WS_P, WS_HH = WS_P + 152 * MiB, WS_END = 578 * MiB;
constexpr int CW_TMO = 0, CW_BAR = 4096, CW_WGCNT = 16384, CW_TOT = 32768;
constexpr int RING_BYTES = 131072, LDSCTL_OFF = RING_BYTES, MISC_OFF = LDSCTL_OFF + 320, P2E_OFF = LDSCTL_OFF + 1024, PST_OFF = LDSCTL_OFF + 2048, LDS_BYTES = 147456;
constexpr int MAXPANELS = 304;

#define GAS __attribute__((address_space(1)))
#define LAS __attribute__((address_space(3)))
typedef unsigned short bf16;
typedef unsigned v4u __attribute__((ext_vector_type(4)));
typedef unsigned v2u __attribute__((ext_vector_type(2)));
typedef float f32x4 __attribute__((ext_vector_type(4)));
#define LDS_WAIT() asm volatile("s_waitcnt lgkmcnt(0)" ::: "memory")
#define VM_WAIT() asm volatile("s_waitcnt vmcnt(0)" ::: "memory")
__device__ __forceinline__ unsigned f2bf(float f) { unsigned u = __builtin_bit_cast(unsigned, f); return (u + 0x7fffu + ((u >> 16) & 1u)) >> 16; }
__device__ __forceinline__ unsigned pk2(float lo, float hi) { return f2bf(lo) | (f2bf(hi) << 16); }
__device__ __forceinline__ float bflo(unsigned w) { return __builtin_bit_cast(float, w << 16); }
__device__ __forceinline__ float bfhi(unsigned w) { return __builtin_bit_cast(float, w & 0xffff0000u); }
__device__ __forceinline__ float wave_sum(float v) {
#pragma unroll
    for (int o = 1; o < 64; o <<= 1) v += __shfl_xor(v, o);
    return v;
}
__device__ __forceinline__ float log_sigmoid_f(float x) { return -log1pf(expf(-x)); }

struct Args { const float* in[24]; float* out; unsigned char* ws; int ph_lo, ph_hi; };
#define XB_TMO      128
#define XB_XCNT(j)  (256  + 64 * (j))
#define XB_XSUB(j)  (1280 + 64 * (j))
#define XB_XGEN(j)  (2304 + 64 * (j))
#define XB_TOP      3328
#define XB_TOPGEN   3392
#define XCD_BAR_WORDS 3456
#define XB_SPIN_CAP (1u << 18)

__device__ __forceinline__ unsigned xb_ld(unsigned* p)              { return __hip_atomic_load(p, __ATOMIC_RELAXED, __HIP_MEMORY_SCOPE_AGENT); }
__device__ __forceinline__ unsigned xb_add(unsigned* p, unsigned v) { return __hip_atomic_fetch_add(p, v, __ATOMIC_RELAXED, __HIP_MEMORY_SCOPE_AGENT); }
__device__ __forceinline__ unsigned xb_xcc_id() { return (unsigned)__builtin_amdgcn_s_getreg((3 << 11) | 20) & 0xFu; }
#define XB_SPIN(cond, bar) do { unsigned _sp = 0; while (cond) { __builtin_amdgcn_s_sleep(1); \
    if ((++_sp & 255u) == 0u) { if (xb_ld(&(bar)[XB_TMO])) break; if (_sp > XB_SPIN_CAP) { atomicAdd(&(bar)[XB_TMO], 1u); break; } } } } while (0)

struct XcdBarrier {
    unsigned* bar; unsigned x;
    volatile LAS unsigned* st;
};

__device__ __forceinline__ XcdBarrier xcd_barrier_post(unsigned* bar, volatile LAS unsigned* st) {
    XcdBarrier b; b.bar = bar; b.x = xb_xcc_id(); b.st = st;
    if (threadIdx.x == 0) (void)xb_add(&bar[XB_XCNT(b.x)], 1u);
    return b;
}
__device__ __forceinline__ void xcd_barrier_complete(unsigned* bar, unsigned x, unsigned& nloc, unsigned& nx) {
    const unsigned G = gridDim.x * gridDim.y * gridDim.z;
    unsigned sum, cnt, mine, sp = 0u;
    for (;;) {
        sum = 0u; cnt = 0u; mine = 0u;
#pragma unroll
        for (unsigned j = 0; j < 16; ++j) { const unsigned c = xb_ld(&bar[XB_XCNT(j)]); sum += c; cnt += (c > 0u) ? 1u : 0u; mine = (j == x) ? c : mine; }
        if (sum == G) break;
        __builtin_amdgcn_s_sleep(1);
        if ((++sp & 255u) == 0u) { if (xb_ld(&bar[XB_TMO])) break; if (sp > XB_SPIN_CAP) { atomicAdd(&bar[XB_TMO], 1u); break; } }
    }
    nloc = mine > 0u ? mine : 1u; nx = cnt > 0u ? cnt : 1u;
}

__device__ __forceinline__ void xcd_barrier(const XcdBarrier& b) {
    asm volatile("s_waitcnt vmcnt(0)" ::: "memory");
    __syncthreads();
    if (threadIdx.x == 0) {
        unsigned* bar = b.bar;
        __builtin_amdgcn_s_waitcnt(0);
        unsigned nloc = b.st[0], nx = b.st[1];
        if (nloc == 0u) { xcd_barrier_complete(bar, b.x, nloc, nx); b.st[0] = nloc; b.st[1] = nx; }
        const unsigned old = xb_add(&bar[XB_XSUB(b.x)], 1u);
        const unsigned gen = old / nloc;
        if (old + 1u == (gen + 1u) * nloc) {
            __builtin_amdgcn_fence(__ATOMIC_RELEASE, "agent");
            asm volatile("s_waitcnt vmcnt(0)" ::: "memory");
            const unsigned og = xb_add(&bar[XB_TOP], 1u);
            const unsigned tg = og / nx;
            if (og + 1u == (tg + 1u) * nx) xb_add(&bar[XB_TOPGEN], 1u);
            else XB_SPIN(xb_ld(&bar[XB_TOPGEN]) == tg, bar);
            __builtin_amdgcn_fence(__ATOMIC_ACQUIRE, "agent");
            xb_add(&bar[XB_XGEN(b.x)], 1u);
            asm volatile("s_waitcnt vmcnt(0)" ::: "memory");
        } else {
            XB_SPIN(xb_ld(&bar[XB_XGEN(b.x)]) == gen, bar);
            __builtin_amdgcn_fence(__ATOMIC_ACQUIRE, "agent");
            asm volatile("s_waitcnt vmcnt(0)" ::: "memory");
        }
    }
    __syncthreads();
}
__device__ __forceinline__ void transpose_tile(const float* Wsrc, int ldn, bf16* dst, int ldk, float scale, LAS float* scr, int lane) {
#pragma unroll 8
    for (int i = 0; i < 32; ++i) { const int kk = 2 * i + (lane >> 5); scr[kk * 33 + (lane & 31)] = Wsrc[(size_t)kk * ldn + (lane & 31)] * scale; }
    LDS_WAIT(); asm volatile("" ::: "memory");
    const int c = lane & 7;
#pragma unroll
    for (int j = 0; j < 4; ++j) { const int n = (lane >> 3) + 8 * j; const LAS float* s = scr + (8 * c) * 33 + n;
        v4u o; o.x = pk2(s[0 * 33], s[1 * 33]); o.y = pk2(s[2 * 33], s[3 * 33]); o.z = pk2(s[4 * 33], s[5 * 33]); o.w = pk2(s[6 * 33], s[7 * 33]);
        *(GAS v4u*)(dst + (size_t)n * ldk + 8 * c) = o; }
    LDS_WAIT(); asm volatile("" ::: "memory");
}

__device__ __forceinline__ void phase_p0(const Args& a, LAS unsigned char* lds, int tid, int lane, int wave) {
    const int G = gridDim.x;
    {
        LAS float* s = (LAS float*)lds; LAS float* red = (LAS float*)(lds + 36864);
        const float* c = a.in[1]; const float* cctx = a.in[3]; const float* wada = a.in[4]; const float* bada = a.in[5];
        float* mod = (float*)(a.ws + WS_MOD);
        for (int u = blockIdx.x; u < 192; u += G) {
            const int l = u / 96, j0 = (u % 96) * 64;
            for (int i = tid; i < 9 * 1024; i += NTHR) { const int r = i >> 10, k = i & 1023; const float v = r < 8 ? c[r * 1024 + k] : cctx[k]; s[i] = v / (1.0f + expf(-v)); }
            __syncthreads();
            const int jq = tid & 15, kg = tid >> 4;
            float acc[9][4];
#pragma unroll
            for (int r = 0; r < 9; ++r) { acc[r][0] = 0.f; acc[r][1] = 0.f; acc[r][2] = 0.f; acc[r][3] = 0.f; }
            const float* w = wada + (size_t)l * 1024 * 6144 + j0 + jq * 4;
            for (int k = kg; k < 1024; k += 32) { const f32x4 wv = *(const f32x4*)(w + (size_t)k * 6144);
#pragma unroll
                for (int r = 0; r < 9; ++r) { const float sr = s[r * 1024 + k]; acc[r][0] += sr * wv.x; acc[r][1] += sr * wv.y; acc[r][2] += sr * wv.z; acc[r][3] += sr * wv.w; } }
#pragma unroll
            for (int r = 0; r < 9; ++r)
#pragma unroll
                for (int i = 0; i < 4; ++i) red[(kg * 9 + r) * 64 + jq * 4 + i] = acc[r][i];
            __syncthreads();
            for (int o = tid; o < 576; o += NTHR) { const int r = o >> 6, j = o & 63; float sum = 0.f;
                for (int g2 = 0; g2 < 32; ++g2) sum += red[(g2 * 9 + r) * 64 + j];
                mod[(l * 9 + r) * 6144 + j0 + j] = sum + bada[l * 6144 + j0 + j]; }
            __syncthreads();
        }
    }
    {
        LAS float* scr = (LAS float*)(lds + wave * 16384);
        const int gw = blockIdx.x * NWAVES + wave, NGW = G * NWAVES;
        const float* w_in = a.in[6]; const float* w_out = a.in[12]; const float* w_gate = a.in[19]; const float* w_up = a.in[20]; const float* w_down = a.in[21];
        bf16* WIN = (bf16*)(a.ws + WS_WIN); bf16* WOUT = (bf16*)(a.ws + WS_WOUT); bf16* WGU = (bf16*)(a.ws + WS_WGU); bf16* WD = (bf16*)(a.ws + WS_WD);
        constexpr int I_IN = 2 * 16 * 104, I_OUT = 2 * 16 * 32, I_GU = 2 * 2 * 32 * 256, I_D = 2 * 32 * 256, NITEMS = I_IN + I_OUT + I_GU + I_D;
        for (int it = gw; it < NITEMS; it += NGW) {
            int r = it;
            if (r < I_IN) { const int l = r / 1664, q = r % 1664, k0 = 64 * (q / 104), n0 = 32 * (q % 104);
                const float sc = (n0 >= OFF_K && n0 < OFF_V) ? 0.125f : 1.0f;
                transpose_tile(w_in + ((size_t)l * 1024 + k0) * INC + n0, INC, WIN + ((size_t)l * INC + n0) * 1024 + k0, 1024, sc, scr, lane); continue; }
            r -= I_IN;
            if (r < I_OUT) { const int l = r / 512, q = r % 512, k0 = 64 * (q / 32), n0 = 32 * (q % 32);
                transpose_tile(w_out + ((size_t)l * 1024 + k0) * 1024 + n0, 1024, WOUT + ((size_t)l * 1024 + n0) * 1024 + k0, 1024, 1.0f, scr, lane); continue; }
            r -= I_OUT;
            if (r < I_GU) { const int isup = r >= (I_GU / 2) ? 1 : 0; r -= isup * (I_GU / 2);
                const int le = r / 256, q = r % 256, k0 = 64 * (q / 16), n0 = 32 * (q % 16);
                const float* src = (isup ? w_up : w_gate) + ((size_t)le * 1024 + k0) * 512 + n0;
                const int drow = (n0 >> 7) * 256 + (n0 & 127) + isup * 128;
                transpose_tile(src, 512, WGU + ((size_t)le * 1024 + drow) * 1024 + k0, 1024, 1.0f, scr, lane); continue; }
            r -= I_GU;
            { const int le = r / 256, q = r % 256, k0 = 64 * (q / 32), n0 = 32 * (q % 32);
                transpose_tile(w_down + ((size_t)le * 512 + k0) * 1024 + n0, 1024, WD + ((size_t)le * 1024 + n0) * 512 + k0, 512, 1.0f, scr, lane); }
        }
    }
}

__device__ __forceinline__ void phase_p1(const Args& a, int lane, int wave) {
    const int gw = blockIdx.x * NWAVES + wave, NGW = gridDim.x * NWAVES;
    const float* mod = (const float*)(a.ws + WS_MOD); bf16* Hb = (bf16*)(a.ws + WS_HB);
    for (int row = gw; row < NROWS; row += NGW) {
        const float* src = row < NLAT ? a.in[0] + (size_t)row * 1024 : a.in[2] + (size_t)(row - NLAT) * 1024;
        const float* m0 = mod + (row < NLAT ? (row >> 12) : 8) * 6144;
#pragma unroll
        for (int j = 0; j < 4; ++j) { const int idx = (lane + 64 * j) * 4;
            const f32x4 v = *(const f32x4*)(src + idx), sh = *(const f32x4*)(m0 + idx), sc = *(const f32x4*)(m0 + 1024 + idx);
            const f32x4 o = v * (sc + 1.0f) + sh; v2u w; w.x = pk2(o.x, o.y); w.y = pk2(o.z, o.w);
            *(v2u*)(Hb + (size_t)row * 1024 + idx) = w; }
    }
}

__device__ __forceinline__ int chunk_row0(int b, int c) { return c < 2 ? NLAT + b * 256 + c * 128 : b * 4096 + (c - 2) * 128; }
__device__ __forceinline__ size_t st_off(int b, int c, int h, int dir) { return ((((size_t)b * NCH + c) * 8 + h) * 2 + dir) * 4096; }

__device__ __forceinline__ void phase_b(const Args& a, int l, LAS unsigned char* lds, int tid) {
    const bf16* P = (const bf16*)(a.ws + WS_P); float* ST = (float*)(a.ws + WS_ST);
    LAS float* Ks = (LAS float*)lds; LAS float* Vs = (LAS float*)(lds + 32768); LAS float* pf = (LAS float*)(lds + 65536); LAS float* pb = pf + 128;
    for (int u = blockIdx.x; u < 8 * NCH * 8; u += gridDim.x) {
        const int b = u / (NCH * 8), c = (u % (NCH * 8)) / 8, h = u % 8; const int row0 = chunk_row0(b, c);
        __syncthreads();
        if (tid < 128) { const float lgf = log_sigmoid_f(a.in[8][l * 8 + h]), lgb = log_sigmoid_f(a.in[9][l * 8 + h]);
            pf[tid] = expf(lgf * (float)(127 - tid)); pb[tid] = expf(lgb * (float)tid); }
        { const int j = tid >> 2, part = tid & 3; const bf16* kp = P + (size_t)(row0 + j) * INC + OFF_K + h * 64 + part * 16; const bf16* vp = kp + (OFF_V - OFF_K);
#pragma unroll
          for (int q = 0; q < 2; ++q) { const v4u kw = *(const v4u*)(kp + 8 * q), vw = *(const v4u*)(vp + 8 * q);
              LAS float* kd = Ks + j * 64 + part * 16 + 8 * q; LAS float* vd = Vs + j * 64 + part * 16 + 8 * q;
              kd[0] = bflo(kw.x); kd[1] = bfhi(kw.x); kd[2] = bflo(kw.y); kd[3] = bfhi(kw.y); kd[4] = bflo(kw.z); kd[5] = bfhi(kw.z); kd[6] = bflo(kw.w); kd[7] = bfhi(kw.w);
              vd[0] = bflo(vw.x); vd[1] = bfhi(vw.x); vd[2] = bflo(vw.y); vd[3] = bfhi(vw.y); vd[4] = bflo(vw.z); vd[5] = bfhi(vw.z); vd[6] = bflo(vw.w); vd[7] = bfhi(vw.w); } }
        __syncthreads();
        const int d = tid >> 3, e0 = (tid & 7) * 8;
        float af[8], ab[8];
#pragma unroll
        for (int i = 0; i < 8; ++i) { af[i] = 0.f; ab[i] = 0.f; }
        for (int j = 0; j < 128; ++j) { const float kd = Ks[j * 64 + d], kf = kd * pf[j], kb = kd * pb[j];
            const f32x4 v0 = *(const LAS f32x4*)(Vs + j * 64 + e0), v1 = *(const LAS f32x4*)(Vs + j * 64 + e0 + 4);
            af[0] += kf * v0.x; af[1] += kf * v0.y; af[2] += kf * v0.z; af[3] += kf * v0.w; af[4] += kf * v1.x; af[5] += kf * v1.y; af[6] += kf * v1.z; af[7] += kf * v1.w;
            ab[0] += kb * v0.x; ab[1] += kb * v0.y; ab[2] += kb * v0.z; ab[3] += kb * v0.w; ab[4] += kb * v1.x; ab[5] += kb * v1.y; ab[6] += kb * v1.z; ab[7] += kb * v1.w; }
        float* o0 = ST + st_off(b, c, h, 0) + d * 64 + e0; float* o1 = ST + st_off(b, c, h, 1) + d * 64 + e0;
        *(f32x4*)o0 = (f32x4){af[0], af[1], af[2], af[3]}; *(f32x4*)(o0 + 4) = (f32x4){af[4], af[5], af[6], af[7]};
        *(f32x4*)o1 = (f32x4){ab[0], ab[1], ab[2], ab[3]}; *(f32x4*)(o1 + 4) = (f32x4){ab[4], ab[5], ab[6], ab[7]};
    }
    __syncthreads();
}

__device__ __forceinline__ void phase_c(const Args& a, int l, int tid) {
    float* ST = (float*)(a.ws + WS_ST);
    for (int it = blockIdx.x * NTHR + tid; it < 8 * 8 * 2 * 1024; it += gridDim.x * NTHR) {
        const int q = it & 1023, dir = (it >> 10) & 1, h = (it >> 11) & 7, b = it >> 14;
        const float lg = log_sigmoid_f(dir ? a.in[9][l * 8 + h] : a.in[8][l * 8 + h]); const float dec = expf(128.0f * lg);
        f32x4 kv[NCH];
#pragma unroll
        for (int s = 0; s < NCH; ++s) { const int c = dir ? (s < 2 ? 1 - s : 35 - s) : s; kv[s] = *(const f32x4*)(ST + st_off(b, c, h, dir) + q * 4); }
        f32x4 st = (f32x4){0.f, 0.f, 0.f, 0.f};
#pragma unroll
        for (int s = 0; s < NCH; ++s) { const int c = dir ? (s < 2 ? 1 - s : 35 - s) : s; *(f32x4*)(ST + st_off(b, c, h, dir) + q * 4) = st; st = st * dec + kv[s]; }
    }
}
__device__ __forceinline__ void unpack8(const v4u w, float* f) { f[0] = bflo(w.x); f[1] = bfhi(w.x); f[2] = bflo(w.y); f[3] = bfhi(w.y); f[4] = bflo(w.z); f[5] = bfhi(w.z); f[6] = bflo(w.w); f[7] = bfhi(w.w); }
__device__ __forceinline__ v4u pack8(const float* f) { v4u w; w.x = pk2(f[0], f[1]); w.y = pk2(f[2], f[3]); w.z = pk2(f[4], f[5]); w.w = pk2(f[6], f[7]); return w; }

__device__ __forceinline__ void phase_d(const Args& a, int l, LAS unsigned char* lds, int tid, int lane) {
    const bf16* P = (const bf16*)(a.ws + WS_P); const float* ST = (const float*)(a.ws + WS_ST); bf16* Y = (bf16*)(a.ws + WS_YMIX);
    const float* convw = a.in[7] + l * 3 * 256; const float* sguw = a.in[10] + (size_t)l * 4 * 128 * 128; const float* sgub = a.in[11] + l * 4 * 128;
    const int c_lo = l == 1 ? 2 : 0, cpb = NCH - c_lo, nunits = 8 * cpb;
    LAS float* Sf = (LAS float*)lds; LAS float* Sb = (LAS float*)(lds + 16384); LAS float* Ks = (LAS float*)(lds + 32768); LAS float* Vs = (LAS float*)(lds + 65536);
    LAS float* VN = (LAS float*)lds;
    for (int u = blockIdx.x; u < nunits; u += gridDim.x) {
        const int b = u / cpb, c = c_lo + u % cpb; const int row0 = chunk_row0(b, c); const bool isc = c < 2;
#ifndef NO_D1
        for (int idx = tid; idx < 128 * 32; idx += NTHR) {
            const int p = idx >> 5, ch0 = (idx & 31) * 8; const int row = row0 + p;
            int dprev = -1, dnext = 1; bool vprev, vnext;
            if (isc) { const int t = c * 128 + p; vprev = t > 0; vnext = t < 255; }
            else { const int t = (c - 2) * 128 + p;
                if (ch0 < 128) { const int col = t & 63; vprev = col > 0; vnext = col < 63; }
                else { const int rg = t >> 6; vprev = rg > 0; vnext = rg < 63; dprev = -64; dnext = 64; } }
            const bf16* pr = P + (size_t)row * INC;
            float cb[8], zc[8], zp[8], zn[8], t0[8], t1[8];
            unpack8(*(const v4u*)(pr + OFF_CB + ch0), cb);
            unpack8(*(const v4u*)(pr + OFF_CC + ch0), t0); unpack8(*(const v4u*)(pr + OFF_CX + ch0), t1);
#pragma unroll
            for (int i = 0; i < 8; ++i) { zc[i] = t0[i] * t1[i]; zp[i] = 0.f; zn[i] = 0.f; }
            if (vprev) { const bf16* q = pr + (ptrdiff_t)dprev * INC; unpack8(*(const v4u*)(q + OFF_CC + ch0), t0); unpack8(*(const v4u*)(q + OFF_CX + ch0), t1);
#pragma unroll
                for (int i = 0; i < 8; ++i) zp[i] = t0[i] * t1[i]; }
            if (vnext) { const bf16* q = pr + (ptrdiff_t)dnext * INC; unpack8(*(const v4u*)(q + OFF_CC + ch0), t0); unpack8(*(const v4u*)(q + OFF_CX + ch0), t1);
#pragma unroll
                for (int i = 0; i < 8; ++i) zn[i] = t0[i] * t1[i]; }
            float o[8];
#pragma unroll
            for (int i = 0; i < 8; ++i) o[i] = cb[i] * (convw[ch0 + i] * zp[i] + convw[256 + ch0 + i] * zc[i] + convw[512 + ch0 + i] * zn[i]);
            *(v4u*)(Y + (size_t)row * 1024 + ch0) = pack8(o);
        }
#endif
        const int i = tid >> 2, part = tid & 3;
#ifndef NO_D2
#pragma unroll 1
        for (int h = 0; h < 8; ++h) {
            __syncthreads();
            { const bf16* kp = P + (size_t)(row0 + i) * INC + OFF_K + h * 64 + part * 16; const bf16* vp = kp + (OFF_V - OFF_K);
#pragma unroll
              for (int q = 0; q < 2; ++q) { float kf[8], vf[8]; unpack8(*(const v4u*)(kp + 8 * q), kf); unpack8(*(const v4u*)(vp + 8 * q), vf);
                  LAS float* kd = Ks + i * 64 + part * 16 + 8 * q; LAS float* vd = Vs + i * 64 + part * 16 + 8 * q;
#pragma unroll
                  for (int e = 0; e < 8; ++e) { kd[e] = kf[e]; vd[e] = vf[e]; } }
              const float* sf = ST + st_off(b, c, h, 0); const float* sb = ST + st_off(b, c, h, 1);
#pragma unroll
              for (int q = 0; q < 2; ++q) { const int o4 = (tid + NTHR * q) * 4; *(LAS f32x4*)(Sf + o4) = *(const f32x4*)(sf + o4); *(LAS f32x4*)(Sb + o4) = *(const f32x4*)(sb + o4); } }
            float qv[16];
            { const bf16* qp = P + (size_t)(row0 + i) * INC + OFF_Q + h * 64 + part * 16; unpack8(*(const v4u*)qp, qv); unpack8(*(const v4u*)(qp + 8), qv + 8); }
            const float lgf = log_sigmoid_f(a.in[8][l * 8 + h]), lgb = log_sigmoid_f(a.in[9][l * 8 + h]);
            __syncthreads();
            float o[16];
#pragma unroll
            for (int e = 0; e < 16; ++e) o[e] = 0.f;
#pragma unroll 1
            for (int j = 0; j < 128; ++j) {
                const LAS f32x4* kr = (const LAS f32x4*)(Ks + j * 64 + part * 16);
                float s = 0.f;
#pragma unroll
                for (int q = 0; q < 4; ++q) { const f32x4 k4 = kr[q]; s += qv[4 * q] * k4.x + qv[4 * q + 1] * k4.y + qv[4 * q + 2] * k4.z + qv[4 * q + 3] * k4.w; }
                s += __shfl_xor(s, 1); s += __shfl_xor(s, 2);
                const int rel = i - j;
                const float dec = rel > 0 ? expf(lgf * (float)rel) : (rel < 0 ? expf(lgb * (float)(-rel)) : 2.0f);
                s *= dec;
                const LAS f32x4* vr = (const LAS f32x4*)(Vs + j * 64 + part * 16);
#pragma unroll
                for (int q = 0; q < 4; ++q) { const f32x4 v4 = vr[q]; o[4 * q] += s * v4.x; o[4 * q + 1] += s * v4.y; o[4 * q + 2] += s * v4.z; o[4 * q + 3] += s * v4.w; }
            }
            float of[16], ob[16];
#pragma unroll
            for (int e = 0; e < 16; ++e) { of[e] = 0.f; ob[e] = 0.f; }
            __syncthreads();
#pragma unroll
            for (int dd = 0; dd < 16; ++dd) Ks[i * 64 + ((part * 16 + dd + i) & 63)] = qv[dd];
            __syncthreads();
#pragma unroll 2
            for (int d = 0; d < 64; ++d) { const float qd = Ks[i * 64 + ((d + i) & 63)];
                const LAS f32x4* fr = (const LAS f32x4*)(Sf + d * 64 + part * 16); const LAS f32x4* br = (const LAS f32x4*)(Sb + d * 64 + part * 16);
#pragma unroll
                for (int q = 0; q < 4; ++q) { const f32x4 f4 = fr[q], b4 = br[q];
                    of[4 * q] += qd * f4.x; of[4 * q + 1] += qd * f4.y; of[4 * q + 2] += qd * f4.z; of[4 * q + 3] += qd * f4.w;
                    ob[4 * q] += qd * b4.x; ob[4 * q + 1] += qd * b4.y; ob[4 * q + 2] += qd * b4.z; ob[4 * q + 3] += qd * b4.w; } }
            const float df = expf(lgf * (float)(i + 1)), db = expf(lgb * (float)(128 - i));
            float sum = 0.f;
#pragma unroll
            for (int e = 0; e < 16; ++e) { o[e] += df * of[e] + db * ob[e]; sum += o[e]; }
            sum += __shfl_xor(sum, 1); sum += __shfl_xor(sum, 2);
            const float mu = sum * (1.0f / 64.0f); float vs = 0.f;
#pragma unroll
            for (int e = 0; e < 16; ++e) { o[e] -= mu; vs += o[e] * o[e]; }
            vs += __shfl_xor(vs, 1); vs += __shfl_xor(vs, 2);
            const float rs = 1.0f / sqrtf(vs * (1.0f / 64.0f) + LN_EPS);
            float gv[16];
            { const bf16* gp = P + (size_t)(row0 + i) * INC + OFF_G + h * 64 + part * 16; unpack8(*(const v4u*)gp, gv); unpack8(*(const v4u*)(gp + 8), gv + 8); }
#pragma unroll
            for (int e = 0; e < 16; ++e) o[e] = (gv[e] / (1.0f + expf(-gv[e]))) * (o[e] * rs);
            bf16* yp = Y + (size_t)(row0 + i) * 1024 + 256 + h * 64 + part * 16;
            *(v4u*)yp = pack8(o); *(v4u*)(yp + 8) = pack8(o + 8);
        }
#endif
#ifndef NO_D3
        __syncthreads();
        {
            const bf16* vp = P + (size_t)(row0 + i) * INC + OFF_VV + part * 64;
            float sum = 0.f;
#pragma unroll 2
            for (int q = 0; q < 8; ++q) { float t8[8]; unpack8(*(const v4u*)(vp + 8 * q), t8);
#pragma unroll
                for (int e = 0; e < 8; ++e) sum += t8[e]; }
            sum += __shfl_xor(sum, 1); sum += __shfl_xor(sum, 2);
            const float mu = sum * (1.0f / 256.0f); float vs = 0.f;
#pragma unroll 2
            for (int q = 0; q < 8; ++q) { float t8[8]; unpack8(*(const v4u*)(vp + 8 * q), t8);
#pragma unroll
                for (int e = 0; e < 8; ++e) { const float dlt = t8[e] - mu; vs += dlt * dlt; } }
            vs += __shfl_xor(vs, 1); vs += __shfl_xor(vs, 2);
            const float rs = 1.0f / sqrtf(vs * (1.0f / 256.0f) + LN_EPS);
            LAS float* dst = VN + (part * 128 + i) * 64;
#pragma unroll 2
            for (int q = 0; q < 8; ++q) { float t8[8]; unpack8(*(const v4u*)(vp + 8 * q), t8);
                *(LAS f32x4*)(dst + 8 * q) = (f32x4){(t8[0] - mu) * rs, (t8[1] - mu) * rs, (t8[2] - mu) * rs, (t8[3] - mu) * rs};
                *(LAS f32x4*)(dst + 8 * q + 4) = (f32x4){(t8[4] - mu) * rs, (t8[5] - mu) * rs, (t8[6] - mu) * rs, (t8[7] - mu) * rs}; }
        }
        __syncthreads();
        for (int g = 0; g < 4; ++g) {
            float acc[16];
#pragma unroll
            for (int e = 0; e < 16; ++e) acc[e] = 0.f;
            const float* wrow = sguw + ((size_t)g * 128 + i) * 128;
            for (int q = 0; q < 128; q += 4) { const f32x4 w4 = *(const f32x4*)(wrow + q);
#pragma unroll
                for (int qq = 0; qq < 4; ++qq) { const float w = w4[qq]; const LAS f32x4* vr = (const LAS f32x4*)(VN + (g * 128 + q + qq) * 64 + part * 16);
#pragma unroll
                    for (int t = 0; t < 4; ++t) { const f32x4 v4 = vr[t]; acc[4 * t] += w * v4.x; acc[4 * t + 1] += w * v4.y; acc[4 * t + 2] += w * v4.z; acc[4 * t + 3] += w * v4.w; } } }
            const float bias = sgub[g * 128 + i];
            float uv[16];
            { const bf16* up = P + (size_t)(row0 + i) * INC + OFF_U + g * 64 + part * 16; unpack8(*(const v4u*)up, uv); unpack8(*(const v4u*)(up + 8), uv + 8); }
#pragma unroll
            for (int e = 0; e < 16; ++e) acc[e] = uv[e] * (acc[e] + bias);
            bf16* yp = Y + (size_t)(row0 + i) * 1024 + 768 + g * 64 + part * 16;
            *(v4u*)yp = pack8(acc); *(v4u*)(yp + 8) = pack8(acc + 8);
        }
#endif
        __syncthreads();
    }
}

__device__ __forceinline__ void phase_f(const Args& a, int l, LAS unsigned char* lds, int tid, int lane, int wave) {
    LAS int* lcnt = (LAS int*)lds;
    __syncthreads();
    if (tid < 32) lcnt[tid] = 0;
    __syncthreads();
    const int gw = blockIdx.x * NWAVES + wave, NGW = gridDim.x * NWAVES, nrows = l == 0 ? NROWS : NLAT;
    const float* mod = (const float*)(a.ws + WS_MOD) + l * 9 * 6144;
    const float* lng = a.in[13] + l * 1024; const float* lnb = a.in[14] + l * 1024;
    const float* rgw = a.in[15] + l * 1024 * 4; const float* rgb = a.in[16] + l * 4; const float* rew = a.in[17] + (size_t)l * 4 * 1024 * 8; const float* reb = a.in[18] + l * 32;
    bf16* Hb = (bf16*)(a.ws + WS_HB); unsigned* tok = (unsigned*)(a.ws + WS_TOK); float* xctx = (float*)(a.ws + WS_XCTX);
    for (int row = gw; row < nrows; row += NGW) {
        float* xr = row < NLAT ? a.out + (size_t)row * 1024 : xctx + (size_t)(row - NLAT) * 1024;
        const float* m0 = mod + (row < NLAT ? (row >> 12) : 8) * 6144;
        f32x4 v[4]; float s = 0.f;
#pragma unroll
        for (int j = 0; j < 4; ++j) { v[j] = *(const f32x4*)(xr + (lane + 64 * j) * 4); s += (v[j].x + v[j].y) + (v[j].z + v[j].w); }
        const float mean = wave_sum(s) * (1.0f / 1024.0f); float s2 = 0.f;
#pragma unroll
        for (int j = 0; j < 4; ++j) { v[j] = v[j] - mean; s2 += (v[j].x * v[j].x + v[j].y * v[j].y) + (v[j].z * v[j].z + v[j].w * v[j].w); }
        const float rstd = 1.0f / sqrtf(wave_sum(s2) * (1.0f / 1024.0f) + LN_EPS);
        float lg[4] = {0.f, 0.f, 0.f, 0.f};
#pragma unroll
        for (int j = 0; j < 4; ++j) { const int idx = (lane + 64 * j) * 4;
            const f32x4 x1 = v[j] * rstd * *(const f32x4*)(lng + idx) + *(const f32x4*)(lnb + idx);
            *(f32x4*)(xr + idx) = x1;
            const f32x4 hm = x1 * (*(const f32x4*)(m0 + 4096 + idx) + 1.0f) + *(const f32x4*)(m0 + 3072 + idx);
            v[j] = hm;
            v2u w; w.x = pk2(hm.x, hm.y); w.y = pk2(hm.z, hm.w); *(v2u*)(Hb + (size_t)row * 1024 + idx) = w;
#pragma unroll
            for (int t = 0; t < 4; ++t) { const f32x4 w4 = *(const f32x4*)(rgw + (idx + t) * 4); const float hv = hm[t];
                lg[0] += hv * w4.x; lg[1] += hv * w4.y; lg[2] += hv * w4.z; lg[3] += hv * w4.w; } }
#pragma unroll
        for (int g = 0; g < 4; ++g) lg[g] = wave_sum(lg[g]) + rgb[g];
        int gi = 0; float gm = lg[0];
#pragma unroll
        for (int g = 1; g < 4; ++g) if (lg[g] > gm) { gm = lg[g]; gi = g; }
        float gden = 0.f;
#pragma unroll
        for (int g = 0; g < 4; ++g) gden += expf(lg[g] - gm);
        const float gprob = 1.0f / gden;
        float le[8] = {0.f, 0.f, 0.f, 0.f, 0.f, 0.f, 0.f, 0.f};
        const float* rw = rew + (size_t)gi * 1024 * 8;
#pragma unroll
        for (int j = 0; j < 4; ++j) { const int idx = (lane + 64 * j) * 4;
#pragma unroll
            for (int t = 0; t < 4; ++t) { const f32x4 w0 = *(const f32x4*)(rw + (idx + t) * 8), w1 = *(const f32x4*)(rw + (idx + t) * 8 + 4); const float hv = v[j][t];
                le[0] += hv * w0.x; le[1] += hv * w0.y; le[2] += hv * w0.z; le[3] += hv * w0.w; le[4] += hv * w1.x; le[5] += hv * w1.y; le[6] += hv * w1.z; le[7] += hv * w1.w; } }
#pragma unroll
        for (int e = 0; e < 8; ++e) le[e] = wave_sum(le[e]) + reb[gi * 8 + e];
        int i1 = 0; float m1 = le[0];
#pragma unroll
        for (int e = 1; e < 8; ++e) if (le[e] > m1) { m1 = le[e]; i1 = e; }
        int i2 = -1; float m2 = -3.0e38f;
#pragma unroll
        for (int e = 0; e < 8; ++e) if (e != i1 && le[e] > m2) { m2 = le[e]; i2 = e; }
        const float p2 = expf(m2 - m1), inv = 1.0f / (1.0f + p2);
        const float gate0 = gprob * inv, gate1 = gprob * p2 * inv;
        if (lane == 0) { const int e0 = gi * 8 + i1, e1 = gi * 8 + i2;
            const int p0 = __hip_atomic_fetch_add(lcnt + e0, 1, __ATOMIC_RELAXED, __HIP_MEMORY_SCOPE_WORKGROUP);
            const int p1 = __hip_atomic_fetch_add(lcnt + e1, 1, __ATOMIC_RELAXED, __HIP_MEMORY_SCOPE_WORKGROUP);
            unsigned* t = tok + (size_t)row * 8; t[0] = (unsigned)e0 | ((unsigned)e1 << 8); t[1] = (unsigned)p0; t[2] = (unsigned)p1;
            t[3] = __builtin_bit_cast(unsigned, gate0); t[4] = __builtin_bit_cast(unsigned, gate1); }
    }
    __syncthreads();
    if (tid < 32) ((unsigned*)(a.ws + WS_CTL))[CW_WGCNT + (l * 256 + blockIdx.x) * 32 + tid] = (unsigned)lcnt[tid];
    __syncthreads();
}

__device__ __forceinline__ void phase_g(const Args& a, int l, LAS unsigned char* lds, int tid, int lane, int wave) {
    LAS int* cn = (LAS int*)lds; LAS int* base = (LAS int*)(lds + 32768); LAS int* pst = base + 32; LAS int* totl = base + 80;
    unsigned* ctl = (unsigned*)(a.ws + WS_CTL);
    __syncthreads();
    for (int i = tid; i < 256 * 32; i += NTHR) cn[i] = (int)ctl[CW_WGCNT + l * 256 * 32 + i];
    __syncthreads();
    if (tid < 32) { int tot = 0, bs = 0; for (int w = 0; w < 256; ++w) { const int v = cn[w * 32 + tid]; if (w < (int)blockIdx.x) bs += v; tot += v; } base[tid] = bs; totl[tid] = tot; }
    __syncthreads();
    if (tid == 0) { int run = 0; for (int e = 0; e < 32; ++e) { pst[e] = run; run += ((totl[e] + 255) >> 8) << 8; } pst[32] = run; }
    __syncthreads();
    if (blockIdx.x == 0 && tid < 32) ctl[CW_TOT + l * 64 + tid] = (unsigned)totl[tid];
    const int gw = blockIdx.x * NWAVES + wave, NGW = gridDim.x * NWAVES, nrows = l == 0 ? NROWS : NLAT;
    const bf16* Hb = (const bf16*)(a.ws + WS_HB); bf16* XB = (bf16*)(a.ws + WS_XB); unsigned* tok = (unsigned*)(a.ws + WS_TOK);
    for (int row = gw; row < nrows; row += NGW) {
        unsigned* t = tok + (size_t)row * 8; const unsigned ee = t[0]; const int e0 = ee & 255, e1 = (ee >> 8) & 255;
        const int s0 = pst[e0] + base[e0] + (int)t[1], s1 = pst[e1] + base[e1] + (int)t[2];
        if (lane == 0) { t[5] = (unsigned)s0; t[6] = (unsigned)s1; }
        const v4u a0 = *(const v4u*)(Hb + (size_t)row * 1024 + lane * 8), a1 = *(const v4u*)(Hb + (size_t)row * 1024 + 512 + lane * 8);
        *(v4u*)(XB + (size_t)s0 * 1024 + lane * 8) = a0; *(v4u*)(XB + (size_t)s0 * 1024 + 512 + lane * 8) = a1;
        *(v4u*)(XB + (size_t)s1 * 1024 + lane * 8) = a0; *(v4u*)(XB + (size_t)s1 * 1024 + 512 + lane * 8) = a1;
    }
    __syncthreads();
}

__device__ __forceinline__ int build_p2e(const Args& a, int l, LAS unsigned char* lds, int tid) {
    LAS unsigned char* p2e = lds + P2E_OFF; LAS int* np = (LAS int*)(lds + PST_OFF);
    const unsigned* ctl = (const unsigned*)(a.ws + WS_CTL);
    __syncthreads();
    if (tid == 0) { int pm = 0; for (int e = 0; e < 32; ++e) { const int n = ((int)ctl[CW_TOT + l * 64 + e] + 255) >> 8; for (int k = 0; k < n && pm < MAXPANELS; ++k) p2e[pm++] = (unsigned char)e; } np[0] = pm; }
    __syncthreads();
    return np[0];
}

__device__ __forceinline__ void phase_j(const Args& a, int l, int lane, int wave) {
    const int gw = blockIdx.x * NWAVES + wave, NGW = gridDim.x * NWAVES, nrows = l == 0 ? NROWS : NLAT;
    const float* mod = (const float*)(a.ws + WS_MOD) + l * 9 * 6144; const float* modn = (const float*)(a.ws + WS_MOD) + 9 * 6144;
    const float* lng = a.in[22] + l * 1024; const float* lnb = a.in[23] + l * 1024;
    bf16* Hb = (bf16*)(a.ws + WS_HB); const bf16* Y = (const bf16*)(a.ws + WS_Y); const unsigned* tok = (const unsigned*)(a.ws + WS_TOK); float* xctx = (float*)(a.ws + WS_XCTX);
    for (int row = gw; row < nrows; row += NGW) {
        float* xr = row < NLAT ? a.out + (size_t)row * 1024 : xctx + (size_t)(row - NLAT) * 1024;
        const int mrow = row < NLAT ? (row >> 12) : 8; const float* m0 = mod + mrow * 6144;
        const unsigned* t = tok + (size_t)row * 8; const float g0 = __builtin_bit_cast(float, t[3]), g1 = __builtin_bit_cast(float, t[4]);
        const bf16* y0 = Y + (size_t)t[5] * 1024; const bf16* y1 = Y + (size_t)t[6] * 1024;
        f32x4 v[4]; float s = 0.f;
#pragma unroll
        for (int j = 0; j < 4; ++j) { const int idx = (lane + 64 * j) * 4;
            const f32x4 x1 = *(const f32x4*)(xr + idx); const v2u w0 = *(const v2u*)(y0 + idx), w1 = *(const v2u*)(y1 + idx);
            const f32x4 ya = (f32x4){bflo(w0.x), bfhi(w0.x), bflo(w0.y), bfhi(w0.y)}, yb = (f32x4){bflo(w1.x), bfhi(w1.x), bflo(w1.y), bfhi(w1.y)};
            v[j] = x1 * ALPHA + *(const f32x4*)(m0 + 5120 + idx) * (ya * g0 + yb * g1);
            s += (v[j].x + v[j].y) + (v[j].z + v[j].w); }
        const float mean = wave_sum(s) * (1.0f / 1024.0f); float s2 = 0.f;
#pragma unroll
        for (int j = 0; j < 4; ++j) { v[j] = v[j] - mean; s2 += (v[j].x * v[j].x + v[j].y * v[j].y) + (v[j].z * v[j].z + v[j].w * v[j].w); }
        const float rstd = 1.0f / sqrtf(wave_sum(s2) * (1.0f / 1024.0f) + LN_EPS);
#pragma unroll
        for (int j = 0; j < 4; ++j) { const int idx = (lane + 64 * j) * 4;
            const f32x4 x2 = v[j] * rstd * *(const f32x4*)(lng + idx) + *(const f32x4*)(lnb + idx);
            *(f32x4*)(xr + idx) = x2;
            if (l == 0) { const float* m1 = modn + mrow * 6144; const f32x4 hh = x2 * (*(const f32x4*)(m1 + 1024 + idx) + 1.0f) + *(const f32x4*)(m1 + idx);
                v2u w; w.x = pk2(hh.x, hh.y); w.y = pk2(hh.z, hh.w); *(v2u*)(Hb + (size_t)row * 1024 + idx) = w; } }
    }
}
#ifndef MK_PER_PHASE
#define MK_PER_PHASE 0
#endif
constexpr int N_PHASES = 22;

__global__ void __launch_bounds__(NTHR, 2) hybrid_fwd(Args args) {
    extern __shared__ __attribute__((aligned(16))) unsigned char lds_raw[];
    LAS unsigned char* lds = (LAS unsigned char*)lds_raw;
    const int tid0 = threadIdx.x;
    for (int u = tid0; u < (LDS_BYTES - LDSCTL_OFF) / 4; u += NTHR) ((LAS unsigned*)(lds + LDSCTL_OFF))[u] = 0u;
#define TIDS int tid = threadIdx.x; asm volatile("" : "+v"(tid)); const int lane = tid & 63, wave = __builtin_amdgcn_readfirstlane(tid >> 6); (void)lane; (void)wave
    __syncthreads();
    unsigned* ctl = (unsigned*)(args.ws + WS_CTL);
    XcdBarrier bar; bar.bar = ctl + CW_BAR; bar.x = 0; bar.st = nullptr;
    if (!MK_PER_PHASE) bar = xcd_barrier_post(ctl + CW_BAR, (volatile LAS unsigned*)(lds + MISC_OFF + 32));
    const int lo = args.ph_lo, hi = args.ph_hi;
#ifndef PHMASK
#define PHMASK 0xFFFFFFu
#endif
#define PHON(k) (((PHMASK) >> ((k) < 2 ? (k) : 2 + ((k) - 2) % 10)) & 1u)
#define IN(k) (PHON(k) && lo <= (k) && (k) < hi)
#define SEAM(k) do { if (IN(k) && IN((k) + 1)) xcd_barrier(bar); } while (0)

    if (IN(0)) { TIDS; phase_p0(args, lds, tid, lane, wave); }
    SEAM(0);
    if (IN(1)) { TIDS; phase_p1(args, lane, wave); }
    SEAM(1);
    for (int l = 0; l < 2; ++l) {
        const int pb = 2 + 10 * l;
        bf16* Hb = (bf16*)(args.ws + WS_HB);
        if (IN(pb + 0)) {
            pg8::Gemm g{Hb, (const bf16*)(args.ws + WS_WIN) + (size_t)l * INC * 1024, NROWS, INC, 1024}; pg8::StaticOrder S; S.init(NROWS, INC, (int)gridDim.x, (int)blockIdx.x);
            pg8::EpiBf16<0> E{(bf16*)(args.ws + WS_P), INC, nullptr, 0, 0, 1.0f};
            pg8::gemm_phase<pg8::EpiBf16<0>, pg8::StaticOrder, true, true>(lds, g, S, E);
        }
        SEAM(pb + 0);
        if (IN(pb + 1)) { TIDS; phase_b(args, l, lds, tid); }
        SEAM(pb + 1);
        if (IN(pb + 2)) { TIDS; phase_c(args, l, tid); }
        SEAM(pb + 2);
        if (IN(pb + 3)) { TIDS; phase_d(args, l, lds, tid, lane); }
        SEAM(pb + 3);
        if (IN(pb + 4)) {
            const int M = l == 0 ? NROWS : NLAT;
            pg8::Gemm g{(const bf16*)(args.ws + WS_YMIX), (const bf16*)(args.ws + WS_WOUT) + (size_t)l * 1024 * 1024, M, 1024, 1024}; pg8::StaticOrder S; S.init(M, 1024, (int)gridDim.x, (int)blockIdx.x);
            float* xctx = (float*)(args.ws + WS_XCTX);
            pg8::EpiResid E{l == 0 ? args.in[0] : args.out, l == 0 ? args.in[2] : xctx, args.out, xctx, (const float*)(args.ws + WS_MOD) + l * 9 * 6144, ALPHA};
            pg8::gemm_phase<pg8::EpiResid, pg8::StaticOrder, true, true>(lds, g, S, E);
        }
        SEAM(pb + 4);
        if (IN(pb + 5)) { TIDS; phase_f(args, l, lds, tid, lane, wave); }
        SEAM(pb + 5);
        if (IN(pb + 6)) { TIDS; phase_g(args, l, lds, tid, lane, wave); }
        SEAM(pb + 6);
        if (IN(pb + 7)) {
            int npan; { TIDS; npan = build_p2e(args, l, lds, tid); }
            pg8::Gemm g{(const bf16*)(args.ws + WS_XB), (const bf16*)(args.ws + WS_WGU) + (size_t)l * 32 * 1024 * 1024, npan * 256, 1024, 1024};
            pg8::MoeOrder S{(const LAS unsigned char*)(lds + P2E_OFF), npan * 4, (int)gridDim.x, (int)blockIdx.x};
            pg8::EpiGLU E{(bf16*)(args.ws + WS_HH)};
            pg8::gemm_phase<pg8::EpiGLU, pg8::MoeOrder, true, true>(lds, g, S, E);
        }
        SEAM(pb + 7);
        if (IN(pb + 8)) {
            int npan; { TIDS; npan = build_p2e(args, l, lds, tid); }
            pg8::Gemm g{(const bf16*)(args.ws + WS_HH), (const bf16*)(args.ws + WS_WD) + (size_t)l * 32 * 1024 * 512, npan * 256, 1024, 512};
            pg8::MoeOrder S{(const LAS unsigned char*)(lds + P2E_OFF), npan * 4, (int)gridDim.x, (int)blockIdx.x};
            pg8::EpiY E{(bf16*)(args.ws + WS_Y)};
            pg8::gemm_phase<pg8::EpiY, pg8::MoeOrder, true, true>(lds, g, S, E);
        }
        SEAM(pb + 8);
        if (IN(pb + 9)) { TIDS; phase_j(args, l, lane, wave); }
        SEAM(pb + 9);
    }
#undef IN
#undef SEAM
}

extern "C" void kernel_launch(void* const* d_in, const int* in_sizes, int n_in, void* d_out, int out_size, void* d_ws, size_t ws_size, hipStream_t stream) {
    static int grid = 0;
    if (grid == 0) {
        if (n_in != 24 || in_sizes[0] != NLAT * DM || out_size != NLAT * DM || ws_size < WS_END) { fprintf(stderr, "kernel_launch: unexpected problem (n_in %d, ws %zu < %zu?)\n", n_in, ws_size, (size_t)WS_END); grid = -1; return; }
        int dev = 0, cus = 0, per_cu = 0;
        if (hipGetDevice(&dev) != hipSuccess || hipDeviceGetAttribute(&cus, hipDeviceAttributeMultiprocessorCount, dev) != hipSuccess) { grid = -1; return; }
        if (hipFuncSetAttribute((const void*)hybrid_fwd, hipFuncAttributeMaxDynamicSharedMemorySize, LDS_BYTES) != hipSuccess) { grid = -1; return; }
        if (hipOccupancyMaxActiveBlocksPerMultiprocessor(&per_cu, (const void*)hybrid_fwd, NTHR, LDS_BYTES) != hipSuccess || per_cu < 1) { fprintf(stderr, "kernel_launch: occupancy query says %d\n", per_cu); }
        (void)hipGetLastError();
        grid = cus;
        if (grid != 256) { fprintf(stderr, "kernel_launch: built for 256 CUs, device has %d\n", cus); grid = -1; return; }
    }
    if (grid < 0) return;
    if (hipMemsetAsync((char*)d_ws + WS_CTL, 0, CTL_ZERO_BYTES, stream) != hipSuccess) return;
    Args a{};
    for (int i = 0; i < 24; ++i) a.in[i] = (const float*)d_in[i];
    a.out = (float*)d_out; a.ws = (unsigned char*)d_ws;
#if MK_PER_PHASE
    for (int p = 0; p < N_PHASES; ++p) { a.ph_lo = p; a.ph_hi = p + 1; hipLaunchKernelGGL(hybrid_fwd, dim3(grid), dim3(NTHR), LDS_BYTES, stream, a); }
#else
    a.ph_lo = 0; a.ph_hi = N_PHASES;
    hipLaunchKernelGGL(hybrid_fwd, dim3(grid), dim3(NTHR), LDS_BYTES, stream, a);
#endif
}
```

```cpp
#include <hip/hip_runtime.h>
#include <cstdio>
#include <cstdint>
#include <cstddef>
namespace pg8 {
#define PG8_LAS __attribute__((address_space(3)))
typedef unsigned short bf16_t;
typedef short bf16x8 __attribute__((ext_vector_type(8)));
typedef float f32x4 __attribute__((ext_vector_type(4)));
typedef unsigned u32x4 __attribute__((ext_vector_type(4)));
constexpr int BM = 256, BK = 64, HALF = 128, HTB = HALF * BK * 2  , STAGE_BYTES = 8 * HTB, NXCD = 8, WGM = 8;

__host__ __device__ __forceinline__ int lds_byte(int r, int c) { const int st = (r >> 4) * 2 + (c >> 5), rr = r & 15, cc = c & 31, ob = rr * 64 + cc * 2; return st * 1024 + (ob ^ (((ob >> 9) & 1) << 5)); }
__host__ __device__ __forceinline__ void stage_rc(int b, int& R, int& C) { const int st = b / 1024, sb = b % 1024, swz = sb ^ (((sb >> 9) & 1) << 5); R = (st >> 1) * 16 + swz / 64; C = (st & 1) * 32 + (swz % 64) / 2; }
__host__ __device__ __forceinline__ int perm32(int rho) { const int n = rho >> 4, i = rho & 15; return 8 * (i >> 2) + 4 * n + (i & 3); }

struct Unit { int pm, pn; };
struct Gemm { const bf16_t* A; const bf16_t* Bt; int M, N, K; };

struct StaticOrder {
    int nM, nN, nwg, G, c;
    __host__ __device__ void init(int M, int N, int G_, int c_) { nM = M / BM; nN = N / BM; nwg = nM * nN; G = G_; c = c_; }
    __host__ __device__ bool next(int i, Unit& u) const {
        const long L = (long)i * G + c; if (L >= nwg) return false;
        int wgid = (int)L; { const int q = nwg / NXCD, r = nwg % NXCD, xcd = wgid % NXCD, off = wgid / NXCD; wgid = (xcd < r ? xcd * (q + 1) : r * (q + 1) + (xcd - r) * q) + off; }
        const int nig = WGM * nN, gid = wgid / nig, fm = gid * WGM, gsz = (nM - fm) < WGM ? (nM - fm) : WGM;
        u.pm = fm + ((wgid % nig) % gsz); u.pn = (wgid % nig) / gsz; return true;
    }
    __device__ __forceinline__ void a_ready(const Unit&) const {}
    __device__ __forceinline__ void done(const Unit&) const {}
};

__device__ __forceinline__ unsigned cvt_pk_bf16(float lo, float hi) { unsigned r; asm volatile("v_cvt_pk_bf16_f32 %0, %1, %2" : "=v"(r) : "v"(lo), "v"(hi)); return r; }
typedef float f32x2 __attribute__((ext_vector_type(2)));
__device__ __forceinline__ f32x2 gelu_pk(f32x2 v) {
    const f32x2 av = __builtin_elementwise_abs(v), d = av * 0.2316418882f + 1.0f;
    f32x2 t; t.x = __builtin_amdgcn_rcpf(d.x); t.y = __builtin_amdgcn_rcpf(d.y);
    f32x2 q = t * 0.5307027145f + (-0.7265760135f); q = q * t + 0.7107068705f; q = q * t + (-0.142248368f); q = q * t + 0.127414796f; q = q * t;
    const f32x2 s = (v * v) * (-0.72134752044f);
    f32x2 e; e.x = __builtin_amdgcn_exp2f(s.x); e.y = __builtin_amdgcn_exp2f(s.y);
    const f32x2 m = v * (q * e), r = v - m;
    f32x2 o; o.x = v.x < 0.f ? m.x : r.x; o.y = v.y < 0.f ? m.y : r.y; return o;
}

template <int ACT  > struct EpiBf16 {
    static constexpr bool PERM = true, AFTER_DRAIN = false; static_assert(ACT == 0 || ACT == 1, "EpiBf16: ACT is 0 (none) or 1 (gelu_pk)");
    bf16_t* O; int ldc; const float* bias; int split_cols; size_t split_stride; float scale0;
    __device__ __forceinline__ void operator()(const f32x4 (&acc)[2][2][4][2], const Unit& u, int wr, int wc, int fr, int fq) const {
        const int row0 = u.pm * BM + wr * 64 + fr; int colt = u.pn * BM; bf16_t* base = O;
        float sc = 1.f; if (split_cols) { const int t = colt / split_cols; base += (size_t)t * split_stride; colt -= t * split_cols; if (t == 0) sc = scale0; }
        const int col0 = colt + wc * 32 + 8 * fq, bcol0 = u.pn * BM + wc * 32 + 8 * fq;
        f32x4 bv[2][2];
#pragma unroll
        for (int bj = 0; bj < 2; ++bj)
#pragma unroll
            for (int n = 0; n < 2; ++n) bv[bj][n] = bias ? *(const f32x4*)(bias + bcol0 + bj * HALF + 4 * n) : (f32x4){0.f, 0.f, 0.f, 0.f};
#pragma unroll
        for (int ai = 0; ai < 2; ++ai)
#pragma unroll
            for (int m = 0; m < 4; ++m) { bf16_t* rowp = base + (size_t)(row0 + ai * HALF + m * 16) * ldc + col0;
#pragma unroll
                for (int bj = 0; bj < 2; ++bj) { f32x4 v0 = acc[ai][bj][m][0] + bv[bj][0], v1 = acc[ai][bj][m][1] + bv[bj][1];
                    if (ACT == 1) { f32x2 a = gelu_pk((f32x2){v0[0], v0[1]}), b = gelu_pk((f32x2){v0[2], v0[3]}), c = gelu_pk((f32x2){v1[0], v1[1]}), d = gelu_pk((f32x2){v1[2], v1[3]});
                        v0 = (f32x4){a.x, a.y, b.x, b.y}; v1 = (f32x4){c.x, c.y, d.x, d.y}; }
                    v0 = v0 * sc; v1 = v1 * sc; u32x4 w; w.x = cvt_pk_bf16(v0[0], v0[1]); w.y = cvt_pk_bf16(v0[2], v0[3]); w.z = cvt_pk_bf16(v1[0], v1[1]); w.w = cvt_pk_bf16(v1[2], v1[3]);
                    *(u32x4*)(rowp + bj * HALF) = w; } }
    }
};
__device__ __forceinline__ float silu_f(float x) { return x / (1.0f + __expf(-x)); }
struct EpiResid {
    static constexpr bool PERM = false, AFTER_DRAIN = false;
    const float* xin_lat; const float* xin_ctx; float* xo_lat; float* xo_ctx; const float* mod; float alpha;
    __device__ __forceinline__ void operator()(const f32x4 (&acc)[2][2][4][2], const Unit& u, int wr, int wc, int fr, int fq) const {
        const int prow0 = u.pm * BM; const bool isc = prow0 >= 32768;
        const float* xin = isc ? xin_ctx + (size_t)(prow0 - 32768) * 1024 : xin_lat + (size_t)prow0 * 1024;
        float* xo = isc ? xo_ctx + (size_t)(prow0 - 32768) * 1024 : xo_lat + (size_t)prow0 * 1024;
        const float* g1 = mod + (isc ? 8 : (prow0 >> 12)) * 6144 + 2048;
        const int col0 = u.pn * BM + wc * 32 + 4 * fq;
        f32x4 gv[2][2];
#pragma unroll
        for (int bj = 0; bj < 2; ++bj)
#pragma unroll
            for (int n = 0; n < 2; ++n) gv[bj][n] = *(const f32x4*)(g1 + col0 + bj * HALF + n * 16);
#pragma unroll
        for (int ai = 0; ai < 2; ++ai)
#pragma unroll
            for (int m = 0; m < 4; ++m) { const size_t off = (size_t)(ai * HALF + wr * 64 + m * 16 + fr) * 1024 + col0;
#pragma unroll
                for (int bj = 0; bj < 2; ++bj)
#pragma unroll
                    for (int n = 0; n < 2; ++n) { const f32x4 xv = *(const f32x4*)(xin + off + bj * HALF + n * 16);
                        *(f32x4*)(xo + off + bj * HALF + n * 16) = xv * alpha + gv[bj][n] * acc[ai][bj][m][n]; }
                if (m & 1) asm volatile("" ::: "memory"); }
    }
};
struct EpiGLU {
    static constexpr bool PERM = true, AFTER_DRAIN = false;
    bf16_t* Hh;
    __device__ __forceinline__ void operator()(const f32x4 (&acc)[2][2][4][2], const Unit& u, int wr, int wc, int fr, int fq) const {
        const int row0 = u.pm * BM + wr * 64 + fr; const int col0 = (u.pn & 3) * 128 + wc * 32 + 8 * fq;
#pragma unroll
        for (int ai = 0; ai < 2; ++ai)
#pragma unroll
            for (int m = 0; m < 4; ++m) { bf16_t* rowp = Hh + (size_t)(row0 + ai * HALF + m * 16) * 512 + col0;
                const f32x4 g0 = acc[ai][0][m][0], g1 = acc[ai][0][m][1], u0 = acc[ai][1][m][0], u1 = acc[ai][1][m][1];
                u32x4 w; w.x = cvt_pk_bf16(silu_f(g0[0]) * u0[0], silu_f(g0[1]) * u0[1]); w.y = cvt_pk_bf16(silu_f(g0[2]) * u0[2], silu_f(g0[3]) * u0[3]);
                w.z = cvt_pk_bf16(silu_f(g1[0]) * u1[0], silu_f(g1[1]) * u1[1]); w.w = cvt_pk_bf16(silu_f(g1[2]) * u1[2], silu_f(g1[3]) * u1[3]);
                *(u32x4*)rowp = w; }
    }
};
struct EpiY {
    static constexpr bool PERM = true, AFTER_DRAIN = false;
    bf16_t* O;
    __device__ __forceinline__ void operator()(const f32x4 (&acc)[2][2][4][2], const Unit& u, int wr, int wc, int fr, int fq) const {
        const int row0 = u.pm * BM + wr * 64 + fr; const int col0 = (u.pn & 3) * BM + wc * 32 + 8 * fq;
#pragma unroll
        for (int ai = 0; ai < 2; ++ai)
#pragma unroll
            for (int m = 0; m < 4; ++m) { bf16_t* rowp = O + (size_t)(row0 + ai * HALF + m * 16) * 1024 + col0;
#pragma unroll
                for (int bj = 0; bj < 2; ++bj) { const f32x4 v0 = acc[ai][bj][m][0], v1 = acc[ai][bj][m][1];
                    u32x4 w; w.x = cvt_pk_bf16(v0[0], v0[1]); w.y = cvt_pk_bf16(v0[2], v0[3]); w.z = cvt_pk_bf16(v1[0], v1[1]); w.w = cvt_pk_bf16(v1[2], v1[3]);
                    *(u32x4*)(rowp + bj * HALF) = w; } }
    }
};
struct MoeOrder {
    const PG8_LAS unsigned char* p2e; int nunits, G, c;
    __device__ __forceinline__ bool next(int i, Unit& u) const {
        const int L = i * G + c; if (L >= nunits) return false;
        u.pm = L >> 2; u.pn = (int)p2e[L >> 2] * 4 + (L & 3); return true;
    }
    __device__ __forceinline__ void a_ready(const Unit&) const {}
    __device__ __forceinline__ void done(const Unit&) const {}
};
template <class Epi, class Sched, bool ALIGN_EPI = false, bool SP2 = false>
__device__ __forceinline__ void gemm_phase(PG8_LAS unsigned char* lds, const Gemm g, const Sched& S, const Epi& E) {
    int tid_ = threadIdx.x; asm volatile("" : "+v"(tid_));
    const int tid = tid_, wid = __builtin_amdgcn_readfirstlane(tid >> 6), lane = tid & 63, wr = wid >> 2, wc = wid & 3, fr = lane & 15, fq = lane >> 4;
    const int K = g.K, nt = K / BK;
    unsigned voffA[2], voffB[2];
#pragma unroll
    for (int i = 0; i < 2; ++i) { int R, C; stage_rc(tid * 16 + i * 8192, R, C); const int Rb = Epi::PERM ? ((R & ~31) + perm32(R & 31)) : R;
        voffA[i] = (unsigned)(R * K + C) * 2u; voffB[i] = (unsigned)(Rb * K + C) * 2u; }
    const size_t kstep = (size_t)(BK * 2);
    const size_t hstep = (size_t)HALF * K * 2;
    const size_t tstep = 2 * hstep;
    const unsigned ldsw = (unsigned)wid * 1024u;
    const int aoff = lds_byte(wr * 64 + fr, fq * 8), boff = lds_byte(wc * 32 + fr, fq * 8);
#define PG8_SA(b, h) (((b) * 2 + (h)) * HTB)
#define PG8_SB(b, h) ((4 + (b) * 2 + (h)) * HTB)
#define PG8_STAGE(bufoff, gbase, voff) do { _Pragma("unroll") for (int _i = 0; _i < 2; ++_i) \
        __builtin_amdgcn_global_load_lds((const unsigned*)((const char*)(gbase) + (voff)[_i]), (PG8_LAS unsigned*)(lds + (bufoff) + ldsw + _i * 8192), 16, 0, 0); } while (0)
#define PG8_LDA(dst, b, h) do { _Pragma("unroll") for (int m = 0; m < 4; ++m) _Pragma("unroll") for (int k = 0; k < 2; ++k) dst[m][k] = *(const PG8_LAS bf16x8*)(lds + PG8_SA(b, h) + aoff + m * 2048 + k * 1024); } while (0)
#define PG8_LDB(dst, b, h) do { _Pragma("unroll") for (int n = 0; n < 2; ++n) _Pragma("unroll") for (int k = 0; k < 2; ++k) dst[n][k] = *(const PG8_LAS bf16x8*)(lds + PG8_SB(b, h) + boff + n * 2048 + k * 1024); } while (0)
#define PG8_MMA(ai, bj, At, Bt) do { __builtin_amdgcn_s_setprio(1); _Pragma("unroll") for (int m = 0; m < 4; ++m) _Pragma("unroll") for (int n = 0; n < 2; ++n) _Pragma("unroll") for (int k = 0; k < 2; ++k) \
        acc[ai][bj][m][n] = __builtin_amdgcn_mfma_f32_16x16x32_bf16(Bt[n][k], At[m][k], acc[ai][bj][m][n], 0, 0, 0); __builtin_amdgcn_s_setprio(0); } while (0)
#define PG8_WAIT_V(n) asm volatile("s_waitcnt vmcnt(" #n ")" ::: "memory")
#define PG8_WAIT_L(n) asm volatile("s_waitcnt lgkmcnt(" #n ")" ::: "memory")
#define PG8_BAR __builtin_amdgcn_s_barrier()
#define PG8_SCHED __builtin_amdgcn_sched_barrier(0)
    Unit cur, nxt; int ui = 0;
    if (!S.next(0, cur)) return;
    f32x4 acc[2][2][4][2];
#pragma unroll
    for (int a = 0; a < 2; ++a)
#pragma unroll
        for (int b = 0; b < 2; ++b)
#pragma unroll
            for (int m = 0; m < 4; ++m)
#pragma unroll
                for (int n = 0; n < 2; ++n) acc[a][b][m][n] = (f32x4){0.f, 0.f, 0.f, 0.f};
    bf16x8 At[4][2], B0[2][2], B1[2][2];
    const char* cA = (const char*)g.A + (size_t)cur.pm * tstep; const char* cB = (const char*)g.Bt + (size_t)cur.pn * tstep;
    S.a_ready(cur);
    if constexpr (SP2) {
        PG8_STAGE(PG8_SB(0, 0), cB, voffB); PG8_STAGE(PG8_SB(0, 1), cB + hstep, voffB); PG8_STAGE(PG8_SA(0, 0), cA, voffA); PG8_STAGE(PG8_SA(0, 1), cA + hstep, voffA);
        if (wr == 1) PG8_BAR;
        PG8_WAIT_V(2); PG8_BAR;
        PG8_STAGE(PG8_SB(1, 0), cB + kstep, voffB); PG8_STAGE(PG8_SA(1, 0), cA + kstep, voffA); PG8_STAGE(PG8_SB(1, 1), cB + hstep + kstep, voffB);
        PG8_WAIT_V(6); PG8_BAR;
    } else {
        PG8_STAGE(PG8_SB(0, 0), cB, voffB); PG8_STAGE(PG8_SA(0, 0), cA, voffA); PG8_STAGE(PG8_SB(0, 1), cB + hstep, voffB); PG8_STAGE(PG8_SA(0, 1), cA + hstep, voffA);
        if (wr == 1) PG8_BAR;
        PG8_WAIT_V(4); PG8_BAR;
        PG8_STAGE(PG8_SB(1, 0), cB + kstep, voffB); PG8_STAGE(PG8_SA(1, 0), cA + kstep, voffA); PG8_STAGE(PG8_SB(1, 1), cB + hstep + kstep, voffB);
        PG8_WAIT_V(6); PG8_BAR;
    }
    for (;;) {
        const bool has_next = S.next(ui + 1, nxt);
        const char* nA = has_next ? (const char*)g.A + (size_t)nxt.pm * tstep : cA; const char* nB = has_next ? (const char*)g.Bt + (size_t)nxt.pn * tstep : cB;
        for (int t = 0; t < nt; t += 2) {
            const bool last = (t == nt - 2);
            const char* a1 = cA + (size_t)(t + 1) * kstep;
            const char* a2 = last ? nA : cA + (size_t)(t + 2) * kstep; const char* b2 = last ? nB : cB + (size_t)(t + 2) * kstep;
            const char* a3 = a2 + kstep; const char* b3 = b2 + kstep;
            if (last && has_next) S.a_ready(nxt);
            if constexpr (SP2) {
            PG8_LDB(B0, 0, 0); PG8_LDB(B1, 0, 1); PG8_SCHED; PG8_LDA(At, 0, 0); PG8_STAGE(PG8_SA(1, 1), a1 + hstep, voffA);
            PG8_WAIT_V(8); PG8_WAIT_L(0); PG8_BAR; PG8_MMA(0, 0, At, B0); PG8_MMA(0, 1, At, B1); PG8_BAR; PG8_SCHED;
            PG8_LDA(At, 0, 1); PG8_STAGE(PG8_SB(0, 0), b2, voffB); PG8_STAGE(PG8_SB(0, 1), b2 + hstep, voffB); PG8_STAGE(PG8_SA(0, 0), a2, voffA);
            PG8_WAIT_V(8); PG8_WAIT_L(0); PG8_BAR; PG8_MMA(1, 0, At, B0); PG8_MMA(1, 1, At, B1); PG8_BAR; PG8_SCHED;
            PG8_LDB(B0, 1, 0); PG8_LDB(B1, 1, 1); PG8_SCHED; PG8_LDA(At, 1, 0); PG8_STAGE(PG8_SA(0, 1), a2 + hstep, voffA);
            PG8_WAIT_V(8); PG8_WAIT_L(0); PG8_BAR; PG8_MMA(0, 0, At, B0); PG8_MMA(0, 1, At, B1); PG8_BAR; PG8_SCHED;
            PG8_LDA(At, 1, 1); PG8_STAGE(PG8_SB(1, 0), b3, voffB); PG8_STAGE(PG8_SB(1, 1), b3 + hstep, voffB); PG8_STAGE(PG8_SA(1, 0), a3, voffA);
            PG8_WAIT_V(8); PG8_WAIT_L(0); PG8_BAR; PG8_MMA(1, 0, At, B0); PG8_MMA(1, 1, At, B1); PG8_BAR; PG8_SCHED;
            } else {
            PG8_LDB(B0, 0, 0); PG8_SCHED; PG8_LDA(At, 0, 0); PG8_STAGE(PG8_SA(1, 1), a1 + hstep, voffA);
            PG8_WAIT_L(8); PG8_BAR; PG8_WAIT_L(0); PG8_MMA(0, 0, At, B0); PG8_BAR; PG8_SCHED;
            PG8_LDB(B1, 0, 1); PG8_STAGE(PG8_SB(0, 0), b2, voffB);
            PG8_BAR; PG8_WAIT_L(0); PG8_MMA(0, 1, At, B1); PG8_BAR;
            PG8_LDA(At, 0, 1); PG8_STAGE(PG8_SA(0, 0), a2, voffA);
            PG8_BAR; PG8_WAIT_L(0); PG8_MMA(1, 0, At, B0); PG8_BAR; PG8_SCHED;
            PG8_STAGE(PG8_SB(0, 1), b2 + hstep, voffB);
            PG8_WAIT_V(6); PG8_BAR; PG8_MMA(1, 1, At, B1); PG8_BAR;
            PG8_LDB(B0, 1, 0); PG8_SCHED; PG8_LDA(At, 1, 0); PG8_STAGE(PG8_SA(0, 1), a2 + hstep, voffA);
            PG8_WAIT_L(8); PG8_BAR; PG8_WAIT_L(0); PG8_MMA(0, 0, At, B0); PG8_BAR; PG8_SCHED;
            PG8_LDB(B1, 1, 1); PG8_STAGE(PG8_SB(1, 0), b3, voffB);
            PG8_BAR; PG8_WAIT_L(0); PG8_MMA(0, 1, At, B1); PG8_BAR;
            PG8_LDA(At, 1, 1); PG8_STAGE(PG8_SA(1, 0), a3, voffA);
            PG8_BAR; PG8_WAIT_L(0); PG8_MMA(1, 0, At, B0); PG8_BAR; PG8_SCHED;
            PG8_STAGE(PG8_SB(1, 1), b3 + hstep, voffB);
            PG8_WAIT_V(6); PG8_BAR; PG8_MMA(1, 1, At, B1); PG8_BAR;
            }
        }
        if constexpr (ALIGN_EPI) { if (wr == 0) PG8_BAR; }
        if constexpr (!Epi::AFTER_DRAIN) { E(acc, cur, wr, wc, fr, fq); S.done(cur); }
        if (!has_next) break;
#pragma unroll
        for (int a = 0; a < 2; ++a)
#pragma unroll
            for (int b = 0; b < 2; ++b)
#pragma unroll
                for (int m = 0; m < 4; ++m)
#pragma unroll
                    for (int n = 0; n < 2; ++n) acc[a][b][m][n] = (f32x4){0.f, 0.f, 0.f, 0.f};
        cur = nxt; cA = nA; cB = nB; ++ui;
        if constexpr (ALIGN_EPI) { if (wr == 1) PG8_BAR; }
    }
    PG8_WAIT_V(0);
    if constexpr (!ALIGN_EPI) { if (wr == 0) PG8_BAR; }
    PG8_BAR;
    if constexpr (Epi::AFTER_DRAIN) { E.fused(acc, cur, wr, wc, fr, fq, lds, wid, lane); S.done(cur); }
#undef PG8_SA
#undef PG8_SB
#undef PG8_STAGE
#undef PG8_LDA
#undef PG8_LDB
#undef PG8_MMA
#undef PG8_WAIT_V
#undef PG8_WAIT_L
#undef PG8_BAR
#undef PG8_SCHED
}
}
constexpr int NWAVES = 8, NTHR = 512;
constexpr int DM = 1024, NLAT = 32768, NCTX = 2048, NROWS = 34816, INC = 3328;
constexpr int OFF_CB = 0, OFF_CC = 256, OFF_CX = 512, OFF_Q = 768, OFF_K = 1280, OFF_V = 1792, OFF_G = 2304, OFF_U = 2816, OFF_VV = 3072;
constexpr int NCH = 34;
constexpr float LN_EPS = 1e-5f, ALPHA = 1.41421356237309515f;
constexpr size_t MiB = 1u << 20;
constexpr size_t WS_CTL = 0, CTL_ZERO_BYTES = MiB, WS_MOD = 1 * MiB, WS_TOK = 2 * MiB, WS_WIN = 4 * MiB, WS_WOUT = 17 * MiB, WS_WGU = 21 * MiB, WS_WD = 149 * MiB,
                 WS_HB = 213 * MiB, WS_ST = WS_HB, WS_XCTX = 281 * MiB, WS_P = 289 * MiB, WS_YMIX = 510 * MiB, WS_XB = WS_P, WS_Y = WS_P, WS_HH = WS_P + 152 * MiB, WS_END = 578 * MiB;
constexpr int CW_TMO = 0, CW_BAR = 4096, CW_WGCNT = 16384, CW_TOT = 32768;
constexpr int RING_BYTES = 131072, LDSCTL_OFF = RING_BYTES, MISC_OFF = LDSCTL_OFF + 320, P2E_OFF = LDSCTL_OFF + 1024, PST_OFF = LDSCTL_OFF + 2048, LDS_BYTES = 147456;
constexpr int MAXPANELS = 304;

#define GAS __attribute__((address_space(1)))
#define LAS __attribute__((address_space(3)))
typedef unsigned short bf16;
typedef unsigned v4u __attribute__((ext_vector_type(4)));
typedef unsigned v2u __attribute__((ext_vector_type(2)));
typedef float f32x4 __attribute__((ext_vector_type(4)));
#define LDS_WAIT() asm volatile("s_waitcnt lgkmcnt(0)" ::: "memory")
#define VM_WAIT() asm volatile("s_waitcnt vmcnt(0)" ::: "memory")
__device__ __forceinline__ unsigned f2bf(float f) { unsigned u = __builtin_bit_cast(unsigned, f); return (u + 0x7fffu + ((u >> 16) & 1u)) >> 16; }
__device__ __forceinline__ unsigned pk2(float lo, float hi) { return f2bf(lo) | (f2bf(hi) << 16); }
__device__ __forceinline__ float bflo(unsigned w) { return __builtin_bit_cast(float, w << 16); }
__device__ __forceinline__ float bfhi(unsigned w) { return __builtin_bit_cast(float, w & 0xffff0000u); }
__device__ __forceinline__ float wave_sum(float v) {
#pragma unroll
    for (int o = 1; o < 64; o <<= 1) v += __shfl_xor(v, o);
    return v;
}
__device__ __forceinline__ float log_sigmoid_f(float x) { return -log1pf(expf(-x)); }

struct Args { const float* in[24]; float* out; unsigned char* ws; int ph_lo, ph_hi; };
#define XB_TMO      128
#define XB_XCNT(j)  (256  + 64 * (j))
#define XB_XSUB(j)  (1280 + 64 * (j))
#define XB_XGEN(j)  (2304 + 64 * (j))
#define XB_TOP      3328
#define XB_TOPGEN   3392
#define XCD_BAR_WORDS 3456
#define XB_SPIN_CAP (1u << 18)

__device__ __forceinline__ unsigned xb_ld(unsigned* p)              { return __hip_atomic_load(p, __ATOMIC_RELAXED, __HIP_MEMORY_SCOPE_AGENT); }
__device__ __forceinline__ unsigned xb_add(unsigned* p, unsigned v) { return __hip_atomic_fetch_add(p, v, __ATOMIC_RELAXED, __HIP_MEMORY_SCOPE_AGENT); }
__device__ __forceinline__ unsigned xb_xcc_id() { return (unsigned)__builtin_amdgcn_s_getreg((3 << 11) | 20) & 0xFu; }
#define XB_SPIN(cond, bar) do { unsigned _sp = 0; while (cond) { __builtin_amdgcn_s_sleep(1); \
    if ((++_sp & 255u) == 0u) { if (xb_ld(&(bar)[XB_TMO])) break; if (_sp > XB_SPIN_CAP) { atomicAdd(&(bar)[XB_TMO], 1u); break; } } } } while (0)

struct XcdBarrier {
    unsigned* bar; unsigned x;
    volatile LAS unsigned* st;
};

__device__ __forceinline__ XcdBarrier xcd_barrier_post(unsigned* bar, volatile LAS unsigned* st) {
    XcdBarrier b; b.bar = bar; b.x = xb_xcc_id(); b.st = st;
    if (threadIdx.x == 0) (void)xb_add(&bar[XB_XCNT(b.x)], 1u);
    return b;
}
__device__ __forceinline__ void xcd_barrier_complete(unsigned* bar, unsigned x, unsigned& nloc, unsigned& nx) {
    const unsigned G = gridDim.x * gridDim.y * gridDim.z;
    unsigned sum, cnt, mine, sp = 0u;
    for (;;) {
        sum = 0u; cnt = 0u; mine = 0u;
#pragma unroll
        for (unsigned j = 0; j < 16; ++j) { const unsigned c = xb_ld(&bar[XB_XCNT(j)]); sum += c; cnt += (c > 0u) ? 1u : 0u; mine = (j == x) ? c : mine; }
        if (sum == G) break;
        __builtin_amdgcn_s_sleep(1);
        if ((++sp & 255u) == 0u) { if (xb_ld(&bar[XB_TMO])) break; if (sp > XB_SPIN_CAP) { atomicAdd(&bar[XB_TMO], 1u); break; } }
    }
    nloc = mine > 0u ? mine : 1u; nx = cnt > 0u ? cnt : 1u;
}

__device__ __forceinline__ void xcd_barrier(const XcdBarrier& b) {
    asm volatile("s_waitcnt vmcnt(0)" ::: "memory");
    __syncthreads();
    if (threadIdx.x == 0) {
        unsigned* bar = b.bar;
        __builtin_amdgcn_s_waitcnt(0);
        unsigned nloc = b.st[0], nx = b.st[1];
        if (nloc == 0u) { xcd_barrier_complete(bar, b.x, nloc, nx); b.st[0] = nloc; b.st[1] = nx; }
        const unsigned old = xb_add(&bar[XB_XSUB(b.x)], 1u);
        const unsigned gen = old / nloc;
        if (old + 1u == (gen + 1u) * nloc) {
            __builtin_amdgcn_fence(__ATOMIC_RELEASE, "agent");
            asm volatile("s_waitcnt vmcnt(0)" ::: "memory");
            const unsigned og = xb_add(&bar[XB_TOP], 1u);
            const unsigned tg = og / nx;
            if (og + 1u == (tg + 1u) * nx) xb_add(&bar[XB_TOPGEN], 1u);
            else XB_SPIN(xb_ld(&bar[XB_TOPGEN]) == tg, bar);
            __builtin_amdgcn_fence(__ATOMIC_ACQUIRE, "agent");
            xb_add(&bar[XB_XGEN(b.x)], 1u);
            asm volatile("s_waitcnt vmcnt(0)" ::: "memory");
        } else {
            XB_SPIN(xb_ld(&bar[XB_XGEN(b.x)]) == gen, bar);
            __builtin_amdgcn_fence(__ATOMIC_ACQUIRE, "agent");
            asm volatile("s_waitcnt vmcnt(0)" ::: "memory");
        }
    }
    __syncthreads();
}
__device__ __forceinline__ void transpose_tile(const float* Wsrc, int ldn, bf16* dst, int ldk, float scale, LAS float* scr, int lane) {
#pragma unroll 8
    for (int i = 0; i < 32; ++i) { const int kk = 2 * i + (lane >> 5); scr[kk * 33 + (lane & 31)] = Wsrc[(size_t)kk * ldn + (lane & 31)] * scale; }
    LDS_WAIT(); asm volatile("" ::: "memory");
    const int c = lane & 7;
#pragma unroll
    for (int j = 0; j < 4; ++j) { const int n = (lane >> 3) + 8 * j; const LAS float* s = scr + (8 * c) * 33 + n;
        v4u o; o.x = pk2(s[0 * 33], s[1 * 33]); o.y = pk2(s[2 * 33], s[3 * 33]); o.z = pk2(s[4 * 33], s[5 * 33]); o.w = pk2(s[6 * 33], s[7 * 33]);
        *(GAS v4u*)(dst + (size_t)n * ldk + 8 * c) = o; }
    LDS_WAIT(); asm volatile("" ::: "memory");
}

__device__ __forceinline__ void phase_p0(const Args& a, LAS unsigned char* lds, int tid, int lane, int wave) {
    const int G = gridDim.x;
    {
        LAS float* s = (LAS float*)lds; LAS float* red = (LAS float*)(lds + 36864);
        const float* c = a.in[1]; const float* cctx = a.in[3]; const float* wada = a.in[4]; const float* bada = a.in[5];
        float* mod = (float*)(a.ws + WS_MOD);
        for (int u = blockIdx.x; u < 192; u += G) {
            const int l = u / 96, j0 = (u % 96) * 64;
            for (int i = tid; i < 9 * 1024; i += NTHR) { const int r = i >> 10, k = i & 1023; const float v = r < 8 ? c[r * 1024 + k] : cctx[k]; s[i] = v / (1.0f + expf(-v)); }
            __syncthreads();
            const int jq = tid & 15, kg = tid >> 4;
            float acc[9][4];
#pragma unroll
            for (int r = 0; r < 9; ++r) { acc[r][0] = 0.f; acc[r][1] = 0.f; acc[r][2] = 0.f; acc[r][3] = 0.f; }
            const float* w = wada + (size_t)l * 1024 * 6144 + j0 + jq * 4;
            for (int k = kg; k < 1024; k += 32) { const f32x4 wv = *(const f32x4*)(w + (size_t)k * 6144);
#pragma unroll
                for (int r = 0; r < 9; ++r) { const float sr = s[r * 1024 + k]; acc[r][0] += sr * wv.x; acc[r][1] += sr * wv.y; acc[r][2] += sr * wv.z; acc[r][3] += sr * wv.w; } }
#pragma unroll
            for (int r = 0; r < 9; ++r)
#pragma unroll
                for (int i = 0; i < 4; ++i) red[(kg * 9 + r) * 64 + jq * 4 + i] = acc[r][i];
            __syncthreads();
            for (int o = tid; o < 576; o += NTHR) { const int r = o >> 6, j = o & 63; float sum = 0.f;
                for (int g2 = 0; g2 < 32; ++g2) sum += red[(g2 * 9 + r) * 64 + j];
                mod[(l * 9 + r) * 6144 + j0 + j] = sum + bada[l * 6144 + j0 + j]; }
            __syncthreads();
        }
    }
    {
        LAS float* scr = (LAS float*)(lds + wave * 16384);
        const int gw = blockIdx.x * NWAVES + wave, NGW = G * NWAVES;
        const float* w_in = a.in[6]; const float* w_out = a.in[12]; const float* w_gate = a.in[19]; const float* w_up = a.in[20]; const float* w_down = a.in[21];
        bf16* WIN = (bf16*)(a.ws + WS_WIN); bf16* WOUT = (bf16*)(a.ws + WS_WOUT); bf16* WGU = (bf16*)(a.ws + WS_WGU); bf16* WD = (bf16*)(a.ws + WS_WD);
        constexpr int I_IN = 2 * 16 * 104, I_OUT = 2 * 16 * 32, I_GU = 2 * 2 * 32 * 256, I_D = 2 * 32 * 256, NITEMS = I_IN + I_OUT + I_GU + I_D;
        for (int it = gw; it < NITEMS; it += NGW) {
            int r = it;
            if (r < I_IN) { const int l = r / 1664, q = r % 1664, k0 = 64 * (q / 104), n0 = 32 * (q % 104);
                const float sc = (n0 >= OFF_K && n0 < OFF_V) ? 0.125f : 1.0f;
                transpose_tile(w_in + ((size_t)l * 1024 + k0) * INC + n0, INC, WIN + ((size_t)l * INC + n0) * 1024 + k0, 1024, sc, scr, lane); continue; }
            r -= I_IN;
            if (r < I_OUT) { const int l = r / 512, q = r % 512, k0 = 64 * (q / 32), n0 = 32 * (q % 32);
                transpose_tile(w_out + ((size_t)l * 1024 + k0) * 1024 + n0, 1024, WOUT + ((size_t)l * 1024 + n0) * 1024 + k0, 1024, 1.0f, scr, lane); continue; }
            r -= I_OUT;
            if (r < I_GU) { const int isup = r >= (I_GU / 2) ? 1 : 0; r -= isup * (I_GU / 2);
                const int le = r / 256, q = r % 256, k0 = 64 * (q / 16), n0 = 32 * (q % 16);
                const float* src = (isup ? w_up : w_gate) + ((size_t)le * 1024 + k0) * 512 + n0;
                const int drow = (n0 >> 7) * 256 + (n0 & 127) + isup * 128;
                transpose_tile(src, 512, WGU + ((size_t)le * 1024 + drow) * 1024 + k0, 1024, 1.0f, scr, lane); continue; }
            r -= I_GU;
            { const int le = r / 256, q = r % 256, k0 = 64 * (q / 32), n0 = 32 * (q % 32);
                transpose_tile(w_down + ((size_t)le * 512 + k0) * 1024 + n0, 1024, WD + ((size_t)le * 1024 + n0) * 512 + k0, 512, 1.0f, scr, lane); }
        }
    }
}

__device__ __forceinline__ void phase_p1(const Args& a, int lane, int wave) {
    const int gw = blockIdx.x * NWAVES + wave, NGW = gridDim.x * NWAVES;
    const float* mod = (const float*)(a.ws + WS_MOD); bf16* Hb = (bf16*)(a.ws + WS_HB);
    for (int row = gw; row < NROWS; row += NGW) {
        const float* src = row < NLAT ? a.in[0] + (size_t)row * 1024 : a.in[2] + (size_t)(row - NLAT) * 1024;
        const float* m0 = mod + (row < NLAT ? (row >> 12) : 8) * 6144;
#pragma unroll
        for (int j = 0; j < 4; ++j) { const int idx = (lane + 64 * j) * 4;
            const f32x4 v = *(const f32x4*)(src + idx), sh = *(const f32x4*)(m0 + idx), sc = *(const f32x4*)(m0 + 1024 + idx);
            const f32x4 o = v * (sc + 1.0f) + sh; v2u w; w.x = pk2(o.x, o.y); w.y = pk2(o.z, o.w);
            *(v2u*)(Hb + (size_t)row * 1024 + idx) = w; }
    }
}

__device__ __forceinline__ int chunk_row0(int b, int c) { return c < 2 ? NLAT + b * 256 + c * 128 : b * 4096 + (c - 2) * 128; }
__device__ __forceinline__ size_t st_off(int b, int c, int h, int dir) { return ((((size_t)b * NCH + c) * 8 + h) * 2 + dir) * 4096; }

__device__ __forceinline__ void phase_b(const Args& a, int l, LAS unsigned char* lds, int tid) {
    const bf16* P = (const bf16*)(a.ws + WS_P); float* ST = (float*)(a.ws + WS_ST);
    LAS float* Ks = (LAS float*)lds; LAS float* Vs = (LAS float*)(lds + 32768); LAS float* pf = (LAS float*)(lds + 65536); LAS float* pb = pf + 128;
    for (int u = blockIdx.x; u < 8 * NCH * 8; u += gridDim.x) {
        const int b = u / (NCH * 8), c = (u % (NCH * 8)) / 8, h = u % 8; const int row0 = chunk_row0(b, c);
        __syncthreads();
        if (tid < 128) { const float lgf = log_sigmoid_f(a.in[8][l * 8 + h]), lgb = log_sigmoid_f(a.in[9][l * 8 + h]);
            pf[tid] = expf(lgf * (float)(127 - tid)); pb[tid] = expf(lgb * (float)tid); }
        { const int j = tid >> 2, part = tid & 3; const bf16* kp = P + (size_t)(row0 + j) * INC + OFF_K + h * 64 + part * 16; const bf16* vp = kp + (OFF_V - OFF_K);
#pragma unroll
          for (int q = 0; q < 2; ++q) { const v4u kw = *(const v4u*)(kp + 8 * q), vw = *(const v4u*)(vp + 8 * q);
              LAS float* kd = Ks + j * 64 + part * 16 + 8 * q; LAS float* vd = Vs + j * 64 + part * 16 + 8 * q;
              kd[0] = bflo(kw.x); kd[1] = bfhi(kw.x); kd[2] = bflo(kw.y); kd[3] = bfhi(kw.y); kd[4] = bflo(kw.z); kd[5] = bfhi(kw.z); kd[6] = bflo(kw.w); kd[7] = bfhi(kw.w);
              vd[0] = bflo(vw.x); vd[1] = bfhi(vw.x); vd[2] = bflo(vw.y); vd[3] = bfhi(vw.y); vd[4] = bflo(vw.z); vd[5] = bfhi(vw.z); vd[6] = bflo(vw.w); vd[7] = bfhi(vw.w); } }
        __syncthreads();
        const int d = tid >> 3, e0 = (tid & 7) * 8;
        float af[8], ab[8];
#pragma unroll
        for (int i = 0; i < 8; ++i) { af[i] = 0.f; ab[i] = 0.f; }
        for (int j = 0; j < 128; ++j) { const float kd = Ks[j * 64 + d], kf = kd * pf[j], kb = kd * pb[j];
            const f32x4 v0 = *(const LAS f32x4*)(Vs + j * 64 + e0), v1 = *(const LAS f32x4*)(Vs + j * 64 + e0 + 4);
            af[0] += kf * v0.x; af[1] += kf * v0.y; af[2] += kf * v0.z; af[3] += kf * v0.w; af[4] += kf * v1.x; af[5] += kf * v1.y; af[6] += kf * v1.z; af[7] += kf * v1.w;
            ab[0] += kb * v0.x; ab[1] += kb * v0.y; ab[2] += kb * v0.z; ab[3] += kb * v0.w; ab[4] += kb * v1.x; ab[5] += kb * v1.y; ab[6] += kb * v1.z; ab[7] += kb * v1.w; }
        float* o0 = ST + st_off(b, c, h, 0) + d * 64 + e0; float* o1 = ST + st_off(b, c, h, 1) + d * 64 + e0;
        *(f32x4*)o0 = (f32x4){af[0], af[1], af[2], af[3]}; *(f32x4*)(o0 + 4) = (f32x4){af[4], af[5], af[6], af[7]};
        *(f32x4*)o1 = (f32x4){ab[0], ab[1], ab[2], ab[3]}; *(f32x4*)(o1 + 4) = (f32x4){ab[4], ab[5], ab[6], ab[7]};
    }
    __syncthreads();
}

__device__ __forceinline__ void phase_c(const Args& a, int l, int tid) {
    float* ST = (float*)(a.ws + WS_ST);
    for (int it = blockIdx.x * NTHR + tid; it < 8 * 8 * 2 * 1024; it += gridDim.x * NTHR) {
        const int q = it & 1023, dir = (it >> 10) & 1, h = (it >> 11) & 7, b = it >> 14;
        const float lg = log_sigmoid_f(dir ? a.in[9][l * 8 + h] : a.in[8][l * 8 + h]); const float dec = expf(128.0f * lg);
        f32x4 kv[NCH];
#pragma unroll
        for (int s = 0; s < NCH; ++s) { const int c = dir ? (s < 2 ? 1 - s : 35 - s) : s; kv[s] = *(const f32x4*)(ST + st_off(b, c, h, dir) + q * 4); }
        f32x4 st = (f32x4){0.f, 0.f, 0.f, 0.f};
#pragma unroll
        for (int s = 0; s < NCH; ++s) { const int c = dir ? (s < 2 ? 1 - s : 35 - s) : s; *(f32x4*)(ST + st_off(b, c, h, dir) + q * 4) = st; st = st * dec + kv[s]; }
    }
}
__device__ __forceinline__ void unpack8(const v4u w, float* f) { f[0] = bflo(w.x); f[1] = bfhi(w.x); f[2] = bflo(w.y); f[3] = bfhi(w.y); f[4] = bflo(w.z); f[5] = bfhi(w.z); f[6] = bflo(w.w); f[7] = bfhi(w.w); }
__device__ __forceinline__ v4u pack8(const float* f) { v4u w; w.x = pk2(f[0], f[1]); w.y = pk2(f[2], f[3]); w.z = pk2(f[4], f[5]); w.w = pk2(f[6], f[7]); return w; }

__device__ __forceinline__ void phase_d(const Args& a, int l, LAS unsigned char* lds, int tid, int lane) {
    const bf16* P = (const bf16*)(a.ws + WS_P); const float* ST = (const float*)(a.ws + WS_ST); bf16* Y = (bf16*)(a.ws + WS_YMIX);
    const float* convw = a.in[7] + l * 3 * 256; const float* sguw = a.in[10] + (size_t)l * 4 * 128 * 128; const float* sgub = a.in[11] + l * 4 * 128;
    const int c_lo = l == 1 ? 2 : 0, cpb = NCH - c_lo, nunits = 8 * cpb;
    LAS float* Sf = (LAS float*)lds; LAS float* Sb = (LAS float*)(lds + 16384); LAS float* Ks = (LAS float*)(lds + 32768); LAS float* Vs = (LAS float*)(lds + 65536);
    LAS float* VN = (LAS float*)lds;
    for (int u = blockIdx.x; u < nunits; u += gridDim.x) {
        const int b = u / cpb, c = c_lo + u % cpb; const int row0 = chunk_row0(b, c); const bool isc = c < 2;
#ifndef NO_D1
        for (int idx = tid; idx < 128 * 32; idx += NTHR) {
            const int p = idx >> 5, ch0 = (idx & 31) * 8; const int row = row0 + p;
            int dprev = -1, dnext = 1; bool vprev, vnext;
            if (isc) { const int t = c * 128 + p; vprev = t > 0; vnext = t < 255; }
            else { const int t = (c - 2) * 128 + p;
                if (ch0 < 128) { const int col = t & 63; vprev = col > 0; vnext = col < 63; }
                else { const int rg = t >> 6; vprev = rg > 0; vnext = rg < 63; dprev = -64; dnext = 64; } }
            const bf16* pr = P + (size_t)row * INC;
            float cb[8], zc[8], zp[8], zn[8], t0[8], t1[8];
            unpack8(*(const v4u*)(pr + OFF_CB + ch0), cb);
            unpack8(*(const v4u*)(pr + OFF_CC + ch0), t0); unpack8(*(const v4u*)(pr + OFF_CX + ch0), t1);
#pragma unroll
            for (int i = 0; i < 8; ++i) { zc[i] = t0[i] * t1[i]; zp[i] = 0.f; zn[i] = 0.f; }
            if (vprev) { const bf16* q = pr + (ptrdiff_t)dprev * INC; unpack8(*(const v4u*)(q + OFF_CC + ch0), t0); unpack8(*(const v4u*)(q + OFF_CX + ch0), t1);
#pragma unroll
                for (int i = 0; i < 8; ++i) zp[i] = t0[i] * t1[i]; }
            if (vnext) { const bf16* q = pr + (ptrdiff_t)dnext * INC; unpack8(*(const v4u*)(q + OFF_CC + ch0), t0); unpack8(*(const v4u*)(q + OFF_CX + ch0), t1);
#pragma unroll
                for (int i = 0; i < 8; ++i) zn[i] = t0[i] * t1[i]; }
            float o[8];
#pragma unroll
            for (int i = 0; i < 8; ++i) o[i] = cb[i] * (convw[ch0 + i] * zp[i] + convw[256 + ch0 + i] * zc[i] + convw[512 + ch0 + i] * zn[i]);
            *(v4u*)(Y + (size_t)row * 1024 + ch0) = pack8(o);
        }
#endif
        const int i = tid >> 2, part = tid & 3;
#ifndef NO_D2
#pragma unroll 1
        for (int h = 0; h < 8; ++h) {
            __syncthreads();
            { const bf16* kp = P + (size_t)(row0 + i) * INC + OFF_K + h * 64 + part * 16; const bf16* vp = kp + (OFF_V - OFF_K);
#pragma unroll
              for (int q = 0; q < 2; ++q) { float kf[8], vf[8]; unpack8(*(const v4u*)(kp + 8 * q), kf); unpack8(*(const v4u*)(vp + 8 * q), vf);
                  LAS float* kd = Ks + i * 64 + part * 16 + 8 * q; LAS float* vd = Vs + i * 64 + part * 16 + 8 * q;
#pragma unroll
                  for (int e = 0; e < 8; ++e) { kd[e] = kf[e]; vd[e] = vf[e]; } }
              const float* sf = ST + st_off(b, c, h, 0); const float* sb = ST + st_off(b, c, h, 1);
#pragma unroll
              for (int q = 0; q < 2; ++q) { const int o4 = (tid + NTHR * q) * 4; *(LAS f32x4*)(Sf + o4) = *(const f32x4*)(sf + o4); *(LAS f32x4*)(Sb + o4) = *(const f32x4*)(sb + o4); } }
            float qv[16];
            { const bf16* qp = P + (size_t)(row0 + i) * INC + OFF_Q + h * 64 + part * 16; unpack8(*(const v4u*)qp, qv); unpack8(*(const v4u*)(qp + 8), qv + 8); }
            const float lgf = log_sigmoid_f(a.in[8][l * 8 + h]), lgb = log_sigmoid_f(a.in[9][l * 8 + h]);
            __syncthreads();
            float o[16];
#pragma unroll
            for (int e = 0; e < 16; ++e) o[e] = 0.f;
#pragma unroll 1
            for (int j = 0; j < 128; ++j) {
                const LAS f32x4* kr = (const LAS f32x4*)(Ks + j * 64 + part * 16);
                float s = 0.f;
#pragma unroll
                for (int q = 0; q < 4; ++q) { const f32x4 k4 = kr[q]; s += qv[4 * q] * k4.x + qv[4 * q + 1] * k4.y + qv[4 * q + 2] * k4.z + qv[4 * q + 3] * k4.w; }
                s += __shfl_xor(s, 1); s += __shfl_xor(s, 2);
                const int rel = i - j;
                const float dec = rel > 0 ? expf(lgf * (float)rel) : (rel < 0 ? expf(lgb * (float)(-rel)) : 2.0f);
                s *= dec;
                const LAS f32x4* vr = (const LAS f32x4*)(Vs + j * 64 + part * 16);
#pragma unroll
                for (int q = 0; q < 4; ++q) { const f32x4 v4 = vr[q]; o[4 * q] += s * v4.x; o[4 * q + 1] += s * v4.y; o[4 * q + 2] += s * v4.z; o[4 * q + 3] += s * v4.w; }
            }
            float of[16], ob[16];
#pragma unroll
            for (int e = 0; e < 16; ++e) { of[e] = 0.f; ob[e] = 0.f; }
            __syncthreads();
#pragma unroll
            for (int dd = 0; dd < 16; ++dd) Ks[i * 64 + ((part * 16 + dd + i) & 63)] = qv[dd];
            __syncthreads();
#pragma unroll 2
            for (int d = 0; d < 64; ++d) { const float qd = Ks[i * 64 + ((d + i) & 63)];
                const LAS f32x4* fr = (const LAS f32x4*)(Sf + d * 64 + part * 16); const LAS f32x4* br = (const LAS f32x4*)(Sb + d * 64 + part * 16);
#pragma unroll
                for (int q = 0; q < 4; ++q) { const f32x4 f4 = fr[q], b4 = br[q];
                    of[4 * q] += qd * f4.x; of[4 * q + 1] += qd * f4.y; of[4 * q + 2] += qd * f4.z; of[4 * q + 3] += qd * f4.w;
                    ob[4 * q] += qd * b4.x; ob[4 * q + 1] += qd * b4.y; ob[4 * q + 2] += qd * b4.z; ob[4 * q + 3] += qd * b4.w; } }
            const float df = expf(lgf * (float)(i + 1)), db = expf(lgb * (float)(128 - i));
            float sum = 0.f;
#pragma unroll
            for (int e = 0; e < 16; ++e) { o[e] += df * of[e] + db * ob[e]; sum += o[e]; }
            sum += __shfl_xor(sum, 1); sum += __shfl_xor(sum, 2);
            const float mu = sum * (1.0f / 64.0f); float vs = 0.f;
#pragma unroll
            for (int e = 0; e < 16; ++e) { o[e] -= mu; vs += o[e] * o[e]; }
            vs += __shfl_xor(vs, 1); vs += __shfl_xor(vs, 2);
            const float rs = 1.0f / sqrtf(vs * (1.0f / 64.0f) + LN_EPS);
            float gv[16];
            { const bf16* gp = P + (size_t)(row0 + i) * INC + OFF_G + h * 64 + part * 16; unpack8(*(const v4u*)gp, gv); unpack8(*(const v4u*)(gp + 8), gv + 8); }
#pragma unroll
            for (int e = 0; e < 16; ++e) o[e] = (gv[e] / (1.0f + expf(-gv[e]))) * (o[e] * rs);
            bf16* yp = Y + (size_t)(row0 + i) * 1024 + 256 + h * 64 + part * 16;
            *(v4u*)yp = pack8(o); *(v4u*)(yp + 8) = pack8(o + 8);
        }
#endif
#ifndef NO_D3
        __syncthreads();
        {
            const bf16* vp = P + (size_t)(row0 + i) * INC + OFF_VV + part * 64;
            float sum = 0.f;
#pragma unroll 2
            for (int q = 0; q < 8; ++q) { float t8[8]; unpack8(*(const v4u*)(vp + 8 * q), t8);
#pragma unroll
                for (int e = 0; e < 8; ++e) sum += t8[e]; }
            sum += __shfl_xor(sum, 1); sum += __shfl_xor(sum, 2);
            const float mu = sum * (1.0f / 256.0f); float vs = 0.f;
#pragma unroll 2
            for (int q = 0; q < 8; ++q) { float t8[8]; unpack8(*(const v4u*)(vp + 8 * q), t8);
#pragma unroll
                for (int e = 0; e < 8; ++e) { const float dlt = t8[e] - mu; vs += dlt * dlt; } }
            vs += __shfl_xor(vs, 1); vs += __shfl_xor(vs, 2);
            const float rs = 1.0f / sqrtf(vs * (1.0f / 256.0f) + LN_EPS);
            LAS float* dst = VN + (part * 128 + i) * 64;
#pragma unroll 2
            for (int q = 0; q < 8; ++q) { float t8[8]; unpack8(*(const v4u*)(vp + 8 * q), t8);
                *(LAS f32x4*)(dst + 8 * q) = (f32x4){(t8[0] - mu) * rs, (t8[1] - mu) * rs, (t8[2] - mu) * rs, (t8[3] - mu) * rs};
                *(LAS f32x4*)(dst + 8 * q + 4) = (f32x4){(t8[4] - mu) * rs, (t8[5] - mu) * rs, (t8[6] - mu) * rs, (t8[7] - mu) * rs}; }
        }
        __syncthreads();
        for (int g = 0; g < 4; ++g) {
            float acc[16];
#pragma unroll
            for (int e = 0; e < 16; ++e) acc[e] = 0.f;
            const float* wrow = sguw + ((size_t)g * 128 + i) * 128;
            for (int q = 0; q < 128; q += 4) { const f32x4 w4 = *(const f32x4*)(wrow + q);
#pragma unroll
                for (int qq = 0; qq < 4; ++qq) { const float w = w4[qq]; const LAS f32x4* vr = (const LAS f32x4*)(VN + (g * 128 + q + qq) * 64 + part * 16);
#pragma unroll
                    for (int t = 0; t < 4; ++t) { const f32x4 v4 = vr[t]; acc[4 * t] += w * v4.x; acc[4 * t + 1] += w * v4.y; acc[4 * t + 2] += w * v4.z; acc[4 * t + 3] += w * v4.w; } } }
            const float bias = sgub[g * 128 + i];
            float uv[16];
            { const bf16* up = P + (size_t)(row0 + i) * INC + OFF_U + g * 64 + part * 16; unpack8(*(const v4u*)up, uv); unpack8(*(const v4u*)(up + 8), uv + 8); }
#pragma unroll
            for (int e = 0; e < 16; ++e) acc[e] = uv[e] * (acc[e] + bias);
            bf16* yp = Y + (size_t)(row0 + i) * 1024 + 768 + g * 64 + part * 16;
            *(v4u*)yp = pack8(acc); *(v4u*)(yp + 8) = pack8(acc + 8);
        }
#endif
        __syncthreads();
    }
}

__device__ __forceinline__ void phase_f(const Args& a, int l, LAS unsigned char* lds, int tid, int lane, int wave) {
    LAS int* lcnt = (LAS int*)lds;
    __syncthreads();
    if (tid < 32) lcnt[tid] = 0;
    __syncthreads();
    const int gw = blockIdx.x * NWAVES + wave, NGW = gridDim.x * NWAVES, nrows = l == 0 ? NROWS : NLAT;
    const float* mod = (const float*)(a.ws + WS_MOD) + l * 9 * 6144;
    const float* lng = a.in[13] + l * 1024; const float* lnb = a.in[14] + l * 1024;
    const float* rgw = a.in[15] + l * 1024 * 4; const float* rgb = a.in[16] + l * 4; const float* rew = a.in[17] + (size_t)l * 4 * 1024 * 8; const float* reb = a.in[18] + l * 32;
    bf16* Hb = (bf16*)(a.ws + WS_HB); unsigned* tok = (unsigned*)(a.ws + WS_TOK); float* xctx = (float*)(a.ws + WS_XCTX);
    for (int row = gw; row < nrows; row += NGW) {
        float* xr = row < NLAT ? a.out + (size_t)row * 1024 : xctx + (size_t)(row - NLAT) * 1024;
        const float* m0 = mod + (row < NLAT ? (row >> 12) : 8) * 6144;
        f32x4 v[4]; float s = 0.f;
#pragma unroll
        for (int j = 0; j < 4; ++j) { v[j] = *(const f32x4*)(xr + (lane + 64 * j) * 4); s += (v[j].x + v[j].y) + (v[j].z + v[j].w); }
        const float mean = wave_sum(s) * (1.0f / 1024.0f); float s2 = 0.f;
#pragma unroll
        for (int j = 0; j < 4; ++j) { v[j] = v[j] - mean; s2 += (v[j].x * v[j].x + v[j].y * v[j].y) + (v[j].z * v[j].z + v[j].w * v[j].w); }
        const float rstd = 1.0f / sqrtf(wave_sum(s2) * (1.0f / 1024.0f) + LN_EPS);
        float lg[4] = {0.f, 0.f, 0.f, 0.f};
#pragma unroll
        for (int j = 0; j < 4; ++j) { const int idx = (lane + 64 * j) * 4;
            const f32x4 x1 = v[j] * rstd * *(const f32x4*)(lng + idx) + *(const f32x4*)(lnb + idx);
            *(f32x4*)(xr + idx) = x1;
            const f32x4 hm = x1 * (*(const f32x4*)(m0 + 4096 + idx) + 1.0f) + *(const f32x4*)(m0 + 3072 + idx);
            v[j] = hm;
            v2u w; w.x = pk2(hm.x, hm.y); w.y = pk2(hm.z, hm.w); *(v2u*)(Hb + (size_t)row * 1024 + idx) = w;
#pragma unroll
            for (int t = 0; t < 4; ++t) { const f32x4 w4 = *(const f32x4*)(rgw + (idx + t) * 4); const float hv = hm[t];
                lg[0] += hv * w4.x; lg[1] += hv * w4.y; lg[2] += hv * w4.z; lg[3] += hv * w4.w; } }
#pragma unroll
        for (int g = 0; g < 4; ++g) lg[g] = wave_sum(lg[g]) + rgb[g];
        int gi = 0; float gm = lg[0];
#pragma unroll
        for (int g = 1; g < 4; ++g) if (lg[g] > gm) { gm = lg[g]; gi = g; }
        float gden = 0.f;
#pragma unroll
        for (int g = 0; g < 4; ++g) gden += expf(lg[g] - gm);
        const float gprob = 1.0f / gden;
        float le[8] = {0.f, 0.f, 0.f, 0.f, 0.f, 0.f, 0.f, 0.f};
        const float* rw = rew + (size_t)gi * 1024 * 8;
#pragma unroll
        for (int j = 0; j < 4; ++j) { const int idx = (lane + 64 * j) * 4;
#pragma unroll
            for (int t = 0; t < 4; ++t) { const f32x4 w0 = *(const f32x4*)(rw + (idx + t) * 8), w1 = *(const f32x4*)(rw + (idx + t) * 8 + 4); const float hv = v[j][t];
                le[0] += hv * w0.x; le[1] += hv * w0.y; le[2] += hv * w0.z; le[3] += hv * w0.w; le[4] += hv * w1.x; le[5] += hv * w1.y; le[6] += hv * w1.z; le[7] += hv * w1.w; } }
#pragma unroll
        for (int e = 0; e < 8; ++e) le[e] = wave_sum(le[e]) + reb[gi * 8 + e];
        int i1 = 0; float m1 = le[0];
#pragma unroll
        for (int e = 1; e < 8; ++e) if (le[e] > m1) { m1 = le[e]; i1 = e; }
        int i2 = -1; float m2 = -3.0e38f;
#pragma unroll
        for (int e = 0; e < 8; ++e) if (e != i1 && le[e] > m2) { m2 = le[e]; i2 = e; }
        const float p2 = expf(m2 - m1), inv = 1.0f / (1.0f + p2);
        const float gate0 = gprob * inv, gate1 = gprob * p2 * inv;
        if (lane == 0) { const int e0 = gi * 8 + i1, e1 = gi * 8 + i2;
            const int p0 = __hip_atomic_fetch_add(lcnt + e0, 1, __ATOMIC_RELAXED, __HIP_MEMORY_SCOPE_WORKGROUP);
            const int p1 = __hip_atomic_fetch_add(lcnt + e1, 1, __ATOMIC_RELAXED, __HIP_MEMORY_SCOPE_WORKGROUP);
            unsigned* t = tok + (size_t)row * 8; t[0] = (unsigned)e0 | ((unsigned)e1 << 8); t[1] = (unsigned)p0; t[2] = (unsigned)p1;
            t[3] = __builtin_bit_cast(unsigned, gate0); t[4] = __builtin_bit_cast(unsigned, gate1); }
    }
    __syncthreads();
    if (tid < 32) ((unsigned*)(a.ws + WS_CTL))[CW_WGCNT + (l * 256 + blockIdx.x) * 32 + tid] = (unsigned)lcnt[tid];
    __syncthreads();
}

__device__ __forceinline__ void phase_g(const Args& a, int l, LAS unsigned char* lds, int tid, int lane, int wave) {
    LAS int* cn = (LAS int*)lds; LAS int* base = (LAS int*)(lds + 32768); LAS int* pst = base + 32; LAS int* totl = base + 80;
    unsigned* ctl = (unsigned*)(a.ws + WS_CTL);
    __syncthreads();
    for (int i = tid; i < 256 * 32; i += NTHR) cn[i] = (int)ctl[CW_WGCNT + l * 256 * 32 + i];
    __syncthreads();
    if (tid < 32) { int tot = 0, bs = 0; for (int w = 0; w < 256; ++w) { const int v = cn[w * 32 + tid]; if (w < (int)blockIdx.x) bs += v; tot += v; } base[tid] = bs; totl[tid] = tot; }
    __syncthreads();
    if (tid == 0) { int run = 0; for (int e = 0; e < 32; ++e) { pst[e] = run; run += ((totl[e] + 255) >> 8) << 8; } pst[32] = run; }
    __syncthreads();
    if (blockIdx.x == 0 && tid < 32) ctl[CW_TOT + l * 64 + tid] = (unsigned)totl[tid];
    const int gw = blockIdx.x * NWAVES + wave, NGW = gridDim.x * NWAVES, nrows = l == 0 ? NROWS : NLAT;
    const bf16* Hb = (const bf16*)(a.ws + WS_HB); bf16* XB = (bf16*)(a.ws + WS_XB); unsigned* tok = (unsigned*)(a.ws + WS_TOK);
    for (int row = gw; row < nrows; row += NGW) {
        unsigned* t = tok + (size_t)row * 8; const unsigned ee = t[0]; const int e0 = ee & 255, e1 = (ee >> 8) & 255;
        const int s0 = pst[e0] + base[e0] + (int)t[1], s1 = pst[e1] + base[e1] + (int)t[2];
        if (lane == 0) { t[5] = (unsigned)s0; t[6] = (unsigned)s1; }
        const v4u a0 = *(const v4u*)(Hb + (size_t)row * 1024 + lane * 8), a1 = *(const v4u*)(Hb + (size_t)row * 1024 + 512 + lane * 8);
        *(v4u*)(XB + (size_t)s0 * 1024 + lane * 8) = a0; *(v4u*)(XB + (size_t)s0 * 1024 + 512 + lane * 8) = a1;
        *(v4u*)(XB + (size_t)s1 * 1024 + lane * 8) = a0; *(v4u*)(XB + (size_t)s1 * 1024 + 512 + lane * 8) = a1;
    }
    __syncthreads();
}

__device__ __forceinline__ int build_p2e(const Args& a, int l, LAS unsigned char* lds, int tid) {
    LAS unsigned char* p2e = lds + P2E_OFF; LAS int* np = (LAS int*)(lds + PST_OFF);
    const unsigned* ctl = (const unsigned*)(a.ws + WS_CTL);
    __syncthreads();
    if (tid == 0) { int pm = 0; for (int e = 0; e < 32; ++e) { const int n = ((int)ctl[CW_TOT + l * 64 + e] + 255) >> 8; for (int k = 0; k < n && pm < MAXPANELS; ++k) p2e[pm++] = (unsigned char)e; } np[0] = pm; }
    __syncthreads();
    return np[0];
}

__device__ __forceinline__ void phase_j(const Args& a, int l, int lane, int wave) {
    const int gw = blockIdx.x * NWAVES + wave, NGW = gridDim.x * NWAVES, nrows = l == 0 ? NROWS : NLAT;
    const float* mod = (const float*)(a.ws + WS_MOD) + l * 9 * 6144; const float* modn = (const float*)(a.ws + WS_MOD) + 9 * 6144;
    const float* lng = a.in[22] + l * 1024; const float* lnb = a.in[23] + l * 1024;
    bf16* Hb = (bf16*)(a.ws + WS_HB); const bf16* Y = (const bf16*)(a.ws + WS_Y); const unsigned* tok = (const unsigned*)(a.ws + WS_TOK); float* xctx = (float*)(a.ws + WS_XCTX);
    for (int row = gw; row < nrows; row += NGW) {
        float* xr = row < NLAT ? a.out + (size_t)row * 1024 : xctx + (size_t)(row - NLAT) * 1024;
        const int mrow = row < NLAT ? (row >> 12) : 8; const float* m0 = mod + mrow * 6144;
        const unsigned* t = tok + (size_t)row * 8; const float g0 = __builtin_bit_cast(float, t[3]), g1 = __builtin_bit_cast(float, t[4]);
        const bf16* y0 = Y + (size_t)t[5] * 1024; const bf16* y1 = Y + (size_t)t[6] * 1024;
        f32x4 v[4]; float s = 0.f;
#pragma unroll
        for (int j = 0; j < 4; ++j) { const int idx = (lane + 64 * j) * 4;
            const f32x4 x1 = *(const f32x4*)(xr + idx); const v2u w0 = *(const v2u*)(y0 + idx), w1 = *(const v2u*)(y1 + idx);
            const f32x4 ya = (f32x4){bflo(w0.x), bfhi(w0.x), bflo(w0.y), bfhi(w0.y)}, yb = (f32x4){bflo(w1.x), bfhi(w1.x), bflo(w1.y), bfhi(w1.y)};
            v[j] = x1 * ALPHA + *(const f32x4*)(m0 + 5120 + idx) * (ya * g0 + yb * g1);
            s += (v[j].x + v[j].y) + (v[j].z + v[j].w); }
        const float mean = wave_sum(s) * (1.0f / 1024.0f); float s2 = 0.f;
#pragma unroll
        for (int j = 0; j < 4; ++j) { v[j] = v[j] - mean; s2 += (v[j].x * v[j].x + v[j].y * v[j].y) + (v[j].z * v[j].z + v[j].w * v[j].w); }
        const float rstd = 1.0f / sqrtf(wave_sum(s2) * (1.0f / 1024.0f) + LN_EPS);
#pragma unroll
        for (int j = 0; j < 4; ++j) { const int idx = (lane + 64 * j) * 4;
            const f32x4 x2 = v[j] * rstd * *(const f32x4*)(lng + idx) + *(const f32x4*)(lnb + idx);
            *(f32x4*)(xr + idx) = x2;
            if (l == 0) { const float* m1 = modn + mrow * 6144; const f32x4 hh = x2 * (*(const f32x4*)(m1 + 1024 + idx) + 1.0f) + *(const f32x4*)(m1 + idx);
                v2u w; w.x = pk2(hh.x, hh.y); w.y = pk2(hh.z, hh.w); *(v2u*)(Hb + (size_t)row * 1024 + idx) = w; } }
    }
}
typedef short bf16x8 __attribute__((ext_vector_type(8)));
typedef short s16x4 __attribute__((ext_vector_type(4)));
typedef short v4i16_t __attribute__((ext_vector_type(4)));
typedef float f32x16 __attribute__((ext_vector_type(16)));
typedef float f32x2_t __attribute__((ext_vector_type(2))); typedef __bf16 bf16x2_t __attribute__((ext_vector_type(2)));
#define MFMA32(a, b, c) __builtin_amdgcn_mfma_f32_32x32x16_bf16((a), (b), (c), 0, 0, 0)
__device__ __forceinline__ unsigned cvtpk(float lo, float hi) { f32x2_t v = {lo, hi}; bf16x2_t b = __builtin_convertvector(v, bf16x2_t); return __builtin_bit_cast(unsigned, b); }
__device__ __forceinline__ int crow(int reg, int hf) { return (reg & 3) + 8 * (reg >> 2) + 4 * hf; }
__device__ __forceinline__ int tro(int r, int b) { return r * 128 + (b ^ (((r >> 1) & 1) << 6)); }
__device__ __forceinline__ int rro(int r, int c16) { return r * 128 + ((c16 ^ ((r >> 1) & 7)) << 4); }
__device__ __forceinline__ s16x4 tr4(const LAS unsigned char* p) { return __builtin_bit_cast(s16x4, __builtin_amdgcn_ds_read_tr16_b64_v4i16((LAS v4i16_t*)p)); }
__device__ __forceinline__ bf16x8 tr_frag(const LAS unsigned char* img, int rlo, int rhi, int colbyte) {
    const s16x4 lo = tr4(img + tro(rlo, colbyte)), hi = tr4(img + tro(rhi, colbyte));
    return (bf16x8){lo[0], lo[1], lo[2], lo[3], hi[0], hi[1], hi[2], hi[3]};
}

#ifndef ST_TRANSPOSED
#define ST_TRANSPOSED 1
#endif
__device__ __forceinline__ void phase_b_mfma(const Args& a, int l, LAS unsigned char* lds, int tid, int lane, int wave) {
    const bf16* P = (const bf16*)(a.ws + WS_P); float* ST = (float*)(a.ws + WS_ST);
    const int r32 = lane & 31, hf = lane >> 5, q4 = (lane & 15) >> 2, p4 = lane & 3, blk = (lane >> 4) & 1;
    for (int u = blockIdx.x; u < 8 * NCH * 4; u += gridDim.x) {
        const int b = u / (NCH * 4), c = (u % (NCH * 4)) >> 2, h0 = (u & 3) * 2; const int row0 = chunk_row0(b, c);
        __syncthreads();
#pragma unroll
        for (int k = 0; k < 4; ++k) {
            const int ci = tid + NTHR * k, hh = ci >> 10, row = (ci & 1023) >> 3, c16 = ci & 7, h = h0 + hh;
            const bf16* src = P + (size_t)(row0 + row) * INC + h * 64 + c16 * 8;
            const v4u kw = *(const v4u*)(src + OFF_K), vw = *(const v4u*)(src + OFF_V);
            LAS unsigned char* base = lds + hh * 49152;
            *(LAS v4u*)(base + tro(row, c16 * 16)) = kw;
            const float lgf = log_sigmoid_f(a.in[8][l * 8 + h]), lgb = log_sigmoid_f(a.in[9][l * 8 + h]);
            const float wf = __expf(lgf * (float)(127 - row)), wb = __expf(lgb * (float)row);
            float v[8]; unpack8(vw, v);
            v4u of, ob;
            of.x = cvtpk(v[0] * wf, v[1] * wf); of.y = cvtpk(v[2] * wf, v[3] * wf); of.z = cvtpk(v[4] * wf, v[5] * wf); of.w = cvtpk(v[6] * wf, v[7] * wf);
            ob.x = cvtpk(v[0] * wb, v[1] * wb); ob.y = cvtpk(v[2] * wb, v[3] * wb); ob.z = cvtpk(v[4] * wb, v[5] * wb); ob.w = cvtpk(v[6] * wb, v[7] * wb);
            *(LAS v4u*)(base + 16384 + tro(row, c16 * 16)) = of;
            *(LAS v4u*)(base + 32768 + tro(row, c16 * 16)) = ob;
        }
        __syncthreads();
        const int hh = wave >> 2, dir = (wave >> 1) & 1, et = wave & 1;
        const LAS unsigned char* kimg = lds + hh * 49152; const LAS unsigned char* vimg = kimg + 16384 + dir * 16384;
        f32x16 acc[2];
#pragma unroll
        for (int i = 0; i < 16; ++i) { acc[0][i] = 0.f; acc[1][i] = 0.f; }
#pragma unroll
        for (int ks = 0; ks < 8; ++ks) {
            const int rlo = 16 * ks + 8 * hf + q4;
            const bf16x8 A = tr_frag(vimg, rlo, rlo + 4, (et * 32 + 16 * blk + 4 * p4) * 2);
#pragma unroll
            for (int dt = 0; dt < 2; ++dt) { const bf16x8 B = tr_frag(kimg, rlo, rlo + 4, (dt * 32 + 16 * blk + 4 * p4) * 2); acc[dt] = MFMA32(A, B, acc[dt]); }
        }
        float* dst = ST + st_off(b, c, h0 + hh, dir);
#pragma unroll
        for (int dt = 0; dt < 2; ++dt)
#pragma unroll
            for (int r = 0; r < 16; ++r) { const int e = et * 32 + crow(r, hf), d = dt * 32 + r32;
#if ST_TRANSPOSED
                dst[e * 64 + d] = acc[dt][r];
#else
                dst[d * 64 + e] = acc[dt][r];
#endif
            }
    }
    __syncthreads();
}
__device__ __forceinline__ bf16x8 scale_frag(const bf16x8 q, float sc) {
    const v4u w = __builtin_bit_cast(v4u, q); v4u o;
    o.x = cvtpk(bflo(w.x) * sc, bfhi(w.x) * sc); o.y = cvtpk(bflo(w.y) * sc, bfhi(w.y) * sc); o.z = cvtpk(bflo(w.z) * sc, bfhi(w.z) * sc); o.w = cvtpk(bflo(w.w) * sc, bfhi(w.w) * sc);
    return __builtin_bit_cast(bf16x8, o);
}
__device__ __forceinline__ bf16x8 f32x8_to_frag(const f32x4 a0, const f32x4 a1) {
    v4u o; o.x = cvtpk(a0.x, a0.y); o.y = cvtpk(a0.z, a0.w); o.z = cvtpk(a1.x, a1.y); o.w = cvtpk(a1.z, a1.w); return __builtin_bit_cast(bf16x8, o);
}
__device__ __forceinline__ void phase_d_mfma(const Args& a, int l, LAS unsigned char* lds, int tid, int lane, int wave) {
    const bf16* P = (const bf16*)(a.ws + WS_P); const float* ST = (const float*)(a.ws + WS_ST); bf16* Y = (bf16*)(a.ws + WS_YMIX);
    const float* convw = a.in[7] + l * 3 * 256; const float* sguw = a.in[10] + (size_t)l * 4 * 128 * 128; const float* sgub = a.in[11] + l * 4 * 128;
    const int c_lo = l == 1 ? 2 : 0, cpb = NCH - c_lo, nunits = 8 * cpb;
#define LANEC int ln_ = lane; asm volatile("" : "+v"(ln_)); const int r32 = ln_ & 31, hf = ln_ >> 5, q4 = (ln_ & 15) >> 2, p4 = ln_ & 3, blk = (ln_ >> 4) & 1; (void)q4; (void)p4; (void)blk
    for (int u = blockIdx.x; u < nunits; u += gridDim.x) {
        const int b = u / cpb, c = c_lo + u % cpb; const int row0 = chunk_row0(b, c); const bool isc = c < 2;
        for (int idx = tid; idx < 128 * 32; idx += NTHR) {
            const int p = idx >> 5, ch0 = (idx & 31) * 8; const int row = row0 + p;
            int dprev = -1, dnext = 1; bool vprev, vnext;
            if (isc) { const int t = c * 128 + p; vprev = t > 0; vnext = t < 255; }
            else { const int t = (c - 2) * 128 + p;
                if (ch0 < 128) { const int col = t & 63; vprev = col > 0; vnext = col < 63; }
                else { const int rg = t >> 6; vprev = rg > 0; vnext = rg < 63; dprev = -64; dnext = 64; } }
            const bf16* pr = P + (size_t)row * INC;
            float cb[8], zc[8], zp[8], zn[8], t0[8], t1[8];
            unpack8(*(const v4u*)(pr + OFF_CB + ch0), cb);
            unpack8(*(const v4u*)(pr + OFF_CC + ch0), t0); unpack8(*(const v4u*)(pr + OFF_CX + ch0), t1);
#pragma unroll
            for (int i = 0; i < 8; ++i) { zc[i] = t0[i] * t1[i]; zp[i] = 0.f; zn[i] = 0.f; }
            if (vprev) { const bf16* q = pr + (ptrdiff_t)dprev * INC; unpack8(*(const v4u*)(q + OFF_CC + ch0), t0); unpack8(*(const v4u*)(q + OFF_CX + ch0), t1);
#pragma unroll
                for (int i = 0; i < 8; ++i) zp[i] = t0[i] * t1[i]; }
            if (vnext) { const bf16* q = pr + (ptrdiff_t)dnext * INC; unpack8(*(const v4u*)(q + OFF_CC + ch0), t0); unpack8(*(const v4u*)(q + OFF_CX + ch0), t1);
#pragma unroll
                for (int i = 0; i < 8; ++i) zn[i] = t0[i] * t1[i]; }
            float o[8];
#pragma unroll
            for (int i = 0; i < 8; ++i) o[i] = cb[i] * (convw[ch0 + i] * zp[i] + convw[256 + ch0 + i] * zc[i] + convw[512 + ch0 + i] * zn[i]);
            *(v4u*)(Y + (size_t)row * 1024 + ch0) = pack8(o);
        }
#ifndef NO_D2
#pragma unroll 1
        for (int pass = 0; pass < 2; ++pass) {
            __syncthreads();
#pragma unroll 4
            for (int k = 0; k < 16; ++k) {
                int ts_ = tid; asm volatile("" : "+v"(ts_));
                const int ci = ts_ + NTHR * k, tile = ci >> 10, hd = tile >> 1, isv = tile & 1, row = (ci & 1023) >> 3, c16 = ci & 7;
                const v4u w = *(const v4u*)(P + (size_t)(row0 + row) * INC + (isv ? OFF_V : OFF_K) + (pass * 4 + hd) * 64 + c16 * 8);
                *(LAS v4u*)(lds + hd * 32768 + isv * 16384 + (isv ? tro(row, c16 * 16) : rro(row, c16))) = w;
            }
            __syncthreads();
            LANEC;
            const int hd = wave >> 1, ih = wave & 1, h = pass * 4 + hd;
            const LAS unsigned char* kimg = lds + hd * 32768; const LAS unsigned char* vimg = kimg + 16384;
            const float lg2f = log_sigmoid_f(a.in[8][l * 8 + h]) * 1.44269504088896f, lg2b = log_sigmoid_f(a.in[9][l * 8 + h]) * 1.44269504088896f;
            bf16x8 qf[2][4];
#pragma unroll
            for (int t = 0; t < 2; ++t)
#pragma unroll
                for (int s = 0; s < 4; ++s) qf[t][s] = *(const bf16x8*)(P + (size_t)(row0 + (2 * ih + t) * 32 + r32) * INC + OFF_Q + h * 64 + 16 * s + 8 * hf);
            f32x16 acc[2][2];
#pragma unroll
            for (int t = 0; t < 2; ++t)
#pragma unroll
                for (int et = 0; et < 2; ++et)
#pragma unroll
                    for (int r = 0; r < 16; ++r) acc[t][et][r] = 0.f;
#pragma unroll
            for (int dir = 0; dir < 2; ++dir) {
                const int i0 = 2 * ih * 32 + r32;
                const float sc0 = dir == 0 ? __builtin_amdgcn_exp2f(lg2f * (float)(i0 + 1)) : __builtin_amdgcn_exp2f(lg2b * (float)(128 - i0));
                const float sc1 = dir == 0 ? __builtin_amdgcn_exp2f(lg2f * (float)(i0 + 33)) : __builtin_amdgcn_exp2f(lg2b * (float)(96 - i0));
                const float* sp = ST + st_off(b, c, h, dir) + r32 * 64 + 8 * hf;
#pragma unroll
                for (int s = 0; s < 4; ++s) {
                    const bf16x8 qs0 = scale_frag(qf[0][s], sc0), qs1 = scale_frag(qf[1][s], sc1);
#pragma unroll
                    for (int et = 0; et < 2; ++et) { const float* q = sp + et * 2048 + 16 * s;
                        const bf16x8 A = f32x8_to_frag(*(const f32x4*)q, *(const f32x4*)(q + 4));
                        acc[0][et] = MFMA32(A, qs0, acc[0][et]); acc[1][et] = MFMA32(A, qs1, acc[1][et]); }
                }
            }
#pragma unroll
            for (int t = 0; t < 2; ++t) {
                const int it = 2 * ih + t;
                bf16x8 qq[4];
                if (t == 0) {
#pragma unroll
                    for (int s = 0; s < 4; ++s) qq[s] = qf[0][s];
                } else {
                    asm volatile("" ::: "memory");
#pragma unroll
                    for (int s = 0; s < 4; ++s) qq[s] = *(const bf16x8*)(P + (size_t)(row0 + it * 32 + r32) * INC + OFF_Q + h * 64 + 16 * s + 8 * hf);
                }
#pragma unroll 1
                for (int jt = 0; jt < 4; ++jt) {
                    f32x16 X;
#pragma unroll
                    for (int r = 0; r < 16; ++r) X[r] = 0.f;
#pragma unroll
                    for (int s = 0; s < 4; ++s) { const bf16x8 Kf = *(const LAS bf16x8*)(kimg + rro(jt * 32 + r32, 2 * s + hf)); X = MFMA32(Kf, qq[s], X); }
                    const int rel0 = (it - jt) * 32 + r32 - 4 * hf;
#pragma unroll
                    for (int r = 0; r < 16; ++r) { const int rel = rel0 - ((r & 3) + 8 * (r >> 2));
                        const float x = rel > 0 ? lg2f * (float)rel : lg2b * (float)(-rel);
                        const float dcy = rel == 0 ? 2.0f : __builtin_amdgcn_exp2f(x);
                        X[r] *= dcy; }
#pragma unroll
                    for (int s2 = 0; s2 < 2; ++s2) {
                        v4u pk; pk.x = cvtpk(X[8 * s2], X[8 * s2 + 1]); pk.y = cvtpk(X[8 * s2 + 2], X[8 * s2 + 3]); pk.z = cvtpk(X[8 * s2 + 4], X[8 * s2 + 5]); pk.w = cvtpk(X[8 * s2 + 6], X[8 * s2 + 7]);
                        const bf16x8 Pk = __builtin_bit_cast(bf16x8, pk);
                        const int rlo = jt * 32 + 16 * s2 + 4 * hf + q4;
#pragma unroll
                        for (int et = 0; et < 2; ++et) { const bf16x8 Vt = tr_frag(vimg, rlo, rlo + 8, (et * 32 + 16 * blk + 4 * p4) * 2); acc[t][et] = MFMA32(Vt, Pk, acc[t][et]); }
                    }
                }
                const int row = row0 + (2 * ih + t) * 32 + r32;
                float sum = 0.f;
#pragma unroll
                for (int et = 0; et < 2; ++et)
#pragma unroll
                    for (int r = 0; r < 16; ++r) sum += acc[t][et][r];
                sum += __shfl_xor(sum, 32);
                const float mu = sum * (1.0f / 64.0f); float vs = 0.f;
#pragma unroll
                for (int et = 0; et < 2; ++et)
#pragma unroll
                    for (int r = 0; r < 16; ++r) { const float dlt = acc[t][et][r] - mu; vs += dlt * dlt; }
                vs += __shfl_xor(vs, 32);
                const float rs = 1.0f / sqrtf(vs * (1.0f / 64.0f) + LN_EPS);
#pragma unroll
                for (int et = 0; et < 2; ++et)
#pragma unroll
                    for (int g4 = 0; g4 < 4; ++g4) { const int e0 = et * 32 + 8 * g4 + 4 * hf;
                        const v2u gw = *(const v2u*)(P + (size_t)row * INC + OFF_G + h * 64 + e0);
                        const float g0 = bflo(gw.x), g1 = bfhi(gw.x), g2 = bflo(gw.y), g3 = bfhi(gw.y);
                        const float o0 = (acc[t][et][4 * g4] - mu) * rs, o1 = (acc[t][et][4 * g4 + 1] - mu) * rs, o2 = (acc[t][et][4 * g4 + 2] - mu) * rs, o3 = (acc[t][et][4 * g4 + 3] - mu) * rs;
                        v2u w; w.x = cvtpk(g0 / (1.0f + __expf(-g0)) * o0, g1 / (1.0f + __expf(-g1)) * o1); w.y = cvtpk(g2 / (1.0f + __expf(-g2)) * o2, g3 / (1.0f + __expf(-g3)) * o3);
                        *(v2u*)(Y + (size_t)row * 1024 + 256 + h * 64 + e0) = w; }
            }
        }
#endif
#ifndef NO_D3
        __syncthreads();
        {
            int tq_ = tid; asm volatile("" : "+v"(tq_));
            const int i = tq_ >> 2, part = tq_ & 3;
            const bf16* vp = P + (size_t)(row0 + i) * INC + OFF_VV + part * 64;
            float sum = 0.f;
#pragma unroll 2
            for (int q = 0; q < 8; ++q) { float t8[8]; unpack8(*(const v4u*)(vp + 8 * q), t8);
#pragma unroll
                for (int e = 0; e < 8; ++e) sum += t8[e]; }
            sum += __shfl_xor(sum, 1); sum += __shfl_xor(sum, 2);
            const float mu = sum * (1.0f / 256.0f); float vs = 0.f;
#pragma unroll 2
            for (int q = 0; q < 8; ++q) { float t8[8]; unpack8(*(const v4u*)(vp + 8 * q), t8);
#pragma unroll
                for (int e = 0; e < 8; ++e) { const float dlt = t8[e] - mu; vs += dlt * dlt; } }
            vs += __shfl_xor(vs, 1); vs += __shfl_xor(vs, 2);
            const float rs = 1.0f / sqrtf(vs * (1.0f / 256.0f) + LN_EPS);
#pragma unroll 2
            for (int q = 0; q < 8; ++q) { float t8[8]; unpack8(*(const v4u*)(vp + 8 * q), t8);
                v4u w; w.x = cvtpk((t8[0] - mu) * rs, (t8[1] - mu) * rs); w.y = cvtpk((t8[2] - mu) * rs, (t8[3] - mu) * rs); w.z = cvtpk((t8[4] - mu) * rs, (t8[5] - mu) * rs); w.w = cvtpk((t8[6] - mu) * rs, (t8[7] - mu) * rs);
                *(LAS v4u*)(lds + part * 16384 + tro(i, q * 16)) = w; }
        }
        __syncthreads();
        {
            LANEC;
            const int g = wave >> 1, ph = wave & 1;
            const LAS unsigned char* vn = lds + g * 16384;
            f32x16 acc[2][2];
#pragma unroll
            for (int ct = 0; ct < 2; ++ct)
#pragma unroll
                for (int pt = 0; pt < 2; ++pt)
#pragma unroll
                    for (int r = 0; r < 16; ++r) acc[ct][pt][r] = 0.f;
#pragma unroll 2
            for (int ks = 0; ks < 8; ++ks) {
                const int rlo = 16 * ks + 8 * hf + q4;
                bf16x8 A[2], B[2];
#pragma unroll
                for (int ct = 0; ct < 2; ++ct) A[ct] = tr_frag(vn, rlo, rlo + 4, (ct * 32 + 16 * blk + 4 * p4) * 2);
#pragma unroll
                for (int pt = 0; pt < 2; ++pt) { const float* wp = sguw + ((size_t)g * 128 + ph * 64 + pt * 32 + r32) * 128 + 16 * ks + 8 * hf; B[pt] = f32x8_to_frag(*(const f32x4*)wp, *(const f32x4*)(wp + 4)); }
#pragma unroll
                for (int ct = 0; ct < 2; ++ct)
#pragma unroll
                    for (int pt = 0; pt < 2; ++pt) acc[ct][pt] = MFMA32(A[ct], B[pt], acc[ct][pt]);
            }
#pragma unroll
            for (int pt = 0; pt < 2; ++pt) {
                const int p = ph * 64 + pt * 32 + r32; const int row = row0 + p; const float bias = sgub[g * 128 + p];
#pragma unroll
                for (int ct = 0; ct < 2; ++ct)
#pragma unroll
                    for (int g4 = 0; g4 < 4; ++g4) { const int c0 = ct * 32 + 8 * g4 + 4 * hf;
                        const v2u uw = *(const v2u*)(P + (size_t)row * INC + OFF_U + g * 64 + c0);
                        v2u w; w.x = cvtpk(bflo(uw.x) * (acc[ct][pt][4 * g4] + bias), bfhi(uw.x) * (acc[ct][pt][4 * g4 + 1] + bias));
                        w.y = cvtpk(bflo(uw.y) * (acc[ct][pt][4 * g4 + 2] + bias), bfhi(uw.y) * (acc[ct][pt][4 * g4 + 3] + bias));
                        *(v2u*)(Y + (size_t)row * 1024 + 768 + g * 64 + c0) = w; }
            }
        }
#endif
        __syncthreads();
    }
}
#ifndef MK_PER_PHASE
#define MK_PER_PHASE 0
#endif
constexpr int N_PHASES = 22;

__global__ void __launch_bounds__(NTHR, 2) hybrid_fwd(Args args) {
    extern __shared__ __attribute__((aligned(16))) unsigned char lds_raw[];
    LAS unsigned char* lds = (LAS unsigned char*)lds_raw;
    const int tid0 = threadIdx.x;
    for (int u = tid0; u < (LDS_BYTES - LDSCTL_OFF) / 4; u += NTHR) ((LAS unsigned*)(lds + LDSCTL_OFF))[u] = 0u;
#define TIDS int tid = threadIdx.x; asm volatile("" : "+v"(tid)); const int lane = tid & 63, wave = __builtin_amdgcn_readfirstlane(tid >> 6); (void)lane; (void)wave
    __syncthreads();
    unsigned* ctl = (unsigned*)(args.ws + WS_CTL);
    XcdBarrier bar; bar.bar = ctl + CW_BAR; bar.x = 0; bar.st = nullptr;
    if (!MK_PER_PHASE) bar = xcd_barrier_post(ctl + CW_BAR, (volatile LAS unsigned*)(lds + MISC_OFF + 32));
    const int lo = args.ph_lo, hi = args.ph_hi;
#ifndef PHMASK
#define PHMASK 0xFFFFFFu
#endif
#define PHON(k) (((PHMASK) >> ((k) < 2 ? (k) : 2 + ((k) - 2) % 10)) & 1u)
#define IN(k) (PHON(k) && lo <= (k) && (k) < hi)
#define SEAM(k) do { if (IN(k) && IN((k) + 1)) xcd_barrier(bar); } while (0)

    if (IN(0)) { TIDS; phase_p0(args, lds, tid, lane, wave); }
    SEAM(0);
    if (IN(1)) { TIDS; phase_p1(args, lane, wave); }
    SEAM(1);
    for (int l = 0; l < 2; ++l) {
        const int pb = 2 + 10 * l;
        bf16* Hb = (bf16*)(args.ws + WS_HB);
        if (IN(pb + 0)) {
            pg8::Gemm g{Hb, (const bf16*)(args.ws + WS_WIN) + (size_t)l * INC * 1024, NROWS, INC, 1024}; pg8::StaticOrder S; S.init(NROWS, INC, (int)gridDim.x, (int)blockIdx.x);
            pg8::EpiBf16<0> E{(bf16*)(args.ws + WS_P), INC, nullptr, 0, 0, 1.0f};
            pg8::gemm_phase<pg8::EpiBf16<0>, pg8::StaticOrder, true, true>(lds, g, S, E);
        }
        SEAM(pb + 0);
        if (IN(pb + 1)) { TIDS; phase_b_mfma(args, l, lds, tid, lane, wave); }
        SEAM(pb + 1);
        if (IN(pb + 2)) { TIDS; phase_c(args, l, tid); }
        SEAM(pb + 2);
        if (IN(pb + 3)) { TIDS; phase_d_mfma(args, l, lds, tid, lane, wave); }
        SEAM(pb + 3);
        if (IN(pb + 4)) {
            const int M = l == 0 ? NROWS : NLAT;
            pg8::Gemm g{(const bf16*)(args.ws + WS_YMIX), (const bf16*)(args.ws + WS_WOUT) + (size_t)l * 1024 * 1024, M, 1024, 1024}; pg8::StaticOrder S; S.init(M, 1024, (int)gridDim.x, (int)blockIdx.x);
            float* xctx = (float*)(args.ws + WS_XCTX);
            pg8::EpiResid E{l == 0 ? args.in[0] : args.out, l == 0 ? args.in[2] : xctx, args.out, xctx, (const float*)(args.ws + WS_MOD) + l * 9 * 6144, ALPHA};
            pg8::gemm_phase<pg8::EpiResid, pg8::StaticOrder, true, true>(lds, g, S, E);
        }
        SEAM(pb + 4);
        if (IN(pb + 5)) { TIDS; phase_f(args, l, lds, tid, lane, wave); }
        SEAM(pb + 5);
        if (IN(pb + 6)) { TIDS; phase_g(args, l, lds, tid, lane, wave); }
        SEAM(pb + 6);
        if (IN(pb + 7)) {
            int npan; { TIDS; npan = build_p2e(args, l, lds, tid); }
            pg8::Gemm g{(const bf16*)(args.ws + WS_XB), (const bf16*)(args.ws + WS_WGU) + (size_t)l * 32 * 1024 * 1024, npan * 256, 1024, 1024};
            pg8::MoeOrder S{(const LAS unsigned char*)(lds + P2E_OFF), npan * 4, (int)gridDim.x, (int)blockIdx.x};
            pg8::EpiGLU E{(bf16*)(args.ws + WS_HH)};
            pg8::gemm_phase<pg8::EpiGLU, pg8::MoeOrder, true, true>(lds, g, S, E);
        }
        SEAM(pb + 7);
        if (IN(pb + 8)) {
            int npan; { TIDS; npan = build_p2e(args, l, lds, tid); }
            pg8::Gemm g{(const bf16*)(args.ws + WS_HH), (const bf16*)(args.ws + WS_WD) + (size_t)l * 32 * 1024 * 512, npan * 256, 1024, 512};
            pg8::MoeOrder S{(const LAS unsigned char*)(lds + P2E_OFF), npan * 4, (int)gridDim.x, (int)blockIdx.x};
            pg8::EpiY E{(bf16*)(args.ws + WS_Y)};
            pg8::gemm_phase<pg8::EpiY, pg8::MoeOrder, true, true>(lds, g, S, E);
        }
        SEAM(pb + 8);
        if (IN(pb + 9)) { TIDS; phase_j(args, l, lane, wave); }
        SEAM(pb + 9);
    }
#undef IN
#undef SEAM
}

extern "C" void kernel_launch(void* const* d_in, const int* in_sizes, int n_in, void* d_out, int out_size, void* d_ws, size_t ws_size, hipStream_t stream) {
    static int grid = 0;
    if (grid == 0) {
        if (n_in != 24 || in_sizes[0] != NLAT * DM || out_size != NLAT * DM || ws_size < WS_END) { fprintf(stderr, "kernel_launch: unexpected problem (n_in %d, ws %zu < %zu?)\n", n_in, ws_size, (size_t)WS_END); grid = -1; return; }
        int dev = 0, cus = 0, per_cu = 0;
        if (hipGetDevice(&dev) != hipSuccess || hipDeviceGetAttribute(&cus, hipDeviceAttributeMultiprocessorCount, dev) != hipSuccess) { grid = -1; return; }
        if (hipFuncSetAttribute((const void*)hybrid_fwd, hipFuncAttributeMaxDynamicSharedMemorySize, LDS_BYTES) != hipSuccess) { grid = -1; return; }
        if (hipOccupancyMaxActiveBlocksPerMultiprocessor(&per_cu, (const void*)hybrid_fwd, NTHR, LDS_BYTES) != hipSuccess || per_cu < 1) { fprintf(stderr, "kernel_launch: occupancy query says %d\n", per_cu); }
        (void)hipGetLastError();
        grid = cus;
        if (grid != 256) { fprintf(stderr, "kernel_launch: built for 256 CUs, device has %d\n", cus); grid = -1; return; }
    }
    if (grid < 0) return;
    if (hipMemsetAsync((char*)d_ws + WS_CTL, 0, CTL_ZERO_BYTES, stream) != hipSuccess) return;
    Args a{};
    for (int i = 0; i < 24; ++i) a.in[i] = (const float*)d_in[i];
    a.out = (float*)d_out; a.ws = (unsigned char*)d_ws;
#if MK_PER_PHASE
    for (int p = 0; p < N_PHASES; ++p) { a.ph_lo = p; a.ph_hi = p + 1; hipLaunchKernelGGL(hybrid_fwd, dim3(grid), dim3(NTHR), LDS_BYTES, stream, a); }
#else
    a.ph_lo = 0; a.ph_hi = N_PHASES;
    hipLaunchKernelGGL(hybrid_fwd, dim3(grid), dim3(NTHR), LDS_BYTES, stream, a);
#endif
}
```

```cpp
#include <hip/hip_runtime.h>
#include <cstdio>
#include <cstdint>
#include <cstddef>
namespace pg8 {
#define PG8_LAS __attribute__((address_space(3)))
typedef unsigned short bf16_t;
typedef short bf16x8 __attribute__((ext_vector_type(8)));
typedef float f32x4 __attribute__((ext_vector_type(4)));
typedef unsigned u32x4 __attribute__((ext_vector_type(4)));
constexpr int BM = 256, BK = 64, HALF = 128, HTB = HALF * BK * 2  , STAGE_BYTES = 8 * HTB, NXCD = 8, WGM = 8;

__host__ __device__ __forceinline__ int lds_byte(int r, int c) { const int st = (r >> 4) * 2 + (c >> 5), rr = r & 15, cc = c & 31, ob = rr * 64 + cc * 2; return st * 1024 + (ob ^ (((ob >> 9) & 1) << 5)); }
__host__ __device__ __forceinline__ void stage_rc(int b, int& R, int& C) { const int st = b / 1024, sb = b % 1024, swz = sb ^ (((sb >> 9) & 1) << 5); R = (st >> 1) * 16 + swz / 64; C = (st & 1) * 32 + (swz % 64) / 2; }
__host__ __device__ __forceinline__ int perm32(int rho) { const int n = rho >> 4, i = rho & 15; return 8 * (i >> 2) + 4 * n + (i & 3); }

struct Unit { int pm, pn; };
struct Gemm { const bf16_t* A; const bf16_t* Bt; int M, N, K; };

struct StaticOrder {
    int nM, nN, nwg, G, c;
    __host__ __device__ void init(int M, int N, int G_, int c_) { nM = M / BM; nN = N / BM; nwg = nM * nN; G = G_; c = c_; }
    __host__ __device__ bool next(int i, Unit& u) const {
        const long L = (long)i * G + c; if (L >= nwg) return false;
        int wgid = (int)L; { const int q = nwg / NXCD, r = nwg % NXCD, xcd = wgid % NXCD, off = wgid / NXCD; wgid = (xcd < r ? xcd * (q + 1) : r * (q + 1) + (xcd - r) * q) + off; }
        const int nig = WGM * nN, gid = wgid / nig, fm = gid * WGM, gsz = (nM - fm) < WGM ? (nM - fm) : WGM;
        u.pm = fm + ((wgid % nig) % gsz); u.pn = (wgid % nig) / gsz; return true;
    }
    __device__ __forceinline__ void a_ready(const Unit&) const {}
    __device__ __forceinline__ void done(const Unit&) const {}
};

__device__ __forceinline__ unsigned cvt_pk_bf16(float lo, float hi) { unsigned r; asm volatile("v_cvt_pk_bf16_f32 %0, %1, %2" : "=v"(r) : "v"(lo), "v"(hi)); return r; }
typedef float f32x2 __attribute__((ext_vector_type(2)));
__device__ __forceinline__ f32x2 gelu_pk(f32x2 v) {
    const f32x2 av = __builtin_elementwise_abs(v), d = av * 0.2316418882f + 1.0f;
    f32x2 t; t.x = __builtin_amdgcn_rcpf(d.x); t.y = __builtin_amdgcn_rcpf(d.y);
    f32x2 q = t * 0.5307027145f + (-0.7265760135f); q = q * t + 0.7107068705f; q = q * t + (-0.142248368f); q = q * t + 0.127414796f; q = q * t;
    const f32x2 s = (v * v) * (-0.72134752044f);
    f32x2 e; e.x = __builtin_amdgcn_exp2f(s.x); e.y = __builtin_amdgcn_exp2f(s.y);
    const f32x2 m = v * (q * e), r = v - m;
    f32x2 o; o.x = v.x < 0.f ? m.x : r.x; o.y = v.y < 0.f ? m.y : r.y; return o;
}

template <int ACT  > struct EpiBf16 {
    static constexpr bool PERM = true, AFTER_DRAIN = false; static_assert(ACT == 0 || ACT == 1, "EpiBf16: ACT is 0 (none) or 1 (gelu_pk)");
    bf16_t* O; int ldc; const float* bias; int split_cols; size_t split_stride; float scale0;
    __device__ __forceinline__ void operator()(const f32x4 (&acc)[2][2][4][2], const Unit& u, int wr, int wc, int fr, int fq) const {
        const int row0 = u.pm * BM + wr * 64 + fr; int colt = u.pn * BM; bf16_t* base = O;
        float sc = 1.f; if (split_cols) { const int t = colt / split_cols; base += (size_t)t * split_stride; colt -= t * split_cols; if (t == 0) sc = scale0; }
        const int col0 = colt + wc * 32 + 8 * fq, bcol0 = u.pn * BM + wc * 32 + 8 * fq;
        f32x4 bv[2][2];
#pragma unroll
        for (int bj = 0; bj < 2; ++bj)
#pragma unroll
            for (int n = 0; n < 2; ++n) bv[bj][n] = bias ? *(const f32x4*)(bias + bcol0 + bj * HALF + 4 * n) : (f32x4){0.f, 0.f, 0.f, 0.f};
#pragma unroll
        for (int ai = 0; ai < 2; ++ai)
#pragma unroll
            for (int m = 0; m < 4; ++m) { bf16_t* rowp = base + (size_t)(row0 + ai * HALF + m * 16) * ldc + col0;
#pragma unroll
                for (int bj = 0; bj < 2; ++bj) { f32x4 v0 = acc[ai][bj][m][0] + bv[bj][0], v1 = acc[ai][bj][m][1] + bv[bj][1];
                    if (ACT == 1) { f32x2 a = gelu_pk((f32x2){v0[0], v0[1]}), b = gelu_pk((f32x2){v0[2], v0[3]}), c = gelu_pk((f32x2){v1[0], v1[1]}), d = gelu_pk((f32x2){v1[2], v1[3]});
                        v0 = (f32x4){a.x, a.y, b.x, b.y}; v1 = (f32x4){c.x, c.y, d.x, d.y}; }
                    v0 = v0 * sc; v1 = v1 * sc; u32x4 w; w.x = cvt_pk_bf16(v0[0], v0[1]); w.y = cvt_pk_bf16(v0[2], v0[3]); w.z = cvt_pk_bf16(v1[0], v1[1]); w.w = cvt_pk_bf16(v1[2], v1[3]);
                    *(u32x4*)(rowp + bj * HALF) = w; } }
    }
};
__device__ __forceinline__ float silu_f(float x) { return x / (1.0f + __expf(-x)); }
struct EpiResid {
    static constexpr bool PERM = false, AFTER_DRAIN = false;
    const float* xin_lat; const float* xin_ctx; float* xo_lat; float* xo_ctx; const float* mod; float alpha;
    __device__ __forceinline__ void operator()(const f32x4 (&acc)[2][2][4][2], const Unit& u, int wr, int wc, int fr, int fq) const {
        const int prow0 = u.pm * BM; const bool isc = prow0 >= 32768;
        const float* xin = isc ? xin_ctx + (size_t)(prow0 - 32768) * 1024 : xin_lat + (size_t)prow0 * 1024;
        float* xo = isc ? xo_ctx + (size_t)(prow0 - 32768) * 1024 : xo_lat + (size_t)prow0 * 1024;
        const float* g1 = mod + (isc ? 8 : (prow0 >> 12)) * 6144 + 2048;
        const int col0 = u.pn * BM + wc * 32 + 4 * fq;
        f32x4 gv[2][2];
#pragma unroll
        for (int bj = 0; bj < 2; ++bj)
#pragma unroll
            for (int n = 0; n < 2; ++n) gv[bj][n] = *(const f32x4*)(g1 + col0 + bj * HALF + n * 16);
#pragma unroll
        for (int ai = 0; ai < 2; ++ai)
#pragma unroll
            for (int m = 0; m < 4; ++m) { const size_t off = (size_t)(ai * HALF + wr * 64 + m * 16 + fr) * 1024 + col0;
#pragma unroll
                for (int bj = 0; bj < 2; ++bj)
#pragma unroll
                    for (int n = 0; n < 2; ++n) { const f32x4 xv = *(const f32x4*)(xin + off + bj * HALF + n * 16);
                        *(f32x4*)(xo + off + bj * HALF + n * 16) = xv * alpha + gv[bj][n] * acc[ai][bj][m][n]; }
                if (m & 1) asm volatile("" ::: "memory"); }
    }
};
struct EpiGLU {
    static constexpr bool PERM = true, AFTER_DRAIN = false;
    bf16_t* Hh;
    __device__ __forceinline__ void operator()(const f32x4 (&acc)[2][2][4][2], const Unit& u, int wr, int wc, int fr, int fq) const {
        const int row0 = u.pm * BM + wr * 64 + fr; const int col0 = (u.pn & 3) * 128 + wc * 32 + 8 * fq;
#pragma unroll
        for (int ai = 0; ai < 2; ++ai)
#pragma unroll
            for (int m = 0; m < 4; ++m) { bf16_t* rowp = Hh + (size_t)(row0 + ai * HALF + m * 16) * 512 + col0;
                const f32x4 g0 = acc[ai][0][m][0], g1 = acc[ai][0][m][1], u0 = acc[ai][1][m][0], u1 = acc[ai][1][m][1];
                u32x4 w; w.x = cvt_pk_bf16(silu_f(g0[0]) * u0[0], silu_f(g0[1]) * u0[1]); w.y = cvt_pk_bf16(silu_f(g0[2]) * u0[2], silu_f(g0[3]) * u0[3]);
                w.z = cvt_pk_bf16(silu_f(g1[0]) * u1[0], silu_f(g1[1]) * u1[1]); w.w = cvt_pk_bf16(silu_f(g1[2]) * u1[2], silu_f(g1[3]) * u1[3]);
                *(u32x4*)rowp = w; }
    }
};
struct EpiY {
    static constexpr bool PERM = true, AFTER_DRAIN = false;
    bf16_t* O;
    __device__ __forceinline__ void operator()(const f32x4 (&acc)[2][2][4][2], const Unit& u, int wr, int wc, int fr, int fq) const {
        const int row0 = u.pm * BM + wr * 64 + fr; const int col0 = (u.pn & 3) * BM + wc * 32 + 8 * fq;
#pragma unroll
        for (int ai = 0; ai < 2; ++ai)
#pragma unroll
            for (int m = 0; m < 4; ++m) { bf16_t* rowp = O + (size_t)(row0 + ai * HALF + m * 16) * 1024 + col0;
#pragma unroll
                for (int bj = 0; bj < 2; ++bj) { const f32x4 v0 = acc[ai][bj][m][0], v1 = acc[ai][bj][m][1];
                    u32x4 w; w.x = cvt_pk_bf16(v0[0], v0[1]); w.y = cvt_pk_bf16(v0[2], v0[3]); w.z = cvt_pk_bf16(v1[0], v1[1]); w.w = cvt_pk_bf16(v1[2], v1[3]);
                    *(u32x4*)(rowp + bj * HALF) = w; } }
    }
};
struct MoeOrder {
    const PG8_LAS unsigned char* p2e; int nunits, G, c;
    __device__ __forceinline__ bool next(int i, Unit& u) const {
        const int L = i * G + c; if (L >= nunits) return false;
        u.pm = L >> 2; u.pn = (int)p2e[L >> 2] * 4 + (L & 3); return true;
    }
    __device__ __forceinline__ void a_ready(const Unit&) const {}
    __device__ __forceinline__ void done(const Unit&) const {}
};
template <class Epi, class Sched, bool ALIGN_EPI = false, bool SP2 = false>
__device__ __forceinline__ void gemm_phase(PG8_LAS unsigned char* lds, const Gemm g, const Sched& S, const Epi& E) {
    int tid_ = threadIdx.x; asm volatile("" : "+v"(tid_));
    const int tid = tid_, wid = __builtin_amdgcn_readfirstlane(tid >> 6), lane = tid & 63, wr = wid >> 2, wc = wid & 3, fr = lane & 15, fq = lane >> 4;
    const int K = g.K, nt = K / BK;
    unsigned voffA[2], voffB[2];
#pragma unroll
    for (int i = 0; i < 2; ++i) { int R, C; stage_rc(tid * 16 + i * 8192, R, C); const int Rb = Epi::PERM ? ((R & ~31) + perm32(R & 31)) : R;
        voffA[i] = (unsigned)(R * K + C) * 2u; voffB[i] = (unsigned)(Rb * K + C) * 2u; }
    const size_t kstep = (size_t)(BK * 2);
    const size_t hstep = (size_t)HALF * K * 2;
    const size_t tstep = 2 * hstep;
    const unsigned ldsw = (unsigned)wid * 1024u;
    const int aoff = lds_byte(wr * 64 + fr, fq * 8), boff = lds_byte(wc * 32 + fr, fq * 8);
#define PG8_SA(b, h) (((b) * 2 + (h)) * HTB)
#define PG8_SB(b, h) ((4 + (b) * 2 + (h)) * HTB)
#define PG8_STAGE(bufoff, gbase, voff) do { _Pragma("unroll") for (int _i = 0; _i < 2; ++_i) \
        __builtin_amdgcn_global_load_lds((const unsigned*)((const char*)(gbase) + (voff)[_i]), (PG8_LAS unsigned*)(lds + (bufoff) + ldsw + _i * 8192), 16, 0, 0); } while (0)
#define PG8_LDA(dst, b, h) do { _Pragma("unroll") for (int m = 0; m < 4; ++m) _Pragma("unroll") for (int k = 0; k < 2; ++k) dst[m][k] = *(const PG8_LAS bf16x8*)(lds + PG8_SA(b, h) + aoff + m * 2048 + k * 1024); } while (0)
#define PG8_LDB(dst, b, h) do { _Pragma("unroll") for (int n = 0; n < 2; ++n) _Pragma("unroll") for (int k = 0; k < 2; ++k) dst[n][k] = *(const PG8_LAS bf16x8*)(lds + PG8_SB(b, h) + boff + n * 2048 + k * 1024); } while (0)
#define PG8_MMA(ai, bj, At, Bt) do { __builtin_amdgcn_s_setprio(1); _Pragma("unroll") for (int m = 0; m < 4; ++m) _Pragma("unroll") for (int n = 0; n < 2; ++n) _Pragma("unroll") for (int k = 0; k < 2; ++k) \
        acc[ai][bj][m][n] = __builtin_amdgcn_mfma_f32_16x16x32_bf16(Bt[n][k], At[m][k], acc[ai][bj][m][n], 0, 0, 0); __builtin_amdgcn_s_setprio(0); } while (0)
#define PG8_WAIT_V(n) asm volatile("s_waitcnt vmcnt(" #n ")" ::: "memory")
#define PG8_WAIT_L(n) asm volatile("s_waitcnt lgkmcnt(" #n ")" ::: "memory")
#define PG8_BAR __builtin_amdgcn_s_barrier()
#define PG8_SCHED __builtin_amdgcn_sched_barrier(0)
    Unit cur, nxt; int ui = 0;
    if (!S.next(0, cur)) return;
    f32x4 acc[2][2][4][2];
#pragma unroll
    for (int a = 0; a < 2; ++a)
#pragma unroll
        for (int b = 0; b < 2; ++b)
#pragma unroll
            for (int m = 0; m < 4; ++m)
#pragma unroll
                for (int n = 0; n < 2; ++n) acc[a][b][m][n] = (f32x4){0.f, 0.f, 0.f, 0.f};
    bf16x8 At[4][2], B0[2][2], B1[2][2];
    const char* cA = (const char*)g.A + (size_t)cur.pm * tstep; const char* cB = (const char*)g.Bt + (size_t)cur.pn * tstep;
    S.a_ready(cur);
    if constexpr (SP2) {
        PG8_STAGE(PG8_SB(0, 0), cB, voffB); PG8_STAGE(PG8_SB(0, 1), cB + hstep, voffB); PG8_STAGE(PG8_SA(0, 0), cA, voffA); PG8_STAGE(PG8_SA(0, 1), cA + hstep, voffA);
        if (wr == 1) PG8_BAR;
        PG8_WAIT_V(2); PG8_BAR;
        PG8_STAGE(PG8_SB(1, 0), cB + kstep, voffB); PG8_STAGE(PG8_SA(1, 0), cA + kstep, voffA); PG8_STAGE(PG8_SB(1, 1), cB + hstep + kstep, voffB);
        PG8_WAIT_V(6); PG8_BAR;
    } else {
        PG8_STAGE(PG8_SB(0, 0), cB, voffB); PG8_STAGE(PG8_SA(0, 0), cA, voffA); PG8_STAGE(PG8_SB(0, 1), cB + hstep, voffB); PG8_STAGE(PG8_SA(0, 1), cA + hstep, voffA);
        if (wr == 1) PG8_BAR;
        PG8_WAIT_V(4); PG8_BAR;
        PG8_STAGE(PG8_SB(1, 0), cB + kstep, voffB); PG8_STAGE(PG8_SA(1, 0), cA + kstep, voffA); PG8_STAGE(PG8_SB(1, 1), cB + hstep + kstep, voffB);
        PG8_WAIT_V(6); PG8_BAR;
    }
    for (;;) {
        const bool has_next = S.next(ui + 1, nxt);
        const char* nA = has_next ? (const char*)g.A + (size_t)nxt.pm * tstep : cA; const char* nB = has_next ? (const char*)g.Bt + (size_t)nxt.pn * tstep : cB;
        for (int t = 0; t < nt; t += 2) {
            const bool last = (t == nt - 2);
            const char* a1 = cA + (size_t)(t + 1) * kstep;
            const char* a2 = last ? nA : cA + (size_t)(t + 2) * kstep; const char* b2 = last ? nB : cB + (size_t)(t + 2) * kstep;
            const char* a3 = a2 + kstep; const char* b3 = b2 + kstep;
            if (last && has_next) S.a_ready(nxt);
            if constexpr (SP2) {
            PG8_LDB(B0, 0, 0); PG8_LDB(B1, 0, 1); PG8_SCHED; PG8_LDA(At, 0, 0); PG8_STAGE(PG8_SA(1, 1), a1 + hstep, voffA);
            PG8_WAIT_V(8); PG8_WAIT_L(0); PG8_BAR; PG8_MMA(0, 0, At, B0); PG8_MMA(0, 1, At, B1); PG8_BAR; PG8_SCHED;
            PG8_LDA(At, 0, 1); PG8_STAGE(PG8_SB(0, 0), b2, voffB); PG8_STAGE(PG8_SB(0, 1), b2 + hstep, voffB); PG8_STAGE(PG8_SA(0, 0), a2, voffA);
            PG8_WAIT_V(8); PG8_WAIT_L(0); PG8_BAR; PG8_MMA(1, 0, At, B0); PG8_MMA(1, 1, At, B1); PG8_BAR; PG8_SCHED;
            PG8_LDB(B0, 1, 0); PG8_LDB(B1, 1, 1); PG8_SCHED; PG8_LDA(At, 1, 0); PG8_STAGE(PG8_SA(0, 1), a2 + hstep, voffA);
            PG8_WAIT_V(8); PG8_WAIT_L(0); PG8_BAR; PG8_MMA(0, 0, At, B0); PG8_MMA(0, 1, At, B1); PG8_BAR; PG8_SCHED;
            PG8_LDA(At, 1, 1); PG8_STAGE(PG8_SB(1, 0), b3, voffB); PG8_STAGE(PG8_SB(1, 1), b3 + hstep, voffB); PG8_STAGE(PG8_SA(1, 0), a3, voffA);
            PG8_WAIT_V(8); PG8_WAIT_L(0); PG8_BAR; PG8_MMA(1, 0, At, B0); PG8_MMA(1, 1, At, B1); PG8_BAR; PG8_SCHED;
            } else {
            PG8_LDB(B0, 0, 0); PG8_SCHED; PG8_LDA(At, 0, 0); PG8_STAGE(PG8_SA(1, 1), a1 + hstep, voffA);
            PG8_WAIT_L(8); PG8_BAR; PG8_WAIT_L(0); PG8_MMA(0, 0, At, B0); PG8_BAR; PG8_SCHED;
            PG8_LDB(B1, 0, 1); PG8_STAGE(PG8_SB(0, 0), b2, voffB);
            PG8_BAR; PG8_WAIT_L(0); PG8_MMA(0, 1, At, B1); PG8_BAR;
            PG8_LDA(At, 0, 1); PG8_STAGE(PG8_SA(0, 0), a2, voffA);
            PG8_BAR; PG8_WAIT_L(0); PG8_MMA(1, 0, At, B0); PG8_BAR; PG8_SCHED;
            PG8_STAGE(PG8_SB(0, 1), b2 + hstep, voffB);
            PG8_WAIT_V(6); PG8_BAR; PG8_MMA(1, 1, At, B1); PG8_BAR;
            PG8_LDB(B0, 1, 0); PG8_SCHED; PG8_LDA(At, 1, 0); PG8_STAGE(PG8_SA(0, 1), a2 + hstep, voffA);
            PG8_WAIT_L(8); PG8_BAR; PG8_WAIT_L(0); PG8_MMA(0, 0, At, B0); PG8_BAR; PG8_SCHED;
            PG8_LDB(B1, 1, 1); PG8_STAGE(PG8_SB(1, 0), b3, voffB);
            PG8_BAR; PG8_WAIT_L(0); PG8_MMA(0, 1, At, B1); PG8_BAR;
            PG8_LDA(At, 1, 1); PG8_STAGE(PG8_SA(1, 0), a3, voffA);
            PG8_BAR; PG8_WAIT_L(0); PG8_MMA(1, 0, At, B0); PG8_BAR; PG8_SCHED;
            PG8_STAGE(PG8_SB(1, 1), b3 + hstep, voffB);
            PG8_WAIT_V(6); PG8_BAR; PG8_MMA(1, 1, At, B1); PG8_BAR;
            }
        }
        if constexpr (ALIGN_EPI) { if (wr == 0) PG8_BAR; }
        if constexpr (!Epi::AFTER_DRAIN) { E(acc, cur, wr, wc, fr, fq); S.done(cur); }
        if (!has_next) break;
#pragma unroll
        for (int a = 0; a < 2; ++a)
#pragma unroll
            for (int b = 0; b < 2; ++b)
#pragma unroll
                for (int m = 0; m < 4; ++m)
#pragma unroll
                    for (int n = 0; n < 2; ++n) acc[a][b][m][n] = (f32x4){0.f, 0.f, 0.f, 0.f};
        cur = nxt; cA = nA; cB = nB; ++ui;
        if constexpr (ALIGN_EPI) { if (wr == 1) PG8_BAR; }
    }
    PG8_WAIT_V(0);
    if constexpr (!ALIGN_EPI) { if (wr == 0) PG8_BAR; }
    PG8_BAR;
    if constexpr (Epi::AFTER_DRAIN) { E.fused(acc, cur, wr, wc, fr, fq, lds, wid, lane); S.done(cur); }
#undef PG8_SA
#undef PG8_SB
#undef PG8_STAGE
#undef PG8_LDA
#undef PG8_LDB
#undef PG8_MMA
#undef PG8_WAIT_V
#undef PG8_WAIT_L
#undef PG8_BAR
#undef PG8_SCHED
}
}
constexpr int NWAVES = 8, NTHR = 512;
constexpr int DM = 1024, NLAT = 32768, NCTX = 2048, NROWS = 34816, INC = 3328;
constexpr int OFF_CB = 0, OFF_CC = 256, OFF_CX = 512, OFF_Q = 768, OFF_K = 1280, OFF_V = 1792, OFF_G = 2304, OFF_U = 2816, OFF_VV = 3072;
constexpr int NCH = 34;
constexpr float LN_EPS = 1e-5f, ALPHA = 1.41421356237309515f;
constexpr size_t MiB = 1u << 20;
constexpr size_t WS_CTL = 0, CTL_ZERO_BYTES = MiB, WS_MOD = 1 * MiB, WS_WR = 1 * MiB + 512 * 1024, WS_TOK = 2 * MiB, WS_WIN = 4 * MiB, WS_WOUT = 17 * MiB, WS_WGU = 21 * MiB, WS_WD = 149 * MiB,
                 WS_HB = 213 * MiB, WS_ST = WS_HB, WS_XCTX = 281 * MiB, WS_P = 289 * MiB, WS_YMIX = 510 * MiB, WS_XB = WS_P, WS_Y = WS_P, WS_HH = WS_P + 152 * MiB, WS_END = 578 * MiB;
constexpr int CW_TMO = 0, CW_BAR = 4096, CW_WGCNT = 16384, CW_TOT = 32768;
constexpr int RING_BYTES = 131072, LDSCTL_OFF = RING_BYTES, MISC_OFF = LDSCTL_OFF + 320, P2E_OFF = LDSCTL_OFF + 1024, PST_OFF = LDSCTL_OFF + 2048, LDS_BYTES = 147456;
constexpr int MAXPANELS = 304;

#define GAS __attribute__((address_space(1)))
#define LAS __attribute__((address_space(3)))
typedef unsigned short bf16;
typedef unsigned v4u __attribute__((ext_vector_type(4)));
typedef unsigned v2u __attribute__((ext_vector_type(2)));
typedef float f32x4 __attribute__((ext_vector_type(4)));
#define LDS_WAIT() asm volatile("s_waitcnt lgkmcnt(0)" ::: "memory")
#define VM_WAIT() asm volatile("s_waitcnt vmcnt(0)" ::: "memory")
__device__ __forceinline__ unsigned f2bf(float f) { unsigned u = __builtin_bit_cast(unsigned, f); return (u + 0x7fffu + ((u >> 16) & 1u)) >> 16; }
__device__ __forceinline__ unsigned pk2(float lo, float hi) { return f2bf(lo) | (f2bf(hi) << 16); }
__device__ __forceinline__ float bflo(unsigned w) { return __builtin_bit_cast(float, w << 16); }
__device__ __forceinline__ float bfhi(unsigned w) { return __builtin_bit_cast(float, w & 0xffff0000u); }
__device__ __forceinline__ float wave_sum(float v) {
#pragma unroll
    for (int o = 1; o < 64; o <<= 1) v += __shfl_xor(v, o);
    return v;
}
__device__ __forceinline__ float log_sigmoid_f(float x) { return -log1pf(expf(-x)); }

struct Args { const float* in[24]; float* out; unsigned char* ws; int ph_lo, ph_hi; };
#define XB_TMO      128
#define XB_XCNT(j)  (256  + 64 * (j))
#define XB_XSUB(j)  (1280 + 64 * (j))
#define XB_XGEN(j)  (2304 + 64 * (j))
#define XB_TOP      3328
#define XB_TOPGEN   3392
#define XCD_BAR_WORDS 3456
#define XB_SPIN_CAP (1u << 18)

__device__ __forceinline__ unsigned xb_ld(unsigned* p)              { return __hip_atomic_load(p, __ATOMIC_RELAXED, __HIP_MEMORY_SCOPE_AGENT); }
__device__ __forceinline__ unsigned xb_add(unsigned* p, unsigned v) { return __hip_atomic_fetch_add(p, v, __ATOMIC_RELAXED, __HIP_MEMORY_SCOPE_AGENT); }
__device__ __forceinline__ unsigned xb_xcc_id() { return (unsigned)__builtin_amdgcn_s_getreg((3 << 11) | 20) & 0xFu; }
#define XB_SPIN(cond, bar) do { unsigned _sp = 0; while (cond) { __builtin_amdgcn_s_sleep(1); \
    if ((++_sp & 255u) == 0u) { if (xb_ld(&(bar)[XB_TMO])) break; if (_sp > XB_SPIN_CAP) { atomicAdd(&(bar)[XB_TMO], 1u); break; } } } } while (0)

struct XcdBarrier {
    unsigned* bar; unsigned x;
    volatile LAS unsigned* st;
};

__device__ __forceinline__ XcdBarrier xcd_barrier_post(unsigned* bar, volatile LAS unsigned* st) {
    XcdBarrier b; b.bar = bar; b.x = xb_xcc_id(); b.st = st;
    if (threadIdx.x == 0) (void)xb_add(&bar[XB_XCNT(b.x)], 1u);
    return b;
}
__device__ __forceinline__ void xcd_barrier_complete(unsigned* bar, unsigned x, unsigned& nloc, unsigned& nx) {
    const unsigned G = gridDim.x * gridDim.y * gridDim.z;
    unsigned sum, cnt, mine, sp = 0u;
    for (;;) {
        sum = 0u; cnt = 0u; mine = 0u;
#pragma unroll
        for (unsigned j = 0; j < 16; ++j) { const unsigned c = xb_ld(&bar[XB_XCNT(j)]); sum += c; cnt += (c > 0u) ? 1u : 0u; mine = (j == x) ? c : mine; }
        if (sum == G) break;
        __builtin_amdgcn_s_sleep(1);
        if ((++sp & 255u) == 0u) { if (xb_ld(&bar[XB_TMO])) break; if (sp > XB_SPIN_CAP) { atomicAdd(&bar[XB_TMO], 1u); break; } }
    }
    nloc = mine > 0u ? mine : 1u; nx = cnt > 0u ? cnt : 1u;
}

__device__ __forceinline__ void xcd_barrier(const XcdBarrier& b) {
    asm volatile("s_waitcnt vmcnt(0)" ::: "memory");
    __syncthreads();
    if (threadIdx.x == 0) {
        unsigned* bar = b.bar;
        __builtin_amdgcn_s_waitcnt(0);
        unsigned nloc = b.st[0], nx = b.st[1];
        if (nloc == 0u) { xcd_barrier_complete(bar, b.x, nloc, nx); b.st[0] = nloc; b.st[1] = nx; }
        const unsigned old = xb_add(&bar[XB_XSUB(b.x)], 1u);
        const unsigned gen = old / nloc;
        if (old + 1u == (gen + 1u) * nloc) {
            __builtin_amdgcn_fence(__ATOMIC_RELEASE, "agent");
            asm volatile("s_waitcnt vmcnt(0)" ::: "memory");
            const unsigned og = xb_add(&bar[XB_TOP], 1u);
            const unsigned tg = og / nx;
            if (og + 1u == (tg + 1u) * nx) xb_add(&bar[XB_TOPGEN], 1u);
            else XB_SPIN(xb_ld(&bar[XB_TOPGEN]) == tg, bar);
            __builtin_amdgcn_fence(__ATOMIC_ACQUIRE, "agent");
            xb_add(&bar[XB_XGEN(b.x)], 1u);
            asm volatile("s_waitcnt vmcnt(0)" ::: "memory");
        } else {
            XB_SPIN(xb_ld(&bar[XB_XGEN(b.x)]) == gen, bar);
            __builtin_amdgcn_fence(__ATOMIC_ACQUIRE, "agent");
            asm volatile("s_waitcnt vmcnt(0)" ::: "memory");
        }
    }
    __syncthreads();
}
__device__ __forceinline__ void transpose_tile(const float* Wsrc, int ldn, bf16* dst, int ldk, float scale, LAS float* scr, int lane) {
#pragma unroll 8
    for (int i = 0; i < 32; ++i) { const int kk = 2 * i + (lane >> 5); scr[kk * 33 + (lane & 31)] = Wsrc[(size_t)kk * ldn + (lane & 31)] * scale; }
    LDS_WAIT(); asm volatile("" ::: "memory");
    const int c = lane & 7;
#pragma unroll
    for (int j = 0; j < 4; ++j) { const int n = (lane >> 3) + 8 * j; const LAS float* s = scr + (8 * c) * 33 + n;
        v4u o; o.x = pk2(s[0 * 33], s[1 * 33]); o.y = pk2(s[2 * 33], s[3 * 33]); o.z = pk2(s[4 * 33], s[5 * 33]); o.w = pk2(s[6 * 33], s[7 * 33]);
        *(GAS v4u*)(dst + (size_t)n * ldk + 8 * c) = o; }
    LDS_WAIT(); asm volatile("" ::: "memory");
}

__device__ __forceinline__ void phase_p0(const Args& a, LAS unsigned char* lds, int tid, int lane, int wave) {
    const int G = gridDim.x;
    {
        LAS float* s = (LAS float*)lds; LAS float* red = (LAS float*)(lds + 36864);
        const float* c = a.in[1]; const float* cctx = a.in[3]; const float* wada = a.in[4]; const float* bada = a.in[5];
        float* mod = (float*)(a.ws + WS_MOD);
        for (int u = blockIdx.x; u < 192; u += G) {
            const int l = u / 96, j0 = (u % 96) * 64;
            for (int i = tid; i < 9 * 1024; i += NTHR) { const int r = i >> 10, k = i & 1023; const float v = r < 8 ? c[r * 1024 + k] : cctx[k]; s[i] = v / (1.0f + expf(-v)); }
            __syncthreads();
            const int jq = tid & 15, kg = tid >> 4;
            float acc[9][4];
#pragma unroll
            for (int r = 0; r < 9; ++r) { acc[r][0] = 0.f; acc[r][1] = 0.f; acc[r][2] = 0.f; acc[r][3] = 0.f; }
            const float* w = wada + (size_t)l * 1024 * 6144 + j0 + jq * 4;
            for (int k = kg; k < 1024; k += 32) { const f32x4 wv = *(const f32x4*)(w + (size_t)k * 6144);
#pragma unroll
                for (int r = 0; r < 9; ++r) { const float sr = s[r * 1024 + k]; acc[r][0] += sr * wv.x; acc[r][1] += sr * wv.y; acc[r][2] += sr * wv.z; acc[r][3] += sr * wv.w; } }
#pragma unroll
            for (int r = 0; r < 9; ++r)
#pragma unroll
                for (int i = 0; i < 4; ++i) red[(kg * 9 + r) * 64 + jq * 4 + i] = acc[r][i];
            __syncthreads();
            for (int o = tid; o < 576; o += NTHR) { const int r = o >> 6, j = o & 63; float sum = 0.f;
                for (int g2 = 0; g2 < 32; ++g2) sum += red[(g2 * 9 + r) * 64 + j];
                mod[(l * 9 + r) * 6144 + j0 + j] = sum + bada[l * 6144 + j0 + j]; }
            __syncthreads();
        }
    }
    {
        LAS float* scr = (LAS float*)(lds + wave * 16384);
        const int gw = blockIdx.x * NWAVES + wave, NGW = G * NWAVES;
        const float* w_in = a.in[6]; const float* w_out = a.in[12]; const float* w_gate = a.in[19]; const float* w_up = a.in[20]; const float* w_down = a.in[21];
        bf16* WIN = (bf16*)(a.ws + WS_WIN); bf16* WOUT = (bf16*)(a.ws + WS_WOUT); bf16* WGU = (bf16*)(a.ws + WS_WGU); bf16* WD = (bf16*)(a.ws + WS_WD);
        constexpr int I_IN = 2 * 16 * 104, I_OUT = 2 * 16 * 32, I_GU = 2 * 2 * 32 * 256, I_D = 2 * 32 * 256, NITEMS = I_IN + I_OUT + I_GU + I_D;
        for (int it = gw; it < NITEMS; it += NGW) {
            int r = it;
            if (r < I_IN) { const int l = r / 1664, q = r % 1664, k0 = 64 * (q / 104), n0 = 32 * (q % 104);
                const float sc = (n0 >= OFF_K && n0 < OFF_V) ? 0.125f : 1.0f;
                transpose_tile(w_in + ((size_t)l * 1024 + k0) * INC + n0, INC, WIN + ((size_t)l * INC + n0) * 1024 + k0, 1024, sc, scr, lane); continue; }
            r -= I_IN;
            if (r < I_OUT) { const int l = r / 512, q = r % 512, k0 = 64 * (q / 32), n0 = 32 * (q % 32);
                transpose_tile(w_out + ((size_t)l * 1024 + k0) * 1024 + n0, 1024, WOUT + ((size_t)l * 1024 + n0) * 1024 + k0, 1024, 1.0f, scr, lane); continue; }
            r -= I_OUT;
            if (r < I_GU) { const int isup = r >= (I_GU / 2) ? 1 : 0; r -= isup * (I_GU / 2);
                const int le = r / 256, q = r % 256, k0 = 64 * (q / 16), n0 = 32 * (q % 16);
                const float* src = (isup ? w_up : w_gate) + ((size_t)le * 1024 + k0) * 512 + n0;
                const int drow = (n0 >> 7) * 256 + (n0 & 127) + isup * 128;
                transpose_tile(src, 512, WGU + ((size_t)le * 1024 + drow) * 1024 + k0, 1024, 1.0f, scr, lane); continue; }
            r -= I_GU;
            { const int le = r / 256, q = r % 256, k0 = 64 * (q / 32), n0 = 32 * (q % 32);
                transpose_tile(w_down + ((size_t)le * 512 + k0) * 1024 + n0, 1024, WD + ((size_t)le * 1024 + n0) * 512 + k0, 512, 1.0f, scr, lane); }
        }
    }
    {
        bf16* WR = (bf16*)(a.ws + WS_WR);
        for (int i = blockIdx.x * NTHR + tid; i < 2 * 64 * 1024; i += G * NTHR) { const int l = i >> 16, j = (i >> 10) & 63, k = i & 1023;
            float v = 0.f;
            if (j < 4) v = a.in[15][((size_t)l * 1024 + k) * 4 + j]; else if (j < 36) v = a.in[17][(((size_t)l * 4 + ((j - 4) >> 3)) * 1024 + k) * 8 + ((j - 4) & 7)];
            const unsigned hi = f2bf(v); const float r = v - __builtin_bit_cast(float, hi << 16);
            WR[((size_t)(l * 2) * 64 + j) * 1024 + k] = (bf16)hi; WR[((size_t)(l * 2 + 1) * 64 + j) * 1024 + k] = (bf16)f2bf(r); }
    }
    __syncthreads();
}

__device__ __forceinline__ void phase_p1(const Args& a, int lane, int wave) {
    const int gw = blockIdx.x * NWAVES + wave, NGW = gridDim.x * NWAVES;
    const float* mod = (const float*)(a.ws + WS_MOD); bf16* Hb = (bf16*)(a.ws + WS_HB);
    for (int row = gw; row < NROWS; row += NGW) {
        const float* src = row < NLAT ? a.in[0] + (size_t)row * 1024 : a.in[2] + (size_t)(row - NLAT) * 1024;
        const float* m0 = mod + (row < NLAT ? (row >> 12) : 8) * 6144;
#pragma unroll
        for (int j = 0; j < 4; ++j) { const int idx = (lane + 64 * j) * 4;
            const f32x4 v = *(const f32x4*)(src + idx), sh = *(const f32x4*)(m0 + idx), sc = *(const f32x4*)(m0 + 1024 + idx);
            const f32x4 o = v * (sc + 1.0f) + sh; v2u w; w.x = pk2(o.x, o.y); w.y = pk2(o.z, o.w);
            *(v2u*)(Hb + (size_t)row * 1024 + idx) = w; }
    }
}

__device__ __forceinline__ int chunk_row0(int b, int c) { return c < 2 ? NLAT + b * 256 + c * 128 : b * 4096 + (c - 2) * 128; }
__device__ __forceinline__ size_t st_off(int b, int c, int h, int dir) { return ((((size_t)b * NCH + c) * 8 + h) * 2 + dir) * 4096; }

__device__ __forceinline__ void phase_b(const Args& a, int l, LAS unsigned char* lds, int tid) {
    const bf16* P = (const bf16*)(a.ws + WS_P); float* ST = (float*)(a.ws + WS_ST);
    LAS float* Ks = (LAS float*)lds; LAS float* Vs = (LAS float*)(lds + 32768); LAS float* pf = (LAS float*)(lds + 65536); LAS float* pb = pf + 128;
    for (int u = blockIdx.x; u < 8 * NCH * 8; u += gridDim.x) {
        const int b = u / (NCH * 8), c = (u % (NCH * 8)) / 8, h = u % 8; const int row0 = chunk_row0(b, c);
        __syncthreads();
        if (tid < 128) { const float lgf = log_sigmoid_f(a.in[8][l * 8 + h]), lgb = log_sigmoid_f(a.in[9][l * 8 + h]);
            pf[tid] = expf(lgf * (float)(127 - tid)); pb[tid] = expf(lgb * (float)tid); }
        { const int j = tid >> 2, part = tid & 3; const bf16* kp = P + (size_t)(row0 + j) * INC + OFF_K + h * 64 + part * 16; const bf16* vp = kp + (OFF_V - OFF_K);
#pragma unroll
          for (int q = 0; q < 2; ++q) { const v4u kw = *(const v4u*)(kp + 8 * q), vw = *(const v4u*)(vp + 8 * q);
              LAS float* kd = Ks + j * 64 + part * 16 + 8 * q; LAS float* vd = Vs + j * 64 + part * 16 + 8 * q;
              kd[0] = bflo(kw.x); kd[1] = bfhi(kw.x); kd[2] = bflo(kw.y); kd[3] = bfhi(kw.y); kd[4] = bflo(kw.z); kd[5] = bfhi(kw.z); kd[6] = bflo(kw.w); kd[7] = bfhi(kw.w);
              vd[0] = bflo(vw.x); vd[1] = bfhi(vw.x); vd[2] = bflo(vw.y); vd[3] = bfhi(vw.y); vd[4] = bflo(vw.z); vd[5] = bfhi(vw.z); vd[6] = bflo(vw.w); vd[7] = bfhi(vw.w); } }
        __syncthreads();
        const int d = tid >> 3, e0 = (tid & 7) * 8;
        float af[8], ab[8];
#pragma unroll
        for (int i = 0; i < 8; ++i) { af[i] = 0.f; ab[i] = 0.f; }
        for (int j = 0; j < 128; ++j) { const float kd = Ks[j * 64 + d], kf = kd * pf[j], kb = kd * pb[j];
            const f32x4 v0 = *(const LAS f32x4*)(Vs + j * 64 + e0), v1 = *(const LAS f32x4*)(Vs + j * 64 + e0 + 4);
            af[0] += kf * v0.x; af[1] += kf * v0.y; af[2] += kf * v0.z; af[3] += kf * v0.w; af[4] += kf * v1.x; af[5] += kf * v1.y; af[6] += kf * v1.z; af[7] += kf * v1.w;
            ab[0] += kb * v0.x; ab[1] += kb * v0.y; ab[2] += kb * v0.z; ab[3] += kb * v0.w; ab[4] += kb * v1.x; ab[5] += kb * v1.y; ab[6] += kb * v1.z; ab[7] += kb * v1.w; }
        float* o0 = ST + st_off(b, c, h, 0) + d * 64 + e0; float* o1 = ST + st_off(b, c, h, 1) + d * 64 + e0;
        *(f32x4*)o0 = (f32x4){af[0], af[1], af[2], af[3]}; *(f32x4*)(o0 + 4) = (f32x4){af[4], af[5], af[6], af[7]};
        *(f32x4*)o1 = (f32x4){ab[0], ab[1], ab[2], ab[3]}; *(f32x4*)(o1 + 4) = (f32x4){ab[4], ab[5], ab[6], ab[7]};
    }
    __syncthreads();
}

__device__ __forceinline__ void phase_c(const Args& a, int l, int tid, bool dry = false) {
    float* ST = (float*)(a.ws + WS_ST); float* STW = dry ? (float*)(a.ws + WS_YMIX) : ST;
    for (int it = blockIdx.x * NTHR + tid; it < 8 * 8 * 2 * 1024; it += gridDim.x * NTHR) {
        const int q = it & 1023, dir = (it >> 10) & 1, h = (it >> 11) & 7, b = it >> 14;
        const float lg = log_sigmoid_f(dir ? a.in[9][l * 8 + h] : a.in[8][l * 8 + h]); const float dec = expf(128.0f * lg);
        f32x4 kv[NCH];
#pragma unroll
        for (int s = 0; s < NCH; ++s) { const int c = dir ? (s < 2 ? 1 - s : 35 - s) : s; kv[s] = *(const f32x4*)(ST + st_off(b, c, h, dir) + q * 4); }
        f32x4 st = (f32x4){0.f, 0.f, 0.f, 0.f};
#pragma unroll
        for (int s = 0; s < NCH; ++s) { const int c = dir ? (s < 2 ? 1 - s : 35 - s) : s; *(f32x4*)(STW + st_off(b, c, h, dir) + q * 4) = st; st = st * dec + kv[s]; }
    }
}
__device__ __forceinline__ void unpack8(const v4u w, float* f) { f[0] = bflo(w.x); f[1] = bfhi(w.x); f[2] = bflo(w.y); f[3] = bfhi(w.y); f[4] = bflo(w.z); f[5] = bfhi(w.z); f[6] = bflo(w.w); f[7] = bfhi(w.w); }
__device__ __forceinline__ v4u pack8(const float* f) { v4u w; w.x = pk2(f[0], f[1]); w.y = pk2(f[2], f[3]); w.z = pk2(f[4], f[5]); w.w = pk2(f[6], f[7]); return w; }

__device__ __forceinline__ void phase_d(const Args& a, int l, LAS unsigned char* lds, int tid, int lane) {
    const bf16* P = (const bf16*)(a.ws + WS_P); const float* ST = (const float*)(a.ws + WS_ST); bf16* Y = (bf16*)(a.ws + WS_YMIX);
    const float* convw = a.in[7] + l * 3 * 256; const float* sguw = a.in[10] + (size_t)l * 4 * 128 * 128; const float* sgub = a.in[11] + l * 4 * 128;
    const int c_lo = l == 1 ? 2 : 0, cpb = NCH - c_lo, nunits = 8 * cpb;
    LAS float* Sf = (LAS float*)lds; LAS float* Sb = (LAS float*)(lds + 16384); LAS float* Ks = (LAS float*)(lds + 32768); LAS float* Vs = (LAS float*)(lds + 65536);
    LAS float* VN = (LAS float*)lds;
    for (int u = blockIdx.x; u < nunits; u += gridDim.x) {
        const int b = u / cpb, c = c_lo + u % cpb; const int row0 = chunk_row0(b, c); const bool isc = c < 2;
#ifndef NO_D1
        for (int idx = tid; idx < 128 * 32; idx += NTHR) {
            const int p = idx >> 5, ch0 = (idx & 31) * 8; const int row = row0 + p;
            int dprev = -1, dnext = 1; bool vprev, vnext;
            if (isc) { const int t = c * 128 + p; vprev = t > 0; vnext = t < 255; }
            else { const int t = (c - 2) * 128 + p;
                if (ch0 < 128) { const int col = t & 63; vprev = col > 0; vnext = col < 63; }
                else { const int rg = t >> 6; vprev = rg > 0; vnext = rg < 63; dprev = -64; dnext = 64; } }
            const bf16* pr = P + (size_t)row * INC;
            float cb[8], zc[8], zp[8], zn[8], t0[8], t1[8];
            unpack8(*(const v4u*)(pr + OFF_CB + ch0), cb);
            unpack8(*(const v4u*)(pr + OFF_CC + ch0), t0); unpack8(*(const v4u*)(pr + OFF_CX + ch0), t1);
#pragma unroll
            for (int i = 0; i < 8; ++i) { zc[i] = t0[i] * t1[i]; zp[i] = 0.f; zn[i] = 0.f; }
            if (vprev) { const bf16* q = pr + (ptrdiff_t)dprev * INC; unpack8(*(const v4u*)(q + OFF_CC + ch0), t0); unpack8(*(const v4u*)(q + OFF_CX + ch0), t1);
#pragma unroll
                for (int i = 0; i < 8; ++i) zp[i] = t0[i] * t1[i]; }
            if (vnext) { const bf16* q = pr + (ptrdiff_t)dnext * INC; unpack8(*(const v4u*)(q + OFF_CC + ch0), t0); unpack8(*(const v4u*)(q + OFF_CX + ch0), t1);
#pragma unroll
                for (int i = 0; i < 8; ++i) zn[i] = t0[i] * t1[i]; }
            float o[8];
#pragma unroll
            for (int i = 0; i < 8; ++i) o[i] = cb[i] * (convw[ch0 + i] * zp[i] + convw[256 + ch0 + i] * zc[i] + convw[512 + ch0 + i] * zn[i]);
            *(v4u*)(Y + (size_t)row * 1024 + ch0) = pack8(o);
        }
#endif
        const int i = tid >> 2, part = tid & 3;
#ifndef NO_D2
#pragma unroll 1
        for (int h = 0; h < 8; ++h) {
            __syncthreads();
            { const bf16* kp = P + (size_t)(row0 + i) * INC + OFF_K + h * 64 + part * 16; const bf16* vp = kp + (OFF_V - OFF_K);
#pragma unroll
              for (int q = 0; q < 2; ++q) { float kf[8], vf[8]; unpack8(*(const v4u*)(kp + 8 * q), kf); unpack8(*(const v4u*)(vp + 8 * q), vf);
                  LAS float* kd = Ks + i * 64 + part * 16 + 8 * q; LAS float* vd = Vs + i * 64 + part * 16 + 8 * q;
#pragma unroll
                  for (int e = 0; e < 8; ++e) { kd[e] = kf[e]; vd[e] = vf[e]; } }
              const float* sf = ST + st_off(b, c, h, 0); const float* sb = ST + st_off(b, c, h, 1);
#pragma unroll
              for (int q = 0; q < 2; ++q) { const int o4 = (tid + NTHR * q) * 4; *(LAS f32x4*)(Sf + o4) = *(const f32x4*)(sf + o4); *(LAS f32x4*)(Sb + o4) = *(const f32x4*)(sb + o4); } }
            float qv[16];
            { const bf16* qp = P + (size_t)(row0 + i) * INC + OFF_Q + h * 64 + part * 16; unpack8(*(const v4u*)qp, qv); unpack8(*(const v4u*)(qp + 8), qv + 8); }
            const float lgf = log_sigmoid_f(a.in[8][l * 8 + h]), lgb = log_sigmoid_f(a.in[9][l * 8 + h]);
            __syncthreads();
            float o[16];
#pragma unroll
            for (int e = 0; e < 16; ++e) o[e] = 0.f;
#pragma unroll 1
            for (int j = 0; j < 128; ++j) {
                const LAS f32x4* kr = (const LAS f32x4*)(Ks + j * 64 + part * 16);
                float s = 0.f;
#pragma unroll
                for (int q = 0; q < 4; ++q) { const f32x4 k4 = kr[q]; s += qv[4 * q] * k4.x + qv[4 * q + 1] * k4.y + qv[4 * q + 2] * k4.z + qv[4 * q + 3] * k4.w; }
                s += __shfl_xor(s, 1); s += __shfl_xor(s, 2);
                const int rel = i - j;
                const float dec = rel > 0 ? expf(lgf * (float)rel) : (rel < 0 ? expf(lgb * (float)(-rel)) : 2.0f);
                s *= dec;
                const LAS f32x4* vr = (const LAS f32x4*)(Vs + j * 64 + part * 16);
#pragma unroll
                for (int q = 0; q < 4; ++q) { const f32x4 v4 = vr[q]; o[4 * q] += s * v4.x; o[4 * q + 1] += s * v4.y; o[4 * q + 2] += s * v4.z; o[4 * q + 3] += s * v4.w; }
            }
            float of[16], ob[16];
#pragma unroll
            for (int e = 0; e < 16; ++e) { of[e] = 0.f; ob[e] = 0.f; }
            __syncthreads();
#pragma unroll
            for (int dd = 0; dd < 16; ++dd) Ks[i * 64 + ((part * 16 + dd + i) & 63)] = qv[dd];
            __syncthreads();
#pragma unroll 2
            for (int d = 0; d < 64; ++d) { const float qd = Ks[i * 64 + ((d + i) & 63)];
                const LAS f32x4* fr = (const LAS f32x4*)(Sf + d * 64 + part * 16); const LAS f32x4* br = (const LAS f32x4*)(Sb + d * 64 + part * 16);
#pragma unroll
                for (int q = 0; q < 4; ++q) { const f32x4 f4 = fr[q], b4 = br[q];
                    of[4 * q] += qd * f4.x; of[4 * q + 1] += qd * f4.y; of[4 * q + 2] += qd * f4.z; of[4 * q + 3] += qd * f4.w;
                    ob[4 * q] += qd * b4.x; ob[4 * q + 1] += qd * b4.y; ob[4 * q + 2] += qd * b4.z; ob[4 * q + 3] += qd * b4.w; } }
            const float df = expf(lgf * (float)(i + 1)), db = expf(lgb * (float)(128 - i));
            float sum = 0.f;
#pragma unroll
            for (int e = 0; e < 16; ++e) { o[e] += df * of[e] + db * ob[e]; sum += o[e]; }
            sum += __shfl_xor(sum, 1); sum += __shfl_xor(sum, 2);
            const float mu = sum * (1.0f / 64.0f); float vs = 0.f;
#pragma unroll
            for (int e = 0; e < 16; ++e) { o[e] -= mu; vs += o[e] * o[e]; }
            vs += __shfl_xor(vs, 1); vs += __shfl_xor(vs, 2);
            const float rs = 1.0f / sqrtf(vs * (1.0f / 64.0f) + LN_EPS);
            float gv[16];
            { const bf16* gp = P + (size_t)(row0 + i) * INC + OFF_G + h * 64 + part * 16; unpack8(*(const v4u*)gp, gv); unpack8(*(const v4u*)(gp + 8), gv + 8); }
#pragma unroll
            for (int e = 0; e < 16; ++e) o[e] = (gv[e] / (1.0f + expf(-gv[e]))) * (o[e] * rs);
            bf16* yp = Y + (size_t)(row0 + i) * 1024 + 256 + h * 64 + part * 16;
            *(v4u*)yp = pack8(o); *(v4u*)(yp + 8) = pack8(o + 8);
        }
#endif
#ifndef NO_D3
        __syncthreads();
        {
            const bf16* vp = P + (size_t)(row0 + i) * INC + OFF_VV + part * 64;
            float sum = 0.f;
#pragma unroll 2
            for (int q = 0; q < 8; ++q) { float t8[8]; unpack8(*(const v4u*)(vp + 8 * q), t8);
#pragma unroll
                for (int e = 0; e < 8; ++e) sum += t8[e]; }
            sum += __shfl_xor(sum, 1); sum += __shfl_xor(sum, 2);
            const float mu = sum * (1.0f / 256.0f); float vs = 0.f;
#pragma unroll 2
            for (int q = 0; q < 8; ++q) { float t8[8]; unpack8(*(const v4u*)(vp + 8 * q), t8);
#pragma unroll
                for (int e = 0; e < 8; ++e) { const float dlt = t8[e] - mu; vs += dlt * dlt; } }
            vs += __shfl_xor(vs, 1); vs += __shfl_xor(vs, 2);
            const float rs = 1.0f / sqrtf(vs * (1.0f / 256.0f) + LN_EPS);
            LAS float* dst = VN + (part * 128 + i) * 64;
#pragma unroll 2
            for (int q = 0; q < 8; ++q) { float t8[8]; unpack8(*(const v4u*)(vp + 8 * q), t8);
                *(LAS f32x4*)(dst + 8 * q) = (f32x4){(t8[0] - mu) * rs, (t8[1] - mu) * rs, (t8[2] - mu) * rs, (t8[3] - mu) * rs};
                *(LAS f32x4*)(dst + 8 * q + 4) = (f32x4){(t8[4] - mu) * rs, (t8[5] - mu) * rs, (t8[6] - mu) * rs, (t8[7] - mu) * rs}; }
        }
        __syncthreads();
        for (int g = 0; g < 4; ++g) {
            float acc[16];
#pragma unroll
            for (int e = 0; e < 16; ++e) acc[e] = 0.f;
            const float* wrow = sguw + ((size_t)g * 128 + i) * 128;
            for (int q = 0; q < 128; q += 4) { const f32x4 w4 = *(const f32x4*)(wrow + q);
#pragma unroll
                for (int qq = 0; qq < 4; ++qq) { const float w = w4[qq]; const LAS f32x4* vr = (const LAS f32x4*)(VN + (g * 128 + q + qq) * 64 + part * 16);
#pragma unroll
                    for (int t = 0; t < 4; ++t) { const f32x4 v4 = vr[t]; acc[4 * t] += w * v4.x; acc[4 * t + 1] += w * v4.y; acc[4 * t + 2] += w * v4.z; acc[4 * t + 3] += w * v4.w; } } }
            const float bias = sgub[g * 128 + i];
            float uv[16];
            { const bf16* up = P + (size_t)(row0 + i) * INC + OFF_U + g * 64 + part * 16; unpack8(*(const v4u*)up, uv); unpack8(*(const v4u*)(up + 8), uv + 8); }
#pragma unroll
            for (int e = 0; e < 16; ++e) acc[e] = uv[e] * (acc[e] + bias);
            bf16* yp = Y + (size_t)(row0 + i) * 1024 + 768 + g * 64 + part * 16;
            *(v4u*)yp = pack8(acc); *(v4u*)(yp + 8) = pack8(acc + 8);
        }
#endif
        __syncthreads();
    }
}

__device__ __forceinline__ void phase_f(const Args& a, int l, LAS unsigned char* lds, int tid, int lane, int wave, bool dry = false) {
    LAS int* lcnt = (LAS int*)lds;
    __syncthreads();
    if (tid < 32) lcnt[tid] = 0;
    __syncthreads();
    const int gw = blockIdx.x * NWAVES + wave, NGW = gridDim.x * NWAVES, nrows = l == 0 ? NROWS : NLAT;
    const float* mod = (const float*)(a.ws + WS_MOD) + l * 9 * 6144;
    const float* lng = a.in[13] + l * 1024; const float* lnb = a.in[14] + l * 1024;
    const float* rgw = a.in[15] + l * 1024 * 4; const float* rgb = a.in[16] + l * 4; const float* rew = a.in[17] + (size_t)l * 4 * 1024 * 8; const float* reb = a.in[18] + l * 32;
    bf16* Hb = (bf16*)(a.ws + (dry ? WS_P + 160 * MiB : WS_HB)); unsigned* tok = (unsigned*)(a.ws + (dry ? WS_P + 240 * MiB : WS_TOK)); float* xctx = (float*)(a.ws + WS_XCTX);
    for (int row = gw; row < nrows; row += NGW) {
        float* xr = row < NLAT ? a.out + (size_t)row * 1024 : xctx + (size_t)(row - NLAT) * 1024;
        float* xw = dry ? (float*)(a.ws + WS_P) + (size_t)row * 1024 : xr;
        const float* m0 = mod + (row < NLAT ? (row >> 12) : 8) * 6144;
        f32x4 v[4]; float s = 0.f;
#pragma unroll
        for (int j = 0; j < 4; ++j) { v[j] = *(const f32x4*)(xr + (lane + 64 * j) * 4); s += (v[j].x + v[j].y) + (v[j].z + v[j].w); }
        const float mean = wave_sum(s) * (1.0f / 1024.0f); float s2 = 0.f;
#pragma unroll
        for (int j = 0; j < 4; ++j) { v[j] = v[j] - mean; s2 += (v[j].x * v[j].x + v[j].y * v[j].y) + (v[j].z * v[j].z + v[j].w * v[j].w); }
        const float rstd = 1.0f / sqrtf(wave_sum(s2) * (1.0f / 1024.0f) + LN_EPS);
        float lg[4] = {0.f, 0.f, 0.f, 0.f};
#pragma unroll
        for (int j = 0; j < 4; ++j) { const int idx = (lane + 64 * j) * 4;
            const f32x4 x1 = v[j] * rstd * *(const f32x4*)(lng + idx) + *(const f32x4*)(lnb + idx);
            *(f32x4*)(xw + idx) = x1;
            const f32x4 hm = x1 * (*(const f32x4*)(m0 + 4096 + idx) + 1.0f) + *(const f32x4*)(m0 + 3072 + idx);
            v[j] = hm;
            v2u w; w.x = pk2(hm.x, hm.y); w.y = pk2(hm.z, hm.w); *(v2u*)(Hb + (size_t)row * 1024 + idx) = w;
#pragma unroll
            for (int t = 0; t < 4; ++t) { const f32x4 w4 = *(const f32x4*)(rgw + (idx + t) * 4); const float hv = hm[t];
                lg[0] += hv * w4.x; lg[1] += hv * w4.y; lg[2] += hv * w4.z; lg[3] += hv * w4.w; } }
#pragma unroll
        for (int g = 0; g < 4; ++g) lg[g] = wave_sum(lg[g]) + rgb[g];
        int gi = 0; float gm = lg[0];
#pragma unroll
        for (int g = 1; g < 4; ++g) if (lg[g] > gm) { gm = lg[g]; gi = g; }
        float gden = 0.f;
#pragma unroll
        for (int g = 0; g < 4; ++g) gden += expf(lg[g] - gm);
        const float gprob = 1.0f / gden;
        float le[8] = {0.f, 0.f, 0.f, 0.f, 0.f, 0.f, 0.f, 0.f};
        const float* rw = rew + (size_t)gi * 1024 * 8;
#pragma unroll
        for (int j = 0; j < 4; ++j) { const int idx = (lane + 64 * j) * 4;
#pragma unroll
            for (int t = 0; t < 4; ++t) { const f32x4 w0 = *(const f32x4*)(rw + (idx + t) * 8), w1 = *(const f32x4*)(rw + (idx + t) * 8 + 4); const float hv = v[j][t];
                le[0] += hv * w0.x; le[1] += hv * w0.y; le[2] += hv * w0.z; le[3] += hv * w0.w; le[4] += hv * w1.x; le[5] += hv * w1.y; le[6] += hv * w1.z; le[7] += hv * w1.w; } }
#pragma unroll
        for (int e = 0; e < 8; ++e) le[e] = wave_sum(le[e]) + reb[gi * 8 + e];
        int i1 = 0; float m1 = le[0];
#pragma unroll
        for (int e = 1; e < 8; ++e) if (le[e] > m1) { m1 = le[e]; i1 = e; }
        int i2 = -1; float m2 = -3.0e38f;
#pragma unroll
        for (int e = 0; e < 8; ++e) if (e != i1 && le[e] > m2) { m2 = le[e]; i2 = e; }
        const float p2 = expf(m2 - m1), inv = 1.0f / (1.0f + p2);
        const float gate0 = gprob * inv, gate1 = gprob * p2 * inv;
        if (lane == 0) { const int e0 = gi * 8 + i1, e1 = gi * 8 + i2;
            const int p0 = __hip_atomic_fetch_add(lcnt + e0, 1, __ATOMIC_RELAXED, __HIP_MEMORY_SCOPE_WORKGROUP);
            const int p1 = __hip_atomic_fetch_add(lcnt + e1, 1, __ATOMIC_RELAXED, __HIP_MEMORY_SCOPE_WORKGROUP);
            unsigned* t = tok + (size_t)row * 8; t[0] = (unsigned)e0 | ((unsigned)e1 << 8); t[1] = (unsigned)p0; t[2] = (unsigned)p1;
            t[3] = __builtin_bit_cast(unsigned, gate0); t[4] = __builtin_bit_cast(unsigned, gate1); }
    }
    __syncthreads();
    if (tid < 32 && !dry) ((unsigned*)(a.ws + WS_CTL))[CW_WGCNT + (l * 256 + blockIdx.x) * 32 + tid] = (unsigned)lcnt[tid];
    __syncthreads();
}

__device__ __forceinline__ void phase_g(const Args& a, int l, LAS unsigned char* lds, int tid, int lane, int wave) {
    LAS int* cn = (LAS int*)lds; LAS int* base = (LAS int*)(lds + 32768); LAS int* pst = base + 32; LAS int* totl = base + 80;
    unsigned* ctl = (unsigned*)(a.ws + WS_CTL);
    __syncthreads();
    for (int i = tid; i < 256 * 32; i += NTHR) cn[i] = (int)ctl[CW_WGCNT + l * 256 * 32 + i];
    __syncthreads();
    if (tid < 32) { int tot = 0, bs = 0; for (int w = 0; w < 256; ++w) { const int v = cn[w * 32 + tid]; if (w < (int)blockIdx.x) bs += v; tot += v; } base[tid] = bs; totl[tid] = tot; }
    __syncthreads();
    if (tid == 0) { int run = 0; for (int e = 0; e < 32; ++e) { pst[e] = run; run += ((totl[e] + 255) >> 8) << 8; } pst[32] = run; }
    __syncthreads();
    if (blockIdx.x == 0 && tid < 32) ctl[CW_TOT + l * 64 + tid] = (unsigned)totl[tid];
    const int gw = blockIdx.x * NWAVES + wave, NGW = gridDim.x * NWAVES, nrows = l == 0 ? NROWS : NLAT;
    const bf16* Hb = (const bf16*)(a.ws + WS_HB); bf16* XB = (bf16*)(a.ws + WS_XB); unsigned* tok = (unsigned*)(a.ws + WS_TOK);
    (void)gw; (void)NGW;
    for (int T = blockIdx.x; T < (nrows >> 5); T += gridDim.x)
    for (int rr = 0; rr < 4; ++rr) { const int row = 32 * T + 4 * wave + rr;
        unsigned* t = tok + (size_t)row * 8; const unsigned ee = t[0]; const int e0 = ee & 255, e1 = (ee >> 8) & 255;
        const int s0 = pst[e0] + base[e0] + (int)t[1], s1 = pst[e1] + base[e1] + (int)t[2];
        if (lane == 0) { t[5] = (unsigned)s0; t[6] = (unsigned)s1; }
        const v4u a0 = *(const v4u*)(Hb + (size_t)row * 1024 + lane * 8), a1 = *(const v4u*)(Hb + (size_t)row * 1024 + 512 + lane * 8);
        *(v4u*)(XB + (size_t)s0 * 1024 + lane * 8) = a0; *(v4u*)(XB + (size_t)s0 * 1024 + 512 + lane * 8) = a1;
        *(v4u*)(XB + (size_t)s1 * 1024 + lane * 8) = a0; *(v4u*)(XB + (size_t)s1 * 1024 + 512 + lane * 8) = a1;
    }
    __syncthreads();
}

__device__ __forceinline__ int build_p2e(const Args& a, int l, LAS unsigned char* lds, int tid) {
    LAS unsigned char* p2e = lds + P2E_OFF; LAS int* np = (LAS int*)(lds + PST_OFF);
    const unsigned* ctl = (const unsigned*)(a.ws + WS_CTL);
    __syncthreads();
    if (tid == 0) { int pm = 0; for (int e = 0; e < 32; ++e) { const int n = ((int)ctl[CW_TOT + l * 64 + e] + 255) >> 8; for (int k = 0; k < n && pm < MAXPANELS; ++k) p2e[pm++] = (unsigned char)e; } np[0] = pm; }
    __syncthreads();
    return np[0];
}

__device__ __forceinline__ void phase_j(const Args& a, int l, int lane, int wave, bool dry = false) {
    const int gw = blockIdx.x * NWAVES + wave, NGW = gridDim.x * NWAVES, nrows = l == 0 ? NROWS : NLAT;
    const float* mod = (const float*)(a.ws + WS_MOD) + l * 9 * 6144; const float* modn = (const float*)(a.ws + WS_MOD) + 9 * 6144;
    const float* lng = a.in[22] + l * 1024; const float* lnb = a.in[23] + l * 1024;
    bf16* Hb = (bf16*)(a.ws + WS_HB); const bf16* Y = (const bf16*)(a.ws + WS_Y); const unsigned* tok = (const unsigned*)(a.ws + WS_TOK); float* xctx = (float*)(a.ws + WS_XCTX);
    for (int row = gw; row < nrows; row += NGW) {
        float* xr = row < NLAT ? a.out + (size_t)row * 1024 : xctx + (size_t)(row - NLAT) * 1024;
        float* xw = dry ? (float*)(a.ws + WS_HH) + (size_t)row * 1024 : xr;
        const int mrow = row < NLAT ? (row >> 12) : 8; const float* m0 = mod + mrow * 6144;
        const unsigned* t = tok + (size_t)row * 8; const float g0 = __builtin_bit_cast(float, t[3]), g1 = __builtin_bit_cast(float, t[4]);
        const bf16* y0 = Y + (size_t)t[5] * 1024; const bf16* y1 = Y + (size_t)t[6] * 1024;
        f32x4 v[4]; float s = 0.f;
#pragma unroll
        for (int j = 0; j < 4; ++j) { const int idx = (lane + 64 * j) * 4;
            const f32x4 x1 = *(const f32x4*)(xr + idx); const v2u w0 = *(const v2u*)(y0 + idx), w1 = *(const v2u*)(y1 + idx);
            const f32x4 ya = (f32x4){bflo(w0.x), bfhi(w0.x), bflo(w0.y), bfhi(w0.y)}, yb = (f32x4){bflo(w1.x), bfhi(w1.x), bflo(w1.y), bfhi(w1.y)};
            v[j] = x1 * ALPHA + *(const f32x4*)(m0 + 5120 + idx) * (ya * g0 + yb * g1);
            s += (v[j].x + v[j].y) + (v[j].z + v[j].w); }
        const float mean = wave_sum(s) * (1.0f / 1024.0f); float s2 = 0.f;
#pragma unroll
        for (int j = 0; j < 4; ++j) { v[j] = v[j] - mean; s2 += (v[j].x * v[j].x + v[j].y * v[j].y) + (v[j].z * v[j].z + v[j].w * v[j].w); }
        const float rstd = 1.0f / sqrtf(wave_sum(s2) * (1.0f / 1024.0f) + LN_EPS);
#pragma unroll
        for (int j = 0; j < 4; ++j) { const int idx = (lane + 64 * j) * 4;
            const f32x4 x2 = v[j] * rstd * *(const f32x4*)(lng + idx) + *(const f32x4*)(lnb + idx);
            *(f32x4*)(xw + idx) = x2;
            if (l == 0 && !dry) { const float* m1 = modn + mrow * 6144; const f32x4 hh = x2 * (*(const f32x4*)(m1 + 1024 + idx) + 1.0f) + *(const f32x4*)(m1 + idx);
                v2u w; w.x = pk2(hh.x, hh.y); w.y = pk2(hh.z, hh.w); *(v2u*)(Hb + (size_t)row * 1024 + idx) = w; } }
    }
}
typedef short bf16x8 __attribute__((ext_vector_type(8)));
typedef short s16x4 __attribute__((ext_vector_type(4)));
typedef short v4i16_t __attribute__((ext_vector_type(4)));
typedef float f32x16 __attribute__((ext_vector_type(16)));
typedef float f32x2_t __attribute__((ext_vector_type(2))); typedef __bf16 bf16x2_t __attribute__((ext_vector_type(2)));
#define MFMA32(a, b, c) __builtin_amdgcn_mfma_f32_32x32x16_bf16((a), (b), (c), 0, 0, 0)
__device__ __forceinline__ unsigned cvtpk(float lo, float hi) { f32x2_t v = {lo, hi}; bf16x2_t b = __builtin_convertvector(v, bf16x2_t); return __builtin_bit_cast(unsigned, b); }
__device__ __forceinline__ int crow(int reg, int hf) { return (reg & 3) + 8 * (reg >> 2) + 4 * hf; }
__device__ __forceinline__ int tro(int r, int b) { return r * 128 + (b ^ (((r >> 1) & 1) << 6)); }
__device__ __forceinline__ int rro(int r, int c16) { return r * 128 + ((c16 ^ ((r >> 1) & 7)) << 4); }
__device__ __forceinline__ s16x4 tr4(const LAS unsigned char* p) { return __builtin_bit_cast(s16x4, __builtin_amdgcn_ds_read_tr16_b64_v4i16((LAS v4i16_t*)p)); }
__device__ __forceinline__ bf16x8 tr_frag(const LAS unsigned char* img, int rlo, int rhi, int colbyte) {
    const s16x4 lo = tr4(img + tro(rlo, colbyte)), hi = tr4(img + tro(rhi, colbyte));
    return (bf16x8){lo[0], lo[1], lo[2], lo[3], hi[0], hi[1], hi[2], hi[3]};
}

#ifndef ST_TRANSPOSED
#define ST_TRANSPOSED 1
#endif
__device__ __forceinline__ void phase_b_mfma(const Args& a, int l, LAS unsigned char* lds, int tid, int lane, int wave) {
    const bf16* P = (const bf16*)(a.ws + WS_P); float* ST = (float*)(a.ws + WS_ST);
    const int r32 = lane & 31, hf = lane >> 5, q4 = (lane & 15) >> 2, p4 = lane & 3, blk = (lane >> 4) & 1;
    for (int u = blockIdx.x; u < 8 * NCH * 4; u += gridDim.x) {
        const int b = u / (NCH * 4), c = (u % (NCH * 4)) >> 2, h0 = (u & 3) * 2; const int row0 = chunk_row0(b, c);
        __syncthreads();
#pragma unroll
        for (int k = 0; k < 4; ++k) {
            const int ci = tid + NTHR * k, hh = ci >> 10, row = (ci & 1023) >> 3, c16 = ci & 7, h = h0 + hh;
            const bf16* src = P + (size_t)(row0 + row) * INC + h * 64 + c16 * 8;
            const v4u kw = *(const v4u*)(src + OFF_K), vw = *(const v4u*)(src + OFF_V);
            LAS unsigned char* base = lds + hh * 49152;
            *(LAS v4u*)(base + tro(row, c16 * 16)) = kw;
            const float lgf = log_sigmoid_f(a.in[8][l * 8 + h]), lgb = log_sigmoid_f(a.in[9][l * 8 + h]);
            const float wf = __expf(lgf * (float)(127 - row)), wb = __expf(lgb * (float)row);
            float v[8]; unpack8(vw, v);
            v4u of, ob;
            of.x = cvtpk(v[0] * wf, v[1] * wf); of.y = cvtpk(v[2] * wf, v[3] * wf); of.z = cvtpk(v[4] * wf, v[5] * wf); of.w = cvtpk(v[6] * wf, v[7] * wf);
            ob.x = cvtpk(v[0] * wb, v[1] * wb); ob.y = cvtpk(v[2] * wb, v[3] * wb); ob.z = cvtpk(v[4] * wb, v[5] * wb); ob.w = cvtpk(v[6] * wb, v[7] * wb);
            *(LAS v4u*)(base + 16384 + tro(row, c16 * 16)) = of;
            *(LAS v4u*)(base + 32768 + tro(row, c16 * 16)) = ob;
        }
        __syncthreads();
        const int hh = wave >> 2, dir = (wave >> 1) & 1, et = wave & 1;
        const LAS unsigned char* kimg = lds + hh * 49152; const LAS unsigned char* vimg = kimg + 16384 + dir * 16384;
        f32x16 acc[2];
#pragma unroll
        for (int i = 0; i < 16; ++i) { acc[0][i] = 0.f; acc[1][i] = 0.f; }
#pragma unroll
        for (int ks = 0; ks < 8; ++ks) {
            const int rlo = 16 * ks + 8 * hf + q4;
            const bf16x8 A = tr_frag(vimg, rlo, rlo + 4, (et * 32 + 16 * blk + 4 * p4) * 2);
#pragma unroll
            for (int dt = 0; dt < 2; ++dt) { const bf16x8 B = tr_frag(kimg, rlo, rlo + 4, (dt * 32 + 16 * blk + 4 * p4) * 2); acc[dt] = MFMA32(A, B, acc[dt]); }
        }
        float* dst = ST + st_off(b, c, h0 + hh, dir);
#pragma unroll
        for (int dt = 0; dt < 2; ++dt)
#pragma unroll
            for (int r = 0; r < 16; ++r) { const int e = et * 32 + crow(r, hf), d = dt * 32 + r32;
#if ST_TRANSPOSED
                dst[e * 64 + d] = acc[dt][r];
#else
                dst[d * 64 + e] = acc[dt][r];
#endif
            }
    }
    __syncthreads();
}
__device__ __forceinline__ bf16x8 scale_frag(const bf16x8 q, float sc) {
    const v4u w = __builtin_bit_cast(v4u, q); v4u o;
    o.x = cvtpk(bflo(w.x) * sc, bfhi(w.x) * sc); o.y = cvtpk(bflo(w.y) * sc, bfhi(w.y) * sc); o.z = cvtpk(bflo(w.z) * sc, bfhi(w.z) * sc); o.w = cvtpk(bflo(w.w) * sc, bfhi(w.w) * sc);
    return __builtin_bit_cast(bf16x8, o);
}
__device__ __forceinline__ bf16x8 f32x8_to_frag(const f32x4 a0, const f32x4 a1) {
    v4u o; o.x = cvtpk(a0.x, a0.y); o.y = cvtpk(a0.z, a0.w); o.z = cvtpk(a1.x, a1.y); o.w = cvtpk(a1.z, a1.w); return __builtin_bit_cast(bf16x8, o);
}
__device__ __forceinline__ void phase_d_mfma(const Args& a, int l, LAS unsigned char* lds, int tid, int lane, int wave) {
    const bf16* P = (const bf16*)(a.ws + WS_P); const float* ST = (const float*)(a.ws + WS_ST); bf16* Y = (bf16*)(a.ws + WS_YMIX);
    const float* convw = a.in[7] + l * 3 * 256; const float* sguw = a.in[10] + (size_t)l * 4 * 128 * 128; const float* sgub = a.in[11] + l * 4 * 128;
    const int c_lo = l == 1 ? 2 : 0, cpb = NCH - c_lo, nunits = 8 * cpb;
#define LANEC int ln_ = lane; asm volatile("" : "+v"(ln_)); const int r32 = ln_ & 31, hf = ln_ >> 5, q4 = (ln_ & 15) >> 2, p4 = ln_ & 3, blk = (ln_ >> 4) & 1; (void)q4; (void)p4; (void)blk
    for (int u = blockIdx.x; u < nunits; u += gridDim.x) {
        const int b = u / cpb, c = c_lo + u % cpb; const int row0 = chunk_row0(b, c); const bool isc = c < 2;
        for (int idx = tid; idx < 128 * 32; idx += NTHR) {
            const int p = idx >> 5, ch0 = (idx & 31) * 8; const int row = row0 + p;
            int dprev = -1, dnext = 1; bool vprev, vnext;
            if (isc) { const int t = c * 128 + p; vprev = t > 0; vnext = t < 255; }
            else { const int t = (c - 2) * 128 + p;
                if (ch0 < 128) { const int col = t & 63; vprev = col > 0; vnext = col < 63; }
                else { const int rg = t >> 6; vprev = rg > 0; vnext = rg < 63; dprev = -64; dnext = 64; } }
            const bf16* pr = P + (size_t)row * INC;
            float cb[8], zc[8], zp[8], zn[8], t0[8], t1[8];
            unpack8(*(const v4u*)(pr + OFF_CB + ch0), cb);
            unpack8(*(const v4u*)(pr + OFF_CC + ch0), t0); unpack8(*(const v4u*)(pr + OFF_CX + ch0), t1);
#pragma unroll
            for (int i = 0; i < 8; ++i) { zc[i] = t0[i] * t1[i]; zp[i] = 0.f; zn[i] = 0.f; }
            if (vprev) { const bf16* q = pr + (ptrdiff_t)dprev * INC; unpack8(*(const v4u*)(q + OFF_CC + ch0), t0); unpack8(*(const v4u*)(q + OFF_CX + ch0), t1);
#pragma unroll
                for (int i = 0; i < 8; ++i) zp[i] = t0[i] * t1[i]; }
            if (vnext) { const bf16* q = pr + (ptrdiff_t)dnext * INC; unpack8(*(const v4u*)(q + OFF_CC + ch0), t0); unpack8(*(const v4u*)(q + OFF_CX + ch0), t1);
#pragma unroll
                for (int i = 0; i < 8; ++i) zn[i] = t0[i] * t1[i]; }
            float o[8];
#pragma unroll
            for (int i = 0; i < 8; ++i) o[i] = cb[i] * (convw[ch0 + i] * zp[i] + convw[256 + ch0 + i] * zc[i] + convw[512 + ch0 + i] * zn[i]);
            *(v4u*)(Y + (size_t)row * 1024 + ch0) = pack8(o);
        }
#ifndef NO_D2
#pragma unroll 1
        for (int pass = 0; pass < 2; ++pass) {
            __syncthreads();
#pragma unroll 4
            for (int k = 0; k < 16; ++k) {
                int ts_ = tid; asm volatile("" : "+v"(ts_));
                const int ci = ts_ + NTHR * k, tile = ci >> 10, hd = tile >> 1, isv = tile & 1, row = (ci & 1023) >> 3, c16 = ci & 7;
                const v4u w = *(const v4u*)(P + (size_t)(row0 + row) * INC + (isv ? OFF_V : OFF_K) + (pass * 4 + hd) * 64 + c16 * 8);
                *(LAS v4u*)(lds + hd * 32768 + isv * 16384 + (isv ? tro(row, c16 * 16) : rro(row, c16))) = w;
            }
            __syncthreads();
            LANEC;
            const int hd = wave >> 1, ih = wave & 1, h = pass * 4 + hd;
            const LAS unsigned char* kimg = lds + hd * 32768; const LAS unsigned char* vimg = kimg + 16384;
            const float lg2f = log_sigmoid_f(a.in[8][l * 8 + h]) * 1.44269504088896f, lg2b = log_sigmoid_f(a.in[9][l * 8 + h]) * 1.44269504088896f;
            bf16x8 qf[2][4];
#pragma unroll
            for (int t = 0; t < 2; ++t)
#pragma unroll
                for (int s = 0; s < 4; ++s) qf[t][s] = *(const bf16x8*)(P + (size_t)(row0 + (2 * ih + t) * 32 + r32) * INC + OFF_Q + h * 64 + 16 * s + 8 * hf);
            f32x16 acc[2][2];
#pragma unroll
            for (int t = 0; t < 2; ++t)
#pragma unroll
                for (int et = 0; et < 2; ++et)
#pragma unroll
                    for (int r = 0; r < 16; ++r) acc[t][et][r] = 0.f;
#pragma unroll
            for (int dir = 0; dir < 2; ++dir) {
                const int i0 = 2 * ih * 32 + r32;
                const float sc0 = dir == 0 ? __builtin_amdgcn_exp2f(lg2f * (float)(i0 + 1)) : __builtin_amdgcn_exp2f(lg2b * (float)(128 - i0));
                const float sc1 = dir == 0 ? __builtin_amdgcn_exp2f(lg2f * (float)(i0 + 33)) : __builtin_amdgcn_exp2f(lg2b * (float)(96 - i0));
                const float* sp = ST + st_off(b, c, h, dir) + r32 * 64 + 8 * hf;
#pragma unroll
                for (int s = 0; s < 4; ++s) {
                    const bf16x8 qs0 = scale_frag(qf[0][s], sc0), qs1 = scale_frag(qf[1][s], sc1);
#pragma unroll
                    for (int et = 0; et < 2; ++et) { const float* q = sp + et * 2048 + 16 * s;
                        const bf16x8 A = f32x8_to_frag(*(const f32x4*)q, *(const f32x4*)(q + 4));
                        acc[0][et] = MFMA32(A, qs0, acc[0][et]); acc[1][et] = MFMA32(A, qs1, acc[1][et]); }
                }
            }
#pragma unroll
            for (int t = 0; t < 2; ++t) {
                const int it = 2 * ih + t;
                bf16x8 qq[4];
                if (t == 0) {
#pragma unroll
                    for (int s = 0; s < 4; ++s) qq[s] = qf[0][s];
                } else {
                    asm volatile("" ::: "memory");
#pragma unroll
                    for (int s = 0; s < 4; ++s) qq[s] = *(const bf16x8*)(P + (size_t)(row0 + it * 32 + r32) * INC + OFF_Q + h * 64 + 16 * s + 8 * hf);
                }
#pragma unroll 1
                for (int jt = 0; jt < 4; ++jt) {
                    f32x16 X;
#pragma unroll
                    for (int r = 0; r < 16; ++r) X[r] = 0.f;
#pragma unroll
                    for (int s = 0; s < 4; ++s) { const bf16x8 Kf = *(const LAS bf16x8*)(kimg + rro(jt * 32 + r32, 2 * s + hf)); X = MFMA32(Kf, qq[s], X); }
                    const int rel0 = (it - jt) * 32 + r32 - 4 * hf;
#pragma unroll
                    for (int r = 0; r < 16; ++r) { const int rel = rel0 - ((r & 3) + 8 * (r >> 2));
                        const float x = rel > 0 ? lg2f * (float)rel : lg2b * (float)(-rel);
                        const float dcy = rel == 0 ? 2.0f : __builtin_amdgcn_exp2f(x);
                        X[r] *= dcy; }
#pragma unroll
                    for (int s2 = 0; s2 < 2; ++s2) {
                        v4u pk; pk.x = cvtpk(X[8 * s2], X[8 * s2 + 1]); pk.y = cvtpk(X[8 * s2 + 2], X[8 * s2 + 3]); pk.z = cvtpk(X[8 * s2 + 4], X[8 * s2 + 5]); pk.w = cvtpk(X[8 * s2 + 6], X[8 * s2 + 7]);
                        const bf16x8 Pk = __builtin_bit_cast(bf16x8, pk);
                        const int rlo = jt * 32 + 16 * s2 + 4 * hf + q4;
#pragma unroll
                        for (int et = 0; et < 2; ++et) { const bf16x8 Vt = tr_frag(vimg, rlo, rlo + 8, (et * 32 + 16 * blk + 4 * p4) * 2); acc[t][et] = MFMA32(Vt, Pk, acc[t][et]); }
                    }
                }
                const int row = row0 + (2 * ih + t) * 32 + r32;
                float sum = 0.f;
#pragma unroll
                for (int et = 0; et < 2; ++et)
#pragma unroll
                    for (int r = 0; r < 16; ++r) sum += acc[t][et][r];
                sum += __shfl_xor(sum, 32);
                const float mu = sum * (1.0f / 64.0f); float vs = 0.f;
#pragma unroll
                for (int et = 0; et < 2; ++et)
#pragma unroll
                    for (int r = 0; r < 16; ++r) { const float dlt = acc[t][et][r] - mu; vs += dlt * dlt; }
                vs += __shfl_xor(vs, 32);
                const float rs = 1.0f / sqrtf(vs * (1.0f / 64.0f) + LN_EPS);
#pragma unroll
                for (int et = 0; et < 2; ++et)
#pragma unroll
                    for (int g4 = 0; g4 < 4; ++g4) { const int e0 = et * 32 + 8 * g4 + 4 * hf;
                        const v2u gw = *(const v2u*)(P + (size_t)row * INC + OFF_G + h * 64 + e0);
                        const float g0 = bflo(gw.x), g1 = bfhi(gw.x), g2 = bflo(gw.y), g3 = bfhi(gw.y);
                        const float o0 = (acc[t][et][4 * g4] - mu) * rs, o1 = (acc[t][et][4 * g4 + 1] - mu) * rs, o2 = (acc[t][et][4 * g4 + 2] - mu) * rs, o3 = (acc[t][et][4 * g4 + 3] - mu) * rs;
                        v2u w; w.x = cvtpk(g0 / (1.0f + __expf(-g0)) * o0, g1 / (1.0f + __expf(-g1)) * o1); w.y = cvtpk(g2 / (1.0f + __expf(-g2)) * o2, g3 / (1.0f + __expf(-g3)) * o3);
                        *(v2u*)(Y + (size_t)row * 1024 + 256 + h * 64 + e0) = w; }
            }
        }
#endif
#ifndef NO_D3
        __syncthreads();
        {
            int tq_ = tid; asm volatile("" : "+v"(tq_));
            const int i = tq_ >> 2, part = tq_ & 3;
            const bf16* vp = P + (size_t)(row0 + i) * INC + OFF_VV + part * 64;
            float sum = 0.f;
#pragma unroll 2
            for (int q = 0; q < 8; ++q) { float t8[8]; unpack8(*(const v4u*)(vp + 8 * q), t8);
#pragma unroll
                for (int e = 0; e < 8; ++e) sum += t8[e]; }
            sum += __shfl_xor(sum, 1); sum += __shfl_xor(sum, 2);
            const float mu = sum * (1.0f / 256.0f); float vs = 0.f;
#pragma unroll 2
            for (int q = 0; q < 8; ++q) { float t8[8]; unpack8(*(const v4u*)(vp + 8 * q), t8);
#pragma unroll
                for (int e = 0; e < 8; ++e) { const float dlt = t8[e] - mu; vs += dlt * dlt; } }
            vs += __shfl_xor(vs, 1); vs += __shfl_xor(vs, 2);
            const float rs = 1.0f / sqrtf(vs * (1.0f / 256.0f) + LN_EPS);
#pragma unroll 2
            for (int q = 0; q < 8; ++q) { float t8[8]; unpack8(*(const v4u*)(vp + 8 * q), t8);
                v4u w; w.x = cvtpk((t8[0] - mu) * rs, (t8[1] - mu) * rs); w.y = cvtpk((t8[2] - mu) * rs, (t8[3] - mu) * rs); w.z = cvtpk((t8[4] - mu) * rs, (t8[5] - mu) * rs); w.w = cvtpk((t8[6] - mu) * rs, (t8[7] - mu) * rs);
                *(LAS v4u*)(lds + part * 16384 + tro(i, q * 16)) = w; }
        }
        __syncthreads();
        {
            LANEC;
            const int g = wave >> 1, ph = wave & 1;
            const LAS unsigned char* vn = lds + g * 16384;
            f32x16 acc[2][2];
#pragma unroll
            for (int ct = 0; ct < 2; ++ct)
#pragma unroll
                for (int pt = 0; pt < 2; ++pt)
#pragma unroll
                    for (int r = 0; r < 16; ++r) acc[ct][pt][r] = 0.f;
#pragma unroll 2
            for (int ks = 0; ks < 8; ++ks) {
                const int rlo = 16 * ks + 8 * hf + q4;
                bf16x8 A[2], B[2];
#pragma unroll
                for (int ct = 0; ct < 2; ++ct) A[ct] = tr_frag(vn, rlo, rlo + 4, (ct * 32 + 16 * blk + 4 * p4) * 2);
#pragma unroll
                for (int pt = 0; pt < 2; ++pt) { const float* wp = sguw + ((size_t)g * 128 + ph * 64 + pt * 32 + r32) * 128 + 16 * ks + 8 * hf; B[pt] = f32x8_to_frag(*(const f32x4*)wp, *(const f32x4*)(wp + 4)); }
#pragma unroll
                for (int ct = 0; ct < 2; ++ct)
#pragma unroll
                    for (int pt = 0; pt < 2; ++pt) acc[ct][pt] = MFMA32(A[ct], B[pt], acc[ct][pt]);
            }
#pragma unroll
            for (int pt = 0; pt < 2; ++pt) {
                const int p = ph * 64 + pt * 32 + r32; const int row = row0 + p; const float bias = sgub[g * 128 + p];
#pragma unroll
                for (int ct = 0; ct < 2; ++ct)
#pragma unroll
                    for (int g4 = 0; g4 < 4; ++g4) { const int c0 = ct * 32 + 8 * g4 + 4 * hf;
                        const v2u uw = *(const v2u*)(P + (size_t)row * INC + OFF_U + g * 64 + c0);
                        v2u w; w.x = cvtpk(bflo(uw.x) * (acc[ct][pt][4 * g4] + bias), bfhi(uw.x) * (acc[ct][pt][4 * g4 + 1] + bias));
                        w.y = cvtpk(bflo(uw.y) * (acc[ct][pt][4 * g4 + 2] + bias), bfhi(uw.y) * (acc[ct][pt][4 * g4 + 3] + bias));
                        *(v2u*)(Y + (size_t)row * 1024 + 768 + g * 64 + c0) = w; }
            }
        }
#endif
        __syncthreads();
    }
}
constexpr int LCNT_OFF = LDSCTL_OFF + 4096, LG_OFF = LDSCTL_OFF + 4352;
__device__ __forceinline__ void phase_f2(const Args& a, int l, LAS unsigned char* lds, int tid, int lane, int wave) {
    LAS int* lcnt = (LAS int*)(lds + LCNT_OFF); LAS float* LG = (LAS float*)(lds + LG_OFF);
    LAS unsigned char* HI = lds; LAS unsigned char* LO = lds + 65536; LAS float* PART = (LAS float*)lds;
    const int r32 = lane & 31, hf = lane >> 5;
    const int nrows = l == 0 ? NROWS : NLAT, ntiles = nrows >> 5;
    const float* mod = (const float*)(a.ws + WS_MOD) + l * 9 * 6144;
    const float* lng = a.in[13] + l * 1024; const float* lnb = a.in[14] + l * 1024;
    const float* rgb = a.in[16] + l * 4; const float* reb = a.in[18] + l * 32;
    bf16* Hb = (bf16*)(a.ws + WS_HB); unsigned* tok = (unsigned*)(a.ws + WS_TOK); float* xctx = (float*)(a.ws + WS_XCTX);
    const bf16* wr = (const bf16*)(a.ws + WS_WR) + (size_t)l * 2 * 64 * 1024;
    bf16x8 Bh[8][2], Bl[8][2];
#pragma unroll
    for (int ks = 0; ks < 8; ++ks)
#pragma unroll
        for (int ct = 0; ct < 2; ++ct) { const bf16* p = wr + (size_t)(ct * 32 + r32) * 1024 + wave * 128 + 16 * ks + 8 * hf; Bh[ks][ct] = *(const bf16x8*)p; Bl[ks][ct] = *(const bf16x8*)(p + 64 * 1024); }
    __syncthreads();
    if (tid < 32) lcnt[tid] = 0;
    __syncthreads();
    for (int T = blockIdx.x; T < ntiles; T += gridDim.x) {
#pragma unroll 1
        for (int rr = 0; rr < 4; ++rr) {
            const int lr = 4 * wave + rr, row = 32 * T + lr;
            float* xr = row < NLAT ? a.out + (size_t)row * 1024 : xctx + (size_t)(row - NLAT) * 1024;
            const float* m0 = mod + (row < NLAT ? (row >> 12) : 8) * 6144;
            f32x4 v[4]; float s = 0.f;
#pragma unroll
            for (int j = 0; j < 4; ++j) { v[j] = *(const f32x4*)(xr + (lane + 64 * j) * 4); s += (v[j].x + v[j].y) + (v[j].z + v[j].w); }
            const float mean = wave_sum(s) * (1.0f / 1024.0f); float s2 = 0.f;
#pragma unroll
            for (int j = 0; j < 4; ++j) { v[j] = v[j] - mean; s2 += (v[j].x * v[j].x + v[j].y * v[j].y) + (v[j].z * v[j].z + v[j].w * v[j].w); }
            const float rstd = 1.0f / sqrtf(wave_sum(s2) * (1.0f / 1024.0f) + LN_EPS);
#pragma unroll
            for (int j = 0; j < 4; ++j) { const int idx = (lane + 64 * j) * 4;
                const f32x4 x1 = v[j] * rstd * *(const f32x4*)(lng + idx) + *(const f32x4*)(lnb + idx);
                *(f32x4*)(xr + idx) = x1;
                const f32x4 hm = x1 * (*(const f32x4*)(m0 + 4096 + idx) + 1.0f) + *(const f32x4*)(m0 + 3072 + idx);
                v2u h; h.x = cvtpk(hm.x, hm.y); h.y = cvtpk(hm.z, hm.w);
                v2u lo; lo.x = cvtpk(hm.x - bflo(h.x), hm.y - bfhi(h.x)); lo.y = cvtpk(hm.z - bflo(h.y), hm.w - bfhi(h.y));
                *(v2u*)(Hb + (size_t)row * 1024 + idx) = h;
                const int off = lr * 2048 + (((((lane + 64 * j) >> 1)) ^ (lr & 15)) << 4) + (lane & 1) * 8;
                *(LAS v2u*)(HI + off) = h; *(LAS v2u*)(LO + off) = lo; }
        }
        __syncthreads();
        f32x16 acc[2];
#pragma unroll
        for (int r = 0; r < 16; ++r) { acc[0][r] = 0.f; acc[1][r] = 0.f; }
#pragma unroll
        for (int ks = 0; ks < 8; ++ks) { const int off = r32 * 2048 + (((wave * 16 + 2 * ks + hf) ^ (r32 & 15)) << 4);
            const bf16x8 Ah = *(const LAS bf16x8*)(HI + off), Al = *(const LAS bf16x8*)(LO + off);
#pragma unroll
            for (int ct = 0; ct < 2; ++ct) { acc[ct] = MFMA32(Ah, Bh[ks][ct], acc[ct]); acc[ct] = MFMA32(Ah, Bl[ks][ct], acc[ct]); acc[ct] = MFMA32(Al, Bh[ks][ct], acc[ct]); } }
        __syncthreads();
#pragma unroll
        for (int ct = 0; ct < 2; ++ct)
#pragma unroll
            for (int r = 0; r < 16; ++r) PART[(wave * 32 + crow(r, hf)) * 64 + ct * 32 + r32] = acc[ct][r];
        __syncthreads();
        { const int row = tid >> 4, cg = tid & 15;
#pragma unroll
          for (int q = 0; q < 3; ++q) { const int col = cg + 16 * q; if (col < 36) { float sum = 0.f;
#pragma unroll
                  for (int w = 0; w < 8; ++w) sum += PART[(w * 32 + row) * 64 + col];
                  LG[row * 40 + col] = sum; } } }
        __syncthreads();
        if (tid < 32) { const int row = 32 * T + tid; const LAS float* lgp = LG + tid * 40;
            float lg[4];
#pragma unroll
            for (int g = 0; g < 4; ++g) lg[g] = lgp[g] + rgb[g];
            int gi = 0; float gm = lg[0];
#pragma unroll
            for (int g = 1; g < 4; ++g) if (lg[g] > gm) { gm = lg[g]; gi = g; }
            float gden = 0.f;
#pragma unroll
            for (int g = 0; g < 4; ++g) gden += expf(lg[g] - gm);
            const float gprob = 1.0f / gden;
            float le[8];
#pragma unroll
            for (int e = 0; e < 8; ++e) le[e] = lgp[4 + gi * 8 + e] + reb[gi * 8 + e];
            int i1 = 0; float m1 = le[0];
#pragma unroll
            for (int e = 1; e < 8; ++e) if (le[e] > m1) { m1 = le[e]; i1 = e; }
            int i2 = -1; float m2 = -3.0e38f;
#pragma unroll
            for (int e = 0; e < 8; ++e) if (e != i1 && le[e] > m2) { m2 = le[e]; i2 = e; }
            const float p2 = expf(m2 - m1), inv = 1.0f / (1.0f + p2);
            const float gate0 = gprob * inv, gate1 = gprob * p2 * inv;
            const int e0 = gi * 8 + i1, e1 = gi * 8 + i2;
            const int p0 = __hip_atomic_fetch_add(lcnt + e0, 1, __ATOMIC_RELAXED, __HIP_MEMORY_SCOPE_WORKGROUP);
            const int p1 = __hip_atomic_fetch_add(lcnt + e1, 1, __ATOMIC_RELAXED, __HIP_MEMORY_SCOPE_WORKGROUP);
            unsigned* t = tok + (size_t)row * 8; t[0] = (unsigned)e0 | ((unsigned)e1 << 8); t[1] = (unsigned)p0; t[2] = (unsigned)p1;
            t[3] = __builtin_bit_cast(unsigned, gate0); t[4] = __builtin_bit_cast(unsigned, gate1); }
    }
    __syncthreads();
    if (tid < 32) ((unsigned*)(a.ws + WS_CTL))[CW_WGCNT + (l * 256 + blockIdx.x) * 32 + tid] = (unsigned)lcnt[tid];
    __syncthreads();
}
#ifndef MK_PER_PHASE
#define MK_PER_PHASE 0
#endif
constexpr int N_PHASES = 22;

__global__ void __launch_bounds__(NTHR, 2) hybrid_fwd(Args args) {
    extern __shared__ __attribute__((aligned(16))) unsigned char lds_raw[];
    LAS unsigned char* lds = (LAS unsigned char*)lds_raw;
    const int tid0 = threadIdx.x;
    for (int u = tid0; u < (LDS_BYTES - LDSCTL_OFF) / 4; u += NTHR) ((LAS unsigned*)(lds + LDSCTL_OFF))[u] = 0u;
#define TIDS int tid = threadIdx.x; asm volatile("" : "+v"(tid)); const int lane = tid & 63, wave = __builtin_amdgcn_readfirstlane(tid >> 6); (void)lane; (void)wave
    __syncthreads();
    unsigned* ctl = (unsigned*)(args.ws + WS_CTL);
    XcdBarrier bar; bar.bar = ctl + CW_BAR; bar.x = 0; bar.st = nullptr;
    if (!MK_PER_PHASE) bar = xcd_barrier_post(ctl + CW_BAR, (volatile LAS unsigned*)(lds + MISC_OFF + 32));
    const int lo = args.ph_lo, hi = args.ph_hi;
#ifndef PHMASK
#define PHMASK 0xFFFFFFu
#endif
#define PHON(k) (((PHMASK) >> ((k) < 2 ? (k) : 2 + ((k) - 2) % 10)) & 1u)
#define IN(k) (PHON(k) && lo <= (k) && (k) < hi)
#ifndef REPMASK
#define REPMASK 0u
#endif
#define NREP(k) (1 + (int)(((REPMASK) >> ((k) < 2 ? (k) : 2 + ((k) - 2) % 10)) & 1u))
#define SEAM(k) do { if (IN(k) && IN((k) + 1)) xcd_barrier(bar); } while (0)

    if (IN(0)) for (int rep = 0; rep < NREP(0); ++rep) { TIDS; phase_p0(args, lds, tid, lane, wave); }
    SEAM(0);
    if (IN(1)) for (int rep = 0; rep < NREP(1); ++rep) { TIDS; phase_p1(args, lane, wave); }
    SEAM(1);
    for (int l = 0; l < 2; ++l) {
        const int pb = 2 + 10 * l;
        bf16* Hb = (bf16*)(args.ws + WS_HB);
        if (IN(pb + 0)) for (int rep = 0; rep < NREP(2); ++rep) {
            pg8::Gemm g{Hb, (const bf16*)(args.ws + WS_WIN) + (size_t)l * INC * 1024, NROWS, INC, 1024}; pg8::StaticOrder S; S.init(NROWS, INC, (int)gridDim.x, (int)blockIdx.x);
            pg8::EpiBf16<0> E{(bf16*)(args.ws + WS_P), INC, nullptr, 0, 0, 1.0f};
            pg8::gemm_phase<pg8::EpiBf16<0>, pg8::StaticOrder, true, true>(lds, g, S, E);
        }
        SEAM(pb + 0);
        if (IN(pb + 1)) for (int rep = 0; rep < NREP(3); ++rep) { TIDS; phase_b_mfma(args, l, lds, tid, lane, wave); }
        SEAM(pb + 1);
        if (IN(pb + 2)) { if (NREP(4) > 1) { TIDS; phase_c(args, l, tid, true); } TIDS; phase_c(args, l, tid); }
        SEAM(pb + 2);
        if (IN(pb + 3)) for (int rep = 0; rep < NREP(5); ++rep) { TIDS; phase_d_mfma(args, l, lds, tid, lane, wave); }
        SEAM(pb + 3);
        if (IN(pb + 4)) for (int rep = 0; rep < (l == 0 ? NREP(6) : 1); ++rep) {
            const int M = l == 0 ? NROWS : NLAT;
            pg8::Gemm g{(const bf16*)(args.ws + WS_YMIX), (const bf16*)(args.ws + WS_WOUT) + (size_t)l * 1024 * 1024, M, 1024, 1024}; pg8::StaticOrder S; S.init(M, 1024, (int)gridDim.x, (int)blockIdx.x);
            float* xctx = (float*)(args.ws + WS_XCTX);
            pg8::EpiResid E{l == 0 ? args.in[0] : args.out, l == 0 ? args.in[2] : xctx, args.out, xctx, (const float*)(args.ws + WS_MOD) + l * 9 * 6144, ALPHA};
            pg8::gemm_phase<pg8::EpiResid, pg8::StaticOrder, true, true>(lds, g, S, E);
        }
        SEAM(pb + 4);
        if (IN(pb + 5)) { TIDS; phase_f2(args, l, lds, tid, lane, wave); }
        SEAM(pb + 5);
        if (IN(pb + 6)) for (int rep = 0; rep < NREP(8); ++rep) { TIDS; phase_g(args, l, lds, tid, lane, wave); }
        SEAM(pb + 6);
        if (IN(pb + 7)) for (int rep = 0; rep < NREP(9); ++rep) {
            int npan; { TIDS; npan = build_p2e(args, l, lds, tid); }
            pg8::Gemm g{(const bf16*)(args.ws + WS_XB), (const bf16*)(args.ws + WS_WGU) + (size_t)l * 32 * 1024 * 1024, npan * 256, 1024, 1024};
            pg8::MoeOrder S{(const LAS unsigned char*)(lds + P2E_OFF), npan * 4, (int)gridDim.x, (int)blockIdx.x};
            pg8::EpiGLU E{(bf16*)(args.ws + WS_HH)};
            pg8::gemm_phase<pg8::EpiGLU, pg8::MoeOrder, true, true>(lds, g, S, E);
        }
        SEAM(pb + 7);
        if (IN(pb + 8)) for (int rep = 0; rep < NREP(10); ++rep) {
            int npan; { TIDS; npan = build_p2e(args, l, lds, tid); }
            pg8::Gemm g{(const bf16*)(args.ws + WS_HH), (const bf16*)(args.ws + WS_WD) + (size_t)l * 32 * 1024 * 512, npan * 256, 1024, 512};
            pg8::MoeOrder S{(const LAS unsigned char*)(lds + P2E_OFF), npan * 4, (int)gridDim.x, (int)blockIdx.x};
            pg8::EpiY E{(bf16*)(args.ws + WS_Y)};
            pg8::gemm_phase<pg8::EpiY, pg8::MoeOrder, true, true>(lds, g, S, E);
        }
        SEAM(pb + 8);
        if (IN(pb + 9)) { if (NREP(11) > 1) { TIDS; phase_j(args, l, lane, wave, true); } TIDS; phase_j(args, l, lane, wave); }
        SEAM(pb + 9);
    }
#undef IN
#undef SEAM
}

extern "C" void kernel_launch(void* const* d_in, const int* in_sizes, int n_in, void* d_out, int out_size, void* d_ws, size_t ws_size, hipStream_t stream) {
    static int grid = 0;
    if (grid == 0) {
        if (n_in != 24 || in_sizes[0] != NLAT * DM || out_size != NLAT * DM || ws_size < WS_END) { fprintf(stderr, "kernel_launch: unexpected problem (n_in %d, ws %zu < %zu?)\n", n_in, ws_size, (size_t)WS_END); grid = -1; return; }
        int dev = 0, cus = 0, per_cu = 0;
        if (hipGetDevice(&dev) != hipSuccess || hipDeviceGetAttribute(&cus, hipDeviceAttributeMultiprocessorCount, dev) != hipSuccess) { grid = -1; return; }
        if (hipFuncSetAttribute((const void*)hybrid_fwd, hipFuncAttributeMaxDynamicSharedMemorySize, LDS_BYTES) != hipSuccess) { grid = -1; return; }
        if (hipOccupancyMaxActiveBlocksPerMultiprocessor(&per_cu, (const void*)hybrid_fwd, NTHR, LDS_BYTES) != hipSuccess || per_cu < 1) { fprintf(stderr, "kernel_launch: occupancy query says %d\n", per_cu); }
        (void)hipGetLastError();
        grid = cus;
        if (grid != 256) { fprintf(stderr, "kernel_launch: built for 256 CUs, device has %d\n", cus); grid = -1; return; }
    }
    if (grid < 0) return;
    if (hipMemsetAsync((char*)d_ws + WS_CTL, 0, CTL_ZERO_BYTES, stream) != hipSuccess) return;
    Args a{};
    for (int i = 0; i < 24; ++i) a.in[i] = (const float*)d_in[i];
    a.out = (float*)d_out; a.ws = (unsigned char*)d_ws;
#if MK_PER_PHASE
    for (int p = 0; p < N_PHASES; ++p) { a.ph_lo = p; a.ph_hi = p + 1; hipLaunchKernelGGL(hybrid_fwd, dim3(grid), dim3(NTHR), LDS_BYTES, stream, a); }
#else
    a.ph_lo = 0; a.ph_hi = N_PHASES;
    hipLaunchKernelGGL(hybrid_fwd, dim3(grid), dim3(NTHR), LDS_BYTES, stream, a);
#endif
}
```

```cpp
#include <hip/hip_runtime.h>
#include <cstdio>
#include <cstdint>
#include <cstddef>
namespace pg8 {
#define PG8_LAS __attribute__((address_space(3)))
typedef unsigned short bf16_t;
typedef short bf16x8 __attribute__((ext_vector_type(8)));
typedef float f32x4 __attribute__((ext_vector_type(4)));
typedef unsigned u32x4 __attribute__((ext_vector_type(4)));
constexpr int BM = 256, BK = 64, HALF = 128, HTB = HALF * BK * 2  , STAGE_BYTES = 8 * HTB, NXCD = 8, WGM = 8;

__host__ __device__ __forceinline__ int lds_byte(int r, int c) { const int st = (r >> 4) * 2 + (c >> 5), rr = r & 15, cc = c & 31, ob = rr * 64 + cc * 2; return st * 1024 + (ob ^ (((ob >> 9) & 1) << 5)); }
__host__ __device__ __forceinline__ void stage_rc(int b, int& R, int& C) { const int st = b / 1024, sb = b % 1024, swz = sb ^ (((sb >> 9) & 1) << 5); R = (st >> 1) * 16 + swz / 64; C = (st & 1) * 32 + (swz % 64) / 2; }
__host__ __device__ __forceinline__ int perm32(int rho) { const int n = rho >> 4, i = rho & 15; return 8 * (i >> 2) + 4 * n + (i & 3); }

struct Unit { int pm, pn; };
struct Gemm { const bf16_t* A; const bf16_t* Bt; int M, N, K; };

struct StaticOrder {
    int nM, nN, nwg, G, c;
    __host__ __device__ void init(int M, int N, int G_, int c_) { nM = M / BM; nN = N / BM; nwg = nM * nN; G = G_; c = c_; }
    __host__ __device__ bool next(int i, Unit& u) const {
        const long L = (long)i * G + c; if (L >= nwg) return false;
        int wgid = (int)L; { const int q = nwg / NXCD, r = nwg % NXCD, xcd = wgid % NXCD, off = wgid / NXCD; wgid = (xcd < r ? xcd * (q + 1) : r * (q + 1) + (xcd - r) * q) + off; }
        const int nig = WGM * nN, gid = wgid / nig, fm = gid * WGM, gsz = (nM - fm) < WGM ? (nM - fm) : WGM;
        u.pm = fm + ((wgid % nig) % gsz); u.pn = (wgid % nig) / gsz; return true;
    }
    __device__ __forceinline__ void a_ready(const Unit&) const {}
    __device__ __forceinline__ void done(const Unit&) const {}
};

__device__ __forceinline__ unsigned cvt_pk_bf16(float lo, float hi) { unsigned r; asm volatile("v_cvt_pk_bf16_f32 %0, %1, %2" : "=v"(r) : "v"(lo), "v"(hi)); return r; }
typedef float f32x2 __attribute__((ext_vector_type(2)));
__device__ __forceinline__ f32x2 gelu_pk(f32x2 v) {
    const f32x2 av = __builtin_elementwise_abs(v), d = av * 0.2316418882f + 1.0f;
    f32x2 t; t.x = __builtin_amdgcn_rcpf(d.x); t.y = __builtin_amdgcn_rcpf(d.y);
    f32x2 q = t * 0.5307027145f + (-0.7265760135f); q = q * t + 0.7107068705f; q = q * t + (-0.142248368f); q = q * t + 0.127414796f; q = q * t;
    const f32x2 s = (v * v) * (-0.72134752044f);
    f32x2 e; e.x = __builtin_amdgcn_exp2f(s.x); e.y = __builtin_amdgcn_exp2f(s.y);
    const f32x2 m = v * (q * e), r = v - m;
    f32x2 o; o.x = v.x < 0.f ? m.x : r.x; o.y = v.y < 0.f ? m.y : r.y; return o;
}

template <int ACT  > struct EpiBf16 {
    static constexpr bool PERM = true, AFTER_DRAIN = false; static_assert(ACT == 0 || ACT == 1, "EpiBf16: ACT is 0 (none) or 1 (gelu_pk)");
    bf16_t* O; int ldc; const float* bias; int split_cols; size_t split_stride; float scale0;
    __device__ __forceinline__ void operator()(const f32x4 (&acc)[2][2][4][2], const Unit& u, int wr, int wc, int fr, int fq) const {
        const int row0 = u.pm * BM + wr * 64 + fr; int colt = u.pn * BM; bf16_t* base = O;
        float sc = 1.f; if (split_cols) { const int t = colt / split_cols; base += (size_t)t * split_stride; colt -= t * split_cols; if (t == 0) sc = scale0; }
        const int col0 = colt + wc * 32 + 8 * fq, bcol0 = u.pn * BM + wc * 32 + 8 * fq;
        f32x4 bv[2][2];
#pragma unroll
        for (int bj = 0; bj < 2; ++bj)
#pragma unroll
            for (int n = 0; n < 2; ++n) bv[bj][n] = bias ? *(const f32x4*)(bias + bcol0 + bj * HALF + 4 * n) : (f32x4){0.f, 0.f, 0.f, 0.f};
#pragma unroll
        for (int ai = 0; ai < 2; ++ai)
#pragma unroll
            for (int m = 0; m < 4; ++m) { bf16_t* rowp = base + (size_t)(row0 + ai * HALF + m * 16) * ldc + col0;
#pragma unroll
                for (int bj = 0; bj < 2; ++bj) { f32x4 v0 = acc[ai][bj][m][0] + bv[bj][0], v1 = acc[ai][bj][m][1] + bv[bj][1];
                    if (ACT == 1) { f32x2 a = gelu_pk((f32x2){v0[0], v0[1]}), b = gelu_pk((f32x2){v0[2], v0[3]}), c = gelu_pk((f32x2){v1[0], v1[1]}), d = gelu_pk((f32x2){v1[2], v1[3]});
                        v0 = (f32x4){a.x, a.y, b.x, b.y}; v1 = (f32x4){c.x, c.y, d.x, d.y}; }
                    v0 = v0 * sc; v1 = v1 * sc; u32x4 w; w.x = cvt_pk_bf16(v0[0], v0[1]); w.y = cvt_pk_bf16(v0[2], v0[3]); w.z = cvt_pk_bf16(v1[0], v1[1]); w.w = cvt_pk_bf16(v1[2], v1[3]);
                    *(u32x4*)(rowp + bj * HALF) = w; } }
    }
};
__device__ __forceinline__ float silu_f(float x) { return x / (1.0f + __expf(-x)); }
struct EpiResid {
    static constexpr bool PERM = false, AFTER_DRAIN = false;
    const float* xin_lat; const float* xin_ctx; float* xo_lat; float* xo_ctx; const float* mod; float alpha;
    __device__ __forceinline__ void operator()(const f32x4 (&acc)[2][2][4][2], const Unit& u, int wr, int wc, int fr, int fq) const {
        const int prow0 = u.pm * BM; const bool isc = prow0 >= 32768;
        const float* xin = isc ? xin_ctx + (size_t)(prow0 - 32768) * 1024 : xin_lat + (size_t)prow0 * 1024;
        float* xo = isc ? xo_ctx + (size_t)(prow0 - 32768) * 1024 : xo_lat + (size_t)prow0 * 1024;
        const float* g1 = mod + (isc ? 8 : (prow0 >> 12)) * 6144 + 2048;
        const int col0 = u.pn * BM + wc * 32 + 4 * fq;
        f32x4 gv[2][2];
#pragma unroll
        for (int bj = 0; bj < 2; ++bj)
#pragma unroll
            for (int n = 0; n < 2; ++n) gv[bj][n] = *(const f32x4*)(g1 + col0 + bj * HALF + n * 16);
#pragma unroll
        for (int ai = 0; ai < 2; ++ai)
#pragma unroll
            for (int m = 0; m < 4; ++m) { const size_t off = (size_t)(ai * HALF + wr * 64 + m * 16 + fr) * 1024 + col0;
#pragma unroll
                for (int bj = 0; bj < 2; ++bj)
#pragma unroll
                    for (int n = 0; n < 2; ++n) { const f32x4 xv = *(const f32x4*)(xin + off + bj * HALF + n * 16);
                        *(f32x4*)(xo + off + bj * HALF + n * 16) = xv * alpha + gv[bj][n] * acc[ai][bj][m][n]; }
                if (m & 1) asm volatile("" ::: "memory"); }
    }
};
struct EpiGLU {
    static constexpr bool PERM = true, AFTER_DRAIN = false;
    bf16_t* Hh;
    __device__ __forceinline__ void operator()(const f32x4 (&acc)[2][2][4][2], const Unit& u, int wr, int wc, int fr, int fq) const {
        const int row0 = u.pm * BM + wr * 64 + fr; const int col0 = (u.pn & 3) * 128 + wc * 32 + 8 * fq;
#pragma unroll
        for (int ai = 0; ai < 2; ++ai)
#pragma unroll
            for (int m = 0; m < 4; ++m) { bf16_t* rowp = Hh + (size_t)(row0 + ai * HALF + m * 16) * 512 + col0;
                const f32x4 g0 = acc[ai][0][m][0], g1 = acc[ai][0][m][1], u0 = acc[ai][1][m][0], u1 = acc[ai][1][m][1];
                u32x4 w; w.x = cvt_pk_bf16(silu_f(g0[0]) * u0[0], silu_f(g0[1]) * u0[1]); w.y = cvt_pk_bf16(silu_f(g0[2]) * u0[2], silu_f(g0[3]) * u0[3]);
                w.z = cvt_pk_bf16(silu_f(g1[0]) * u1[0], silu_f(g1[1]) * u1[1]); w.w = cvt_pk_bf16(silu_f(g1[2]) * u1[2], silu_f(g1[3]) * u1[3]);
                *(u32x4*)rowp = w; }
    }
};
struct EpiY {
    static constexpr bool PERM = true, AFTER_DRAIN = false;
    bf16_t* O;
    __device__ __forceinline__ void operator()(const f32x4 (&acc)[2][2][4][2], const Unit& u, int wr, int wc, int fr, int fq) const {
        const int row0 = u.pm * BM + wr * 64 + fr; const int col0 = (u.pn & 3) * BM + wc * 32 + 8 * fq;
#pragma unroll
        for (int ai = 0; ai < 2; ++ai)
#pragma unroll
            for (int m = 0; m < 4; ++m) { bf16_t* rowp = O + (size_t)(row0 + ai * HALF + m * 16) * 1024 + col0;
#pragma unroll
                for (int bj = 0; bj < 2; ++bj) { const f32x4 v0 = acc[ai][bj][m][0], v1 = acc[ai][bj][m][1];
                    u32x4 w; w.x = cvt_pk_bf16(v0[0], v0[1]); w.y = cvt_pk_bf16(v0[2], v0[3]); w.z = cvt_pk_bf16(v1[0], v1[1]); w.w = cvt_pk_bf16(v1[2], v1[3]);
                    *(u32x4*)(rowp + bj * HALF) = w; } }
    }
};
struct MoeOrder {
    const PG8_LAS unsigned char* p2e; int nunits, G, c;
    __device__ __forceinline__ bool next(int i, Unit& u) const {
        const int L = i * G + c; if (L >= nunits) return false;
        u.pm = L >> 2; u.pn = (int)p2e[L >> 2] * 4 + (L & 3); return true;
    }
    __device__ __forceinline__ void a_ready(const Unit&) const {}
    __device__ __forceinline__ void done(const Unit&) const {}
};
template <class Epi, class Sched, bool ALIGN_EPI = false, bool SP2 = false>
__device__ __forceinline__ void gemm_phase(PG8_LAS unsigned char* lds, const Gemm g, const Sched& S, const Epi& E) {
    int tid_ = threadIdx.x; asm volatile("" : "+v"(tid_));
    const int tid = tid_, wid = __builtin_amdgcn_readfirstlane(tid >> 6), lane = tid & 63, wr = wid >> 2, wc = wid & 3, fr = lane & 15, fq = lane >> 4;
    const int K = g.K, nt = K / BK;
    unsigned voffA[2], voffB[2];
#pragma unroll
    for (int i = 0; i < 2; ++i) { int R, C; stage_rc(tid * 16 + i * 8192, R, C); const int Rb = Epi::PERM ? ((R & ~31) + perm32(R & 31)) : R;
        voffA[i] = (unsigned)(R * K + C) * 2u; voffB[i] = (unsigned)(Rb * K + C) * 2u; }
    const size_t kstep = (size_t)(BK * 2);
    const size_t hstep = (size_t)HALF * K * 2;
    const size_t tstep = 2 * hstep;
    const unsigned ldsw = (unsigned)wid * 1024u;
    const int aoff = lds_byte(wr * 64 + fr, fq * 8), boff = lds_byte(wc * 32 + fr, fq * 8);
#define PG8_SA(b, h) (((b) * 2 + (h)) * HTB)
#define PG8_SB(b, h) ((4 + (b) * 2 + (h)) * HTB)
#define PG8_STAGE(bufoff, gbase, voff) do { _Pragma("unroll") for (int _i = 0; _i < 2; ++_i) \
        __builtin_amdgcn_global_load_lds((const unsigned*)((const char*)(gbase) + (voff)[_i]), (PG8_LAS unsigned*)(lds + (bufoff) + ldsw + _i * 8192), 16, 0, 0); } while (0)
#define PG8_LDA(dst, b, h) do { _Pragma("unroll") for (int m = 0; m < 4; ++m) _Pragma("unroll") for (int k = 0; k < 2; ++k) dst[m][k] = *(const PG8_LAS bf16x8*)(lds + PG8_SA(b, h) + aoff + m * 2048 + k * 1024); } while (0)
#define PG8_LDB(dst, b, h) do { _Pragma("unroll") for (int n = 0; n < 2; ++n) _Pragma("unroll") for (int k = 0; k < 2; ++k) dst[n][k] = *(const PG8_LAS bf16x8*)(lds + PG8_SB(b, h) + boff + n * 2048 + k * 1024); } while (0)
#define PG8_MMA(ai, bj, At, Bt) do { __builtin_amdgcn_s_setprio(1); _Pragma("unroll") for (int m = 0; m < 4; ++m) _Pragma("unroll") for (int n = 0; n < 2; ++n) _Pragma("unroll") for (int k = 0; k < 2; ++k) \
        acc[ai][bj][m][n] = __builtin_amdgcn_mfma_f32_16x16x32_bf16(Bt[n][k], At[m][k], acc[ai][bj][m][n], 0, 0, 0); __builtin_amdgcn_s_setprio(0); } while (0)
#define PG8_WAIT_V(n) asm volatile("s_waitcnt vmcnt(" #n ")" ::: "memory")
#define PG8_WAIT_L(n) asm volatile("s_waitcnt lgkmcnt(" #n ")" ::: "memory")
#define PG8_BAR __builtin_amdgcn_s_barrier()
#define PG8_SCHED __builtin_amdgcn_sched_barrier(0)
    Unit cur, nxt; int ui = 0;
    if (!S.next(0, cur)) return;
    f32x4 acc[2][2][4][2];
#pragma unroll
    for (int a = 0; a < 2; ++a)
#pragma unroll
        for (int b = 0; b < 2; ++b)
#pragma unroll
            for (int m = 0; m < 4; ++m)
#pragma unroll
                for (int n = 0; n < 2; ++n) acc[a][b][m][n] = (f32x4){0.f, 0.f, 0.f, 0.f};
    bf16x8 At[4][2], B0[2][2], B1[2][2];
    const char* cA = (const char*)g.A + (size_t)cur.pm * tstep; const char* cB = (const char*)g.Bt + (size_t)cur.pn * tstep;
    S.a_ready(cur);
    if constexpr (SP2) {
        PG8_STAGE(PG8_SB(0, 0), cB, voffB); PG8_STAGE(PG8_SB(0, 1), cB + hstep, voffB); PG8_STAGE(PG8_SA(0, 0), cA, voffA); PG8_STAGE(PG8_SA(0, 1), cA + hstep, voffA);
        if (wr == 1) PG8_BAR;
        PG8_WAIT_V(2); PG8_BAR;
        PG8_STAGE(PG8_SB(1, 0), cB + kstep, voffB); PG8_STAGE(PG8_SA(1, 0), cA + kstep, voffA); PG8_STAGE(PG8_SB(1, 1), cB + hstep + kstep, voffB);
        PG8_WAIT_V(6); PG8_BAR;
    } else {
        PG8_STAGE(PG8_SB(0, 0), cB, voffB); PG8_STAGE(PG8_SA(0, 0), cA, voffA); PG8_STAGE(PG8_SB(0, 1), cB + hstep, voffB); PG8_STAGE(PG8_SA(0, 1), cA + hstep, voffA);
        if (wr == 1) PG8_BAR;
        PG8_WAIT_V(4); PG8_BAR;
        PG8_STAGE(PG8_SB(1, 0), cB + kstep, voffB); PG8_STAGE(PG8_SA(1, 0), cA + kstep, voffA); PG8_STAGE(PG8_SB(1, 1), cB + hstep + kstep, voffB);
        PG8_WAIT_V(6); PG8_BAR;
    }
    for (;;) {
        const bool has_next = S.next(ui + 1, nxt);
        const char* nA = has_next ? (const char*)g.A + (size_t)nxt.pm * tstep : cA; const char* nB = has_next ? (const char*)g.Bt + (size_t)nxt.pn * tstep : cB;
        for (int t = 0; t < nt; t += 2) {
            const bool last = (t == nt - 2);
            const char* a1 = cA + (size_t)(t + 1) * kstep;
            const char* a2 = last ? nA : cA + (size_t)(t + 2) * kstep; const char* b2 = last ? nB : cB + (size_t)(t + 2) * kstep;
            const char* a3 = a2 + kstep; const char* b3 = b2 + kstep;
            if (last && has_next) S.a_ready(nxt);
            if constexpr (SP2) {
            PG8_LDB(B0, 0, 0); PG8_LDB(B1, 0, 1); PG8_SCHED; PG8_LDA(At, 0, 0); PG8_STAGE(PG8_SA(1, 1), a1 + hstep, voffA);
            PG8_WAIT_V(8); PG8_WAIT_L(0); PG8_BAR; PG8_MMA(0, 0, At, B0); PG8_MMA(0, 1, At, B1); PG8_BAR; PG8_SCHED;
            PG8_LDA(At, 0, 1); PG8_STAGE(PG8_SB(0, 0), b2, voffB); PG8_STAGE(PG8_SB(0, 1), b2 + hstep, voffB); PG8_STAGE(PG8_SA(0, 0), a2, voffA);
            PG8_WAIT_V(8); PG8_WAIT_L(0); PG8_BAR; PG8_MMA(1, 0, At, B0); PG8_MMA(1, 1, At, B1); PG8_BAR; PG8_SCHED;
            PG8_LDB(B0, 1, 0); PG8_LDB(B1, 1, 1); PG8_SCHED; PG8_LDA(At, 1, 0); PG8_STAGE(PG8_SA(0, 1), a2 + hstep, voffA);
            PG8_WAIT_V(8); PG8_WAIT_L(0); PG8_BAR; PG8_MMA(0, 0, At, B0); PG8_MMA(0, 1, At, B1); PG8_BAR; PG8_SCHED;
            PG8_LDA(At, 1, 1); PG8_STAGE(PG8_SB(1, 0), b3, voffB); PG8_STAGE(PG8_SB(1, 1), b3 + hstep, voffB); PG8_STAGE(PG8_SA(1, 0), a3, voffA);
            PG8_WAIT_V(8); PG8_WAIT_L(0); PG8_BAR; PG8_MMA(1, 0, At, B0); PG8_MMA(1, 1, At, B1); PG8_BAR; PG8_SCHED;
            } else {
            PG8_LDB(B0, 0, 0); PG8_SCHED; PG8_LDA(At, 0, 0); PG8_STAGE(PG8_SA(1, 1), a1 + hstep, voffA);
            PG8_WAIT_L(8); PG8_BAR; PG8_WAIT_L(0); PG8_MMA(0, 0, At, B0); PG8_BAR; PG8_SCHED;
            PG8_LDB(B1, 0, 1); PG8_STAGE(PG8_SB(0, 0), b2, voffB);
            PG8_BAR; PG8_WAIT_L(0); PG8_MMA(0, 1, At, B1); PG8_BAR;
            PG8_LDA(At, 0, 1); PG8_STAGE(PG8_SA(0, 0), a2, voffA);
            PG8_BAR; PG8_WAIT_L(0); PG8_MMA(1, 0, At, B0); PG8_BAR; PG8_SCHED;
            PG8_STAGE(PG8_SB(0, 1), b2 + hstep, voffB);
            PG8_WAIT_V(6); PG8_BAR; PG8_MMA(1, 1, At, B1); PG8_BAR;
            PG8_LDB(B0, 1, 0); PG8_SCHED; PG8_LDA(At, 1, 0); PG8_STAGE(PG8_SA(0, 1), a2 + hstep, voffA);
            PG8_WAIT_L(8); PG8_BAR; PG8_WAIT_L(0); PG8_MMA(0, 0, At, B0); PG8_BAR; PG8_SCHED;
            PG8_LDB(B1, 1, 1); PG8_STAGE(PG8_SB(1, 0), b3, voffB);
            PG8_BAR; PG8_WAIT_L(0); PG8_MMA(0, 1, At, B1); PG8_BAR;
            PG8_LDA(At, 1, 1); PG8_STAGE(PG8_SA(1, 0), a3, voffA);
            PG8_BAR; PG8_WAIT_L(0); PG8_MMA(1, 0, At, B0); PG8_BAR; PG8_SCHED;
            PG8_STAGE(PG8_SB(1, 1), b3 + hstep, voffB);
            PG8_WAIT_V(6); PG8_BAR; PG8_MMA(1, 1, At, B1); PG8_BAR;
            }
        }
        if constexpr (ALIGN_EPI) { if (wr == 0) PG8_BAR; }
        if constexpr (!Epi::AFTER_DRAIN) { E(acc, cur, wr, wc, fr, fq); S.done(cur); }
        if (!has_next) break;
#pragma unroll
        for (int a = 0; a < 2; ++a)
#pragma unroll
            for (int b = 0; b < 2; ++b)
#pragma unroll
                for (int m = 0; m < 4; ++m)
#pragma unroll
                    for (int n = 0; n < 2; ++n) acc[a][b][m][n] = (f32x4){0.f, 0.f, 0.f, 0.f};
        cur = nxt; cA = nA; cB = nB; ++ui;
        if constexpr (ALIGN_EPI) { if (wr == 1) PG8_BAR; }
    }
    PG8_WAIT_V(0);
    if constexpr (!ALIGN_EPI) { if (wr == 0) PG8_BAR; }
    PG8_BAR;
    if constexpr (Epi::AFTER_DRAIN) { E.fused(acc, cur, wr, wc, fr, fq, lds, wid, lane); S.done(cur); }
#undef PG8_SA
#undef PG8_SB
#undef PG8_STAGE
#undef PG8_LDA
#undef PG8_LDB
#undef PG8_MMA
#undef PG8_WAIT_V
#undef PG8_WAIT_L
#undef PG8_BAR
#undef PG8_SCHED
}
}
constexpr int NWAVES = 8, NTHR = 512;
constexpr int DM = 1024, NLAT = 32768, NCTX = 2048, NROWS = 34816, INC = 3328;
constexpr int OFF_CB = 0, OFF_CC = 256, OFF_CX = 512, OFF_Q = 768, OFF_K = 1280, OFF_V = 1792, OFF_G = 2304, OFF_U = 2816, OFF_VV = 3072;
constexpr int NCH = 34;
constexpr float LN_EPS = 1e-5f, ALPHA = 1.41421356237309515f;
constexpr size_t MiB = 1u << 20;
constexpr size_t WS_CTL = 0, CTL_ZERO_BYTES = MiB, WS_MOD = 1 * MiB, WS_WR = 1 * MiB + 512 * 1024, WS_TOK = 2 * MiB, WS_WIN = 4 * MiB, WS_WOUT = 17 * MiB, WS_WGU = 21 * MiB, WS_WD = 149 * MiB,
                 WS_HB = 213 * MiB, WS_ST = WS_HB, WS_XCTX = 281 * MiB, WS_P = 289 * MiB, WS_YMIX = 510 * MiB, WS_XB = WS_P, WS_Y = WS_P, WS_HH = WS_P + 152 * MiB, WS_END = 578 * MiB;
constexpr int CW_TMO = 0, CW_BAR = 4096, CW_WGCNT = 16384, CW_TOT = 32768;
constexpr int RING_BYTES = 131072, LDSCTL_OFF = RING_BYTES, MISC_OFF = LDSCTL_OFF + 320, P2E_OFF = LDSCTL_OFF + 1024, PST_OFF = LDSCTL_OFF + 2048, LDS_BYTES = 147456;
constexpr int MAXPANELS = 304;

#define GAS __attribute__((address_space(1)))
#define LAS __attribute__((address_space(3)))
typedef unsigned short bf16;
typedef unsigned v4u __attribute__((ext_vector_type(4)));
typedef unsigned v2u __attribute__((ext_vector_type(2)));
typedef float f32x4 __attribute__((ext_vector_type(4)));
#define LDS_WAIT() asm volatile("s_waitcnt lgkmcnt(0)" ::: "memory")
#define VM_WAIT() asm volatile("s_waitcnt vmcnt(0)" ::: "memory")
__device__ __forceinline__ unsigned f2bf(float f) { unsigned u = __builtin_bit_cast(unsigned, f); return (u + 0x7fffu + ((u >> 16) & 1u)) >> 16; }
__device__ __forceinline__ unsigned pk2(float lo, float hi) { return f2bf(lo) | (f2bf(hi) << 16); }
typedef float f32x2_t __attribute__((ext_vector_type(2))); typedef __bf16 bf16x2_t __attribute__((ext_vector_type(2)));
__device__ __forceinline__ unsigned cvtpk(float lo, float hi) { f32x2_t v = {lo, hi}; bf16x2_t b = __builtin_convertvector(v, bf16x2_t); return __builtin_bit_cast(unsigned, b); }
__device__ __forceinline__ float bflo(unsigned w) { return __builtin_bit_cast(float, w << 16); }
__device__ __forceinline__ float bfhi(unsigned w) { return __builtin_bit_cast(float, w & 0xffff0000u); }
__device__ __forceinline__ float wave_sum(float v) {
#pragma unroll
    for (int o = 1; o < 64; o <<= 1) v += __shfl_xor(v, o);
    return v;
}
__device__ __forceinline__ float log_sigmoid_f(float x) { return -log1pf(expf(-x)); }

struct Args { const float* in[24]; float* out; unsigned char* ws; int ph_lo, ph_hi; };
#define XB_TMO      128
#define XB_XCNT(j)  (256  + 64 * (j))
#define XB_XSUB(j)  (1280 + 64 * (j))
#define XB_XGEN(j)  (2304 + 64 * (j))
#define XB_TOP      3328
#define XB_TOPGEN   3392
#define XCD_BAR_WORDS 3456
#define XB_SPIN_CAP (1u << 18)

__device__ __forceinline__ unsigned xb_ld(unsigned* p)              { return __hip_atomic_load(p, __ATOMIC_RELAXED, __HIP_MEMORY_SCOPE_AGENT); }
__device__ __forceinline__ unsigned xb_add(unsigned* p, unsigned v) { return __hip_atomic_fetch_add(p, v, __ATOMIC_RELAXED, __HIP_MEMORY_SCOPE_AGENT); }
__device__ __forceinline__ unsigned xb_xcc_id() { return (unsigned)__builtin_amdgcn_s_getreg((3 << 11) | 20) & 0xFu; }
#define XB_SPIN(cond, bar) do { unsigned _sp = 0; while (cond) { __builtin_amdgcn_s_sleep(1); \
    if ((++_sp & 255u) == 0u) { if (xb_ld(&(bar)[XB_TMO])) break; if (_sp > XB_SPIN_CAP) { atomicAdd(&(bar)[XB_TMO], 1u); break; } } } } while (0)

struct XcdBarrier {
    unsigned* bar; unsigned x;
    volatile LAS unsigned* st;
};

__device__ __forceinline__ XcdBarrier xcd_barrier_post(unsigned* bar, volatile LAS unsigned* st) {
    XcdBarrier b; b.bar = bar; b.x = xb_xcc_id(); b.st = st;
    if (threadIdx.x == 0) (void)xb_add(&bar[XB_XCNT(b.x)], 1u);
    return b;
}
__device__ __forceinline__ void xcd_barrier_complete(unsigned* bar, unsigned x, unsigned& nloc, unsigned& nx) {
    const unsigned G = gridDim.x * gridDim.y * gridDim.z;
    unsigned sum, cnt, mine, sp = 0u;
    for (;;) {
        sum = 0u; cnt = 0u; mine = 0u;
#pragma unroll
        for (unsigned j = 0; j < 16; ++j) { const unsigned c = xb_ld(&bar[XB_XCNT(j)]); sum += c; cnt += (c > 0u) ? 1u : 0u; mine = (j == x) ? c : mine; }
        if (sum == G) break;
        __builtin_amdgcn_s_sleep(1);
        if ((++sp & 255u) == 0u) { if (xb_ld(&bar[XB_TMO])) break; if (sp > XB_SPIN_CAP) { atomicAdd(&bar[XB_TMO], 1u); break; } }
    }
    nloc = mine > 0u ? mine : 1u; nx = cnt > 0u ? cnt : 1u;
}

__device__ __forceinline__ void xcd_barrier(const XcdBarrier& b) {
    asm volatile("s_waitcnt vmcnt(0)" ::: "memory");
    __syncthreads();
    if (threadIdx.x == 0) {
        unsigned* bar = b.bar;
        __builtin_amdgcn_s_waitcnt(0);
        unsigned nloc = b.st[0], nx = b.st[1];
        if (nloc == 0u) { xcd_barrier_complete(bar, b.x, nloc, nx); b.st[0] = nloc; b.st[1] = nx; }
        const unsigned old = xb_add(&bar[XB_XSUB(b.x)], 1u);
        const unsigned gen = old / nloc;
        if (old + 1u == (gen + 1u) * nloc) {
            __builtin_amdgcn_fence(__ATOMIC_RELEASE, "agent");
            asm volatile("s_waitcnt vmcnt(0)" ::: "memory");
            const unsigned og = xb_add(&bar[XB_TOP], 1u);
            const unsigned tg = og / nx;
            if (og + 1u == (tg + 1u) * nx) xb_add(&bar[XB_TOPGEN], 1u);
            else XB_SPIN(xb_ld(&bar[XB_TOPGEN]) == tg, bar);
            __builtin_amdgcn_fence(__ATOMIC_ACQUIRE, "agent");
            xb_add(&bar[XB_XGEN(b.x)], 1u);
            asm volatile("s_waitcnt vmcnt(0)" ::: "memory");
        } else {
            XB_SPIN(xb_ld(&bar[XB_XGEN(b.x)]) == gen, bar);
            __builtin_amdgcn_fence(__ATOMIC_ACQUIRE, "agent");
            asm volatile("s_waitcnt vmcnt(0)" ::: "memory");
        }
    }
    __syncthreads();
}
__device__ __forceinline__ void transpose_tile(const float* Wsrc, int ldn, bf16* dst, int ldk, float scale, LAS float* scr, int lane) {
#pragma unroll 8
    for (int i = 0; i < 32; ++i) { const int kk = 2 * i + (lane >> 5); scr[kk * 33 + (lane & 31)] = Wsrc[(size_t)kk * ldn + (lane & 31)] * scale; }
    LDS_WAIT(); asm volatile("" ::: "memory");
    const int c = lane & 7;
#pragma unroll
    for (int j = 0; j < 4; ++j) { const int n = (lane >> 3) + 8 * j; const LAS float* s = scr + (8 * c) * 33 + n;
        v4u o; o.x = pk2(s[0 * 33], s[1 * 33]); o.y = pk2(s[2 * 33], s[3 * 33]); o.z = pk2(s[4 * 33], s[5 * 33]); o.w = pk2(s[6 * 33], s[7 * 33]);
        *(GAS v4u*)(dst + (size_t)n * ldk + 8 * c) = o; }
    LDS_WAIT(); asm volatile("" ::: "memory");
}

__device__ __forceinline__ void phase_p0(const Args& a, LAS unsigned char* lds, int tid, int lane, int wave) {
    const int G = gridDim.x;
    {
        LAS float* s = (LAS float*)lds; LAS float* red = (LAS float*)(lds + 36864);
        const float* c = a.in[1]; const float* cctx = a.in[3]; const float* wada = a.in[4]; const float* bada = a.in[5];
        float* mod = (float*)(a.ws + WS_MOD);
        for (int u = blockIdx.x; u < 192; u += G) {
            const int l = u / 96, j0 = (u % 96) * 64;
            for (int i = tid; i < 9 * 1024; i += NTHR) { const int r = i >> 10, k = i & 1023; const float v = r < 8 ? c[r * 1024 + k] : cctx[k]; s[i] = v / (1.0f + expf(-v)); }
            __syncthreads();
            const int jq = tid & 15, kg = tid >> 4;
            float acc[9][4];
#pragma unroll
            for (int r = 0; r < 9; ++r) { acc[r][0] = 0.f; acc[r][1] = 0.f; acc[r][2] = 0.f; acc[r][3] = 0.f; }
            const float* w = wada + (size_t)l * 1024 * 6144 + j0 + jq * 4;
            for (int k = kg; k < 1024; k += 32) { const f32x4 wv = *(const f32x4*)(w + (size_t)k * 6144);
#pragma unroll
                for (int r = 0; r < 9; ++r) { const float sr = s[r * 1024 + k]; acc[r][0] += sr * wv.x; acc[r][1] += sr * wv.y; acc[r][2] += sr * wv.z; acc[r][3] += sr * wv.w; } }
#pragma unroll
            for (int r = 0; r < 9; ++r)
#pragma unroll
                for (int i = 0; i < 4; ++i) red[(kg * 9 + r) * 64 + jq * 4 + i] = acc[r][i];
            __syncthreads();
            for (int o = tid; o < 576; o += NTHR) { const int r = o >> 6, j = o & 63; float sum = 0.f;
                for (int g2 = 0; g2 < 32; ++g2) sum += red[(g2 * 9 + r) * 64 + j];
                mod[(l * 9 + r) * 6144 + j0 + j] = sum + bada[l * 6144 + j0 + j]; }
            __syncthreads();
        }
    }
    {
        LAS float* scr = (LAS float*)(lds + wave * 16384);
        const int gw = blockIdx.x * NWAVES + wave, NGW = G * NWAVES;
        const float* w_in = a.in[6]; const float* w_out = a.in[12]; const float* w_gate = a.in[19]; const float* w_up = a.in[20]; const float* w_down = a.in[21];
        bf16* WIN = (bf16*)(a.ws + WS_WIN); bf16* WOUT = (bf16*)(a.ws + WS_WOUT); bf16* WGU = (bf16*)(a.ws + WS_WGU); bf16* WD = (bf16*)(a.ws + WS_WD);
        constexpr int I_IN = 2 * 16 * 104, I_OUT = 2 * 16 * 32, I_GU = 2 * 2 * 32 * 256, I_D = 2 * 32 * 256, NITEMS = I_IN + I_OUT + I_GU + I_D;
        for (int it = gw; it < NITEMS; it += NGW) {
            int r = it;
            if (r < I_IN) { const int l = r / 1664, q = r % 1664, k0 = 64 * (q / 104), n0 = 32 * (q % 104);
                const float sc = (n0 >= OFF_K && n0 < OFF_V) ? 0.125f : 1.0f;
                transpose_tile(w_in + ((size_t)l * 1024 + k0) * INC + n0, INC, WIN + ((size_t)l * INC + n0) * 1024 + k0, 1024, sc, scr, lane); continue; }
            r -= I_IN;
            if (r < I_OUT) { const int l = r / 512, q = r % 512, k0 = 64 * (q / 32), n0 = 32 * (q % 32);
                transpose_tile(w_out + ((size_t)l * 1024 + k0) * 1024 + n0, 1024, WOUT + ((size_t)l * 1024 + n0) * 1024 + k0, 1024, 1.0f, scr, lane); continue; }
            r -= I_OUT;
            if (r < I_GU) { const int isup = r >= (I_GU / 2) ? 1 : 0; r -= isup * (I_GU / 2);
                const int le = r / 256, q = r % 256, k0 = 64 * (q / 16), n0 = 32 * (q % 16);
                const float* src = (isup ? w_up : w_gate) + ((size_t)le * 1024 + k0) * 512 + n0;
                const int drow = (n0 >> 7) * 256 + (n0 & 127) + isup * 128;
                transpose_tile(src, 512, WGU + ((size_t)le * 1024 + drow) * 1024 + k0, 1024, 1.0f, scr, lane); continue; }
            r -= I_GU;
            { const int le = r / 256, q = r % 256, k0 = 64 * (q / 32), n0 = 32 * (q % 32);
                transpose_tile(w_down + ((size_t)le * 512 + k0) * 1024 + n0, 1024, WD + ((size_t)le * 1024 + n0) * 512 + k0, 512, 1.0f, scr, lane); }
        }
    }
    {
        bf16* WR = (bf16*)(a.ws + WS_WR);
        for (int i = blockIdx.x * NTHR + tid; i < 2 * 64 * 1024; i += G * NTHR) { const int l = i >> 16, j = (i >> 10) & 63, k = i & 1023;
            float v = 0.f;
            if (j < 4) v = a.in[15][((size_t)l * 1024 + k) * 4 + j]; else if (j < 36) v = a.in[17][(((size_t)l * 4 + ((j - 4) >> 3)) * 1024 + k) * 8 + ((j - 4) & 7)];
            const unsigned hi = f2bf(v); const float r = v - __builtin_bit_cast(float, hi << 16);
            WR[((size_t)(l * 2) * 64 + j) * 1024 + k] = (bf16)hi; WR[((size_t)(l * 2 + 1) * 64 + j) * 1024 + k] = (bf16)f2bf(r); }
    }
    __syncthreads();
}

__device__ __forceinline__ void phase_p1(const Args& a, int lane, int wave) {
    const int gw = blockIdx.x * NWAVES + wave, NGW = gridDim.x * NWAVES;
    const float* mod = (const float*)(a.ws + WS_MOD); bf16* Hb = (bf16*)(a.ws + WS_HB);
    for (int row = gw; row < NROWS; row += NGW) {
        const float* src = row < NLAT ? a.in[0] + (size_t)row * 1024 : a.in[2] + (size_t)(row - NLAT) * 1024;
        const float* m0 = mod + (row < NLAT ? (row >> 12) : 8) * 6144;
#pragma unroll
        for (int j = 0; j < 4; ++j) { const int idx = (lane + 64 * j) * 4;
            const f32x4 v = *(const f32x4*)(src + idx), sh = *(const f32x4*)(m0 + idx), sc = *(const f32x4*)(m0 + 1024 + idx);
            const f32x4 o = v * (sc + 1.0f) + sh; v2u w; w.x = pk2(o.x, o.y); w.y = pk2(o.z, o.w);
            *(v2u*)(Hb + (size_t)row * 1024 + idx) = w; }
    }
}

__device__ __forceinline__ int chunk_row0(int b, int c) { return c < 2 ? NLAT + b * 256 + c * 128 : b * 4096 + (c - 2) * 128; }
__device__ __forceinline__ size_t st_off(int b, int c, int h, int dir) { return ((((size_t)b * NCH + c) * 8 + h) * 2 + dir) * 4096; }

__device__ __forceinline__ void phase_b(const Args& a, int l, LAS unsigned char* lds, int tid) {
    const bf16* P = (const bf16*)(a.ws + WS_P); float* ST = (float*)(a.ws + WS_ST);
    LAS float* Ks = (LAS float*)lds; LAS float* Vs = (LAS float*)(lds + 32768); LAS float* pf = (LAS float*)(lds + 65536); LAS float* pb = pf + 128;
    for (int u = blockIdx.x; u < 8 * NCH * 8; u += gridDim.x) {
        const int b = u / (NCH * 8), c = (u % (NCH * 8)) / 8, h = u % 8; const int row0 = chunk_row0(b, c);
        __syncthreads();
        if (tid < 128) { const float lgf = log_sigmoid_f(a.in[8][l * 8 + h]), lgb = log_sigmoid_f(a.in[9][l * 8 + h]);
            pf[tid] = expf(lgf * (float)(127 - tid)); pb[tid] = expf(lgb * (float)tid); }
        { const int j = tid >> 2, part = tid & 3; const bf16* kp = P + (size_t)(row0 + j) * INC + OFF_K + h * 64 + part * 16; const bf16* vp = kp + (OFF_V - OFF_K);
#pragma unroll
          for (int q = 0; q < 2; ++q) { const v4u kw = *(const v4u*)(kp + 8 * q), vw = *(const v4u*)(vp + 8 * q);
              LAS float* kd = Ks + j * 64 + part * 16 + 8 * q; LAS float* vd = Vs + j * 64 + part * 16 + 8 * q;
              kd[0] = bflo(kw.x); kd[1] = bfhi(kw.x); kd[2] = bflo(kw.y); kd[3] = bfhi(kw.y); kd[4] = bflo(kw.z); kd[5] = bfhi(kw.z); kd[6] = bflo(kw.w); kd[7] = bfhi(kw.w);
              vd[0] = bflo(vw.x); vd[1] = bfhi(vw.x); vd[2] = bflo(vw.y); vd[3] = bfhi(vw.y); vd[4] = bflo(vw.z); vd[5] = bfhi(vw.z); vd[6] = bflo(vw.w); vd[7] = bfhi(vw.w); } }
        __syncthreads();
        const int d = tid >> 3, e0 = (tid & 7) * 8;
        float af[8], ab[8];
#pragma unroll
        for (int i = 0; i < 8; ++i) { af[i] = 0.f; ab[i] = 0.f; }
        for (int j = 0; j < 128; ++j) { const float kd = Ks[j * 64 + d], kf = kd * pf[j], kb = kd * pb[j];
            const f32x4 v0 = *(const LAS f32x4*)(Vs + j * 64 + e0), v1 = *(const LAS f32x4*)(Vs + j * 64 + e0 + 4);
            af[0] += kf * v0.x; af[1] += kf * v0.y; af[2] += kf * v0.z; af[3] += kf * v0.w; af[4] += kf * v1.x; af[5] += kf * v1.y; af[6] += kf * v1.z; af[7] += kf * v1.w;
            ab[0] += kb * v0.x; ab[1] += kb * v0.y; ab[2] += kb * v0.z; ab[3] += kb * v0.w; ab[4] += kb * v1.x; ab[5] += kb * v1.y; ab[6] += kb * v1.z; ab[7] += kb * v1.w; }
        float* o0 = ST + st_off(b, c, h, 0) + d * 64 + e0; float* o1 = ST + st_off(b, c, h, 1) + d * 64 + e0;
        *(f32x4*)o0 = (f32x4){af[0], af[1], af[2], af[3]}; *(f32x4*)(o0 + 4) = (f32x4){af[4], af[5], af[6], af[7]};
        *(f32x4*)o1 = (f32x4){ab[0], ab[1], ab[2], ab[3]}; *(f32x4*)(o1 + 4) = (f32x4){ab[4], ab[5], ab[6], ab[7]};
    }
    __syncthreads();
}

__device__ __forceinline__ void phase_c(const Args& a, int l, int tid, bool dry = false) {
    float* ST = (float*)(a.ws + WS_ST); float* STW = dry ? (float*)(a.ws + WS_YMIX) : ST;
    for (int it = blockIdx.x * NTHR + tid; it < 8 * 8 * 2 * 1024; it += gridDim.x * NTHR) {
        const int q = it & 1023, dir = (it >> 10) & 1, h = (it >> 11) & 7, b = it >> 14;
        const float lg = log_sigmoid_f(dir ? a.in[9][l * 8 + h] : a.in[8][l * 8 + h]); const float dec = expf(128.0f * lg);
        f32x4 kv[NCH];
#pragma unroll
        for (int s = 0; s < NCH; ++s) { const int c = dir ? (s < 2 ? 1 - s : 35 - s) : s; kv[s] = *(const f32x4*)(ST + st_off(b, c, h, dir) + q * 4); }
        f32x4 st = (f32x4){0.f, 0.f, 0.f, 0.f};
#pragma unroll
        for (int s = 0; s < NCH; ++s) { const int c = dir ? (s < 2 ? 1 - s : 35 - s) : s; *(f32x4*)(STW + st_off(b, c, h, dir) + q * 4) = st; st = st * dec + kv[s]; }
    }
}
__device__ __forceinline__ void unpack8(const v4u w, float* f) { f[0] = bflo(w.x); f[1] = bfhi(w.x); f[2] = bflo(w.y); f[3] = bfhi(w.y); f[4] = bflo(w.z); f[5] = bfhi(w.z); f[6] = bflo(w.w); f[7] = bfhi(w.w); }
__device__ __forceinline__ v4u pack8(const float* f) { v4u w; w.x = pk2(f[0], f[1]); w.y = pk2(f[2], f[3]); w.z = pk2(f[4], f[5]); w.w = pk2(f[6], f[7]); return w; }

__device__ __forceinline__ void phase_d(const Args& a, int l, LAS unsigned char* lds, int tid, int lane) {
    const bf16* P = (const bf16*)(a.ws + WS_P); const float* ST = (const float*)(a.ws + WS_ST); bf16* Y = (bf16*)(a.ws + WS_YMIX);
    const float* convw = a.in[7] + l * 3 * 256; const float* sguw = a.in[10] + (size_t)l * 4 * 128 * 128; const float* sgub = a.in[11] + l * 4 * 128;
    const int c_lo = l == 1 ? 2 : 0, cpb = NCH - c_lo, nunits = 8 * cpb;
    LAS float* Sf = (LAS float*)lds; LAS float* Sb = (LAS float*)(lds + 16384); LAS float* Ks = (LAS float*)(lds + 32768); LAS float* Vs = (LAS float*)(lds + 65536);
    LAS float* VN = (LAS float*)lds;
    for (int u = blockIdx.x; u < nunits; u += gridDim.x) {
        const int b = u / cpb, c = c_lo + u % cpb; const int row0 = chunk_row0(b, c); const bool isc = c < 2;
#ifndef NO_D1
        for (int idx = tid; idx < 128 * 32; idx += NTHR) {
            const int p = idx >> 5, ch0 = (idx & 31) * 8; const int row = row0 + p;
            int dprev = -1, dnext = 1; bool vprev, vnext;
            if (isc) { const int t = c * 128 + p; vprev = t > 0; vnext = t < 255; }
            else { const int t = (c - 2) * 128 + p;
                if (ch0 < 128) { const int col = t & 63; vprev = col > 0; vnext = col < 63; }
                else { const int rg = t >> 6; vprev = rg > 0; vnext = rg < 63; dprev = -64; dnext = 64; } }
            const bf16* pr = P + (size_t)row * INC;
            float cb[8], zc[8], zp[8], zn[8], t0[8], t1[8];
            unpack8(*(const v4u*)(pr + OFF_CB + ch0), cb);
            unpack8(*(const v4u*)(pr + OFF_CC + ch0), t0); unpack8(*(const v4u*)(pr + OFF_CX + ch0), t1);
#pragma unroll
            for (int i = 0; i < 8; ++i) { zc[i] = t0[i] * t1[i]; zp[i] = 0.f; zn[i] = 0.f; }
            if (vprev) { const bf16* q = pr + (ptrdiff_t)dprev * INC; unpack8(*(const v4u*)(q + OFF_CC + ch0), t0); unpack8(*(const v4u*)(q + OFF_CX + ch0), t1);
#pragma unroll
                for (int i = 0; i < 8; ++i) zp[i] = t0[i] * t1[i]; }
            if (vnext) { const bf16* q = pr + (ptrdiff_t)dnext * INC; unpack8(*(const v4u*)(q + OFF_CC + ch0), t0); unpack8(*(const v4u*)(q + OFF_CX + ch0), t1);
#pragma unroll
                for (int i = 0; i < 8; ++i) zn[i] = t0[i] * t1[i]; }
            float o[8];
#pragma unroll
            for (int i = 0; i < 8; ++i) o[i] = cb[i] * (convw[ch0 + i] * zp[i] + convw[256 + ch0 + i] * zc[i] + convw[512 + ch0 + i] * zn[i]);
            *(v4u*)(Y + (size_t)row * 1024 + ch0) = pack8(o);
        }
#endif
        const int i = tid >> 2, part = tid & 3;
#ifndef NO_D2
#pragma unroll 1
        for (int h = 0; h < 8; ++h) {
            __syncthreads();
            { const bf16* kp = P + (size_t)(row0 + i) * INC + OFF_K + h * 64 + part * 16; const bf16* vp = kp + (OFF_V - OFF_K);
#pragma unroll
              for (int q = 0; q < 2; ++q) { float kf[8], vf[8]; unpack8(*(const v4u*)(kp + 8 * q), kf); unpack8(*(const v4u*)(vp + 8 * q), vf);
                  LAS float* kd = Ks + i * 64 + part * 16 + 8 * q; LAS float* vd = Vs + i * 64 + part * 16 + 8 * q;
#pragma unroll
                  for (int e = 0; e < 8; ++e) { kd[e] = kf[e]; vd[e] = vf[e]; } }
              const float* sf = ST + st_off(b, c, h, 0); const float* sb = ST + st_off(b, c, h, 1);
#pragma unroll
              for (int q = 0; q < 2; ++q) { const int o4 = (tid + NTHR * q) * 4; *(LAS f32x4*)(Sf + o4) = *(const f32x4*)(sf + o4); *(LAS f32x4*)(Sb + o4) = *(const f32x4*)(sb + o4); } }
            float qv[16];
            { const bf16* qp = P + (size_t)(row0 + i) * INC + OFF_Q + h * 64 + part * 16; unpack8(*(const v4u*)qp, qv); unpack8(*(const v4u*)(qp + 8), qv + 8); }
            const float lgf = log_sigmoid_f(a.in[8][l * 8 + h]), lgb = log_sigmoid_f(a.in[9][l * 8 + h]);
            __syncthreads();
            float o[16];
#pragma unroll
            for (int e = 0; e < 16; ++e) o[e] = 0.f;
#pragma unroll 1
            for (int j = 0; j < 128; ++j) {
                const LAS f32x4* kr = (const LAS f32x4*)(Ks + j * 64 + part * 16);
                float s = 0.f;
#pragma unroll
                for (int q = 0; q < 4; ++q) { const f32x4 k4 = kr[q]; s += qv[4 * q] * k4.x + qv[4 * q + 1] * k4.y + qv[4 * q + 2] * k4.z + qv[4 * q + 3] * k4.w; }
                s += __shfl_xor(s, 1); s += __shfl_xor(s, 2);
                const int rel = i - j;
                const float dec = rel > 0 ? expf(lgf * (float)rel) : (rel < 0 ? expf(lgb * (float)(-rel)) : 2.0f);
                s *= dec;
                const LAS f32x4* vr = (const LAS f32x4*)(Vs + j * 64 + part * 16);
#pragma unroll
                for (int q = 0; q < 4; ++q) { const f32x4 v4 = vr[q]; o[4 * q] += s * v4.x; o[4 * q + 1] += s * v4.y; o[4 * q + 2] += s * v4.z; o[4 * q + 3] += s * v4.w; }
            }
            float of[16], ob[16];
#pragma unroll
            for (int e = 0; e < 16; ++e) { of[e] = 0.f; ob[e] = 0.f; }
            __syncthreads();
#pragma unroll
            for (int dd = 0; dd < 16; ++dd) Ks[i * 64 + ((part * 16 + dd + i) & 63)] = qv[dd];
            __syncthreads();
#pragma unroll 2
            for (int d = 0; d < 64; ++d) { const float qd = Ks[i * 64 + ((d + i) & 63)];
                const LAS f32x4* fr = (const LAS f32x4*)(Sf + d * 64 + part * 16); const LAS f32x4* br = (const LAS f32x4*)(Sb + d * 64 + part * 16);
#pragma unroll
                for (int q = 0; q < 4; ++q) { const f32x4 f4 = fr[q], b4 = br[q];
                    of[4 * q] += qd * f4.x; of[4 * q + 1] += qd * f4.y; of[4 * q + 2] += qd * f4.z; of[4 * q + 3] += qd * f4.w;
                    ob[4 * q] += qd * b4.x; ob[4 * q + 1] += qd * b4.y; ob[4 * q + 2] += qd * b4.z; ob[4 * q + 3] += qd * b4.w; } }
            const float df = expf(lgf * (float)(i + 1)), db = expf(lgb * (float)(128 - i));
            float sum = 0.f;
#pragma unroll
            for (int e = 0; e < 16; ++e) { o[e] += df * of[e] + db * ob[e]; sum += o[e]; }
            sum += __shfl_xor(sum, 1); sum += __shfl_xor(sum, 2);
            const float mu = sum * (1.0f / 64.0f); float vs = 0.f;
#pragma unroll
            for (int e = 0; e < 16; ++e) { o[e] -= mu; vs += o[e] * o[e]; }
            vs += __shfl_xor(vs, 1); vs += __shfl_xor(vs, 2);
            const float rs = 1.0f / sqrtf(vs * (1.0f / 64.0f) + LN_EPS);
            float gv[16];
            { const bf16* gp = P + (size_t)(row0 + i) * INC + OFF_G + h * 64 + part * 16; unpack8(*(const v4u*)gp, gv); unpack8(*(const v4u*)(gp + 8), gv + 8); }
#pragma unroll
            for (int e = 0; e < 16; ++e) o[e] = (gv[e] / (1.0f + expf(-gv[e]))) * (o[e] * rs);
            bf16* yp = Y + (size_t)(row0 + i) * 1024 + 256 + h * 64 + part * 16;
            *(v4u*)yp = pack8(o); *(v4u*)(yp + 8) = pack8(o + 8);
        }
#endif
#ifndef NO_D3
        __syncthreads();
        {
            const bf16* vp = P + (size_t)(row0 + i) * INC + OFF_VV + part * 64;
            float sum = 0.f;
#pragma unroll 2
            for (int q = 0; q < 8; ++q) { float t8[8]; unpack8(*(const v4u*)(vp + 8 * q), t8);
#pragma unroll
                for (int e = 0; e < 8; ++e) sum += t8[e]; }
            sum += __shfl_xor(sum, 1); sum += __shfl_xor(sum, 2);
            const float mu = sum * (1.0f / 256.0f); float vs = 0.f;
#pragma unroll 2
            for (int q = 0; q < 8; ++q) { float t8[8]; unpack8(*(const v4u*)(vp + 8 * q), t8);
#pragma unroll
                for (int e = 0; e < 8; ++e) { const float dlt = t8[e] - mu; vs += dlt * dlt; } }
            vs += __shfl_xor(vs, 1); vs += __shfl_xor(vs, 2);
            const float rs = 1.0f / sqrtf(vs * (1.0f / 256.0f) + LN_EPS);
            LAS float* dst = VN + (part * 128 + i) * 64;
#pragma unroll 2
            for (int q = 0; q < 8; ++q) { float t8[8]; unpack8(*(const v4u*)(vp + 8 * q), t8);
                *(LAS f32x4*)(dst + 8 * q) = (f32x4){(t8[0] - mu) * rs, (t8[1] - mu) * rs, (t8[2] - mu) * rs, (t8[3] - mu) * rs};
                *(LAS f32x4*)(dst + 8 * q + 4) = (f32x4){(t8[4] - mu) * rs, (t8[5] - mu) * rs, (t8[6] - mu) * rs, (t8[7] - mu) * rs}; }
        }
        __syncthreads();
        for (int g = 0; g < 4; ++g) {
            float acc[16];
#pragma unroll
            for (int e = 0; e < 16; ++e) acc[e] = 0.f;
            const float* wrow = sguw + ((size_t)g * 128 + i) * 128;
            for (int q = 0; q < 128; q += 4) { const f32x4 w4 = *(const f32x4*)(wrow + q);
#pragma unroll
                for (int qq = 0; qq < 4; ++qq) { const float w = w4[qq]; const LAS f32x4* vr = (const LAS f32x4*)(VN + (g * 128 + q + qq) * 64 + part * 16);
#pragma unroll
                    for (int t = 0; t < 4; ++t) { const f32x4 v4 = vr[t]; acc[4 * t] += w * v4.x; acc[4 * t + 1] += w * v4.y; acc[4 * t + 2] += w * v4.z; acc[4 * t + 3] += w * v4.w; } } }
            const float bias = sgub[g * 128 + i];
            float uv[16];
            { const bf16* up = P + (size_t)(row0 + i) * INC + OFF_U + g * 64 + part * 16; unpack8(*(const v4u*)up, uv); unpack8(*(const v4u*)(up + 8), uv + 8); }
#pragma unroll
            for (int e = 0; e < 16; ++e) acc[e] = uv[e] * (acc[e] + bias);
            bf16* yp = Y + (size_t)(row0 + i) * 1024 + 768 + g * 64 + part * 16;
            *(v4u*)yp = pack8(acc); *(v4u*)(yp + 8) = pack8(acc + 8);
        }
#endif
        __syncthreads();
    }
}

__device__ __forceinline__ void phase_f(const Args& a, int l, LAS unsigned char* lds, int tid, int lane, int wave, bool dry = false) {
    LAS int* lcnt = (LAS int*)lds;
    __syncthreads();
    if (tid < 32) lcnt[tid] = 0;
    __syncthreads();
    const int gw = blockIdx.x * NWAVES + wave, NGW = gridDim.x * NWAVES, nrows = l == 0 ? NROWS : NLAT;
    const float* mod = (const float*)(a.ws + WS_MOD) + l * 9 * 6144;
    const float* lng = a.in[13] + l * 1024; const float* lnb = a.in[14] + l * 1024;
    const float* rgw = a.in[15] + l * 1024 * 4; const float* rgb = a.in[16] + l * 4; const float* rew = a.in[17] + (size_t)l * 4 * 1024 * 8; const float* reb = a.in[18] + l * 32;
    bf16* Hb = (bf16*)(a.ws + (dry ? WS_P + 160 * MiB : WS_HB)); unsigned* tok = (unsigned*)(a.ws + (dry ? WS_P + 240 * MiB : WS_TOK)); float* xctx = (float*)(a.ws + WS_XCTX);
    for (int row = gw; row < nrows; row += NGW) {
        float* xr = row < NLAT ? a.out + (size_t)row * 1024 : xctx + (size_t)(row - NLAT) * 1024;
        float* xw = dry ? (float*)(a.ws + WS_P) + (size_t)row * 1024 : xr;
        const float* m0 = mod + (row < NLAT ? (row >> 12) : 8) * 6144;
        f32x4 v[4]; float s = 0.f;
#pragma unroll
        for (int j = 0; j < 4; ++j) { v[j] = *(const f32x4*)(xr + (lane + 64 * j) * 4); s += (v[j].x + v[j].y) + (v[j].z + v[j].w); }
        const float mean = wave_sum(s) * (1.0f / 1024.0f); float s2 = 0.f;
#pragma unroll
        for (int j = 0; j < 4; ++j) { v[j] = v[j] - mean; s2 += (v[j].x * v[j].x + v[j].y * v[j].y) + (v[j].z * v[j].z + v[j].w * v[j].w); }
        const float rstd = 1.0f / sqrtf(wave_sum(s2) * (1.0f / 1024.0f) + LN_EPS);
        float lg[4] = {0.f, 0.f, 0.f, 0.f};
#pragma unroll
        for (int j = 0; j < 4; ++j) { const int idx = (lane + 64 * j) * 4;
            const f32x4 x1 = v[j] * rstd * *(const f32x4*)(lng + idx) + *(const f32x4*)(lnb + idx);
            *(f32x4*)(xw + idx) = x1;
            const f32x4 hm = x1 * (*(const f32x4*)(m0 + 4096 + idx) + 1.0f) + *(const f32x4*)(m0 + 3072 + idx);
            v[j] = hm;
            v2u w; w.x = pk2(hm.x, hm.y); w.y = pk2(hm.z, hm.w); *(v2u*)(Hb + (size_t)row * 1024 + idx) = w;
#pragma unroll
            for (int t = 0; t < 4; ++t) { const f32x4 w4 = *(const f32x4*)(rgw + (idx + t) * 4); const float hv = hm[t];
                lg[0] += hv * w4.x; lg[1] += hv * w4.y; lg[2] += hv * w4.z; lg[3] += hv * w4.w; } }
#pragma unroll
        for (int g = 0; g < 4; ++g) lg[g] = wave_sum(lg[g]) + rgb[g];
        int gi = 0; float gm = lg[0];
#pragma unroll
        for (int g = 1; g < 4; ++g) if (lg[g] > gm) { gm = lg[g]; gi = g; }
        float gden = 0.f;
#pragma unroll
        for (int g = 0; g < 4; ++g) gden += expf(lg[g] - gm);
        const float gprob = 1.0f / gden;
        float le[8] = {0.f, 0.f, 0.f, 0.f, 0.f, 0.f, 0.f, 0.f};
        const float* rw = rew + (size_t)gi * 1024 * 8;
#pragma unroll
        for (int j = 0; j < 4; ++j) { const int idx = (lane + 64 * j) * 4;
#pragma unroll
            for (int t = 0; t < 4; ++t) { const f32x4 w0 = *(const f32x4*)(rw + (idx + t) * 8), w1 = *(const f32x4*)(rw + (idx + t) * 8 + 4); const float hv = v[j][t];
                le[0] += hv * w0.x; le[1] += hv * w0.y; le[2] += hv * w0.z; le[3] += hv * w0.w; le[4] += hv * w1.x; le[5] += hv * w1.y; le[6] += hv * w1.z; le[7] += hv * w1.w; } }
#pragma unroll
        for (int e = 0; e < 8; ++e) le[e] = wave_sum(le[e]) + reb[gi * 8 + e];
        int i1 = 0; float m1 = le[0];
#pragma unroll
        for (int e = 1; e < 8; ++e) if (le[e] > m1) { m1 = le[e]; i1 = e; }
        int i2 = -1; float m2 = -3.0e38f;
#pragma unroll
        for (int e = 0; e < 8; ++e) if (e != i1 && le[e] > m2) { m2 = le[e]; i2 = e; }
        const float p2 = expf(m2 - m1), inv = 1.0f / (1.0f + p2);
        const float gate0 = gprob * inv, gate1 = gprob * p2 * inv;
        if (lane == 0) { const int e0 = gi * 8 + i1, e1 = gi * 8 + i2;
            const int p0 = __hip_atomic_fetch_add(lcnt + e0, 1, __ATOMIC_RELAXED, __HIP_MEMORY_SCOPE_WORKGROUP);
            const int p1 = __hip_atomic_fetch_add(lcnt + e1, 1, __ATOMIC_RELAXED, __HIP_MEMORY_SCOPE_WORKGROUP);
            unsigned* t = tok + (size_t)row * 8; t[0] = (unsigned)e0 | ((unsigned)e1 << 8); t[1] = (unsigned)p0; t[2] = (unsigned)p1;
            t[4] = __builtin_bit_cast(unsigned, gate0); t[5] = __builtin_bit_cast(unsigned, gate1); }
    }
    __syncthreads();
    if (tid < 32 && !dry) ((unsigned*)(a.ws + WS_CTL))[CW_WGCNT + (l * 256 + blockIdx.x) * 32 + tid] = (unsigned)lcnt[tid];
    __syncthreads();
}

__device__ __forceinline__ void phase_g(const Args& a, int l, LAS unsigned char* lds, int tid, int lane, int wave) {
    LAS int* cn = (LAS int*)lds; LAS int* base = (LAS int*)(lds + 32768); LAS int* pst = base + 32; LAS int* totl = base + 80;
    unsigned* ctl = (unsigned*)(a.ws + WS_CTL);
    __syncthreads();
    for (int i = tid; i < 256 * 32; i += NTHR) cn[i] = (int)ctl[CW_WGCNT + l * 256 * 32 + i];
    __syncthreads();
    if (tid < 32) { int tot = 0, bs = 0; for (int w = 0; w < 256; ++w) { const int v = cn[w * 32 + tid]; if (w < (int)blockIdx.x) bs += v; tot += v; } base[tid] = bs; totl[tid] = tot; }
    __syncthreads();
    if (tid == 0) { int run = 0; for (int e = 0; e < 32; ++e) { pst[e] = run; run += ((totl[e] + 255) >> 8) << 8; } pst[32] = run; }
    __syncthreads();
    if (blockIdx.x == 0 && tid < 32) ctl[CW_TOT + l * 64 + tid] = (unsigned)totl[tid];
    const int gw = blockIdx.x * NWAVES + wave, NGW = gridDim.x * NWAVES, nrows = l == 0 ? NROWS : NLAT;
    const bf16* Hb = (const bf16*)(a.ws + WS_HB); bf16* XB = (bf16*)(a.ws + WS_XB); unsigned* tok = (unsigned*)(a.ws + WS_TOK);
    (void)gw; (void)NGW;
    for (int T = blockIdx.x; T < (nrows >> 5); T += gridDim.x)
    for (int rr = 0; rr < 4; ++rr) { const int row = 32 * T + 4 * wave + rr;
        unsigned* t = tok + (size_t)row * 8; const unsigned ee = t[0]; const int e0 = ee & 255, e1 = (ee >> 8) & 255;
        const int s0 = pst[e0] + base[e0] + (int)t[1], s1 = pst[e1] + base[e1] + (int)t[2];
        if (lane == 0) { t[6] = (unsigned)s0; t[7] = (unsigned)s1; }
        const v4u a0 = *(const v4u*)(Hb + (size_t)row * 1024 + lane * 8), a1 = *(const v4u*)(Hb + (size_t)row * 1024 + 512 + lane * 8);
        *(v4u*)(XB + (size_t)s0 * 1024 + lane * 8) = a0; *(v4u*)(XB + (size_t)s0 * 1024 + 512 + lane * 8) = a1;
        *(v4u*)(XB + (size_t)s1 * 1024 + lane * 8) = a0; *(v4u*)(XB + (size_t)s1 * 1024 + 512 + lane * 8) = a1;
    }
    __syncthreads();
}

__device__ __forceinline__ int build_p2e(const Args& a, int l, LAS unsigned char* lds, int tid) {
    LAS unsigned char* p2e = lds + P2E_OFF; LAS int* np = (LAS int*)(lds + PST_OFF);
    const unsigned* ctl = (const unsigned*)(a.ws + WS_CTL);
    __syncthreads();
    if (tid == 0) { int pm = 0; for (int e = 0; e < 32; ++e) { const int n = ((int)ctl[CW_TOT + l * 64 + e] + 255) >> 8; for (int k = 0; k < n && pm < MAXPANELS; ++k) p2e[pm++] = (unsigned char)e; } np[0] = pm; }
    __syncthreads();
    return np[0];
}

struct JRow { f32x4 x[4]; v2u y0[4], y1[4]; float g0, g1; };
__device__ __forceinline__ void j_issue(JRow& R, const float* xr, const bf16* Y, const v4u tk, int lane) {
    const unsigned gx = tk.x, gy = tk.y;
    R.g0 = __builtin_bit_cast(float, gx); R.g1 = __builtin_bit_cast(float, gy);
    const bf16* y0 = Y + (size_t)tk.z * 1024; const bf16* y1 = Y + (size_t)tk.w * 1024;
#pragma unroll
    for (int j = 0; j < 4; ++j) { const int idx = (lane + 64 * j) * 4; R.x[j] = *(const f32x4*)(xr + idx); R.y0[j] = *(const v2u*)(y0 + idx); R.y1[j] = *(const v2u*)(y1 + idx); }
}
__device__ __forceinline__ void j_finish(const JRow& R, float* xw, bf16* hrow, const float* m0, const float* m1, const float* lng, const float* lnb, int lane) {
    f32x4 v[4]; float s = 0.f;
#pragma unroll
    for (int j = 0; j < 4; ++j) { const int idx = (lane + 64 * j) * 4; const v2u w0 = R.y0[j], w1 = R.y1[j];
        const f32x4 ya = (f32x4){bflo(w0.x), bfhi(w0.x), bflo(w0.y), bfhi(w0.y)}, yb = (f32x4){bflo(w1.x), bfhi(w1.x), bflo(w1.y), bfhi(w1.y)};
        v[j] = R.x[j] * ALPHA + *(const f32x4*)(m0 + 5120 + idx) * (ya * R.g0 + yb * R.g1);
        s += (v[j].x + v[j].y) + (v[j].z + v[j].w); }
    const float mean = wave_sum(s) * (1.0f / 1024.0f); float s2 = 0.f;
#pragma unroll
    for (int j = 0; j < 4; ++j) { v[j] = v[j] - mean; s2 += (v[j].x * v[j].x + v[j].y * v[j].y) + (v[j].z * v[j].z + v[j].w * v[j].w); }
    const float rstd = 1.0f / sqrtf(wave_sum(s2) * (1.0f / 1024.0f) + LN_EPS);
#pragma unroll
    for (int j = 0; j < 4; ++j) { const int idx = (lane + 64 * j) * 4;
        const f32x4 x2 = v[j] * rstd * *(const f32x4*)(lng + idx) + *(const f32x4*)(lnb + idx);
        *(f32x4*)(xw + idx) = x2;
        if (hrow) { const f32x4 hh = x2 * (*(const f32x4*)(m1 + 1024 + idx) + 1.0f) + *(const f32x4*)(m1 + idx);
            v2u w; w.x = cvtpk(hh.x, hh.y); w.y = cvtpk(hh.z, hh.w); *(v2u*)(hrow + idx) = w; } }
}
__device__ __forceinline__ void phase_j(const Args& a, int l, int lane, int wave, bool dry = false) {
    const int gw = blockIdx.x * NWAVES + wave, NGW = gridDim.x * NWAVES, nrows = l == 0 ? NROWS : NLAT;
    const float* mod = (const float*)(a.ws + WS_MOD) + l * 9 * 6144; const float* modn = (const float*)(a.ws + WS_MOD) + 9 * 6144;
    const float* lng = a.in[22] + l * 1024; const float* lnb = a.in[23] + l * 1024;
    bf16* Hb = (bf16*)(a.ws + WS_HB); const bf16* Y = (const bf16*)(a.ws + WS_Y); const unsigned* tok = (const unsigned*)(a.ws + WS_TOK); float* xctx = (float*)(a.ws + WS_XCTX);
    for (int rowA = gw; rowA < nrows; rowA += 2 * NGW) {
        const int rowB = rowA + NGW; const bool hasB = rowB < nrows;
        const v4u tA = *(const v4u*)(tok + (size_t)rowA * 8 + 4); const v4u tB = hasB ? *(const v4u*)(tok + (size_t)rowB * 8 + 4) : tA;
        float* xrA = rowA < NLAT ? a.out + (size_t)rowA * 1024 : xctx + (size_t)(rowA - NLAT) * 1024;
        const int rB = hasB ? rowB : rowA;
        float* xrB = rB < NLAT ? a.out + (size_t)rB * 1024 : xctx + (size_t)(rB - NLAT) * 1024;
        JRow RA, RB;
        j_issue(RA, xrA, Y, tA, lane); j_issue(RB, xrB, Y, tB, lane);
        const int mA = rowA < NLAT ? (rowA >> 12) : 8, mB = rB < NLAT ? (rB >> 12) : 8;
        j_finish(RA, dry ? (float*)(a.ws + WS_HH) + (size_t)rowA * 1024 : xrA, (l == 0 && !dry) ? Hb + (size_t)rowA * 1024 : nullptr, mod + mA * 6144, modn + mA * 6144, lng, lnb, lane);
        if (hasB) j_finish(RB, dry ? (float*)(a.ws + WS_HH) + (size_t)rowB * 1024 : xrB, (l == 0 && !dry) ? Hb + (size_t)rowB * 1024 : nullptr, mod + mB * 6144, modn + mB * 6144, lng, lnb, lane);
    }
}
typedef short bf16x8 __attribute__((ext_vector_type(8)));
typedef short s16x4 __attribute__((ext_vector_type(4)));
typedef short v4i16_t __attribute__((ext_vector_type(4)));
typedef float f32x16 __attribute__((ext_vector_type(16)));
#define MFMA32(a, b, c) __builtin_amdgcn_mfma_f32_32x32x16_bf16((a), (b), (c), 0, 0, 0)
__device__ __forceinline__ int crow(int reg, int hf) { return (reg & 3) + 8 * (reg >> 2) + 4 * hf; }
__device__ __forceinline__ int tro(int r, int b) { return r * 128 + (b ^ (((r >> 1) & 1) << 6)); }
__device__ __forceinline__ int rro(int r, int c16) { return r * 128 + ((c16 ^ ((r >> 1) & 7)) << 4); }
__device__ __forceinline__ s16x4 tr4(const LAS unsigned char* p) { return __builtin_bit_cast(s16x4, __builtin_amdgcn_ds_read_tr16_b64_v4i16((LAS v4i16_t*)p)); }
__device__ __forceinline__ bf16x8 tr_frag(const LAS unsigned char* img, int rlo, int rhi, int colbyte) {
    const s16x4 lo = tr4(img + tro(rlo, colbyte)), hi = tr4(img + tro(rhi, colbyte));
    return (bf16x8){lo[0], lo[1], lo[2], lo[3], hi[0], hi[1], hi[2], hi[3]};
}

#ifndef ST_TRANSPOSED
#define ST_TRANSPOSED 1
#endif
__device__ __forceinline__ void phase_b_mfma(const Args& a, int l, LAS unsigned char* lds, int tid, int lane, int wave) {
    const bf16* P = (const bf16*)(a.ws + WS_P); float* ST = (float*)(a.ws + WS_ST);
    const int r32 = lane & 31, hf = lane >> 5, q4 = (lane & 15) >> 2, p4 = lane & 3, blk = (lane >> 4) & 1;
    for (int u = blockIdx.x; u < 8 * NCH * 4; u += gridDim.x) {
        const int b = u / (NCH * 4), c = (u % (NCH * 4)) >> 2, h0 = (u & 3) * 2; const int row0 = chunk_row0(b, c);
        __syncthreads();
#pragma unroll
        for (int k = 0; k < 4; ++k) {
            const int ci = tid + NTHR * k, hh = ci >> 10, row = (ci & 1023) >> 3, c16 = ci & 7, h = h0 + hh;
            const bf16* src = P + (size_t)(row0 + row) * INC + h * 64 + c16 * 8;
            const v4u kw = *(const v4u*)(src + OFF_K), vw = *(const v4u*)(src + OFF_V);
            LAS unsigned char* base = lds + hh * 49152;
            *(LAS v4u*)(base + tro(row, c16 * 16)) = kw;
            const float lgf = log_sigmoid_f(a.in[8][l * 8 + h]), lgb = log_sigmoid_f(a.in[9][l * 8 + h]);
            const float wf = __expf(lgf * (float)(127 - row)), wb = __expf(lgb * (float)row);
            float v[8]; unpack8(vw, v);
            v4u of, ob;
            of.x = cvtpk(v[0] * wf, v[1] * wf); of.y = cvtpk(v[2] * wf, v[3] * wf); of.z = cvtpk(v[4] * wf, v[5] * wf); of.w = cvtpk(v[6] * wf, v[7] * wf);
            ob.x = cvtpk(v[0] * wb, v[1] * wb); ob.y = cvtpk(v[2] * wb, v[3] * wb); ob.z = cvtpk(v[4] * wb, v[5] * wb); ob.w = cvtpk(v[6] * wb, v[7] * wb);
            *(LAS v4u*)(base + 16384 + tro(row, c16 * 16)) = of;
            *(LAS v4u*)(base + 32768 + tro(row, c16 * 16)) = ob;
        }
        __syncthreads();
        const int hh = wave >> 2, dir = (wave >> 1) & 1, et = wave & 1;
        const LAS unsigned char* kimg = lds + hh * 49152; const LAS unsigned char* vimg = kimg + 16384 + dir * 16384;
        f32x16 acc[2];
#pragma unroll
        for (int i = 0; i < 16; ++i) { acc[0][i] = 0.f; acc[1][i] = 0.f; }
#pragma unroll
        for (int ks = 0; ks < 8; ++ks) {
            const int rlo = 16 * ks + 8 * hf + q4;
            const bf16x8 A = tr_frag(vimg, rlo, rlo + 4, (et * 32 + 16 * blk + 4 * p4) * 2);
#pragma unroll
            for (int dt = 0; dt < 2; ++dt) { const bf16x8 B = tr_frag(kimg, rlo, rlo + 4, (dt * 32 + 16 * blk + 4 * p4) * 2); acc[dt] = MFMA32(A, B, acc[dt]); }
        }
        float* dst = ST + st_off(b, c, h0 + hh, dir);
#pragma unroll
        for (int dt = 0; dt < 2; ++dt)
#pragma unroll
            for (int r = 0; r < 16; ++r) { const int e = et * 32 + crow(r, hf), d = dt * 32 + r32;
#if ST_TRANSPOSED
                dst[e * 64 + d] = acc[dt][r];
#else
                dst[d * 64 + e] = acc[dt][r];
#endif
            }
    }
    __syncthreads();
}
__device__ __forceinline__ bf16x8 scale_frag(const bf16x8 q, float sc) {
    const v4u w = __builtin_bit_cast(v4u, q); v4u o;
    o.x = cvtpk(bflo(w.x) * sc, bfhi(w.x) * sc); o.y = cvtpk(bflo(w.y) * sc, bfhi(w.y) * sc); o.z = cvtpk(bflo(w.z) * sc, bfhi(w.z) * sc); o.w = cvtpk(bflo(w.w) * sc, bfhi(w.w) * sc);
    return __builtin_bit_cast(bf16x8, o);
}
__device__ __forceinline__ bf16x8 f32x8_to_frag(const f32x4 a0, const f32x4 a1) {
    v4u o; o.x = cvtpk(a0.x, a0.y); o.y = cvtpk(a0.z, a0.w); o.z = cvtpk(a1.x, a1.y); o.w = cvtpk(a1.z, a1.w); return __builtin_bit_cast(bf16x8, o);
}
__device__ __forceinline__ void phase_d_mfma(const Args& a, int l, LAS unsigned char* lds, int tid, int lane, int wave) {
    const bf16* P = (const bf16*)(a.ws + WS_P); const float* ST = (const float*)(a.ws + WS_ST); bf16* Y = (bf16*)(a.ws + WS_YMIX);
    const float* convw = a.in[7] + l * 3 * 256; const float* sguw = a.in[10] + (size_t)l * 4 * 128 * 128; const float* sgub = a.in[11] + l * 4 * 128;
    const int c_lo = l == 1 ? 2 : 0, cpb = NCH - c_lo, nunits = 8 * cpb;
#define LANEC int ln_ = lane; asm volatile("" : "+v"(ln_)); const int r32 = ln_ & 31, hf = ln_ >> 5, q4 = (ln_ & 15) >> 2, p4 = ln_ & 3, blk = (ln_ >> 4) & 1; (void)q4; (void)p4; (void)blk
    for (int u = blockIdx.x; u < nunits; u += gridDim.x) {
        const int b = u / cpb, c = c_lo + u % cpb; const int row0 = chunk_row0(b, c); const bool isc = c < 2;
        for (int idx = tid; idx < 128 * 32; idx += NTHR) {
            const int p = idx >> 5, ch0 = (idx & 31) * 8; const int row = row0 + p;
            int dprev = -1, dnext = 1; bool vprev, vnext;
            if (isc) { const int t = c * 128 + p; vprev = t > 0; vnext = t < 255; }
            else { const int t = (c - 2) * 128 + p;
                if (ch0 < 128) { const int col = t & 63; vprev = col > 0; vnext = col < 63; }
                else { const int rg = t >> 6; vprev = rg > 0; vnext = rg < 63; dprev = -64; dnext = 64; } }
            const bf16* pr = P + (size_t)row * INC;
            float cb[8], zc[8], zp[8], zn[8], t0[8], t1[8];
            unpack8(*(const v4u*)(pr + OFF_CB + ch0), cb);
            unpack8(*(const v4u*)(pr + OFF_CC + ch0), t0); unpack8(*(const v4u*)(pr + OFF_CX + ch0), t1);
#pragma unroll
            for (int i = 0; i < 8; ++i) { zc[i] = t0[i] * t1[i]; zp[i] = 0.f; zn[i] = 0.f; }
            if (vprev) { const bf16* q = pr + (ptrdiff_t)dprev * INC; unpack8(*(const v4u*)(q + OFF_CC + ch0), t0); unpack8(*(const v4u*)(q + OFF_CX + ch0), t1);
#pragma unroll
                for (int i = 0; i < 8; ++i) zp[i] = t0[i] * t1[i]; }
            if (vnext) { const bf16* q = pr + (ptrdiff_t)dnext * INC; unpack8(*(const v4u*)(q + OFF_CC + ch0), t0); unpack8(*(const v4u*)(q + OFF_CX + ch0), t1);
#pragma unroll
                for (int i = 0; i < 8; ++i) zn[i] = t0[i] * t1[i]; }
            float o[8];
#pragma unroll
            for (int i = 0; i < 8; ++i) o[i] = cb[i] * (convw[ch0 + i] * zp[i] + convw[256 + ch0 + i] * zc[i] + convw[512 + ch0 + i] * zn[i]);
            *(v4u*)(Y + (size_t)row * 1024 + ch0) = pack8(o);
        }
#ifndef NO_D2
#pragma unroll 1
        for (int pass = 0; pass < 2; ++pass) {
            __syncthreads();
#pragma unroll 4
            for (int k = 0; k < 16; ++k) {
                int ts_ = tid; asm volatile("" : "+v"(ts_));
                const int ci = ts_ + NTHR * k, tile = ci >> 10, hd = tile >> 1, isv = tile & 1, row = (ci & 1023) >> 3, c16 = ci & 7;
                const v4u w = *(const v4u*)(P + (size_t)(row0 + row) * INC + (isv ? OFF_V : OFF_K) + (pass * 4 + hd) * 64 + c16 * 8);
                *(LAS v4u*)(lds + hd * 32768 + isv * 16384 + (isv ? tro(row, c16 * 16) : rro(row, c16))) = w;
            }
            __syncthreads();
            LANEC;
            const int hd = wave >> 1, ih = wave & 1, h = pass * 4 + hd;
            const LAS unsigned char* kimg = lds + hd * 32768; const LAS unsigned char* vimg = kimg + 16384;
            const float lg2f = log_sigmoid_f(a.in[8][l * 8 + h]) * 1.44269504088896f, lg2b = log_sigmoid_f(a.in[9][l * 8 + h]) * 1.44269504088896f;
            bf16x8 qf[2][4];
#pragma unroll
            for (int t = 0; t < 2; ++t)
#pragma unroll
                for (int s = 0; s < 4; ++s) qf[t][s] = *(const bf16x8*)(P + (size_t)(row0 + (2 * ih + t) * 32 + r32) * INC + OFF_Q + h * 64 + 16 * s + 8 * hf);
            f32x16 acc[2][2];
#pragma unroll
            for (int t = 0; t < 2; ++t)
#pragma unroll
                for (int et = 0; et < 2; ++et)
#pragma unroll
                    for (int r = 0; r < 16; ++r) acc[t][et][r] = 0.f;
#pragma unroll
            for (int dir = 0; dir < 2; ++dir) {
                const int i0 = 2 * ih * 32 + r32;
                const float sc0 = dir == 0 ? __builtin_amdgcn_exp2f(lg2f * (float)(i0 + 1)) : __builtin_amdgcn_exp2f(lg2b * (float)(128 - i0));
                const float sc1 = dir == 0 ? __builtin_amdgcn_exp2f(lg2f * (float)(i0 + 33)) : __builtin_amdgcn_exp2f(lg2b * (float)(96 - i0));
                const float* sp = ST + st_off(b, c, h, dir) + r32 * 64 + 8 * hf;
#pragma unroll
                for (int s = 0; s < 4; ++s) {
                    const bf16x8 qs0 = scale_frag(qf[0][s], sc0), qs1 = scale_frag(qf[1][s], sc1);
#pragma unroll
                    for (int et = 0; et < 2; ++et) { const float* q = sp + et * 2048 + 16 * s;
                        const bf16x8 A = f32x8_to_frag(*(const f32x4*)q, *(const f32x4*)(q + 4));
                        acc[0][et] = MFMA32(A, qs0, acc[0][et]); acc[1][et] = MFMA32(A, qs1, acc[1][et]); }
                }
            }
#pragma unroll
            for (int t = 0; t < 2; ++t) {
                const int it = 2 * ih + t;
                bf16x8 qq[4];
                if (t == 0) {
#pragma unroll
                    for (int s = 0; s < 4; ++s) qq[s] = qf[0][s];
                } else {
                    asm volatile("" ::: "memory");
#pragma unroll
                    for (int s = 0; s < 4; ++s) qq[s] = *(const bf16x8*)(P + (size_t)(row0 + it * 32 + r32) * INC + OFF_Q + h * 64 + 16 * s + 8 * hf);
                }
#pragma unroll 1
                for (int jt = 0; jt < 4; ++jt) {
                    f32x16 X;
#pragma unroll
                    for (int r = 0; r < 16; ++r) X[r] = 0.f;
#pragma unroll
                    for (int s = 0; s < 4; ++s) { const bf16x8 Kf = *(const LAS bf16x8*)(kimg + rro(jt * 32 + r32, 2 * s + hf)); X = MFMA32(Kf, qq[s], X); }
                    const int rel0 = (it - jt) * 32 + r32 - 4 * hf;
#pragma unroll
                    for (int r = 0; r < 16; ++r) { const int rel = rel0 - ((r & 3) + 8 * (r >> 2));
                        const float x = rel > 0 ? lg2f * (float)rel : lg2b * (float)(-rel);
                        const float dcy = rel == 0 ? 2.0f : __builtin_amdgcn_exp2f(x);
                        X[r] *= dcy; }
#pragma unroll
                    for (int s2 = 0; s2 < 2; ++s2) {
                        v4u pk; pk.x = cvtpk(X[8 * s2], X[8 * s2 + 1]); pk.y = cvtpk(X[8 * s2 + 2], X[8 * s2 + 3]); pk.z = cvtpk(X[8 * s2 + 4], X[8 * s2 + 5]); pk.w = cvtpk(X[8 * s2 + 6], X[8 * s2 + 7]);
                        const bf16x8 Pk = __builtin_bit_cast(bf16x8, pk);
                        const int rlo = jt * 32 + 16 * s2 + 4 * hf + q4;
#pragma unroll
                        for (int et = 0; et < 2; ++et) { const bf16x8 Vt = tr_frag(vimg, rlo, rlo + 8, (et * 32 + 16 * blk + 4 * p4) * 2); acc[t][et] = MFMA32(Vt, Pk, acc[t][et]); }
                    }
                }
                const int row = row0 + (2 * ih + t) * 32 + r32;
                float sum = 0.f;
#pragma unroll
                for (int et = 0; et < 2; ++et)
#pragma unroll
                    for (int r = 0; r < 16; ++r) sum += acc[t][et][r];
                sum += __shfl_xor(sum, 32);
                const float mu = sum * (1.0f / 64.0f); float vs = 0.f;
#pragma unroll
                for (int et = 0; et < 2; ++et)
#pragma unroll
                    for (int r = 0; r < 16; ++r) { const float dlt = acc[t][et][r] - mu; vs += dlt * dlt; }
                vs += __shfl_xor(vs, 32);
                const float rs = 1.0f / sqrtf(vs * (1.0f / 64.0f) + LN_EPS);
#pragma unroll
                for (int et = 0; et < 2; ++et)
#pragma unroll
                    for (int g4 = 0; g4 < 4; ++g4) { const int e0 = et * 32 + 8 * g4 + 4 * hf;
                        const v2u gw = *(const v2u*)(P + (size_t)row * INC + OFF_G + h * 64 + e0);
                        const float g0 = bflo(gw.x), g1 = bfhi(gw.x), g2 = bflo(gw.y), g3 = bfhi(gw.y);
                        const float o0 = (acc[t][et][4 * g4] - mu) * rs, o1 = (acc[t][et][4 * g4 + 1] - mu) * rs, o2 = (acc[t][et][4 * g4 + 2] - mu) * rs, o3 = (acc[t][et][4 * g4 + 3] - mu) * rs;
                        v2u w; w.x = cvtpk(g0 / (1.0f + __expf(-g0)) * o0, g1 / (1.0f + __expf(-g1)) * o1); w.y = cvtpk(g2 / (1.0f + __expf(-g2)) * o2, g3 / (1.0f + __expf(-g3)) * o3);
                        *(v2u*)(Y + (size_t)row * 1024 + 256 + h * 64 + e0) = w; }
            }
        }
#endif
#ifndef NO_D3
        __syncthreads();
        {
            int tq_ = tid; asm volatile("" : "+v"(tq_));
            const int i = tq_ >> 2, part = tq_ & 3;
            const bf16* vp = P + (size_t)(row0 + i) * INC + OFF_VV + part * 64;
            float sum = 0.f;
#pragma unroll 2
            for (int q = 0; q < 8; ++q) { float t8[8]; unpack8(*(const v4u*)(vp + 8 * q), t8);
#pragma unroll
                for (int e = 0; e < 8; ++e) sum += t8[e]; }
            sum += __shfl_xor(sum, 1); sum += __shfl_xor(sum, 2);
            const float mu = sum * (1.0f / 256.0f); float vs = 0.f;
#pragma unroll 2
            for (int q = 0; q < 8; ++q) { float t8[8]; unpack8(*(const v4u*)(vp + 8 * q), t8);
#pragma unroll
                for (int e = 0; e < 8; ++e) { const float dlt = t8[e] - mu; vs += dlt * dlt; } }
            vs += __shfl_xor(vs, 1); vs += __shfl_xor(vs, 2);
            const float rs = 1.0f / sqrtf(vs * (1.0f / 256.0f) + LN_EPS);
#pragma unroll 2
            for (int q = 0; q < 8; ++q) { float t8[8]; unpack8(*(const v4u*)(vp + 8 * q), t8);
                v4u w; w.x = cvtpk((t8[0] - mu) * rs, (t8[1] - mu) * rs); w.y = cvtpk((t8[2] - mu) * rs, (t8[3] - mu) * rs); w.z = cvtpk((t8[4] - mu) * rs, (t8[5] - mu) * rs); w.w = cvtpk((t8[6] - mu) * rs, (t8[7] - mu) * rs);
                *(LAS v4u*)(lds + part * 16384 + tro(i, q * 16)) = w; }
        }
        __syncthreads();
        {
            LANEC;
            const int g = wave >> 1, ph = wave & 1;
            const LAS unsigned char* vn = lds + g * 16384;
            f32x16 acc[2][2];
#pragma unroll
            for (int ct = 0; ct < 2; ++ct)
#pragma unroll
                for (int pt = 0; pt < 2; ++pt)
#pragma unroll
                    for (int r = 0; r < 16; ++r) acc[ct][pt][r] = 0.f;
#pragma unroll 2
            for (int ks = 0; ks < 8; ++ks) {
                const int rlo = 16 * ks + 8 * hf + q4;
                bf16x8 A[2], B[2];
#pragma unroll
                for (int ct = 0; ct < 2; ++ct) A[ct] = tr_frag(vn, rlo, rlo + 4, (ct * 32 + 16 * blk + 4 * p4) * 2);
#pragma unroll
                for (int pt = 0; pt < 2; ++pt) { const float* wp = sguw + ((size_t)g * 128 + ph * 64 + pt * 32 + r32) * 128 + 16 * ks + 8 * hf; B[pt] = f32x8_to_frag(*(const f32x4*)wp, *(const f32x4*)(wp + 4)); }
#pragma unroll
                for (int ct = 0; ct < 2; ++ct)
#pragma unroll
                    for (int pt = 0; pt < 2; ++pt) acc[ct][pt] = MFMA32(A[ct], B[pt], acc[ct][pt]);
            }
#pragma unroll
            for (int pt = 0; pt < 2; ++pt) {
                const int p = ph * 64 + pt * 32 + r32; const int row = row0 + p; const float bias = sgub[g * 128 + p];
#pragma unroll
                for (int ct = 0; ct < 2; ++ct)
#pragma unroll
                    for (int g4 = 0; g4 < 4; ++g4) { const int c0 = ct * 32 + 8 * g4 + 4 * hf;
                        const v2u uw = *(const v2u*)(P + (size_t)row * INC + OFF_U + g * 64 + c0);
                        v2u w; w.x = cvtpk(bflo(uw.x) * (acc[ct][pt][4 * g4] + bias), bfhi(uw.x) * (acc[ct][pt][4 * g4 + 1] + bias));
                        w.y = cvtpk(bflo(uw.y) * (acc[ct][pt][4 * g4 + 2] + bias), bfhi(uw.y) * (acc[ct][pt][4 * g4 + 3] + bias));
                        *(v2u*)(Y + (size_t)row * 1024 + 768 + g * 64 + c0) = w; }
            }
        }
#endif
        __syncthreads();
    }
}
constexpr int LCNT_OFF = LDSCTL_OFF + 4096, LG_OFF = LDSCTL_OFF + 4352;
__device__ __forceinline__ void phase_f2(const Args& a, int l, LAS unsigned char* lds, int tid, int lane, int wave) {
    LAS int* lcnt = (LAS int*)(lds + LCNT_OFF); LAS float* LG = (LAS float*)(lds + LG_OFF);
    LAS unsigned char* HI = lds; LAS unsigned char* LO = lds + 65536; LAS float* PART = (LAS float*)lds;
    const int r32 = lane & 31, hf = lane >> 5;
    const int nrows = l == 0 ? NROWS : NLAT, ntiles = nrows >> 5;
    const float* mod = (const float*)(a.ws + WS_MOD) + l * 9 * 6144;
    const float* lng = a.in[13] + l * 1024; const float* lnb = a.in[14] + l * 1024;
    const float* rgb = a.in[16] + l * 4; const float* reb = a.in[18] + l * 32;
    bf16* Hb = (bf16*)(a.ws + WS_HB); unsigned* tok = (unsigned*)(a.ws + WS_TOK); float* xctx = (float*)(a.ws + WS_XCTX);
    const bf16* wr = (const bf16*)(a.ws + WS_WR) + (size_t)l * 2 * 64 * 1024;
    bf16x8 Bh[8][2], Bl[8][2];
#pragma unroll
    for (int ks = 0; ks < 8; ++ks)
#pragma unroll
        for (int ct = 0; ct < 2; ++ct) { const bf16* p = wr + (size_t)(ct * 32 + r32) * 1024 + wave * 128 + 16 * ks + 8 * hf; Bh[ks][ct] = *(const bf16x8*)p; Bl[ks][ct] = *(const bf16x8*)(p + 64 * 1024); }
    __syncthreads();
    if (tid < 32) lcnt[tid] = 0;
    __syncthreads();
    for (int T = blockIdx.x; T < ntiles; T += gridDim.x) {
#pragma unroll 1
        for (int rh = 0; rh < 2; ++rh) {
        f32x4 vv[2][4];
#pragma unroll
        for (int rq = 0; rq < 2; ++rq) { const int row = 32 * T + 4 * wave + 2 * rh + rq;
            const float* xr = row < NLAT ? a.out + (size_t)row * 1024 : xctx + (size_t)(row - NLAT) * 1024;
#pragma unroll
            for (int j = 0; j < 4; ++j) vv[rq][j] = *(const f32x4*)(xr + (lane + 64 * j) * 4); }
#pragma unroll
        for (int rq = 0; rq < 2; ++rq) {
            const int lr = 4 * wave + 2 * rh + rq, row = 32 * T + lr;
            float* xr = row < NLAT ? a.out + (size_t)row * 1024 : xctx + (size_t)(row - NLAT) * 1024;
            const float* m0 = mod + (row < NLAT ? (row >> 12) : 8) * 6144;
            f32x4 v[4]; float s = 0.f;
#pragma unroll
            for (int j = 0; j < 4; ++j) { v[j] = vv[rq][j]; s += (v[j].x + v[j].y) + (v[j].z + v[j].w); }
            const float mean = wave_sum(s) * (1.0f / 1024.0f); float s2 = 0.f;
#pragma unroll
            for (int j = 0; j < 4; ++j) { v[j] = v[j] - mean; s2 += (v[j].x * v[j].x + v[j].y * v[j].y) + (v[j].z * v[j].z + v[j].w * v[j].w); }
            const float rstd = 1.0f / sqrtf(wave_sum(s2) * (1.0f / 1024.0f) + LN_EPS);
#pragma unroll
            for (int j = 0; j < 4; ++j) { const int idx = (lane + 64 * j) * 4;
                const f32x4 x1 = v[j] * rstd * *(const f32x4*)(lng + idx) + *(const f32x4*)(lnb + idx);
                *(f32x4*)(xr + idx) = x1;
                const f32x4 hm = x1 * (*(const f32x4*)(m0 + 4096 + idx) + 1.0f) + *(const f32x4*)(m0 + 3072 + idx);
                v2u h; h.x = cvtpk(hm.x, hm.y); h.y = cvtpk(hm.z, hm.w);
                v2u lo; lo.x = cvtpk(hm.x - bflo(h.x), hm.y - bfhi(h.x)); lo.y = cvtpk(hm.z - bflo(h.y), hm.w - bfhi(h.y));
                *(v2u*)(Hb + (size_t)row * 1024 + idx) = h;
                const int off = lr * 2048 + (((((lane + 64 * j) >> 1)) ^ (lr & 15)) << 4) + (lane & 1) * 8;
                *(LAS v2u*)(HI + off) = h; *(LAS v2u*)(LO + off) = lo; }
        }
        }
        __syncthreads();
        f32x16 acc[2];
#pragma unroll
        for (int r = 0; r < 16; ++r) { acc[0][r] = 0.f; acc[1][r] = 0.f; }
#pragma unroll
        for (int ks = 0; ks < 8; ++ks) { const int off = r32 * 2048 + (((wave * 16 + 2 * ks + hf) ^ (r32 & 15)) << 4);
            const bf16x8 Ah = *(const LAS bf16x8*)(HI + off), Al = *(const LAS bf16x8*)(LO + off);
#pragma unroll
            for (int ct = 0; ct < 2; ++ct) { acc[ct] = MFMA32(Ah, Bh[ks][ct], acc[ct]); acc[ct] = MFMA32(Ah, Bl[ks][ct], acc[ct]); acc[ct] = MFMA32(Al, Bh[ks][ct], acc[ct]); } }
        __syncthreads();
#pragma unroll
        for (int ct = 0; ct < 2; ++ct)
#pragma unroll
            for (int r = 0; r < 16; ++r) PART[(wave * 32 + crow(r, hf)) * 64 + ct * 32 + r32] = acc[ct][r];
        __syncthreads();
        { const int row = tid >> 4, cg = tid & 15;
#pragma unroll
          for (int q = 0; q < 3; ++q) { const int col = cg + 16 * q; if (col < 36) { float sum = 0.f;
#pragma unroll
                  for (int w = 0; w < 8; ++w) sum += PART[(w * 32 + row) * 64 + col];
                  LG[row * 40 + col] = sum; } } }
        __syncthreads();
        if (tid < 32) { const int row = 32 * T + tid; const LAS float* lgp = LG + tid * 40;
            float lg[4];
#pragma unroll
            for (int g = 0; g < 4; ++g) lg[g] = lgp[g] + rgb[g];
            int gi = 0; float gm = lg[0];
#pragma unroll
            for (int g = 1; g < 4; ++g) if (lg[g] > gm) { gm = lg[g]; gi = g; }
            float gden = 0.f;
#pragma unroll
            for (int g = 0; g < 4; ++g) gden += expf(lg[g] - gm);
            const float gprob = 1.0f / gden;
            float le[8];
#pragma unroll
            for (int e = 0; e < 8; ++e) le[e] = lgp[4 + gi * 8 + e] + reb[gi * 8 + e];
            int i1 = 0; float m1 = le[0];
#pragma unroll
            for (int e = 1; e < 8; ++e) if (le[e] > m1) { m1 = le[e]; i1 = e; }
            int i2 = -1; float m2 = -3.0e38f;
#pragma unroll
            for (int e = 0; e < 8; ++e) if (e != i1 && le[e] > m2) { m2 = le[e]; i2 = e; }
            const float p2 = expf(m2 - m1), inv = 1.0f / (1.0f + p2);
            const float gate0 = gprob * inv, gate1 = gprob * p2 * inv;
            const int e0 = gi * 8 + i1, e1 = gi * 8 + i2;
            const int p0 = __hip_atomic_fetch_add(lcnt + e0, 1, __ATOMIC_RELAXED, __HIP_MEMORY_SCOPE_WORKGROUP);
            const int p1 = __hip_atomic_fetch_add(lcnt + e1, 1, __ATOMIC_RELAXED, __HIP_MEMORY_SCOPE_WORKGROUP);
            unsigned* t = tok + (size_t)row * 8; t[0] = (unsigned)e0 | ((unsigned)e1 << 8); t[1] = (unsigned)p0; t[2] = (unsigned)p1;
            t[4] = __builtin_bit_cast(unsigned, gate0); t[5] = __builtin_bit_cast(unsigned, gate1); }
    }
    __syncthreads();
    if (tid < 32) ((unsigned*)(a.ws + WS_CTL))[CW_WGCNT + (l * 256 + blockIdx.x) * 32 + tid] = (unsigned)lcnt[tid];
    __syncthreads();
}
#ifndef MK_PER_PHASE
#define MK_PER_PHASE 0
#endif
constexpr int N_PHASES = 22;

__global__ void __launch_bounds__(NTHR, 2) hybrid_fwd(Args args) {
    extern __shared__ __attribute__((aligned(16))) unsigned char lds_raw[];
    LAS unsigned char* lds = (LAS unsigned char*)lds_raw;
    const int tid0 = threadIdx.x;
    for (int u = tid0; u < (LDS_BYTES - LDSCTL_OFF) / 4; u += NTHR) ((LAS unsigned*)(lds + LDSCTL_OFF))[u] = 0u;
#define TIDS int tid = threadIdx.x; asm volatile("" : "+v"(tid)); const int lane = tid & 63, wave = __builtin_amdgcn_readfirstlane(tid >> 6); (void)lane; (void)wave
    __syncthreads();
    unsigned* ctl = (unsigned*)(args.ws + WS_CTL);
    XcdBarrier bar; bar.bar = ctl + CW_BAR; bar.x = 0; bar.st = nullptr;
    if (!MK_PER_PHASE) bar = xcd_barrier_post(ctl + CW_BAR, (volatile LAS unsigned*)(lds + MISC_OFF + 32));
    const int lo = args.ph_lo, hi = args.ph_hi;
#ifndef PHMASK
#define PHMASK 0xFFFFFFu
#endif
#define PHON(k) (((PHMASK) >> ((k) < 2 ? (k) : 2 + ((k) - 2) % 10)) & 1u)
#define IN(k) (PHON(k) && lo <= (k) && (k) < hi)
#ifndef REPMASK
#define REPMASK 0u
#endif
#define NREP(k) (1 + (int)(((REPMASK) >> ((k) < 2 ? (k) : 2 + ((k) - 2) % 10)) & 1u))
#define SEAM(k) do { if (IN(k) && IN((k) + 1)) xcd_barrier(bar); } while (0)

    if (IN(0)) for (int rep = 0; rep < NREP(0); ++rep) { TIDS; phase_p0(args, lds, tid, lane, wave); }
    SEAM(0);
    if (IN(1)) for (int rep = 0; rep < NREP(1); ++rep) { TIDS; phase_p1(args, lane, wave); }
    SEAM(1);
    for (int l = 0; l < 2; ++l) {
        const int pb = 2 + 10 * l;
        bf16* Hb = (bf16*)(args.ws + WS_HB);
        if (IN(pb + 0)) for (int rep = 0; rep < NREP(2); ++rep) {
            pg8::Gemm g{Hb, (const bf16*)(args.ws + WS_WIN) + (size_t)l * INC * 1024, NROWS, INC, 1024}; pg8::StaticOrder S; S.init(NROWS, INC, (int)gridDim.x, (int)blockIdx.x);
            pg8::EpiBf16<0> E{(bf16*)(args.ws + WS_P), INC, nullptr, 0, 0, 1.0f};
            pg8::gemm_phase<pg8::EpiBf16<0>, pg8::StaticOrder, true, true>(lds, g, S, E);
        }
        SEAM(pb + 0);
        if (IN(pb + 1)) for (int rep = 0; rep < NREP(3); ++rep) { TIDS; phase_b_mfma(args, l, lds, tid, lane, wave); }
        SEAM(pb + 1);
        if (IN(pb + 2)) { if (NREP(4) > 1) { TIDS; phase_c(args, l, tid, true); } TIDS; phase_c(args, l, tid); }
        SEAM(pb + 2);
        if (IN(pb + 3)) for (int rep = 0; rep < NREP(5); ++rep) { TIDS; phase_d_mfma(args, l, lds, tid, lane, wave); }
        SEAM(pb + 3);
        if (IN(pb + 4)) for (int rep = 0; rep < (l == 0 ? NREP(6) : 1); ++rep) {
            const int M = l == 0 ? NROWS : NLAT;
            pg8::Gemm g{(const bf16*)(args.ws + WS_YMIX), (const bf16*)(args.ws + WS_WOUT) + (size_t)l * 1024 * 1024, M, 1024, 1024}; pg8::StaticOrder S; S.init(M, 1024, (int)gridDim.x, (int)blockIdx.x);
            float* xctx = (float*)(args.ws + WS_XCTX);
            pg8::EpiResid E{l == 0 ? args.in[0] : args.out, l == 0 ? args.in[2] : xctx, args.out, xctx, (const float*)(args.ws + WS_MOD) + l * 9 * 6144, ALPHA};
            pg8::gemm_phase<pg8::EpiResid, pg8::StaticOrder, true, true>(lds, g, S, E);
        }
        SEAM(pb + 4);
        if (IN(pb + 5)) { TIDS; phase_f2(args, l, lds, tid, lane, wave); }
        SEAM(pb + 5);
        if (IN(pb + 6)) for (int rep = 0; rep < NREP(8); ++rep) { TIDS; phase_g(args, l, lds, tid, lane, wave); }
        SEAM(pb + 6);
        if (IN(pb + 7)) for (int rep = 0; rep < NREP(9); ++rep) {
            int npan; { TIDS; npan = build_p2e(args, l, lds, tid); }
            pg8::Gemm g{(const bf16*)(args.ws + WS_XB), (const bf16*)(args.ws + WS_WGU) + (size_t)l * 32 * 1024 * 1024, npan * 256, 1024, 1024};
            pg8::MoeOrder S{(const LAS unsigned char*)(lds + P2E_OFF), npan * 4, (int)gridDim.x, (int)blockIdx.x};
            pg8::EpiGLU E{(bf16*)(args.ws + WS_HH)};
            pg8::gemm_phase<pg8::EpiGLU, pg8::MoeOrder, true, true>(lds, g, S, E);
        }
        SEAM(pb + 7);
        if (IN(pb + 8)) for (int rep = 0; rep < NREP(10); ++rep) {
            int npan; { TIDS; npan = build_p2e(args, l, lds, tid); }
            pg8::Gemm g{(const bf16*)(args.ws + WS_HH), (const bf16*)(args.ws + WS_WD) + (size_t)l * 32 * 1024 * 512, npan * 256, 1024, 512};
            pg8::MoeOrder S{(const LAS unsigned char*)(lds + P2E_OFF), npan * 4, (int)gridDim.x, (int)blockIdx.x};
            pg8::EpiY E{(bf16*)(args.ws + WS_Y)};
            pg8::gemm_phase<pg8::EpiY, pg8::MoeOrder, true, true>(lds, g, S, E);
        }
        SEAM(pb + 8);
        if (IN(pb + 9)) { if (NREP(11) > 1) { TIDS; phase_j(args, l, lane, wave, true); } TIDS; phase_j(args, l, lane, wave); }
        SEAM(pb + 9);
    }
#undef IN
#undef SEAM
}

extern "C" void kernel_launch(void* const* d_in, const int* in_sizes, int n_in, void* d_out, int out_size, void* d_ws, size_t ws_size, hipStream_t stream) {
    static int grid = 0;
    if (grid == 0) {
        if (n_in != 24 || in_sizes[0] != NLAT * DM || out_size != NLAT * DM || ws_size < WS_END) { fprintf(stderr, "kernel_launch: unexpected problem (n_in %d, ws %zu < %zu?)\n", n_in, ws_size, (size_t)WS_END); grid = -1; return; }
        int dev = 0, cus = 0, per_cu = 0;
        if (hipGetDevice(&dev) != hipSuccess || hipDeviceGetAttribute(&cus, hipDeviceAttributeMultiprocessorCount, dev) != hipSuccess) { grid = -1; return; }
        if (hipFuncSetAttribute((const void*)hybrid_fwd, hipFuncAttributeMaxDynamicSharedMemorySize, LDS_BYTES) != hipSuccess) { grid = -1; return; }
        if (hipOccupancyMaxActiveBlocksPerMultiprocessor(&per_cu, (const void*)hybrid_fwd, NTHR, LDS_BYTES) != hipSuccess || per_cu < 1) { fprintf(stderr, "kernel_launch: occupancy query says %d\n", per_cu); }
        (void)hipGetLastError();
        grid = cus;
        if (grid != 256) { fprintf(stderr, "kernel_launch: built for 256 CUs, device has %d\n", cus); grid = -1; return; }
    }
    if (grid < 0) return;
    if (hipMemsetAsync((char*)d_ws + WS_CTL, 0, CTL_ZERO_BYTES, stream) != hipSuccess) return;
    Args a{};
    for (int i = 0; i < 24; ++i) a.in[i] = (const float*)d_in[i];
    a.out = (float*)d_out; a.ws = (unsigned char*)d_ws;
#if MK_PER_PHASE
    for (int p = 0; p < N_PHASES; ++p) { a.ph_lo = p; a.ph_hi = p + 1; hipLaunchKernelGGL(hybrid_fwd, dim3(grid), dim3(NTHR), LDS_BYTES, stream, a); }
#else
    a.ph_lo = 0; a.ph_hi = N_PHASES;
    hipLaunchKernelGGL(hybrid_fwd, dim3(grid), dim3(NTHR), LDS_BYTES, stream, a);
#endif
}
```

```cpp
#include <hip/hip_runtime.h>
#include <cstdio>
#include <cstdint>
#include <cstddef>
namespace pg8 {
#define PG8_LAS __attribute__((address_space(3)))
typedef unsigned short bf16_t;
typedef short bf16x8 __attribute__((ext_vector_type(8)));
typedef float f32x4 __attribute__((ext_vector_type(4)));
typedef unsigned u32x4 __attribute__((ext_vector_type(4)));
constexpr int BM = 256, BK = 64, HALF = 128, HTB = HALF * BK * 2  , STAGE_BYTES = 8 * HTB, NXCD = 8, WGM = 8;

__host__ __device__ __forceinline__ int lds_byte(int r, int c) { const int st = (r >> 4) * 2 + (c >> 5), rr = r & 15, cc = c & 31, ob = rr * 64 + cc * 2; return st * 1024 + (ob ^ (((ob >> 9) & 1) << 5)); }
__host__ __device__ __forceinline__ void stage_rc(int b, int& R, int& C) { const int st = b / 1024, sb = b % 1024, swz = sb ^ (((sb >> 9) & 1) << 5); R = (st >> 1) * 16 + swz / 64; C = (st & 1) * 32 + (swz % 64) / 2; }
__host__ __device__ __forceinline__ int perm32(int rho) { const int n = rho >> 4, i = rho & 15; return 8 * (i >> 2) + 4 * n + (i & 3); }

struct Unit { int pm, pn; };
struct Gemm { const bf16_t* A; const bf16_t* Bt; int M, N, K; };

struct StaticOrder {
    int nM, nN, nwg, G, c;
    __host__ __device__ void init(int M, int N, int G_, int c_) { nM = M / BM; nN = N / BM; nwg = nM * nN; G = G_; c = c_; }
    __host__ __device__ bool next(int i, Unit& u) const {
        const long L = (long)i * G + c; if (L >= nwg) return false;
        int wgid = (int)L; { const int q = nwg / NXCD, r = nwg % NXCD, xcd = wgid % NXCD, off = wgid / NXCD; wgid = (xcd < r ? xcd * (q + 1) : r * (q + 1) + (xcd - r) * q) + off; }
        const int nig = WGM * nN, gid = wgid / nig, fm = gid * WGM, gsz = (nM - fm) < WGM ? (nM - fm) : WGM;
        u.pm = fm + ((wgid % nig) % gsz); u.pn = (wgid % nig) / gsz; return true;
    }
    __device__ __forceinline__ void a_ready(const Unit&) const {}
    __device__ __forceinline__ void done(const Unit&) const {}
};

__device__ __forceinline__ unsigned cvt_pk_bf16(float lo, float hi) { unsigned r; asm volatile("v_cvt_pk_bf16_f32 %0, %1, %2" : "=v"(r) : "v"(lo), "v"(hi)); return r; }
typedef float f32x2 __attribute__((ext_vector_type(2)));
__device__ __forceinline__ f32x2 gelu_pk(f32x2 v) {
    const f32x2 av = __builtin_elementwise_abs(v), d = av * 0.2316418882f + 1.0f;
    f32x2 t; t.x = __builtin_amdgcn_rcpf(d.x); t.y = __builtin_amdgcn_rcpf(d.y);
    f32x2 q = t * 0.5307027145f + (-0.7265760135f); q = q * t + 0.7107068705f; q = q * t + (-0.142248368f); q = q * t + 0.127414796f; q = q * t;
    const f32x2 s = (v * v) * (-0.72134752044f);
    f32x2 e; e.x = __builtin_amdgcn_exp2f(s.x); e.y = __builtin_amdgcn_exp2f(s.y);
    const f32x2 m = v * (q * e), r = v - m;
    f32x2 o; o.x = v.x < 0.f ? m.x : r.x; o.y = v.y < 0.f ? m.y : r.y; return o;
}

template <int ACT  > struct EpiBf16 {
    static constexpr bool PERM = true, AFTER_DRAIN = false; static_assert(ACT == 0 || ACT == 1, "EpiBf16: ACT is 0 (none) or 1 (gelu_pk)");
    bf16_t* O; int ldc; const float* bias; int split_cols; size_t split_stride; float scale0;
    __device__ __forceinline__ void operator()(const f32x4 (&acc)[2][2][4][2], const Unit& u, int wr, int wc, int fr, int fq) const {
        const int row0 = u.pm * BM + wr * 64 + fr; int colt = u.pn * BM; bf16_t* base = O;
        float sc = 1.f; if (split_cols) { const int t = colt / split_cols; base += (size_t)t * split_stride; colt -= t * split_cols; if (t == 0) sc = scale0; }
        const int col0 = colt + wc * 32 + 8 * fq, bcol0 = u.pn * BM + wc * 32 + 8 * fq;
        f32x4 bv[2][2];
#pragma unroll
        for (int bj = 0; bj < 2; ++bj)
#pragma unroll
            for (int n = 0; n < 2; ++n) bv[bj][n] = bias ? *(const f32x4*)(bias + bcol0 + bj * HALF + 4 * n) : (f32x4){0.f, 0.f, 0.f, 0.f};
#pragma unroll
        for (int ai = 0; ai < 2; ++ai)
#pragma unroll
            for (int m = 0; m < 4; ++m) { bf16_t* rowp = base + (size_t)(row0 + ai * HALF + m * 16) * ldc + col0;
#pragma unroll
                for (int bj = 0; bj < 2; ++bj) { f32x4 v0 = acc[ai][bj][m][0] + bv[bj][0], v1 = acc[ai][bj][m][1] + bv[bj][1];
                    if (ACT == 1) { f32x2 a = gelu_pk((f32x2){v0[0], v0[1]}), b = gelu_pk((f32x2){v0[2], v0[3]}), c = gelu_pk((f32x2){v1[0], v1[1]}), d = gelu_pk((f32x2){v1[2], v1[3]});
                        v0 = (f32x4){a.x, a.y, b.x, b.y}; v1 = (f32x4){c.x, c.y, d.x, d.y}; }
                    v0 = v0 * sc; v1 = v1 * sc; u32x4 w; w.x = cvt_pk_bf16(v0[0], v0[1]); w.y = cvt_pk_bf16(v0[2], v0[3]); w.z = cvt_pk_bf16(v1[0], v1[1]); w.w = cvt_pk_bf16(v1[2], v1[3]);
                    *(u32x4*)(rowp + bj * HALF) = w; } }
    }
};
__device__ __forceinline__ float silu_f(float x) { return x / (1.0f + __expf(-x)); }
struct EpiResid {
    static constexpr bool PERM = false, AFTER_DRAIN = false;
    const float* xin_lat; const float* xin_ctx; float* xo_lat; float* xo_ctx; const float* mod; float alpha;
    __device__ __forceinline__ void operator()(const f32x4 (&acc)[2][2][4][2], const Unit& u, int wr, int wc, int fr, int fq) const {
        const int prow0 = u.pm * BM; const bool isc = prow0 >= 32768;
        const float* xin = isc ? xin_ctx + (size_t)(prow0 - 32768) * 1024 : xin_lat + (size_t)prow0 * 1024;
        float* xo = isc ? xo_ctx + (size_t)(prow0 - 32768) * 1024 : xo_lat + (size_t)prow0 * 1024;
        const float* g1 = mod + (isc ? 8 : (prow0 >> 12)) * 6144 + 2048;
        const int col0 = u.pn * BM + wc * 32 + 4 * fq;
        f32x4 gv[2][2];
#pragma unroll
        for (int bj = 0; bj < 2; ++bj)
#pragma unroll
            for (int n = 0; n < 2; ++n) gv[bj][n] = *(const f32x4*)(g1 + col0 + bj * HALF + n * 16);
#pragma unroll
        for (int ai = 0; ai < 2; ++ai)
#pragma unroll
            for (int m = 0; m < 4; ++m) { const size_t off = (size_t)(ai * HALF + wr * 64 + m * 16 + fr) * 1024 + col0;
#pragma unroll
                for (int bj = 0; bj < 2; ++bj)
#pragma unroll
                    for (int n = 0; n < 2; ++n) { const f32x4 xv = *(const f32x4*)(xin + off + bj * HALF + n * 16);
                        *(f32x4*)(xo + off + bj * HALF + n * 16) = xv * alpha + gv[bj][n] * acc[ai][bj][m][n]; }
                if (m & 1) asm volatile("" ::: "memory"); }
    }
};
struct EpiGLU {
    static constexpr bool PERM = true, AFTER_DRAIN = false;
    bf16_t* Hh;
    __device__ __forceinline__ void operator()(const f32x4 (&acc)[2][2][4][2], const Unit& u, int wr, int wc, int fr, int fq) const {
        const int row0 = u.pm * BM + wr * 64 + fr; const int col0 = (u.pn & 3) * 128 + wc * 32 + 8 * fq;
#pragma unroll
        for (int ai = 0; ai < 2; ++ai)
#pragma unroll
            for (int m = 0; m < 4; ++m) { bf16_t* rowp = Hh + (size_t)(row0 + ai * HALF + m * 16) * 512 + col0;
                const f32x4 g0 = acc[ai][0][m][0], g1 = acc[ai][0][m][1], u0 = acc[ai][1][m][0], u1 = acc[ai][1][m][1];
                u32x4 w; w.x = cvt_pk_bf16(silu_f(g0[0]) * u0[0], silu_f(g0[1]) * u0[1]); w.y = cvt_pk_bf16(silu_f(g0[2]) * u0[2], silu_f(g0[3]) * u0[3]);
                w.z = cvt_pk_bf16(silu_f(g1[0]) * u1[0], silu_f(g1[1]) * u1[1]); w.w = cvt_pk_bf16(silu_f(g1[2]) * u1[2], silu_f(g1[3]) * u1[3]);
                *(u32x4*)rowp = w; }
    }
};
struct EpiY {
    static constexpr bool PERM = true, AFTER_DRAIN = false;
    bf16_t* O;
    __device__ __forceinline__ void operator()(const f32x4 (&acc)[2][2][4][2], const Unit& u, int wr, int wc, int fr, int fq) const {
        const int row0 = u.pm * BM + wr * 64 + fr; const int col0 = (u.pn & 3) * BM + wc * 32 + 8 * fq;
#pragma unroll
        for (int ai = 0; ai < 2; ++ai)
#pragma unroll
            for (int m = 0; m < 4; ++m) { bf16_t* rowp = O + (size_t)(row0 + ai * HALF + m * 16) * 1024 + col0;
#pragma unroll
                for (int bj = 0; bj < 2; ++bj) { const f32x4 v0 = acc[ai][bj][m][0], v1 = acc[ai][bj][m][1];
                    u32x4 w; w.x = cvt_pk_bf16(v0[0], v0[1]); w.y = cvt_pk_bf16(v0[2], v0[3]); w.z = cvt_pk_bf16(v1[0], v1[1]); w.w = cvt_pk_bf16(v1[2], v1[3]);
                    *(u32x4*)(rowp + bj * HALF) = w; } }
    }
};
struct MoeOrder {
    const PG8_LAS unsigned char* p2e; int nunits, G, c;
    __device__ __forceinline__ bool next(int i, Unit& u) const {
        const int L = i * G + c; if (L >= nunits) return false;
        u.pm = L >> 2; u.pn = (int)p2e[L >> 2] * 4 + (L & 3); return true;
    }
    __device__ __forceinline__ void a_ready(const Unit&) const {}
    __device__ __forceinline__ void done(const Unit&) const {}
};
template <class Epi, class Sched, bool ALIGN_EPI = false, bool SP2 = false>
__device__ __forceinline__ void gemm_phase(PG8_LAS unsigned char* lds, const Gemm g, const Sched& S, const Epi& E) {
    int tid_ = threadIdx.x; asm volatile("" : "+v"(tid_));
    const int tid = tid_, wid = __builtin_amdgcn_readfirstlane(tid >> 6), lane = tid & 63, wr = wid >> 2, wc = wid & 3, fr = lane & 15, fq = lane >> 4;
    const int K = g.K, nt = K / BK;
    unsigned voffA[2], voffB[2];
#pragma unroll
    for (int i = 0; i < 2; ++i) { int R, C; stage_rc(tid * 16 + i * 8192, R, C); const int Rb = Epi::PERM ? ((R & ~31) + perm32(R & 31)) : R;
        voffA[i] = (unsigned)(R * K + C) * 2u; voffB[i] = (unsigned)(Rb * K + C) * 2u; }
    const size_t kstep = (size_t)(BK * 2);
    const size_t hstep = (size_t)HALF * K * 2;
    const size_t tstep = 2 * hstep;
    const unsigned ldsw = (unsigned)wid * 1024u;
    const int aoff = lds_byte(wr * 64 + fr, fq * 8), boff = lds_byte(wc * 32 + fr, fq * 8);
#define PG8_SA(b, h) (((b) * 2 + (h)) * HTB)
#define PG8_SB(b, h) ((4 + (b) * 2 + (h)) * HTB)
#define PG8_STAGE(bufoff, gbase, voff) do { _Pragma("unroll") for (int _i = 0; _i < 2; ++_i) \
        __builtin_amdgcn_global_load_lds((const unsigned*)((const char*)(gbase) + (voff)[_i]), (PG8_LAS unsigned*)(lds + (bufoff) + ldsw + _i * 8192), 16, 0, 0); } while (0)
#define PG8_LDA(dst, b, h) do { _Pragma("unroll") for (int m = 0; m < 4; ++m) _Pragma("unroll") for (int k = 0; k < 2; ++k) dst[m][k] = *(const PG8_LAS bf16x8*)(lds + PG8_SA(b, h) + aoff + m * 2048 + k * 1024); } while (0)
#define PG8_LDB(dst, b, h) do { _Pragma("unroll") for (int n = 0; n < 2; ++n) _Pragma("unroll") for (int k = 0; k < 2; ++k) dst[n][k] = *(const PG8_LAS bf16x8*)(lds + PG8_SB(b, h) + boff + n * 2048 + k * 1024); } while (0)
#define PG8_MMA(ai, bj, At, Bt) do { __builtin_amdgcn_s_setprio(1); _Pragma("unroll") for (int m = 0; m < 4; ++m) _Pragma("unroll") for (int n = 0; n < 2; ++n) _Pragma("unroll") for (int k = 0; k < 2; ++k) \
        acc[ai][bj][m][n] = __builtin_amdgcn_mfma_f32_16x16x32_bf16(Bt[n][k], At[m][k], acc[ai][bj][m][n], 0, 0, 0); __builtin_amdgcn_s_setprio(0); } while (0)
#define PG8_WAIT_V(n) asm volatile("s_waitcnt vmcnt(" #n ")" ::: "memory")
#define PG8_WAIT_L(n) asm volatile("s_waitcnt lgkmcnt(" #n ")" ::: "memory")
#define PG8_BAR __builtin_amdgcn_s_barrier()
#define PG8_SCHED __builtin_amdgcn_sched_barrier(0)
    Unit cur, nxt; int ui = 0;
    if (!S.next(0, cur)) return;
    f32x4 acc[2][2][4][2];
#pragma unroll
    for (int a = 0; a < 2; ++a)
#pragma unroll
        for (int b = 0; b < 2; ++b)
#pragma unroll
            for (int m = 0; m < 4; ++m)
#pragma unroll
                for (int n = 0; n < 2; ++n) acc[a][b][m][n] = (f32x4){0.f, 0.f, 0.f, 0.f};
    bf16x8 At[4][2], B0[2][2], B1[2][2];
    const char* cA = (const char*)g.A + (size_t)cur.pm * tstep; const char* cB = (const char*)g.Bt + (size_t)cur.pn * tstep;
    S.a_ready(cur);
    if constexpr (SP2) {
        PG8_STAGE(PG8_SB(0, 0), cB, voffB); PG8_STAGE(PG8_SB(0, 1), cB + hstep, voffB); PG8_STAGE(PG8_SA(0, 0), cA, voffA); PG8_STAGE(PG8_SA(0, 1), cA + hstep, voffA);
        if (wr == 1) PG8_BAR;
        PG8_WAIT_V(2); PG8_BAR;
        PG8_STAGE(PG8_SB(1, 0), cB + kstep, voffB); PG8_STAGE(PG8_SA(1, 0), cA + kstep, voffA); PG8_STAGE(PG8_SB(1, 1), cB + hstep + kstep, voffB);
        PG8_WAIT_V(6); PG8_BAR;
    } else {
        PG8_STAGE(PG8_SB(0, 0), cB, voffB); PG8_STAGE(PG8_SA(0, 0), cA, voffA); PG8_STAGE(PG8_SB(0, 1), cB + hstep, voffB); PG8_STAGE(PG8_SA(0, 1), cA + hstep, voffA);
        if (wr == 1) PG8_BAR;
        PG8_WAIT_V(4); PG8_BAR;
        PG8_STAGE(PG8_SB(1, 0), cB + kstep, voffB); PG8_STAGE(PG8_SA(1, 0), cA + kstep, voffA); PG8_STAGE(PG8_SB(1, 1), cB + hstep + kstep, voffB);
        PG8_WAIT_V(6); PG8_BAR;
    }
    for (;;) {
        const bool has_next = S.next(ui + 1, nxt);
        const char* nA = has_next ? (const char*)g.A + (size_t)nxt.pm * tstep : cA; const char* nB = has_next ? (const char*)g.Bt + (size_t)nxt.pn * tstep : cB;
        for (int t = 0; t < nt; t += 2) {
            const bool last = (t == nt - 2);
            const char* a1 = cA + (size_t)(t + 1) * kstep;
            const char* a2 = last ? nA : cA + (size_t)(t + 2) * kstep; const char* b2 = last ? nB : cB + (size_t)(t + 2) * kstep;
            const char* a3 = a2 + kstep; const char* b3 = b2 + kstep;
            if (last && has_next) S.a_ready(nxt);
            if constexpr (SP2) {
            PG8_LDB(B0, 0, 0); PG8_LDB(B1, 0, 1); PG8_SCHED; PG8_LDA(At, 0, 0); PG8_STAGE(PG8_SA(1, 1), a1 + hstep, voffA);
            PG8_WAIT_V(8); PG8_WAIT_L(0); PG8_BAR; PG8_MMA(0, 0, At, B0); PG8_MMA(0, 1, At, B1); PG8_BAR; PG8_SCHED;
            PG8_LDA(At, 0, 1); PG8_STAGE(PG8_SB(0, 0), b2, voffB); PG8_STAGE(PG8_SB(0, 1), b2 + hstep, voffB); PG8_STAGE(PG8_SA(0, 0), a2, voffA);
            PG8_WAIT_V(8); PG8_WAIT_L(0); PG8_BAR; PG8_MMA(1, 0, At, B0); PG8_MMA(1, 1, At, B1); PG8_BAR; PG8_SCHED;
            PG8_LDB(B0, 1, 0); PG8_LDB(B1, 1, 1); PG8_SCHED; PG8_LDA(At, 1, 0); PG8_STAGE(PG8_SA(0, 1), a2 + hstep, voffA);
            PG8_WAIT_V(8); PG8_WAIT_L(0); PG8_BAR; PG8_MMA(0, 0, At, B0); PG8_MMA(0, 1, At, B1); PG8_BAR; PG8_SCHED;
            PG8_LDA(At, 1, 1); PG8_STAGE(PG8_SB(1, 0), b3, voffB); PG8_STAGE(PG8_SB(1, 1), b3 + hstep, voffB); PG8_STAGE(PG8_SA(1, 0), a3, voffA);
            PG8_WAIT_V(8); PG8_WAIT_L(0); PG8_BAR; PG8_MMA(1, 0, At, B0); PG8_MMA(1, 1, At, B1); PG8_BAR; PG8_SCHED;
            } else {
            PG8_LDB(B0, 0, 0); PG8_SCHED; PG8_LDA(At, 0, 0); PG8_STAGE(PG8_SA(1, 1), a1 + hstep, voffA);
            PG8_WAIT_L(8); PG8_BAR; PG8_WAIT_L(0); PG8_MMA(0, 0, At, B0); PG8_BAR; PG8_SCHED;
            PG8_LDB(B1, 0, 1); PG8_STAGE(PG8_SB(0, 0), b2, voffB);
            PG8_BAR; PG8_WAIT_L(0); PG8_MMA(0, 1, At, B1); PG8_BAR;
            PG8_LDA(At, 0, 1); PG8_STAGE(PG8_SA(0, 0), a2, voffA);
            PG8_BAR; PG8_WAIT_L(0); PG8_MMA(1, 0, At, B0); PG8_BAR; PG8_SCHED;
            PG8_STAGE(PG8_SB(0, 1), b2 + hstep, voffB);
            PG8_WAIT_V(6); PG8_BAR; PG8_MMA(1, 1, At, B1); PG8_BAR;
            PG8_LDB(B0, 1, 0); PG8_SCHED; PG8_LDA(At, 1, 0); PG8_STAGE(PG8_SA(0, 1), a2 + hstep, voffA);
            PG8_WAIT_L(8); PG8_BAR; PG8_WAIT_L(0); PG8_MMA(0, 0, At, B0); PG8_BAR; PG8_SCHED;
            PG8_LDB(B1, 1, 1); PG8_STAGE(PG8_SB(1, 0), b3, voffB);
            PG8_BAR; PG8_WAIT_L(0); PG8_MMA(0, 1, At, B1); PG8_BAR;
            PG8_LDA(At, 1, 1); PG8_STAGE(PG8_SA(1, 0), a3, voffA);
            PG8_BAR; PG8_WAIT_L(0); PG8_MMA(1, 0, At, B0); PG8_BAR; PG8_SCHED;
            PG8_STAGE(PG8_SB(1, 1), b3 + hstep, voffB);
            PG8_WAIT_V(6); PG8_BAR; PG8_MMA(1, 1, At, B1); PG8_BAR;
            }
        }
        if constexpr (ALIGN_EPI) { if (wr == 0) PG8_BAR; }
        if constexpr (!Epi::AFTER_DRAIN) { E(acc, cur, wr, wc, fr, fq); S.done(cur); }
        if (!has_next) break;
#pragma unroll
        for (int a = 0; a < 2; ++a)
#pragma unroll
            for (int b = 0; b < 2; ++b)
#pragma unroll
                for (int m = 0; m < 4; ++m)
#pragma unroll
                    for (int n = 0; n < 2; ++n) acc[a][b][m][n] = (f32x4){0.f, 0.f, 0.f, 0.f};
        cur = nxt; cA = nA; cB = nB; ++ui;
        if constexpr (ALIGN_EPI) { if (wr == 1) PG8_BAR; }
    }
    PG8_WAIT_V(0);
    if constexpr (!ALIGN_EPI) { if (wr == 0) PG8_BAR; }
    PG8_BAR;
    if constexpr (Epi::AFTER_DRAIN) { E.fused(acc, cur, wr, wc, fr, fq, lds, wid, lane); S.done(cur); }
#undef PG8_SA
#undef PG8_SB
#undef PG8_STAGE
#undef PG8_LDA
#undef PG8_LDB
#undef PG8_MMA
#undef PG8_WAIT_V
#undef PG8_WAIT_L
#undef PG8_BAR
#undef PG8_SCHED
}
}
constexpr int NWAVES = 8, NTHR = 512;
constexpr int DM = 1024, NLAT = 32768, NCTX = 2048, NROWS = 34816, INC = 3328;
constexpr int OFF_CB = 0, OFF_CC = 256, OFF_CX = 512, OFF_Q = 768, OFF_K = 1280, OFF_V = 1792, OFF_G = 2304, OFF_U = 2816, OFF_VV = 3072;
constexpr int NCH = 34;
constexpr float LN_EPS = 1e-5f, ALPHA = 1.41421356237309515f;
constexpr size_t MiB = 1u << 20;
constexpr size_t WS_CTL = 0, CTL_ZERO_BYTES = MiB, WS_MOD = 1 * MiB, WS_WR = 1 * MiB + 512 * 1024, WS_TOK = 2 * MiB, WS_WIN = 4 * MiB, WS_WOUT = 17 * MiB, WS_WGU = 21 * MiB, WS_WD = 149 * MiB,
                 WS_HB = 213 * MiB, WS_ST = WS_HB, WS_XCTX = 281 * MiB, WS_P = 289 * MiB, WS_YMIX = 510 * MiB, WS_XB = WS_P, WS_Y = WS_P, WS_HH = WS_P + 152 * MiB, WS_END = 578 * MiB;
constexpr int CW_TMO = 0, CW_BAR = 4096, CW_WGCNT = 16384, CW_TOT = 32768;
constexpr int RING_BYTES = 131072, LDSCTL_OFF = RING_BYTES, MISC_OFF = LDSCTL_OFF + 320, P2E_OFF = LDSCTL_OFF + 1024, PST_OFF = LDSCTL_OFF + 2048, LDS_BYTES = 147456;
constexpr int MAXPANELS = 304;

#define GAS __attribute__((address_space(1)))
#define LAS __attribute__((address_space(3)))
typedef unsigned short bf16;
typedef unsigned v4u __attribute__((ext_vector_type(4)));
typedef unsigned v2u __attribute__((ext_vector_type(2)));
typedef float f32x4 __attribute__((ext_vector_type(4)));
#define LDS_WAIT() asm volatile("s_waitcnt lgkmcnt(0)" ::: "memory")
#define VM_WAIT() asm volatile("s_waitcnt vmcnt(0)" ::: "memory")
__device__ __forceinline__ unsigned f2bf(float f) { unsigned u = __builtin_bit_cast(unsigned, f); return (u + 0x7fffu + ((u >> 16) & 1u)) >> 16; }
__device__ __forceinline__ unsigned pk2(float lo, float hi) { return f2bf(lo) | (f2bf(hi) << 16); }
typedef float f32x2_t __attribute__((ext_vector_type(2))); typedef __bf16 bf16x2_t __attribute__((ext_vector_type(2)));
__device__ __forceinline__ unsigned cvtpk(float lo, float hi) { f32x2_t v = {lo, hi}; bf16x2_t b = __builtin_convertvector(v, bf16x2_t); return __builtin_bit_cast(unsigned, b); }
__device__ __forceinline__ float bflo(unsigned w) { return __builtin_bit_cast(float, w << 16); }
__device__ __forceinline__ float bfhi(unsigned w) { return __builtin_bit_cast(float, w & 0xffff0000u); }
__device__ __forceinline__ float wave_sum(float v) {
#pragma unroll
    for (int o = 1; o < 64; o <<= 1) v += __shfl_xor(v, o);
    return v;
}
__device__ __forceinline__ float log_sigmoid_f(float x) { return -log1pf(expf(-x)); }

struct Args { const float* in[24]; float* out; unsigned char* ws; int ph_lo, ph_hi; };
#define XB_TMO      128
#define XB_XCNT(j)  (256  + 64 * (j))
#define XB_XSUB(j)  (1280 + 64 * (j))
#define XB_XGEN(j)  (2304 + 64 * (j))
#define XB_TOP      3328
#define XB_TOPGEN   3392
#define XCD_BAR_WORDS 3456
#define XB_SPIN_CAP (1u << 18)

__device__ __forceinline__ unsigned xb_ld(unsigned* p)              { return __hip_atomic_load(p, __ATOMIC_RELAXED, __HIP_MEMORY_SCOPE_AGENT); }
__device__ __forceinline__ unsigned xb_add(unsigned* p, unsigned v) { return __hip_atomic_fetch_add(p, v, __ATOMIC_RELAXED, __HIP_MEMORY_SCOPE_AGENT); }
__device__ __forceinline__ unsigned xb_xcc_id() { return (unsigned)__builtin_amdgcn_s_getreg((3 << 11) | 20) & 0xFu; }
#define XB_SPIN(cond, bar) do { unsigned _sp = 0; while (cond) { __builtin_amdgcn_s_sleep(1); \
    if ((++_sp & 255u) == 0u) { if (xb_ld(&(bar)[XB_TMO])) break; if (_sp > XB_SPIN_CAP) { atomicAdd(&(bar)[XB_TMO], 1u); break; } } } } while (0)

struct XcdBarrier {
    unsigned* bar; unsigned x;
    volatile LAS unsigned* st;
};

__device__ __forceinline__ XcdBarrier xcd_barrier_post(unsigned* bar, volatile LAS unsigned* st) {
    XcdBarrier b; b.bar = bar; b.x = xb_xcc_id(); b.st = st;
    if (threadIdx.x == 0) (void)xb_add(&bar[XB_XCNT(b.x)], 1u);
    return b;
}
__device__ __forceinline__ void xcd_barrier_complete(unsigned* bar, unsigned x, unsigned& nloc, unsigned& nx) {
    const unsigned G = gridDim.x * gridDim.y * gridDim.z;
    unsigned sum, cnt, mine, sp = 0u;
    for (;;) {
        sum = 0u; cnt = 0u; mine = 0u;
#pragma unroll
        for (unsigned j = 0; j < 16; ++j) { const unsigned c = xb_ld(&bar[XB_XCNT(j)]); sum += c; cnt += (c > 0u) ? 1u : 0u; mine = (j == x) ? c : mine; }
        if (sum == G) break;
        __builtin_amdgcn_s_sleep(1);
        if ((++sp & 255u) == 0u) { if (xb_ld(&bar[XB_TMO])) break; if (sp > XB_SPIN_CAP) { atomicAdd(&bar[XB_TMO], 1u); break; } }
    }
    nloc = mine > 0u ? mine : 1u; nx = cnt > 0u ? cnt : 1u;
}

__device__ __forceinline__ void xcd_barrier(const XcdBarrier& b) {
    asm volatile("s_waitcnt vmcnt(0)" ::: "memory");
    __syncthreads();
    if (threadIdx.x == 0) {
        unsigned* bar = b.bar;
        __builtin_amdgcn_s_waitcnt(0);
        unsigned nloc = b.st[0], nx = b.st[1];
        if (nloc == 0u) { xcd_barrier_complete(bar, b.x, nloc, nx); b.st[0] = nloc; b.st[1] = nx; }
        const unsigned old = xb_add(&bar[XB_XSUB(b.x)], 1u);
        const unsigned gen = old / nloc;
        if (old + 1u == (gen + 1u) * nloc) {
            __builtin_amdgcn_fence(__ATOMIC_RELEASE, "agent");
            asm volatile("s_waitcnt vmcnt(0)" ::: "memory");
            const unsigned og = xb_add(&bar[XB_TOP], 1u);
            const unsigned tg = og / nx;
            if (og + 1u == (tg + 1u) * nx) xb_add(&bar[XB_TOPGEN], 1u);
            else XB_SPIN(xb_ld(&bar[XB_TOPGEN]) == tg, bar);
            __builtin_amdgcn_fence(__ATOMIC_ACQUIRE, "agent");
            xb_add(&bar[XB_XGEN(b.x)], 1u);
            asm volatile("s_waitcnt vmcnt(0)" ::: "memory");
        } else {
            XB_SPIN(xb_ld(&bar[XB_XGEN(b.x)]) == gen, bar);
            __builtin_amdgcn_fence(__ATOMIC_ACQUIRE, "agent");
            asm volatile("s_waitcnt vmcnt(0)" ::: "memory");
        }
    }
    __syncthreads();
}
__device__ __forceinline__ void transpose_tile(const float* Wsrc, int ldn, bf16* dst, int ldk, float scale, LAS float* scr, int lane) {
#pragma unroll 8
    for (int i = 0; i < 32; ++i) { const int kk = 2 * i + (lane >> 5); scr[kk * 33 + (lane & 31)] = Wsrc[(size_t)kk * ldn + (lane & 31)] * scale; }
    LDS_WAIT(); asm volatile("" ::: "memory");
    const int c = lane & 7;
#pragma unroll
    for (int j = 0; j < 4; ++j) { const int n = (lane >> 3) + 8 * j; const LAS float* s = scr + (8 * c) * 33 + n;
        v4u o; o.x = pk2(s[0 * 33], s[1 * 33]); o.y = pk2(s[2 * 33], s[3 * 33]); o.z = pk2(s[4 * 33], s[5 * 33]); o.w = pk2(s[6 * 33], s[7 * 33]);
        *(GAS v4u*)(dst + (size_t)n * ldk + 8 * c) = o; }
    LDS_WAIT(); asm volatile("" ::: "memory");
}

__device__ __forceinline__ void phase_p0(const Args& a, LAS unsigned char* lds, int tid, int lane, int wave) {
    const int G = gridDim.x;
    {
        LAS float* s = (LAS float*)lds; LAS float* red = (LAS float*)(lds + 36864);
        const float* c = a.in[1]; const float* cctx = a.in[3]; const float* wada = a.in[4]; const float* bada = a.in[5];
        float* mod = (float*)(a.ws + WS_MOD);
        for (int u = blockIdx.x; u < 192; u += G) {
            const int l = u / 96, j0 = (u % 96) * 64;
            for (int i = tid; i < 9 * 1024; i += NTHR) { const int r = i >> 10, k = i & 1023; const float v = r < 8 ? c[r * 1024 + k] : cctx[k]; s[i] = v / (1.0f + expf(-v)); }
            __syncthreads();
            const int jq = tid & 15, kg = tid >> 4;
            float acc[9][4];
#pragma unroll
            for (int r = 0; r < 9; ++r) { acc[r][0] = 0.f; acc[r][1] = 0.f; acc[r][2] = 0.f; acc[r][3] = 0.f; }
            const float* w = wada + (size_t)l * 1024 * 6144 + j0 + jq * 4;
            for (int k = kg; k < 1024; k += 32) { const f32x4 wv = *(const f32x4*)(w + (size_t)k * 6144);
#pragma unroll
                for (int r = 0; r < 9; ++r) { const float sr = s[r * 1024 + k]; acc[r][0] += sr * wv.x; acc[r][1] += sr * wv.y; acc[r][2] += sr * wv.z; acc[r][3] += sr * wv.w; } }
#pragma unroll
            for (int r = 0; r < 9; ++r)
#pragma unroll
                for (int i = 0; i < 4; ++i) red[(kg * 9 + r) * 64 + jq * 4 + i] = acc[r][i];
            __syncthreads();
            for (int o = tid; o < 576; o += NTHR) { const int r = o >> 6, j = o & 63; float sum = 0.f;
                for (int g2 = 0; g2 < 32; ++g2) sum += red[(g2 * 9 + r) * 64 + j];
                mod[(l * 9 + r) * 6144 + j0 + j] = sum + bada[l * 6144 + j0 + j]; }
            __syncthreads();
        }
    }
    {
        LAS float* scr = (LAS float*)(lds + wave * 16384);
        const int gw = blockIdx.x * NWAVES + wave, NGW = G * NWAVES;
        const float* w_in = a.in[6]; const float* w_out = a.in[12]; const float* w_gate = a.in[19]; const float* w_up = a.in[20]; const float* w_down = a.in[21];
        bf16* WIN = (bf16*)(a.ws + WS_WIN); bf16* WOUT = (bf16*)(a.ws + WS_WOUT); bf16* WGU = (bf16*)(a.ws + WS_WGU); bf16* WD = (bf16*)(a.ws + WS_WD);
        constexpr int I_IN = 2 * 16 * 104, I_OUT = 2 * 16 * 32, I_GU = 2 * 2 * 32 * 256, I_D = 2 * 32 * 256, NITEMS = I_IN + I_OUT + I_GU + I_D;
        for (int it = gw; it < NITEMS; it += NGW) {
            int r = it;
            if (r < I_IN) { const int l = r / 1664, q = r % 1664, k0 = 64 * (q / 104), n0 = 32 * (q % 104);
                const float sc = (n0 >= OFF_K && n0 < OFF_V) ? 0.125f : 1.0f;
                transpose_tile(w_in + ((size_t)l * 1024 + k0) * INC + n0, INC, WIN + ((size_t)l * INC + n0) * 1024 + k0, 1024, sc, scr, lane); continue; }
            r -= I_IN;
            if (r < I_OUT) { const int l = r / 512, q = r % 512, k0 = 64 * (q / 32), n0 = 32 * (q % 32);
                transpose_tile(w_out + ((size_t)l * 1024 + k0) * 1024 + n0, 1024, WOUT + ((size_t)l * 1024 + n0) * 1024 + k0, 1024, 1.0f, scr, lane); continue; }
            r -= I_OUT;
            if (r < I_GU) { const int isup = r >= (I_GU / 2) ? 1 : 0; r -= isup * (I_GU / 2);
                const int le = r / 256, q = r % 256, k0 = 64 * (q / 16), n0 = 32 * (q % 16);
                const float* src = (isup ? w_up : w_gate) + ((size_t)le * 1024 + k0) * 512 + n0;
                const int drow = (n0 >> 7) * 256 + (n0 & 127) + isup * 128;
                transpose_tile(src, 512, WGU + ((size_t)le * 1024 + drow) * 1024 + k0, 1024, 1.0f, scr, lane); continue; }
            r -= I_GU;
            { const int le = r / 256, q = r % 256, k0 = 64 * (q / 32), n0 = 32 * (q % 32);
                transpose_tile(w_down + ((size_t)le * 512 + k0) * 1024 + n0, 1024, WD + ((size_t)le * 1024 + n0) * 512 + k0, 512, 1.0f, scr, lane); }
        }
    }
    {
        bf16* WR = (bf16*)(a.ws + WS_WR);
        for (int i = blockIdx.x * NTHR + tid; i < 2 * 64 * 1024; i += G * NTHR) { const int l = i >> 16, j = (i >> 10) & 63, k = i & 1023;
            float v = 0.f;
            if (j < 4) v = a.in[15][((size_t)l * 1024 + k) * 4 + j]; else if (j < 36) v = a.in[17][(((size_t)l * 4 + ((j - 4) >> 3)) * 1024 + k) * 8 + ((j - 4) & 7)];
            const unsigned hi = f2bf(v); const float r = v - __builtin_bit_cast(float, hi << 16);
            WR[((size_t)(l * 2) * 64 + j) * 1024 + k] = (bf16)hi; WR[((size_t)(l * 2 + 1) * 64 + j) * 1024 + k] = (bf16)f2bf(r); }
    }
    __syncthreads();
}

__device__ __forceinline__ void phase_p1(const Args& a, int lane, int wave) {
    const int gw = blockIdx.x * NWAVES + wave, NGW = gridDim.x * NWAVES;
    const float* mod = (const float*)(a.ws + WS_MOD); bf16* Hb = (bf16*)(a.ws + WS_HB);
    for (int row = gw; row < NROWS; row += NGW) {
        const float* src = row < NLAT ? a.in[0] + (size_t)row * 1024 : a.in[2] + (size_t)(row - NLAT) * 1024;
        const float* m0 = mod + (row < NLAT ? (row >> 12) : 8) * 6144;
#pragma unroll
        for (int j = 0; j < 4; ++j) { const int idx = (lane + 64 * j) * 4;
            const f32x4 v = *(const f32x4*)(src + idx), sh = *(const f32x4*)(m0 + idx), sc = *(const f32x4*)(m0 + 1024 + idx);
            const f32x4 o = v * (sc + 1.0f) + sh; v2u w; w.x = pk2(o.x, o.y); w.y = pk2(o.z, o.w);
            *(v2u*)(Hb + (size_t)row * 1024 + idx) = w; }
    }
}

__device__ __forceinline__ int chunk_row0(int b, int c) { return c < 2 ? NLAT + b * 256 + c * 128 : b * 4096 + (c - 2) * 128; }
__device__ __forceinline__ size_t st_off(int b, int c, int h, int dir) { return ((((size_t)b * NCH + c) * 8 + h) * 2 + dir) * 4096; }

__device__ __forceinline__ void phase_b(const Args& a, int l, LAS unsigned char* lds, int tid) {
    const bf16* P = (const bf16*)(a.ws + WS_P); float* ST = (float*)(a.ws + WS_ST);
    LAS float* Ks = (LAS float*)lds; LAS float* Vs = (LAS float*)(lds + 32768); LAS float* pf = (LAS float*)(lds + 65536); LAS float* pb = pf + 128;
    for (int u = blockIdx.x; u < 8 * NCH * 8; u += gridDim.x) {
        const int b = u / (NCH * 8), c = (u % (NCH * 8)) / 8, h = u % 8; const int row0 = chunk_row0(b, c);
        __syncthreads();
        if (tid < 128) { const float lgf = log_sigmoid_f(a.in[8][l * 8 + h]), lgb = log_sigmoid_f(a.in[9][l * 8 + h]);
            pf[tid] = expf(lgf * (float)(127 - tid)); pb[tid] = expf(lgb * (float)tid); }
        { const int j = tid >> 2, part = tid & 3; const bf16* kp = P + (size_t)(row0 + j) * INC + OFF_K + h * 64 + part * 16; const bf16* vp = kp + (OFF_V - OFF_K);
#pragma unroll
          for (int q = 0; q < 2; ++q) { const v4u kw = *(const v4u*)(kp + 8 * q), vw = *(const v4u*)(vp + 8 * q);
              LAS float* kd = Ks + j * 64 + part * 16 + 8 * q; LAS float* vd = Vs + j * 64 + part * 16 + 8 * q;
              kd[0] = bflo(kw.x); kd[1] = bfhi(kw.x); kd[2] = bflo(kw.y); kd[3] = bfhi(kw.y); kd[4] = bflo(kw.z); kd[5] = bfhi(kw.z); kd[6] = bflo(kw.w); kd[7] = bfhi(kw.w);
              vd[0] = bflo(vw.x); vd[1] = bfhi(vw.x); vd[2] = bflo(vw.y); vd[3] = bfhi(vw.y); vd[4] = bflo(vw.z); vd[5] = bfhi(vw.z); vd[6] = bflo(vw.w); vd[7] = bfhi(vw.w); } }
        __syncthreads();
        const int d = tid >> 3, e0 = (tid & 7) * 8;
        float af[8], ab[8];
#pragma unroll
        for (int i = 0; i < 8; ++i) { af[i] = 0.f; ab[i] = 0.f; }
        for (int j = 0; j < 128; ++j) { const float kd = Ks[j * 64 + d], kf = kd * pf[j], kb = kd * pb[j];
            const f32x4 v0 = *(const LAS f32x4*)(Vs + j * 64 + e0), v1 = *(const LAS f32x4*)(Vs + j * 64 + e0 + 4);
            af[0] += kf * v0.x; af[1] += kf * v0.y; af[2] += kf * v0.z; af[3] += kf * v0.w; af[4] += kf * v1.x; af[5] += kf * v1.y; af[6] += kf * v1.z; af[7] += kf * v1.w;
            ab[0] += kb * v0.x; ab[1] += kb * v0.y; ab[2] += kb * v0.z; ab[3] += kb * v0.w; ab[4] += kb * v1.x; ab[5] += kb * v1.y; ab[6] += kb * v1.z; ab[7] += kb * v1.w; }
        float* o0 = ST + st_off(b, c, h, 0) + d * 64 + e0; float* o1 = ST + st_off(b, c, h, 1) + d * 64 + e0;
        *(f32x4*)o0 = (f32x4){af[0], af[1], af[2], af[3]}; *(f32x4*)(o0 + 4) = (f32x4){af[4], af[5], af[6], af[7]};
        *(f32x4*)o1 = (f32x4){ab[0], ab[1], ab[2], ab[3]}; *(f32x4*)(o1 + 4) = (f32x4){ab[4], ab[5], ab[6], ab[7]};
    }
    __syncthreads();
}

__device__ __forceinline__ void phase_c(const Args& a, int l, int tid) {
    bf16* ST = (bf16*)(a.ws + WS_ST);
    for (int it = blockIdx.x * NTHR + tid; it < 8 * 8 * 2 * 1024; it += gridDim.x * NTHR) {
        const int q = it & 1023, dir = (it >> 10) & 1, h = (it >> 11) & 7, b = it >> 14;
        const float lg = log_sigmoid_f(dir ? a.in[9][l * 8 + h] : a.in[8][l * 8 + h]); const float dec = expf(128.0f * lg);
        v2u kv[NCH];
#pragma unroll
        for (int s = 0; s < NCH; ++s) { const int c = dir ? (s < 2 ? 1 - s : 35 - s) : s; kv[s] = *(const v2u*)(ST + st_off(b, c, h, dir) + q * 4); }
        f32x4 st = (f32x4){0.f, 0.f, 0.f, 0.f};
#pragma unroll
        for (int s = 0; s < NCH; ++s) { const int c = dir ? (s < 2 ? 1 - s : 35 - s) : s;
            v2u w; w.x = cvtpk(st.x, st.y); w.y = cvtpk(st.z, st.w); *(v2u*)(ST + st_off(b, c, h, dir) + q * 4) = w;
            st = st * dec + (f32x4){bflo(kv[s].x), bfhi(kv[s].x), bflo(kv[s].y), bfhi(kv[s].y)}; }
    }
}
__device__ __forceinline__ void unpack8(const v4u w, float* f) { f[0] = bflo(w.x); f[1] = bfhi(w.x); f[2] = bflo(w.y); f[3] = bfhi(w.y); f[4] = bflo(w.z); f[5] = bfhi(w.z); f[6] = bflo(w.w); f[7] = bfhi(w.w); }
__device__ __forceinline__ v4u pack8(const float* f) { v4u w; w.x = pk2(f[0], f[1]); w.y = pk2(f[2], f[3]); w.z = pk2(f[4], f[5]); w.w = pk2(f[6], f[7]); return w; }

__device__ __forceinline__ void phase_d(const Args& a, int l, LAS unsigned char* lds, int tid, int lane) {
    const bf16* P = (const bf16*)(a.ws + WS_P); const float* ST = (const float*)(a.ws + WS_ST); bf16* Y = (bf16*)(a.ws + WS_YMIX);
    const float* convw = a.in[7] + l * 3 * 256; const float* sguw = a.in[10] + (size_t)l * 4 * 128 * 128; const float* sgub = a.in[11] + l * 4 * 128;
    const int c_lo = l == 1 ? 2 : 0, cpb = NCH - c_lo, nunits = 8 * cpb;
    LAS float* Sf = (LAS float*)lds; LAS float* Sb = (LAS float*)(lds + 16384); LAS float* Ks = (LAS float*)(lds + 32768); LAS float* Vs = (LAS float*)(lds + 65536);
    LAS float* VN = (LAS float*)lds;
    for (int u = blockIdx.x; u < nunits; u += gridDim.x) {
        const int b = u / cpb, c = c_lo + u % cpb; const int row0 = chunk_row0(b, c); const bool isc = c < 2;
#ifndef NO_D1
        for (int idx = tid; idx < 128 * 32; idx += NTHR) {
            const int p = idx >> 5, ch0 = (idx & 31) * 8; const int row = row0 + p;
            int dprev = -1, dnext = 1; bool vprev, vnext;
            if (isc) { const int t = c * 128 + p; vprev = t > 0; vnext = t < 255; }
            else { const int t = (c - 2) * 128 + p;
                if (ch0 < 128) { const int col = t & 63; vprev = col > 0; vnext = col < 63; }
                else { const int rg = t >> 6; vprev = rg > 0; vnext = rg < 63; dprev = -64; dnext = 64; } }
            const bf16* pr = P + (size_t)row * INC;
            float cb[8], zc[8], zp[8], zn[8], t0[8], t1[8];
            unpack8(*(const v4u*)(pr + OFF_CB + ch0), cb);
            unpack8(*(const v4u*)(pr + OFF_CC + ch0), t0); unpack8(*(const v4u*)(pr + OFF_CX + ch0), t1);
#pragma unroll
            for (int i = 0; i < 8; ++i) { zc[i] = t0[i] * t1[i]; zp[i] = 0.f; zn[i] = 0.f; }
            if (vprev) { const bf16* q = pr + (ptrdiff_t)dprev * INC; unpack8(*(const v4u*)(q + OFF_CC + ch0), t0); unpack8(*(const v4u*)(q + OFF_CX + ch0), t1);
#pragma unroll
                for (int i = 0; i < 8; ++i) zp[i] = t0[i] * t1[i]; }
            if (vnext) { const bf16* q = pr + (ptrdiff_t)dnext * INC; unpack8(*(const v4u*)(q + OFF_CC + ch0), t0); unpack8(*(const v4u*)(q + OFF_CX + ch0), t1);
#pragma unroll
                for (int i = 0; i < 8; ++i) zn[i] = t0[i] * t1[i]; }
            float o[8];
#pragma unroll
            for (int i = 0; i < 8; ++i) o[i] = cb[i] * (convw[ch0 + i] * zp[i] + convw[256 + ch0 + i] * zc[i] + convw[512 + ch0 + i] * zn[i]);
            *(v4u*)(Y + (size_t)row * 1024 + ch0) = pack8(o);
        }
#endif
        const int i = tid >> 2, part = tid & 3;
#ifndef NO_D2
#pragma unroll 1
        for (int h = 0; h < 8; ++h) {
            __syncthreads();
            { const bf16* kp = P + (size_t)(row0 + i) * INC + OFF_K + h * 64 + part * 16; const bf16* vp = kp + (OFF_V - OFF_K);
#pragma unroll
              for (int q = 0; q < 2; ++q) { float kf[8], vf[8]; unpack8(*(const v4u*)(kp + 8 * q), kf); unpack8(*(const v4u*)(vp + 8 * q), vf);
                  LAS float* kd = Ks + i * 64 + part * 16 + 8 * q; LAS float* vd = Vs + i * 64 + part * 16 + 8 * q;
#pragma unroll
                  for (int e = 0; e < 8; ++e) { kd[e] = kf[e]; vd[e] = vf[e]; } }
              const float* sf = ST + st_off(b, c, h, 0); const float* sb = ST + st_off(b, c, h, 1);
#pragma unroll
              for (int q = 0; q < 2; ++q) { const int o4 = (tid + NTHR * q) * 4; *(LAS f32x4*)(Sf + o4) = *(const f32x4*)(sf + o4); *(LAS f32x4*)(Sb + o4) = *(const f32x4*)(sb + o4); } }
            float qv[16];
            { const bf16* qp = P + (size_t)(row0 + i) * INC + OFF_Q + h * 64 + part * 16; unpack8(*(const v4u*)qp, qv); unpack8(*(const v4u*)(qp + 8), qv + 8); }
            const float lgf = log_sigmoid_f(a.in[8][l * 8 + h]), lgb = log_sigmoid_f(a.in[9][l * 8 + h]);
            __syncthreads();
            float o[16];
#pragma unroll
            for (int e = 0; e < 16; ++e) o[e] = 0.f;
#pragma unroll 1
            for (int j = 0; j < 128; ++j) {
                const LAS f32x4* kr = (const LAS f32x4*)(Ks + j * 64 + part * 16);
                float s = 0.f;
#pragma unroll
                for (int q = 0; q < 4; ++q) { const f32x4 k4 = kr[q]; s += qv[4 * q] * k4.x + qv[4 * q + 1] * k4.y + qv[4 * q + 2] * k4.z + qv[4 * q + 3] * k4.w; }
                s += __shfl_xor(s, 1); s += __shfl_xor(s, 2);
                const int rel = i - j;
                const float dec = rel > 0 ? expf(lgf * (float)rel) : (rel < 0 ? expf(lgb * (float)(-rel)) : 2.0f);
                s *= dec;
                const LAS f32x4* vr = (const LAS f32x4*)(Vs + j * 64 + part * 16);
#pragma unroll
                for (int q = 0; q < 4; ++q) { const f32x4 v4 = vr[q]; o[4 * q] += s * v4.x; o[4 * q + 1] += s * v4.y; o[4 * q + 2] += s * v4.z; o[4 * q + 3] += s * v4.w; }
            }
            float of[16], ob[16];
#pragma unroll
            for (int e = 0; e < 16; ++e) { of[e] = 0.f; ob[e] = 0.f; }
            __syncthreads();
#pragma unroll
            for (int dd = 0; dd < 16; ++dd) Ks[i * 64 + ((part * 16 + dd + i) & 63)] = qv[dd];
            __syncthreads();
#pragma unroll 2
            for (int d = 0; d < 64; ++d) { const float qd = Ks[i * 64 + ((d + i) & 63)];
                const LAS f32x4* fr = (const LAS f32x4*)(Sf + d * 64 + part * 16); const LAS f32x4* br = (const LAS f32x4*)(Sb + d * 64 + part * 16);
#pragma unroll
                for (int q = 0; q < 4; ++q) { const f32x4 f4 = fr[q], b4 = br[q];
                    of[4 * q] += qd * f4.x; of[4 * q + 1] += qd * f4.y; of[4 * q + 2] += qd * f4.z; of[4 * q + 3] += qd * f4.w;
                    ob[4 * q] += qd * b4.x; ob[4 * q + 1] += qd * b4.y; ob[4 * q + 2] += qd * b4.z; ob[4 * q + 3] += qd * b4.w; } }
            const float df = expf(lgf * (float)(i + 1)), db = expf(lgb * (float)(128 - i));
            float sum = 0.f;
#pragma unroll
            for (int e = 0; e < 16; ++e) { o[e] += df * of[e] + db * ob[e]; sum += o[e]; }
            sum += __shfl_xor(sum, 1); sum += __shfl_xor(sum, 2);
            const float mu = sum * (1.0f / 64.0f); float vs = 0.f;
#pragma unroll
            for (int e = 0; e < 16; ++e) { o[e] -= mu; vs += o[e] * o[e]; }
            vs += __shfl_xor(vs, 1); vs += __shfl_xor(vs, 2);
            const float rs = 1.0f / sqrtf(vs * (1.0f / 64.0f) + LN_EPS);
            float gv[16];
            { const bf16* gp = P + (size_t)(row0 + i) * INC + OFF_G + h * 64 + part * 16; unpack8(*(const v4u*)gp, gv); unpack8(*(const v4u*)(gp + 8), gv + 8); }
#pragma unroll
            for (int e = 0; e < 16; ++e) o[e] = (gv[e] / (1.0f + expf(-gv[e]))) * (o[e] * rs);
            bf16* yp = Y + (size_t)(row0 + i) * 1024 + 256 + h * 64 + part * 16;
            *(v4u*)yp = pack8(o); *(v4u*)(yp + 8) = pack8(o + 8);
        }
#endif
#ifndef NO_D3
        __syncthreads();
        {
            const bf16* vp = P + (size_t)(row0 + i) * INC + OFF_VV + part * 64;
            float sum = 0.f;
#pragma unroll 2
            for (int q = 0; q < 8; ++q) { float t8[8]; unpack8(*(const v4u*)(vp + 8 * q), t8);
#pragma unroll
                for (int e = 0; e < 8; ++e) sum += t8[e]; }
            sum += __shfl_xor(sum, 1); sum += __shfl_xor(sum, 2);
            const float mu = sum * (1.0f / 256.0f); float vs = 0.f;
#pragma unroll 2
            for (int q = 0; q < 8; ++q) { float t8[8]; unpack8(*(const v4u*)(vp + 8 * q), t8);
#pragma unroll
                for (int e = 0; e < 8; ++e) { const float dlt = t8[e] - mu; vs += dlt * dlt; } }
            vs += __shfl_xor(vs, 1); vs += __shfl_xor(vs, 2);
            const float rs = 1.0f / sqrtf(vs * (1.0f / 256.0f) + LN_EPS);
            LAS float* dst = VN + (part * 128 + i) * 64;
#pragma unroll 2
            for (int q = 0; q < 8; ++q) { float t8[8]; unpack8(*(const v4u*)(vp + 8 * q), t8);
                *(LAS f32x4*)(dst + 8 * q) = (f32x4){(t8[0] - mu) * rs, (t8[1] - mu) * rs, (t8[2] - mu) * rs, (t8[3] - mu) * rs};
                *(LAS f32x4*)(dst + 8 * q + 4) = (f32x4){(t8[4] - mu) * rs, (t8[5] - mu) * rs, (t8[6] - mu) * rs, (t8[7] - mu) * rs}; }
        }
        __syncthreads();
        for (int g = 0; g < 4; ++g) {
            float acc[16];
#pragma unroll
            for (int e = 0; e < 16; ++e) acc[e] = 0.f;
            const float* wrow = sguw + ((size_t)g * 128 + i) * 128;
            for (int q = 0; q < 128; q += 4) { const f32x4 w4 = *(const f32x4*)(wrow + q);
#pragma unroll
                for (int qq = 0; qq < 4; ++qq) { const float w = w4[qq]; const LAS f32x4* vr = (const LAS f32x4*)(VN + (g * 128 + q + qq) * 64 + part * 16);
#pragma unroll
                    for (int t = 0; t < 4; ++t) { const f32x4 v4 = vr[t]; acc[4 * t] += w * v4.x; acc[4 * t + 1] += w * v4.y; acc[4 * t + 2] += w * v4.z; acc[4 * t + 3] += w * v4.w; } } }
            const float bias = sgub[g * 128 + i];
            float uv[16];
            { const bf16* up = P + (size_t)(row0 + i) * INC + OFF_U + g * 64 + part * 16; unpack8(*(const v4u*)up, uv); unpack8(*(const v4u*)(up + 8), uv + 8); }
#pragma unroll
            for (int e = 0; e < 16; ++e) acc[e] = uv[e] * (acc[e] + bias);
            bf16* yp = Y + (size_t)(row0 + i) * 1024 + 768 + g * 64 + part * 16;
            *(v4u*)yp = pack8(acc); *(v4u*)(yp + 8) = pack8(acc + 8);
        }
#endif
        __syncthreads();
    }
}

__device__ __forceinline__ void phase_f(const Args& a, int l, LAS unsigned char* lds, int tid, int lane, int wave, bool dry = false) {
    LAS int* lcnt = (LAS int*)lds;
    __syncthreads();
    if (tid < 32) lcnt[tid] = 0;
    __syncthreads();
    const int gw = blockIdx.x * NWAVES + wave, NGW = gridDim.x * NWAVES, nrows = l == 0 ? NROWS : NLAT;
    const float* mod = (const float*)(a.ws + WS_MOD) + l * 9 * 6144;
    const float* lng = a.in[13] + l * 1024; const float* lnb = a.in[14] + l * 1024;
    const float* rgw = a.in[15] + l * 1024 * 4; const float* rgb = a.in[16] + l * 4; const float* rew = a.in[17] + (size_t)l * 4 * 1024 * 8; const float* reb = a.in[18] + l * 32;
    bf16* Hb = (bf16*)(a.ws + (dry ? WS_P + 160 * MiB : WS_HB)); unsigned* tok = (unsigned*)(a.ws + (dry ? WS_P + 240 * MiB : WS_TOK)); float* xctx = (float*)(a.ws + WS_XCTX);
    for (int row = gw; row < nrows; row += NGW) {
        float* xr = row < NLAT ? a.out + (size_t)row * 1024 : xctx + (size_t)(row - NLAT) * 1024;
        float* xw = dry ? (float*)(a.ws + WS_P) + (size_t)row * 1024 : xr;
        const float* m0 = mod + (row < NLAT ? (row >> 12) : 8) * 6144;
        f32x4 v[4]; float s = 0.f;
#pragma unroll
        for (int j = 0; j < 4; ++j) { v[j] = *(const f32x4*)(xr + (lane + 64 * j) * 4); s += (v[j].x + v[j].y) + (v[j].z + v[j].w); }
        const float mean = wave_sum(s) * (1.0f / 1024.0f); float s2 = 0.f;
#pragma unroll
        for (int j = 0; j < 4; ++j) { v[j] = v[j] - mean; s2 += (v[j].x * v[j].x + v[j].y * v[j].y) + (v[j].z * v[j].z + v[j].w * v[j].w); }
        const float rstd = 1.0f / sqrtf(wave_sum(s2) * (1.0f / 1024.0f) + LN_EPS);
        float lg[4] = {0.f, 0.f, 0.f, 0.f};
#pragma unroll
        for (int j = 0; j < 4; ++j) { const int idx = (lane + 64 * j) * 4;
            const f32x4 x1 = v[j] * rstd * *(const f32x4*)(lng + idx) + *(const f32x4*)(lnb + idx);
            *(f32x4*)(xw + idx) = x1;
            const f32x4 hm = x1 * (*(const f32x4*)(m0 + 4096 + idx) + 1.0f) + *(const f32x4*)(m0 + 3072 + idx);
            v[j] = hm;
            v2u w; w.x = pk2(hm.x, hm.y); w.y = pk2(hm.z, hm.w); *(v2u*)(Hb + (size_t)row * 1024 + idx) = w;
#pragma unroll
            for (int t = 0; t < 4; ++t) { const f32x4 w4 = *(const f32x4*)(rgw + (idx + t) * 4); const float hv = hm[t];
                lg[0] += hv * w4.x; lg[1] += hv * w4.y; lg[2] += hv * w4.z; lg[3] += hv * w4.w; } }
#pragma unroll
        for (int g = 0; g < 4; ++g) lg[g] = wave_sum(lg[g]) + rgb[g];
        int gi = 0; float gm = lg[0];
#pragma unroll
        for (int g = 1; g < 4; ++g) if (lg[g] > gm) { gm = lg[g]; gi = g; }
        float gden = 0.f;
#pragma unroll
        for (int g = 0; g < 4; ++g) gden += expf(lg[g] - gm);
        const float gprob = 1.0f / gden;
        float le[8] = {0.f, 0.f, 0.f, 0.f, 0.f, 0.f, 0.f, 0.f};
        const float* rw = rew + (size_t)gi * 1024 * 8;
#pragma unroll
        for (int j = 0; j < 4; ++j) { const int idx = (lane + 64 * j) * 4;
#pragma unroll
            for (int t = 0; t < 4; ++t) { const f32x4 w0 = *(const f32x4*)(rw + (idx + t) * 8), w1 = *(const f32x4*)(rw + (idx + t) * 8 + 4); const float hv = v[j][t];
                le[0] += hv * w0.x; le[1] += hv * w0.y; le[2] += hv * w0.z; le[3] += hv * w0.w; le[4] += hv * w1.x; le[5] += hv * w1.y; le[6] += hv * w1.z; le[7] += hv * w1.w; } }
#pragma unroll
        for (int e = 0; e < 8; ++e) le[e] = wave_sum(le[e]) + reb[gi * 8 + e];
        int i1 = 0; float m1 = le[0];
#pragma unroll
        for (int e = 1; e < 8; ++e) if (le[e] > m1) { m1 = le[e]; i1 = e; }
        int i2 = -1; float m2 = -3.0e38f;
#pragma unroll
        for (int e = 0; e < 8; ++e) if (e != i1 && le[e] > m2) { m2 = le[e]; i2 = e; }
        const float p2 = expf(m2 - m1), inv = 1.0f / (1.0f + p2);
        const float gate0 = gprob * inv, gate1 = gprob * p2 * inv;
        if (lane == 0) { const int e0 = gi * 8 + i1, e1 = gi * 8 + i2;
            const int p0 = __hip_atomic_fetch_add(lcnt + e0, 1, __ATOMIC_RELAXED, __HIP_MEMORY_SCOPE_WORKGROUP);
            const int p1 = __hip_atomic_fetch_add(lcnt + e1, 1, __ATOMIC_RELAXED, __HIP_MEMORY_SCOPE_WORKGROUP);
            unsigned* t = tok + (size_t)row * 8; t[0] = (unsigned)e0 | ((unsigned)e1 << 8); t[1] = (unsigned)p0; t[2] = (unsigned)p1;
            t[4] = __builtin_bit_cast(unsigned, gate0); t[5] = __builtin_bit_cast(unsigned, gate1); }
    }
    __syncthreads();
    if (tid < 32 && !dry) ((unsigned*)(a.ws + WS_CTL))[CW_WGCNT + (l * 256 + blockIdx.x) * 32 + tid] = (unsigned)lcnt[tid];
    __syncthreads();
}

__device__ __forceinline__ void phase_g(const Args& a, int l, LAS unsigned char* lds, int tid, int lane, int wave) {
    LAS int* cn = (LAS int*)lds; LAS int* base = (LAS int*)(lds + 32768); LAS int* pst = base + 32; LAS int* totl = base + 80;
    unsigned* ctl = (unsigned*)(a.ws + WS_CTL);
    __syncthreads();
    for (int i = tid; i < 256 * 32; i += NTHR) cn[i] = (int)ctl[CW_WGCNT + l * 256 * 32 + i];
    __syncthreads();
    if (tid < 32) { int tot = 0, bs = 0; for (int w = 0; w < 256; ++w) { const int v = cn[w * 32 + tid]; if (w < (int)blockIdx.x) bs += v; tot += v; } base[tid] = bs; totl[tid] = tot; }
    __syncthreads();
    if (tid == 0) { int run = 0; for (int e = 0; e < 32; ++e) { pst[e] = run; run += ((totl[e] + 255) >> 8) << 8; } pst[32] = run; }
    __syncthreads();
    if (blockIdx.x == 0 && tid < 32) ctl[CW_TOT + l * 64 + tid] = (unsigned)totl[tid];
    const int gw = blockIdx.x * NWAVES + wave, NGW = gridDim.x * NWAVES, nrows = l == 0 ? NROWS : NLAT;
    const bf16* Hb = (const bf16*)(a.ws + WS_HB); bf16* XB = (bf16*)(a.ws + WS_XB); unsigned* tok = (unsigned*)(a.ws + WS_TOK);
    (void)gw; (void)NGW;
    for (int T = blockIdx.x; T < (nrows >> 5); T += gridDim.x)
    for (int rr = 0; rr < 4; ++rr) { const int row = 32 * T + 4 * wave + rr;
        unsigned* t = tok + (size_t)row * 8; const unsigned ee = t[0]; const int e0 = ee & 255, e1 = (ee >> 8) & 255;
        const int s0 = pst[e0] + base[e0] + (int)t[1], s1 = pst[e1] + base[e1] + (int)t[2];
        if (lane == 0) { t[6] = (unsigned)s0; t[7] = (unsigned)s1; }
        const v4u a0 = *(const v4u*)(Hb + (size_t)row * 1024 + lane * 8), a1 = *(const v4u*)(Hb + (size_t)row * 1024 + 512 + lane * 8);
        *(v4u*)(XB + (size_t)s0 * 1024 + lane * 8) = a0; *(v4u*)(XB + (size_t)s0 * 1024 + 512 + lane * 8) = a1;
        *(v4u*)(XB + (size_t)s1 * 1024 + lane * 8) = a0; *(v4u*)(XB + (size_t)s1 * 1024 + 512 + lane * 8) = a1;
    }
    __syncthreads();
}

__device__ __forceinline__ int build_p2e(const Args& a, int l, LAS unsigned char* lds, int tid) {
    LAS unsigned char* p2e = lds + P2E_OFF; LAS int* np = (LAS int*)(lds + PST_OFF);
    const unsigned* ctl = (const unsigned*)(a.ws + WS_CTL);
    __syncthreads();
    if (tid == 0) { int pm = 0; for (int e = 0; e < 32; ++e) { const int n = ((int)ctl[CW_TOT + l * 64 + e] + 255) >> 8; for (int k = 0; k < n && pm < MAXPANELS; ++k) p2e[pm++] = (unsigned char)e; } np[0] = pm; }
    __syncthreads();
    return np[0];
}

struct JRow { f32x4 x[4]; v2u y0[4], y1[4]; float g0, g1; };
__device__ __forceinline__ void j_issue(JRow& R, const float* xr, const bf16* Y, const v4u tk, int lane) {
    const unsigned gx = tk.x, gy = tk.y;
    R.g0 = __builtin_bit_cast(float, gx); R.g1 = __builtin_bit_cast(float, gy);
    const bf16* y0 = Y + (size_t)tk.z * 1024; const bf16* y1 = Y + (size_t)tk.w * 1024;
#pragma unroll
    for (int j = 0; j < 4; ++j) { const int idx = (lane + 64 * j) * 4; R.x[j] = *(const f32x4*)(xr + idx); R.y0[j] = *(const v2u*)(y0 + idx); R.y1[j] = *(const v2u*)(y1 + idx); }
}
__device__ __forceinline__ void j_finish(const JRow& R, float* xw, bf16* hrow, const float* m0, const float* m1, const float* lng, const float* lnb, int lane) {
    f32x4 v[4]; float s = 0.f;
#pragma unroll
    for (int j = 0; j < 4; ++j) { const int idx = (lane + 64 * j) * 4; const v2u w0 = R.y0[j], w1 = R.y1[j];
        const f32x4 ya = (f32x4){bflo(w0.x), bfhi(w0.x), bflo(w0.y), bfhi(w0.y)}, yb = (f32x4){bflo(w1.x), bfhi(w1.x), bflo(w1.y), bfhi(w1.y)};
        v[j] = R.x[j] * ALPHA + *(const f32x4*)(m0 + 5120 + idx) * (ya * R.g0 + yb * R.g1);
        s += (v[j].x + v[j].y) + (v[j].z + v[j].w); }
    const float mean = wave_sum(s) * (1.0f / 1024.0f); float s2 = 0.f;
#pragma unroll
    for (int j = 0; j < 4; ++j) { v[j] = v[j] - mean; s2 += (v[j].x * v[j].x + v[j].y * v[j].y) + (v[j].z * v[j].z + v[j].w * v[j].w); }
    const float rstd = 1.0f / sqrtf(wave_sum(s2) * (1.0f / 1024.0f) + LN_EPS);
#pragma unroll
    for (int j = 0; j < 4; ++j) { const int idx = (lane + 64 * j) * 4;
        const f32x4 x2 = v[j] * rstd * *(const f32x4*)(lng + idx) + *(const f32x4*)(lnb + idx);
        *(f32x4*)(xw + idx) = x2;
        if (hrow) { const f32x4 hh = x2 * (*(const f32x4*)(m1 + 1024 + idx) + 1.0f) + *(const f32x4*)(m1 + idx);
            v2u w; w.x = cvtpk(hh.x, hh.y); w.y = cvtpk(hh.z, hh.w); *(v2u*)(hrow + idx) = w; } }
}
__device__ __forceinline__ void phase_j(const Args& a, int l, int lane, int wave, bool dry = false) {
    const int gw = blockIdx.x * NWAVES + wave, NGW = gridDim.x * NWAVES, nrows = l == 0 ? NROWS : NLAT;
    const float* mod = (const float*)(a.ws + WS_MOD) + l * 9 * 6144; const float* modn = (const float*)(a.ws + WS_MOD) + 9 * 6144;
    const float* lng = a.in[22] + l * 1024; const float* lnb = a.in[23] + l * 1024;
    bf16* Hb = (bf16*)(a.ws + WS_HB); const bf16* Y = (const bf16*)(a.ws + WS_Y); const unsigned* tok = (const unsigned*)(a.ws + WS_TOK); float* xctx = (float*)(a.ws + WS_XCTX);
    for (int rowA = gw; rowA < nrows; rowA += 2 * NGW) {
        const int rowB = rowA + NGW; const bool hasB = rowB < nrows;
        const v4u tA = *(const v4u*)(tok + (size_t)rowA * 8 + 4); const v4u tB = hasB ? *(const v4u*)(tok + (size_t)rowB * 8 + 4) : tA;
        float* xrA = rowA < NLAT ? a.out + (size_t)rowA * 1024 : xctx + (size_t)(rowA - NLAT) * 1024;
        const int rB = hasB ? rowB : rowA;
        float* xrB = rB < NLAT ? a.out + (size_t)rB * 1024 : xctx + (size_t)(rB - NLAT) * 1024;
        JRow RA, RB;
        j_issue(RA, xrA, Y, tA, lane); j_issue(RB, xrB, Y, tB, lane);
        const int mA = rowA < NLAT ? (rowA >> 12) : 8, mB = rB < NLAT ? (rB >> 12) : 8;
        j_finish(RA, dry ? (float*)(a.ws + WS_HH) + (size_t)rowA * 1024 : xrA, (l == 0 && !dry) ? Hb + (size_t)rowA * 1024 : nullptr, mod + mA * 6144, modn + mA * 6144, lng, lnb, lane);
        if (hasB) j_finish(RB, dry ? (float*)(a.ws + WS_HH) + (size_t)rowB * 1024 : xrB, (l == 0 && !dry) ? Hb + (size_t)rowB * 1024 : nullptr, mod + mB * 6144, modn + mB * 6144, lng, lnb, lane);
    }
}
typedef short bf16x8 __attribute__((ext_vector_type(8)));
typedef short s16x4 __attribute__((ext_vector_type(4)));
typedef short v4i16_t __attribute__((ext_vector_type(4)));
typedef float f32x16 __attribute__((ext_vector_type(16)));
#define MFMA32(a, b, c) __builtin_amdgcn_mfma_f32_32x32x16_bf16((a), (b), (c), 0, 0, 0)
__device__ __forceinline__ int crow(int reg, int hf) { return (reg & 3) + 8 * (reg >> 2) + 4 * hf; }
__device__ __forceinline__ int tro(int r, int b) { return r * 128 + (b ^ (((r >> 1) & 1) << 6)); }
__device__ __forceinline__ int rro(int r, int c16) { return r * 128 + ((c16 ^ ((r >> 1) & 7)) << 4); }
__device__ __forceinline__ s16x4 tr4(const LAS unsigned char* p) { return __builtin_bit_cast(s16x4, __builtin_amdgcn_ds_read_tr16_b64_v4i16((LAS v4i16_t*)p)); }
__device__ __forceinline__ bf16x8 tr_frag(const LAS unsigned char* img, int rlo, int rhi, int colbyte) {
    const s16x4 lo = tr4(img + tro(rlo, colbyte)), hi = tr4(img + tro(rhi, colbyte));
    return (bf16x8){lo[0], lo[1], lo[2], lo[3], hi[0], hi[1], hi[2], hi[3]};
}

#ifndef ST_TRANSPOSED
#define ST_TRANSPOSED 1
#endif
__device__ __forceinline__ void phase_b_mfma(const Args& a, int l, LAS unsigned char* lds, int tid, int lane, int wave) {
    const bf16* P = (const bf16*)(a.ws + WS_P); bf16* ST = (bf16*)(a.ws + WS_ST);
    const int r32 = lane & 31, hf = lane >> 5, q4 = (lane & 15) >> 2, p4 = lane & 3, blk = (lane >> 4) & 1;
    for (int u = blockIdx.x; u < 8 * NCH * 4; u += gridDim.x) {
        const int b = u / (NCH * 4), c = (u % (NCH * 4)) >> 2, h0 = (u & 3) * 2; const int row0 = chunk_row0(b, c);
        __syncthreads();
#pragma unroll
        for (int k = 0; k < 4; ++k) {
            const int ci = tid + NTHR * k, hh = ci >> 10, row = (ci & 1023) >> 3, c16 = ci & 7, h = h0 + hh;
            const bf16* src = P + (size_t)(row0 + row) * INC + h * 64 + c16 * 8;
            const v4u kw = *(const v4u*)(src + OFF_K), vw = *(const v4u*)(src + OFF_V);
            LAS unsigned char* base = lds + hh * 49152;
            *(LAS v4u*)(base + tro(row, c16 * 16)) = kw;
            const float lgf = log_sigmoid_f(a.in[8][l * 8 + h]), lgb = log_sigmoid_f(a.in[9][l * 8 + h]);
            const float wf = __expf(lgf * (float)(127 - row)), wb = __expf(lgb * (float)row);
            float v[8]; unpack8(vw, v);
            v4u of, ob;
            of.x = cvtpk(v[0] * wf, v[1] * wf); of.y = cvtpk(v[2] * wf, v[3] * wf); of.z = cvtpk(v[4] * wf, v[5] * wf); of.w = cvtpk(v[6] * wf, v[7] * wf);
            ob.x = cvtpk(v[0] * wb, v[1] * wb); ob.y = cvtpk(v[2] * wb, v[3] * wb); ob.z = cvtpk(v[4] * wb, v[5] * wb); ob.w = cvtpk(v[6] * wb, v[7] * wb);
            *(LAS v4u*)(base + 16384 + tro(row, c16 * 16)) = of;
            *(LAS v4u*)(base + 32768 + tro(row, c16 * 16)) = ob;
        }
        __syncthreads();
        const int hh = wave >> 2, dir = (wave >> 1) & 1, et = wave & 1;
        const LAS unsigned char* kimg = lds + hh * 49152; const LAS unsigned char* vimg = kimg + 16384 + dir * 16384;
        f32x16 acc[2];
#pragma unroll
        for (int i = 0; i < 16; ++i) { acc[0][i] = 0.f; acc[1][i] = 0.f; }
#pragma unroll
        for (int ks = 0; ks < 8; ++ks) {
            const int rlo = 16 * ks + 8 * hf + q4;
            const bf16x8 Bv = tr_frag(vimg, rlo, rlo + 4, (et * 32 + 16 * blk + 4 * p4) * 2);
#pragma unroll
            for (int dt = 0; dt < 2; ++dt) { const bf16x8 Ak = tr_frag(kimg, rlo, rlo + 4, (dt * 32 + 16 * blk + 4 * p4) * 2); acc[dt] = MFMA32(Ak, Bv, acc[dt]); }
        }
        bf16* dst = ST + st_off(b, c, h0 + hh, dir) + (size_t)(et * 32 + r32) * 64;
#pragma unroll
        for (int dt = 0; dt < 2; ++dt)
#pragma unroll
            for (int g4 = 0; g4 < 4; ++g4) { v2u w; w.x = cvtpk(acc[dt][4 * g4], acc[dt][4 * g4 + 1]); w.y = cvtpk(acc[dt][4 * g4 + 2], acc[dt][4 * g4 + 3]);
                *(v2u*)(dst + dt * 32 + 8 * g4 + 4 * hf) = w; }
    }
    __syncthreads();
}
__device__ __forceinline__ bf16x8 scale_frag(const bf16x8 q, float sc) {
    const v4u w = __builtin_bit_cast(v4u, q); v4u o;
    o.x = cvtpk(bflo(w.x) * sc, bfhi(w.x) * sc); o.y = cvtpk(bflo(w.y) * sc, bfhi(w.y) * sc); o.z = cvtpk(bflo(w.z) * sc, bfhi(w.z) * sc); o.w = cvtpk(bflo(w.w) * sc, bfhi(w.w) * sc);
    return __builtin_bit_cast(bf16x8, o);
}
__device__ __forceinline__ bf16x8 f32x8_to_frag(const f32x4 a0, const f32x4 a1) {
    v4u o; o.x = cvtpk(a0.x, a0.y); o.y = cvtpk(a0.z, a0.w); o.z = cvtpk(a1.x, a1.y); o.w = cvtpk(a1.z, a1.w); return __builtin_bit_cast(bf16x8, o);
}
__device__ __forceinline__ void phase_d_mfma(const Args& a, int l, LAS unsigned char* lds, int tid, int lane, int wave) {
    const bf16* P = (const bf16*)(a.ws + WS_P); const bf16* ST = (const bf16*)(a.ws + WS_ST); bf16* Y = (bf16*)(a.ws + WS_YMIX);
    const float* convw = a.in[7] + l * 3 * 256; const float* sguw = a.in[10] + (size_t)l * 4 * 128 * 128; const float* sgub = a.in[11] + l * 4 * 128;
    const int c_lo = l == 1 ? 2 : 0, cpb = NCH - c_lo, nunits = 8 * cpb;
#define LANEC int ln_ = lane; asm volatile("" : "+v"(ln_)); const int r32 = ln_ & 31, hf = ln_ >> 5, q4 = (ln_ & 15) >> 2, p4 = ln_ & 3, blk = (ln_ >> 4) & 1; (void)q4; (void)p4; (void)blk
    for (int u = blockIdx.x; u < nunits; u += gridDim.x) {
        const int b = u / cpb, c = c_lo + u % cpb; const int row0 = chunk_row0(b, c); const bool isc = c < 2;
        for (int idx = tid; idx < 128 * 32; idx += NTHR) {
            const int p = idx >> 5, ch0 = (idx & 31) * 8; const int row = row0 + p;
            int dprev = -1, dnext = 1; bool vprev, vnext;
            if (isc) { const int t = c * 128 + p; vprev = t > 0; vnext = t < 255; }
            else { const int t = (c - 2) * 128 + p;
                if (ch0 < 128) { const int col = t & 63; vprev = col > 0; vnext = col < 63; }
                else { const int rg = t >> 6; vprev = rg > 0; vnext = rg < 63; dprev = -64; dnext = 64; } }
            const bf16* pr = P + (size_t)row * INC;
            float cb[8], zc[8], zp[8], zn[8], t0[8], t1[8];
            unpack8(*(const v4u*)(pr + OFF_CB + ch0), cb);
            unpack8(*(const v4u*)(pr + OFF_CC + ch0), t0); unpack8(*(const v4u*)(pr + OFF_CX + ch0), t1);
#pragma unroll
            for (int i = 0; i < 8; ++i) { zc[i] = t0[i] * t1[i]; zp[i] = 0.f; zn[i] = 0.f; }
            if (vprev) { const bf16* q = pr + (ptrdiff_t)dprev * INC; unpack8(*(const v4u*)(q + OFF_CC + ch0), t0); unpack8(*(const v4u*)(q + OFF_CX + ch0), t1);
#pragma unroll
                for (int i = 0; i < 8; ++i) zp[i] = t0[i] * t1[i]; }
            if (vnext) { const bf16* q = pr + (ptrdiff_t)dnext * INC; unpack8(*(const v4u*)(q + OFF_CC + ch0), t0); unpack8(*(const v4u*)(q + OFF_CX + ch0), t1);
#pragma unroll
                for (int i = 0; i < 8; ++i) zn[i] = t0[i] * t1[i]; }
            float o[8];
#pragma unroll
            for (int i = 0; i < 8; ++i) o[i] = cb[i] * (convw[ch0 + i] * zp[i] + convw[256 + ch0 + i] * zc[i] + convw[512 + ch0 + i] * zn[i]);
            *(v4u*)(Y + (size_t)row * 1024 + ch0) = pack8(o);
        }
#ifndef NO_D2
#pragma unroll 1
        for (int pass = 0; pass < 2; ++pass) {
            __syncthreads();
#pragma unroll 4
            for (int k = 0; k < 16; ++k) {
                int ts_ = tid; asm volatile("" : "+v"(ts_));
                const int ci = ts_ + NTHR * k, tile = ci >> 10, hd = tile >> 1, isv = tile & 1, row = (ci & 1023) >> 3, c16 = ci & 7;
                const v4u w = *(const v4u*)(P + (size_t)(row0 + row) * INC + (isv ? OFF_V : OFF_K) + (pass * 4 + hd) * 64 + c16 * 8);
                *(LAS v4u*)(lds + hd * 32768 + isv * 16384 + (isv ? tro(row, c16 * 16) : rro(row, c16))) = w;
            }
            __syncthreads();
            LANEC;
            const int hd = wave >> 1, ih = wave & 1, h = pass * 4 + hd;
            const LAS unsigned char* kimg = lds + hd * 32768; const LAS unsigned char* vimg = kimg + 16384;
            const float lg2f = log_sigmoid_f(a.in[8][l * 8 + h]) * 1.44269504088896f, lg2b = log_sigmoid_f(a.in[9][l * 8 + h]) * 1.44269504088896f;
            bf16x8 qf[2][4];
#pragma unroll
            for (int t = 0; t < 2; ++t)
#pragma unroll
                for (int s = 0; s < 4; ++s) qf[t][s] = *(const bf16x8*)(P + (size_t)(row0 + (2 * ih + t) * 32 + r32) * INC + OFF_Q + h * 64 + 16 * s + 8 * hf);
            f32x16 acc[2][2];
#pragma unroll
            for (int t = 0; t < 2; ++t)
#pragma unroll
                for (int et = 0; et < 2; ++et)
#pragma unroll
                    for (int r = 0; r < 16; ++r) acc[t][et][r] = 0.f;
#pragma unroll
            for (int dir = 0; dir < 2; ++dir) {
                const int i0 = 2 * ih * 32 + r32;
                const float sc0 = dir == 0 ? __builtin_amdgcn_exp2f(lg2f * (float)(i0 + 1)) : __builtin_amdgcn_exp2f(lg2b * (float)(128 - i0));
                const float sc1 = dir == 0 ? __builtin_amdgcn_exp2f(lg2f * (float)(i0 + 33)) : __builtin_amdgcn_exp2f(lg2b * (float)(96 - i0));
                const bf16* sp = ST + st_off(b, c, h, dir) + r32 * 64 + 8 * hf;
#pragma unroll
                for (int s = 0; s < 4; ++s) {
                    const bf16x8 qs0 = scale_frag(qf[0][s], sc0), qs1 = scale_frag(qf[1][s], sc1);
#pragma unroll
                    for (int et = 0; et < 2; ++et) { const bf16x8 A = *(const bf16x8*)(sp + et * 2048 + 16 * s);
                        acc[0][et] = MFMA32(A, qs0, acc[0][et]); acc[1][et] = MFMA32(A, qs1, acc[1][et]); }
                }
            }
#pragma unroll
            for (int t = 0; t < 2; ++t) {
                const int it = 2 * ih + t;
                bf16x8 qq[4];
                if (t == 0) {
#pragma unroll
                    for (int s = 0; s < 4; ++s) qq[s] = qf[0][s];
                } else {
                    asm volatile("" ::: "memory");
#pragma unroll
                    for (int s = 0; s < 4; ++s) qq[s] = *(const bf16x8*)(P + (size_t)(row0 + it * 32 + r32) * INC + OFF_Q + h * 64 + 16 * s + 8 * hf);
                }
#pragma unroll 1
                for (int jt = 0; jt < 4; ++jt) {
                    f32x16 X;
#pragma unroll
                    for (int r = 0; r < 16; ++r) X[r] = 0.f;
#pragma unroll
                    for (int s = 0; s < 4; ++s) { const bf16x8 Kf = *(const LAS bf16x8*)(kimg + rro(jt * 32 + r32, 2 * s + hf)); X = MFMA32(Kf, qq[s], X); }
                    const int rel0 = (it - jt) * 32 + r32 - 4 * hf;
#pragma unroll
                    for (int r = 0; r < 16; ++r) { const int rel = rel0 - ((r & 3) + 8 * (r >> 2));
                        const float x = rel > 0 ? lg2f * (float)rel : lg2b * (float)(-rel);
                        const float dcy = rel == 0 ? 2.0f : __builtin_amdgcn_exp2f(x);
                        X[r] *= dcy; }
#pragma unroll
                    for (int s2 = 0; s2 < 2; ++s2) {
                        v4u pk; pk.x = cvtpk(X[8 * s2], X[8 * s2 + 1]); pk.y = cvtpk(X[8 * s2 + 2], X[8 * s2 + 3]); pk.z = cvtpk(X[8 * s2 + 4], X[8 * s2 + 5]); pk.w = cvtpk(X[8 * s2 + 6], X[8 * s2 + 7]);
                        const bf16x8 Pk = __builtin_bit_cast(bf16x8, pk);
                        const int rlo = jt * 32 + 16 * s2 + 4 * hf + q4;
#pragma unroll
                        for (int et = 0; et < 2; ++et) { const bf16x8 Vt = tr_frag(vimg, rlo, rlo + 8, (et * 32 + 16 * blk + 4 * p4) * 2); acc[t][et] = MFMA32(Vt, Pk, acc[t][et]); }
                    }
                }
                const int row = row0 + (2 * ih + t) * 32 + r32;
                float sum = 0.f;
#pragma unroll
                for (int et = 0; et < 2; ++et)
#pragma unroll
                    for (int r = 0; r < 16; ++r) sum += acc[t][et][r];
                sum += __shfl_xor(sum, 32);
                const float mu = sum * (1.0f / 64.0f); float vs = 0.f;
#pragma unroll
                for (int et = 0; et < 2; ++et)
#pragma unroll
                    for (int r = 0; r < 16; ++r) { const float dlt = acc[t][et][r] - mu; vs += dlt * dlt; }
                vs += __shfl_xor(vs, 32);
                const float rs = 1.0f / sqrtf(vs * (1.0f / 64.0f) + LN_EPS);
#pragma unroll
                for (int et = 0; et < 2; ++et)
#pragma unroll
                    for (int g4 = 0; g4 < 4; ++g4) { const int e0 = et * 32 + 8 * g4 + 4 * hf;
                        const v2u gw = *(const v2u*)(P + (size_t)row * INC + OFF_G + h * 64 + e0);
                        const float g0 = bflo(gw.x), g1 = bfhi(gw.x), g2 = bflo(gw.y), g3 = bfhi(gw.y);
                        const float o0 = (acc[t][et][4 * g4] - mu) * rs, o1 = (acc[t][et][4 * g4 + 1] - mu) * rs, o2 = (acc[t][et][4 * g4 + 2] - mu) * rs, o3 = (acc[t][et][4 * g4 + 3] - mu) * rs;
                        v2u w; w.x = cvtpk(g0 / (1.0f + __expf(-g0)) * o0, g1 / (1.0f + __expf(-g1)) * o1); w.y = cvtpk(g2 / (1.0f + __expf(-g2)) * o2, g3 / (1.0f + __expf(-g3)) * o3);
                        *(v2u*)(Y + (size_t)row * 1024 + 256 + h * 64 + e0) = w; }
            }
        }
#endif
#ifndef NO_D3
        __syncthreads();
        {
            int tq_ = tid; asm volatile("" : "+v"(tq_));
            const int i = tq_ >> 2, part = tq_ & 3;
            const bf16* vp = P + (size_t)(row0 + i) * INC + OFF_VV + part * 64;
            float sum = 0.f;
#pragma unroll 2
            for (int q = 0; q < 8; ++q) { float t8[8]; unpack8(*(const v4u*)(vp + 8 * q), t8);
#pragma unroll
                for (int e = 0; e < 8; ++e) sum += t8[e]; }
            sum += __shfl_xor(sum, 1); sum += __shfl_xor(sum, 2);
            const float mu = sum * (1.0f / 256.0f); float vs = 0.f;
#pragma unroll 2
            for (int q = 0; q < 8; ++q) { float t8[8]; unpack8(*(const v4u*)(vp + 8 * q), t8);
#pragma unroll
                for (int e = 0; e < 8; ++e) { const float dlt = t8[e] - mu; vs += dlt * dlt; } }
            vs += __shfl_xor(vs, 1); vs += __shfl_xor(vs, 2);
            const float rs = 1.0f / sqrtf(vs * (1.0f / 256.0f) + LN_EPS);
#pragma unroll 2
            for (int q = 0; q < 8; ++q) { float t8[8]; unpack8(*(const v4u*)(vp + 8 * q), t8);
                v4u w; w.x = cvtpk((t8[0] - mu) * rs, (t8[1] - mu) * rs); w.y = cvtpk((t8[2] - mu) * rs, (t8[3] - mu) * rs); w.z = cvtpk((t8[4] - mu) * rs, (t8[5] - mu) * rs); w.w = cvtpk((t8[6] - mu) * rs, (t8[7] - mu) * rs);
                *(LAS v4u*)(lds + part * 16384 + tro(i, q * 16)) = w; }
        }
        __syncthreads();
        {
            LANEC;
            const int g = wave >> 1, ph = wave & 1;
            const LAS unsigned char* vn = lds + g * 16384;
            f32x16 acc[2][2];
#pragma unroll
            for (int ct = 0; ct < 2; ++ct)
#pragma unroll
                for (int pt = 0; pt < 2; ++pt)
#pragma unroll
                    for (int r = 0; r < 16; ++r) acc[ct][pt][r] = 0.f;
#pragma unroll 2
            for (int ks = 0; ks < 8; ++ks) {
                const int rlo = 16 * ks + 8 * hf + q4;
                bf16x8 A[2], B[2];
#pragma unroll
                for (int ct = 0; ct < 2; ++ct) A[ct] = tr_frag(vn, rlo, rlo + 4, (ct * 32 + 16 * blk + 4 * p4) * 2);
#pragma unroll
                for (int pt = 0; pt < 2; ++pt) { const float* wp = sguw + ((size_t)g * 128 + ph * 64 + pt * 32 + r32) * 128 + 16 * ks + 8 * hf; B[pt] = f32x8_to_frag(*(const f32x4*)wp, *(const f32x4*)(wp + 4)); }
#pragma unroll
                for (int ct = 0; ct < 2; ++ct)
#pragma unroll
                    for (int pt = 0; pt < 2; ++pt) acc[ct][pt] = MFMA32(A[ct], B[pt], acc[ct][pt]);
            }
#pragma unroll
            for (int pt = 0; pt < 2; ++pt) {
                const int p = ph * 64 + pt * 32 + r32; const int row = row0 + p; const float bias = sgub[g * 128 + p];
#pragma unroll
                for (int ct = 0; ct < 2; ++ct)
#pragma unroll
                    for (int g4 = 0; g4 < 4; ++g4) { const int c0 = ct * 32 + 8 * g4 + 4 * hf;
                        const v2u uw = *(const v2u*)(P + (size_t)row * INC + OFF_U + g * 64 + c0);
                        v2u w; w.x = cvtpk(bflo(uw.x) * (acc[ct][pt][4 * g4] + bias), bfhi(uw.x) * (acc[ct][pt][4 * g4 + 1] + bias));
                        w.y = cvtpk(bflo(uw.y) * (acc[ct][pt][4 * g4 + 2] + bias), bfhi(uw.y) * (acc[ct][pt][4 * g4 + 3] + bias));
                        *(v2u*)(Y + (size_t)row * 1024 + 768 + g * 64 + c0) = w; }
            }
        }
#endif
        __syncthreads();
    }
}
constexpr int LCNT_OFF = LDSCTL_OFF + 4096, LG_OFF = LDSCTL_OFF + 4352;
__device__ __forceinline__ void phase_f2(const Args& a, int l, LAS unsigned char* lds, int tid, int lane, int wave) {
    LAS int* lcnt = (LAS int*)(lds + LCNT_OFF); LAS float* LG = (LAS float*)(lds + LG_OFF);
    LAS unsigned char* HI = lds; LAS unsigned char* LO = lds + 65536; LAS float* PART = (LAS float*)lds;
    const int r32 = lane & 31, hf = lane >> 5;
    const int nrows = l == 0 ? NROWS : NLAT, ntiles = nrows >> 5;
    const float* mod = (const float*)(a.ws + WS_MOD) + l * 9 * 6144;
    const float* lng = a.in[13] + l * 1024; const float* lnb = a.in[14] + l * 1024;
    const float* rgb = a.in[16] + l * 4; const float* reb = a.in[18] + l * 32;
    bf16* Hb = (bf16*)(a.ws + WS_HB); unsigned* tok = (unsigned*)(a.ws + WS_TOK); float* xctx = (float*)(a.ws + WS_XCTX);
    const bf16* wr = (const bf16*)(a.ws + WS_WR) + (size_t)l * 2 * 64 * 1024;
    bf16x8 Bh[8][2], Bl[8][2];
#pragma unroll
    for (int ks = 0; ks < 8; ++ks)
#pragma unroll
        for (int ct = 0; ct < 2; ++ct) { const bf16* p = wr + (size_t)(ct * 32 + r32) * 1024 + wave * 128 + 16 * ks + 8 * hf; Bh[ks][ct] = *(const bf16x8*)p; Bl[ks][ct] = *(const bf16x8*)(p + 64 * 1024); }
    __syncthreads();
    if (tid < 32) lcnt[tid] = 0;
    __syncthreads();
    for (int T = blockIdx.x; T < ntiles; T += gridDim.x) {
#pragma unroll 1
        for (int rh = 0; rh < 2; ++rh) {
        f32x4 vv[2][4];
#pragma unroll
        for (int rq = 0; rq < 2; ++rq) { const int row = 32 * T + 4 * wave + 2 * rh + rq;
            const float* xr = row < NLAT ? a.out + (size_t)row * 1024 : xctx + (size_t)(row - NLAT) * 1024;
#pragma unroll
            for (int j = 0; j < 4; ++j) vv[rq][j] = *(const f32x4*)(xr + (lane + 64 * j) * 4); }
#pragma unroll
        for (int rq = 0; rq < 2; ++rq) {
            const int lr = 4 * wave + 2 * rh + rq, row = 32 * T + lr;
            float* xr = row < NLAT ? a.out + (size_t)row * 1024 : xctx + (size_t)(row - NLAT) * 1024;
            const float* m0 = mod + (row < NLAT ? (row >> 12) : 8) * 6144;
            f32x4 v[4]; float s = 0.f;
#pragma unroll
            for (int j = 0; j < 4; ++j) { v[j] = vv[rq][j]; s += (v[j].x + v[j].y) + (v[j].z + v[j].w); }
            const float mean = wave_sum(s) * (1.0f / 1024.0f); float s2 = 0.f;
#pragma unroll
            for (int j = 0; j < 4; ++j) { v[j] = v[j] - mean; s2 += (v[j].x * v[j].x + v[j].y * v[j].y) + (v[j].z * v[j].z + v[j].w * v[j].w); }
            const float rstd = 1.0f / sqrtf(wave_sum(s2) * (1.0f / 1024.0f) + LN_EPS);
#pragma unroll
            for (int j = 0; j < 4; ++j) { const int idx = (lane + 64 * j) * 4;
                const f32x4 x1 = v[j] * rstd * *(const f32x4*)(lng + idx) + *(const f32x4*)(lnb + idx);
                *(f32x4*)(xr + idx) = x1;
                const f32x4 hm = x1 * (*(const f32x4*)(m0 + 4096 + idx) + 1.0f) + *(const f32x4*)(m0 + 3072 + idx);
                v2u h; h.x = cvtpk(hm.x, hm.y); h.y = cvtpk(hm.z, hm.w);
                v2u lo; lo.x = cvtpk(hm.x - bflo(h.x), hm.y - bfhi(h.x)); lo.y = cvtpk(hm.z - bflo(h.y), hm.w - bfhi(h.y));
                *(v2u*)(Hb + (size_t)row * 1024 + idx) = h;
                const int off = lr * 2048 + (((((lane + 64 * j) >> 1)) ^ (lr & 15)) << 4) + (lane & 1) * 8;
                *(LAS v2u*)(HI + off) = h; *(LAS v2u*)(LO + off) = lo; }
        }
        }
        __syncthreads();
        f32x16 acc[2];
#pragma unroll
        for (int r = 0; r < 16; ++r) { acc[0][r] = 0.f; acc[1][r] = 0.f; }
#pragma unroll
        for (int ks = 0; ks < 8; ++ks) { const int off = r32 * 2048 + (((wave * 16 + 2 * ks + hf) ^ (r32 & 15)) << 4);
            const bf16x8 Ah = *(const LAS bf16x8*)(HI + off), Al = *(const LAS bf16x8*)(LO + off);
#pragma unroll
            for (int ct = 0; ct < 2; ++ct) { acc[ct] = MFMA32(Ah, Bh[ks][ct], acc[ct]); acc[ct] = MFMA32(Ah, Bl[ks][ct], acc[ct]); acc[ct] = MFMA32(Al, Bh[ks][ct], acc[ct]); } }
        __syncthreads();
#pragma unroll
        for (int ct = 0; ct < 2; ++ct)
#pragma unroll
            for (int r = 0; r < 16; ++r) PART[(wave * 32 + crow(r, hf)) * 64 + ct * 32 + r32] = acc[ct][r];
        __syncthreads();
        { const int row = tid >> 4, cg = tid & 15;
#pragma unroll
          for (int q = 0; q < 3; ++q) { const int col = cg + 16 * q; if (col < 36) { float sum = 0.f;
#pragma unroll
                  for (int w = 0; w < 8; ++w) sum += PART[(w * 32 + row) * 64 + col];
                  LG[row * 40 + col] = sum; } } }
        __syncthreads();
        if (tid < 32) { const int row = 32 * T + tid; const LAS float* lgp = LG + tid * 40;
            float lg[4];
#pragma unroll
            for (int g = 0; g < 4; ++g) lg[g] = lgp[g] + rgb[g];
            int gi = 0; float gm = lg[0];
#pragma unroll
            for (int g = 1; g < 4; ++g) if (lg[g] > gm) { gm = lg[g]; gi = g; }
            float gden = 0.f;
#pragma unroll
            for (int g = 0; g < 4; ++g) gden += expf(lg[g] - gm);
            const float gprob = 1.0f / gden;
            float le[8];
#pragma unroll
            for (int e = 0; e < 8; ++e) le[e] = lgp[4 + gi * 8 + e] + reb[gi * 8 + e];
            int i1 = 0; float m1 = le[0];
#pragma unroll
            for (int e = 1; e < 8; ++e) if (le[e] > m1) { m1 = le[e]; i1 = e; }
            int i2 = -1; float m2 = -3.0e38f;
#pragma unroll
            for (int e = 0; e < 8; ++e) if (e != i1 && le[e] > m2) { m2 = le[e]; i2 = e; }
            const float p2 = expf(m2 - m1), inv = 1.0f / (1.0f + p2);
            const float gate0 = gprob * inv, gate1 = gprob * p2 * inv;
            const int e0 = gi * 8 + i1, e1 = gi * 8 + i2;
            const int p0 = __hip_atomic_fetch_add(lcnt + e0, 1, __ATOMIC_RELAXED, __HIP_MEMORY_SCOPE_WORKGROUP);
            const int p1 = __hip_atomic_fetch_add(lcnt + e1, 1, __ATOMIC_RELAXED, __HIP_MEMORY_SCOPE_WORKGROUP);
            unsigned* t = tok + (size_t)row * 8; t[0] = (unsigned)e0 | ((unsigned)e1 << 8); t[1] = (unsigned)p0; t[2] = (unsigned)p1;
            t[4] = __builtin_bit_cast(unsigned, gate0); t[5] = __builtin_bit_cast(unsigned, gate1); }
    }
    __syncthreads();
    if (tid < 32) ((unsigned*)(a.ws + WS_CTL))[CW_WGCNT + (l * 256 + blockIdx.x) * 32 + tid] = (unsigned)lcnt[tid];
    __syncthreads();
}
#ifndef MK_PER_PHASE
#define MK_PER_PHASE 0
#endif
constexpr int N_PHASES = 22;

__global__ void __launch_bounds__(NTHR, 2) hybrid_fwd(Args args) {
    extern __shared__ __attribute__((aligned(16))) unsigned char lds_raw[];
    LAS unsigned char* lds = (LAS unsigned char*)lds_raw;
    const int tid0 = threadIdx.x;
    for (int u = tid0; u < (LDS_BYTES - LDSCTL_OFF) / 4; u += NTHR) ((LAS unsigned*)(lds + LDSCTL_OFF))[u] = 0u;
#define TIDS int tid = threadIdx.x; asm volatile("" : "+v"(tid)); const int lane = tid & 63, wave = __builtin_amdgcn_readfirstlane(tid >> 6); (void)lane; (void)wave
    __syncthreads();
    unsigned* ctl = (unsigned*)(args.ws + WS_CTL);
    XcdBarrier bar; bar.bar = ctl + CW_BAR; bar.x = 0; bar.st = nullptr;
    if (!MK_PER_PHASE) bar = xcd_barrier_post(ctl + CW_BAR, (volatile LAS unsigned*)(lds + MISC_OFF + 32));
    const int lo = args.ph_lo, hi = args.ph_hi;
#ifndef PHMASK
#define PHMASK 0xFFFFFFu
#endif
#define PHON(k) (((PHMASK) >> ((k) < 2 ? (k) : 2 + ((k) - 2) % 10)) & 1u)
#define IN(k) (PHON(k) && lo <= (k) && (k) < hi)
#ifndef REPMASK
#define REPMASK 0u
#endif
#define NREP(k) (1 + (int)(((REPMASK) >> ((k) < 2 ? (k) : 2 + ((k) - 2) % 10)) & 1u))
#define SEAM(k) do { if (IN(k) && IN((k) + 1)) xcd_barrier(bar); } while (0)

    if (IN(0)) for (int rep = 0; rep < NREP(0); ++rep) { TIDS; phase_p0(args, lds, tid, lane, wave); }
    SEAM(0);
    if (IN(1)) for (int rep = 0; rep < NREP(1); ++rep) { TIDS; phase_p1(args, lane, wave); }
    SEAM(1);
    for (int l = 0; l < 2; ++l) {
        const int pb = 2 + 10 * l;
        bf16* Hb = (bf16*)(args.ws + WS_HB);
        if (IN(pb + 0)) for (int rep = 0; rep < NREP(2); ++rep) {
            pg8::Gemm g{Hb, (const bf16*)(args.ws + WS_WIN) + (size_t)l * INC * 1024, NROWS, INC, 1024}; pg8::StaticOrder S; S.init(NROWS, INC, (int)gridDim.x, (int)blockIdx.x);
            pg8::EpiBf16<0> E{(bf16*)(args.ws + WS_P), INC, nullptr, 0, 0, 1.0f};
            pg8::gemm_phase<pg8::EpiBf16<0>, pg8::StaticOrder, true, true>(lds, g, S, E);
        }
        SEAM(pb + 0);
        if (IN(pb + 1)) for (int rep = 0; rep < NREP(3); ++rep) { TIDS; phase_b_mfma(args, l, lds, tid, lane, wave); }
        SEAM(pb + 1);
        if (IN(pb + 2)) { TIDS; phase_c(args, l, tid); }
        SEAM(pb + 2);
        if (IN(pb + 3)) for (int rep = 0; rep < NREP(5); ++rep) { TIDS; phase_d_mfma(args, l, lds, tid, lane, wave); }
        SEAM(pb + 3);
        if (IN(pb + 4)) for (int rep = 0; rep < (l == 0 ? NREP(6) : 1); ++rep) {
            const int M = l == 0 ? NROWS : NLAT;
            pg8::Gemm g{(const bf16*)(args.ws + WS_YMIX), (const bf16*)(args.ws + WS_WOUT) + (size_t)l * 1024 * 1024, M, 1024, 1024}; pg8::StaticOrder S; S.init(M, 1024, (int)gridDim.x, (int)blockIdx.x);
            float* xctx = (float*)(args.ws + WS_XCTX);
            pg8::EpiResid E{l == 0 ? args.in[0] : args.out, l == 0 ? args.in[2] : xctx, args.out, xctx, (const float*)(args.ws + WS_MOD) + l * 9 * 6144, ALPHA};
            pg8::gemm_phase<pg8::EpiResid, pg8::StaticOrder, true, true>(lds, g, S, E);
        }
        SEAM(pb + 4);
        if (IN(pb + 5)) { TIDS; phase_f2(args, l, lds, tid, lane, wave); }
        SEAM(pb + 5);
        if (IN(pb + 6)) for (int rep = 0; rep < NREP(8); ++rep) { TIDS; phase_g(args, l, lds, tid, lane, wave); }
        SEAM(pb + 6);
        if (IN(pb + 7)) for (int rep = 0; rep < NREP(9); ++rep) {
            int npan; { TIDS; npan = build_p2e(args, l, lds, tid); }
            pg8::Gemm g{(const bf16*)(args.ws + WS_XB), (const bf16*)(args.ws + WS_WGU) + (size_t)l * 32 * 1024 * 1024, npan * 256, 1024, 1024};
            pg8::MoeOrder S{(const LAS unsigned char*)(lds + P2E_OFF), npan * 4, (int)gridDim.x, (int)blockIdx.x};
            pg8::EpiGLU E{(bf16*)(args.ws + WS_HH)};
            pg8::gemm_phase<pg8::EpiGLU, pg8::MoeOrder, true, true>(lds, g, S, E);
        }
        SEAM(pb + 7);
        if (IN(pb + 8)) for (int rep = 0; rep < NREP(10); ++rep) {
            int npan; { TIDS; npan = build_p2e(args, l, lds, tid); }
            pg8::Gemm g{(const bf16*)(args.ws + WS_HH), (const bf16*)(args.ws + WS_WD) + (size_t)l * 32 * 1024 * 512, npan * 256, 1024, 512};
            pg8::MoeOrder S{(const LAS unsigned char*)(lds + P2E_OFF), npan * 4, (int)gridDim.x, (int)blockIdx.x};
            pg8::EpiY E{(bf16*)(args.ws + WS_Y)};
            pg8::gemm_phase<pg8::EpiY, pg8::MoeOrder, true, true>(lds, g, S, E);
        }
        SEAM(pb + 8);
        if (IN(pb + 9)) { if (NREP(11) > 1) { TIDS; phase_j(args, l, lane, wave, true); } TIDS; phase_j(args, l, lane, wave); }
        SEAM(pb + 9);
    }
#undef IN
#undef SEAM
}

extern "C" void kernel_launch(void* const* d_in, const int* in_sizes, int n_in, void* d_out, int out_size, void* d_ws, size_t ws_size, hipStream_t stream) {
    static int grid = 0;
    if (grid == 0) {
        if (n_in != 24 || in_sizes[0] != NLAT * DM || out_size != NLAT * DM || ws_size < WS_END) { fprintf(stderr, "kernel_launch: unexpected problem (n_in %d, ws %zu < %zu?)\n", n_in, ws_size, (size_t)WS_END); grid = -1; return; }
        int dev = 0, cus = 0, per_cu = 0;
        if (hipGetDevice(&dev) != hipSuccess || hipDeviceGetAttribute(&cus, hipDeviceAttributeMultiprocessorCount, dev) != hipSuccess) { grid = -1; return; }
        if (hipFuncSetAttribute((const void*)hybrid_fwd, hipFuncAttributeMaxDynamicSharedMemorySize, LDS_BYTES) != hipSuccess) { grid = -1; return; }
        if (hipOccupancyMaxActiveBlocksPerMultiprocessor(&per_cu, (const void*)hybrid_fwd, NTHR, LDS_BYTES) != hipSuccess || per_cu < 1) { fprintf(stderr, "kernel_launch: occupancy query says %d\n", per_cu); }
        (void)hipGetLastError();
        grid = cus;
        if (grid != 256) { fprintf(stderr, "kernel_launch: built for 256 CUs, device has %d\n", cus); grid = -1; return; }
    }
    if (grid < 0) return;
    if (hipMemsetAsync((char*)d_ws + WS_CTL, 0, CTL_ZERO_BYTES, stream) != hipSuccess) return;
    Args a{};
    for (int i = 0; i < 24; ++i) a.in[i] = (const float*)d_in[i];
    a.out = (float*)d_out; a.ws = (unsigned char*)d_ws;
#if MK_PER_PHASE
    for (int p = 0; p < N_PHASES; ++p) { a.ph_lo = p; a.ph_hi = p + 1; hipLaunchKernelGGL(hybrid_fwd, dim3(grid), dim3(NTHR), LDS_BYTES, stream, a); }
#else
    a.ph_lo = 0; a.ph_hi = N_PHASES;
    hipLaunchKernelGGL(hybrid_fwd, dim3(grid), dim3(NTHR), LDS_BYTES, stream, a);
#endif
}
```

```cpp
#include <hip/hip_runtime.h>
#include <cstdio>
#include <cstdint>
#include <cstddef>
namespace pg8 {
#define PG8_LAS __attribute__((address_space(3)))
typedef unsigned short bf16_t;
typedef short bf16x8 __attribute__((ext_vector_type(8)));
typedef float f32x4 __attribute__((ext_vector_type(4)));
typedef unsigned u32x4 __attribute__((ext_vector_type(4)));
constexpr int BM = 256, BK = 64, HALF = 128, HTB = HALF * BK * 2  , STAGE_BYTES = 8 * HTB, NXCD = 8, WGM = 8;

__host__ __device__ __forceinline__ int lds_byte(int r, int c) { const int st = (r >> 4) * 2 + (c >> 5), rr = r & 15, cc = c & 31, ob = rr * 64 + cc * 2; return st * 1024 + (ob ^ (((ob >> 9) & 1) << 5)); }
__host__ __device__ __forceinline__ void stage_rc(int b, int& R, int& C) { const int st = b / 1024, sb = b % 1024, swz = sb ^ (((sb >> 9) & 1) << 5); R = (st >> 1) * 16 + swz / 64; C = (st & 1) * 32 + (swz % 64) / 2; }
__host__ __device__ __forceinline__ int perm32(int rho) { const int n = rho >> 4, i = rho & 15; return 8 * (i >> 2) + 4 * n + (i & 3); }

struct Unit { int pm, pn; };
struct Gemm { const bf16_t* A; const bf16_t* Bt; int M, N, K; };

struct StaticOrder {
    int nM, nN, nwg, G, c;
    __host__ __device__ void init(int M, int N, int G_, int c_) { nM = M / BM; nN = N / BM; nwg = nM * nN; G = G_; c = c_; }
    __host__ __device__ bool next(int i, Unit& u) const {
        const long L = (long)i * G + c; if (L >= nwg) return false;
        int wgid = (int)L; { const int q = nwg / NXCD, r = nwg % NXCD, xcd = wgid % NXCD, off = wgid / NXCD; wgid = (xcd < r ? xcd * (q + 1) : r * (q + 1) + (xcd - r) * q) + off; }
        const int nig = WGM * nN, gid = wgid / nig, fm = gid * WGM, gsz = (nM - fm) < WGM ? (nM - fm) : WGM;
        u.pm = fm + ((wgid % nig) % gsz); u.pn = (wgid % nig) / gsz; return true;
    }
    __device__ __forceinline__ void a_ready(const Unit&) const {}
    __device__ __forceinline__ void done(const Unit&) const {}
};

__device__ __forceinline__ unsigned cvt_pk_bf16(float lo, float hi) { unsigned r; asm volatile("v_cvt_pk_bf16_f32 %0, %1, %2" : "=v"(r) : "v"(lo), "v"(hi)); return r; }
typedef float f32x2 __attribute__((ext_vector_type(2)));
__device__ __forceinline__ f32x2 gelu_pk(f32x2 v) {
    const f32x2 av = __builtin_elementwise_abs(v), d = av * 0.2316418882f + 1.0f;
    f32x2 t; t.x = __builtin_amdgcn_rcpf(d.x); t.y = __builtin_amdgcn_rcpf(d.y);
    f32x2 q = t * 0.5307027145f + (-0.7265760135f); q = q * t + 0.7107068705f; q = q * t + (-0.142248368f); q = q * t + 0.127414796f; q = q * t;
    const f32x2 s = (v * v) * (-0.72134752044f);
    f32x2 e; e.x = __builtin_amdgcn_exp2f(s.x); e.y = __builtin_amdgcn_exp2f(s.y);
    const f32x2 m = v * (q * e), r = v - m;
    f32x2 o; o.x = v.x < 0.f ? m.x : r.x; o.y = v.y < 0.f ? m.y : r.y; return o;
}

template <int ACT  > struct EpiBf16 {
    static constexpr bool PERM = true, AFTER_DRAIN = false; static_assert(ACT == 0 || ACT == 1, "EpiBf16: ACT is 0 (none) or 1 (gelu_pk)");
    bf16_t* O; int ldc; const float* bias; int split_cols; size_t split_stride; float scale0;
    __device__ __forceinline__ void operator()(const f32x4 (&acc)[2][2][4][2], const Unit& u, int wr, int wc, int fr, int fq) const {
        const int row0 = u.pm * BM + wr * 64 + fr; int colt = u.pn * BM; bf16_t* base = O;
        float sc = 1.f; if (split_cols) { const int t = colt / split_cols; base += (size_t)t * split_stride; colt -= t * split_cols; if (t == 0) sc = scale0; }
        const int col0 = colt + wc * 32 + 8 * fq, bcol0 = u.pn * BM + wc * 32 + 8 * fq;
        f32x4 bv[2][2];
#pragma unroll
        for (int bj = 0; bj < 2; ++bj)
#pragma unroll
            for (int n = 0; n < 2; ++n) bv[bj][n] = bias ? *(const f32x4*)(bias + bcol0 + bj * HALF + 4 * n) : (f32x4){0.f, 0.f, 0.f, 0.f};
#pragma unroll
        for (int ai = 0; ai < 2; ++ai)
#pragma unroll
            for (int m = 0; m < 4; ++m) { bf16_t* rowp = base + (size_t)(row0 + ai * HALF + m * 16) * ldc + col0;
#pragma unroll
                for (int bj = 0; bj < 2; ++bj) { f32x4 v0 = acc[ai][bj][m][0] + bv[bj][0], v1 = acc[ai][bj][m][1] + bv[bj][1];
                    if (ACT == 1) { f32x2 a = gelu_pk((f32x2){v0[0], v0[1]}), b = gelu_pk((f32x2){v0[2], v0[3]}), c = gelu_pk((f32x2){v1[0], v1[1]}), d = gelu_pk((f32x2){v1[2], v1[3]});
                        v0 = (f32x4){a.x, a.y, b.x, b.y}; v1 = (f32x4){c.x, c.y, d.x, d.y}; }
                    v0 = v0 * sc; v1 = v1 * sc; u32x4 w; w.x = cvt_pk_bf16(v0[0], v0[1]); w.y = cvt_pk_bf16(v0[2], v0[3]); w.z = cvt_pk_bf16(v1[0], v1[1]); w.w = cvt_pk_bf16(v1[2], v1[3]);
                    *(u32x4*)(rowp + bj * HALF) = w; } }
    }
};
__device__ __forceinline__ float silu_f(float x) { return x / (1.0f + __expf(-x)); }
struct EpiResid {
    static constexpr bool PERM = false, AFTER_DRAIN = false;
    const float* xin_lat; const float* xin_ctx; float* xo_lat; float* xo_ctx; const float* mod; float alpha;
    __device__ __forceinline__ void operator()(const f32x4 (&acc)[2][2][4][2], const Unit& u, int wr, int wc, int fr, int fq) const {
        const int prow0 = u.pm * BM; const bool isc = prow0 >= 32768;
        const float* xin = isc ? xin_ctx + (size_t)(prow0 - 32768) * 1024 : xin_lat + (size_t)prow0 * 1024;
        float* xo = isc ? xo_ctx + (size_t)(prow0 - 32768) * 1024 : xo_lat + (size_t)prow0 * 1024;
        const float* g1 = mod + (isc ? 8 : (prow0 >> 12)) * 6144 + 2048;
        const int col0 = u.pn * BM + wc * 32 + 4 * fq;
        f32x4 gv[2][2];
#pragma unroll
        for (int bj = 0; bj < 2; ++bj)
#pragma unroll
            for (int n = 0; n < 2; ++n) gv[bj][n] = *(const f32x4*)(g1 + col0 + bj * HALF + n * 16);
#pragma unroll
        for (int ai = 0; ai < 2; ++ai)
#pragma unroll
            for (int m = 0; m < 4; ++m) { const size_t off = (size_t)(ai * HALF + wr * 64 + m * 16 + fr) * 1024 + col0;
#pragma unroll
                for (int bj = 0; bj < 2; ++bj)
#pragma unroll
                    for (int n = 0; n < 2; ++n) { const f32x4 xv = *(const f32x4*)(xin + off + bj * HALF + n * 16);
                        *(f32x4*)(xo + off + bj * HALF + n * 16) = xv * alpha + gv[bj][n] * acc[ai][bj][m][n]; }
                if (m & 1) asm volatile("" ::: "memory"); }
    }
};
struct EpiGLU {
    static constexpr bool PERM = true, AFTER_DRAIN = false;
    bf16_t* Hh;
    __device__ __forceinline__ void operator()(const f32x4 (&acc)[2][2][4][2], const Unit& u, int wr, int wc, int fr, int fq) const {
        const int row0 = u.pm * BM + wr * 64 + fr; const int col0 = (u.pn & 3) * 128 + wc * 32 + 8 * fq;
#pragma unroll
        for (int ai = 0; ai < 2; ++ai)
#pragma unroll
            for (int m = 0; m < 4; ++m) { bf16_t* rowp = Hh + (size_t)(row0 + ai * HALF + m * 16) * 512 + col0;
                const f32x4 g0 = acc[ai][0][m][0], g1 = acc[ai][0][m][1], u0 = acc[ai][1][m][0], u1 = acc[ai][1][m][1];
                u32x4 w; w.x = cvt_pk_bf16(silu_f(g0[0]) * u0[0], silu_f(g0[1]) * u0[1]); w.y = cvt_pk_bf16(silu_f(g0[2]) * u0[2], silu_f(g0[3]) * u0[3]);
                w.z = cvt_pk_bf16(silu_f(g1[0]) * u1[0], silu_f(g1[1]) * u1[1]); w.w = cvt_pk_bf16(silu_f(g1[2]) * u1[2], silu_f(g1[3]) * u1[3]);
                *(u32x4*)rowp = w; }
    }
};
struct EpiY {
    static constexpr bool PERM = true, AFTER_DRAIN = false;
    bf16_t* O;
    __device__ __forceinline__ void operator()(const f32x4 (&acc)[2][2][4][2], const Unit& u, int wr, int wc, int fr, int fq) const {
        const int row0 = u.pm * BM + wr * 64 + fr; const int col0 = (u.pn & 3) * BM + wc * 32 + 8 * fq;
#pragma unroll
        for (int ai = 0; ai < 2; ++ai)
#pragma unroll
            for (int m = 0; m < 4; ++m) { bf16_t* rowp = O + (size_t)(row0 + ai * HALF + m * 16) * 1024 + col0;
#pragma unroll
                for (int bj = 0; bj < 2; ++bj) { const f32x4 v0 = acc[ai][bj][m][0], v1 = acc[ai][bj][m][1];
                    u32x4 w; w.x = cvt_pk_bf16(v0[0], v0[1]); w.y = cvt_pk_bf16(v0[2], v0[3]); w.z = cvt_pk_bf16(v1[0], v1[1]); w.w = cvt_pk_bf16(v1[2], v1[3]);
                    *(u32x4*)(rowp + bj * HALF) = w; } }
    }
};
struct MoeOrder {
    const PG8_LAS unsigned char* p2e; int nunits, G, c;
    __device__ __forceinline__ bool next(int i, Unit& u) const {
        const int L = i * G + c; if (L >= nunits) return false;
        u.pm = L >> 2; u.pn = (int)p2e[L >> 2] * 4 + (L & 3); return true;
    }
    __device__ __forceinline__ void a_ready(const Unit&) const {}
    __device__ __forceinline__ void done(const Unit&) const {}
};
template <class Epi, class Sched, bool ALIGN_EPI = false, bool SP2 = false>
__device__ __forceinline__ void gemm_phase(PG8_LAS unsigned char* lds, const Gemm g, const Sched& S, const Epi& E) {
    int tid_ = threadIdx.x; asm volatile("" : "+v"(tid_));
    const int tid = tid_, wid = __builtin_amdgcn_readfirstlane(tid >> 6), lane = tid & 63, wr = wid >> 2, wc = wid & 3, fr = lane & 15, fq = lane >> 4;
    const int K = g.K, nt = K / BK;
    unsigned voffA[2], voffB[2];
#pragma unroll
    for (int i = 0; i < 2; ++i) { int R, C; stage_rc(tid * 16 + i * 8192, R, C); const int Rb = Epi::PERM ? ((R & ~31) + perm32(R & 31)) : R;
        voffA[i] = (unsigned)(R * K + C) * 2u; voffB[i] = (unsigned)(Rb * K + C) * 2u; }
    const size_t kstep = (size_t)(BK * 2);
    const size_t hstep = (size_t)HALF * K * 2;
    const size_t tstep = 2 * hstep;
    const unsigned ldsw = (unsigned)wid * 1024u;
    const int aoff = lds_byte(wr * 64 + fr, fq * 8), boff = lds_byte(wc * 32 + fr, fq * 8);
#define PG8_SA(b, h) (((b) * 2 + (h)) * HTB)
#define PG8_SB(b, h) ((4 + (b) * 2 + (h)) * HTB)
#define PG8_STAGE(bufoff, gbase, voff) do { _Pragma("unroll") for (int _i = 0; _i < 2; ++_i) \
        __builtin_amdgcn_global_load_lds((const unsigned*)((const char*)(gbase) + (voff)[_i]), (PG8_LAS unsigned*)(lds + (bufoff) + ldsw + _i * 8192), 16, 0, 0); } while (0)
#define PG8_LDA(dst, b, h) do { _Pragma("unroll") for (int m = 0; m < 4; ++m) _Pragma("unroll") for (int k = 0; k < 2; ++k) dst[m][k] = *(const PG8_LAS bf16x8*)(lds + PG8_SA(b, h) + aoff + m * 2048 + k * 1024); } while (0)
#define PG8_LDB(dst, b, h) do { _Pragma("unroll") for (int n = 0; n < 2; ++n) _Pragma("unroll") for (int k = 0; k < 2; ++k) dst[n][k] = *(const PG8_LAS bf16x8*)(lds + PG8_SB(b, h) + boff + n * 2048 + k * 1024); } while (0)
#define PG8_MMA(ai, bj, At, Bt) do { __builtin_amdgcn_s_setprio(1); _Pragma("unroll") for (int m = 0; m < 4; ++m) _Pragma("unroll") for (int n = 0; n < 2; ++n) _Pragma("unroll") for (int k = 0; k < 2; ++k) \
        acc[ai][bj][m][n] = __builtin_amdgcn_mfma_f32_16x16x32_bf16(Bt[n][k], At[m][k], acc[ai][bj][m][n], 0, 0, 0); __builtin_amdgcn_s_setprio(0); } while (0)
#define PG8_WAIT_V(n) asm volatile("s_waitcnt vmcnt(" #n ")" ::: "memory")
#define PG8_WAIT_L(n) asm volatile("s_waitcnt lgkmcnt(" #n ")" ::: "memory")
#define PG8_BAR __builtin_amdgcn_s_barrier()
#define PG8_SCHED __builtin_amdgcn_sched_barrier(0)
    Unit cur, nxt; int ui = 0;
    if (!S.next(0, cur)) return;
    f32x4 acc[2][2][4][2];
#pragma unroll
    for (int a = 0; a < 2; ++a)
#pragma unroll
        for (int b = 0; b < 2; ++b)
#pragma unroll
            for (int m = 0; m < 4; ++m)
#pragma unroll
                for (int n = 0; n < 2; ++n) acc[a][b][m][n] = (f32x4){0.f, 0.f, 0.f, 0.f};
    bf16x8 At[4][2], B0[2][2], B1[2][2];
    const char* cA = (const char*)g.A + (size_t)cur.pm * tstep; const char* cB = (const char*)g.Bt + (size_t)cur.pn * tstep;
    S.a_ready(cur);
    if constexpr (SP2) {
        PG8_STAGE(PG8_SB(0, 0), cB, voffB); PG8_STAGE(PG8_SB(0, 1), cB + hstep, voffB); PG8_STAGE(PG8_SA(0, 0), cA, voffA); PG8_STAGE(PG8_SA(0, 1), cA + hstep, voffA);
        if (wr == 1) PG8_BAR;
        PG8_WAIT_V(2); PG8_BAR;
        PG8_STAGE(PG8_SB(1, 0), cB + kstep, voffB); PG8_STAGE(PG8_SA(1, 0), cA + kstep, voffA); PG8_STAGE(PG8_SB(1, 1), cB + hstep + kstep, voffB);
        PG8_WAIT_V(6); PG8_BAR;
    } else {
        PG8_STAGE(PG8_SB(0, 0), cB, voffB); PG8_STAGE(PG8_SA(0, 0), cA, voffA); PG8_STAGE(PG8_SB(0, 1), cB + hstep, voffB); PG8_STAGE(PG8_SA(0, 1), cA + hstep, voffA);
        if (wr == 1) PG8_BAR;
        PG8_WAIT_V(4); PG8_BAR;
        PG8_STAGE(PG8_SB(1, 0), cB + kstep, voffB); PG8_STAGE(PG8_SA(1, 0), cA + kstep, voffA); PG8_STAGE(PG8_SB(1, 1), cB + hstep + kstep, voffB);
        PG8_WAIT_V(6); PG8_BAR;
    }
    for (;;) {
        const bool has_next = S.next(ui + 1, nxt);
        const char* nA = has_next ? (const char*)g.A + (size_t)nxt.pm * tstep : cA; const char* nB = has_next ? (const char*)g.Bt + (size_t)nxt.pn * tstep : cB;
        for (int t = 0; t < nt; t += 2) {
            const bool last = (t == nt - 2);
            const char* a1 = cA + (size_t)(t + 1) * kstep;
            const char* a2 = last ? nA : cA + (size_t)(t + 2) * kstep; const char* b2 = last ? nB : cB + (size_t)(t + 2) * kstep;
            const char* a3 = a2 + kstep; const char* b3 = b2 + kstep;
            if (last && has_next) S.a_ready(nxt);
            if constexpr (SP2) {
            PG8_LDB(B0, 0, 0); PG8_LDB(B1, 0, 1); PG8_SCHED; PG8_LDA(At, 0, 0); PG8_STAGE(PG8_SA(1, 1), a1 + hstep, voffA);
            PG8_WAIT_V(8); PG8_WAIT_L(0); PG8_BAR; PG8_MMA(0, 0, At, B0); PG8_MMA(0, 1, At, B1); PG8_BAR; PG8_SCHED;
            PG8_LDA(At, 0, 1); PG8_STAGE(PG8_SB(0, 0), b2, voffB); PG8_STAGE(PG8_SB(0, 1), b2 + hstep, voffB); PG8_STAGE(PG8_SA(0, 0), a2, voffA);
            PG8_WAIT_V(8); PG8_WAIT_L(0); PG8_BAR; PG8_MMA(1, 0, At, B0); PG8_MMA(1, 1, At, B1); PG8_BAR; PG8_SCHED;
            PG8_LDB(B0, 1, 0); PG8_LDB(B1, 1, 1); PG8_SCHED; PG8_LDA(At, 1, 0); PG8_STAGE(PG8_SA(0, 1), a2 + hstep, voffA);
            PG8_WAIT_V(8); PG8_WAIT_L(0); PG8_BAR; PG8_MMA(0, 0, At, B0); PG8_MMA(0, 1, At, B1); PG8_BAR; PG8_SCHED;
            PG8_LDA(At, 1, 1); PG8_STAGE(PG8_SB(1, 0), b3, voffB); PG8_STAGE(PG8_SB(1, 1), b3 + hstep, voffB); PG8_STAGE(PG8_SA(1, 0), a3, voffA);
            PG8_WAIT_V(8); PG8_WAIT_L(0); PG8_BAR; PG8_MMA(1, 0, At, B0); PG8_MMA(1, 1, At, B1); PG8_BAR; PG8_SCHED;
            } else {
            PG8_LDB(B0, 0, 0); PG8_SCHED; PG8_LDA(At, 0, 0); PG8_STAGE(PG8_SA(1, 1), a1 + hstep, voffA);
            PG8_WAIT_L(8); PG8_BAR; PG8_WAIT_L(0); PG8_MMA(0, 0, At, B0); PG8_BAR; PG8_SCHED;
            PG8_LDB(B1, 0, 1); PG8_STAGE(PG8_SB(0, 0), b2, voffB);
            PG8_BAR; PG8_WAIT_L(0); PG8_MMA(0, 1, At, B1); PG8_BAR;
            PG8_LDA(At, 0, 1); PG8_STAGE(PG8_SA(0, 0), a2, voffA);
            PG8_BAR; PG8_WAIT_L(0); PG8_MMA(1, 0, At, B0); PG8_BAR; PG8_SCHED;
            PG8_STAGE(PG8_SB(0, 1), b2 + hstep, voffB);
            PG8_WAIT_V(6); PG8_BAR; PG8_MMA(1, 1, At, B1); PG8_BAR;
            PG8_LDB(B0, 1, 0); PG8_SCHED; PG8_LDA(At, 1, 0); PG8_STAGE(PG8_SA(0, 1), a2 + hstep, voffA);
            PG8_WAIT_L(8); PG8_BAR; PG8_WAIT_L(0); PG8_MMA(0, 0, At, B0); PG8_BAR; PG8_SCHED;
            PG8_LDB(B1, 1, 1); PG8_STAGE(PG8_SB(1, 0), b3, voffB);
            PG8_BAR; PG8_WAIT_L(0); PG8_MMA(0, 1, At, B1); PG8_BAR;
            PG8_LDA(At, 1, 1); PG8_STAGE(PG8_SA(1, 0), a3, voffA);
            PG8_BAR; PG8_WAIT_L(0); PG8_MMA(1, 0, At, B0); PG8_BAR; PG8_SCHED;
            PG8_STAGE(PG8_SB(1, 1), b3 + hstep, voffB);
            PG8_WAIT_V(6); PG8_BAR; PG8_MMA(1, 1, At, B1); PG8_BAR;
            }
        }
        if constexpr (ALIGN_EPI) { if (wr == 0) PG8_BAR; }
        if constexpr (!Epi::AFTER_DRAIN) { E(acc, cur, wr, wc, fr, fq); S.done(cur); }
        if (!has_next) break;
#pragma unroll
        for (int a = 0; a < 2; ++a)
#pragma unroll
            for (int b = 0; b < 2; ++b)
#pragma unroll
                for (int m = 0; m < 4; ++m)
#pragma unroll
                    for (int n = 0; n < 2; ++n) acc[a][b][m][n] = (f32x4){0.f, 0.f, 0.f, 0.f};
        cur = nxt; cA = nA; cB = nB; ++ui;
        if constexpr (ALIGN_EPI) { if (wr == 1) PG8_BAR; }
    }
    PG8_WAIT_V(0);
    if constexpr (!ALIGN_EPI) { if (wr == 0) PG8_BAR; }
    PG8_BAR;
    if constexpr (Epi::AFTER_DRAIN) { E.fused(acc, cur, wr, wc, fr, fq, lds, wid, lane); S.done(cur); }
#undef PG8_SA
#undef PG8_SB
#undef PG8_STAGE
#undef PG8_LDA
#undef PG8_LDB
#undef PG8_MMA
#undef PG8_WAIT_V
#undef PG8_WAIT_L
#undef PG8_BAR
#undef PG8_SCHED
}
}
constexpr int NWAVES = 8, NTHR = 512;
constexpr int DM = 1024, NLAT = 32768, NCTX = 2048, NROWS = 34816, INC = 3328;
constexpr int OFF_CB = 0, OFF_CC = 256, OFF_CX = 512, OFF_Q = 768, OFF_K = 1280, OFF_V = 1792, OFF_G = 2304, OFF_U = 2816, OFF_VV = 3072;
constexpr int NCH = 34;
constexpr float LN_EPS = 1e-5f, ALPHA = 1.41421356237309515f;
constexpr size_t MiB = 1u << 20;
constexpr size_t WS_CTL = 0, CTL_ZERO_BYTES = MiB, WS_MOD = 1 * MiB, WS_WR = 1 * MiB + 512 * 1024, WS_TOK = 2 * MiB, WS_WIN = 4 * MiB, WS_WOUT = 17 * MiB, WS_WGU = 21 * MiB, WS_WD = 149 * MiB,
                 WS_HB = 213 * MiB, WS_ST = WS_HB, WS_XCTX = 281 * MiB, WS_P = 289 * MiB, WS_YMIX = 510 * MiB, WS_XB = WS_P, WS_Y = WS_P, WS_HH = WS_P + 152 * MiB, WS_END = 578 * MiB;
constexpr int CW_TMO = 0, CW_BAR = 4096, CW_WGCNT = 16384, CW_TOT = 32768, CW_DQ = 33024;
constexpr int RING_BYTES = 131072, LDSCTL_OFF = RING_BYTES, MISC_OFF = LDSCTL_OFF + 320, P2E_OFF = LDSCTL_OFF + 1024, PST_OFF = LDSCTL_OFF + 2048, LDS_BYTES = 147456;
constexpr int MAXPANELS = 304;
constexpr int LCNT_OFF = LDSCTL_OFF + 4096, LG_OFF = LDSCTL_OFF + 4352, DQ_OFF = LDSCTL_OFF + 9600;

#define GAS __attribute__((address_space(1)))
#define LAS __attribute__((address_space(3)))
typedef unsigned short bf16;
typedef unsigned v4u __attribute__((ext_vector_type(4)));
typedef unsigned v2u __attribute__((ext_vector_type(2)));
typedef float f32x4 __attribute__((ext_vector_type(4)));
#define LDS_WAIT() asm volatile("s_waitcnt lgkmcnt(0)" ::: "memory")
#define VM_WAIT() asm volatile("s_waitcnt vmcnt(0)" ::: "memory")
__device__ __forceinline__ unsigned f2bf(float f) { unsigned u = __builtin_bit_cast(unsigned, f); return (u + 0x7fffu + ((u >> 16) & 1u)) >> 16; }
__device__ __forceinline__ unsigned pk2(float lo, float hi) { return f2bf(lo) | (f2bf(hi) << 16); }
typedef float f32x2_t __attribute__((ext_vector_type(2))); typedef __bf16 bf16x2_t __attribute__((ext_vector_type(2)));
__device__ __forceinline__ unsigned cvtpk(float lo, float hi) { f32x2_t v = {lo, hi}; bf16x2_t b = __builtin_convertvector(v, bf16x2_t); return __builtin_bit_cast(unsigned, b); }
__device__ __forceinline__ float bflo(unsigned w) { return __builtin_bit_cast(float, w << 16); }
__device__ __forceinline__ float bfhi(unsigned w) { return __builtin_bit_cast(float, w & 0xffff0000u); }
__device__ __forceinline__ float wave_sum(float v) {
#pragma unroll
    for (int o = 1; o < 64; o <<= 1) v += __shfl_xor(v, o);
    return v;
}
__device__ __forceinline__ float log_sigmoid_f(float x) { return -log1pf(expf(-x)); }

struct Args { const float* in[24]; float* out; unsigned char* ws; int ph_lo, ph_hi; };
#define XB_TMO      128
#define XB_XCNT(j)  (256  + 64 * (j))
#define XB_XSUB(j)  (1280 + 64 * (j))
#define XB_XGEN(j)  (2304 + 64 * (j))
#define XB_TOP      3328
#define XB_TOPGEN   3392
#define XCD_BAR_WORDS 3456
#define XB_SPIN_CAP (1u << 18)

__device__ __forceinline__ unsigned xb_ld(unsigned* p)              { return __hip_atomic_load(p, __ATOMIC_RELAXED, __HIP_MEMORY_SCOPE_AGENT); }
__device__ __forceinline__ unsigned xb_add(unsigned* p, unsigned v) { return __hip_atomic_fetch_add(p, v, __ATOMIC_RELAXED, __HIP_MEMORY_SCOPE_AGENT); }
__device__ __forceinline__ unsigned xb_xcc_id() { return (unsigned)__builtin_amdgcn_s_getreg((3 << 11) | 20) & 0xFu; }
#define XB_SPIN(cond, bar) do { unsigned _sp = 0; while (cond) { __builtin_amdgcn_s_sleep(1); \
    if ((++_sp & 255u) == 0u) { if (xb_ld(&(bar)[XB_TMO])) break; if (_sp > XB_SPIN_CAP) { atomicAdd(&(bar)[XB_TMO], 1u); break; } } } } while (0)

struct XcdBarrier {
    unsigned* bar; unsigned x;
    volatile LAS unsigned* st;
};

__device__ __forceinline__ XcdBarrier xcd_barrier_post(unsigned* bar, volatile LAS unsigned* st) {
    XcdBarrier b; b.bar = bar; b.x = xb_xcc_id(); b.st = st;
    if (threadIdx.x == 0) (void)xb_add(&bar[XB_XCNT(b.x)], 1u);
    return b;
}
__device__ __forceinline__ void xcd_barrier_complete(unsigned* bar, unsigned x, unsigned& nloc, unsigned& nx) {
    const unsigned G = gridDim.x * gridDim.y * gridDim.z;
    unsigned sum, cnt, mine, sp = 0u;
    for (;;) {
        sum = 0u; cnt = 0u; mine = 0u;
#pragma unroll
        for (unsigned j = 0; j < 16; ++j) { const unsigned c = xb_ld(&bar[XB_XCNT(j)]); sum += c; cnt += (c > 0u) ? 1u : 0u; mine = (j == x) ? c : mine; }
        if (sum == G) break;
        __builtin_amdgcn_s_sleep(1);
        if ((++sp & 255u) == 0u) { if (xb_ld(&bar[XB_TMO])) break; if (sp > XB_SPIN_CAP) { atomicAdd(&bar[XB_TMO], 1u); break; } }
    }
    nloc = mine > 0u ? mine : 1u; nx = cnt > 0u ? cnt : 1u;
}

__device__ __forceinline__ void xcd_barrier(const XcdBarrier& b) {
    asm volatile("s_waitcnt vmcnt(0)" ::: "memory");
    __syncthreads();
    if (threadIdx.x == 0) {
        unsigned* bar = b.bar;
        __builtin_amdgcn_s_waitcnt(0);
        unsigned nloc = b.st[0], nx = b.st[1];
        if (nloc == 0u) { xcd_barrier_complete(bar, b.x, nloc, nx); b.st[0] = nloc; b.st[1] = nx; }
        const unsigned old = xb_add(&bar[XB_XSUB(b.x)], 1u);
        const unsigned gen = old / nloc;
        if (old + 1u == (gen + 1u) * nloc) {
            __builtin_amdgcn_fence(__ATOMIC_RELEASE, "agent");
            asm volatile("s_waitcnt vmcnt(0)" ::: "memory");
            const unsigned og = xb_add(&bar[XB_TOP], 1u);
            const unsigned tg = og / nx;
            if (og + 1u == (tg + 1u) * nx) xb_add(&bar[XB_TOPGEN], 1u);
            else XB_SPIN(xb_ld(&bar[XB_TOPGEN]) == tg, bar);
            __builtin_amdgcn_fence(__ATOMIC_ACQUIRE, "agent");
            xb_add(&bar[XB_XGEN(b.x)], 1u);
            asm volatile("s_waitcnt vmcnt(0)" ::: "memory");
        } else {
            XB_SPIN(xb_ld(&bar[XB_XGEN(b.x)]) == gen, bar);
            __builtin_amdgcn_fence(__ATOMIC_ACQUIRE, "agent");
            asm volatile("s_waitcnt vmcnt(0)" ::: "memory");
        }
    }
    __syncthreads();
}
__device__ __forceinline__ void transpose_tile(const float* Wsrc, int ldn, bf16* dst, int ldk, float scale, LAS float* scr, int lane) {
#pragma unroll 8
    for (int i = 0; i < 32; ++i) { const int kk = 2 * i + (lane >> 5); scr[kk * 33 + (lane & 31)] = Wsrc[(size_t)kk * ldn + (lane & 31)] * scale; }
    LDS_WAIT(); asm volatile("" ::: "memory");
    const int c = lane & 7;
#pragma unroll
    for (int j = 0; j < 4; ++j) { const int n = (lane >> 3) + 8 * j; const LAS float* s = scr + (8 * c) * 33 + n;
        v4u o; o.x = pk2(s[0 * 33], s[1 * 33]); o.y = pk2(s[2 * 33], s[3 * 33]); o.z = pk2(s[4 * 33], s[5 * 33]); o.w = pk2(s[6 * 33], s[7 * 33]);
        *(GAS v4u*)(dst + (size_t)n * ldk + 8 * c) = o; }
    LDS_WAIT(); asm volatile("" ::: "memory");
}

__device__ __forceinline__ void phase_p0(const Args& a, LAS unsigned char* lds, int tid, int lane, int wave) {
    const int G = gridDim.x;
    {
        LAS float* s = (LAS float*)lds; LAS float* red = (LAS float*)(lds + 36864);
        const float* c = a.in[1]; const float* cctx = a.in[3]; const float* wada = a.in[4]; const float* bada = a.in[5];
        float* mod = (float*)(a.ws + WS_MOD);
        for (int u = blockIdx.x; u < 192; u += G) {
            const int l = u / 96, j0 = (u % 96) * 64;
            for (int i = tid; i < 9 * 1024; i += NTHR) { const int r = i >> 10, k = i & 1023; const float v = r < 8 ? c[r * 1024 + k] : cctx[k]; s[i] = v / (1.0f + expf(-v)); }
            __syncthreads();
            const int jq = tid & 15, kg = tid >> 4;
            float acc[9][4];
#pragma unroll
            for (int r = 0; r < 9; ++r) { acc[r][0] = 0.f; acc[r][1] = 0.f; acc[r][2] = 0.f; acc[r][3] = 0.f; }
            const float* w = wada + (size_t)l * 1024 * 6144 + j0 + jq * 4;
            for (int k = kg; k < 1024; k += 32) { const f32x4 wv = *(const f32x4*)(w + (size_t)k * 6144);
#pragma unroll
                for (int r = 0; r < 9; ++r) { const float sr = s[r * 1024 + k]; acc[r][0] += sr * wv.x; acc[r][1] += sr * wv.y; acc[r][2] += sr * wv.z; acc[r][3] += sr * wv.w; } }
#pragma unroll
            for (int r = 0; r < 9; ++r)
#pragma unroll
                for (int i = 0; i < 4; ++i) red[(kg * 9 + r) * 64 + jq * 4 + i] = acc[r][i];
            __syncthreads();
            for (int o = tid; o < 576; o += NTHR) { const int r = o >> 6, j = o & 63; float sum = 0.f;
                for (int g2 = 0; g2 < 32; ++g2) sum += red[(g2 * 9 + r) * 64 + j];
                mod[(l * 9 + r) * 6144 + j0 + j] = sum + bada[l * 6144 + j0 + j]; }
            __syncthreads();
        }
    }
    {
        LAS float* scr = (LAS float*)(lds + wave * 16384);
        const int gw = blockIdx.x * NWAVES + wave, NGW = G * NWAVES;
        const float* w_in = a.in[6]; const float* w_out = a.in[12]; const float* w_gate = a.in[19]; const float* w_up = a.in[20]; const float* w_down = a.in[21];
        bf16* WIN = (bf16*)(a.ws + WS_WIN); bf16* WOUT = (bf16*)(a.ws + WS_WOUT); bf16* WGU = (bf16*)(a.ws + WS_WGU); bf16* WD = (bf16*)(a.ws + WS_WD);
        constexpr int I_IN = 2 * 16 * 104, I_OUT = 2 * 16 * 32, I_GU = 2 * 2 * 32 * 256, I_D = 2 * 32 * 256, NITEMS = I_IN + I_OUT + I_GU + I_D;
        for (int it = gw; it < NITEMS; it += NGW) {
            int r = it;
            if (r < I_IN) { const int l = r / 1664, q = r % 1664, k0 = 64 * (q / 104), n0 = 32 * (q % 104);
                const float sc = (n0 >= OFF_K && n0 < OFF_V) ? 0.125f : 1.0f;
                transpose_tile(w_in + ((size_t)l * 1024 + k0) * INC + n0, INC, WIN + ((size_t)l * INC + n0) * 1024 + k0, 1024, sc, scr, lane); continue; }
            r -= I_IN;
            if (r < I_OUT) { const int l = r / 512, q = r % 512, k0 = 64 * (q / 32), n0 = 32 * (q % 32);
                transpose_tile(w_out + ((size_t)l * 1024 + k0) * 1024 + n0, 1024, WOUT + ((size_t)l * 1024 + n0) * 1024 + k0, 1024, 1.0f, scr, lane); continue; }
            r -= I_OUT;
            if (r < I_GU) { const int isup = r >= (I_GU / 2) ? 1 : 0; r -= isup * (I_GU / 2);
                const int le = r / 256, q = r % 256, k0 = 64 * (q / 16), n0 = 32 * (q % 16);
                const float* src = (isup ? w_up : w_gate) + ((size_t)le * 1024 + k0) * 512 + n0;
                const int drow = (n0 >> 7) * 256 + (n0 & 127) + isup * 128;
                transpose_tile(src, 512, WGU + ((size_t)le * 1024 + drow) * 1024 + k0, 1024, 1.0f, scr, lane); continue; }
            r -= I_GU;
            { const int le = r / 256, q = r % 256, k0 = 64 * (q / 32), n0 = 32 * (q % 32);
                transpose_tile(w_down + ((size_t)le * 512 + k0) * 1024 + n0, 1024, WD + ((size_t)le * 1024 + n0) * 512 + k0, 512, 1.0f, scr, lane); }
        }
    }
    {
        bf16* WR = (bf16*)(a.ws + WS_WR);
        for (int i = blockIdx.x * NTHR + tid; i < 2 * 64 * 1024; i += G * NTHR) { const int l = i >> 16, j = (i >> 10) & 63, k = i & 1023;
            float v = 0.f;
            if (j < 4) v = a.in[15][((size_t)l * 1024 + k) * 4 + j]; else if (j < 36) v = a.in[17][(((size_t)l * 4 + ((j - 4) >> 3)) * 1024 + k) * 8 + ((j - 4) & 7)];
            const unsigned hi = f2bf(v); const float r = v - __builtin_bit_cast(float, hi << 16);
            WR[((size_t)(l * 2) * 64 + j) * 1024 + k] = (bf16)hi; WR[((size_t)(l * 2 + 1) * 64 + j) * 1024 + k] = (bf16)f2bf(r); }
    }
    __syncthreads();
}

__device__ __forceinline__ void phase_p1(const Args& a, int lane, int wave) {
    const int gw = blockIdx.x * NWAVES + wave, NGW = gridDim.x * NWAVES;
    const float* mod = (const float*)(a.ws + WS_MOD); bf16* Hb = (bf16*)(a.ws + WS_HB);
    for (int row = gw; row < NROWS; row += NGW) {
        const float* src = row < NLAT ? a.in[0] + (size_t)row * 1024 : a.in[2] + (size_t)(row - NLAT) * 1024;
        const float* m0 = mod + (row < NLAT ? (row >> 12) : 8) * 6144;
#pragma unroll
        for (int j = 0; j < 4; ++j) { const int idx = (lane + 64 * j) * 4;
            const f32x4 v = *(const f32x4*)(src + idx), sh = *(const f32x4*)(m0 + idx), sc = *(const f32x4*)(m0 + 1024 + idx);
            const f32x4 o = v * (sc + 1.0f) + sh; v2u w; w.x = pk2(o.x, o.y); w.y = pk2(o.z, o.w);
            *(v2u*)(Hb + (size_t)row * 1024 + idx) = w; }
    }
}

__device__ __forceinline__ int chunk_row0(int b, int c) { return c < 2 ? NLAT + b * 256 + c * 128 : b * 4096 + (c - 2) * 128; }
__device__ __forceinline__ size_t st_off(int b, int c, int h, int dir) { return ((((size_t)b * NCH + c) * 8 + h) * 2 + dir) * 4096; }

__device__ __forceinline__ void phase_b(const Args& a, int l, LAS unsigned char* lds, int tid) {
    const bf16* P = (const bf16*)(a.ws + WS_P); float* ST = (float*)(a.ws + WS_ST);
    LAS float* Ks = (LAS float*)lds; LAS float* Vs = (LAS float*)(lds + 32768); LAS float* pf = (LAS float*)(lds + 65536); LAS float* pb = pf + 128;
    for (int u = blockIdx.x; u < 8 * NCH * 8; u += gridDim.x) {
        const int b = u / (NCH * 8), c = (u % (NCH * 8)) / 8, h = u % 8; const int row0 = chunk_row0(b, c);
        __syncthreads();
        if (tid < 128) { const float lgf = log_sigmoid_f(a.in[8][l * 8 + h]), lgb = log_sigmoid_f(a.in[9][l * 8 + h]);
            pf[tid] = expf(lgf * (float)(127 - tid)); pb[tid] = expf(lgb * (float)tid); }
        { const int j = tid >> 2, part = tid & 3; const bf16* kp = P + (size_t)(row0 + j) * INC + OFF_K + h * 64 + part * 16; const bf16* vp = kp + (OFF_V - OFF_K);
#pragma unroll
          for (int q = 0; q < 2; ++q) { const v4u kw = *(const v4u*)(kp + 8 * q), vw = *(const v4u*)(vp + 8 * q);
              LAS float* kd = Ks + j * 64 + part * 16 + 8 * q; LAS float* vd = Vs + j * 64 + part * 16 + 8 * q;
              kd[0] = bflo(kw.x); kd[1] = bfhi(kw.x); kd[2] = bflo(kw.y); kd[3] = bfhi(kw.y); kd[4] = bflo(kw.z); kd[5] = bfhi(kw.z); kd[6] = bflo(kw.w); kd[7] = bfhi(kw.w);
              vd[0] = bflo(vw.x); vd[1] = bfhi(vw.x); vd[2] = bflo(vw.y); vd[3] = bfhi(vw.y); vd[4] = bflo(vw.z); vd[5] = bfhi(vw.z); vd[6] = bflo(vw.w); vd[7] = bfhi(vw.w); } }
        __syncthreads();
        const int d = tid >> 3, e0 = (tid & 7) * 8;
        float af[8], ab[8];
#pragma unroll
        for (int i = 0; i < 8; ++i) { af[i] = 0.f; ab[i] = 0.f; }
        for (int j = 0; j < 128; ++j) { const float kd = Ks[j * 64 + d], kf = kd * pf[j], kb = kd * pb[j];
            const f32x4 v0 = *(const LAS f32x4*)(Vs + j * 64 + e0), v1 = *(const LAS f32x4*)(Vs + j * 64 + e0 + 4);
            af[0] += kf * v0.x; af[1] += kf * v0.y; af[2] += kf * v0.z; af[3] += kf * v0.w; af[4] += kf * v1.x; af[5] += kf * v1.y; af[6] += kf * v1.z; af[7] += kf * v1.w;
            ab[0] += kb * v0.x; ab[1] += kb * v0.y; ab[2] += kb * v0.z; ab[3] += kb * v0.w; ab[4] += kb * v1.x; ab[5] += kb * v1.y; ab[6] += kb * v1.z; ab[7] += kb * v1.w; }
        float* o0 = ST + st_off(b, c, h, 0) + d * 64 + e0; float* o1 = ST + st_off(b, c, h, 1) + d * 64 + e0;
        *(f32x4*)o0 = (f32x4){af[0], af[1], af[2], af[3]}; *(f32x4*)(o0 + 4) = (f32x4){af[4], af[5], af[6], af[7]};
        *(f32x4*)o1 = (f32x4){ab[0], ab[1], ab[2], ab[3]}; *(f32x4*)(o1 + 4) = (f32x4){ab[4], ab[5], ab[6], ab[7]};
    }
    __syncthreads();
}

__device__ __forceinline__ void phase_c(const Args& a, int l, int tid) {
    bf16* ST = (bf16*)(a.ws + WS_ST);
    for (int it = blockIdx.x * NTHR + tid; it < 8 * 8 * 2 * 1024; it += gridDim.x * NTHR) {
        const int q = it & 1023, dir = (it >> 10) & 1, h = (it >> 11) & 7, b = it >> 14;
        const float lg = log_sigmoid_f(dir ? a.in[9][l * 8 + h] : a.in[8][l * 8 + h]); const float dec = expf(128.0f * lg);
        v2u kv[NCH];
#pragma unroll
        for (int s = 0; s < NCH; ++s) { const int c = dir ? (s < 2 ? 1 - s : 35 - s) : s; kv[s] = *(const v2u*)(ST + st_off(b, c, h, dir) + q * 4); }
        f32x4 st = (f32x4){0.f, 0.f, 0.f, 0.f};
#pragma unroll
        for (int s = 0; s < NCH; ++s) { const int c = dir ? (s < 2 ? 1 - s : 35 - s) : s;
            v2u w; w.x = cvtpk(st.x, st.y); w.y = cvtpk(st.z, st.w); *(v2u*)(ST + st_off(b, c, h, dir) + q * 4) = w;
            st = st * dec + (f32x4){bflo(kv[s].x), bfhi(kv[s].x), bflo(kv[s].y), bfhi(kv[s].y)}; }
    }
}
__device__ __forceinline__ void unpack8(const v4u w, float* f) { f[0] = bflo(w.x); f[1] = bfhi(w.x); f[2] = bflo(w.y); f[3] = bfhi(w.y); f[4] = bflo(w.z); f[5] = bfhi(w.z); f[6] = bflo(w.w); f[7] = bfhi(w.w); }
__device__ __forceinline__ v4u pack8(const float* f) { v4u w; w.x = pk2(f[0], f[1]); w.y = pk2(f[2], f[3]); w.z = pk2(f[4], f[5]); w.w = pk2(f[6], f[7]); return w; }

__device__ __forceinline__ void phase_d(const Args& a, int l, LAS unsigned char* lds, int tid, int lane) {
    const bf16* P = (const bf16*)(a.ws + WS_P); const float* ST = (const float*)(a.ws + WS_ST); bf16* Y = (bf16*)(a.ws + WS_YMIX);
    const float* convw = a.in[7] + l * 3 * 256; const float* sguw = a.in[10] + (size_t)l * 4 * 128 * 128; const float* sgub = a.in[11] + l * 4 * 128;
    const int c_lo = l == 1 ? 2 : 0, cpb = NCH - c_lo, nunits = 8 * cpb;
    LAS float* Sf = (LAS float*)lds; LAS float* Sb = (LAS float*)(lds + 16384); LAS float* Ks = (LAS float*)(lds + 32768); LAS float* Vs = (LAS float*)(lds + 65536);
    LAS float* VN = (LAS float*)lds;
    for (int u = blockIdx.x; u < nunits; u += gridDim.x) {
        const int b = u / cpb, c = c_lo + u % cpb; const int row0 = chunk_row0(b, c); const bool isc = c < 2;
#ifndef NO_D1
        for (int idx = tid; idx < 128 * 32; idx += NTHR) {
            const int p = idx >> 5, ch0 = (idx & 31) * 8; const int row = row0 + p;
            int dprev = -1, dnext = 1; bool vprev, vnext;
            if (isc) { const int t = c * 128 + p; vprev = t > 0; vnext = t < 255; }
            else { const int t = (c - 2) * 128 + p;
                if (ch0 < 128) { const int col = t & 63; vprev = col > 0; vnext = col < 63; }
                else { const int rg = t >> 6; vprev = rg > 0; vnext = rg < 63; dprev = -64; dnext = 64; } }
            const bf16* pr = P + (size_t)row * INC;
            float cb[8], zc[8], zp[8], zn[8], t0[8], t1[8];
            unpack8(*(const v4u*)(pr + OFF_CB + ch0), cb);
            unpack8(*(const v4u*)(pr + OFF_CC + ch0), t0); unpack8(*(const v4u*)(pr + OFF_CX + ch0), t1);
#pragma unroll
            for (int i = 0; i < 8; ++i) { zc[i] = t0[i] * t1[i]; zp[i] = 0.f; zn[i] = 0.f; }
            if (vprev) { const bf16* q = pr + (ptrdiff_t)dprev * INC; unpack8(*(const v4u*)(q + OFF_CC + ch0), t0); unpack8(*(const v4u*)(q + OFF_CX + ch0), t1);
#pragma unroll
                for (int i = 0; i < 8; ++i) zp[i] = t0[i] * t1[i]; }
            if (vnext) { const bf16* q = pr + (ptrdiff_t)dnext * INC; unpack8(*(const v4u*)(q + OFF_CC + ch0), t0); unpack8(*(const v4u*)(q + OFF_CX + ch0), t1);
#pragma unroll
                for (int i = 0; i < 8; ++i) zn[i] = t0[i] * t1[i]; }
            float o[8];
#pragma unroll
            for (int i = 0; i < 8; ++i) o[i] = cb[i] * (convw[ch0 + i] * zp[i] + convw[256 + ch0 + i] * zc[i] + convw[512 + ch0 + i] * zn[i]);
            *(v4u*)(Y + (size_t)row * 1024 + ch0) = pack8(o);
        }
#endif
        const int i = tid >> 2, part = tid & 3;
#ifndef NO_D2
#pragma unroll 1
        for (int h = 0; h < 8; ++h) {
            __syncthreads();
            { const bf16* kp = P + (size_t)(row0 + i) * INC + OFF_K + h * 64 + part * 16; const bf16* vp = kp + (OFF_V - OFF_K);
#pragma unroll
              for (int q = 0; q < 2; ++q) { float kf[8], vf[8]; unpack8(*(const v4u*)(kp + 8 * q), kf); unpack8(*(const v4u*)(vp + 8 * q), vf);
                  LAS float* kd = Ks + i * 64 + part * 16 + 8 * q; LAS float* vd = Vs + i * 64 + part * 16 + 8 * q;
#pragma unroll
                  for (int e = 0; e < 8; ++e) { kd[e] = kf[e]; vd[e] = vf[e]; } }
              const float* sf = ST + st_off(b, c, h, 0); const float* sb = ST + st_off(b, c, h, 1);
#pragma unroll
              for (int q = 0; q < 2; ++q) { const int o4 = (tid + NTHR * q) * 4; *(LAS f32x4*)(Sf + o4) = *(const f32x4*)(sf + o4); *(LAS f32x4*)(Sb + o4) = *(const f32x4*)(sb + o4); } }
            float qv[16];
            { const bf16* qp = P + (size_t)(row0 + i) * INC + OFF_Q + h * 64 + part * 16; unpack8(*(const v4u*)qp, qv); unpack8(*(const v4u*)(qp + 8), qv + 8); }
            const float lgf = log_sigmoid_f(a.in[8][l * 8 + h]), lgb = log_sigmoid_f(a.in[9][l * 8 + h]);
            __syncthreads();
            float o[16];
#pragma unroll
            for (int e = 0; e < 16; ++e) o[e] = 0.f;
#pragma unroll 1
            for (int j = 0; j < 128; ++j) {
                const LAS f32x4* kr = (const LAS f32x4*)(Ks + j * 64 + part * 16);
                float s = 0.f;
#pragma unroll
                for (int q = 0; q < 4; ++q) { const f32x4 k4 = kr[q]; s += qv[4 * q] * k4.x + qv[4 * q + 1] * k4.y + qv[4 * q + 2] * k4.z + qv[4 * q + 3] * k4.w; }
                s += __shfl_xor(s, 1); s += __shfl_xor(s, 2);
                const int rel = i - j;
                const float dec = rel > 0 ? expf(lgf * (float)rel) : (rel < 0 ? expf(lgb * (float)(-rel)) : 2.0f);
                s *= dec;
                const LAS f32x4* vr = (const LAS f32x4*)(Vs + j * 64 + part * 16);
#pragma unroll
                for (int q = 0; q < 4; ++q) { const f32x4 v4 = vr[q]; o[4 * q] += s * v4.x; o[4 * q + 1] += s * v4.y; o[4 * q + 2] += s * v4.z; o[4 * q + 3] += s * v4.w; }
            }
            float of[16], ob[16];
#pragma unroll
            for (int e = 0; e < 16; ++e) { of[e] = 0.f; ob[e] = 0.f; }
            __syncthreads();
#pragma unroll
            for (int dd = 0; dd < 16; ++dd) Ks[i * 64 + ((part * 16 + dd + i) & 63)] = qv[dd];
            __syncthreads();
#pragma unroll 2
            for (int d = 0; d < 64; ++d) { const float qd = Ks[i * 64 + ((d + i) & 63)];
                const LAS f32x4* fr = (const LAS f32x4*)(Sf + d * 64 + part * 16); const LAS f32x4* br = (const LAS f32x4*)(Sb + d * 64 + part * 16);
#pragma unroll
                for (int q = 0; q < 4; ++q) { const f32x4 f4 = fr[q], b4 = br[q];
                    of[4 * q] += qd * f4.x; of[4 * q + 1] += qd * f4.y; of[4 * q + 2] += qd * f4.z; of[4 * q + 3] += qd * f4.w;
                    ob[4 * q] += qd * b4.x; ob[4 * q + 1] += qd * b4.y; ob[4 * q + 2] += qd * b4.z; ob[4 * q + 3] += qd * b4.w; } }
            const float df = expf(lgf * (float)(i + 1)), db = expf(lgb * (float)(128 - i));
            float sum = 0.f;
#pragma unroll
            for (int e = 0; e < 16; ++e) { o[e] += df * of[e] + db * ob[e]; sum += o[e]; }
            sum += __shfl_xor(sum, 1); sum += __shfl_xor(sum, 2);
            const float mu = sum * (1.0f / 64.0f); float vs = 0.f;
#pragma unroll
            for (int e = 0; e < 16; ++e) { o[e] -= mu; vs += o[e] * o[e]; }
            vs += __shfl_xor(vs, 1); vs += __shfl_xor(vs, 2);
            const float rs = 1.0f / sqrtf(vs * (1.0f / 64.0f) + LN_EPS);
            float gv[16];
            { const bf16* gp = P + (size_t)(row0 + i) * INC + OFF_G + h * 64 + part * 16; unpack8(*(const v4u*)gp, gv); unpack8(*(const v4u*)(gp + 8), gv + 8); }
#pragma unroll
            for (int e = 0; e < 16; ++e) o[e] = (gv[e] / (1.0f + expf(-gv[e]))) * (o[e] * rs);
            bf16* yp = Y + (size_t)(row0 + i) * 1024 + 256 + h * 64 + part * 16;
            *(v4u*)yp = pack8(o); *(v4u*)(yp + 8) = pack8(o + 8);
        }
#endif
#ifndef NO_D3
        __syncthreads();
        {
            const bf16* vp = P + (size_t)(row0 + i) * INC + OFF_VV + part * 64;
            float sum = 0.f;
#pragma unroll 2
            for (int q = 0; q < 8; ++q) { float t8[8]; unpack8(*(const v4u*)(vp + 8 * q), t8);
#pragma unroll
                for (int e = 0; e < 8; ++e) sum += t8[e]; }
            sum += __shfl_xor(sum, 1); sum += __shfl_xor(sum, 2);
            const float mu = sum * (1.0f / 256.0f); float vs = 0.f;
#pragma unroll 2
            for (int q = 0; q < 8; ++q) { float t8[8]; unpack8(*(const v4u*)(vp + 8 * q), t8);
#pragma unroll
                for (int e = 0; e < 8; ++e) { const float dlt = t8[e] - mu; vs += dlt * dlt; } }
            vs += __shfl_xor(vs, 1); vs += __shfl_xor(vs, 2);
            const float rs = 1.0f / sqrtf(vs * (1.0f / 256.0f) + LN_EPS);
            LAS float* dst = VN + (part * 128 + i) * 64;
#pragma unroll 2
            for (int q = 0; q < 8; ++q) { float t8[8]; unpack8(*(const v4u*)(vp + 8 * q), t8);
                *(LAS f32x4*)(dst + 8 * q) = (f32x4){(t8[0] - mu) * rs, (t8[1] - mu) * rs, (t8[2] - mu) * rs, (t8[3] - mu) * rs};
                *(LAS f32x4*)(dst + 8 * q + 4) = (f32x4){(t8[4] - mu) * rs, (t8[5] - mu) * rs, (t8[6] - mu) * rs, (t8[7] - mu) * rs}; }
        }
        __syncthreads();
        for (int g = 0; g < 4; ++g) {
            float acc[16];
#pragma unroll
            for (int e = 0; e < 16; ++e) acc[e] = 0.f;
            const float* wrow = sguw + ((size_t)g * 128 + i) * 128;
            for (int q = 0; q < 128; q += 4) { const f32x4 w4 = *(const f32x4*)(wrow + q);
#pragma unroll
                for (int qq = 0; qq < 4; ++qq) { const float w = w4[qq]; const LAS f32x4* vr = (const LAS f32x4*)(VN + (g * 128 + q + qq) * 64 + part * 16);
#pragma unroll
                    for (int t = 0; t < 4; ++t) { const f32x4 v4 = vr[t]; acc[4 * t] += w * v4.x; acc[4 * t + 1] += w * v4.y; acc[4 * t + 2] += w * v4.z; acc[4 * t + 3] += w * v4.w; } } }
            const float bias = sgub[g * 128 + i];
            float uv[16];
            { const bf16* up = P + (size_t)(row0 + i) * INC + OFF_U + g * 64 + part * 16; unpack8(*(const v4u*)up, uv); unpack8(*(const v4u*)(up + 8), uv + 8); }
#pragma unroll
            for (int e = 0; e < 16; ++e) acc[e] = uv[e] * (acc[e] + bias);
            bf16* yp = Y + (size_t)(row0 + i) * 1024 + 768 + g * 64 + part * 16;
            *(v4u*)yp = pack8(acc); *(v4u*)(yp + 8) = pack8(acc + 8);
        }
#endif
        __syncthreads();
    }
}

__device__ __forceinline__ void phase_f(const Args& a, int l, LAS unsigned char* lds, int tid, int lane, int wave, bool dry = false) {
    LAS int* lcnt = (LAS int*)lds;
    __syncthreads();
    if (tid < 32) lcnt[tid] = 0;
    __syncthreads();
    const int gw = blockIdx.x * NWAVES + wave, NGW = gridDim.x * NWAVES, nrows = l == 0 ? NROWS : NLAT;
    const float* mod = (const float*)(a.ws + WS_MOD) + l * 9 * 6144;
    const float* lng = a.in[13] + l * 1024; const float* lnb = a.in[14] + l * 1024;
    const float* rgw = a.in[15] + l * 1024 * 4; const float* rgb = a.in[16] + l * 4; const float* rew = a.in[17] + (size_t)l * 4 * 1024 * 8; const float* reb = a.in[18] + l * 32;
    bf16* Hb = (bf16*)(a.ws + (dry ? WS_P + 160 * MiB : WS_HB)); unsigned* tok = (unsigned*)(a.ws + (dry ? WS_P + 240 * MiB : WS_TOK)); float* xctx = (float*)(a.ws + WS_XCTX);
    for (int row = gw; row < nrows; row += NGW) {
        float* xr = row < NLAT ? a.out + (size_t)row * 1024 : xctx + (size_t)(row - NLAT) * 1024;
        float* xw = dry ? (float*)(a.ws + WS_P) + (size_t)row * 1024 : xr;
        const float* m0 = mod + (row < NLAT ? (row >> 12) : 8) * 6144;
        f32x4 v[4]; float s = 0.f;
#pragma unroll
        for (int j = 0; j < 4; ++j) { v[j] = *(const f32x4*)(xr + (lane + 64 * j) * 4); s += (v[j].x + v[j].y) + (v[j].z + v[j].w); }
        const float mean = wave_sum(s) * (1.0f / 1024.0f); float s2 = 0.f;
#pragma unroll
        for (int j = 0; j < 4; ++j) { v[j] = v[j] - mean; s2 += (v[j].x * v[j].x + v[j].y * v[j].y) + (v[j].z * v[j].z + v[j].w * v[j].w); }
        const float rstd = 1.0f / sqrtf(wave_sum(s2) * (1.0f / 1024.0f) + LN_EPS);
        float lg[4] = {0.f, 0.f, 0.f, 0.f};
#pragma unroll
        for (int j = 0; j < 4; ++j) { const int idx = (lane + 64 * j) * 4;
            const f32x4 x1 = v[j] * rstd * *(const f32x4*)(lng + idx) + *(const f32x4*)(lnb + idx);
            *(f32x4*)(xw + idx) = x1;
            const f32x4 hm = x1 * (*(const f32x4*)(m0 + 4096 + idx) + 1.0f) + *(const f32x4*)(m0 + 3072 + idx);
            v[j] = hm;
            v2u w; w.x = pk2(hm.x, hm.y); w.y = pk2(hm.z, hm.w); *(v2u*)(Hb + (size_t)row * 1024 + idx) = w;
#pragma unroll
            for (int t = 0; t < 4; ++t) { const f32x4 w4 = *(const f32x4*)(rgw + (idx + t) * 4); const float hv = hm[t];
                lg[0] += hv * w4.x; lg[1] += hv * w4.y; lg[2] += hv * w4.z; lg[3] += hv * w4.w; } }
#pragma unroll
        for (int g = 0; g < 4; ++g) lg[g] = wave_sum(lg[g]) + rgb[g];
        int gi = 0; float gm = lg[0];
#pragma unroll
        for (int g = 1; g < 4; ++g) if (lg[g] > gm) { gm = lg[g]; gi = g; }
        float gden = 0.f;
#pragma unroll
        for (int g = 0; g < 4; ++g) gden += expf(lg[g] - gm);
        const float gprob = 1.0f / gden;
        float le[8] = {0.f, 0.f, 0.f, 0.f, 0.f, 0.f, 0.f, 0.f};
        const float* rw = rew + (size_t)gi * 1024 * 8;
#pragma unroll
        for (int j = 0; j < 4; ++j) { const int idx = (lane + 64 * j) * 4;
#pragma unroll
            for (int t = 0; t < 4; ++t) { const f32x4 w0 = *(const f32x4*)(rw + (idx + t) * 8), w1 = *(const f32x4*)(rw + (idx + t) * 8 + 4); const float hv = v[j][t];
                le[0] += hv * w0.x; le[1] += hv * w0.y; le[2] += hv * w0.z; le[3] += hv * w0.w; le[4] += hv * w1.x; le[5] += hv * w1.y; le[6] += hv * w1.z; le[7] += hv * w1.w; } }
#pragma unroll
        for (int e = 0; e < 8; ++e) le[e] = wave_sum(le[e]) + reb[gi * 8 + e];
        int i1 = 0; float m1 = le[0];
#pragma unroll
        for (int e = 1; e < 8; ++e) if (le[e] > m1) { m1 = le[e]; i1 = e; }
        int i2 = -1; float m2 = -3.0e38f;
#pragma unroll
        for (int e = 0; e < 8; ++e) if (e != i1 && le[e] > m2) { m2 = le[e]; i2 = e; }
        const float p2 = expf(m2 - m1), inv = 1.0f / (1.0f + p2);
        const float gate0 = gprob * inv, gate1 = gprob * p2 * inv;
        if (lane == 0) { const int e0 = gi * 8 + i1, e1 = gi * 8 + i2;
            const int p0 = __hip_atomic_fetch_add(lcnt + e0, 1, __ATOMIC_RELAXED, __HIP_MEMORY_SCOPE_WORKGROUP);
            const int p1 = __hip_atomic_fetch_add(lcnt + e1, 1, __ATOMIC_RELAXED, __HIP_MEMORY_SCOPE_WORKGROUP);
            unsigned* t = tok + (size_t)row * 8; t[0] = (unsigned)e0 | ((unsigned)e1 << 8); t[1] = (unsigned)p0; t[2] = (unsigned)p1;
            t[4] = __builtin_bit_cast(unsigned, gate0); t[5] = __builtin_bit_cast(unsigned, gate1); }
    }
    __syncthreads();
    if (tid < 32 && !dry) ((unsigned*)(a.ws + WS_CTL))[CW_WGCNT + (l * 256 + blockIdx.x) * 32 + tid] = (unsigned)lcnt[tid];
    __syncthreads();
}

__device__ __forceinline__ void phase_g(const Args& a, int l, LAS unsigned char* lds, int tid, int lane, int wave) {
    LAS int* cn = (LAS int*)lds; LAS int* base = (LAS int*)(lds + 32768); LAS int* pst = base + 32; LAS int* totl = base + 80;
    unsigned* ctl = (unsigned*)(a.ws + WS_CTL);
    __syncthreads();
    for (int i = tid; i < 256 * 32; i += NTHR) cn[i] = (int)ctl[CW_WGCNT + l * 256 * 32 + i];
    __syncthreads();
    if (tid < 32) { int tot = 0, bs = 0; for (int w = 0; w < 256; ++w) { const int v = cn[w * 32 + tid]; if (w < (int)blockIdx.x) bs += v; tot += v; } base[tid] = bs; totl[tid] = tot; }
    __syncthreads();
    if (tid == 0) { int run = 0; for (int e = 0; e < 32; ++e) { pst[e] = run; run += ((totl[e] + 255) >> 8) << 8; } pst[32] = run; }
    __syncthreads();
    if (blockIdx.x == 0 && tid < 32) ctl[CW_TOT + l * 64 + tid] = (unsigned)totl[tid];
    const int gw = blockIdx.x * NWAVES + wave, NGW = gridDim.x * NWAVES, nrows = l == 0 ? NROWS : NLAT;
    const bf16* Hb = (const bf16*)(a.ws + WS_HB); bf16* XB = (bf16*)(a.ws + WS_XB); unsigned* tok = (unsigned*)(a.ws + WS_TOK);
    (void)gw; (void)NGW;
    for (int T = blockIdx.x; T < (nrows >> 5); T += gridDim.x)
    for (int rr = 0; rr < 4; ++rr) { const int row = 32 * T + 4 * wave + rr;
        unsigned* t = tok + (size_t)row * 8; const unsigned ee = t[0]; const int e0 = ee & 255, e1 = (ee >> 8) & 255;
        const int s0 = pst[e0] + base[e0] + (int)t[1], s1 = pst[e1] + base[e1] + (int)t[2];
        if (lane == 0) { t[6] = (unsigned)s0; t[7] = (unsigned)s1; }
        const v4u a0 = *(const v4u*)(Hb + (size_t)row * 1024 + lane * 8), a1 = *(const v4u*)(Hb + (size_t)row * 1024 + 512 + lane * 8);
        *(v4u*)(XB + (size_t)s0 * 1024 + lane * 8) = a0; *(v4u*)(XB + (size_t)s0 * 1024 + 512 + lane * 8) = a1;
        *(v4u*)(XB + (size_t)s1 * 1024 + lane * 8) = a0; *(v4u*)(XB + (size_t)s1 * 1024 + 512 + lane * 8) = a1;
    }
    __syncthreads();
}

__device__ __forceinline__ int build_p2e(const Args& a, int l, LAS unsigned char* lds, int tid) {
    LAS unsigned char* p2e = lds + P2E_OFF; LAS int* np = (LAS int*)(lds + PST_OFF);
    const unsigned* ctl = (const unsigned*)(a.ws + WS_CTL);
    __syncthreads();
    if (tid == 0) { int pm = 0; for (int e = 0; e < 32; ++e) { const int n = ((int)ctl[CW_TOT + l * 64 + e] + 255) >> 8; for (int k = 0; k < n && pm < MAXPANELS; ++k) p2e[pm++] = (unsigned char)e; } np[0] = pm; }
    __syncthreads();
    return np[0];
}

struct JRow { f32x4 x[4]; v2u y0[4], y1[4]; float g0, g1; };
__device__ __forceinline__ void j_issue(JRow& R, const float* xr, const bf16* Y, const v4u tk, int lane) {
    const unsigned gx = tk.x, gy = tk.y;
    R.g0 = __builtin_bit_cast(float, gx); R.g1 = __builtin_bit_cast(float, gy);
    const bf16* y0 = Y + (size_t)tk.z * 1024; const bf16* y1 = Y + (size_t)tk.w * 1024;
#pragma unroll
    for (int j = 0; j < 4; ++j) { const int idx = (lane + 64 * j) * 4; R.x[j] = *(const f32x4*)(xr + idx); R.y0[j] = *(const v2u*)(y0 + idx); R.y1[j] = *(const v2u*)(y1 + idx); }
}
__device__ __forceinline__ void j_finish(const JRow& R, float* xw, bf16* hrow, const float* m0, const float* m1, const float* lng, const float* lnb, int lane) {
    f32x4 v[4]; float s = 0.f;
#pragma unroll
    for (int j = 0; j < 4; ++j) { const int idx = (lane + 64 * j) * 4; const v2u w0 = R.y0[j], w1 = R.y1[j];
        const f32x4 ya = (f32x4){bflo(w0.x), bfhi(w0.x), bflo(w0.y), bfhi(w0.y)}, yb = (f32x4){bflo(w1.x), bfhi(w1.x), bflo(w1.y), bfhi(w1.y)};
        v[j] = R.x[j] * ALPHA + *(const f32x4*)(m0 + 5120 + idx) * (ya * R.g0 + yb * R.g1);
        s += (v[j].x + v[j].y) + (v[j].z + v[j].w); }
    const float mean = wave_sum(s) * (1.0f / 1024.0f); float s2 = 0.f;
#pragma unroll
    for (int j = 0; j < 4; ++j) { v[j] = v[j] - mean; s2 += (v[j].x * v[j].x + v[j].y * v[j].y) + (v[j].z * v[j].z + v[j].w * v[j].w); }
    const float rstd = 1.0f / sqrtf(wave_sum(s2) * (1.0f / 1024.0f) + LN_EPS);
#pragma unroll
    for (int j = 0; j < 4; ++j) { const int idx = (lane + 64 * j) * 4;
        const f32x4 x2 = v[j] * rstd * *(const f32x4*)(lng + idx) + *(const f32x4*)(lnb + idx);
        *(f32x4*)(xw + idx) = x2;
        if (hrow) { const f32x4 hh = x2 * (*(const f32x4*)(m1 + 1024 + idx) + 1.0f) + *(const f32x4*)(m1 + idx);
            v2u w; w.x = cvtpk(hh.x, hh.y); w.y = cvtpk(hh.z, hh.w); *(v2u*)(hrow + idx) = w; } }
}
__device__ __forceinline__ void phase_j(const Args& a, int l, int lane, int wave, bool dry = false) {
    const int gw = blockIdx.x * NWAVES + wave, NGW = gridDim.x * NWAVES, nrows = l == 0 ? NROWS : NLAT;
    const float* mod = (const float*)(a.ws + WS_MOD) + l * 9 * 6144; const float* modn = (const float*)(a.ws + WS_MOD) + 9 * 6144;
    const float* lng = a.in[22] + l * 1024; const float* lnb = a.in[23] + l * 1024;
    bf16* Hb = (bf16*)(a.ws + WS_HB); const bf16* Y = (const bf16*)(a.ws + WS_Y); const unsigned* tok = (const unsigned*)(a.ws + WS_TOK); float* xctx = (float*)(a.ws + WS_XCTX);
    for (int rowA = gw; rowA < nrows; rowA += 2 * NGW) {
        const int rowB = rowA + NGW; const bool hasB = rowB < nrows;
        const v4u tA = *(const v4u*)(tok + (size_t)rowA * 8 + 4); const v4u tB = hasB ? *(const v4u*)(tok + (size_t)rowB * 8 + 4) : tA;
        float* xrA = rowA < NLAT ? a.out + (size_t)rowA * 1024 : xctx + (size_t)(rowA - NLAT) * 1024;
        const int rB = hasB ? rowB : rowA;
        float* xrB = rB < NLAT ? a.out + (size_t)rB * 1024 : xctx + (size_t)(rB - NLAT) * 1024;
        JRow RA, RB;
        j_issue(RA, xrA, Y, tA, lane); j_issue(RB, xrB, Y, tB, lane);
        const int mA = rowA < NLAT ? (rowA >> 12) : 8, mB = rB < NLAT ? (rB >> 12) : 8;
        j_finish(RA, dry ? (float*)(a.ws + WS_HH) + (size_t)rowA * 1024 : xrA, (l == 0 && !dry) ? Hb + (size_t)rowA * 1024 : nullptr, mod + mA * 6144, modn + mA * 6144, lng, lnb, lane);
        if (hasB) j_finish(RB, dry ? (float*)(a.ws + WS_HH) + (size_t)rowB * 1024 : xrB, (l == 0 && !dry) ? Hb + (size_t)rowB * 1024 : nullptr, mod + mB * 6144, modn + mB * 6144, lng, lnb, lane);
    }
}
typedef short bf16x8 __attribute__((ext_vector_type(8)));
typedef short s16x4 __attribute__((ext_vector_type(4)));
typedef short v4i16_t __attribute__((ext_vector_type(4)));
typedef float f32x16 __attribute__((ext_vector_type(16)));
#define MFMA32(a, b, c) __builtin_amdgcn_mfma_f32_32x32x16_bf16((a), (b), (c), 0, 0, 0)
__device__ __forceinline__ int crow(int reg, int hf) { return (reg & 3) + 8 * (reg >> 2) + 4 * hf; }
__device__ __forceinline__ int tro(int r, int b) { return r * 128 + (b ^ (((r >> 1) & 1) << 6)); }
__device__ __forceinline__ int rro(int r, int c16) { return r * 128 + ((c16 ^ ((r >> 1) & 7)) << 4); }
__device__ __forceinline__ s16x4 tr4(const LAS unsigned char* p) { return __builtin_bit_cast(s16x4, __builtin_amdgcn_ds_read_tr16_b64_v4i16((LAS v4i16_t*)p)); }
__device__ __forceinline__ bf16x8 tr_frag(const LAS unsigned char* img, int rlo, int rhi, int colbyte) {
    const s16x4 lo = tr4(img + tro(rlo, colbyte)), hi = tr4(img + tro(rhi, colbyte));
    return (bf16x8){lo[0], lo[1], lo[2], lo[3], hi[0], hi[1], hi[2], hi[3]};
}

#ifndef ST_TRANSPOSED
#define ST_TRANSPOSED 1
#endif
__device__ __forceinline__ void phase_b_mfma(const Args& a, int l, LAS unsigned char* lds, int tid, int lane, int wave) {
    const bf16* P = (const bf16*)(a.ws + WS_P); bf16* ST = (bf16*)(a.ws + WS_ST);
    const int r32 = lane & 31, hf = lane >> 5, q4 = (lane & 15) >> 2, p4 = lane & 3, blk = (lane >> 4) & 1;
    for (int u = blockIdx.x; u < 8 * NCH * 4; u += gridDim.x) {
        const int b = u / (NCH * 4), c = (u % (NCH * 4)) >> 2, h0 = (u & 3) * 2; const int row0 = chunk_row0(b, c);
        __syncthreads();
#pragma unroll
        for (int k = 0; k < 4; ++k) {
            const int ci = tid + NTHR * k, hh = ci >> 10, row = (ci & 1023) >> 3, c16 = ci & 7, h = h0 + hh;
            const bf16* src = P + (size_t)(row0 + row) * INC + h * 64 + c16 * 8;
            const v4u kw = *(const v4u*)(src + OFF_K), vw = *(const v4u*)(src + OFF_V);
            LAS unsigned char* base = lds + hh * 49152;
            *(LAS v4u*)(base + tro(row, c16 * 16)) = kw;
            const float lgf = log_sigmoid_f(a.in[8][l * 8 + h]), lgb = log_sigmoid_f(a.in[9][l * 8 + h]);
            const float wf = __expf(lgf * (float)(127 - row)), wb = __expf(lgb * (float)row);
            float v[8]; unpack8(vw, v);
            v4u of, ob;
            of.x = cvtpk(v[0] * wf, v[1] * wf); of.y = cvtpk(v[2] * wf, v[3] * wf); of.z = cvtpk(v[4] * wf, v[5] * wf); of.w = cvtpk(v[6] * wf, v[7] * wf);
            ob.x = cvtpk(v[0] * wb, v[1] * wb); ob.y = cvtpk(v[2] * wb, v[3] * wb); ob.z = cvtpk(v[4] * wb, v[5] * wb); ob.w = cvtpk(v[6] * wb, v[7] * wb);
            *(LAS v4u*)(base + 16384 + tro(row, c16 * 16)) = of;
            *(LAS v4u*)(base + 32768 + tro(row, c16 * 16)) = ob;
        }
        __syncthreads();
        const int hh = wave >> 2, dir = (wave >> 1) & 1, et = wave & 1;
        const LAS unsigned char* kimg = lds + hh * 49152; const LAS unsigned char* vimg = kimg + 16384 + dir * 16384;
        f32x16 acc[2];
#pragma unroll
        for (int i = 0; i < 16; ++i) { acc[0][i] = 0.f; acc[1][i] = 0.f; }
#pragma unroll
        for (int ks = 0; ks < 8; ++ks) {
            const int rlo = 16 * ks + 8 * hf + q4;
            const bf16x8 Bv = tr_frag(vimg, rlo, rlo + 4, (et * 32 + 16 * blk + 4 * p4) * 2);
#pragma unroll
            for (int dt = 0; dt < 2; ++dt) { const bf16x8 Ak = tr_frag(kimg, rlo, rlo + 4, (dt * 32 + 16 * blk + 4 * p4) * 2); acc[dt] = MFMA32(Ak, Bv, acc[dt]); }
        }
        bf16* dst = ST + st_off(b, c, h0 + hh, dir) + (size_t)(et * 32 + r32) * 64;
#pragma unroll
        for (int dt = 0; dt < 2; ++dt)
#pragma unroll
            for (int g4 = 0; g4 < 4; ++g4) { v2u w; w.x = cvtpk(acc[dt][4 * g4], acc[dt][4 * g4 + 1]); w.y = cvtpk(acc[dt][4 * g4 + 2], acc[dt][4 * g4 + 3]);
                *(v2u*)(dst + dt * 32 + 8 * g4 + 4 * hf) = w; }
    }
    __syncthreads();
}
__device__ __forceinline__ bf16x8 scale_frag(const bf16x8 q, float sc) {
    const v4u w = __builtin_bit_cast(v4u, q); v4u o;
    o.x = cvtpk(bflo(w.x) * sc, bfhi(w.x) * sc); o.y = cvtpk(bflo(w.y) * sc, bfhi(w.y) * sc); o.z = cvtpk(bflo(w.z) * sc, bfhi(w.z) * sc); o.w = cvtpk(bflo(w.w) * sc, bfhi(w.w) * sc);
    return __builtin_bit_cast(bf16x8, o);
}
__device__ __forceinline__ bf16x8 f32x8_to_frag(const f32x4 a0, const f32x4 a1) {
    v4u o; o.x = cvtpk(a0.x, a0.y); o.y = cvtpk(a0.z, a0.w); o.z = cvtpk(a1.x, a1.y); o.w = cvtpk(a1.z, a1.w); return __builtin_bit_cast(bf16x8, o);
}
struct ConvIn { v4u cb, c0, x0, cp, xp, cn, xn; };
__device__ __forceinline__ void conv_load(ConvIn& I, const bf16* P, int row0, int c, bool isc, int idx) {
    const int p = idx >> 5, ch0 = (idx & 31) * 8; const int row = row0 + p;
    int dprev = -1, dnext = 1; bool vprev, vnext;
    if (isc) { const int t = c * 128 + p; vprev = t > 0; vnext = t < 255; }
    else { const int t = (c - 2) * 128 + p;
        if (ch0 < 128) { const int col = t & 63; vprev = col > 0; vnext = col < 63; }
        else { const int rg = t >> 6; vprev = rg > 0; vnext = rg < 63; dprev = -64; dnext = 64; } }
    const bf16* pr = P + (size_t)row * INC; const v4u z = (v4u){0u, 0u, 0u, 0u};
    I.cb = *(const v4u*)(pr + OFF_CB + ch0); I.c0 = *(const v4u*)(pr + OFF_CC + ch0); I.x0 = *(const v4u*)(pr + OFF_CX + ch0);
    I.cp = z; I.xp = z; I.cn = z; I.xn = z;
    if (vprev) { const bf16* q = pr + (ptrdiff_t)dprev * INC; I.cp = *(const v4u*)(q + OFF_CC + ch0); I.xp = *(const v4u*)(q + OFF_CX + ch0); }
    if (vnext) { const bf16* q = pr + (ptrdiff_t)dnext * INC; I.cn = *(const v4u*)(q + OFF_CC + ch0); I.xn = *(const v4u*)(q + OFF_CX + ch0); }
}
__device__ __forceinline__ void conv_store(const ConvIn& I, bf16* Y, const float* convw, int row0, int idx) {
    const int p = idx >> 5, ch0 = (idx & 31) * 8;
    float cb[8], a0[8], a1[8], o[8], zc, zp, zn;
    unpack8(I.cb, cb);
    unpack8(I.c0, a0); unpack8(I.x0, a1);
#pragma unroll
    for (int i = 0; i < 8; ++i) o[i] = convw[256 + ch0 + i] * (a0[i] * a1[i]);
    unpack8(I.cp, a0); unpack8(I.xp, a1);
#pragma unroll
    for (int i = 0; i < 8; ++i) o[i] += convw[ch0 + i] * (a0[i] * a1[i]);
    unpack8(I.cn, a0); unpack8(I.xn, a1);
#pragma unroll
    for (int i = 0; i < 8; ++i) o[i] = cb[i] * (o[i] + convw[512 + ch0 + i] * (a0[i] * a1[i]));
    (void)zc; (void)zp; (void)zn;
    *(v4u*)(Y + (size_t)(row0 + p) * 1024 + ch0) = pack8(o);
}
__device__ __forceinline__ void phase_d_mfma(const Args& a, int l, LAS unsigned char* lds, int tid, int lane, int wave) {
    const bf16* P = (const bf16*)(a.ws + WS_P); const bf16* ST = (const bf16*)(a.ws + WS_ST); bf16* Y = (bf16*)(a.ws + WS_YMIX);
    const float* convw = a.in[7] + l * 3 * 256; const float* sguw = a.in[10] + (size_t)l * 4 * 128 * 128; const float* sgub = a.in[11] + l * 4 * 128;
    const int c_lo = l == 1 ? 2 : 0, cpb = NCH - c_lo, nunits = 8 * cpb;
#define LANEC int ln_ = lane; asm volatile("" : "+v"(ln_)); const int r32 = ln_ & 31, hf = ln_ >> 5, q4 = (ln_ & 15) >> 2, p4 = ln_ & 3, blk = (ln_ >> 4) & 1; (void)q4; (void)p4; (void)blk
    unsigned* dq = (unsigned*)(a.ws + WS_CTL) + CW_DQ + l * 64; LAS int* dqw = (LAS int*)(lds + DQ_OFF);
    const int npass = 2 * nunits, total = 4 * nunits;
    __syncthreads();
    if (tid == 0) dqw[0] = (int)__hip_atomic_fetch_add(dq, 1u, __ATOMIC_RELAXED, __HIP_MEMORY_SCOPE_AGENT);
    __syncthreads();
    int item = __builtin_amdgcn_readfirstlane(dqw[0]);
    while (item < total) {
        int nxt = 0;
        if (tid == 0) nxt = (int)__hip_atomic_fetch_add(dq, 1u, __ATOMIC_RELAXED, __HIP_MEMORY_SCOPE_AGENT);
        const int type = item < npass ? 0 : (item < npass + nunits ? 1 : 2);
        const int u = type == 0 ? (item >> 1) : (type == 1 ? item - npass : item - npass - nunits), pass = item & 1;
        const int b = u / cpb, c = c_lo + u % cpb; const int row0 = chunk_row0(b, c); const bool isc = c < 2;
        if (type == 2) {
#pragma unroll 1
            for (int idx = tid; idx < 128 * 32; idx += 2 * NTHR) {
                ConvIn I0, I1;
                conv_load(I0, P, row0, c, isc, idx); conv_load(I1, P, row0, c, isc, idx + NTHR);
                conv_store(I0, Y, convw, row0, idx); conv_store(I1, Y, convw, row0, idx + NTHR);
            }
        }
#ifndef NO_D2
        if (type == 0) {
            __syncthreads();
#pragma unroll 4
            for (int k = 0; k < 16; ++k) {
                int ts_ = tid; asm volatile("" : "+v"(ts_));
                const int ci = ts_ + NTHR * k, tile = ci >> 10, hd = tile >> 1, isv = tile & 1, row = (ci & 1023) >> 3, c16 = ci & 7;
                const v4u w = *(const v4u*)(P + (size_t)(row0 + row) * INC + (isv ? OFF_V : OFF_K) + (pass * 4 + hd) * 64 + c16 * 8);
                *(LAS v4u*)(lds + hd * 32768 + isv * 16384 + (isv ? tro(row, c16 * 16) : rro(row, c16))) = w;
            }
            __syncthreads();
            LANEC;
            const int hd = wave >> 1, ih = wave & 1, h = pass * 4 + hd;
            const LAS unsigned char* kimg = lds + hd * 32768; const LAS unsigned char* vimg = kimg + 16384;
            const float lg2f = log_sigmoid_f(a.in[8][l * 8 + h]) * 1.44269504088896f, lg2b = log_sigmoid_f(a.in[9][l * 8 + h]) * 1.44269504088896f;
            bf16x8 qf[2][4];
#pragma unroll
            for (int t = 0; t < 2; ++t)
#pragma unroll
                for (int s = 0; s < 4; ++s) qf[t][s] = *(const bf16x8*)(P + (size_t)(row0 + (2 * ih + t) * 32 + r32) * INC + OFF_Q + h * 64 + 16 * s + 8 * hf);
            f32x16 acc[2][2];
#pragma unroll
            for (int t = 0; t < 2; ++t)
#pragma unroll
                for (int et = 0; et < 2; ++et)
#pragma unroll
                    for (int r = 0; r < 16; ++r) acc[t][et][r] = 0.f;
#pragma unroll
            for (int dir = 0; dir < 2; ++dir) {
                const int i0 = 2 * ih * 32 + r32;
                const float sc0 = dir == 0 ? __builtin_amdgcn_exp2f(lg2f * (float)(i0 + 1)) : __builtin_amdgcn_exp2f(lg2b * (float)(128 - i0));
                const float sc1 = dir == 0 ? __builtin_amdgcn_exp2f(lg2f * (float)(i0 + 33)) : __builtin_amdgcn_exp2f(lg2b * (float)(96 - i0));
                const bf16* sp = ST + st_off(b, c, h, dir) + r32 * 64 + 8 * hf;
#pragma unroll
                for (int s = 0; s < 4; ++s) {
                    const bf16x8 qs0 = scale_frag(qf[0][s], sc0), qs1 = scale_frag(qf[1][s], sc1);
#pragma unroll
                    for (int et = 0; et < 2; ++et) { const bf16x8 A = *(const bf16x8*)(sp + et * 2048 + 16 * s);
                        acc[0][et] = MFMA32(A, qs0, acc[0][et]); acc[1][et] = MFMA32(A, qs1, acc[1][et]); }
                }
            }
#pragma unroll
            for (int t = 0; t < 2; ++t) {
                const int it = 2 * ih + t;
                bf16x8 qq[4];
                if (t == 0) {
#pragma unroll
                    for (int s = 0; s < 4; ++s) qq[s] = qf[0][s];
                } else {
                    asm volatile("" ::: "memory");
#pragma unroll
                    for (int s = 0; s < 4; ++s) qq[s] = *(const bf16x8*)(P + (size_t)(row0 + it * 32 + r32) * INC + OFF_Q + h * 64 + 16 * s + 8 * hf);
                }
#pragma unroll 1
                for (int jt = 0; jt < 4; ++jt) {
                    f32x16 X;
#pragma unroll
                    for (int r = 0; r < 16; ++r) X[r] = 0.f;
#pragma unroll
                    for (int s = 0; s < 4; ++s) { const bf16x8 Kf = *(const LAS bf16x8*)(kimg + rro(jt * 32 + r32, 2 * s + hf)); X = MFMA32(Kf, qq[s], X); }
                    const int rel0 = (it - jt) * 32 + r32 - 4 * hf;
#pragma unroll
                    for (int r = 0; r < 16; ++r) { const int rel = rel0 - ((r & 3) + 8 * (r >> 2));
                        const float x = rel > 0 ? lg2f * (float)rel : lg2b * (float)(-rel);
                        const float dcy = rel == 0 ? 2.0f : __builtin_amdgcn_exp2f(x);
                        X[r] *= dcy; }
#pragma unroll
                    for (int s2 = 0; s2 < 2; ++s2) {
                        v4u pk; pk.x = cvtpk(X[8 * s2], X[8 * s2 + 1]); pk.y = cvtpk(X[8 * s2 + 2], X[8 * s2 + 3]); pk.z = cvtpk(X[8 * s2 + 4], X[8 * s2 + 5]); pk.w = cvtpk(X[8 * s2 + 6], X[8 * s2 + 7]);
                        const bf16x8 Pk = __builtin_bit_cast(bf16x8, pk);
                        const int rlo = jt * 32 + 16 * s2 + 4 * hf + q4;
#pragma unroll
                        for (int et = 0; et < 2; ++et) { const bf16x8 Vt = tr_frag(vimg, rlo, rlo + 8, (et * 32 + 16 * blk + 4 * p4) * 2); acc[t][et] = MFMA32(Vt, Pk, acc[t][et]); }
                    }
                }
                const int row = row0 + (2 * ih + t) * 32 + r32;
                float sum = 0.f;
#pragma unroll
                for (int et = 0; et < 2; ++et)
#pragma unroll
                    for (int r = 0; r < 16; ++r) sum += acc[t][et][r];
                sum += __shfl_xor(sum, 32);
                const float mu = sum * (1.0f / 64.0f); float vs = 0.f;
#pragma unroll
                for (int et = 0; et < 2; ++et)
#pragma unroll
                    for (int r = 0; r < 16; ++r) { const float dlt = acc[t][et][r] - mu; vs += dlt * dlt; }
                vs += __shfl_xor(vs, 32);
                const float rs = 1.0f / sqrtf(vs * (1.0f / 64.0f) + LN_EPS);
#pragma unroll
                for (int et = 0; et < 2; ++et)
#pragma unroll
                    for (int g4 = 0; g4 < 4; ++g4) { const int e0 = et * 32 + 8 * g4 + 4 * hf;
                        const v2u gw = *(const v2u*)(P + (size_t)row * INC + OFF_G + h * 64 + e0);
                        const float g0 = bflo(gw.x), g1 = bfhi(gw.x), g2 = bflo(gw.y), g3 = bfhi(gw.y);
                        const float o0 = (acc[t][et][4 * g4] - mu) * rs, o1 = (acc[t][et][4 * g4 + 1] - mu) * rs, o2 = (acc[t][et][4 * g4 + 2] - mu) * rs, o3 = (acc[t][et][4 * g4 + 3] - mu) * rs;
                        v2u w; w.x = cvtpk(g0 / (1.0f + __expf(-g0)) * o0, g1 / (1.0f + __expf(-g1)) * o1); w.y = cvtpk(g2 / (1.0f + __expf(-g2)) * o2, g3 / (1.0f + __expf(-g3)) * o3);
                        *(v2u*)(Y + (size_t)row * 1024 + 256 + h * 64 + e0) = w; }
            }
        }
#endif
#ifndef NO_D3
        if (type == 1) {
        __syncthreads();
        {
            int tq_ = tid; asm volatile("" : "+v"(tq_));
            const int i = tq_ >> 2, part = tq_ & 3;
            const bf16* vp = P + (size_t)(row0 + i) * INC + OFF_VV + part * 64;
            float sum = 0.f;
#pragma unroll 2
            for (int q = 0; q < 8; ++q) { float t8[8]; unpack8(*(const v4u*)(vp + 8 * q), t8);
#pragma unroll
                for (int e = 0; e < 8; ++e) sum += t8[e]; }
            sum += __shfl_xor(sum, 1); sum += __shfl_xor(sum, 2);
            const float mu = sum * (1.0f / 256.0f); float vs = 0.f;
#pragma unroll 2
            for (int q = 0; q < 8; ++q) { float t8[8]; unpack8(*(const v4u*)(vp + 8 * q), t8);
#pragma unroll
                for (int e = 0; e < 8; ++e) { const float dlt = t8[e] - mu; vs += dlt * dlt; } }
            vs += __shfl_xor(vs, 1); vs += __shfl_xor(vs, 2);
            const float rs = 1.0f / sqrtf(vs * (1.0f / 256.0f) + LN_EPS);
#pragma unroll 2
            for (int q = 0; q < 8; ++q) { float t8[8]; unpack8(*(const v4u*)(vp + 8 * q), t8);
                v4u w; w.x = cvtpk((t8[0] - mu) * rs, (t8[1] - mu) * rs); w.y = cvtpk((t8[2] - mu) * rs, (t8[3] - mu) * rs); w.z = cvtpk((t8[4] - mu) * rs, (t8[5] - mu) * rs); w.w = cvtpk((t8[6] - mu) * rs, (t8[7] - mu) * rs);
                *(LAS v4u*)(lds + part * 16384 + tro(i, q * 16)) = w; }
        }
        __syncthreads();
        {
            LANEC;
            const int g = wave >> 1, ph = wave & 1;
            const LAS unsigned char* vn = lds + g * 16384;
            f32x16 acc[2][2];
#pragma unroll
            for (int ct = 0; ct < 2; ++ct)
#pragma unroll
                for (int pt = 0; pt < 2; ++pt)
#pragma unroll
                    for (int r = 0; r < 16; ++r) acc[ct][pt][r] = 0.f;
#pragma unroll 2
            for (int ks = 0; ks < 8; ++ks) {
                const int rlo = 16 * ks + 8 * hf + q4;
                bf16x8 A[2], B[2];
#pragma unroll
                for (int ct = 0; ct < 2; ++ct) A[ct] = tr_frag(vn, rlo, rlo + 4, (ct * 32 + 16 * blk + 4 * p4) * 2);
#pragma unroll
                for (int pt = 0; pt < 2; ++pt) { const float* wp = sguw + ((size_t)g * 128 + ph * 64 + pt * 32 + r32) * 128 + 16 * ks + 8 * hf; B[pt] = f32x8_to_frag(*(const f32x4*)wp, *(const f32x4*)(wp + 4)); }
#pragma unroll
                for (int ct = 0; ct < 2; ++ct)
#pragma unroll
                    for (int pt = 0; pt < 2; ++pt) acc[ct][pt] = MFMA32(A[ct], B[pt], acc[ct][pt]);
            }
#pragma unroll
            for (int pt = 0; pt < 2; ++pt) {
                const int p = ph * 64 + pt * 32 + r32; const int row = row0 + p; const float bias = sgub[g * 128 + p];
#pragma unroll
                for (int ct = 0; ct < 2; ++ct)
#pragma unroll
                    for (int g4 = 0; g4 < 4; ++g4) { const int c0 = ct * 32 + 8 * g4 + 4 * hf;
                        const v2u uw = *(const v2u*)(P + (size_t)row * INC + OFF_U + g * 64 + c0);
                        v2u w; w.x = cvtpk(bflo(uw.x) * (acc[ct][pt][4 * g4] + bias), bfhi(uw.x) * (acc[ct][pt][4 * g4 + 1] + bias));
                        w.y = cvtpk(bflo(uw.y) * (acc[ct][pt][4 * g4 + 2] + bias), bfhi(uw.y) * (acc[ct][pt][4 * g4 + 3] + bias));
                        *(v2u*)(Y + (size_t)row * 1024 + 768 + g * 64 + c0) = w; }
            }
        }
        }
#endif
        __syncthreads();
        if (tid == 0) dqw[0] = nxt;
        __syncthreads();
        item = __builtin_amdgcn_readfirstlane(dqw[0]);
    }
}

__device__ __forceinline__ void phase_f2(const Args& a, int l, LAS unsigned char* lds, int tid, int lane, int wave) {
    LAS int* lcnt = (LAS int*)(lds + LCNT_OFF); LAS float* LG = (LAS float*)(lds + LG_OFF);
    LAS unsigned char* HI = lds; LAS unsigned char* LO = lds + 65536; LAS float* PART = (LAS float*)lds;
    const int r32 = lane & 31, hf = lane >> 5;
    const int nrows = l == 0 ? NROWS : NLAT, ntiles = nrows >> 5;
    const float* mod = (const float*)(a.ws + WS_MOD) + l * 9 * 6144;
    const float* lng = a.in[13] + l * 1024; const float* lnb = a.in[14] + l * 1024;
    const float* rgb = a.in[16] + l * 4; const float* reb = a.in[18] + l * 32;
    bf16* Hb = (bf16*)(a.ws + WS_HB); unsigned* tok = (unsigned*)(a.ws + WS_TOK); float* xctx = (float*)(a.ws + WS_XCTX);
    const bf16* wr = (const bf16*)(a.ws + WS_WR) + (size_t)l * 2 * 64 * 1024;
    bf16x8 Bh[8][2], Bl[8][2];
#pragma unroll
    for (int ks = 0; ks < 8; ++ks)
#pragma unroll
        for (int ct = 0; ct < 2; ++ct) { const bf16* p = wr + (size_t)(ct * 32 + r32) * 1024 + wave * 128 + 16 * ks + 8 * hf; Bh[ks][ct] = *(const bf16x8*)p; Bl[ks][ct] = *(const bf16x8*)(p + 64 * 1024); }
    __syncthreads();
    if (tid < 32) lcnt[tid] = 0;
    __syncthreads();
    for (int T = blockIdx.x; T < ntiles; T += gridDim.x) {
#pragma unroll 1
        for (int rh = 0; rh < 2; ++rh) {
        f32x4 vv[2][4];
#pragma unroll
        for (int rq = 0; rq < 2; ++rq) { const int row = 32 * T + 4 * wave + 2 * rh + rq;
            const float* xr = row < NLAT ? a.out + (size_t)row * 1024 : xctx + (size_t)(row - NLAT) * 1024;
#pragma unroll
            for (int j = 0; j < 4; ++j) vv[rq][j] = *(const f32x4*)(xr + (lane + 64 * j) * 4); }
#pragma unroll
        for (int rq = 0; rq < 2; ++rq) {
            const int lr = 4 * wave + 2 * rh + rq, row = 32 * T + lr;
            float* xr = row < NLAT ? a.out + (size_t)row * 1024 : xctx + (size_t)(row - NLAT) * 1024;
            const float* m0 = mod + (row < NLAT ? (row >> 12) : 8) * 6144;
            f32x4 v[4]; float s = 0.f;
#pragma unroll
            for (int j = 0; j < 4; ++j) { v[j] = vv[rq][j]; s += (v[j].x + v[j].y) + (v[j].z + v[j].w); }
            const float mean = wave_sum(s) * (1.0f / 1024.0f); float s2 = 0.f;
#pragma unroll
            for (int j = 0; j < 4; ++j) { v[j] = v[j] - mean; s2 += (v[j].x * v[j].x + v[j].y * v[j].y) + (v[j].z * v[j].z + v[j].w * v[j].w); }
            const float rstd = 1.0f / sqrtf(wave_sum(s2) * (1.0f / 1024.0f) + LN_EPS);
#pragma unroll
            for (int j = 0; j < 4; ++j) { const int idx = (lane + 64 * j) * 4;
                const f32x4 x1 = v[j] * rstd * *(const f32x4*)(lng + idx) + *(const f32x4*)(lnb + idx);
                *(f32x4*)(xr + idx) = x1;
                const f32x4 hm = x1 * (*(const f32x4*)(m0 + 4096 + idx) + 1.0f) + *(const f32x4*)(m0 + 3072 + idx);
                v2u h; h.x = cvtpk(hm.x, hm.y); h.y = cvtpk(hm.z, hm.w);
                v2u lo; lo.x = cvtpk(hm.x - bflo(h.x), hm.y - bfhi(h.x)); lo.y = cvtpk(hm.z - bflo(h.y), hm.w - bfhi(h.y));
                *(v2u*)(Hb + (size_t)row * 1024 + idx) = h;
                const int off = lr * 2048 + (((((lane + 64 * j) >> 1)) ^ (lr & 15)) << 4) + (lane & 1) * 8;
                *(LAS v2u*)(HI + off) = h; *(LAS v2u*)(LO + off) = lo; }
        }
        }
        __syncthreads();
        f32x16 acc[2];
#pragma unroll
        for (int r = 0; r < 16; ++r) { acc[0][r] = 0.f; acc[1][r] = 0.f; }
#pragma unroll
        for (int ks = 0; ks < 8; ++ks) { const int off = r32 * 2048 + (((wave * 16 + 2 * ks + hf) ^ (r32 & 15)) << 4);
            const bf16x8 Ah = *(const LAS bf16x8*)(HI + off), Al = *(const LAS bf16x8*)(LO + off);
#pragma unroll
            for (int ct = 0; ct < 2; ++ct) { acc[ct] = MFMA32(Ah, Bh[ks][ct], acc[ct]); acc[ct] = MFMA32(Ah, Bl[ks][ct], acc[ct]); acc[ct] = MFMA32(Al, Bh[ks][ct], acc[ct]); } }
        __syncthreads();
#pragma unroll
        for (int ct = 0; ct < 2; ++ct)
#pragma unroll
            for (int r = 0; r < 16; ++r) PART[(wave * 32 + crow(r, hf)) * 64 + ct * 32 + r32] = acc[ct][r];
        __syncthreads();
        { const int row = tid >> 4, cg = tid & 15;
#pragma unroll
          for (int q = 0; q < 3; ++q) { const int col = cg + 16 * q; if (col < 36) { float sum = 0.f;
#pragma unroll
                  for (int w = 0; w < 8; ++w) sum += PART[(w * 32 + row) * 64 + col];
                  LG[row * 40 + col] = sum; } } }
        __syncthreads();
        if (tid < 32) { const int row = 32 * T + tid; const LAS float* lgp = LG + tid * 40;
            float lg[4];
#pragma unroll
            for (int g = 0; g < 4; ++g) lg[g] = lgp[g] + rgb[g];
            int gi = 0; float gm = lg[0];
#pragma unroll
            for (int g = 1; g < 4; ++g) if (lg[g] > gm) { gm = lg[g]; gi = g; }
            float gden = 0.f;
#pragma unroll
            for (int g = 0; g < 4; ++g) gden += expf(lg[g] - gm);
            const float gprob = 1.0f / gden;
            float le[8];
#pragma unroll
            for (int e = 0; e < 8; ++e) le[e] = lgp[4 + gi * 8 + e] + reb[gi * 8 + e];
            int i1 = 0; float m1 = le[0];
#pragma unroll
            for (int e = 1; e < 8; ++e) if (le[e] > m1) { m1 = le[e]; i1 = e; }
            int i2 = -1; float m2 = -3.0e38f;
#pragma unroll
            for (int e = 0; e < 8; ++e) if (e != i1 && le[e] > m2) { m2 = le[e]; i2 = e; }
            const float p2 = expf(m2 - m1), inv = 1.0f / (1.0f + p2);
            const float gate0 = gprob * inv, gate1 = gprob * p2 * inv;
            const int e0 = gi * 8 + i1, e1 = gi * 8 + i2;
            const int p0 = __hip_atomic_fetch_add(lcnt + e0, 1, __ATOMIC_RELAXED, __HIP_MEMORY_SCOPE_WORKGROUP);
            const int p1 = __hip_atomic_fetch_add(lcnt + e1, 1, __ATOMIC_RELAXED, __HIP_MEMORY_SCOPE_WORKGROUP);
            unsigned* t = tok + (size_t)row * 8; t[0] = (unsigned)e0 | ((unsigned)e1 << 8); t[1] = (unsigned)p0; t[2] = (unsigned)p1;
            t[4] = __builtin_bit_cast(unsigned, gate0); t[5] = __builtin_bit_cast(unsigned, gate1); }
    }
    __syncthreads();
    if (tid < 32) ((unsigned*)(a.ws + WS_CTL))[CW_WGCNT + (l * 256 + blockIdx.x) * 32 + tid] = (unsigned)lcnt[tid];
    __syncthreads();
}
#ifndef MK_PER_PHASE
#define MK_PER_PHASE 0
#endif
constexpr int N_PHASES = 22;

__global__ void __launch_bounds__(NTHR, 2) hybrid_fwd(Args args) {
    extern __shared__ __attribute__((aligned(16))) unsigned char lds_raw[];
    LAS unsigned char* lds = (LAS unsigned char*)lds_raw;
    const int tid0 = threadIdx.x;
    for (int u = tid0; u < (LDS_BYTES - LDSCTL_OFF) / 4; u += NTHR) ((LAS unsigned*)(lds + LDSCTL_OFF))[u] = 0u;
#define TIDS int tid = threadIdx.x; asm volatile("" : "+v"(tid)); const int lane = tid & 63, wave = __builtin_amdgcn_readfirstlane(tid >> 6); (void)lane; (void)wave
    __syncthreads();
    unsigned* ctl = (unsigned*)(args.ws + WS_CTL);
    XcdBarrier bar; bar.bar = ctl + CW_BAR; bar.x = 0; bar.st = nullptr;
    if (!MK_PER_PHASE) bar = xcd_barrier_post(ctl + CW_BAR, (volatile LAS unsigned*)(lds + MISC_OFF + 32));
    const int lo = args.ph_lo, hi = args.ph_hi;
#ifndef PHMASK
#define PHMASK 0xFFFFFFu
#endif
#define PHON(k) (((PHMASK) >> ((k) < 2 ? (k) : 2 + ((k) - 2) % 10)) & 1u)
#define IN(k) (PHON(k) && lo <= (k) && (k) < hi)
#ifndef REPMASK
#define REPMASK 0u
#endif
#define NREP(k) (1 + (int)(((REPMASK) >> ((k) < 2 ? (k) : 2 + ((k) - 2) % 10)) & 1u))
#define SEAM(k) do { if (IN(k) && IN((k) + 1)) xcd_barrier(bar); } while (0)

    if (IN(0)) for (int rep = 0; rep < NREP(0); ++rep) { TIDS; phase_p0(args, lds, tid, lane, wave); }
    SEAM(0);
    if (IN(1)) for (int rep = 0; rep < NREP(1); ++rep) { TIDS; phase_p1(args, lane, wave); }
    SEAM(1);
    for (int l = 0; l < 2; ++l) {
        const int pb = 2 + 10 * l;
        bf16* Hb = (bf16*)(args.ws + WS_HB);
        if (IN(pb + 0)) for (int rep = 0; rep < NREP(2); ++rep) {
            pg8::Gemm g{Hb, (const bf16*)(args.ws + WS_WIN) + (size_t)l * INC * 1024, NROWS, INC, 1024}; pg8::StaticOrder S; S.init(NROWS, INC, (int)gridDim.x, (int)blockIdx.x);
            pg8::EpiBf16<0> E{(bf16*)(args.ws + WS_P), INC, nullptr, 0, 0, 1.0f};
            pg8::gemm_phase<pg8::EpiBf16<0>, pg8::StaticOrder, true, true>(lds, g, S, E);
        }
        SEAM(pb + 0);
        if (IN(pb + 1)) for (int rep = 0; rep < NREP(3); ++rep) { TIDS; phase_b_mfma(args, l, lds, tid, lane, wave); }
        SEAM(pb + 1);
        if (IN(pb + 2)) { TIDS; phase_c(args, l, tid); }
        SEAM(pb + 2);
        if (IN(pb + 3)) for (int rep = 0; rep < NREP(5); ++rep) { TIDS; phase_d_mfma(args, l, lds, tid, lane, wave); }
        SEAM(pb + 3);
        if (IN(pb + 4)) for (int rep = 0; rep < (l == 0 ? NREP(6) : 1); ++rep) {
            const int M = l == 0 ? NROWS : NLAT;
            pg8::Gemm g{(const bf16*)(args.ws + WS_YMIX), (const bf16*)(args.ws + WS_WOUT) + (size_t)l * 1024 * 1024, M, 1024, 1024}; pg8::StaticOrder S; S.init(M, 1024, (int)gridDim.x, (int)blockIdx.x);
            float* xctx = (float*)(args.ws + WS_XCTX);
            pg8::EpiResid E{l == 0 ? args.in[0] : args.out, l == 0 ? args.in[2] : xctx, args.out, xctx, (const float*)(args.ws + WS_MOD) + l * 9 * 6144, ALPHA};
            pg8::gemm_phase<pg8::EpiResid, pg8::StaticOrder, true, true>(lds, g, S, E);
        }
        SEAM(pb + 4);
        if (IN(pb + 5)) { TIDS; phase_f2(args, l, lds, tid, lane, wave); }
        SEAM(pb + 5);
        if (IN(pb + 6)) for (int rep = 0; rep < NREP(8); ++rep) { TIDS; phase_g(args, l, lds, tid, lane, wave); }
        SEAM(pb + 6);
        if (IN(pb + 7)) for (int rep = 0; rep < NREP(9); ++rep) {
            int npan; { TIDS; npan = build_p2e(args, l, lds, tid); }
            pg8::Gemm g{(const bf16*)(args.ws + WS_XB), (const bf16*)(args.ws + WS_WGU) + (size_t)l * 32 * 1024 * 1024, npan * 256, 1024, 1024};
            pg8::MoeOrder S{(const LAS unsigned char*)(lds + P2E_OFF), npan * 4, (int)gridDim.x, (int)blockIdx.x};
            pg8::EpiGLU E{(bf16*)(args.ws + WS_HH)};
            pg8::gemm_phase<pg8::EpiGLU, pg8::MoeOrder, true, true>(lds, g, S, E);
        }
        SEAM(pb + 7);
        if (IN(pb + 8)) for (int rep = 0; rep < NREP(10); ++rep) {
            int npan; { TIDS; npan = build_p2e(args, l, lds, tid); }
            pg8::Gemm g{(const bf16*)(args.ws + WS_HH), (const bf16*)(args.ws + WS_WD) + (size_t)l * 32 * 1024 * 512, npan * 256, 1024, 512};
            pg8::MoeOrder S{(const LAS unsigned char*)(lds + P2E_OFF), npan * 4, (int)gridDim.x, (int)blockIdx.x};
            pg8::EpiY E{(bf16*)(args.ws + WS_Y)};
            pg8::gemm_phase<pg8::EpiY, pg8::MoeOrder, true, true>(lds, g, S, E);
        }
        SEAM(pb + 8);
        if (IN(pb + 9)) { if (NREP(11) > 1) { TIDS; phase_j(args, l, lane, wave, true); } TIDS; phase_j(args, l, lane, wave); }
        SEAM(pb + 9);
    }
#undef IN
#undef SEAM
}

extern "C" void kernel_launch(void* const* d_in, const int* in_sizes, int n_in, void* d_out, int out_size, void* d_ws, size_t ws_size, hipStream_t stream) {
    static int grid = 0;
    if (grid == 0) {
        if (n_in != 24 || in_sizes[0] != NLAT * DM || out_size != NLAT * DM || ws_size < WS_END) { fprintf(stderr, "kernel_launch: unexpected problem (n_in %d, ws %zu < %zu?)\n", n_in, ws_size, (size_t)WS_END); grid = -1; return; }
        int dev = 0, cus = 0, per_cu = 0;
        if (hipGetDevice(&dev) != hipSuccess || hipDeviceGetAttribute(&cus, hipDeviceAttributeMultiprocessorCount, dev) != hipSuccess) { grid = -1; return; }
        if (hipFuncSetAttribute((const void*)hybrid_fwd, hipFuncAttributeMaxDynamicSharedMemorySize, LDS_BYTES) != hipSuccess) { grid = -1; return; }
        if (hipOccupancyMaxActiveBlocksPerMultiprocessor(&per_cu, (const void*)hybrid_fwd, NTHR, LDS_BYTES) != hipSuccess || per_cu < 1) { fprintf(stderr, "kernel_launch: occupancy query says %d\n", per_cu); }
        (void)hipGetLastError();
        grid = cus;
        if (grid != 256) { fprintf(stderr, "kernel_launch: built for 256 CUs, device has %d\n", cus); grid = -1; return; }
    }
    if (grid < 0) return;
    if (hipMemsetAsync((char*)d_ws + WS_CTL, 0, CTL_ZERO_BYTES, stream) != hipSuccess) return;
    Args a{};
    for (int i = 0; i < 24; ++i) a.in[i] = (const float*)d_in[i];
    a.out = (float*)d_out; a.ws = (unsigned char*)d_ws;
#if MK_PER_PHASE
    for (int p = 0; p < N_PHASES; ++p) { a.ph_lo = p; a.ph_hi = p + 1; hipLaunchKernelGGL(hybrid_fwd, dim3(grid), dim3(NTHR), LDS_BYTES, stream, a); }
#else
    a.ph_lo = 0; a.ph_hi = N_PHASES;
    hipLaunchKernelGGL(hybrid_fwd, dim3(grid), dim3(NTHR), LDS_BYTES, stream, a);
#endif
}
```

```cpp
#include <hip/hip_runtime.h>
#include <cstdio>
#include <cstdint>
#include <cstddef>
namespace pg8 {
#define PG8_LAS __attribute__((address_space(3)))
typedef unsigned short bf16_t;
typedef short bf16x8 __attribute__((ext_vector_type(8)));
typedef float f32x4 __attribute__((ext_vector_type(4)));
typedef unsigned u32x4 __attribute__((ext_vector_type(4)));
constexpr int BM = 256, BK = 64, HALF = 128, HTB = HALF * BK * 2  , STAGE_BYTES = 8 * HTB, NXCD = 8, WGM = 8;

__host__ __device__ __forceinline__ int lds_byte(int r, int c) { const int st = (r >> 4) * 2 + (c >> 5), rr = r & 15, cc = c & 31, ob = rr * 64 + cc * 2; return st * 1024 + (ob ^ (((ob >> 9) & 1) << 5)); }
__host__ __device__ __forceinline__ void stage_rc(int b, int& R, int& C) { const int st = b / 1024, sb = b % 1024, swz = sb ^ (((sb >> 9) & 1) << 5); R = (st >> 1) * 16 + swz / 64; C = (st & 1) * 32 + (swz % 64) / 2; }
__host__ __device__ __forceinline__ int perm32(int rho) { const int n = rho >> 4, i = rho & 15; return 8 * (i >> 2) + 4 * n + (i & 3); }

struct Unit { int pm, pn; };
struct Gemm { const bf16_t* A; const bf16_t* Bt; int M, N, K; };

struct StaticOrder {
    int nM, nN, nwg, G, c;
    __host__ __device__ void init(int M, int N, int G_, int c_) { nM = M / BM; nN = N / BM; nwg = nM * nN; G = G_; c = c_; }
    __host__ __device__ bool next(int i, Unit& u) const {
        const long L = (long)i * G + c; if (L >= nwg) return false;
        int wgid = (int)L; { const int q = nwg / NXCD, r = nwg % NXCD, xcd = wgid % NXCD, off = wgid / NXCD; wgid = (xcd < r ? xcd * (q + 1) : r * (q + 1) + (xcd - r) * q) + off; }
        const int nig = WGM * nN, gid = wgid / nig, fm = gid * WGM, gsz = (nM - fm) < WGM ? (nM - fm) : WGM;
        u.pm = fm + ((wgid % nig) % gsz); u.pn = (wgid % nig) / gsz; return true;
    }
    __device__ __forceinline__ void a_ready(const Unit&) const {}
    __device__ __forceinline__ void done(const Unit&) const {}
};

__device__ __forceinline__ unsigned cvt_pk_bf16(float lo, float hi) { unsigned r; asm volatile("v_cvt_pk_bf16_f32 %0, %1, %2" : "=v"(r) : "v"(lo), "v"(hi)); return r; }
typedef float f32x2 __attribute__((ext_vector_type(2)));
__device__ __forceinline__ f32x2 gelu_pk(f32x2 v) {
    const f32x2 av = __builtin_elementwise_abs(v), d = av * 0.2316418882f + 1.0f;
    f32x2 t; t.x = __builtin_amdgcn_rcpf(d.x); t.y = __builtin_amdgcn_rcpf(d.y);
    f32x2 q = t * 0.5307027145f + (-0.7265760135f); q = q * t + 0.7107068705f; q = q * t + (-0.142248368f); q = q * t + 0.127414796f; q = q * t;
    const f32x2 s = (v * v) * (-0.72134752044f);
    f32x2 e; e.x = __builtin_amdgcn_exp2f(s.x); e.y = __builtin_amdgcn_exp2f(s.y);
    const f32x2 m = v * (q * e), r = v - m;
    f32x2 o; o.x = v.x < 0.f ? m.x : r.x; o.y = v.y < 0.f ? m.y : r.y; return o;
}

template <int ACT  > struct EpiBf16 {
    static constexpr bool PERM = true, AFTER_DRAIN = false; static_assert(ACT == 0 || ACT == 1, "EpiBf16: ACT is 0 (none) or 1 (gelu_pk)");
    bf16_t* O; int ldc; const float* bias; int split_cols; size_t split_stride; float scale0;
    __device__ __forceinline__ void operator()(const f32x4 (&acc)[2][2][4][2], const Unit& u, int wr, int wc, int fr, int fq) const {
        const int row0 = u.pm * BM + wr * 64 + fr; int colt = u.pn * BM; bf16_t* base = O;
        float sc = 1.f; if (split_cols) { const int t = colt / split_cols; base += (size_t)t * split_stride; colt -= t * split_cols; if (t == 0) sc = scale0; }
        const int col0 = colt + wc * 32 + 8 * fq, bcol0 = u.pn * BM + wc * 32 + 8 * fq;
        f32x4 bv[2][2];
#pragma unroll
        for (int bj = 0; bj < 2; ++bj)
#pragma unroll
            for (int n = 0; n < 2; ++n) bv[bj][n] = bias ? *(const f32x4*)(bias + bcol0 + bj * HALF + 4 * n) : (f32x4){0.f, 0.f, 0.f, 0.f};
#pragma unroll
        for (int ai = 0; ai < 2; ++ai)
#pragma unroll
            for (int m = 0; m < 4; ++m) { bf16_t* rowp = base + (size_t)(row0 + ai * HALF + m * 16) * ldc + col0;
#pragma unroll
                for (int bj = 0; bj < 2; ++bj) { f32x4 v0 = acc[ai][bj][m][0] + bv[bj][0], v1 = acc[ai][bj][m][1] + bv[bj][1];
                    if (ACT == 1) { f32x2 a = gelu_pk((f32x2){v0[0], v0[1]}), b = gelu_pk((f32x2){v0[2], v0[3]}), c = gelu_pk((f32x2){v1[0], v1[1]}), d = gelu_pk((f32x2){v1[2], v1[3]});
                        v0 = (f32x4){a.x, a.y, b.x, b.y}; v1 = (f32x4){c.x, c.y, d.x, d.y}; }
                    v0 = v0 * sc; v1 = v1 * sc; u32x4 w; w.x = cvt_pk_bf16(v0[0], v0[1]); w.y = cvt_pk_bf16(v0[2], v0[3]); w.z = cvt_pk_bf16(v1[0], v1[1]); w.w = cvt_pk_bf16(v1[2], v1[3]);
                    *(u32x4*)(rowp + bj * HALF) = w; } }
    }
};
__device__ __forceinline__ float silu_f(float x) { return x / (1.0f + __expf(-x)); }
struct EpiResid {
    static constexpr bool PERM = false, AFTER_DRAIN = false;
    const float* xin_lat; const float* xin_ctx; float* xo_lat; float* xo_ctx; const float* mod; float alpha;
    __device__ __forceinline__ void operator()(const f32x4 (&acc)[2][2][4][2], const Unit& u, int wr, int wc, int fr, int fq) const {
        const int prow0 = u.pm * BM; const bool isc = prow0 >= 32768;
        const float* xin = isc ? xin_ctx + (size_t)(prow0 - 32768) * 1024 : xin_lat + (size_t)prow0 * 1024;
        float* xo = isc ? xo_ctx + (size_t)(prow0 - 32768) * 1024 : xo_lat + (size_t)prow0 * 1024;
        const float* g1 = mod + (isc ? 8 : (prow0 >> 12)) * 6144 + 2048;
        const int col0 = u.pn * BM + wc * 32 + 4 * fq;
        f32x4 gv[2][2];
#pragma unroll
        for (int bj = 0; bj < 2; ++bj)
#pragma unroll
            for (int n = 0; n < 2; ++n) gv[bj][n] = *(const f32x4*)(g1 + col0 + bj * HALF + n * 16);
#pragma unroll
        for (int ai = 0; ai < 2; ++ai)
#pragma unroll
            for (int m = 0; m < 4; ++m) { const size_t off = (size_t)(ai * HALF + wr * 64 + m * 16 + fr) * 1024 + col0;
#pragma unroll
                for (int bj = 0; bj < 2; ++bj)
#pragma unroll
                    for (int n = 0; n < 2; ++n) { const f32x4 xv = *(const f32x4*)(xin + off + bj * HALF + n * 16);
                        *(f32x4*)(xo + off + bj * HALF + n * 16) = xv * alpha + gv[bj][n] * acc[ai][bj][m][n]; }
                if (m & 1) asm volatile("" ::: "memory"); }
    }
};
struct EpiGLU {
    static constexpr bool PERM = true, AFTER_DRAIN = false;
    bf16_t* Hh;
    __device__ __forceinline__ void operator()(const f32x4 (&acc)[2][2][4][2], const Unit& u, int wr, int wc, int fr, int fq) const {
        const int row0 = u.pm * BM + wr * 64 + fr; const int col0 = (u.pn & 3) * 128 + wc * 32 + 8 * fq;
#pragma unroll
        for (int ai = 0; ai < 2; ++ai)
#pragma unroll
            for (int m = 0; m < 4; ++m) { bf16_t* rowp = Hh + (size_t)(row0 + ai * HALF + m * 16) * 512 + col0;
                const f32x4 g0 = acc[ai][0][m][0], g1 = acc[ai][0][m][1], u0 = acc[ai][1][m][0], u1 = acc[ai][1][m][1];
                u32x4 w; w.x = cvt_pk_bf16(silu_f(g0[0]) * u0[0], silu_f(g0[1]) * u0[1]); w.y = cvt_pk_bf16(silu_f(g0[2]) * u0[2], silu_f(g0[3]) * u0[3]);
                w.z = cvt_pk_bf16(silu_f(g1[0]) * u1[0], silu_f(g1[1]) * u1[1]); w.w = cvt_pk_bf16(silu_f(g1[2]) * u1[2], silu_f(g1[3]) * u1[3]);
                *(u32x4*)rowp = w; }
    }
};
struct EpiY {
    static constexpr bool PERM = true, AFTER_DRAIN = false;
    bf16_t* O;
    __device__ __forceinline__ void operator()(const f32x4 (&acc)[2][2][4][2], const Unit& u, int wr, int wc, int fr, int fq) const {
        const int row0 = u.pm * BM + wr * 64 + fr; const int col0 = (u.pn & 3) * BM + wc * 32 + 8 * fq;
#pragma unroll
        for (int ai = 0; ai < 2; ++ai)
#pragma unroll
            for (int m = 0; m < 4; ++m) { bf16_t* rowp = O + (size_t)(row0 + ai * HALF + m * 16) * 1024 + col0;
#pragma unroll
                for (int bj = 0; bj < 2; ++bj) { const f32x4 v0 = acc[ai][bj][m][0], v1 = acc[ai][bj][m][1];
                    u32x4 w; w.x = cvt_pk_bf16(v0[0], v0[1]); w.y = cvt_pk_bf16(v0[2], v0[3]); w.z = cvt_pk_bf16(v1[0], v1[1]); w.w = cvt_pk_bf16(v1[2], v1[3]);
                    *(u32x4*)(rowp + bj * HALF) = w; } }
    }
};
struct MoeOrder {
    const PG8_LAS unsigned char* p2e; int nunits, G, c;
    __device__ __forceinline__ bool next(int i, Unit& u) const {
        const int L = i * G + c; if (L >= nunits) return false;
        u.pm = L >> 2; u.pn = (int)p2e[L >> 2] * 4 + (L & 3); return true;
    }
    __device__ __forceinline__ void a_ready(const Unit&) const {}
    __device__ __forceinline__ void done(const Unit&) const {}
};
template <class Epi, class Sched, bool ALIGN_EPI = false, bool SP2 = false>
__device__ __forceinline__ void gemm_phase(PG8_LAS unsigned char* lds, const Gemm g, const Sched& S, const Epi& E) {
    int tid_ = threadIdx.x; asm volatile("" : "+v"(tid_));
    const int tid = tid_, wid = __builtin_amdgcn_readfirstlane(tid >> 6), lane = tid & 63, wr = wid >> 2, wc = wid & 3, fr = lane & 15, fq = lane >> 4;
    const int K = g.K, nt = K / BK;
    unsigned voffA[2], voffB[2];
#pragma unroll
    for (int i = 0; i < 2; ++i) { int R, C; stage_rc(tid * 16 + i * 8192, R, C); const int Rb = Epi::PERM ? ((R & ~31) + perm32(R & 31)) : R;
        voffA[i] = (unsigned)(R * K + C) * 2u; voffB[i] = (unsigned)(Rb * K + C) * 2u; }
    const size_t kstep = (size_t)(BK * 2);
    const size_t hstep = (size_t)HALF * K * 2;
    const size_t tstep = 2 * hstep;
    const unsigned ldsw = (unsigned)wid * 1024u;
    const int aoff = lds_byte(wr * 64 + fr, fq * 8), boff = lds_byte(wc * 32 + fr, fq * 8);
#define PG8_SA(b, h) (((b) * 2 + (h)) * HTB)
#define PG8_SB(b, h) ((4 + (b) * 2 + (h)) * HTB)
#define PG8_STAGE(bufoff, gbase, voff) do { _Pragma("unroll") for (int _i = 0; _i < 2; ++_i) \
        __builtin_amdgcn_global_load_lds((const unsigned*)((const char*)(gbase) + (voff)[_i]), (PG8_LAS unsigned*)(lds + (bufoff) + ldsw + _i * 8192), 16, 0, 0); } while (0)
#define PG8_LDA(dst, b, h) do { _Pragma("unroll") for (int m = 0; m < 4; ++m) _Pragma("unroll") for (int k = 0; k < 2; ++k) dst[m][k] = *(const PG8_LAS bf16x8*)(lds + PG8_SA(b, h) + aoff + m * 2048 + k * 1024); } while (0)
#define PG8_LDB(dst, b, h) do { _Pragma("unroll") for (int n = 0; n < 2; ++n) _Pragma("unroll") for (int k = 0; k < 2; ++k) dst[n][k] = *(const PG8_LAS bf16x8*)(lds + PG8_SB(b, h) + boff + n * 2048 + k * 1024); } while (0)
#define PG8_MMA(ai, bj, At, Bt) do { __builtin_amdgcn_s_setprio(1); _Pragma("unroll") for (int m = 0; m < 4; ++m) _Pragma("unroll") for (int n = 0; n < 2; ++n) _Pragma("unroll") for (int k = 0; k < 2; ++k) \
        acc[ai][bj][m][n] = __builtin_amdgcn_mfma_f32_16x16x32_bf16(Bt[n][k], At[m][k], acc[ai][bj][m][n], 0, 0, 0); __builtin_amdgcn_s_setprio(0); } while (0)
#define PG8_WAIT_V(n) asm volatile("s_waitcnt vmcnt(" #n ")" ::: "memory")
#define PG8_WAIT_L(n) asm volatile("s_waitcnt lgkmcnt(" #n ")" ::: "memory")
#define PG8_BAR __builtin_amdgcn_s_barrier()
#define PG8_SCHED __builtin_amdgcn_sched_barrier(0)
    Unit cur, nxt; int ui = 0;
    if (!S.next(0, cur)) return;
    f32x4 acc[2][2][4][2];
#pragma unroll
    for (int a = 0; a < 2; ++a)
#pragma unroll
        for (int b = 0; b < 2; ++b)
#pragma unroll
            for (int m = 0; m < 4; ++m)
#pragma unroll
                for (int n = 0; n < 2; ++n) acc[a][b][m][n] = (f32x4){0.f, 0.f, 0.f, 0.f};
    bf16x8 At[4][2], B0[2][2], B1[2][2];
    const char* cA = (const char*)g.A + (size_t)cur.pm * tstep; const char* cB = (const char*)g.Bt + (size_t)cur.pn * tstep;
    S.a_ready(cur);
    if constexpr (SP2) {
        PG8_STAGE(PG8_SB(0, 0), cB, voffB); PG8_STAGE(PG8_SB(0, 1), cB + hstep, voffB); PG8_STAGE(PG8_SA(0, 0), cA, voffA); PG8_STAGE(PG8_SA(0, 1), cA + hstep, voffA);
        if (wr == 1) PG8_BAR;
        PG8_WAIT_V(2); PG8_BAR;
        PG8_STAGE(PG8_SB(1, 0), cB + kstep, voffB); PG8_STAGE(PG8_SA(1, 0), cA + kstep, voffA); PG8_STAGE(PG8_SB(1, 1), cB + hstep + kstep, voffB);
        PG8_WAIT_V(6); PG8_BAR;
    } else {
        PG8_STAGE(PG8_SB(0, 0), cB, voffB); PG8_STAGE(PG8_SA(0, 0), cA, voffA); PG8_STAGE(PG8_SB(0, 1), cB + hstep, voffB); PG8_STAGE(PG8_SA(0, 1), cA + hstep, voffA);
        if (wr == 1) PG8_BAR;
        PG8_WAIT_V(4); PG8_BAR;
        PG8_STAGE(PG8_SB(1, 0), cB + kstep, voffB); PG8_STAGE(PG8_SA(1, 0), cA + kstep, voffA); PG8_STAGE(PG8_SB(1, 1), cB + hstep + kstep, voffB);
        PG8_WAIT_V(6); PG8_BAR;
    }
    for (;;) {
        const bool has_next = S.next(ui + 1, nxt);
        const char* nA = has_next ? (const char*)g.A + (size_t)nxt.pm * tstep : cA; const char* nB = has_next ? (const char*)g.Bt + (size_t)nxt.pn * tstep : cB;
        for (int t = 0; t < nt; t += 2) {
            const bool last = (t == nt - 2);
            const char* a1 = cA + (size_t)(t + 1) * kstep;
            const char* a2 = last ? nA : cA + (size_t)(t + 2) * kstep; const char* b2 = last ? nB : cB + (size_t)(t + 2) * kstep;
            const char* a3 = a2 + kstep; const char* b3 = b2 + kstep;
            if (last && has_next) S.a_ready(nxt);
            if constexpr (SP2) {
            PG8_LDB(B0, 0, 0); PG8_LDB(B1, 0, 1); PG8_SCHED; PG8_LDA(At, 0, 0); PG8_STAGE(PG8_SA(1, 1), a1 + hstep, voffA);
            PG8_WAIT_V(8); PG8_WAIT_L(0); PG8_BAR; PG8_MMA(0, 0, At, B0); PG8_MMA(0, 1, At, B1); PG8_BAR; PG8_SCHED;
            PG8_LDA(At, 0, 1); PG8_STAGE(PG8_SB(0, 0), b2, voffB); PG8_STAGE(PG8_SB(0, 1), b2 + hstep, voffB); PG8_STAGE(PG8_SA(0, 0), a2, voffA);
            PG8_WAIT_V(8); PG8_WAIT_L(0); PG8_BAR; PG8_MMA(1, 0, At, B0); PG8_MMA(1, 1, At, B1); PG8_BAR; PG8_SCHED;
            PG8_LDB(B0, 1, 0); PG8_LDB(B1, 1, 1); PG8_SCHED; PG8_LDA(At, 1, 0); PG8_STAGE(PG8_SA(0, 1), a2 + hstep, voffA);
            PG8_WAIT_V(8); PG8_WAIT_L(0); PG8_BAR; PG8_MMA(0, 0, At, B0); PG8_MMA(0, 1, At, B1); PG8_BAR; PG8_SCHED;
            PG8_LDA(At, 1, 1); PG8_STAGE(PG8_SB(1, 0), b3, voffB); PG8_STAGE(PG8_SB(1, 1), b3 + hstep, voffB); PG8_STAGE(PG8_SA(1, 0), a3, voffA);
            PG8_WAIT_V(8); PG8_WAIT_L(0); PG8_BAR; PG8_MMA(1, 0, At, B0); PG8_MMA(1, 1, At, B1); PG8_BAR; PG8_SCHED;
            } else {
            PG8_LDB(B0, 0, 0); PG8_SCHED; PG8_LDA(At, 0, 0); PG8_STAGE(PG8_SA(1, 1), a1 + hstep, voffA);
            PG8_WAIT_L(8); PG8_BAR; PG8_WAIT_L(0); PG8_MMA(0, 0, At, B0); PG8_BAR; PG8_SCHED;
            PG8_LDB(B1, 0, 1); PG8_STAGE(PG8_SB(0, 0), b2, voffB);
            PG8_BAR; PG8_WAIT_L(0); PG8_MMA(0, 1, At, B1); PG8_BAR;
            PG8_LDA(At, 0, 1); PG8_STAGE(PG8_SA(0, 0), a2, voffA);
            PG8_BAR; PG8_WAIT_L(0); PG8_MMA(1, 0, At, B0); PG8_BAR; PG8_SCHED;
            PG8_STAGE(PG8_SB(0, 1), b2 + hstep, voffB);
            PG8_WAIT_V(6); PG8_BAR; PG8_MMA(1, 1, At, B1); PG8_BAR;
            PG8_LDB(B0, 1, 0); PG8_SCHED; PG8_LDA(At, 1, 0); PG8_STAGE(PG8_SA(0, 1), a2 + hstep, voffA);
            PG8_WAIT_L(8); PG8_BAR; PG8_WAIT_L(0); PG8_MMA(0, 0, At, B0); PG8_BAR; PG8_SCHED;
            PG8_LDB(B1, 1, 1); PG8_STAGE(PG8_SB(1, 0), b3, voffB);
            PG8_BAR; PG8_WAIT_L(0); PG8_MMA(0, 1, At, B1); PG8_BAR;
            PG8_LDA(At, 1, 1); PG8_STAGE(PG8_SA(1, 0), a3, voffA);
            PG8_BAR; PG8_WAIT_L(0); PG8_MMA(1, 0, At, B0); PG8_BAR; PG8_SCHED;
            PG8_STAGE(PG8_SB(1, 1), b3 + hstep, voffB);
            PG8_WAIT_V(6); PG8_BAR; PG8_MMA(1, 1, At, B1); PG8_BAR;
            }
        }
        if constexpr (ALIGN_EPI) { if (wr == 0) PG8_BAR; }
        if constexpr (!Epi::AFTER_DRAIN) { E(acc, cur, wr, wc, fr, fq); S.done(cur); }
        if (!has_next) break;
#pragma unroll
        for (int a = 0; a < 2; ++a)
#pragma unroll
            for (int b = 0; b < 2; ++b)
#pragma unroll
                for (int m = 0; m < 4; ++m)
#pragma unroll
                    for (int n = 0; n < 2; ++n) acc[a][b][m][n] = (f32x4){0.f, 0.f, 0.f, 0.f};
        cur = nxt; cA = nA; cB = nB; ++ui;
        if constexpr (ALIGN_EPI) { if (wr == 1) PG8_BAR; }
    }
    PG8_WAIT_V(0);
    if constexpr (!ALIGN_EPI) { if (wr == 0) PG8_BAR; }
    PG8_BAR;
    if constexpr (Epi::AFTER_DRAIN) { E.fused(acc, cur, wr, wc, fr, fq, lds, wid, lane); S.done(cur); }
#undef PG8_SA
#undef PG8_SB
#undef PG8_STAGE
#undef PG8_LDA
#undef PG8_LDB
#undef PG8_MMA
#undef PG8_WAIT_V
#undef PG8_WAIT_L
#undef PG8_BAR
#undef PG8_SCHED
}
}
constexpr int NWAVES = 8, NTHR = 512;
constexpr int DM = 1024, NLAT = 32768, NCTX = 2048, NROWS = 34816, INC = 3328;
constexpr int OFF_CB = 0, OFF_CC = 256, OFF_CX = 512, OFF_Q = 768, OFF_K = 1280, OFF_V = 1792, OFF_G = 2304, OFF_U = 2816, OFF_VV = 3072;
constexpr int NCH = 34;
constexpr float LN_EPS = 1e-5f, ALPHA = 1.41421356237309515f;
constexpr size_t MiB = 1u << 20;
constexpr size_t WS_CTL = 0, CTL_ZERO_BYTES = MiB, WS_MOD = 1 * MiB, WS_WR = 1 * MiB + 512 * 1024, WS_TOK = 2 * MiB, WS_WIN = 4 * MiB, WS_WOUT = 17 * MiB, WS_WGU = 21 * MiB, WS_WD = 149 * MiB,
                 WS_HB = 213 * MiB, WS_ST = WS_HB, WS_XCTX = 281 * MiB, WS_P = 289 * MiB, WS_YMIX = 510 * MiB, WS_XB = WS_P, WS_Y = WS_P, WS_YO = WS_P, WS_HH = WS_P + 152 * MiB, WS_END = 578 * MiB;
constexpr int CW_TMO = 0, CW_BAR = 4096, CW_WGCNT = 16384, CW_TOT = 32768, CW_DQ = 33024;
constexpr int RING_BYTES = 131072, LDSCTL_OFF = RING_BYTES, MISC_OFF = LDSCTL_OFF + 320, P2E_OFF = LDSCTL_OFF + 1024, PST_OFF = LDSCTL_OFF + 2048, LDS_BYTES = 147456;
constexpr int MAXPANELS = 304;
constexpr int LCNT_OFF = LDSCTL_OFF + 4096, LG_OFF = LDSCTL_OFF + 4352, DQ_OFF = LDSCTL_OFF + 9600;

#define GAS __attribute__((address_space(1)))
#define LAS __attribute__((address_space(3)))
typedef unsigned short bf16;
typedef unsigned v4u __attribute__((ext_vector_type(4)));
typedef unsigned v2u __attribute__((ext_vector_type(2)));
typedef float f32x4 __attribute__((ext_vector_type(4)));
#define LDS_WAIT() asm volatile("s_waitcnt lgkmcnt(0)" ::: "memory")
#define VM_WAIT() asm volatile("s_waitcnt vmcnt(0)" ::: "memory")
__device__ __forceinline__ unsigned f2bf(float f) { unsigned u = __builtin_bit_cast(unsigned, f); return (u + 0x7fffu + ((u >> 16) & 1u)) >> 16; }
__device__ __forceinline__ unsigned pk2(float lo, float hi) { return f2bf(lo) | (f2bf(hi) << 16); }
typedef float f32x2_t __attribute__((ext_vector_type(2))); typedef __bf16 bf16x2_t __attribute__((ext_vector_type(2)));
__device__ __forceinline__ unsigned cvtpk(float lo, float hi) { f32x2_t v = {lo, hi}; bf16x2_t b = __builtin_convertvector(v, bf16x2_t); return __builtin_bit_cast(unsigned, b); }
__device__ __forceinline__ float bflo(unsigned w) { return __builtin_bit_cast(float, w << 16); }
__device__ __forceinline__ float bfhi(unsigned w) { return __builtin_bit_cast(float, w & 0xffff0000u); }
__device__ __forceinline__ float wave_sum(float v) {
#pragma unroll
    for (int o = 1; o < 64; o <<= 1) v += __shfl_xor(v, o);
    return v;
}
__device__ __forceinline__ float log_sigmoid_f(float x) { return -log1pf(expf(-x)); }

struct Args { const float* in[24]; float* out; unsigned char* ws; int ph_lo, ph_hi; };
#define XB_TMO      128
#define XB_XCNT(j)  (256  + 64 * (j))
#define XB_XSUB(j)  (1280 + 64 * (j))
#define XB_XGEN(j)  (2304 + 64 * (j))
#define XB_TOP      3328
#define XB_TOPGEN   3392
#define XCD_BAR_WORDS 3456
#define XB_SPIN_CAP (1u << 18)

__device__ __forceinline__ unsigned xb_ld(unsigned* p)              { return __hip_atomic_load(p, __ATOMIC_RELAXED, __HIP_MEMORY_SCOPE_AGENT); }
__device__ __forceinline__ unsigned xb_add(unsigned* p, unsigned v) { return __hip_atomic_fetch_add(p, v, __ATOMIC_RELAXED, __HIP_MEMORY_SCOPE_AGENT); }
__device__ __forceinline__ unsigned xb_xcc_id() { return (unsigned)__builtin_amdgcn_s_getreg((3 << 11) | 20) & 0xFu; }
#define XB_SPIN(cond, bar) do { unsigned _sp = 0; while (cond) { __builtin_amdgcn_s_sleep(1); \
    if ((++_sp & 255u) == 0u) { if (xb_ld(&(bar)[XB_TMO])) break; if (_sp > XB_SPIN_CAP) { atomicAdd(&(bar)[XB_TMO], 1u); break; } } } } while (0)

struct XcdBarrier {
    unsigned* bar; unsigned x;
    volatile LAS unsigned* st;
};

__device__ __forceinline__ XcdBarrier xcd_barrier_post(unsigned* bar, volatile LAS unsigned* st) {
    XcdBarrier b; b.bar = bar; b.x = xb_xcc_id(); b.st = st;
    if (threadIdx.x == 0) (void)xb_add(&bar[XB_XCNT(b.x)], 1u);
    return b;
}
__device__ __forceinline__ void xcd_barrier_complete(unsigned* bar, unsigned x, unsigned& nloc, unsigned& nx) {
    const unsigned G = gridDim.x * gridDim.y * gridDim.z;
    unsigned sum, cnt, mine, sp = 0u;
    for (;;) {
        sum = 0u; cnt = 0u; mine = 0u;
#pragma unroll
        for (unsigned j = 0; j < 16; ++j) { const unsigned c = xb_ld(&bar[XB_XCNT(j)]); sum += c; cnt += (c > 0u) ? 1u : 0u; mine = (j == x) ? c : mine; }
        if (sum == G) break;
        __builtin_amdgcn_s_sleep(1);
        if ((++sp & 255u) == 0u) { if (xb_ld(&bar[XB_TMO])) break; if (sp > XB_SPIN_CAP) { atomicAdd(&bar[XB_TMO], 1u); break; } }
    }
    nloc = mine > 0u ? mine : 1u; nx = cnt > 0u ? cnt : 1u;
}

__device__ __forceinline__ void xcd_barrier(const XcdBarrier& b) {
    asm volatile("s_waitcnt vmcnt(0)" ::: "memory");
    __syncthreads();
    if (threadIdx.x == 0) {
        unsigned* bar = b.bar;
        __builtin_amdgcn_s_waitcnt(0);
        unsigned nloc = b.st[0], nx = b.st[1];
        if (nloc == 0u) { xcd_barrier_complete(bar, b.x, nloc, nx); b.st[0] = nloc; b.st[1] = nx; }
        const unsigned old = xb_add(&bar[XB_XSUB(b.x)], 1u);
        const unsigned gen = old / nloc;
        if (old + 1u == (gen + 1u) * nloc) {
            __builtin_amdgcn_fence(__ATOMIC_RELEASE, "agent");
            asm volatile("s_waitcnt vmcnt(0)" ::: "memory");
            const unsigned og = xb_add(&bar[XB_TOP], 1u);
            const unsigned tg = og / nx;
            if (og + 1u == (tg + 1u) * nx) xb_add(&bar[XB_TOPGEN], 1u);
            else XB_SPIN(xb_ld(&bar[XB_TOPGEN]) == tg, bar);
            __builtin_amdgcn_fence(__ATOMIC_ACQUIRE, "agent");
            xb_add(&bar[XB_XGEN(b.x)], 1u);
            asm volatile("s_waitcnt vmcnt(0)" ::: "memory");
        } else {
            XB_SPIN(xb_ld(&bar[XB_XGEN(b.x)]) == gen, bar);
            __builtin_amdgcn_fence(__ATOMIC_ACQUIRE, "agent");
            asm volatile("s_waitcnt vmcnt(0)" ::: "memory");
        }
    }
    __syncthreads();
}
__device__ __forceinline__ void transpose_tile(const float* Wsrc, int ldn, bf16* dst, int ldk, float scale, LAS float* scr, int lane) {
#pragma unroll 8
    for (int i = 0; i < 32; ++i) { const int kk = 2 * i + (lane >> 5); scr[kk * 33 + (lane & 31)] = Wsrc[(size_t)kk * ldn + (lane & 31)] * scale; }
    LDS_WAIT(); asm volatile("" ::: "memory");
    const int c = lane & 7;
#pragma unroll
    for (int j = 0; j < 4; ++j) { const int n = (lane >> 3) + 8 * j; const LAS float* s = scr + (8 * c) * 33 + n;
        v4u o; o.x = pk2(s[0 * 33], s[1 * 33]); o.y = pk2(s[2 * 33], s[3 * 33]); o.z = pk2(s[4 * 33], s[5 * 33]); o.w = pk2(s[6 * 33], s[7 * 33]);
        *(GAS v4u*)(dst + (size_t)n * ldk + 8 * c) = o; }
    LDS_WAIT(); asm volatile("" ::: "memory");
}

__device__ __forceinline__ void phase_p0(const Args& a, LAS unsigned char* lds, int tid, int lane, int wave) {
    const int G = gridDim.x;
    {
        LAS float* s = (LAS float*)lds; LAS float* red = (LAS float*)(lds + 36864);
        const float* c = a.in[1]; const float* cctx = a.in[3]; const float* wada = a.in[4]; const float* bada = a.in[5];
        float* mod = (float*)(a.ws + WS_MOD);
        for (int u = blockIdx.x; u < 192; u += G) {
            const int l = u / 96, j0 = (u % 96) * 64;
            for (int i = tid; i < 9 * 1024; i += NTHR) { const int r = i >> 10, k = i & 1023; const float v = r < 8 ? c[r * 1024 + k] : cctx[k]; s[i] = v / (1.0f + expf(-v)); }
            __syncthreads();
            const int jq = tid & 15, kg = tid >> 4;
            float acc[9][4];
#pragma unroll
            for (int r = 0; r < 9; ++r) { acc[r][0] = 0.f; acc[r][1] = 0.f; acc[r][2] = 0.f; acc[r][3] = 0.f; }
            const float* w = wada + (size_t)l * 1024 * 6144 + j0 + jq * 4;
            for (int k = kg; k < 1024; k += 32) { const f32x4 wv = *(const f32x4*)(w + (size_t)k * 6144);
#pragma unroll
                for (int r = 0; r < 9; ++r) { const float sr = s[r * 1024 + k]; acc[r][0] += sr * wv.x; acc[r][1] += sr * wv.y; acc[r][2] += sr * wv.z; acc[r][3] += sr * wv.w; } }
#pragma unroll
            for (int r = 0; r < 9; ++r)
#pragma unroll
                for (int i = 0; i < 4; ++i) red[(kg * 9 + r) * 64 + jq * 4 + i] = acc[r][i];
            __syncthreads();
            for (int o = tid; o < 576; o += NTHR) { const int r = o >> 6, j = o & 63; float sum = 0.f;
                for (int g2 = 0; g2 < 32; ++g2) sum += red[(g2 * 9 + r) * 64 + j];
                mod[(l * 9 + r) * 6144 + j0 + j] = sum + bada[l * 6144 + j0 + j]; }
            __syncthreads();
        }
    }
    {
        LAS float* scr = (LAS float*)(lds + wave * 16384);
        const int gw = blockIdx.x * NWAVES + wave, NGW = G * NWAVES;
        const float* w_in = a.in[6]; const float* w_out = a.in[12]; const float* w_gate = a.in[19]; const float* w_up = a.in[20]; const float* w_down = a.in[21];
        bf16* WIN = (bf16*)(a.ws + WS_WIN); bf16* WOUT = (bf16*)(a.ws + WS_WOUT); bf16* WGU = (bf16*)(a.ws + WS_WGU); bf16* WD = (bf16*)(a.ws + WS_WD);
        constexpr int I_IN = 2 * 16 * 104, I_OUT = 2 * 16 * 32, I_GU = 2 * 2 * 32 * 256, I_D = 2 * 32 * 256, NITEMS = I_IN + I_OUT + I_GU + I_D;
        for (int it = gw; it < NITEMS; it += NGW) {
            int r = it;
            if (r < I_IN) { const int l = r / 1664, q = r % 1664, k0 = 64 * (q / 104), n0 = 32 * (q % 104);
                const float sc = (n0 >= OFF_K && n0 < OFF_V) ? 0.125f : 1.0f;
                transpose_tile(w_in + ((size_t)l * 1024 + k0) * INC + n0, INC, WIN + ((size_t)l * INC + n0) * 1024 + k0, 1024, sc, scr, lane); continue; }
            r -= I_IN;
            if (r < I_OUT) { const int l = r / 512, q = r % 512, k0 = 64 * (q / 32), n0 = 32 * (q % 32);
                transpose_tile(w_out + ((size_t)l * 1024 + k0) * 1024 + n0, 1024, WOUT + ((size_t)l * 1024 + n0) * 1024 + k0, 1024, 1.0f, scr, lane); continue; }
            r -= I_OUT;
            if (r < I_GU) { const int isup = r >= (I_GU / 2) ? 1 : 0; r -= isup * (I_GU / 2);
                const int le = r / 256, q = r % 256, k0 = 64 * (q / 16), n0 = 32 * (q % 16);
                const float* src = (isup ? w_up : w_gate) + ((size_t)le * 1024 + k0) * 512 + n0;
                const int drow = (n0 >> 7) * 256 + (n0 & 127) + isup * 128;
                transpose_tile(src, 512, WGU + ((size_t)le * 1024 + drow) * 1024 + k0, 1024, 1.0f, scr, lane); continue; }
            r -= I_GU;
            { const int le = r / 256, q = r % 256, k0 = 64 * (q / 32), n0 = 32 * (q % 32);
                transpose_tile(w_down + ((size_t)le * 512 + k0) * 1024 + n0, 1024, WD + ((size_t)le * 1024 + n0) * 512 + k0, 512, 1.0f, scr, lane); }
        }
    }
    {
        bf16* WR = (bf16*)(a.ws + WS_WR);
        for (int i = blockIdx.x * NTHR + tid; i < 2 * 64 * 1024; i += G * NTHR) { const int l = i >> 16, j = (i >> 10) & 63, k = i & 1023;
            float v = 0.f;
            if (j < 4) v = a.in[15][((size_t)l * 1024 + k) * 4 + j]; else if (j < 36) v = a.in[17][(((size_t)l * 4 + ((j - 4) >> 3)) * 1024 + k) * 8 + ((j - 4) & 7)];
            const unsigned hi = f2bf(v); const float r = v - __builtin_bit_cast(float, hi << 16);
            WR[((size_t)(l * 2) * 64 + j) * 1024 + k] = (bf16)hi; WR[((size_t)(l * 2 + 1) * 64 + j) * 1024 + k] = (bf16)f2bf(r); }
    }
    __syncthreads();
}

__device__ __forceinline__ void phase_p1(const Args& a, int lane, int wave) {
    const int gw = blockIdx.x * NWAVES + wave, NGW = gridDim.x * NWAVES;
    const float* mod = (const float*)(a.ws + WS_MOD); bf16* Hb = (bf16*)(a.ws + WS_HB);
    for (int row = gw; row < NROWS; row += NGW) {
        const float* src = row < NLAT ? a.in[0] + (size_t)row * 1024 : a.in[2] + (size_t)(row - NLAT) * 1024;
        const float* m0 = mod + (row < NLAT ? (row >> 12) : 8) * 6144;
#pragma unroll
        for (int j = 0; j < 4; ++j) { const int idx = (lane + 64 * j) * 4;
            const f32x4 v = *(const f32x4*)(src + idx), sh = *(const f32x4*)(m0 + idx), sc = *(const f32x4*)(m0 + 1024 + idx);
            const f32x4 o = v * (sc + 1.0f) + sh; v2u w; w.x = pk2(o.x, o.y); w.y = pk2(o.z, o.w);
            *(v2u*)(Hb + (size_t)row * 1024 + idx) = w; }
    }
}

__device__ __forceinline__ int chunk_row0(int b, int c) { return c < 2 ? NLAT + b * 256 + c * 128 : b * 4096 + (c - 2) * 128; }
__device__ __forceinline__ size_t st_off(int b, int c, int h, int dir) { return ((((size_t)b * NCH + c) * 8 + h) * 2 + dir) * 4096; }

__device__ __forceinline__ void phase_b(const Args& a, int l, LAS unsigned char* lds, int tid) {
    const bf16* P = (const bf16*)(a.ws + WS_P); float* ST = (float*)(a.ws + WS_ST);
    LAS float* Ks = (LAS float*)lds; LAS float* Vs = (LAS float*)(lds + 32768); LAS float* pf = (LAS float*)(lds + 65536); LAS float* pb = pf + 128;
    for (int u = blockIdx.x; u < 8 * NCH * 8; u += gridDim.x) {
        const int b = u / (NCH * 8), c = (u % (NCH * 8)) / 8, h = u % 8; const int row0 = chunk_row0(b, c);
        __syncthreads();
        if (tid < 128) { const float lgf = log_sigmoid_f(a.in[8][l * 8 + h]), lgb = log_sigmoid_f(a.in[9][l * 8 + h]);
            pf[tid] = expf(lgf * (float)(127 - tid)); pb[tid] = expf(lgb * (float)tid); }
        { const int j = tid >> 2, part = tid & 3; const bf16* kp = P + (size_t)(row0 + j) * INC + OFF_K + h * 64 + part * 16; const bf16* vp = kp + (OFF_V - OFF_K);
#pragma unroll
          for (int q = 0; q < 2; ++q) { const v4u kw = *(const v4u*)(kp + 8 * q), vw = *(const v4u*)(vp + 8 * q);
              LAS float* kd = Ks + j * 64 + part * 16 + 8 * q; LAS float* vd = Vs + j * 64 + part * 16 + 8 * q;
              kd[0] = bflo(kw.x); kd[1] = bfhi(kw.x); kd[2] = bflo(kw.y); kd[3] = bfhi(kw.y); kd[4] = bflo(kw.z); kd[5] = bfhi(kw.z); kd[6] = bflo(kw.w); kd[7] = bfhi(kw.w);
              vd[0] = bflo(vw.x); vd[1] = bfhi(vw.x); vd[2] = bflo(vw.y); vd[3] = bfhi(vw.y); vd[4] = bflo(vw.z); vd[5] = bfhi(vw.z); vd[6] = bflo(vw.w); vd[7] = bfhi(vw.w); } }
        __syncthreads();
        const int d = tid >> 3, e0 = (tid & 7) * 8;
        float af[8], ab[8];
#pragma unroll
        for (int i = 0; i < 8; ++i) { af[i] = 0.f; ab[i] = 0.f; }
        for (int j = 0; j < 128; ++j) { const float kd = Ks[j * 64 + d], kf = kd * pf[j], kb = kd * pb[j];
            const f32x4 v0 = *(const LAS f32x4*)(Vs + j * 64 + e0), v1 = *(const LAS f32x4*)(Vs + j * 64 + e0 + 4);
            af[0] += kf * v0.x; af[1] += kf * v0.y; af[2] += kf * v0.z; af[3] += kf * v0.w; af[4] += kf * v1.x; af[5] += kf * v1.y; af[6] += kf * v1.z; af[7] += kf * v1.w;
            ab[0] += kb * v0.x; ab[1] += kb * v0.y; ab[2] += kb * v0.z; ab[3] += kb * v0.w; ab[4] += kb * v1.x; ab[5] += kb * v1.y; ab[6] += kb * v1.z; ab[7] += kb * v1.w; }
        float* o0 = ST + st_off(b, c, h, 0) + d * 64 + e0; float* o1 = ST + st_off(b, c, h, 1) + d * 64 + e0;
        *(f32x4*)o0 = (f32x4){af[0], af[1], af[2], af[3]}; *(f32x4*)(o0 + 4) = (f32x4){af[4], af[5], af[6], af[7]};
        *(f32x4*)o1 = (f32x4){ab[0], ab[1], ab[2], ab[3]}; *(f32x4*)(o1 + 4) = (f32x4){ab[4], ab[5], ab[6], ab[7]};
    }
    __syncthreads();
}

__device__ __forceinline__ void phase_c(const Args& a, int l, int tid) {
    bf16* ST = (bf16*)(a.ws + WS_ST);
    for (int it = blockIdx.x * NTHR + tid; it < 8 * 8 * 2 * 1024; it += gridDim.x * NTHR) {
        const int q = it & 1023, dir = (it >> 10) & 1, h = (it >> 11) & 7, b = it >> 14;
        const float lg = log_sigmoid_f(dir ? a.in[9][l * 8 + h] : a.in[8][l * 8 + h]); const float dec = expf(128.0f * lg);
        v2u kv[NCH];
#pragma unroll
        for (int s = 0; s < NCH; ++s) { const int c = dir ? (s < 2 ? 1 - s : 35 - s) : s; kv[s] = *(const v2u*)(ST + st_off(b, c, h, dir) + q * 4); }
        f32x4 st = (f32x4){0.f, 0.f, 0.f, 0.f};
#pragma unroll
        for (int s = 0; s < NCH; ++s) { const int c = dir ? (s < 2 ? 1 - s : 35 - s) : s;
            v2u w; w.x = cvtpk(st.x, st.y); w.y = cvtpk(st.z, st.w); *(v2u*)(ST + st_off(b, c, h, dir) + q * 4) = w;
            st = st * dec + (f32x4){bflo(kv[s].x), bfhi(kv[s].x), bflo(kv[s].y), bfhi(kv[s].y)}; }
    }
}
__device__ __forceinline__ void unpack8(const v4u w, float* f) { f[0] = bflo(w.x); f[1] = bfhi(w.x); f[2] = bflo(w.y); f[3] = bfhi(w.y); f[4] = bflo(w.z); f[5] = bfhi(w.z); f[6] = bflo(w.w); f[7] = bfhi(w.w); }
__device__ __forceinline__ v4u pack8(const float* f) { v4u w; w.x = pk2(f[0], f[1]); w.y = pk2(f[2], f[3]); w.z = pk2(f[4], f[5]); w.w = pk2(f[6], f[7]); return w; }

__device__ __forceinline__ void phase_d(const Args& a, int l, LAS unsigned char* lds, int tid, int lane) {
    const bf16* P = (const bf16*)(a.ws + WS_P); const float* ST = (const float*)(a.ws + WS_ST); bf16* Y = (bf16*)(a.ws + WS_YMIX);
    const float* convw = a.in[7] + l * 3 * 256; const float* sguw = a.in[10] + (size_t)l * 4 * 128 * 128; const float* sgub = a.in[11] + l * 4 * 128;
    const int c_lo = l == 1 ? 2 : 0, cpb = NCH - c_lo, nunits = 8 * cpb;
    LAS float* Sf = (LAS float*)lds; LAS float* Sb = (LAS float*)(lds + 16384); LAS float* Ks = (LAS float*)(lds + 32768); LAS float* Vs = (LAS float*)(lds + 65536);
    LAS float* VN = (LAS float*)lds;
    for (int u = blockIdx.x; u < nunits; u += gridDim.x) {
        const int b = u / cpb, c = c_lo + u % cpb; const int row0 = chunk_row0(b, c); const bool isc = c < 2;
#ifndef NO_D1
        for (int idx = tid; idx < 128 * 32; idx += NTHR) {
            const int p = idx >> 5, ch0 = (idx & 31) * 8; const int row = row0 + p;
            int dprev = -1, dnext = 1; bool vprev, vnext;
            if (isc) { const int t = c * 128 + p; vprev = t > 0; vnext = t < 255; }
            else { const int t = (c - 2) * 128 + p;
                if (ch0 < 128) { const int col = t & 63; vprev = col > 0; vnext = col < 63; }
                else { const int rg = t >> 6; vprev = rg > 0; vnext = rg < 63; dprev = -64; dnext = 64; } }
            const bf16* pr = P + (size_t)row * INC;
            float cb[8], zc[8], zp[8], zn[8], t0[8], t1[8];
            unpack8(*(const v4u*)(pr + OFF_CB + ch0), cb);
            unpack8(*(const v4u*)(pr + OFF_CC + ch0), t0); unpack8(*(const v4u*)(pr + OFF_CX + ch0), t1);
#pragma unroll
            for (int i = 0; i < 8; ++i) { zc[i] = t0[i] * t1[i]; zp[i] = 0.f; zn[i] = 0.f; }
            if (vprev) { const bf16* q = pr + (ptrdiff_t)dprev * INC; unpack8(*(const v4u*)(q + OFF_CC + ch0), t0); unpack8(*(const v4u*)(q + OFF_CX + ch0), t1);
#pragma unroll
                for (int i = 0; i < 8; ++i) zp[i] = t0[i] * t1[i]; }
            if (vnext) { const bf16* q = pr + (ptrdiff_t)dnext * INC; unpack8(*(const v4u*)(q + OFF_CC + ch0), t0); unpack8(*(const v4u*)(q + OFF_CX + ch0), t1);
#pragma unroll
                for (int i = 0; i < 8; ++i) zn[i] = t0[i] * t1[i]; }
            float o[8];
#pragma unroll
            for (int i = 0; i < 8; ++i) o[i] = cb[i] * (convw[ch0 + i] * zp[i] + convw[256 + ch0 + i] * zc[i] + convw[512 + ch0 + i] * zn[i]);
            *(v4u*)(Y + (size_t)row * 1024 + ch0) = pack8(o);
        }
#endif
        const int i = tid >> 2, part = tid & 3;
#ifndef NO_D2
#pragma unroll 1
        for (int h = 0; h < 8; ++h) {
            __syncthreads();
            { const bf16* kp = P + (size_t)(row0 + i) * INC + OFF_K + h * 64 + part * 16; const bf16* vp = kp + (OFF_V - OFF_K);
#pragma unroll
              for (int q = 0; q < 2; ++q) { float kf[8], vf[8]; unpack8(*(const v4u*)(kp + 8 * q), kf); unpack8(*(const v4u*)(vp + 8 * q), vf);
                  LAS float* kd = Ks + i * 64 + part * 16 + 8 * q; LAS float* vd = Vs + i * 64 + part * 16 + 8 * q;
#pragma unroll
                  for (int e = 0; e < 8; ++e) { kd[e] = kf[e]; vd[e] = vf[e]; } }
              const float* sf = ST + st_off(b, c, h, 0); const float* sb = ST + st_off(b, c, h, 1);
#pragma unroll
              for (int q = 0; q < 2; ++q) { const int o4 = (tid + NTHR * q) * 4; *(LAS f32x4*)(Sf + o4) = *(const f32x4*)(sf + o4); *(LAS f32x4*)(Sb + o4) = *(const f32x4*)(sb + o4); } }
            float qv[16];
            { const bf16* qp = P + (size_t)(row0 + i) * INC + OFF_Q + h * 64 + part * 16; unpack8(*(const v4u*)qp, qv); unpack8(*(const v4u*)(qp + 8), qv + 8); }
            const float lgf = log_sigmoid_f(a.in[8][l * 8 + h]), lgb = log_sigmoid_f(a.in[9][l * 8 + h]);
            __syncthreads();
            float o[16];
#pragma unroll
            for (int e = 0; e < 16; ++e) o[e] = 0.f;
#pragma unroll 1
            for (int j = 0; j < 128; ++j) {
                const LAS f32x4* kr = (const LAS f32x4*)(Ks + j * 64 + part * 16);
                float s = 0.f;
#pragma unroll
                for (int q = 0; q < 4; ++q) { const f32x4 k4 = kr[q]; s += qv[4 * q] * k4.x + qv[4 * q + 1] * k4.y + qv[4 * q + 2] * k4.z + qv[4 * q + 3] * k4.w; }
                s += __shfl_xor(s, 1); s += __shfl_xor(s, 2);
                const int rel = i - j;
                const float dec = rel > 0 ? expf(lgf * (float)rel) : (rel < 0 ? expf(lgb * (float)(-rel)) : 2.0f);
                s *= dec;
                const LAS f32x4* vr = (const LAS f32x4*)(Vs + j * 64 + part * 16);
#pragma unroll
                for (int q = 0; q < 4; ++q) { const f32x4 v4 = vr[q]; o[4 * q] += s * v4.x; o[4 * q + 1] += s * v4.y; o[4 * q + 2] += s * v4.z; o[4 * q + 3] += s * v4.w; }
            }
            float of[16], ob[16];
#pragma unroll
            for (int e = 0; e < 16; ++e) { of[e] = 0.f; ob[e] = 0.f; }
            __syncthreads();
#pragma unroll
            for (int dd = 0; dd < 16; ++dd) Ks[i * 64 + ((part * 16 + dd + i) & 63)] = qv[dd];
            __syncthreads();
#pragma unroll 2
            for (int d = 0; d < 64; ++d) { const float qd = Ks[i * 64 + ((d + i) & 63)];
                const LAS f32x4* fr = (const LAS f32x4*)(Sf + d * 64 + part * 16); const LAS f32x4* br = (const LAS f32x4*)(Sb + d * 64 + part * 16);
#pragma unroll
                for (int q = 0; q < 4; ++q) { const f32x4 f4 = fr[q], b4 = br[q];
                    of[4 * q] += qd * f4.x; of[4 * q + 1] += qd * f4.y; of[4 * q + 2] += qd * f4.z; of[4 * q + 3] += qd * f4.w;
                    ob[4 * q] += qd * b4.x; ob[4 * q + 1] += qd * b4.y; ob[4 * q + 2] += qd * b4.z; ob[4 * q + 3] += qd * b4.w; } }
            const float df = expf(lgf * (float)(i + 1)), db = expf(lgb * (float)(128 - i));
            float sum = 0.f;
#pragma unroll
            for (int e = 0; e < 16; ++e) { o[e] += df * of[e] + db * ob[e]; sum += o[e]; }
            sum += __shfl_xor(sum, 1); sum += __shfl_xor(sum, 2);
            const float mu = sum * (1.0f / 64.0f); float vs = 0.f;
#pragma unroll
            for (int e = 0; e < 16; ++e) { o[e] -= mu; vs += o[e] * o[e]; }
            vs += __shfl_xor(vs, 1); vs += __shfl_xor(vs, 2);
            const float rs = 1.0f / sqrtf(vs * (1.0f / 64.0f) + LN_EPS);
            float gv[16];
            { const bf16* gp = P + (size_t)(row0 + i) * INC + OFF_G + h * 64 + part * 16; unpack8(*(const v4u*)gp, gv); unpack8(*(const v4u*)(gp + 8), gv + 8); }
#pragma unroll
            for (int e = 0; e < 16; ++e) o[e] = (gv[e] / (1.0f + expf(-gv[e]))) * (o[e] * rs);
            bf16* yp = Y + (size_t)(row0 + i) * 1024 + 256 + h * 64 + part * 16;
            *(v4u*)yp = pack8(o); *(v4u*)(yp + 8) = pack8(o + 8);
        }
#endif
#ifndef NO_D3
        __syncthreads();
        {
            const bf16* vp = P + (size_t)(row0 + i) * INC + OFF_VV + part * 64;
            float sum = 0.f;
#pragma unroll 2
            for (int q = 0; q < 8; ++q) { float t8[8]; unpack8(*(const v4u*)(vp + 8 * q), t8);
#pragma unroll
                for (int e = 0; e < 8; ++e) sum += t8[e]; }
            sum += __shfl_xor(sum, 1); sum += __shfl_xor(sum, 2);
            const float mu = sum * (1.0f / 256.0f); float vs = 0.f;
#pragma unroll 2
            for (int q = 0; q < 8; ++q) { float t8[8]; unpack8(*(const v4u*)(vp + 8 * q), t8);
#pragma unroll
                for (int e = 0; e < 8; ++e) { const float dlt = t8[e] - mu; vs += dlt * dlt; } }
            vs += __shfl_xor(vs, 1); vs += __shfl_xor(vs, 2);
            const float rs = 1.0f / sqrtf(vs * (1.0f / 256.0f) + LN_EPS);
            LAS float* dst = VN + (part * 128 + i) * 64;
#pragma unroll 2
            for (int q = 0; q < 8; ++q) { float t8[8]; unpack8(*(const v4u*)(vp + 8 * q), t8);
                *(LAS f32x4*)(dst + 8 * q) = (f32x4){(t8[0] - mu) * rs, (t8[1] - mu) * rs, (t8[2] - mu) * rs, (t8[3] - mu) * rs};
                *(LAS f32x4*)(dst + 8 * q + 4) = (f32x4){(t8[4] - mu) * rs, (t8[5] - mu) * rs, (t8[6] - mu) * rs, (t8[7] - mu) * rs}; }
        }
        __syncthreads();
        for (int g = 0; g < 4; ++g) {
            float acc[16];
#pragma unroll
            for (int e = 0; e < 16; ++e) acc[e] = 0.f;
            const float* wrow = sguw + ((size_t)g * 128 + i) * 128;
            for (int q = 0; q < 128; q += 4) { const f32x4 w4 = *(const f32x4*)(wrow + q);
#pragma unroll
                for (int qq = 0; qq < 4; ++qq) { const float w = w4[qq]; const LAS f32x4* vr = (const LAS f32x4*)(VN + (g * 128 + q + qq) * 64 + part * 16);
#pragma unroll
                    for (int t = 0; t < 4; ++t) { const f32x4 v4 = vr[t]; acc[4 * t] += w * v4.x; acc[4 * t + 1] += w * v4.y; acc[4 * t + 2] += w * v4.z; acc[4 * t + 3] += w * v4.w; } } }
            const float bias = sgub[g * 128 + i];
            float uv[16];
            { const bf16* up = P + (size_t)(row0 + i) * INC + OFF_U + g * 64 + part * 16; unpack8(*(const v4u*)up, uv); unpack8(*(const v4u*)(up + 8), uv + 8); }
#pragma unroll
            for (int e = 0; e < 16; ++e) acc[e] = uv[e] * (acc[e] + bias);
            bf16* yp = Y + (size_t)(row0 + i) * 1024 + 768 + g * 64 + part * 16;
            *(v4u*)yp = pack8(acc); *(v4u*)(yp + 8) = pack8(acc + 8);
        }
#endif
        __syncthreads();
    }
}

__device__ __forceinline__ void phase_f(const Args& a, int l, LAS unsigned char* lds, int tid, int lane, int wave, bool dry = false) {
    LAS int* lcnt = (LAS int*)lds;
    __syncthreads();
    if (tid < 32) lcnt[tid] = 0;
    __syncthreads();
    const int gw = blockIdx.x * NWAVES + wave, NGW = gridDim.x * NWAVES, nrows = l == 0 ? NROWS : NLAT;
    const float* mod = (const float*)(a.ws + WS_MOD) + l * 9 * 6144;
    const float* lng = a.in[13] + l * 1024; const float* lnb = a.in[14] + l * 1024;
    const float* rgw = a.in[15] + l * 1024 * 4; const float* rgb = a.in[16] + l * 4; const float* rew = a.in[17] + (size_t)l * 4 * 1024 * 8; const float* reb = a.in[18] + l * 32;
    bf16* Hb = (bf16*)(a.ws + (dry ? WS_P + 160 * MiB : WS_HB)); unsigned* tok = (unsigned*)(a.ws + (dry ? WS_P + 240 * MiB : WS_TOK)); float* xctx = (float*)(a.ws + WS_XCTX);
    for (int row = gw; row < nrows; row += NGW) {
        float* xr = row < NLAT ? a.out + (size_t)row * 1024 : xctx + (size_t)(row - NLAT) * 1024;
        float* xw = dry ? (float*)(a.ws + WS_P) + (size_t)row * 1024 : xr;
        const float* m0 = mod + (row < NLAT ? (row >> 12) : 8) * 6144;
        f32x4 v[4]; float s = 0.f;
#pragma unroll
        for (int j = 0; j < 4; ++j) { v[j] = *(const f32x4*)(xr + (lane + 64 * j) * 4); s += (v[j].x + v[j].y) + (v[j].z + v[j].w); }
        const float mean = wave_sum(s) * (1.0f / 1024.0f); float s2 = 0.f;
#pragma unroll
        for (int j = 0; j < 4; ++j) { v[j] = v[j] - mean; s2 += (v[j].x * v[j].x + v[j].y * v[j].y) + (v[j].z * v[j].z + v[j].w * v[j].w); }
        const float rstd = 1.0f / sqrtf(wave_sum(s2) * (1.0f / 1024.0f) + LN_EPS);
        float lg[4] = {0.f, 0.f, 0.f, 0.f};
#pragma unroll
        for (int j = 0; j < 4; ++j) { const int idx = (lane + 64 * j) * 4;
            const f32x4 x1 = v[j] * rstd * *(const f32x4*)(lng + idx) + *(const f32x4*)(lnb + idx);
            *(f32x4*)(xw + idx) = x1;
            const f32x4 hm = x1 * (*(const f32x4*)(m0 + 4096 + idx) + 1.0f) + *(const f32x4*)(m0 + 3072 + idx);
            v[j] = hm;
            v2u w; w.x = pk2(hm.x, hm.y); w.y = pk2(hm.z, hm.w); *(v2u*)(Hb + (size_t)row * 1024 + idx) = w;
#pragma unroll
            for (int t = 0; t < 4; ++t) { const f32x4 w4 = *(const f32x4*)(rgw + (idx + t) * 4); const float hv = hm[t];
                lg[0] += hv * w4.x; lg[1] += hv * w4.y; lg[2] += hv * w4.z; lg[3] += hv * w4.w; } }
#pragma unroll
        for (int g = 0; g < 4; ++g) lg[g] = wave_sum(lg[g]) + rgb[g];
        int gi = 0; float gm = lg[0];
#pragma unroll
        for (int g = 1; g < 4; ++g) if (lg[g] > gm) { gm = lg[g]; gi = g; }
        float gden = 0.f;
#pragma unroll
        for (int g = 0; g < 4; ++g) gden += expf(lg[g] - gm);
        const float gprob = 1.0f / gden;
        float le[8] = {0.f, 0.f, 0.f, 0.f, 0.f, 0.f, 0.f, 0.f};
        const float* rw = rew + (size_t)gi * 1024 * 8;
#pragma unroll
        for (int j = 0; j < 4; ++j) { const int idx = (lane + 64 * j) * 4;
#pragma unroll
            for (int t = 0; t < 4; ++t) { const f32x4 w0 = *(const f32x4*)(rw + (idx + t) * 8), w1 = *(const f32x4*)(rw + (idx + t) * 8 + 4); const float hv = v[j][t];
                le[0] += hv * w0.x; le[1] += hv * w0.y; le[2] += hv * w0.z; le[3] += hv * w0.w; le[4] += hv * w1.x; le[5] += hv * w1.y; le[6] += hv * w1.z; le[7] += hv * w1.w; } }
#pragma unroll
        for (int e = 0; e < 8; ++e) le[e] = wave_sum(le[e]) + reb[gi * 8 + e];
        int i1 = 0; float m1 = le[0];
#pragma unroll
        for (int e = 1; e < 8; ++e) if (le[e] > m1) { m1 = le[e]; i1 = e; }
        int i2 = -1; float m2 = -3.0e38f;
#pragma unroll
        for (int e = 0; e < 8; ++e) if (e != i1 && le[e] > m2) { m2 = le[e]; i2 = e; }
        const float p2 = expf(m2 - m1), inv = 1.0f / (1.0f + p2);
        const float gate0 = gprob * inv, gate1 = gprob * p2 * inv;
        if (lane == 0) { const int e0 = gi * 8 + i1, e1 = gi * 8 + i2;
            const int p0 = __hip_atomic_fetch_add(lcnt + e0, 1, __ATOMIC_RELAXED, __HIP_MEMORY_SCOPE_WORKGROUP);
            const int p1 = __hip_atomic_fetch_add(lcnt + e1, 1, __ATOMIC_RELAXED, __HIP_MEMORY_SCOPE_WORKGROUP);
            unsigned* t = tok + (size_t)row * 8; t[0] = (unsigned)e0 | ((unsigned)e1 << 8); t[1] = (unsigned)p0; t[2] = (unsigned)p1;
            t[4] = __builtin_bit_cast(unsigned, gate0); t[5] = __builtin_bit_cast(unsigned, gate1); }
    }
    __syncthreads();
    if (tid < 32 && !dry) ((unsigned*)(a.ws + WS_CTL))[CW_WGCNT + (l * 256 + blockIdx.x) * 32 + tid] = (unsigned)lcnt[tid];
    __syncthreads();
}

__device__ __forceinline__ void phase_g(const Args& a, int l, LAS unsigned char* lds, int tid, int lane, int wave) {
    LAS int* cn = (LAS int*)lds; LAS int* base = (LAS int*)(lds + 32768); LAS int* pst = base + 32; LAS int* totl = base + 80;
    unsigned* ctl = (unsigned*)(a.ws + WS_CTL);
    __syncthreads();
    for (int i = tid; i < 256 * 32; i += NTHR) cn[i] = (int)ctl[CW_WGCNT + l * 256 * 32 + i];
    __syncthreads();
    if (tid < 32) { int tot = 0, bs = 0; for (int w = 0; w < 256; ++w) { const int v = cn[w * 32 + tid]; if (w < (int)blockIdx.x) bs += v; tot += v; } base[tid] = bs; totl[tid] = tot; }
    __syncthreads();
    if (tid == 0) { int run = 0; for (int e = 0; e < 32; ++e) { pst[e] = run; run += ((totl[e] + 255) >> 8) << 8; } pst[32] = run; }
    __syncthreads();
    if (blockIdx.x == 0 && tid < 32) ctl[CW_TOT + l * 64 + tid] = (unsigned)totl[tid];
    const int gw = blockIdx.x * NWAVES + wave, NGW = gridDim.x * NWAVES, nrows = l == 0 ? NROWS : NLAT;
    const bf16* Hb = (const bf16*)(a.ws + WS_HB); bf16* XB = (bf16*)(a.ws + WS_XB); unsigned* tok = (unsigned*)(a.ws + WS_TOK);
    (void)gw; (void)NGW;
    for (int T = blockIdx.x; T < (nrows >> 5); T += gridDim.x)
    for (int rr = 0; rr < 4; ++rr) { const int row = 32 * T + 4 * wave + rr;
        unsigned* t = tok + (size_t)row * 8; const unsigned ee = t[0]; const int e0 = ee & 255, e1 = (ee >> 8) & 255;
        const int s0 = pst[e0] + base[e0] + (int)t[1], s1 = pst[e1] + base[e1] + (int)t[2];
        if (lane == 0) { t[6] = (unsigned)s0; t[7] = (unsigned)s1; }
        const v4u a0 = *(const v4u*)(Hb + (size_t)row * 1024 + lane * 8), a1 = *(const v4u*)(Hb + (size_t)row * 1024 + 512 + lane * 8);
        *(v4u*)(XB + (size_t)s0 * 1024 + lane * 8) = a0; *(v4u*)(XB + (size_t)s0 * 1024 + 512 + lane * 8) = a1;
        *(v4u*)(XB + (size_t)s1 * 1024 + lane * 8) = a0; *(v4u*)(XB + (size_t)s1 * 1024 + 512 + lane * 8) = a1;
    }
    __syncthreads();
}

__device__ __forceinline__ int build_p2e(const Args& a, int l, LAS unsigned char* lds, int tid) {
    LAS unsigned char* p2e = lds + P2E_OFF; LAS int* np = (LAS int*)(lds + PST_OFF);
    const unsigned* ctl = (const unsigned*)(a.ws + WS_CTL);
    __syncthreads();
    if (tid == 0) { int pm = 0; for (int e = 0; e < 32; ++e) { const int n = ((int)ctl[CW_TOT + l * 64 + e] + 255) >> 8; for (int k = 0; k < n && pm < MAXPANELS; ++k) p2e[pm++] = (unsigned char)e; } np[0] = pm; }
    __syncthreads();
    return np[0];
}

struct JRow { f32x4 x[4]; v2u y0[4], y1[4]; float g0, g1; };
__device__ __forceinline__ void j_issue(JRow& R, const float* xr, const bf16* Y, const v4u tk, int lane) {
    const unsigned gx = tk.x, gy = tk.y;
    R.g0 = __builtin_bit_cast(float, gx); R.g1 = __builtin_bit_cast(float, gy);
    const bf16* y0 = Y + (size_t)tk.z * 1024; const bf16* y1 = Y + (size_t)tk.w * 1024;
#pragma unroll
    for (int j = 0; j < 4; ++j) { const int idx = (lane + 64 * j) * 4; R.x[j] = *(const f32x4*)(xr + idx); R.y0[j] = *(const v2u*)(y0 + idx); R.y1[j] = *(const v2u*)(y1 + idx); }
}
__device__ __forceinline__ void j_finish(const JRow& R, float* xw, bf16* hrow, const float* m0, const float* m1, const float* lng, const float* lnb, int lane) {
    f32x4 v[4]; float s = 0.f;
#pragma unroll
    for (int j = 0; j < 4; ++j) { const int idx = (lane + 64 * j) * 4; const v2u w0 = R.y0[j], w1 = R.y1[j];
        const f32x4 ya = (f32x4){bflo(w0.x), bfhi(w0.x), bflo(w0.y), bfhi(w0.y)}, yb = (f32x4){bflo(w1.x), bfhi(w1.x), bflo(w1.y), bfhi(w1.y)};
        v[j] = R.x[j] * ALPHA + *(const f32x4*)(m0 + 5120 + idx) * (ya * R.g0 + yb * R.g1);
        s += (v[j].x + v[j].y) + (v[j].z + v[j].w); }
    const float mean = wave_sum(s) * (1.0f / 1024.0f); float s2 = 0.f;
#pragma unroll
    for (int j = 0; j < 4; ++j) { v[j] = v[j] - mean; s2 += (v[j].x * v[j].x + v[j].y * v[j].y) + (v[j].z * v[j].z + v[j].w * v[j].w); }
    const float rstd = 1.0f / sqrtf(wave_sum(s2) * (1.0f / 1024.0f) + LN_EPS);
#pragma unroll
    for (int j = 0; j < 4; ++j) { const int idx = (lane + 64 * j) * 4;
        const f32x4 x2 = v[j] * rstd * *(const f32x4*)(lng + idx) + *(const f32x4*)(lnb + idx);
        *(f32x4*)(xw + idx) = x2;
        if (hrow) { const f32x4 hh = x2 * (*(const f32x4*)(m1 + 1024 + idx) + 1.0f) + *(const f32x4*)(m1 + idx);
            v2u w; w.x = cvtpk(hh.x, hh.y); w.y = cvtpk(hh.z, hh.w); *(v2u*)(hrow + idx) = w; } }
}
__device__ __forceinline__ void phase_j(const Args& a, int l, int lane, int wave, bool dry = false) {
    const int gw = blockIdx.x * NWAVES + wave, NGW = gridDim.x * NWAVES, nrows = l == 0 ? NROWS : NLAT;
    const float* mod = (const float*)(a.ws + WS_MOD) + l * 9 * 6144; const float* modn = (const float*)(a.ws + WS_MOD) + 9 * 6144;
    const float* lng = a.in[22] + l * 1024; const float* lnb = a.in[23] + l * 1024;
    bf16* Hb = (bf16*)(a.ws + WS_HB); const bf16* Y = (const bf16*)(a.ws + WS_Y); const unsigned* tok = (const unsigned*)(a.ws + WS_TOK); float* xctx = (float*)(a.ws + WS_XCTX);
    for (int rowA = gw; rowA < nrows; rowA += 2 * NGW) {
        const int rowB = rowA + NGW; const bool hasB = rowB < nrows;
        const v4u tA = *(const v4u*)(tok + (size_t)rowA * 8 + 4); const v4u tB = hasB ? *(const v4u*)(tok + (size_t)rowB * 8 + 4) : tA;
        float* xrA = rowA < NLAT ? a.out + (size_t)rowA * 1024 : xctx + (size_t)(rowA - NLAT) * 1024;
        const int rB = hasB ? rowB : rowA;
        float* xrB = rB < NLAT ? a.out + (size_t)rB * 1024 : xctx + (size_t)(rB - NLAT) * 1024;
        JRow RA, RB;
        j_issue(RA, xrA, Y, tA, lane); j_issue(RB, xrB, Y, tB, lane);
        const int mA = rowA < NLAT ? (rowA >> 12) : 8, mB = rB < NLAT ? (rB >> 12) : 8;
        j_finish(RA, dry ? (float*)(a.ws + WS_HH) + (size_t)rowA * 1024 : xrA, (l == 0 && !dry) ? Hb + (size_t)rowA * 1024 : nullptr, mod + mA * 6144, modn + mA * 6144, lng, lnb, lane);
        if (hasB) j_finish(RB, dry ? (float*)(a.ws + WS_HH) + (size_t)rowB * 1024 : xrB, (l == 0 && !dry) ? Hb + (size_t)rowB * 1024 : nullptr, mod + mB * 6144, modn + mB * 6144, lng, lnb, lane);
    }
}
typedef short bf16x8 __attribute__((ext_vector_type(8)));
typedef short s16x4 __attribute__((ext_vector_type(4)));
typedef short v4i16_t __attribute__((ext_vector_type(4)));
typedef float f32x16 __attribute__((ext_vector_type(16)));
#define MFMA32(a, b, c) __builtin_amdgcn_mfma_f32_32x32x16_bf16((a), (b), (c), 0, 0, 0)
__device__ __forceinline__ int crow(int reg, int hf) { return (reg & 3) + 8 * (reg >> 2) + 4 * hf; }
__device__ __forceinline__ int tro(int r, int b) { return r * 128 + (b ^ (((r >> 1) & 1) << 6)); }
__device__ __forceinline__ int rro(int r, int c16) { return r * 128 + ((c16 ^ ((r >> 1) & 7)) << 4); }
__device__ __forceinline__ s16x4 tr4(const LAS unsigned char* p) { return __builtin_bit_cast(s16x4, __builtin_amdgcn_ds_read_tr16_b64_v4i16((LAS v4i16_t*)p)); }
__device__ __forceinline__ bf16x8 tr_frag(const LAS unsigned char* img, int rlo, int rhi, int colbyte) {
    const s16x4 lo = tr4(img + tro(rlo, colbyte)), hi = tr4(img + tro(rhi, colbyte));
    return (bf16x8){lo[0], lo[1], lo[2], lo[3], hi[0], hi[1], hi[2], hi[3]};
}

#ifndef ST_TRANSPOSED
#define ST_TRANSPOSED 1
#endif
__device__ __forceinline__ void phase_b_mfma(const Args& a, int l, LAS unsigned char* lds, int tid, int lane, int wave) {
    const bf16* P = (const bf16*)(a.ws + WS_P); bf16* ST = (bf16*)(a.ws + WS_ST);
    const int r32 = lane & 31, hf = lane >> 5, q4 = (lane & 15) >> 2, p4 = lane & 3, blk = (lane >> 4) & 1;
    for (int u = blockIdx.x; u < 8 * NCH * 4; u += gridDim.x) {
        const int b = u / (NCH * 4), c = (u % (NCH * 4)) >> 2, h0 = (u & 3) * 2; const int row0 = chunk_row0(b, c);
        __syncthreads();
#pragma unroll
        for (int k = 0; k < 4; ++k) {
            const int ci = tid + NTHR * k, hh = ci >> 10, row = (ci & 1023) >> 3, c16 = ci & 7, h = h0 + hh;
            const bf16* src = P + (size_t)(row0 + row) * INC + h * 64 + c16 * 8;
            const v4u kw = *(const v4u*)(src + OFF_K), vw = *(const v4u*)(src + OFF_V);
            LAS unsigned char* base = lds + hh * 49152;
            *(LAS v4u*)(base + tro(row, c16 * 16)) = kw;
            const float lgf = log_sigmoid_f(a.in[8][l * 8 + h]), lgb = log_sigmoid_f(a.in[9][l * 8 + h]);
            const float wf = __expf(lgf * (float)(127 - row)), wb = __expf(lgb * (float)row);
            float v[8]; unpack8(vw, v);
            v4u of, ob;
            of.x = cvtpk(v[0] * wf, v[1] * wf); of.y = cvtpk(v[2] * wf, v[3] * wf); of.z = cvtpk(v[4] * wf, v[5] * wf); of.w = cvtpk(v[6] * wf, v[7] * wf);
            ob.x = cvtpk(v[0] * wb, v[1] * wb); ob.y = cvtpk(v[2] * wb, v[3] * wb); ob.z = cvtpk(v[4] * wb, v[5] * wb); ob.w = cvtpk(v[6] * wb, v[7] * wb);
            *(LAS v4u*)(base + 16384 + tro(row, c16 * 16)) = of;
            *(LAS v4u*)(base + 32768 + tro(row, c16 * 16)) = ob;
        }
        __syncthreads();
        const int hh = wave >> 2, dir = (wave >> 1) & 1, et = wave & 1;
        const LAS unsigned char* kimg = lds + hh * 49152; const LAS unsigned char* vimg = kimg + 16384 + dir * 16384;
        f32x16 acc[2];
#pragma unroll
        for (int i = 0; i < 16; ++i) { acc[0][i] = 0.f; acc[1][i] = 0.f; }
#pragma unroll
        for (int ks = 0; ks < 8; ++ks) {
            const int rlo = 16 * ks + 8 * hf + q4;
            const bf16x8 Bv = tr_frag(vimg, rlo, rlo + 4, (et * 32 + 16 * blk + 4 * p4) * 2);
#pragma unroll
            for (int dt = 0; dt < 2; ++dt) { const bf16x8 Ak = tr_frag(kimg, rlo, rlo + 4, (dt * 32 + 16 * blk + 4 * p4) * 2); acc[dt] = MFMA32(Ak, Bv, acc[dt]); }
        }
        bf16* dst = ST + st_off(b, c, h0 + hh, dir) + (size_t)(et * 32 + r32) * 64;
#pragma unroll
        for (int dt = 0; dt < 2; ++dt)
#pragma unroll
            for (int g4 = 0; g4 < 4; ++g4) { v2u w; w.x = cvtpk(acc[dt][4 * g4], acc[dt][4 * g4 + 1]); w.y = cvtpk(acc[dt][4 * g4 + 2], acc[dt][4 * g4 + 3]);
                *(v2u*)(dst + dt * 32 + 8 * g4 + 4 * hf) = w; }
    }
    __syncthreads();
}
__device__ __forceinline__ bf16x8 scale_frag(const bf16x8 q, float sc) {
    const v4u w = __builtin_bit_cast(v4u, q); v4u o;
    o.x = cvtpk(bflo(w.x) * sc, bfhi(w.x) * sc); o.y = cvtpk(bflo(w.y) * sc, bfhi(w.y) * sc); o.z = cvtpk(bflo(w.z) * sc, bfhi(w.z) * sc); o.w = cvtpk(bflo(w.w) * sc, bfhi(w.w) * sc);
    return __builtin_bit_cast(bf16x8, o);
}
__device__ __forceinline__ bf16x8 f32x8_to_frag(const f32x4 a0, const f32x4 a1) {
    v4u o; o.x = cvtpk(a0.x, a0.y); o.y = cvtpk(a0.z, a0.w); o.z = cvtpk(a1.x, a1.y); o.w = cvtpk(a1.z, a1.w); return __builtin_bit_cast(bf16x8, o);
}
struct ConvIn { v4u cb, c0, x0, cp, xp, cn, xn; };
__device__ __forceinline__ void conv_load(ConvIn& I, const bf16* P, int row0, int c, bool isc, int idx) {
    const int p = idx >> 5, ch0 = (idx & 31) * 8; const int row = row0 + p;
    int dprev = -1, dnext = 1; bool vprev, vnext;
    if (isc) { const int t = c * 128 + p; vprev = t > 0; vnext = t < 255; }
    else { const int t = (c - 2) * 128 + p;
        if (ch0 < 128) { const int col = t & 63; vprev = col > 0; vnext = col < 63; }
        else { const int rg = t >> 6; vprev = rg > 0; vnext = rg < 63; dprev = -64; dnext = 64; } }
    const bf16* pr = P + (size_t)row * INC; const v4u z = (v4u){0u, 0u, 0u, 0u};
    I.cb = *(const v4u*)(pr + OFF_CB + ch0); I.c0 = *(const v4u*)(pr + OFF_CC + ch0); I.x0 = *(const v4u*)(pr + OFF_CX + ch0);
    I.cp = z; I.xp = z; I.cn = z; I.xn = z;
    if (vprev) { const bf16* q = pr + (ptrdiff_t)dprev * INC; I.cp = *(const v4u*)(q + OFF_CC + ch0); I.xp = *(const v4u*)(q + OFF_CX + ch0); }
    if (vnext) { const bf16* q = pr + (ptrdiff_t)dnext * INC; I.cn = *(const v4u*)(q + OFF_CC + ch0); I.xn = *(const v4u*)(q + OFF_CX + ch0); }
}
__device__ __forceinline__ void conv_store(const ConvIn& I, bf16* Y, const float* convw, int row0, int idx) {
    const int p = idx >> 5, ch0 = (idx & 31) * 8;
    float cb[8], a0[8], a1[8], o[8], zc, zp, zn;
    unpack8(I.cb, cb);
    unpack8(I.c0, a0); unpack8(I.x0, a1);
#pragma unroll
    for (int i = 0; i < 8; ++i) o[i] = convw[256 + ch0 + i] * (a0[i] * a1[i]);
    unpack8(I.cp, a0); unpack8(I.xp, a1);
#pragma unroll
    for (int i = 0; i < 8; ++i) o[i] += convw[ch0 + i] * (a0[i] * a1[i]);
    unpack8(I.cn, a0); unpack8(I.xn, a1);
#pragma unroll
    for (int i = 0; i < 8; ++i) o[i] = cb[i] * (o[i] + convw[512 + ch0 + i] * (a0[i] * a1[i]));
    (void)zc; (void)zp; (void)zn;
    *(v4u*)(Y + (size_t)(row0 + p) * 1024 + ch0) = pack8(o);
}
__device__ __forceinline__ void phase_d_mfma(const Args& a, int l, LAS unsigned char* lds, int tid, int lane, int wave) {
    const bf16* P = (const bf16*)(a.ws + WS_P); const bf16* ST = (const bf16*)(a.ws + WS_ST); bf16* Y = (bf16*)(a.ws + WS_YMIX);
    const float* convw = a.in[7] + l * 3 * 256; const float* sguw = a.in[10] + (size_t)l * 4 * 128 * 128; const float* sgub = a.in[11] + l * 4 * 128;
    const int c_lo = l == 1 ? 2 : 0, cpb = NCH - c_lo, nunits = 8 * cpb;
#define LANEC int ln_ = lane; asm volatile("" : "+v"(ln_)); const int r32 = ln_ & 31, hf = ln_ >> 5, q4 = (ln_ & 15) >> 2, p4 = ln_ & 3, blk = (ln_ >> 4) & 1; (void)q4; (void)p4; (void)blk
    unsigned* dq = (unsigned*)(a.ws + WS_CTL) + CW_DQ + l * 64; LAS int* dqw = (LAS int*)(lds + DQ_OFF);
    const int npass = 2 * nunits, total = 4 * nunits;
    __syncthreads();
    if (tid == 0) dqw[0] = (int)__hip_atomic_fetch_add(dq, 1u, __ATOMIC_RELAXED, __HIP_MEMORY_SCOPE_AGENT);
    __syncthreads();
    int item = __builtin_amdgcn_readfirstlane(dqw[0]);
    while (item < total) {
        int nxt = 0;
        if (tid == 0) nxt = (int)__hip_atomic_fetch_add(dq, 1u, __ATOMIC_RELAXED, __HIP_MEMORY_SCOPE_AGENT);
        const int type = item < npass ? 0 : (item < npass + nunits ? 1 : 2);
        const int u = type == 0 ? (item >> 1) : (type == 1 ? item - npass : item - npass - nunits), pass = item & 1;
        const int b = u / cpb, c = c_lo + u % cpb; const int row0 = chunk_row0(b, c); const bool isc = c < 2;
        if (type == 2) {
#pragma unroll 1
            for (int idx = tid; idx < 128 * 32; idx += 2 * NTHR) {
                ConvIn I0, I1;
                conv_load(I0, P, row0, c, isc, idx); conv_load(I1, P, row0, c, isc, idx + NTHR);
                conv_store(I0, Y, convw, row0, idx); conv_store(I1, Y, convw, row0, idx + NTHR);
            }
        }
#ifndef NO_D2
        if (type == 0) {
            __syncthreads();
#pragma unroll 4
            for (int k = 0; k < 16; ++k) {
                int ts_ = tid; asm volatile("" : "+v"(ts_));
                const int ci = ts_ + NTHR * k, tile = ci >> 10, hd = tile >> 1, isv = tile & 1, row = (ci & 1023) >> 3, c16 = ci & 7;
                const v4u w = *(const v4u*)(P + (size_t)(row0 + row) * INC + (isv ? OFF_V : OFF_K) + (pass * 4 + hd) * 64 + c16 * 8);
                *(LAS v4u*)(lds + hd * 32768 + isv * 16384 + (isv ? tro(row, c16 * 16) : rro(row, c16))) = w;
            }
            __syncthreads();
            LANEC;
            const int hd = wave >> 1, ih = wave & 1, h = pass * 4 + hd;
            const LAS unsigned char* kimg = lds + hd * 32768; const LAS unsigned char* vimg = kimg + 16384;
            const float lg2f = log_sigmoid_f(a.in[8][l * 8 + h]) * 1.44269504088896f, lg2b = log_sigmoid_f(a.in[9][l * 8 + h]) * 1.44269504088896f;
            bf16x8 qf[2][4];
#pragma unroll
            for (int t = 0; t < 2; ++t)
#pragma unroll
                for (int s = 0; s < 4; ++s) qf[t][s] = *(const bf16x8*)(P + (size_t)(row0 + (2 * ih + t) * 32 + r32) * INC + OFF_Q + h * 64 + 16 * s + 8 * hf);
            f32x16 acc[2][2];
#pragma unroll
            for (int t = 0; t < 2; ++t)
#pragma unroll
                for (int et = 0; et < 2; ++et)
#pragma unroll
                    for (int r = 0; r < 16; ++r) acc[t][et][r] = 0.f;
#pragma unroll
            for (int dir = 0; dir < 2; ++dir) {
                const int i0 = 2 * ih * 32 + r32;
                const float sc0 = dir == 0 ? __builtin_amdgcn_exp2f(lg2f * (float)(i0 + 1)) : __builtin_amdgcn_exp2f(lg2b * (float)(128 - i0));
                const float sc1 = dir == 0 ? __builtin_amdgcn_exp2f(lg2f * (float)(i0 + 33)) : __builtin_amdgcn_exp2f(lg2b * (float)(96 - i0));
                const bf16* sp = ST + st_off(b, c, h, dir) + r32 * 64 + 8 * hf;
#pragma unroll
                for (int s = 0; s < 4; ++s) {
                    const bf16x8 qs0 = scale_frag(qf[0][s], sc0), qs1 = scale_frag(qf[1][s], sc1);
#pragma unroll
                    for (int et = 0; et < 2; ++et) { const bf16x8 A = *(const bf16x8*)(sp + et * 2048 + 16 * s);
                        acc[0][et] = MFMA32(A, qs0, acc[0][et]); acc[1][et] = MFMA32(A, qs1, acc[1][et]); }
                }
            }
#pragma unroll
            for (int t = 0; t < 2; ++t) {
                const int it = 2 * ih + t;
                bf16x8 qq[4];
                if (t == 0) {
#pragma unroll
                    for (int s = 0; s < 4; ++s) qq[s] = qf[0][s];
                } else {
                    asm volatile("" ::: "memory");
#pragma unroll
                    for (int s = 0; s < 4; ++s) qq[s] = *(const bf16x8*)(P + (size_t)(row0 + it * 32 + r32) * INC + OFF_Q + h * 64 + 16 * s + 8 * hf);
                }
#pragma unroll 1
                for (int jt = 0; jt < 4; ++jt) {
                    f32x16 X;
#pragma unroll
                    for (int r = 0; r < 16; ++r) X[r] = 0.f;
#pragma unroll
                    for (int s = 0; s < 4; ++s) { const bf16x8 Kf = *(const LAS bf16x8*)(kimg + rro(jt * 32 + r32, 2 * s + hf)); X = MFMA32(Kf, qq[s], X); }
                    const int rel0 = (it - jt) * 32 + r32 - 4 * hf;
#pragma unroll
                    for (int r = 0; r < 16; ++r) { const int rel = rel0 - ((r & 3) + 8 * (r >> 2));
                        const float x = rel > 0 ? lg2f * (float)rel : lg2b * (float)(-rel);
                        const float dcy = rel == 0 ? 2.0f : __builtin_amdgcn_exp2f(x);
                        X[r] *= dcy; }
#pragma unroll
                    for (int s2 = 0; s2 < 2; ++s2) {
                        v4u pk; pk.x = cvtpk(X[8 * s2], X[8 * s2 + 1]); pk.y = cvtpk(X[8 * s2 + 2], X[8 * s2 + 3]); pk.z = cvtpk(X[8 * s2 + 4], X[8 * s2 + 5]); pk.w = cvtpk(X[8 * s2 + 6], X[8 * s2 + 7]);
                        const bf16x8 Pk = __builtin_bit_cast(bf16x8, pk);
                        const int rlo = jt * 32 + 16 * s2 + 4 * hf + q4;
#pragma unroll
                        for (int et = 0; et < 2; ++et) { const bf16x8 Vt = tr_frag(vimg, rlo, rlo + 8, (et * 32 + 16 * blk + 4 * p4) * 2); acc[t][et] = MFMA32(Vt, Pk, acc[t][et]); }
                    }
                }
                const int row = row0 + (2 * ih + t) * 32 + r32;
                float sum = 0.f;
#pragma unroll
                for (int et = 0; et < 2; ++et)
#pragma unroll
                    for (int r = 0; r < 16; ++r) sum += acc[t][et][r];
                sum += __shfl_xor(sum, 32);
                const float mu = sum * (1.0f / 64.0f); float vs = 0.f;
#pragma unroll
                for (int et = 0; et < 2; ++et)
#pragma unroll
                    for (int r = 0; r < 16; ++r) { const float dlt = acc[t][et][r] - mu; vs += dlt * dlt; }
                vs += __shfl_xor(vs, 32);
                const float rs = 1.0f / sqrtf(vs * (1.0f / 64.0f) + LN_EPS);
#pragma unroll
                for (int et = 0; et < 2; ++et)
#pragma unroll
                    for (int g4 = 0; g4 < 4; ++g4) { const int e0 = et * 32 + 8 * g4 + 4 * hf;
                        const v2u gw = *(const v2u*)(P + (size_t)row * INC + OFF_G + h * 64 + e0);
                        const float g0 = bflo(gw.x), g1 = bfhi(gw.x), g2 = bflo(gw.y), g3 = bfhi(gw.y);
                        const float o0 = (acc[t][et][4 * g4] - mu) * rs, o1 = (acc[t][et][4 * g4 + 1] - mu) * rs, o2 = (acc[t][et][4 * g4 + 2] - mu) * rs, o3 = (acc[t][et][4 * g4 + 3] - mu) * rs;
                        v2u w; w.x = cvtpk(g0 / (1.0f + __expf(-g0)) * o0, g1 / (1.0f + __expf(-g1)) * o1); w.y = cvtpk(g2 / (1.0f + __expf(-g2)) * o2, g3 / (1.0f + __expf(-g3)) * o3);
                        *(v2u*)(Y + (size_t)row * 1024 + 256 + h * 64 + e0) = w; }
            }
        }
#endif
#ifndef NO_D3
        if (type == 1) {
        __syncthreads();
        {
            int tq_ = tid; asm volatile("" : "+v"(tq_));
            const int i = tq_ >> 2, part = tq_ & 3;
            const bf16* vp = P + (size_t)(row0 + i) * INC + OFF_VV + part * 64;
            float sum = 0.f;
#pragma unroll 2
            for (int q = 0; q < 8; ++q) { float t8[8]; unpack8(*(const v4u*)(vp + 8 * q), t8);
#pragma unroll
                for (int e = 0; e < 8; ++e) sum += t8[e]; }
            sum += __shfl_xor(sum, 1); sum += __shfl_xor(sum, 2);
            const float mu = sum * (1.0f / 256.0f); float vs = 0.f;
#pragma unroll 2
            for (int q = 0; q < 8; ++q) { float t8[8]; unpack8(*(const v4u*)(vp + 8 * q), t8);
#pragma unroll
                for (int e = 0; e < 8; ++e) { const float dlt = t8[e] - mu; vs += dlt * dlt; } }
            vs += __shfl_xor(vs, 1); vs += __shfl_xor(vs, 2);
            const float rs = 1.0f / sqrtf(vs * (1.0f / 256.0f) + LN_EPS);
#pragma unroll 2
            for (int q = 0; q < 8; ++q) { float t8[8]; unpack8(*(const v4u*)(vp + 8 * q), t8);
                v4u w; w.x = cvtpk((t8[0] - mu) * rs, (t8[1] - mu) * rs); w.y = cvtpk((t8[2] - mu) * rs, (t8[3] - mu) * rs); w.z = cvtpk((t8[4] - mu) * rs, (t8[5] - mu) * rs); w.w = cvtpk((t8[6] - mu) * rs, (t8[7] - mu) * rs);
                *(LAS v4u*)(lds + part * 16384 + tro(i, q * 16)) = w; }
        }
        __syncthreads();
        {
            LANEC;
            const int g = wave >> 1, ph = wave & 1;
            const LAS unsigned char* vn = lds + g * 16384;
            f32x16 acc[2][2];
#pragma unroll
            for (int ct = 0; ct < 2; ++ct)
#pragma unroll
                for (int pt = 0; pt < 2; ++pt)
#pragma unroll
                    for (int r = 0; r < 16; ++r) acc[ct][pt][r] = 0.f;
#pragma unroll 2
            for (int ks = 0; ks < 8; ++ks) {
                const int rlo = 16 * ks + 8 * hf + q4;
                bf16x8 A[2], B[2];
#pragma unroll
                for (int ct = 0; ct < 2; ++ct) A[ct] = tr_frag(vn, rlo, rlo + 4, (ct * 32 + 16 * blk + 4 * p4) * 2);
#pragma unroll
                for (int pt = 0; pt < 2; ++pt) { const float* wp = sguw + ((size_t)g * 128 + ph * 64 + pt * 32 + r32) * 128 + 16 * ks + 8 * hf; B[pt] = f32x8_to_frag(*(const f32x4*)wp, *(const f32x4*)(wp + 4)); }
#pragma unroll
                for (int ct = 0; ct < 2; ++ct)
#pragma unroll
                    for (int pt = 0; pt < 2; ++pt) acc[ct][pt] = MFMA32(A[ct], B[pt], acc[ct][pt]);
            }
#pragma unroll
            for (int pt = 0; pt < 2; ++pt) {
                const int p = ph * 64 + pt * 32 + r32; const int row = row0 + p; const float bias = sgub[g * 128 + p];
#pragma unroll
                for (int ct = 0; ct < 2; ++ct)
#pragma unroll
                    for (int g4 = 0; g4 < 4; ++g4) { const int c0 = ct * 32 + 8 * g4 + 4 * hf;
                        const v2u uw = *(const v2u*)(P + (size_t)row * INC + OFF_U + g * 64 + c0);
                        v2u w; w.x = cvtpk(bflo(uw.x) * (acc[ct][pt][4 * g4] + bias), bfhi(uw.x) * (acc[ct][pt][4 * g4 + 1] + bias));
                        w.y = cvtpk(bflo(uw.y) * (acc[ct][pt][4 * g4 + 2] + bias), bfhi(uw.y) * (acc[ct][pt][4 * g4 + 3] + bias));
                        *(v2u*)(Y + (size_t)row * 1024 + 768 + g * 64 + c0) = w; }
            }
        }
        }
#endif
        __syncthreads();
        if (tid == 0) dqw[0] = nxt;
        __syncthreads();
        item = __builtin_amdgcn_readfirstlane(dqw[0]);
    }
}

__device__ __forceinline__ void phase_f2(const Args& a, int l, LAS unsigned char* lds, int tid, int lane, int wave) {
    LAS int* lcnt = (LAS int*)(lds + LCNT_OFF); LAS float* LG = (LAS float*)(lds + LG_OFF);
    LAS unsigned char* HI = lds; LAS unsigned char* LO = lds + 65536; LAS float* PART = (LAS float*)lds;
    const int r32 = lane & 31, hf = lane >> 5;
    const int nrows = l == 0 ? NROWS : NLAT, ntiles = nrows >> 5;
    const float* mod = (const float*)(a.ws + WS_MOD) + l * 9 * 6144;
    const float* lng = a.in[13] + l * 1024; const float* lnb = a.in[14] + l * 1024;
    const float* rgb = a.in[16] + l * 4; const float* reb = a.in[18] + l * 32;
    bf16* Hb = (bf16*)(a.ws + WS_HB); unsigned* tok = (unsigned*)(a.ws + WS_TOK); float* xctx = (float*)(a.ws + WS_XCTX); const bf16* YO = (const bf16*)(a.ws + WS_YO);
    const bf16* wr = (const bf16*)(a.ws + WS_WR) + (size_t)l * 2 * 64 * 1024;
    bf16x8 Bh[8][2];
#pragma unroll
    for (int ks = 0; ks < 8; ++ks)
#pragma unroll
        for (int ct = 0; ct < 2; ++ct) { const bf16* p = wr + (size_t)(ct * 32 + r32) * 1024 + wave * 128 + 16 * ks + 8 * hf; Bh[ks][ct] = *(const bf16x8*)p; }
    __syncthreads();
    if (tid < 32) lcnt[tid] = 0;
    __syncthreads();
    for (int T = blockIdx.x; T < ntiles; T += gridDim.x) {
#pragma unroll 1
        for (int rh = 0; rh < 2; ++rh) {
        f32x4 vv[2][4];
#pragma unroll
        for (int rq = 0; rq < 2; ++rq) { const int row = 32 * T + 4 * wave + 2 * rh + rq;
            const float* xin = l == 0 ? (row < NLAT ? a.in[0] + (size_t)row * 1024 : a.in[2] + (size_t)(row - NLAT) * 1024)
                                      : (row < NLAT ? a.out + (size_t)row * 1024 : xctx + (size_t)(row - NLAT) * 1024);
            const float* g1p = mod + (row < NLAT ? (row >> 12) : 8) * 6144 + 2048;
#pragma unroll
            for (int j = 0; j < 4; ++j) { const int idx = (lane + 64 * j) * 4; const v2u yw = *(const v2u*)(YO + (size_t)row * 1024 + idx);
                vv[rq][j] = *(const f32x4*)(xin + idx) * ALPHA + *(const f32x4*)(g1p + idx) * (f32x4){bflo(yw.x), bfhi(yw.x), bflo(yw.y), bfhi(yw.y)}; } }
#pragma unroll
        for (int rq = 0; rq < 2; ++rq) {
            const int lr = 4 * wave + 2 * rh + rq, row = 32 * T + lr;
            float* xr = row < NLAT ? a.out + (size_t)row * 1024 : xctx + (size_t)(row - NLAT) * 1024;
            const float* m0 = mod + (row < NLAT ? (row >> 12) : 8) * 6144;
            f32x4 v[4]; float s = 0.f;
#pragma unroll
            for (int j = 0; j < 4; ++j) { v[j] = vv[rq][j]; s += (v[j].x + v[j].y) + (v[j].z + v[j].w); }
            const float mean = wave_sum(s) * (1.0f / 1024.0f); float s2 = 0.f;
#pragma unroll
            for (int j = 0; j < 4; ++j) { v[j] = v[j] - mean; s2 += (v[j].x * v[j].x + v[j].y * v[j].y) + (v[j].z * v[j].z + v[j].w * v[j].w); }
            const float rstd = 1.0f / sqrtf(wave_sum(s2) * (1.0f / 1024.0f) + LN_EPS);
#pragma unroll
            for (int j = 0; j < 4; ++j) { const int idx = (lane + 64 * j) * 4;
                const f32x4 x1 = v[j] * rstd * *(const f32x4*)(lng + idx) + *(const f32x4*)(lnb + idx);
                *(f32x4*)(xr + idx) = x1;
                const f32x4 hm = x1 * (*(const f32x4*)(m0 + 4096 + idx) + 1.0f) + *(const f32x4*)(m0 + 3072 + idx);
                v2u h; h.x = cvtpk(hm.x, hm.y); h.y = cvtpk(hm.z, hm.w);
                v2u lo; lo.x = cvtpk(hm.x - bflo(h.x), hm.y - bfhi(h.x)); lo.y = cvtpk(hm.z - bflo(h.y), hm.w - bfhi(h.y));
                *(v2u*)(Hb + (size_t)row * 1024 + idx) = h;
                const int off = lr * 2048 + (((((lane + 64 * j) >> 1)) ^ (lr & 15)) << 4) + (lane & 1) * 8;
                *(LAS v2u*)(HI + off) = h; *(LAS v2u*)(LO + off) = lo; }
        }
        }
        __syncthreads();
        f32x16 acc[2];
#pragma unroll
        for (int r = 0; r < 16; ++r) { acc[0][r] = 0.f; acc[1][r] = 0.f; }
#pragma unroll
        for (int ks = 0; ks < 8; ++ks) { const int off = r32 * 2048 + (((wave * 16 + 2 * ks + hf) ^ (r32 & 15)) << 4);
            const bf16x8 Ah = *(const LAS bf16x8*)(HI + off), Al = *(const LAS bf16x8*)(LO + off);
#pragma unroll
            for (int ct = 0; ct < 2; ++ct) { const bf16x8 Bl = *(const bf16x8*)(wr + (size_t)(64 + ct * 32 + r32) * 1024 + wave * 128 + 16 * ks + 8 * hf);
                acc[ct] = MFMA32(Ah, Bh[ks][ct], acc[ct]); acc[ct] = MFMA32(Ah, Bl, acc[ct]); acc[ct] = MFMA32(Al, Bh[ks][ct], acc[ct]); } }
        __syncthreads();
#pragma unroll
        for (int ct = 0; ct < 2; ++ct)
#pragma unroll
            for (int r = 0; r < 16; ++r) PART[(wave * 32 + crow(r, hf)) * 64 + ct * 32 + r32] = acc[ct][r];
        __syncthreads();
        { const int row = tid >> 4, cg = tid & 15;
#pragma unroll
          for (int q = 0; q < 3; ++q) { const int col = cg + 16 * q; if (col < 36) { float sum = 0.f;
#pragma unroll
                  for (int w = 0; w < 8; ++w) sum += PART[(w * 32 + row) * 64 + col];
                  LG[row * 40 + col] = sum; } } }
        __syncthreads();
        if (tid < 32) { const int row = 32 * T + tid; const LAS float* lgp = LG + tid * 40;
            float lg[4];
#pragma unroll
            for (int g = 0; g < 4; ++g) lg[g] = lgp[g] + rgb[g];
            int gi = 0; float gm = lg[0];
#pragma unroll
            for (int g = 1; g < 4; ++g) if (lg[g] > gm) { gm = lg[g]; gi = g; }
            float gden = 0.f;
#pragma unroll
            for (int g = 0; g < 4; ++g) gden += expf(lg[g] - gm);
            const float gprob = 1.0f / gden;
            float le[8];
#pragma unroll
            for (int e = 0; e < 8; ++e) le[e] = lgp[4 + gi * 8 + e] + reb[gi * 8 + e];
            int i1 = 0; float m1 = le[0];
#pragma unroll
            for (int e = 1; e < 8; ++e) if (le[e] > m1) { m1 = le[e]; i1 = e; }
            int i2 = -1; float m2 = -3.0e38f;
#pragma unroll
            for (int e = 0; e < 8; ++e) if (e != i1 && le[e] > m2) { m2 = le[e]; i2 = e; }
            const float p2 = expf(m2 - m1), inv = 1.0f / (1.0f + p2);
            const float gate0 = gprob * inv, gate1 = gprob * p2 * inv;
            const int e0 = gi * 8 + i1, e1 = gi * 8 + i2;
            const int p0 = __hip_atomic_fetch_add(lcnt + e0, 1, __ATOMIC_RELAXED, __HIP_MEMORY_SCOPE_WORKGROUP);
            const int p1 = __hip_atomic_fetch_add(lcnt + e1, 1, __ATOMIC_RELAXED, __HIP_MEMORY_SCOPE_WORKGROUP);
            unsigned* t = tok + (size_t)row * 8; t[0] = (unsigned)e0 | ((unsigned)e1 << 8); t[1] = (unsigned)p0; t[2] = (unsigned)p1;
            t[4] = __builtin_bit_cast(unsigned, gate0); t[5] = __builtin_bit_cast(unsigned, gate1); }
    }
    __syncthreads();
    if (tid < 32) ((unsigned*)(a.ws + WS_CTL))[CW_WGCNT + (l * 256 + blockIdx.x) * 32 + tid] = (unsigned)lcnt[tid];
    __syncthreads();
}
#ifndef MK_PER_PHASE
#define MK_PER_PHASE 0
#endif
constexpr int N_PHASES = 22;

__global__ void __launch_bounds__(NTHR, 2) hybrid_fwd(Args args) {
    extern __shared__ __attribute__((aligned(16))) unsigned char lds_raw[];
    LAS unsigned char* lds = (LAS unsigned char*)lds_raw;
    const int tid0 = threadIdx.x;
    for (int u = tid0; u < (LDS_BYTES - LDSCTL_OFF) / 4; u += NTHR) ((LAS unsigned*)(lds + LDSCTL_OFF))[u] = 0u;
#define TIDS int tid = threadIdx.x; asm volatile("" : "+v"(tid)); const int lane = tid & 63, wave = __builtin_amdgcn_readfirstlane(tid >> 6); (void)lane; (void)wave
    __syncthreads();
    unsigned* ctl = (unsigned*)(args.ws + WS_CTL);
    XcdBarrier bar; bar.bar = ctl + CW_BAR; bar.x = 0; bar.st = nullptr;
    if (!MK_PER_PHASE) bar = xcd_barrier_post(ctl + CW_BAR, (volatile LAS unsigned*)(lds + MISC_OFF + 32));
    const int lo = args.ph_lo, hi = args.ph_hi;
#ifndef PHMASK
#define PHMASK 0xFFFFFFu
#endif
#define PHON(k) (((PHMASK) >> ((k) < 2 ? (k) : 2 + ((k) - 2) % 10)) & 1u)
#define IN(k) (PHON(k) && lo <= (k) && (k) < hi)
#ifndef REPMASK
#define REPMASK 0u
#endif
#define NREP(k) (1 + (int)(((REPMASK) >> ((k) < 2 ? (k) : 2 + ((k) - 2) % 10)) & 1u))
#define SEAM(k) do { if (IN(k) && IN((k) + 1)) xcd_barrier(bar); } while (0)

    if (IN(0)) for (int rep = 0; rep < NREP(0); ++rep) { TIDS; phase_p0(args, lds, tid, lane, wave); }
    SEAM(0);
    if (IN(1)) for (int rep = 0; rep < NREP(1); ++rep) { TIDS; phase_p1(args, lane, wave); }
    SEAM(1);
    for (int l = 0; l < 2; ++l) {
        const int pb = 2 + 10 * l;
        bf16* Hb = (bf16*)(args.ws + WS_HB);
        if (IN(pb + 0)) for (int rep = 0; rep < NREP(2); ++rep) {
            pg8::Gemm g{Hb, (const bf16*)(args.ws + WS_WIN) + (size_t)l * INC * 1024, NROWS, INC, 1024}; pg8::StaticOrder S; S.init(NROWS, INC, (int)gridDim.x, (int)blockIdx.x);
            pg8::EpiBf16<0> E{(bf16*)(args.ws + WS_P), INC, nullptr, 0, 0, 1.0f};
            pg8::gemm_phase<pg8::EpiBf16<0>, pg8::StaticOrder, true, true>(lds, g, S, E);
        }
        SEAM(pb + 0);
        if (IN(pb + 1)) for (int rep = 0; rep < NREP(3); ++rep) { TIDS; phase_b_mfma(args, l, lds, tid, lane, wave); }
        SEAM(pb + 1);
        if (IN(pb + 2)) { TIDS; phase_c(args, l, tid); }
        SEAM(pb + 2);
        if (IN(pb + 3)) for (int rep = 0; rep < NREP(5); ++rep) { TIDS; phase_d_mfma(args, l, lds, tid, lane, wave); }
        SEAM(pb + 3);
        if (IN(pb + 4)) for (int rep = 0; rep < (l == 0 ? NREP(6) : 1); ++rep) {
            const int M = l == 0 ? NROWS : NLAT;
            pg8::Gemm g{(const bf16*)(args.ws + WS_YMIX), (const bf16*)(args.ws + WS_WOUT) + (size_t)l * 1024 * 1024, M, 1024, 1024}; pg8::StaticOrder S; S.init(M, 1024, (int)gridDim.x, (int)blockIdx.x);
            pg8::EpiBf16<0> E{(bf16*)(args.ws + WS_YO), 1024, nullptr, 0, 0, 1.0f};
            pg8::gemm_phase<pg8::EpiBf16<0>, pg8::StaticOrder, true, true>(lds, g, S, E);
        }
        SEAM(pb + 4);
        if (IN(pb + 5)) { TIDS; phase_f2(args, l, lds, tid, lane, wave); }
        SEAM(pb + 5);
        if (IN(pb + 6)) for (int rep = 0; rep < NREP(8); ++rep) { TIDS; phase_g(args, l, lds, tid, lane, wave); }
        SEAM(pb + 6);
        if (IN(pb + 7)) for (int rep = 0; rep < NREP(9); ++rep) {
            int npan; { TIDS; npan = build_p2e(args, l, lds, tid); }
            pg8::Gemm g{(const bf16*)(args.ws + WS_XB), (const bf16*)(args.ws + WS_WGU) + (size_t)l * 32 * 1024 * 1024, npan * 256, 1024, 1024};
            pg8::MoeOrder S{(const LAS unsigned char*)(lds + P2E_OFF), npan * 4, (int)gridDim.x, (int)blockIdx.x};
            pg8::EpiGLU E{(bf16*)(args.ws + WS_HH)};
            pg8::gemm_phase<pg8::EpiGLU, pg8::MoeOrder, true, true>(lds, g, S, E);
        }
        SEAM(pb + 7);
        if (IN(pb + 8)) for (int rep = 0; rep < NREP(10); ++rep) {
            int npan; { TIDS; npan = build_p2e(args, l, lds, tid); }
            pg8::Gemm g{(const bf16*)(args.ws + WS_HH), (const bf16*)(args.ws + WS_WD) + (size_t)l * 32 * 1024 * 512, npan * 256, 1024, 512};
            pg8::MoeOrder S{(const LAS unsigned char*)(lds + P2E_OFF), npan * 4, (int)gridDim.x, (int)blockIdx.x};
            pg8::EpiY E{(bf16*)(args.ws + WS_Y)};
            pg8::gemm_phase<pg8::EpiY, pg8::MoeOrder, true, true>(lds, g, S, E);
        }
        SEAM(pb + 8);
        if (IN(pb + 9)) { if (NREP(11) > 1) { TIDS; phase_j(args, l, lane, wave, true); } TIDS; phase_j(args, l, lane, wave); }
        SEAM(pb + 9);
    }
#undef IN
#undef SEAM
}

extern "C" void kernel_launch(void* const* d_in, const int* in_sizes, int n_in, void* d_out, int out_size, void* d_ws, size_t ws_size, hipStream_t stream) {
    static int grid = 0;
    if (grid == 0) {
        if (n_in != 24 || in_sizes[0] != NLAT * DM || out_size != NLAT * DM || ws_size < WS_END) { fprintf(stderr, "kernel_launch: unexpected problem (n_in %d, ws %zu < %zu?)\n", n_in, ws_size, (size_t)WS_END); grid = -1; return; }
        int dev = 0, cus = 0, per_cu = 0;
        if (hipGetDevice(&dev) != hipSuccess || hipDeviceGetAttribute(&cus, hipDeviceAttributeMultiprocessorCount, dev) != hipSuccess) { grid = -1; return; }
        if (hipFuncSetAttribute((const void*)hybrid_fwd, hipFuncAttributeMaxDynamicSharedMemorySize, LDS_BYTES) != hipSuccess) { grid = -1; return; }
        if (hipOccupancyMaxActiveBlocksPerMultiprocessor(&per_cu, (const void*)hybrid_fwd, NTHR, LDS_BYTES) != hipSuccess || per_cu < 1) { fprintf(stderr, "kernel_launch: occupancy query says %d\n", per_cu); }
        (void)hipGetLastError();
        grid = cus;
        if (grid != 256) { fprintf(stderr, "kernel_launch: built for 256 CUs, device has %d\n", cus); grid = -1; return; }
    }
    if (grid < 0) return;
    if (hipMemsetAsync((char*)d_ws + WS_CTL, 0, CTL_ZERO_BYTES, stream) != hipSuccess) return;
    Args a{};
    for (int i = 0; i < 24; ++i) a.in[i] = (const float*)d_in[i];
    a.out = (float*)d_out; a.ws = (unsigned char*)d_ws;
#if MK_PER_PHASE
    for (int p = 0; p < N_PHASES; ++p) { a.ph_lo = p; a.ph_hi = p + 1; hipLaunchKernelGGL(hybrid_fwd, dim3(grid), dim3(NTHR), LDS_BYTES, stream, a); }
#else
    a.ph_lo = 0; a.ph_hi = N_PHASES;
    hipLaunchKernelGGL(hybrid_fwd, dim3(grid), dim3(NTHR), LDS_BYTES, stream, a);
#endif
}
```

```cpp
#include <hip/hip_runtime.h>
#include <cstdio>
#include <cstdint>
#include <cstddef>
namespace pg8 {
#define PG8_LAS __attribute__((address_space(3)))
typedef unsigned short bf16_t;
typedef short bf16x8 __attribute__((ext_vector_type(8)));
typedef float f32x4 __attribute__((ext_vector_type(4)));
typedef unsigned u32x4 __attribute__((ext_vector_type(4)));
constexpr int BM = 256, BK = 64, HALF = 128, HTB = HALF * BK * 2  , STAGE_BYTES = 8 * HTB, NXCD = 8, WGM = 8;

__host__ __device__ __forceinline__ int lds_byte(int r, int c) { const int st = (r >> 4) * 2 + (c >> 5), rr = r & 15, cc = c & 31, ob = rr * 64 + cc * 2; return st * 1024 + (ob ^ (((ob >> 9) & 1) << 5)); }
__host__ __device__ __forceinline__ void stage_rc(int b, int& R, int& C) { const int st = b / 1024, sb = b % 1024, swz = sb ^ (((sb >> 9) & 1) << 5); R = (st >> 1) * 16 + swz / 64; C = (st & 1) * 32 + (swz % 64) / 2; }
__host__ __device__ __forceinline__ int perm32(int rho) { const int n = rho >> 4, i = rho & 15; return 8 * (i >> 2) + 4 * n + (i & 3); }

struct Unit { int pm, pn; };
struct Gemm { const bf16_t* A; const bf16_t* Bt; int M, N, K; };

struct StaticOrder {
    int nM, nN, nwg, G, c;
    __host__ __device__ void init(int M, int N, int G_, int c_) { nM = M / BM; nN = N / BM; nwg = nM * nN; G = G_; c = c_; }
    __host__ __device__ bool next(int i, Unit& u) const {
        const long L = (long)i * G + c; if (L >= nwg) return false;
        int wgid = (int)L; { const int q = nwg / NXCD, r = nwg % NXCD, xcd = wgid % NXCD, off = wgid / NXCD; wgid = (xcd < r ? xcd * (q + 1) : r * (q + 1) + (xcd - r) * q) + off; }
        const int nig = WGM * nN, gid = wgid / nig, fm = gid * WGM, gsz = (nM - fm) < WGM ? (nM - fm) : WGM;
        u.pm = fm + ((wgid % nig) % gsz); u.pn = (wgid % nig) / gsz; return true;
    }
    __device__ __forceinline__ void a_ready(const Unit&) const {}
    __device__ __forceinline__ void done(const Unit&) const {}
};

__device__ __forceinline__ unsigned cvt_pk_bf16(float lo, float hi) { unsigned r; asm volatile("v_cvt_pk_bf16_f32 %0, %1, %2" : "=v"(r) : "v"(lo), "v"(hi)); return r; }
typedef float f32x2 __attribute__((ext_vector_type(2)));
__device__ __forceinline__ f32x2 gelu_pk(f32x2 v) {
    const f32x2 av = __builtin_elementwise_abs(v), d = av * 0.2316418882f + 1.0f;
    f32x2 t; t.x = __builtin_amdgcn_rcpf(d.x); t.y = __builtin_amdgcn_rcpf(d.y);
    f32x2 q = t * 0.5307027145f + (-0.7265760135f); q = q * t + 0.7107068705f; q = q * t + (-0.142248368f); q = q * t + 0.127414796f; q = q * t;
    const f32x2 s = (v * v) * (-0.72134752044f);
    f32x2 e; e.x = __builtin_amdgcn_exp2f(s.x); e.y = __builtin_amdgcn_exp2f(s.y);
    const f32x2 m = v * (q * e), r = v - m;
    f32x2 o; o.x = v.x < 0.f ? m.x : r.x; o.y = v.y < 0.f ? m.y : r.y; return o;
}

template <int ACT  > struct EpiBf16 {
    static constexpr bool PERM = true, AFTER_DRAIN = false; static_assert(ACT == 0 || ACT == 1, "EpiBf16: ACT is 0 (none) or 1 (gelu_pk)");
    bf16_t* O; int ldc; const float* bias; int split_cols; size_t split_stride; float scale0;
    __device__ __forceinline__ void operator()(const f32x4 (&acc)[2][2][4][2], const Unit& u, int wr, int wc, int fr, int fq) const {
        const int row0 = u.pm * BM + wr * 64 + fr; int colt = u.pn * BM; bf16_t* base = O;
        float sc = 1.f; if (split_cols) { const int t = colt / split_cols; base += (size_t)t * split_stride; colt -= t * split_cols; if (t == 0) sc = scale0; }
        const int col0 = colt + wc * 32 + 8 * fq, bcol0 = u.pn * BM + wc * 32 + 8 * fq;
        f32x4 bv[2][2];
#pragma unroll
        for (int bj = 0; bj < 2; ++bj)
#pragma unroll
            for (int n = 0; n < 2; ++n) bv[bj][n] = bias ? *(const f32x4*)(bias + bcol0 + bj * HALF + 4 * n) : (f32x4){0.f, 0.f, 0.f, 0.f};
#pragma unroll
        for (int ai = 0; ai < 2; ++ai)
#pragma unroll
            for (int m = 0; m < 4; ++m) { bf16_t* rowp = base + (size_t)(row0 + ai * HALF + m * 16) * ldc + col0;
#pragma unroll
                for (int bj = 0; bj < 2; ++bj) { f32x4 v0 = acc[ai][bj][m][0] + bv[bj][0], v1 = acc[ai][bj][m][1] + bv[bj][1];
                    if (ACT == 1) { f32x2 a = gelu_pk((f32x2){v0[0], v0[1]}), b = gelu_pk((f32x2){v0[2], v0[3]}), c = gelu_pk((f32x2){v1[0], v1[1]}), d = gelu_pk((f32x2){v1[2], v1[3]});
                        v0 = (f32x4){a.x, a.y, b.x, b.y}; v1 = (f32x4){c.x, c.y, d.x, d.y}; }
                    v0 = v0 * sc; v1 = v1 * sc; u32x4 w; w.x = cvt_pk_bf16(v0[0], v0[1]); w.y = cvt_pk_bf16(v0[2], v0[3]); w.z = cvt_pk_bf16(v1[0], v1[1]); w.w = cvt_pk_bf16(v1[2], v1[3]);
                    *(u32x4*)(rowp + bj * HALF) = w; } }
    }
};
__device__ __forceinline__ float silu_f(float x) { return x / (1.0f + __expf(-x)); }
struct EpiResid {
    static constexpr bool PERM = false, AFTER_DRAIN = false;
    const float* xin_lat; const float* xin_ctx; float* xo_lat; float* xo_ctx; const float* mod; float alpha;
    __device__ __forceinline__ void operator()(const f32x4 (&acc)[2][2][4][2], const Unit& u, int wr, int wc, int fr, int fq) const {
        const int prow0 = u.pm * BM; const bool isc = prow0 >= 32768;
        const float* xin = isc ? xin_ctx + (size_t)(prow0 - 32768) * 1024 : xin_lat + (size_t)prow0 * 1024;
        float* xo = isc ? xo_ctx + (size_t)(prow0 - 32768) * 1024 : xo_lat + (size_t)prow0 * 1024;
        const float* g1 = mod + (isc ? 8 : (prow0 >> 12)) * 6144 + 2048;
        const int col0 = u.pn * BM + wc * 32 + 4 * fq;
        f32x4 gv[2][2];
#pragma unroll
        for (int bj = 0; bj < 2; ++bj)
#pragma unroll
            for (int n = 0; n < 2; ++n) gv[bj][n] = *(const f32x4*)(g1 + col0 + bj * HALF + n * 16);
#pragma unroll
        for (int ai = 0; ai < 2; ++ai)
#pragma unroll
            for (int m = 0; m < 4; ++m) { const size_t off = (size_t)(ai * HALF + wr * 64 + m * 16 + fr) * 1024 + col0;
#pragma unroll
                for (int bj = 0; bj < 2; ++bj)
#pragma unroll
                    for (int n = 0; n < 2; ++n) { const f32x4 xv = *(const f32x4*)(xin + off + bj * HALF + n * 16);
                        *(f32x4*)(xo + off + bj * HALF + n * 16) = xv * alpha + gv[bj][n] * acc[ai][bj][m][n]; }
                if (m & 1) asm volatile("" ::: "memory"); }
    }
};
struct EpiGLU {
    static constexpr bool PERM = true, AFTER_DRAIN = false;
    bf16_t* Hh;
    __device__ __forceinline__ void operator()(const f32x4 (&acc)[2][2][4][2], const Unit& u, int wr, int wc, int fr, int fq) const {
        const int row0 = u.pm * BM + wr * 64 + fr; const int col0 = (u.pn & 3) * 128 + wc * 32 + 8 * fq;
#pragma unroll
        for (int ai = 0; ai < 2; ++ai)
#pragma unroll
            for (int m = 0; m < 4; ++m) { bf16_t* rowp = Hh + (size_t)(row0 + ai * HALF + m * 16) * 512 + col0;
                const f32x4 g0 = acc[ai][0][m][0], g1 = acc[ai][0][m][1], u0 = acc[ai][1][m][0], u1 = acc[ai][1][m][1];
                u32x4 w; w.x = cvt_pk_bf16(silu_f(g0[0]) * u0[0], silu_f(g0[1]) * u0[1]); w.y = cvt_pk_bf16(silu_f(g0[2]) * u0[2], silu_f(g0[3]) * u0[3]);
                w.z = cvt_pk_bf16(silu_f(g1[0]) * u1[0], silu_f(g1[1]) * u1[1]); w.w = cvt_pk_bf16(silu_f(g1[2]) * u1[2], silu_f(g1[3]) * u1[3]);
                *(u32x4*)rowp = w; }
    }
};
struct EpiY {
    static constexpr bool PERM = true, AFTER_DRAIN = false;
    bf16_t* O;
    __device__ __forceinline__ void operator()(const f32x4 (&acc)[2][2][4][2], const Unit& u, int wr, int wc, int fr, int fq) const {
        const int row0 = u.pm * BM + wr * 64 + fr; const int col0 = (u.pn & 3) * BM + wc * 32 + 8 * fq;
#pragma unroll
        for (int ai = 0; ai < 2; ++ai)
#pragma unroll
            for (int m = 0; m < 4; ++m) { bf16_t* rowp = O + (size_t)(row0 + ai * HALF + m * 16) * 1024 + col0;
#pragma unroll
                for (int bj = 0; bj < 2; ++bj) { const f32x4 v0 = acc[ai][bj][m][0], v1 = acc[ai][bj][m][1];
                    u32x4 w; w.x = cvt_pk_bf16(v0[0], v0[1]); w.y = cvt_pk_bf16(v0[2], v0[3]); w.z = cvt_pk_bf16(v1[0], v1[1]); w.w = cvt_pk_bf16(v1[2], v1[3]);
                    *(u32x4*)(rowp + bj * HALF) = w; } }
    }
};
struct MoeOrder {
    const PG8_LAS unsigned char* p2e; int nunits, G, c; const PG8_LAS int* rows;
    __device__ __forceinline__ const PG8_LAS int* arows(int i) const { return rows + i * 256; }
    __device__ __forceinline__ bool next(int i, Unit& u) const {
        const int L = i * G + c; if (L >= nunits) return false;
        u.pm = L >> 2; u.pn = (int)p2e[L >> 2] * 4 + (L & 3); return true;
    }
    __device__ __forceinline__ void a_ready(const Unit&) const {}
    __device__ __forceinline__ void done(const Unit&) const {}
};
template <class Epi, class Sched, bool ALIGN_EPI = false, bool SP2 = false>
__device__ __forceinline__ void gemm_phase(PG8_LAS unsigned char* lds, const Gemm g, const Sched& S, const Epi& E) {
    int tid_ = threadIdx.x; asm volatile("" : "+v"(tid_));
    const int tid = tid_, wid = __builtin_amdgcn_readfirstlane(tid >> 6), lane = tid & 63, wr = wid >> 2, wc = wid & 3, fr = lane & 15, fq = lane >> 4;
    const int K = g.K, nt = K / BK;
    unsigned voffA[2], voffB[2];
#pragma unroll
    for (int i = 0; i < 2; ++i) { int R, C; stage_rc(tid * 16 + i * 8192, R, C); const int Rb = Epi::PERM ? ((R & ~31) + perm32(R & 31)) : R;
        voffA[i] = (unsigned)(R * K + C) * 2u; voffB[i] = (unsigned)(Rb * K + C) * 2u; }
    const size_t kstep = (size_t)(BK * 2);
    const size_t hstep = (size_t)HALF * K * 2;
    const size_t tstep = 2 * hstep;
    const unsigned ldsw = (unsigned)wid * 1024u;
    const int aoff = lds_byte(wr * 64 + fr, fq * 8), boff = lds_byte(wc * 32 + fr, fq * 8);
#define PG8_SA(b, h) (((b) * 2 + (h)) * HTB)
#define PG8_SB(b, h) ((4 + (b) * 2 + (h)) * HTB)
#define PG8_STAGE(bufoff, gbase, voff) do { _Pragma("unroll") for (int _i = 0; _i < 2; ++_i) \
        __builtin_amdgcn_global_load_lds((const unsigned*)((const char*)(gbase) + (voff)[_i]), (PG8_LAS unsigned*)(lds + (bufoff) + ldsw + _i * 8192), 16, 0, 0); } while (0)
#define PG8_LDA(dst, b, h) do { _Pragma("unroll") for (int m = 0; m < 4; ++m) _Pragma("unroll") for (int k = 0; k < 2; ++k) dst[m][k] = *(const PG8_LAS bf16x8*)(lds + PG8_SA(b, h) + aoff + m * 2048 + k * 1024); } while (0)
#define PG8_LDB(dst, b, h) do { _Pragma("unroll") for (int n = 0; n < 2; ++n) _Pragma("unroll") for (int k = 0; k < 2; ++k) dst[n][k] = *(const PG8_LAS bf16x8*)(lds + PG8_SB(b, h) + boff + n * 2048 + k * 1024); } while (0)
#define PG8_MMA(ai, bj, At, Bt) do { __builtin_amdgcn_s_setprio(1); _Pragma("unroll") for (int m = 0; m < 4; ++m) _Pragma("unroll") for (int n = 0; n < 2; ++n) _Pragma("unroll") for (int k = 0; k < 2; ++k) \
        acc[ai][bj][m][n] = __builtin_amdgcn_mfma_f32_16x16x32_bf16(Bt[n][k], At[m][k], acc[ai][bj][m][n], 0, 0, 0); __builtin_amdgcn_s_setprio(0); } while (0)
#define PG8_WAIT_V(n) asm volatile("s_waitcnt vmcnt(" #n ")" ::: "memory")
#define PG8_WAIT_L(n) asm volatile("s_waitcnt lgkmcnt(" #n ")" ::: "memory")
#define PG8_BAR __builtin_amdgcn_s_barrier()
#define PG8_SCHED __builtin_amdgcn_sched_barrier(0)
    Unit cur, nxt; int ui = 0;
    if (!S.next(0, cur)) return;
    f32x4 acc[2][2][4][2];
#pragma unroll
    for (int a = 0; a < 2; ++a)
#pragma unroll
        for (int b = 0; b < 2; ++b)
#pragma unroll
            for (int m = 0; m < 4; ++m)
#pragma unroll
                for (int n = 0; n < 2; ++n) acc[a][b][m][n] = (f32x4){0.f, 0.f, 0.f, 0.f};
    bf16x8 At[4][2], B0[2][2], B1[2][2];
    const char* cA = (const char*)g.A + (size_t)cur.pm * tstep; const char* cB = (const char*)g.Bt + (size_t)cur.pn * tstep;
    S.a_ready(cur);
    if constexpr (SP2) {
        PG8_STAGE(PG8_SB(0, 0), cB, voffB); PG8_STAGE(PG8_SB(0, 1), cB + hstep, voffB); PG8_STAGE(PG8_SA(0, 0), cA, voffA); PG8_STAGE(PG8_SA(0, 1), cA + hstep, voffA);
        if (wr == 1) PG8_BAR;
        PG8_WAIT_V(2); PG8_BAR;
        PG8_STAGE(PG8_SB(1, 0), cB + kstep, voffB); PG8_STAGE(PG8_SA(1, 0), cA + kstep, voffA); PG8_STAGE(PG8_SB(1, 1), cB + hstep + kstep, voffB);
        PG8_WAIT_V(6); PG8_BAR;
    } else {
        PG8_STAGE(PG8_SB(0, 0), cB, voffB); PG8_STAGE(PG8_SA(0, 0), cA, voffA); PG8_STAGE(PG8_SB(0, 1), cB + hstep, voffB); PG8_STAGE(PG8_SA(0, 1), cA + hstep, voffA);
        if (wr == 1) PG8_BAR;
        PG8_WAIT_V(4); PG8_BAR;
        PG8_STAGE(PG8_SB(1, 0), cB + kstep, voffB); PG8_STAGE(PG8_SA(1, 0), cA + kstep, voffA); PG8_STAGE(PG8_SB(1, 1), cB + hstep + kstep, voffB);
        PG8_WAIT_V(6); PG8_BAR;
    }
    for (;;) {
        const bool has_next = S.next(ui + 1, nxt);
        const char* nA = has_next ? (const char*)g.A + (size_t)nxt.pm * tstep : cA; const char* nB = has_next ? (const char*)g.Bt + (size_t)nxt.pn * tstep : cB;
        for (int t = 0; t < nt; t += 2) {
            const bool last = (t == nt - 2);
            const char* a1 = cA + (size_t)(t + 1) * kstep;
            const char* a2 = last ? nA : cA + (size_t)(t + 2) * kstep; const char* b2 = last ? nB : cB + (size_t)(t + 2) * kstep;
            const char* a3 = a2 + kstep; const char* b3 = b2 + kstep;
            if (last && has_next) S.a_ready(nxt);
            if constexpr (SP2) {
            PG8_LDB(B0, 0, 0); PG8_LDB(B1, 0, 1); PG8_SCHED; PG8_LDA(At, 0, 0); PG8_STAGE(PG8_SA(1, 1), a1 + hstep, voffA);
            PG8_WAIT_V(8); PG8_WAIT_L(0); PG8_BAR; PG8_MMA(0, 0, At, B0); PG8_MMA(0, 1, At, B1); PG8_BAR; PG8_SCHED;
            PG8_LDA(At, 0, 1); PG8_STAGE(PG8_SB(0, 0), b2, voffB); PG8_STAGE(PG8_SB(0, 1), b2 + hstep, voffB); PG8_STAGE(PG8_SA(0, 0), a2, voffA);
            PG8_WAIT_V(8); PG8_WAIT_L(0); PG8_BAR; PG8_MMA(1, 0, At, B0); PG8_MMA(1, 1, At, B1); PG8_BAR; PG8_SCHED;
            PG8_LDB(B0, 1, 0); PG8_LDB(B1, 1, 1); PG8_SCHED; PG8_LDA(At, 1, 0); PG8_STAGE(PG8_SA(0, 1), a2 + hstep, voffA);
            PG8_WAIT_V(8); PG8_WAIT_L(0); PG8_BAR; PG8_MMA(0, 0, At, B0); PG8_MMA(0, 1, At, B1); PG8_BAR; PG8_SCHED;
            PG8_LDA(At, 1, 1); PG8_STAGE(PG8_SB(1, 0), b3, voffB); PG8_STAGE(PG8_SB(1, 1), b3 + hstep, voffB); PG8_STAGE(PG8_SA(1, 0), a3, voffA);
            PG8_WAIT_V(8); PG8_WAIT_L(0); PG8_BAR; PG8_MMA(1, 0, At, B0); PG8_MMA(1, 1, At, B1); PG8_BAR; PG8_SCHED;
            } else {
            PG8_LDB(B0, 0, 0); PG8_SCHED; PG8_LDA(At, 0, 0); PG8_STAGE(PG8_SA(1, 1), a1 + hstep, voffA);
            PG8_WAIT_L(8); PG8_BAR; PG8_WAIT_L(0); PG8_MMA(0, 0, At, B0); PG8_BAR; PG8_SCHED;
            PG8_LDB(B1, 0, 1); PG8_STAGE(PG8_SB(0, 0), b2, voffB);
            PG8_BAR; PG8_WAIT_L(0); PG8_MMA(0, 1, At, B1); PG8_BAR;
            PG8_LDA(At, 0, 1); PG8_STAGE(PG8_SA(0, 0), a2, voffA);
            PG8_BAR; PG8_WAIT_L(0); PG8_MMA(1, 0, At, B0); PG8_BAR; PG8_SCHED;
            PG8_STAGE(PG8_SB(0, 1), b2 + hstep, voffB);
            PG8_WAIT_V(6); PG8_BAR; PG8_MMA(1, 1, At, B1); PG8_BAR;
            PG8_LDB(B0, 1, 0); PG8_SCHED; PG8_LDA(At, 1, 0); PG8_STAGE(PG8_SA(0, 1), a2 + hstep, voffA);
            PG8_WAIT_L(8); PG8_BAR; PG8_WAIT_L(0); PG8_MMA(0, 0, At, B0); PG8_BAR; PG8_SCHED;
            PG8_LDB(B1, 1, 1); PG8_STAGE(PG8_SB(1, 0), b3, voffB);
            PG8_BAR; PG8_WAIT_L(0); PG8_MMA(0, 1, At, B1); PG8_BAR;
            PG8_LDA(At, 1, 1); PG8_STAGE(PG8_SA(1, 0), a3, voffA);
            PG8_BAR; PG8_WAIT_L(0); PG8_MMA(1, 0, At, B0); PG8_BAR; PG8_SCHED;
            PG8_STAGE(PG8_SB(1, 1), b3 + hstep, voffB);
            PG8_WAIT_V(6); PG8_BAR; PG8_MMA(1, 1, At, B1); PG8_BAR;
            }
        }
        if constexpr (ALIGN_EPI) { if (wr == 0) PG8_BAR; }
        if constexpr (!Epi::AFTER_DRAIN) { E(acc, cur, wr, wc, fr, fq); S.done(cur); }
        if (!has_next) break;
#pragma unroll
        for (int a = 0; a < 2; ++a)
#pragma unroll
            for (int b = 0; b < 2; ++b)
#pragma unroll
                for (int m = 0; m < 4; ++m)
#pragma unroll
                    for (int n = 0; n < 2; ++n) acc[a][b][m][n] = (f32x4){0.f, 0.f, 0.f, 0.f};
        cur = nxt; cA = nA; cB = nB; ++ui;
        if constexpr (ALIGN_EPI) { if (wr == 1) PG8_BAR; }
    }
    PG8_WAIT_V(0);
    if constexpr (!ALIGN_EPI) { if (wr == 0) PG8_BAR; }
    PG8_BAR;
    if constexpr (Epi::AFTER_DRAIN) { E.fused(acc, cur, wr, wc, fr, fq, lds, wid, lane); S.done(cur); }
#undef PG8_SA
#undef PG8_SB
#undef PG8_STAGE
#undef PG8_LDA
#undef PG8_LDB
#undef PG8_MMA
#undef PG8_WAIT_V
#undef PG8_WAIT_L
#undef PG8_BAR
#undef PG8_SCHED
}
template <class Epi, class Sched>
__device__ __forceinline__ void gemm_phase_gather(PG8_LAS unsigned char* lds, const Gemm g, const Sched& S, const Epi& E) {
    int tid_ = threadIdx.x; asm volatile("" : "+v"(tid_));
    const int tid = tid_, wid = __builtin_amdgcn_readfirstlane(tid >> 6), lane = tid & 63, wr = wid >> 2, wc = wid & 3, fr = lane & 15, fq = lane >> 4;
    const int K = g.K, nt = K / BK;
    constexpr bool ALIGN_EPI = true, SP2 = true;
    unsigned voffB[2]; unsigned vc[2][2], vn[2][2]; int RA[2], CA[2];
#pragma unroll
    for (int i = 0; i < 2; ++i) { int R, C; stage_rc(tid * 16 + i * 8192, R, C); const int Rb = Epi::PERM ? ((R & ~31) + perm32(R & 31)) : R;
        RA[i] = R; CA[i] = C; voffB[i] = (unsigned)(Rb * K + C) * 2u; }
    const size_t kstep = (size_t)(BK * 2);
    const size_t hstep = (size_t)HALF * K * 2;
    const size_t tstep = 2 * hstep;
    const unsigned ldsw = (unsigned)wid * 1024u;
    const int aoff = lds_byte(wr * 64 + fr, fq * 8), boff = lds_byte(wc * 32 + fr, fq * 8);
#define PG8_SA(b, h) (((b) * 2 + (h)) * HTB)
#define PG8_SB(b, h) ((4 + (b) * 2 + (h)) * HTB)
#define PG8_STAGE(bufoff, gbase, voff) do { _Pragma("unroll") for (int _i = 0; _i < 2; ++_i) \
        __builtin_amdgcn_global_load_lds((const unsigned*)((const char*)(gbase) + (voff)[_i]), (PG8_LAS unsigned*)(lds + (bufoff) + ldsw + _i * 8192), 16, 0, 0); } while (0)
#define PG8_LDA(dst, b, h) do { _Pragma("unroll") for (int m = 0; m < 4; ++m) _Pragma("unroll") for (int k = 0; k < 2; ++k) dst[m][k] = *(const PG8_LAS bf16x8*)(lds + PG8_SA(b, h) + aoff + m * 2048 + k * 1024); } while (0)
#define PG8_LDB(dst, b, h) do { _Pragma("unroll") for (int n = 0; n < 2; ++n) _Pragma("unroll") for (int k = 0; k < 2; ++k) dst[n][k] = *(const PG8_LAS bf16x8*)(lds + PG8_SB(b, h) + boff + n * 2048 + k * 1024); } while (0)
#define PG8_MMA(ai, bj, At, Bt) do { __builtin_amdgcn_s_setprio(1); _Pragma("unroll") for (int m = 0; m < 4; ++m) _Pragma("unroll") for (int n = 0; n < 2; ++n) _Pragma("unroll") for (int k = 0; k < 2; ++k) \
        acc[ai][bj][m][n] = __builtin_amdgcn_mfma_f32_16x16x32_bf16(Bt[n][k], At[m][k], acc[ai][bj][m][n], 0, 0, 0); __builtin_amdgcn_s_setprio(0); } while (0)
#define PG8_WAIT_V(n) asm volatile("s_waitcnt vmcnt(" #n ")" ::: "memory")
#define PG8_WAIT_L(n) asm volatile("s_waitcnt lgkmcnt(" #n ")" ::: "memory")
#define PG8_BAR __builtin_amdgcn_s_barrier()
#define PG8_SCHED __builtin_amdgcn_sched_barrier(0)
    Unit cur, nxt; int ui = 0;
    if (!S.next(0, cur)) return;
    f32x4 acc[2][2][4][2];
#pragma unroll
    for (int a = 0; a < 2; ++a)
#pragma unroll
        for (int b = 0; b < 2; ++b)
#pragma unroll
            for (int m = 0; m < 4; ++m)
#pragma unroll
                for (int n = 0; n < 2; ++n) acc[a][b][m][n] = (f32x4){0.f, 0.f, 0.f, 0.f};
    bf16x8 At[4][2], B0[2][2], B1[2][2];
    const char* kA = (const char*)g.A; const char* cB = (const char*)g.Bt + (size_t)cur.pn * tstep;
#define PG8_ROWS(dst, tab) do { _Pragma("unroll") for (int _h = 0; _h < 2; ++_h) _Pragma("unroll") for (int _i = 0; _i < 2; ++_i) \
        dst[_h][_i] = (unsigned)((tab)[_h * HALF + RA[_i]] * K + CA[_i]) * 2u; } while (0)
    { const PG8_LAS int* tab = S.arows(0); PG8_ROWS(vc, tab); }
    S.a_ready(cur);
    if constexpr (SP2) {
        PG8_STAGE(PG8_SB(0, 0), cB, voffB); PG8_STAGE(PG8_SB(0, 1), cB + hstep, voffB); PG8_STAGE(PG8_SA(0, 0), kA, vc[0]); PG8_STAGE(PG8_SA(0, 1), kA, vc[1]);
        if (wr == 1) PG8_BAR;
        PG8_WAIT_V(2); PG8_BAR;
        PG8_STAGE(PG8_SB(1, 0), cB + kstep, voffB); PG8_STAGE(PG8_SA(1, 0), kA + kstep, vc[0]); PG8_STAGE(PG8_SB(1, 1), cB + hstep + kstep, voffB);
        PG8_WAIT_V(6); PG8_BAR;
    }
    for (;;) {
        const bool has_next = S.next(ui + 1, nxt);
        const char* nB = has_next ? (const char*)g.Bt + (size_t)nxt.pn * tstep : cB;
        if (has_next) { const PG8_LAS int* tab = S.arows(ui + 1); PG8_ROWS(vn, tab); } else { _Pragma("unroll") for (int _h = 0; _h < 2; ++_h) { vn[_h][0] = vc[_h][0]; vn[_h][1] = vc[_h][1]; } }
        for (int t = 0; t < nt; t += 2) {
            const bool last = (t == nt - 2);
            const char* a1 = kA + (size_t)(t + 1) * kstep;
            const char* a2 = last ? kA : kA + (size_t)(t + 2) * kstep; const char* b2 = last ? nB : cB + (size_t)(t + 2) * kstep;
            unsigned v0[2], v1[2]; v0[0] = last ? vn[0][0] : vc[0][0]; v0[1] = last ? vn[0][1] : vc[0][1]; v1[0] = last ? vn[1][0] : vc[1][0]; v1[1] = last ? vn[1][1] : vc[1][1];
            const char* a3 = a2 + kstep; const char* b3 = b2 + kstep;
            if (last && has_next) S.a_ready(nxt);
            if constexpr (SP2) {
            PG8_LDB(B0, 0, 0); PG8_LDB(B1, 0, 1); PG8_SCHED; PG8_LDA(At, 0, 0); PG8_STAGE(PG8_SA(1, 1), a1, vc[1]);
            PG8_WAIT_V(8); PG8_WAIT_L(0); PG8_BAR; PG8_MMA(0, 0, At, B0); PG8_MMA(0, 1, At, B1); PG8_BAR; PG8_SCHED;
            PG8_LDA(At, 0, 1); PG8_STAGE(PG8_SB(0, 0), b2, voffB); PG8_STAGE(PG8_SB(0, 1), b2 + hstep, voffB); PG8_STAGE(PG8_SA(0, 0), a2, v0);
            PG8_WAIT_V(8); PG8_WAIT_L(0); PG8_BAR; PG8_MMA(1, 0, At, B0); PG8_MMA(1, 1, At, B1); PG8_BAR; PG8_SCHED;
            PG8_LDB(B0, 1, 0); PG8_LDB(B1, 1, 1); PG8_SCHED; PG8_LDA(At, 1, 0); PG8_STAGE(PG8_SA(0, 1), a2, v1);
            PG8_WAIT_V(8); PG8_WAIT_L(0); PG8_BAR; PG8_MMA(0, 0, At, B0); PG8_MMA(0, 1, At, B1); PG8_BAR; PG8_SCHED;
            PG8_LDA(At, 1, 1); PG8_STAGE(PG8_SB(1, 0), b3, voffB); PG8_STAGE(PG8_SB(1, 1), b3 + hstep, voffB); PG8_STAGE(PG8_SA(1, 0), a3, v0);
            PG8_WAIT_V(8); PG8_WAIT_L(0); PG8_BAR; PG8_MMA(1, 0, At, B0); PG8_MMA(1, 1, At, B1); PG8_BAR; PG8_SCHED;
            }
        }
        if constexpr (ALIGN_EPI) { if (wr == 0) PG8_BAR; }
        if constexpr (!Epi::AFTER_DRAIN) { E(acc, cur, wr, wc, fr, fq); S.done(cur); }
        if (!has_next) break;
#pragma unroll
        for (int a = 0; a < 2; ++a)
#pragma unroll
            for (int b = 0; b < 2; ++b)
#pragma unroll
                for (int m = 0; m < 4; ++m)
#pragma unroll
                    for (int n = 0; n < 2; ++n) acc[a][b][m][n] = (f32x4){0.f, 0.f, 0.f, 0.f};
        cur = nxt; cB = nB; ++ui;
#pragma unroll
        for (int _h = 0; _h < 2; ++_h) { vc[_h][0] = vn[_h][0]; vc[_h][1] = vn[_h][1]; }
        if constexpr (ALIGN_EPI) { if (wr == 1) PG8_BAR; }
    }
    PG8_WAIT_V(0);
    if constexpr (!ALIGN_EPI) { if (wr == 0) PG8_BAR; }
    PG8_BAR;
    if constexpr (Epi::AFTER_DRAIN) { E.fused(acc, cur, wr, wc, fr, fq, lds, wid, lane); S.done(cur); }
#undef PG8_ROWS
#undef PG8_SA
#undef PG8_SB
#undef PG8_STAGE
#undef PG8_LDA
#undef PG8_LDB
#undef PG8_MMA
#undef PG8_WAIT_V
#undef PG8_WAIT_L
#undef PG8_BAR
#undef PG8_SCHED
}
}
constexpr int NWAVES = 8, NTHR = 512;
constexpr int DM = 1024, NLAT = 32768, NCTX = 2048, NROWS = 34816, INC = 3328;
constexpr int OFF_CB = 0, OFF_CC = 256, OFF_CX = 512, OFF_Q = 768, OFF_K = 1280, OFF_V = 1792, OFF_G = 2304, OFF_U = 2816, OFF_VV = 3072;
constexpr int NCH = 34;
constexpr float LN_EPS = 1e-5f, ALPHA = 1.41421356237309515f;
constexpr size_t MiB = 1u << 20;
constexpr size_t WS_CTL = 0, CTL_ZERO_BYTES = MiB, WS_MOD = 1 * MiB, WS_WR = 1 * MiB + 512 * 1024, WS_TOK = 2 * MiB, WS_ROWOF = 3 * MiB + 512 * 1024, WS_WIN = 4 * MiB, WS_WOUT = 17 * MiB, WS_WGU = 21 * MiB, WS_WD = 149 * MiB,
                 WS_HB = 213 * MiB, WS_ST = WS_HB, WS_XCTX = 281 * MiB, WS_P = 289 * MiB, WS_YMIX = 510 * MiB, WS_XB = WS_P, WS_Y = WS_P, WS_YO = WS_P, WS_HH = WS_P + 152 * MiB, WS_END = 578 * MiB;
constexpr int CW_TMO = 0, CW_BAR = 4096, CW_WGCNT = 16384, CW_TOT = 32768, CW_DQ = 33024;
constexpr int RING_BYTES = 131072, LDSCTL_OFF = RING_BYTES, MISC_OFF = LDSCTL_OFF + 320, P2E_OFF = LDSCTL_OFF + 1024, PST_OFF = LDSCTL_OFF + 2048, LDS_BYTES = 147456;
constexpr int MAXPANELS = 304;
constexpr int LCNT_OFF = LDSCTL_OFF + 4096, LG_OFF = LDSCTL_OFF + 4352, DQ_OFF = LDSCTL_OFF + 9600, AROWS_OFF = LDSCTL_OFF + 9728;

#define GAS __attribute__((address_space(1)))
#define LAS __attribute__((address_space(3)))
typedef unsigned short bf16;
typedef unsigned v4u __attribute__((ext_vector_type(4)));
typedef unsigned v2u __attribute__((ext_vector_type(2)));
typedef float f32x4 __attribute__((ext_vector_type(4)));
#define LDS_WAIT() asm volatile("s_waitcnt lgkmcnt(0)" ::: "memory")
#define VM_WAIT() asm volatile("s_waitcnt vmcnt(0)" ::: "memory")
__device__ __forceinline__ unsigned f2bf(float f) { unsigned u = __builtin_bit_cast(unsigned, f); return (u + 0x7fffu + ((u >> 16) & 1u)) >> 16; }
__device__ __forceinline__ unsigned pk2(float lo, float hi) { return f2bf(lo) | (f2bf(hi) << 16); }
typedef float f32x2_t __attribute__((ext_vector_type(2))); typedef __bf16 bf16x2_t __attribute__((ext_vector_type(2)));
__device__ __forceinline__ unsigned cvtpk(float lo, float hi) { f32x2_t v = {lo, hi}; bf16x2_t b = __builtin_convertvector(v, bf16x2_t); return __builtin_bit_cast(unsigned, b); }
__device__ __forceinline__ float bflo(unsigned w) { return __builtin_bit_cast(float, w << 16); }
__device__ __forceinline__ float bfhi(unsigned w) { return __builtin_bit_cast(float, w & 0xffff0000u); }
__device__ __forceinline__ float wave_sum(float v) {
#pragma unroll
    for (int o = 1; o < 64; o <<= 1) v += __shfl_xor(v, o);
    return v;
}
__device__ __forceinline__ float log_sigmoid_f(float x) { return -log1pf(expf(-x)); }

struct Args { const float* in[24]; float* out; unsigned char* ws; int ph_lo, ph_hi; };
#define XB_TMO      128
#define XB_XCNT(j)  (256  + 64 * (j))
#define XB_XSUB(j)  (1280 + 64 * (j))
#define XB_XGEN(j)  (2304 + 64 * (j))
#define XB_TOP      3328
#define XB_TOPGEN   3392
#define XCD_BAR_WORDS 3456
#define XB_SPIN_CAP (1u << 18)

__device__ __forceinline__ unsigned xb_ld(unsigned* p)              { return __hip_atomic_load(p, __ATOMIC_RELAXED, __HIP_MEMORY_SCOPE_AGENT); }
__device__ __forceinline__ unsigned xb_add(unsigned* p, unsigned v) { return __hip_atomic_fetch_add(p, v, __ATOMIC_RELAXED, __HIP_MEMORY_SCOPE_AGENT); }
__device__ __forceinline__ unsigned xb_xcc_id() { return (unsigned)__builtin_amdgcn_s_getreg((3 << 11) | 20) & 0xFu; }
#define XB_SPIN(cond, bar) do { unsigned _sp = 0; while (cond) { __builtin_amdgcn_s_sleep(1); \
    if ((++_sp & 255u) == 0u) { if (xb_ld(&(bar)[XB_TMO])) break; if (_sp > XB_SPIN_CAP) { atomicAdd(&(bar)[XB_TMO], 1u); break; } } } } while (0)

struct XcdBarrier {
    unsigned* bar; unsigned x;
    volatile LAS unsigned* st;
};

__device__ __forceinline__ XcdBarrier xcd_barrier_post(unsigned* bar, volatile LAS unsigned* st) {
    XcdBarrier b; b.bar = bar; b.x = xb_xcc_id(); b.st = st;
    if (threadIdx.x == 0) (void)xb_add(&bar[XB_XCNT(b.x)], 1u);
    return b;
}
__device__ __forceinline__ void xcd_barrier_complete(unsigned* bar, unsigned x, unsigned& nloc, unsigned& nx) {
    const unsigned G = gridDim.x * gridDim.y * gridDim.z;
    unsigned sum, cnt, mine, sp = 0u;
    for (;;) {
        sum = 0u; cnt = 0u; mine = 0u;
#pragma unroll
        for (unsigned j = 0; j < 16; ++j) { const unsigned c = xb_ld(&bar[XB_XCNT(j)]); sum += c; cnt += (c > 0u) ? 1u : 0u; mine = (j == x) ? c : mine; }
        if (sum == G) break;
        __builtin_amdgcn_s_sleep(1);
        if ((++sp & 255u) == 0u) { if (xb_ld(&bar[XB_TMO])) break; if (sp > XB_SPIN_CAP) { atomicAdd(&bar[XB_TMO], 1u); break; } }
    }
    nloc = mine > 0u ? mine : 1u; nx = cnt > 0u ? cnt : 1u;
}

__device__ __forceinline__ void xcd_barrier(const XcdBarrier& b) {
    asm volatile("s_waitcnt vmcnt(0)" ::: "memory");
    __syncthreads();
    if (threadIdx.x == 0) {
        unsigned* bar = b.bar;
        __builtin_amdgcn_s_waitcnt(0);
        unsigned nloc = b.st[0], nx = b.st[1];
        if (nloc == 0u) { xcd_barrier_complete(bar, b.x, nloc, nx); b.st[0] = nloc; b.st[1] = nx; }
        const unsigned old = xb_add(&bar[XB_XSUB(b.x)], 1u);
        const unsigned gen = old / nloc;
        if (old + 1u == (gen + 1u) * nloc) {
            __builtin_amdgcn_fence(__ATOMIC_RELEASE, "agent");
            asm volatile("s_waitcnt vmcnt(0)" ::: "memory");
            const unsigned og = xb_add(&bar[XB_TOP], 1u);
            const unsigned tg = og / nx;
            if (og + 1u == (tg + 1u) * nx) xb_add(&bar[XB_TOPGEN], 1u);
            else XB_SPIN(xb_ld(&bar[XB_TOPGEN]) == tg, bar);
            __builtin_amdgcn_fence(__ATOMIC_ACQUIRE, "agent");
            xb_add(&bar[XB_XGEN(b.x)], 1u);
            asm volatile("s_waitcnt vmcnt(0)" ::: "memory");
        } else {
            XB_SPIN(xb_ld(&bar[XB_XGEN(b.x)]) == gen, bar);
            __builtin_amdgcn_fence(__ATOMIC_ACQUIRE, "agent");
            asm volatile("s_waitcnt vmcnt(0)" ::: "memory");
        }
    }
    __syncthreads();
}
__device__ __forceinline__ void transpose_tile(const float* Wsrc, int ldn, bf16* dst, int ldk, float scale, LAS float* scr, int lane) {
#pragma unroll 8
    for (int i = 0; i < 32; ++i) { const int kk = 2 * i + (lane >> 5); scr[kk * 33 + (lane & 31)] = Wsrc[(size_t)kk * ldn + (lane & 31)] * scale; }
    LDS_WAIT(); asm volatile("" ::: "memory");
    const int c = lane & 7;
#pragma unroll
    for (int j = 0; j < 4; ++j) { const int n = (lane >> 3) + 8 * j; const LAS float* s = scr + (8 * c) * 33 + n;
        v4u o; o.x = pk2(s[0 * 33], s[1 * 33]); o.y = pk2(s[2 * 33], s[3 * 33]); o.z = pk2(s[4 * 33], s[5 * 33]); o.w = pk2(s[6 * 33], s[7 * 33]);
        *(GAS v4u*)(dst + (size_t)n * ldk + 8 * c) = o; }
    LDS_WAIT(); asm volatile("" ::: "memory");
}

__device__ __forceinline__ void phase_p0(const Args& a, LAS unsigned char* lds, int tid, int lane, int wave) {
    const int G = gridDim.x;
    {
        LAS float* s = (LAS float*)lds; LAS float* red = (LAS float*)(lds + 36864);
        const float* c = a.in[1]; const float* cctx = a.in[3]; const float* wada = a.in[4]; const float* bada = a.in[5];
        float* mod = (float*)(a.ws + WS_MOD);
        for (int u = blockIdx.x; u < 192; u += G) {
            const int l = u / 96, j0 = (u % 96) * 64;
            for (int i = tid; i < 9 * 1024; i += NTHR) { const int r = i >> 10, k = i & 1023; const float v = r < 8 ? c[r * 1024 + k] : cctx[k]; s[i] = v / (1.0f + expf(-v)); }
            __syncthreads();
            const int jq = tid & 15, kg = tid >> 4;
            float acc[9][4];
#pragma unroll
            for (int r = 0; r < 9; ++r) { acc[r][0] = 0.f; acc[r][1] = 0.f; acc[r][2] = 0.f; acc[r][3] = 0.f; }
            const float* w = wada + (size_t)l * 1024 * 6144 + j0 + jq * 4;
            for (int k = kg; k < 1024; k += 32) { const f32x4 wv = *(const f32x4*)(w + (size_t)k * 6144);
#pragma unroll
                for (int r = 0; r < 9; ++r) { const float sr = s[r * 1024 + k]; acc[r][0] += sr * wv.x; acc[r][1] += sr * wv.y; acc[r][2] += sr * wv.z; acc[r][3] += sr * wv.w; } }
#pragma unroll
            for (int r = 0; r < 9; ++r)
#pragma unroll
                for (int i = 0; i < 4; ++i) red[(kg * 9 + r) * 64 + jq * 4 + i] = acc[r][i];
            __syncthreads();
            for (int o = tid; o < 576; o += NTHR) { const int r = o >> 6, j = o & 63; float sum = 0.f;
                for (int g2 = 0; g2 < 32; ++g2) sum += red[(g2 * 9 + r) * 64 + j];
                mod[(l * 9 + r) * 6144 + j0 + j] = sum + bada[l * 6144 + j0 + j]; }
            __syncthreads();
        }
    }
    {
        LAS float* scr = (LAS float*)(lds + wave * 16384);
        const int gw = blockIdx.x * NWAVES + wave, NGW = G * NWAVES;
        const float* w_in = a.in[6]; const float* w_out = a.in[12]; const float* w_gate = a.in[19]; const float* w_up = a.in[20]; const float* w_down = a.in[21];
        bf16* WIN = (bf16*)(a.ws + WS_WIN); bf16* WOUT = (bf16*)(a.ws + WS_WOUT); bf16* WGU = (bf16*)(a.ws + WS_WGU); bf16* WD = (bf16*)(a.ws + WS_WD);
        constexpr int I_IN = 2 * 16 * 104, I_OUT = 2 * 16 * 32, I_GU = 2 * 2 * 32 * 256, I_D = 2 * 32 * 256, NITEMS = I_IN + I_OUT + I_GU + I_D;
        for (int it = gw; it < NITEMS; it += NGW) {
            int r = it;
            if (r < I_IN) { const int l = r / 1664, q = r % 1664, k0 = 64 * (q / 104), n0 = 32 * (q % 104);
                const float sc = (n0 >= OFF_K && n0 < OFF_V) ? 0.125f : 1.0f;
                transpose_tile(w_in + ((size_t)l * 1024 + k0) * INC + n0, INC, WIN + ((size_t)l * INC + n0) * 1024 + k0, 1024, sc, scr, lane); continue; }
            r -= I_IN;
            if (r < I_OUT) { const int l = r / 512, q = r % 512, k0 = 64 * (q / 32), n0 = 32 * (q % 32);
                transpose_tile(w_out + ((size_t)l * 1024 + k0) * 1024 + n0, 1024, WOUT + ((size_t)l * 1024 + n0) * 1024 + k0, 1024, 1.0f, scr, lane); continue; }
            r -= I_OUT;
            if (r < I_GU) { const int isup = r >= (I_GU / 2) ? 1 : 0; r -= isup * (I_GU / 2);
                const int le = r / 256, q = r % 256, k0 = 64 * (q / 16), n0 = 32 * (q % 16);
                const float* src = (isup ? w_up : w_gate) + ((size_t)le * 1024 + k0) * 512 + n0;
                const int drow = (n0 >> 7) * 256 + (n0 & 127) + isup * 128;
                transpose_tile(src, 512, WGU + ((size_t)le * 1024 + drow) * 1024 + k0, 1024, 1.0f, scr, lane); continue; }
            r -= I_GU;
            { const int le = r / 256, q = r % 256, k0 = 64 * (q / 32), n0 = 32 * (q % 32);
                transpose_tile(w_down + ((size_t)le * 512 + k0) * 1024 + n0, 1024, WD + ((size_t)le * 1024 + n0) * 512 + k0, 512, 1.0f, scr, lane); }
        }
    }
    {
        bf16* WR = (bf16*)(a.ws + WS_WR);
        for (int i = blockIdx.x * NTHR + tid; i < 2 * 64 * 1024; i += G * NTHR) { const int l = i >> 16, j = (i >> 10) & 63, k = i & 1023;
            float v = 0.f;
            if (j < 4) v = a.in[15][((size_t)l * 1024 + k) * 4 + j]; else if (j < 36) v = a.in[17][(((size_t)l * 4 + ((j - 4) >> 3)) * 1024 + k) * 8 + ((j - 4) & 7)];
            const unsigned hi = f2bf(v); const float r = v - __builtin_bit_cast(float, hi << 16);
            WR[((size_t)(l * 2) * 64 + j) * 1024 + k] = (bf16)hi; WR[((size_t)(l * 2 + 1) * 64 + j) * 1024 + k] = (bf16)f2bf(r); }
    }
    __syncthreads();
}

__device__ __forceinline__ void phase_p1(const Args& a, int lane, int wave) {
    const int gw = blockIdx.x * NWAVES + wave, NGW = gridDim.x * NWAVES;
    const float* mod = (const float*)(a.ws + WS_MOD); bf16* Hb = (bf16*)(a.ws + WS_HB);
    for (int row = gw; row < NROWS; row += NGW) {
        const float* src = row < NLAT ? a.in[0] + (size_t)row * 1024 : a.in[2] + (size_t)(row - NLAT) * 1024;
        const float* m0 = mod + (row < NLAT ? (row >> 12) : 8) * 6144;
#pragma unroll
        for (int j = 0; j < 4; ++j) { const int idx = (lane + 64 * j) * 4;
            const f32x4 v = *(const f32x4*)(src + idx), sh = *(const f32x4*)(m0 + idx), sc = *(const f32x4*)(m0 + 1024 + idx);
            const f32x4 o = v * (sc + 1.0f) + sh; v2u w; w.x = pk2(o.x, o.y); w.y = pk2(o.z, o.w);
            *(v2u*)(Hb + (size_t)row * 1024 + idx) = w; }
    }
}

__device__ __forceinline__ int chunk_row0(int b, int c) { return c < 2 ? NLAT + b * 256 + c * 128 : b * 4096 + (c - 2) * 128; }
__device__ __forceinline__ size_t st_off(int b, int c, int h, int dir) { return ((((size_t)b * NCH + c) * 8 + h) * 2 + dir) * 4096; }

__device__ __forceinline__ void phase_b(const Args& a, int l, LAS unsigned char* lds, int tid) {
    const bf16* P = (const bf16*)(a.ws + WS_P); float* ST = (float*)(a.ws + WS_ST);
    LAS float* Ks = (LAS float*)lds; LAS float* Vs = (LAS float*)(lds + 32768); LAS float* pf = (LAS float*)(lds + 65536); LAS float* pb = pf + 128;
    for (int u = blockIdx.x; u < 8 * NCH * 8; u += gridDim.x) {
        const int b = u / (NCH * 8), c = (u % (NCH * 8)) / 8, h = u % 8; const int row0 = chunk_row0(b, c);
        __syncthreads();
        if (tid < 128) { const float lgf = log_sigmoid_f(a.in[8][l * 8 + h]), lgb = log_sigmoid_f(a.in[9][l * 8 + h]);
            pf[tid] = expf(lgf * (float)(127 - tid)); pb[tid] = expf(lgb * (float)tid); }
        { const int j = tid >> 2, part = tid & 3; const bf16* kp = P + (size_t)(row0 + j) * INC + OFF_K + h * 64 + part * 16; const bf16* vp = kp + (OFF_V - OFF_K);
#pragma unroll
          for (int q = 0; q < 2; ++q) { const v4u kw = *(const v4u*)(kp + 8 * q), vw = *(const v4u*)(vp + 8 * q);
              LAS float* kd = Ks + j * 64 + part * 16 + 8 * q; LAS float* vd = Vs + j * 64 + part * 16 + 8 * q;
              kd[0] = bflo(kw.x); kd[1] = bfhi(kw.x); kd[2] = bflo(kw.y); kd[3] = bfhi(kw.y); kd[4] = bflo(kw.z); kd[5] = bfhi(kw.z); kd[6] = bflo(kw.w); kd[7] = bfhi(kw.w);
              vd[0] = bflo(vw.x); vd[1] = bfhi(vw.x); vd[2] = bflo(vw.y); vd[3] = bfhi(vw.y); vd[4] = bflo(vw.z); vd[5] = bfhi(vw.z); vd[6] = bflo(vw.w); vd[7] = bfhi(vw.w); } }
        __syncthreads();
        const int d = tid >> 3, e0 = (tid & 7) * 8;
        float af[8], ab[8];
#pragma unroll
        for (int i = 0; i < 8; ++i) { af[i] = 0.f; ab[i] = 0.f; }
        for (int j = 0; j < 128; ++j) { const float kd = Ks[j * 64 + d], kf = kd * pf[j], kb = kd * pb[j];
            const f32x4 v0 = *(const LAS f32x4*)(Vs + j * 64 + e0), v1 = *(const LAS f32x4*)(Vs + j * 64 + e0 + 4);
            af[0] += kf * v0.x; af[1] += kf * v0.y; af[2] += kf * v0.z; af[3] += kf * v0.w; af[4] += kf * v1.x; af[5] += kf * v1.y; af[6] += kf * v1.z; af[7] += kf * v1.w;
            ab[0] += kb * v0.x; ab[1] += kb * v0.y; ab[2] += kb * v0.z; ab[3] += kb * v0.w; ab[4] += kb * v1.x; ab[5] += kb * v1.y; ab[6] += kb * v1.z; ab[7] += kb * v1.w; }
        float* o0 = ST + st_off(b, c, h, 0) + d * 64 + e0; float* o1 = ST + st_off(b, c, h, 1) + d * 64 + e0;
        *(f32x4*)o0 = (f32x4){af[0], af[1], af[2], af[3]}; *(f32x4*)(o0 + 4) = (f32x4){af[4], af[5], af[6], af[7]};
        *(f32x4*)o1 = (f32x4){ab[0], ab[1], ab[2], ab[3]}; *(f32x4*)(o1 + 4) = (f32x4){ab[4], ab[5], ab[6], ab[7]};
    }
    __syncthreads();
}

__device__ __forceinline__ void phase_c(const Args& a, int l, int tid) {
    bf16* ST = (bf16*)(a.ws + WS_ST);
    for (int it = blockIdx.x * NTHR + tid; it < 8 * 8 * 2 * 1024; it += gridDim.x * NTHR) {
        const int q = it & 1023, dir = (it >> 10) & 1, h = (it >> 11) & 7, b = it >> 14;
        const float lg = log_sigmoid_f(dir ? a.in[9][l * 8 + h] : a.in[8][l * 8 + h]); const float dec = expf(128.0f * lg);
        v2u kv[NCH];
#pragma unroll
        for (int s = 0; s < NCH; ++s) { const int c = dir ? (s < 2 ? 1 - s : 35 - s) : s; kv[s] = *(const v2u*)(ST + st_off(b, c, h, dir) + q * 4); }
        f32x4 st = (f32x4){0.f, 0.f, 0.f, 0.f};
#pragma unroll
        for (int s = 0; s < NCH; ++s) { const int c = dir ? (s < 2 ? 1 - s : 35 - s) : s;
            v2u w; w.x = cvtpk(st.x, st.y); w.y = cvtpk(st.z, st.w); *(v2u*)(ST + st_off(b, c, h, dir) + q * 4) = w;
            st = st * dec + (f32x4){bflo(kv[s].x), bfhi(kv[s].x), bflo(kv[s].y), bfhi(kv[s].y)}; }
    }
}
__device__ __forceinline__ void unpack8(const v4u w, float* f) { f[0] = bflo(w.x); f[1] = bfhi(w.x); f[2] = bflo(w.y); f[3] = bfhi(w.y); f[4] = bflo(w.z); f[5] = bfhi(w.z); f[6] = bflo(w.w); f[7] = bfhi(w.w); }
__device__ __forceinline__ v4u pack8(const float* f) { v4u w; w.x = pk2(f[0], f[1]); w.y = pk2(f[2], f[3]); w.z = pk2(f[4], f[5]); w.w = pk2(f[6], f[7]); return w; }

__device__ __forceinline__ void phase_d(const Args& a, int l, LAS unsigned char* lds, int tid, int lane) {
    const bf16* P = (const bf16*)(a.ws + WS_P); const float* ST = (const float*)(a.ws + WS_ST); bf16* Y = (bf16*)(a.ws + WS_YMIX);
    const float* convw = a.in[7] + l * 3 * 256; const float* sguw = a.in[10] + (size_t)l * 4 * 128 * 128; const float* sgub = a.in[11] + l * 4 * 128;
    const int c_lo = l == 1 ? 2 : 0, cpb = NCH - c_lo, nunits = 8 * cpb;
    LAS float* Sf = (LAS float*)lds; LAS float* Sb = (LAS float*)(lds + 16384); LAS float* Ks = (LAS float*)(lds + 32768); LAS float* Vs = (LAS float*)(lds + 65536);
    LAS float* VN = (LAS float*)lds;
    for (int u = blockIdx.x; u < nunits; u += gridDim.x) {
        const int b = u / cpb, c = c_lo + u % cpb; const int row0 = chunk_row0(b, c); const bool isc = c < 2;
#ifndef NO_D1
        for (int idx = tid; idx < 128 * 32; idx += NTHR) {
            const int p = idx >> 5, ch0 = (idx & 31) * 8; const int row = row0 + p;
            int dprev = -1, dnext = 1; bool vprev, vnext;
            if (isc) { const int t = c * 128 + p; vprev = t > 0; vnext = t < 255; }
            else { const int t = (c - 2) * 128 + p;
                if (ch0 < 128) { const int col = t & 63; vprev = col > 0; vnext = col < 63; }
                else { const int rg = t >> 6; vprev = rg > 0; vnext = rg < 63; dprev = -64; dnext = 64; } }
            const bf16* pr = P + (size_t)row * INC;
            float cb[8], zc[8], zp[8], zn[8], t0[8], t1[8];
            unpack8(*(const v4u*)(pr + OFF_CB + ch0), cb);
            unpack8(*(const v4u*)(pr + OFF_CC + ch0), t0); unpack8(*(const v4u*)(pr + OFF_CX + ch0), t1);
#pragma unroll
            for (int i = 0; i < 8; ++i) { zc[i] = t0[i] * t1[i]; zp[i] = 0.f; zn[i] = 0.f; }
            if (vprev) { const bf16* q = pr + (ptrdiff_t)dprev * INC; unpack8(*(const v4u*)(q + OFF_CC + ch0), t0); unpack8(*(const v4u*)(q + OFF_CX + ch0), t1);
#pragma unroll
                for (int i = 0; i < 8; ++i) zp[i] = t0[i] * t1[i]; }
            if (vnext) { const bf16* q = pr + (ptrdiff_t)dnext * INC; unpack8(*(const v4u*)(q + OFF_CC + ch0), t0); unpack8(*(const v4u*)(q + OFF_CX + ch0), t1);
#pragma unroll
                for (int i = 0; i < 8; ++i) zn[i] = t0[i] * t1[i]; }
            float o[8];
#pragma unroll
            for (int i = 0; i < 8; ++i) o[i] = cb[i] * (convw[ch0 + i] * zp[i] + convw[256 + ch0 + i] * zc[i] + convw[512 + ch0 + i] * zn[i]);
            *(v4u*)(Y + (size_t)row * 1024 + ch0) = pack8(o);
        }
#endif
        const int i = tid >> 2, part = tid & 3;
#ifndef NO_D2
#pragma unroll 1
        for (int h = 0; h < 8; ++h) {
            __syncthreads();
            { const bf16* kp = P + (size_t)(row0 + i) * INC + OFF_K + h * 64 + part * 16; const bf16* vp = kp + (OFF_V - OFF_K);
#pragma unroll
              for (int q = 0; q < 2; ++q) { float kf[8], vf[8]; unpack8(*(const v4u*)(kp + 8 * q), kf); unpack8(*(const v4u*)(vp + 8 * q), vf);
                  LAS float* kd = Ks + i * 64 + part * 16 + 8 * q; LAS float* vd = Vs + i * 64 + part * 16 + 8 * q;
#pragma unroll
                  for (int e = 0; e < 8; ++e) { kd[e] = kf[e]; vd[e] = vf[e]; } }
              const float* sf = ST + st_off(b, c, h, 0); const float* sb = ST + st_off(b, c, h, 1);
#pragma unroll
              for (int q = 0; q < 2; ++q) { const int o4 = (tid + NTHR * q) * 4; *(LAS f32x4*)(Sf + o4) = *(const f32x4*)(sf + o4); *(LAS f32x4*)(Sb + o4) = *(const f32x4*)(sb + o4); } }
            float qv[16];
            { const bf16* qp = P + (size_t)(row0 + i) * INC + OFF_Q + h * 64 + part * 16; unpack8(*(const v4u*)qp, qv); unpack8(*(const v4u*)(qp + 8), qv + 8); }
            const float lgf = log_sigmoid_f(a.in[8][l * 8 + h]), lgb = log_sigmoid_f(a.in[9][l * 8 + h]);
            __syncthreads();
            float o[16];
#pragma unroll
            for (int e = 0; e < 16; ++e) o[e] = 0.f;
#pragma unroll 1
            for (int j = 0; j < 128; ++j) {
                const LAS f32x4* kr = (const LAS f32x4*)(Ks + j * 64 + part * 16);
                float s = 0.f;
#pragma unroll
                for (int q = 0; q < 4; ++q) { const f32x4 k4 = kr[q]; s += qv[4 * q] * k4.x + qv[4 * q + 1] * k4.y + qv[4 * q + 2] * k4.z + qv[4 * q + 3] * k4.w; }
                s += __shfl_xor(s, 1); s += __shfl_xor(s, 2);
                const int rel = i - j;
                const float dec = rel > 0 ? expf(lgf * (float)rel) : (rel < 0 ? expf(lgb * (float)(-rel)) : 2.0f);
                s *= dec;
                const LAS f32x4* vr = (const LAS f32x4*)(Vs + j * 64 + part * 16);
#pragma unroll
                for (int q = 0; q < 4; ++q) { const f32x4 v4 = vr[q]; o[4 * q] += s * v4.x; o[4 * q + 1] += s * v4.y; o[4 * q + 2] += s * v4.z; o[4 * q + 3] += s * v4.w; }
            }
            float of[16], ob[16];
#pragma unroll
            for (int e = 0; e < 16; ++e) { of[e] = 0.f; ob[e] = 0.f; }
            __syncthreads();
#pragma unroll
            for (int dd = 0; dd < 16; ++dd) Ks[i * 64 + ((part * 16 + dd + i) & 63)] = qv[dd];
            __syncthreads();
#pragma unroll 2
            for (int d = 0; d < 64; ++d) { const float qd = Ks[i * 64 + ((d + i) & 63)];
                const LAS f32x4* fr = (const LAS f32x4*)(Sf + d * 64 + part * 16); const LAS f32x4* br = (const LAS f32x4*)(Sb + d * 64 + part * 16);
#pragma unroll
                for (int q = 0; q < 4; ++q) { const f32x4 f4 = fr[q], b4 = br[q];
                    of[4 * q] += qd * f4.x; of[4 * q + 1] += qd * f4.y; of[4 * q + 2] += qd * f4.z; of[4 * q + 3] += qd * f4.w;
                    ob[4 * q] += qd * b4.x; ob[4 * q + 1] += qd * b4.y; ob[4 * q + 2] += qd * b4.z; ob[4 * q + 3] += qd * b4.w; } }
            const float df = expf(lgf * (float)(i + 1)), db = expf(lgb * (float)(128 - i));
            float sum = 0.f;
#pragma unroll
            for (int e = 0; e < 16; ++e) { o[e] += df * of[e] + db * ob[e]; sum += o[e]; }
            sum += __shfl_xor(sum, 1); sum += __shfl_xor(sum, 2);
            const float mu = sum * (1.0f / 64.0f); float vs = 0.f;
#pragma unroll
            for (int e = 0; e < 16; ++e) { o[e] -= mu; vs += o[e] * o[e]; }
            vs += __shfl_xor(vs, 1); vs += __shfl_xor(vs, 2);
            const float rs = 1.0f / sqrtf(vs * (1.0f / 64.0f) + LN_EPS);
            float gv[16];
            { const bf16* gp = P + (size_t)(row0 + i) * INC + OFF_G + h * 64 + part * 16; unpack8(*(const v4u*)gp, gv); unpack8(*(const v4u*)(gp + 8), gv + 8); }
#pragma unroll
            for (int e = 0; e < 16; ++e) o[e] = (gv[e] / (1.0f + expf(-gv[e]))) * (o[e] * rs);
            bf16* yp = Y + (size_t)(row0 + i) * 1024 + 256 + h * 64 + part * 16;
            *(v4u*)yp = pack8(o); *(v4u*)(yp + 8) = pack8(o + 8);
        }
#endif
#ifndef NO_D3
        __syncthreads();
        {
            const bf16* vp = P + (size_t)(row0 + i) * INC + OFF_VV + part * 64;
            float sum = 0.f;
#pragma unroll 2
            for (int q = 0; q < 8; ++q) { float t8[8]; unpack8(*(const v4u*)(vp + 8 * q), t8);
#pragma unroll
                for (int e = 0; e < 8; ++e) sum += t8[e]; }
            sum += __shfl_xor(sum, 1); sum += __shfl_xor(sum, 2);
            const float mu = sum * (1.0f / 256.0f); float vs = 0.f;
#pragma unroll 2
            for (int q = 0; q < 8; ++q) { float t8[8]; unpack8(*(const v4u*)(vp + 8 * q), t8);
#pragma unroll
                for (int e = 0; e < 8; ++e) { const float dlt = t8[e] - mu; vs += dlt * dlt; } }
            vs += __shfl_xor(vs, 1); vs += __shfl_xor(vs, 2);
            const float rs = 1.0f / sqrtf(vs * (1.0f / 256.0f) + LN_EPS);
            LAS float* dst = VN + (part * 128 + i) * 64;
#pragma unroll 2
            for (int q = 0; q < 8; ++q) { float t8[8]; unpack8(*(const v4u*)(vp + 8 * q), t8);
                *(LAS f32x4*)(dst + 8 * q) = (f32x4){(t8[0] - mu) * rs, (t8[1] - mu) * rs, (t8[2] - mu) * rs, (t8[3] - mu) * rs};
                *(LAS f32x4*)(dst + 8 * q + 4) = (f32x4){(t8[4] - mu) * rs, (t8[5] - mu) * rs, (t8[6] - mu) * rs, (t8[7] - mu) * rs}; }
        }
        __syncthreads();
        for (int g = 0; g < 4; ++g) {
            float acc[16];
#pragma unroll
            for (int e = 0; e < 16; ++e) acc[e] = 0.f;
            const float* wrow = sguw + ((size_t)g * 128 + i) * 128;
            for (int q = 0; q < 128; q += 4) { const f32x4 w4 = *(const f32x4*)(wrow + q);
#pragma unroll
                for (int qq = 0; qq < 4; ++qq) { const float w = w4[qq]; const LAS f32x4* vr = (const LAS f32x4*)(VN + (g * 128 + q + qq) * 64 + part * 16);
#pragma unroll
                    for (int t = 0; t < 4; ++t) { const f32x4 v4 = vr[t]; acc[4 * t] += w * v4.x; acc[4 * t + 1] += w * v4.y; acc[4 * t + 2] += w * v4.z; acc[4 * t + 3] += w * v4.w; } } }
            const float bias = sgub[g * 128 + i];
            float uv[16];
            { const bf16* up = P + (size_t)(row0 + i) * INC + OFF_U + g * 64 + part * 16; unpack8(*(const v4u*)up, uv); unpack8(*(const v4u*)(up + 8), uv + 8); }
#pragma unroll
            for (int e = 0; e < 16; ++e) acc[e] = uv[e] * (acc[e] + bias);
            bf16* yp = Y + (size_t)(row0 + i) * 1024 + 768 + g * 64 + part * 16;
            *(v4u*)yp = pack8(acc); *(v4u*)(yp + 8) = pack8(acc + 8);
        }
#endif
        __syncthreads();
    }
}

__device__ __forceinline__ void phase_f(const Args& a, int l, LAS unsigned char* lds, int tid, int lane, int wave, bool dry = false) {
    LAS int* lcnt = (LAS int*)lds;
    __syncthreads();
    if (tid < 32) lcnt[tid] = 0;
    __syncthreads();
    const int gw = blockIdx.x * NWAVES + wave, NGW = gridDim.x * NWAVES, nrows = l == 0 ? NROWS : NLAT;
    const float* mod = (const float*)(a.ws + WS_MOD) + l * 9 * 6144;
    const float* lng = a.in[13] + l * 1024; const float* lnb = a.in[14] + l * 1024;
    const float* rgw = a.in[15] + l * 1024 * 4; const float* rgb = a.in[16] + l * 4; const float* rew = a.in[17] + (size_t)l * 4 * 1024 * 8; const float* reb = a.in[18] + l * 32;
    bf16* Hb = (bf16*)(a.ws + (dry ? WS_P + 160 * MiB : WS_HB)); unsigned* tok = (unsigned*)(a.ws + (dry ? WS_P + 240 * MiB : WS_TOK)); float* xctx = (float*)(a.ws + WS_XCTX);
    for (int row = gw; row < nrows; row += NGW) {
        float* xr = row < NLAT ? a.out + (size_t)row * 1024 : xctx + (size_t)(row - NLAT) * 1024;
        float* xw = dry ? (float*)(a.ws + WS_P) + (size_t)row * 1024 : xr;
        const float* m0 = mod + (row < NLAT ? (row >> 12) : 8) * 6144;
        f32x4 v[4]; float s = 0.f;
#pragma unroll
        for (int j = 0; j < 4; ++j) { v[j] = *(const f32x4*)(xr + (lane + 64 * j) * 4); s += (v[j].x + v[j].y) + (v[j].z + v[j].w); }
        const float mean = wave_sum(s) * (1.0f / 1024.0f); float s2 = 0.f;
#pragma unroll
        for (int j = 0; j < 4; ++j) { v[j] = v[j] - mean; s2 += (v[j].x * v[j].x + v[j].y * v[j].y) + (v[j].z * v[j].z + v[j].w * v[j].w); }
        const float rstd = 1.0f / sqrtf(wave_sum(s2) * (1.0f / 1024.0f) + LN_EPS);
        float lg[4] = {0.f, 0.f, 0.f, 0.f};
#pragma unroll
        for (int j = 0; j < 4; ++j) { const int idx = (lane + 64 * j) * 4;
            const f32x4 x1 = v[j] * rstd * *(const f32x4*)(lng + idx) + *(const f32x4*)(lnb + idx);
            *(f32x4*)(xw + idx) = x1;
            const f32x4 hm = x1 * (*(const f32x4*)(m0 + 4096 + idx) + 1.0f) + *(const f32x4*)(m0 + 3072 + idx);
            v[j] = hm;
            v2u w; w.x = pk2(hm.x, hm.y); w.y = pk2(hm.z, hm.w); *(v2u*)(Hb + (size_t)row * 1024 + idx) = w;
#pragma unroll
            for (int t = 0; t < 4; ++t) { const f32x4 w4 = *(const f32x4*)(rgw + (idx + t) * 4); const float hv = hm[t];
                lg[0] += hv * w4.x; lg[1] += hv * w4.y; lg[2] += hv * w4.z; lg[3] += hv * w4.w; } }
#pragma unroll
        for (int g = 0; g < 4; ++g) lg[g] = wave_sum(lg[g]) + rgb[g];
        int gi = 0; float gm = lg[0];
#pragma unroll
        for (int g = 1; g < 4; ++g) if (lg[g] > gm) { gm = lg[g]; gi = g; }
        float gden = 0.f;
#pragma unroll
        for (int g = 0; g < 4; ++g) gden += expf(lg[g] - gm);
        const float gprob = 1.0f / gden;
        float le[8] = {0.f, 0.f, 0.f, 0.f, 0.f, 0.f, 0.f, 0.f};
        const float* rw = rew + (size_t)gi * 1024 * 8;
#pragma unroll
        for (int j = 0; j < 4; ++j) { const int idx = (lane + 64 * j) * 4;
#pragma unroll
            for (int t = 0; t < 4; ++t) { const f32x4 w0 = *(const f32x4*)(rw + (idx + t) * 8), w1 = *(const f32x4*)(rw + (idx + t) * 8 + 4); const float hv = v[j][t];
                le[0] += hv * w0.x; le[1] += hv * w0.y; le[2] += hv * w0.z; le[3] += hv * w0.w; le[4] += hv * w1.x; le[5] += hv * w1.y; le[6] += hv * w1.z; le[7] += hv * w1.w; } }
#pragma unroll
        for (int e = 0; e < 8; ++e) le[e] = wave_sum(le[e]) + reb[gi * 8 + e];
        int i1 = 0; float m1 = le[0];
#pragma unroll
        for (int e = 1; e < 8; ++e) if (le[e] > m1) { m1 = le[e]; i1 = e; }
        int i2 = -1; float m2 = -3.0e38f;
#pragma unroll
        for (int e = 0; e < 8; ++e) if (e != i1 && le[e] > m2) { m2 = le[e]; i2 = e; }
        const float p2 = expf(m2 - m1), inv = 1.0f / (1.0f + p2);
        const float gate0 = gprob * inv, gate1 = gprob * p2 * inv;
        if (lane == 0) { const int e0 = gi * 8 + i1, e1 = gi * 8 + i2;
            const int p0 = __hip_atomic_fetch_add(lcnt + e0, 1, __ATOMIC_RELAXED, __HIP_MEMORY_SCOPE_WORKGROUP);
            const int p1 = __hip_atomic_fetch_add(lcnt + e1, 1, __ATOMIC_RELAXED, __HIP_MEMORY_SCOPE_WORKGROUP);
            unsigned* t = tok + (size_t)row * 8; t[0] = (unsigned)e0 | ((unsigned)e1 << 8); t[1] = (unsigned)p0; t[2] = (unsigned)p1;
            t[4] = __builtin_bit_cast(unsigned, gate0); t[5] = __builtin_bit_cast(unsigned, gate1); }
    }
    __syncthreads();
    if (tid < 32 && !dry) ((unsigned*)(a.ws + WS_CTL))[CW_WGCNT + (l * 256 + blockIdx.x) * 32 + tid] = (unsigned)lcnt[tid];
    __syncthreads();
}

__device__ __forceinline__ void phase_g(const Args& a, int l, LAS unsigned char* lds, int tid, int lane, int wave) {
    LAS int* cn = (LAS int*)lds; LAS int* base = (LAS int*)(lds + 32768); LAS int* pst = base + 32; LAS int* totl = base + 80;
    unsigned* ctl = (unsigned*)(a.ws + WS_CTL);
    __syncthreads();
    for (int i = tid; i < 256 * 32; i += NTHR) cn[i] = (int)ctl[CW_WGCNT + l * 256 * 32 + i];
    __syncthreads();
    if (tid < 32) { int tot = 0, bs = 0; for (int w = 0; w < 256; ++w) { const int v = cn[w * 32 + tid]; if (w < (int)blockIdx.x) bs += v; tot += v; } base[tid] = bs; totl[tid] = tot; }
    __syncthreads();
    if (tid == 0) { int run = 0; for (int e = 0; e < 32; ++e) { pst[e] = run; run += ((totl[e] + 255) >> 8) << 8; } pst[32] = run; }
    __syncthreads();
    if (blockIdx.x == 0 && tid < 32) ctl[CW_TOT + l * 64 + tid] = (unsigned)totl[tid];
    const int gw = blockIdx.x * NWAVES + wave, NGW = gridDim.x * NWAVES, nrows = l == 0 ? NROWS : NLAT;
    const bf16* Hb = (const bf16*)(a.ws + WS_HB); bf16* XB = (bf16*)(a.ws + WS_XB); unsigned* tok = (unsigned*)(a.ws + WS_TOK);
    (void)gw; (void)NGW; (void)Hb; (void)XB;
    int* rowof = (int*)(a.ws + WS_ROWOF);
    if (blockIdx.x < 32 && tid < 256) { const int e = blockIdx.x, pad = pst[e + 1] - pst[e] - totl[e]; if (tid < pad) rowof[pst[e] + totl[e] + tid] = 0; }
    for (int T = blockIdx.x; T < (nrows >> 5); T += gridDim.x) {
        const int row = 32 * T + (tid >> 4);
        if ((tid & 15) == 0) { unsigned* t = tok + (size_t)row * 8; const unsigned ee = t[0]; const int e0 = ee & 255, e1 = (ee >> 8) & 255;
            const int s0 = pst[e0] + base[e0] + (int)t[1], s1 = pst[e1] + base[e1] + (int)t[2];
            t[6] = (unsigned)s0; t[7] = (unsigned)s1; rowof[s0] = row; rowof[s1] = row; }
    }
    __syncthreads();
}

__device__ __forceinline__ int build_p2e(const Args& a, int l, LAS unsigned char* lds, int tid) {
    LAS unsigned char* p2e = lds + P2E_OFF; LAS int* np = (LAS int*)(lds + PST_OFF);
    const unsigned* ctl = (const unsigned*)(a.ws + WS_CTL);
    __syncthreads();
    if (tid == 0) { int pm = 0; for (int e = 0; e < 32; ++e) { const int n = ((int)ctl[CW_TOT + l * 64 + e] + 255) >> 8; for (int k = 0; k < n && pm < MAXPANELS; ++k) p2e[pm++] = (unsigned char)e; } np[0] = pm; }
    __syncthreads();
    return np[0];
}

struct JRow { f32x4 x[4]; v2u y0[4], y1[4]; float g0, g1; };
__device__ __forceinline__ void j_issue(JRow& R, const float* xr, const bf16* Y, const v4u tk, int lane) {
    const unsigned gx = tk.x, gy = tk.y;
    R.g0 = __builtin_bit_cast(float, gx); R.g1 = __builtin_bit_cast(float, gy);
    const bf16* y0 = Y + (size_t)tk.z * 1024; const bf16* y1 = Y + (size_t)tk.w * 1024;
#pragma unroll
    for (int j = 0; j < 4; ++j) { const int idx = (lane + 64 * j) * 4; R.x[j] = *(const f32x4*)(xr + idx); R.y0[j] = *(const v2u*)(y0 + idx); R.y1[j] = *(const v2u*)(y1 + idx); }
}
__device__ __forceinline__ void j_finish(const JRow& R, float* xw, bf16* hrow, const float* m0, const float* m1, const float* lng, const float* lnb, int lane) {
    f32x4 v[4]; float s = 0.f;
#pragma unroll
    for (int j = 0; j < 4; ++j) { const int idx = (lane + 64 * j) * 4; const v2u w0 = R.y0[j], w1 = R.y1[j];
        const f32x4 ya = (f32x4){bflo(w0.x), bfhi(w0.x), bflo(w0.y), bfhi(w0.y)}, yb = (f32x4){bflo(w1.x), bfhi(w1.x), bflo(w1.y), bfhi(w1.y)};
        v[j] = R.x[j] * ALPHA + *(const f32x4*)(m0 + 5120 + idx) * (ya * R.g0 + yb * R.g1);
        s += (v[j].x + v[j].y) + (v[j].z + v[j].w); }
    const float mean = wave_sum(s) * (1.0f / 1024.0f); float s2 = 0.f;
#pragma unroll
    for (int j = 0; j < 4; ++j) { v[j] = v[j] - mean; s2 += (v[j].x * v[j].x + v[j].y * v[j].y) + (v[j].z * v[j].z + v[j].w * v[j].w); }
    const float rstd = 1.0f / sqrtf(wave_sum(s2) * (1.0f / 1024.0f) + LN_EPS);
#pragma unroll
    for (int j = 0; j < 4; ++j) { const int idx = (lane + 64 * j) * 4;
        const f32x4 x2 = v[j] * rstd * *(const f32x4*)(lng + idx) + *(const f32x4*)(lnb + idx);
        *(f32x4*)(xw + idx) = x2;
        if (hrow) { const f32x4 hh = x2 * (*(const f32x4*)(m1 + 1024 + idx) + 1.0f) + *(const f32x4*)(m1 + idx);
            v2u w; w.x = cvtpk(hh.x, hh.y); w.y = cvtpk(hh.z, hh.w); *(v2u*)(hrow + idx) = w; } }
}
__device__ __forceinline__ void phase_j(const Args& a, int l, int lane, int wave, bool dry = false) {
    const int gw = blockIdx.x * NWAVES + wave, NGW = gridDim.x * NWAVES, nrows = l == 0 ? NROWS : NLAT;
    const float* mod = (const float*)(a.ws + WS_MOD) + l * 9 * 6144; const float* modn = (const float*)(a.ws + WS_MOD) + 9 * 6144;
    const float* lng = a.in[22] + l * 1024; const float* lnb = a.in[23] + l * 1024;
    bf16* Hb = (bf16*)(a.ws + WS_HB); const bf16* Y = (const bf16*)(a.ws + WS_Y); const unsigned* tok = (const unsigned*)(a.ws + WS_TOK); float* xctx = (float*)(a.ws + WS_XCTX);
    for (int rowA = gw; rowA < nrows; rowA += 2 * NGW) {
        const int rowB = rowA + NGW; const bool hasB = rowB < nrows;
        const v4u tA = *(const v4u*)(tok + (size_t)rowA * 8 + 4); const v4u tB = hasB ? *(const v4u*)(tok + (size_t)rowB * 8 + 4) : tA;
        float* xrA = rowA < NLAT ? a.out + (size_t)rowA * 1024 : xctx + (size_t)(rowA - NLAT) * 1024;
        const int rB = hasB ? rowB : rowA;
        float* xrB = rB < NLAT ? a.out + (size_t)rB * 1024 : xctx + (size_t)(rB - NLAT) * 1024;
        JRow RA, RB;
        j_issue(RA, xrA, Y, tA, lane); j_issue(RB, xrB, Y, tB, lane);
        const int mA = rowA < NLAT ? (rowA >> 12) : 8, mB = rB < NLAT ? (rB >> 12) : 8;
        j_finish(RA, dry ? (float*)(a.ws + WS_HH) + (size_t)rowA * 1024 : xrA, (l == 0 && !dry) ? Hb + (size_t)rowA * 1024 : nullptr, mod + mA * 6144, modn + mA * 6144, lng, lnb, lane);
        if (hasB) j_finish(RB, dry ? (float*)(a.ws + WS_HH) + (size_t)rowB * 1024 : xrB, (l == 0 && !dry) ? Hb + (size_t)rowB * 1024 : nullptr, mod + mB * 6144, modn + mB * 6144, lng, lnb, lane);
    }
}
typedef short bf16x8 __attribute__((ext_vector_type(8)));
typedef short s16x4 __attribute__((ext_vector_type(4)));
typedef short v4i16_t __attribute__((ext_vector_type(4)));
typedef float f32x16 __attribute__((ext_vector_type(16)));
#define MFMA32(a, b, c) __builtin_amdgcn_mfma_f32_32x32x16_bf16((a), (b), (c), 0, 0, 0)
__device__ __forceinline__ int crow(int reg, int hf) { return (reg & 3) + 8 * (reg >> 2) + 4 * hf; }
__device__ __forceinline__ int tro(int r, int b) { return r * 128 + (b ^ (((r >> 1) & 1) << 6)); }
__device__ __forceinline__ int rro(int r, int c16) { return r * 128 + ((c16 ^ ((r >> 1) & 7)) << 4); }
__device__ __forceinline__ s16x4 tr4(const LAS unsigned char* p) { return __builtin_bit_cast(s16x4, __builtin_amdgcn_ds_read_tr16_b64_v4i16((LAS v4i16_t*)p)); }
__device__ __forceinline__ bf16x8 tr_frag(const LAS unsigned char* img, int rlo, int rhi, int colbyte) {
    const s16x4 lo = tr4(img + tro(rlo, colbyte)), hi = tr4(img + tro(rhi, colbyte));
    return (bf16x8){lo[0], lo[1], lo[2], lo[3], hi[0], hi[1], hi[2], hi[3]};
}

#ifndef ST_TRANSPOSED
#define ST_TRANSPOSED 1
#endif
__device__ __forceinline__ void phase_b_mfma(const Args& a, int l, LAS unsigned char* lds, int tid, int lane, int wave) {
    const bf16* P = (const bf16*)(a.ws + WS_P); bf16* ST = (bf16*)(a.ws + WS_ST);
    const int r32 = lane & 31, hf = lane >> 5, q4 = (lane & 15) >> 2, p4 = lane & 3, blk = (lane >> 4) & 1;
    for (int u = blockIdx.x; u < 8 * NCH * 4; u += gridDim.x) {
        const int b = u / (NCH * 4), c = (u % (NCH * 4)) >> 2, h0 = (u & 3) * 2; const int row0 = chunk_row0(b, c);
        __syncthreads();
#pragma unroll
        for (int k = 0; k < 4; ++k) {
            const int ci = tid + NTHR * k, hh = ci >> 10, row = (ci & 1023) >> 3, c16 = ci & 7, h = h0 + hh;
            const bf16* src = P + (size_t)(row0 + row) * INC + h * 64 + c16 * 8;
            const v4u kw = *(const v4u*)(src + OFF_K), vw = *(const v4u*)(src + OFF_V);
            LAS unsigned char* base = lds + hh * 49152;
            *(LAS v4u*)(base + tro(row, c16 * 16)) = kw;
            const float lgf = log_sigmoid_f(a.in[8][l * 8 + h]), lgb = log_sigmoid_f(a.in[9][l * 8 + h]);
            const float wf = __expf(lgf * (float)(127 - row)), wb = __expf(lgb * (float)row);
            float v[8]; unpack8(vw, v);
            v4u of, ob;
            of.x = cvtpk(v[0] * wf, v[1] * wf); of.y = cvtpk(v[2] * wf, v[3] * wf); of.z = cvtpk(v[4] * wf, v[5] * wf); of.w = cvtpk(v[6] * wf, v[7] * wf);
            ob.x = cvtpk(v[0] * wb, v[1] * wb); ob.y = cvtpk(v[2] * wb, v[3] * wb); ob.z = cvtpk(v[4] * wb, v[5] * wb); ob.w = cvtpk(v[6] * wb, v[7] * wb);
            *(LAS v4u*)(base + 16384 + tro(row, c16 * 16)) = of;
            *(LAS v4u*)(base + 32768 + tro(row, c16 * 16)) = ob;
        }
        __syncthreads();
        const int hh = wave >> 2, dir = (wave >> 1) & 1, et = wave & 1;
        const LAS unsigned char* kimg = lds + hh * 49152; const LAS unsigned char* vimg = kimg + 16384 + dir * 16384;
        f32x16 acc[2];
#pragma unroll
        for (int i = 0; i < 16; ++i) { acc[0][i] = 0.f; acc[1][i] = 0.f; }
#pragma unroll
        for (int ks = 0; ks < 8; ++ks) {
            const int rlo = 16 * ks + 8 * hf + q4;
            const bf16x8 Bv = tr_frag(vimg, rlo, rlo + 4, (et * 32 + 16 * blk + 4 * p4) * 2);
#pragma unroll
            for (int dt = 0; dt < 2; ++dt) { const bf16x8 Ak = tr_frag(kimg, rlo, rlo + 4, (dt * 32 + 16 * blk + 4 * p4) * 2); acc[dt] = MFMA32(Ak, Bv, acc[dt]); }
        }
        bf16* dst = ST + st_off(b, c, h0 + hh, dir) + (size_t)(et * 32 + r32) * 64;
#pragma unroll
        for (int dt = 0; dt < 2; ++dt)
#pragma unroll
            for (int g4 = 0; g4 < 4; ++g4) { v2u w; w.x = cvtpk(acc[dt][4 * g4], acc[dt][4 * g4 + 1]); w.y = cvtpk(acc[dt][4 * g4 + 2], acc[dt][4 * g4 + 3]);
                *(v2u*)(dst + dt * 32 + 8 * g4 + 4 * hf) = w; }
    }
    __syncthreads();
}
__device__ __forceinline__ bf16x8 scale_frag(const bf16x8 q, float sc) {
    const v4u w = __builtin_bit_cast(v4u, q); v4u o;
    o.x = cvtpk(bflo(w.x) * sc, bfhi(w.x) * sc); o.y = cvtpk(bflo(w.y) * sc, bfhi(w.y) * sc); o.z = cvtpk(bflo(w.z) * sc, bfhi(w.z) * sc); o.w = cvtpk(bflo(w.w) * sc, bfhi(w.w) * sc);
    return __builtin_bit_cast(bf16x8, o);
}
__device__ __forceinline__ bf16x8 f32x8_to_frag(const f32x4 a0, const f32x4 a1) {
    v4u o; o.x = cvtpk(a0.x, a0.y); o.y = cvtpk(a0.z, a0.w); o.z = cvtpk(a1.x, a1.y); o.w = cvtpk(a1.z, a1.w); return __builtin_bit_cast(bf16x8, o);
}
struct ConvIn { v4u cb, c0, x0, cp, xp, cn, xn; };
__device__ __forceinline__ void conv_load(ConvIn& I, const bf16* P, int row0, int c, bool isc, int idx) {
    const int p = idx >> 5, ch0 = (idx & 31) * 8; const int row = row0 + p;
    int dprev = -1, dnext = 1; bool vprev, vnext;
    if (isc) { const int t = c * 128 + p; vprev = t > 0; vnext = t < 255; }
    else { const int t = (c - 2) * 128 + p;
        if (ch0 < 128) { const int col = t & 63; vprev = col > 0; vnext = col < 63; }
        else { const int rg = t >> 6; vprev = rg > 0; vnext = rg < 63; dprev = -64; dnext = 64; } }
    const bf16* pr = P + (size_t)row * INC; const v4u z = (v4u){0u, 0u, 0u, 0u};
    I.cb = *(const v4u*)(pr + OFF_CB + ch0); I.c0 = *(const v4u*)(pr + OFF_CC + ch0); I.x0 = *(const v4u*)(pr + OFF_CX + ch0);
    I.cp = z; I.xp = z; I.cn = z; I.xn = z;
    if (vprev) { const bf16* q = pr + (ptrdiff_t)dprev * INC; I.cp = *(const v4u*)(q + OFF_CC + ch0); I.xp = *(const v4u*)(q + OFF_CX + ch0); }
    if (vnext) { const bf16* q = pr + (ptrdiff_t)dnext * INC; I.cn = *(const v4u*)(q + OFF_CC + ch0); I.xn = *(const v4u*)(q + OFF_CX + ch0); }
}
__device__ __forceinline__ void conv_store(const ConvIn& I, bf16* Y, const float* convw, int row0, int idx) {
    const int p = idx >> 5, ch0 = (idx & 31) * 8;
    float cb[8], a0[8], a1[8], o[8], zc, zp, zn;
    unpack8(I.cb, cb);
    unpack8(I.c0, a0); unpack8(I.x0, a1);
#pragma unroll
    for (int i = 0; i < 8; ++i) o[i] = convw[256 + ch0 + i] * (a0[i] * a1[i]);
    unpack8(I.cp, a0); unpack8(I.xp, a1);
#pragma unroll
    for (int i = 0; i < 8; ++i) o[i] += convw[ch0 + i] * (a0[i] * a1[i]);
    unpack8(I.cn, a0); unpack8(I.xn, a1);
#pragma unroll
    for (int i = 0; i < 8; ++i) o[i] = cb[i] * (o[i] + convw[512 + ch0 + i] * (a0[i] * a1[i]));
    (void)zc; (void)zp; (void)zn;
    *(v4u*)(Y + (size_t)(row0 + p) * 1024 + ch0) = pack8(o);
}
__device__ __forceinline__ void phase_d_mfma(const Args& a, int l, LAS unsigned char* lds, int tid, int lane, int wave) {
    const bf16* P = (const bf16*)(a.ws + WS_P); const bf16* ST = (const bf16*)(a.ws + WS_ST); bf16* Y = (bf16*)(a.ws + WS_YMIX);
    const float* convw = a.in[7] + l * 3 * 256; const float* sguw = a.in[10] + (size_t)l * 4 * 128 * 128; const float* sgub = a.in[11] + l * 4 * 128;
    const int c_lo = l == 1 ? 2 : 0, cpb = NCH - c_lo, nunits = 8 * cpb;
#define LANEC int ln_ = lane; asm volatile("" : "+v"(ln_)); const int r32 = ln_ & 31, hf = ln_ >> 5, q4 = (ln_ & 15) >> 2, p4 = ln_ & 3, blk = (ln_ >> 4) & 1; (void)q4; (void)p4; (void)blk
    unsigned* dq = (unsigned*)(a.ws + WS_CTL) + CW_DQ + l * 64; LAS int* dqw = (LAS int*)(lds + DQ_OFF);
    const int npass = 2 * nunits, total = 4 * nunits;
    __syncthreads();
    if (tid == 0) dqw[0] = (int)__hip_atomic_fetch_add(dq, 1u, __ATOMIC_RELAXED, __HIP_MEMORY_SCOPE_AGENT);
    __syncthreads();
    int item = __builtin_amdgcn_readfirstlane(dqw[0]);
    while (item < total) {
        int nxt = 0;
        if (tid == 0) nxt = (int)__hip_atomic_fetch_add(dq, 1u, __ATOMIC_RELAXED, __HIP_MEMORY_SCOPE_AGENT);
        const int type = item < npass ? 0 : (item < npass + nunits ? 1 : 2);
        const int u = type == 0 ? (item >> 1) : (type == 1 ? item - npass : item - npass - nunits), pass = item & 1;
        const int b = u / cpb, c = c_lo + u % cpb; const int row0 = chunk_row0(b, c); const bool isc = c < 2;
        if (type == 2) {
#pragma unroll 1
            for (int idx = tid; idx < 128 * 32; idx += 2 * NTHR) {
                ConvIn I0, I1;
                conv_load(I0, P, row0, c, isc, idx); conv_load(I1, P, row0, c, isc, idx + NTHR);
                conv_store(I0, Y, convw, row0, idx); conv_store(I1, Y, convw, row0, idx + NTHR);
            }
        }
#ifndef NO_D2
        if (type == 0) {
            __syncthreads();
#pragma unroll 4
            for (int k = 0; k < 16; ++k) {
                int ts_ = tid; asm volatile("" : "+v"(ts_));
                const int ci = ts_ + NTHR * k, tile = ci >> 10, hd = tile >> 1, isv = tile & 1, row = (ci & 1023) >> 3, c16 = ci & 7;
                const v4u w = *(const v4u*)(P + (size_t)(row0 + row) * INC + (isv ? OFF_V : OFF_K) + (pass * 4 + hd) * 64 + c16 * 8);
                *(LAS v4u*)(lds + hd * 32768 + isv * 16384 + (isv ? tro(row, c16 * 16) : rro(row, c16))) = w;
            }
            __syncthreads();
            LANEC;
            const int hd = wave >> 1, ih = wave & 1, h = pass * 4 + hd;
            const LAS unsigned char* kimg = lds + hd * 32768; const LAS unsigned char* vimg = kimg + 16384;
            const float lg2f = log_sigmoid_f(a.in[8][l * 8 + h]) * 1.44269504088896f, lg2b = log_sigmoid_f(a.in[9][l * 8 + h]) * 1.44269504088896f;
            bf16x8 qf[2][4];
#pragma unroll
            for (int t = 0; t < 2; ++t)
#pragma unroll
                for (int s = 0; s < 4; ++s) qf[t][s] = *(const bf16x8*)(P + (size_t)(row0 + (2 * ih + t) * 32 + r32) * INC + OFF_Q + h * 64 + 16 * s + 8 * hf);
            f32x16 acc[2][2];
#pragma unroll
            for (int t = 0; t < 2; ++t)
#pragma unroll
                for (int et = 0; et < 2; ++et)
#pragma unroll
                    for (int r = 0; r < 16; ++r) acc[t][et][r] = 0.f;
#pragma unroll
            for (int dir = 0; dir < 2; ++dir) {
                const int i0 = 2 * ih * 32 + r32;
                const float sc0 = dir == 0 ? __builtin_amdgcn_exp2f(lg2f * (float)(i0 + 1)) : __builtin_amdgcn_exp2f(lg2b * (float)(128 - i0));
                const float sc1 = dir == 0 ? __builtin_amdgcn_exp2f(lg2f * (float)(i0 + 33)) : __builtin_amdgcn_exp2f(lg2b * (float)(96 - i0));
                const bf16* sp = ST + st_off(b, c, h, dir) + r32 * 64 + 8 * hf;
#pragma unroll
                for (int s = 0; s < 4; ++s) {
                    const bf16x8 qs0 = scale_frag(qf[0][s], sc0), qs1 = scale_frag(qf[1][s], sc1);
#pragma unroll
                    for (int et = 0; et < 2; ++et) { const bf16x8 A = *(const bf16x8*)(sp + et * 2048 + 16 * s);
                        acc[0][et] = MFMA32(A, qs0, acc[0][et]); acc[1][et] = MFMA32(A, qs1, acc[1][et]); }
                }
            }
#pragma unroll
            for (int t = 0; t < 2; ++t) {
                const int it = 2 * ih + t;
                bf16x8 qq[4];
                if (t == 0) {
#pragma unroll
                    for (int s = 0; s < 4; ++s) qq[s] = qf[0][s];
                } else {
                    asm volatile("" ::: "memory");
#pragma unroll
                    for (int s = 0; s < 4; ++s) qq[s] = *(const bf16x8*)(P + (size_t)(row0 + it * 32 + r32) * INC + OFF_Q + h * 64 + 16 * s + 8 * hf);
                }
#pragma unroll 1
                for (int jt = 0; jt < 4; ++jt) {
                    f32x16 X;
#pragma unroll
                    for (int r = 0; r < 16; ++r) X[r] = 0.f;
#pragma unroll
                    for (int s = 0; s < 4; ++s) { const bf16x8 Kf = *(const LAS bf16x8*)(kimg + rro(jt * 32 + r32, 2 * s + hf)); X = MFMA32(Kf, qq[s], X); }
                    const int rel0 = (it - jt) * 32 + r32 - 4 * hf;
#pragma unroll
                    for (int r = 0; r < 16; ++r) { const int rel = rel0 - ((r & 3) + 8 * (r >> 2));
                        const float x = rel > 0 ? lg2f * (float)rel : lg2b * (float)(-rel);
                        const float dcy = rel == 0 ? 2.0f : __builtin_amdgcn_exp2f(x);
                        X[r] *= dcy; }
#pragma unroll
                    for (int s2 = 0; s2 < 2; ++s2) {
                        v4u pk; pk.x = cvtpk(X[8 * s2], X[8 * s2 + 1]); pk.y = cvtpk(X[8 * s2 + 2], X[8 * s2 + 3]); pk.z = cvtpk(X[8 * s2 + 4], X[8 * s2 + 5]); pk.w = cvtpk(X[8 * s2 + 6], X[8 * s2 + 7]);
                        const bf16x8 Pk = __builtin_bit_cast(bf16x8, pk);
                        const int rlo = jt * 32 + 16 * s2 + 4 * hf + q4;
#pragma unroll
                        for (int et = 0; et < 2; ++et) { const bf16x8 Vt = tr_frag(vimg, rlo, rlo + 8, (et * 32 + 16 * blk + 4 * p4) * 2); acc[t][et] = MFMA32(Vt, Pk, acc[t][et]); }
                    }
                }
                const int row = row0 + (2 * ih + t) * 32 + r32;
                float sum = 0.f;
#pragma unroll
                for (int et = 0; et < 2; ++et)
#pragma unroll
                    for (int r = 0; r < 16; ++r) sum += acc[t][et][r];
                sum += __shfl_xor(sum, 32);
                const float mu = sum * (1.0f / 64.0f); float vs = 0.f;
#pragma unroll
                for (int et = 0; et < 2; ++et)
#pragma unroll
                    for (int r = 0; r < 16; ++r) { const float dlt = acc[t][et][r] - mu; vs += dlt * dlt; }
                vs += __shfl_xor(vs, 32);
                const float rs = 1.0f / sqrtf(vs * (1.0f / 64.0f) + LN_EPS);
#pragma unroll
                for (int et = 0; et < 2; ++et)
#pragma unroll
                    for (int g4 = 0; g4 < 4; ++g4) { const int e0 = et * 32 + 8 * g4 + 4 * hf;
                        const v2u gw = *(const v2u*)(P + (size_t)row * INC + OFF_G + h * 64 + e0);
                        const float g0 = bflo(gw.x), g1 = bfhi(gw.x), g2 = bflo(gw.y), g3 = bfhi(gw.y);
                        const float o0 = (acc[t][et][4 * g4] - mu) * rs, o1 = (acc[t][et][4 * g4 + 1] - mu) * rs, o2 = (acc[t][et][4 * g4 + 2] - mu) * rs, o3 = (acc[t][et][4 * g4 + 3] - mu) * rs;
                        v2u w; w.x = cvtpk(g0 / (1.0f + __expf(-g0)) * o0, g1 / (1.0f + __expf(-g1)) * o1); w.y = cvtpk(g2 / (1.0f + __expf(-g2)) * o2, g3 / (1.0f + __expf(-g3)) * o3);
                        *(v2u*)(Y + (size_t)row * 1024 + 256 + h * 64 + e0) = w; }
            }
        }
#endif
#ifndef NO_D3
        if (type == 1) {
        __syncthreads();
        {
            int tq_ = tid; asm volatile("" : "+v"(tq_));
            const int i = tq_ >> 2, part = tq_ & 3;
            const bf16* vp = P + (size_t)(row0 + i) * INC + OFF_VV + part * 64;
            float sum = 0.f;
#pragma unroll 2
            for (int q = 0; q < 8; ++q) { float t8[8]; unpack8(*(const v4u*)(vp + 8 * q), t8);
#pragma unroll
                for (int e = 0; e < 8; ++e) sum += t8[e]; }
            sum += __shfl_xor(sum, 1); sum += __shfl_xor(sum, 2);
            const float mu = sum * (1.0f / 256.0f); float vs = 0.f;
#pragma unroll 2
            for (int q = 0; q < 8; ++q) { float t8[8]; unpack8(*(const v4u*)(vp + 8 * q), t8);
#pragma unroll
                for (int e = 0; e < 8; ++e) { const float dlt = t8[e] - mu; vs += dlt * dlt; } }
            vs += __shfl_xor(vs, 1); vs += __shfl_xor(vs, 2);
            const float rs = 1.0f / sqrtf(vs * (1.0f / 256.0f) + LN_EPS);
#pragma unroll 2
            for (int q = 0; q < 8; ++q) { float t8[8]; unpack8(*(const v4u*)(vp + 8 * q), t8);
                v4u w; w.x = cvtpk((t8[0] - mu) * rs, (t8[1] - mu) * rs); w.y = cvtpk((t8[2] - mu) * rs, (t8[3] - mu) * rs); w.z = cvtpk((t8[4] - mu) * rs, (t8[5] - mu) * rs); w.w = cvtpk((t8[6] - mu) * rs, (t8[7] - mu) * rs);
                *(LAS v4u*)(lds + part * 16384 + tro(i, q * 16)) = w; }
        }
        __syncthreads();
        {
            LANEC;
            const int g = wave >> 1, ph = wave & 1;
            const LAS unsigned char* vn = lds + g * 16384;
            f32x16 acc[2][2];
#pragma unroll
            for (int ct = 0; ct < 2; ++ct)
#pragma unroll
                for (int pt = 0; pt < 2; ++pt)
#pragma unroll
                    for (int r = 0; r < 16; ++r) acc[ct][pt][r] = 0.f;
#pragma unroll 2
            for (int ks = 0; ks < 8; ++ks) {
                const int rlo = 16 * ks + 8 * hf + q4;
                bf16x8 A[2], B[2];
#pragma unroll
                for (int ct = 0; ct < 2; ++ct) A[ct] = tr_frag(vn, rlo, rlo + 4, (ct * 32 + 16 * blk + 4 * p4) * 2);
#pragma unroll
                for (int pt = 0; pt < 2; ++pt) { const float* wp = sguw + ((size_t)g * 128 + ph * 64 + pt * 32 + r32) * 128 + 16 * ks + 8 * hf; B[pt] = f32x8_to_frag(*(const f32x4*)wp, *(const f32x4*)(wp + 4)); }
#pragma unroll
                for (int ct = 0; ct < 2; ++ct)
#pragma unroll
                    for (int pt = 0; pt < 2; ++pt) acc[ct][pt] = MFMA32(A[ct], B[pt], acc[ct][pt]);
            }
#pragma unroll
            for (int pt = 0; pt < 2; ++pt) {
                const int p = ph * 64 + pt * 32 + r32; const int row = row0 + p; const float bias = sgub[g * 128 + p];
#pragma unroll
                for (int ct = 0; ct < 2; ++ct)
#pragma unroll
                    for (int g4 = 0; g4 < 4; ++g4) { const int c0 = ct * 32 + 8 * g4 + 4 * hf;
                        const v2u uw = *(const v2u*)(P + (size_t)row * INC + OFF_U + g * 64 + c0);
                        v2u w; w.x = cvtpk(bflo(uw.x) * (acc[ct][pt][4 * g4] + bias), bfhi(uw.x) * (acc[ct][pt][4 * g4 + 1] + bias));
                        w.y = cvtpk(bflo(uw.y) * (acc[ct][pt][4 * g4 + 2] + bias), bfhi(uw.y) * (acc[ct][pt][4 * g4 + 3] + bias));
                        *(v2u*)(Y + (size_t)row * 1024 + 768 + g * 64 + c0) = w; }
            }
        }
        }
#endif
        __syncthreads();
        if (tid == 0) dqw[0] = nxt;
        __syncthreads();
        item = __builtin_amdgcn_readfirstlane(dqw[0]);
    }
}

__device__ __forceinline__ void phase_f2(const Args& a, int l, LAS unsigned char* lds, int tid, int lane, int wave) {
    LAS int* lcnt = (LAS int*)(lds + LCNT_OFF); LAS float* LG = (LAS float*)(lds + LG_OFF);
    LAS unsigned char* HI = lds; LAS unsigned char* LO = lds + 65536; LAS float* PART = (LAS float*)lds;
    const int r32 = lane & 31, hf = lane >> 5;
    const int nrows = l == 0 ? NROWS : NLAT, ntiles = nrows >> 5;
    const float* mod = (const float*)(a.ws + WS_MOD) + l * 9 * 6144;
    const float* lng = a.in[13] + l * 1024; const float* lnb = a.in[14] + l * 1024;
    const float* rgb = a.in[16] + l * 4; const float* reb = a.in[18] + l * 32;
    bf16* Hb = (bf16*)(a.ws + WS_HB); unsigned* tok = (unsigned*)(a.ws + WS_TOK); float* xctx = (float*)(a.ws + WS_XCTX); const bf16* YO = (const bf16*)(a.ws + WS_YO);
    const bf16* wr = (const bf16*)(a.ws + WS_WR) + (size_t)l * 2 * 64 * 1024;
    bf16x8 Bh[8][2];
#pragma unroll
    for (int ks = 0; ks < 8; ++ks)
#pragma unroll
        for (int ct = 0; ct < 2; ++ct) { const bf16* p = wr + (size_t)(ct * 32 + r32) * 1024 + wave * 128 + 16 * ks + 8 * hf; Bh[ks][ct] = *(const bf16x8*)p; }
    __syncthreads();
    if (tid < 32) lcnt[tid] = 0;
    __syncthreads();
    for (int T = blockIdx.x; T < ntiles; T += gridDim.x) {
#pragma unroll 1
        for (int rh = 0; rh < 2; ++rh) {
        f32x4 vv[2][4];
#pragma unroll
        for (int rq = 0; rq < 2; ++rq) { const int row = 32 * T + 4 * wave + 2 * rh + rq;
            const float* xin = l == 0 ? (row < NLAT ? a.in[0] + (size_t)row * 1024 : a.in[2] + (size_t)(row - NLAT) * 1024)
                                      : (row < NLAT ? a.out + (size_t)row * 1024 : xctx + (size_t)(row - NLAT) * 1024);
            const float* g1p = mod + (row < NLAT ? (row >> 12) : 8) * 6144 + 2048;
#pragma unroll
            for (int j = 0; j < 4; ++j) { const int idx = (lane + 64 * j) * 4; const v2u yw = *(const v2u*)(YO + (size_t)row * 1024 + idx);
                vv[rq][j] = *(const f32x4*)(xin + idx) * ALPHA + *(const f32x4*)(g1p + idx) * (f32x4){bflo(yw.x), bfhi(yw.x), bflo(yw.y), bfhi(yw.y)}; } }
#pragma unroll
        for (int rq = 0; rq < 2; ++rq) {
            const int lr = 4 * wave + 2 * rh + rq, row = 32 * T + lr;
            float* xr = row < NLAT ? a.out + (size_t)row * 1024 : xctx + (size_t)(row - NLAT) * 1024;
            const float* m0 = mod + (row < NLAT ? (row >> 12) : 8) * 6144;
            f32x4 v[4]; float s = 0.f;
#pragma unroll
            for (int j = 0; j < 4; ++j) { v[j] = vv[rq][j]; s += (v[j].x + v[j].y) + (v[j].z + v[j].w); }
            const float mean = wave_sum(s) * (1.0f / 1024.0f); float s2 = 0.f;
#pragma unroll
            for (int j = 0; j < 4; ++j) { v[j] = v[j] - mean; s2 += (v[j].x * v[j].x + v[j].y * v[j].y) + (v[j].z * v[j].z + v[j].w * v[j].w); }
            const float rstd = 1.0f / sqrtf(wave_sum(s2) * (1.0f / 1024.0f) + LN_EPS);
#pragma unroll
            for (int j = 0; j < 4; ++j) { const int idx = (lane + 64 * j) * 4;
                const f32x4 x1 = v[j] * rstd * *(const f32x4*)(lng + idx) + *(const f32x4*)(lnb + idx);
                *(f32x4*)(xr + idx) = x1;
                const f32x4 hm = x1 * (*(const f32x4*)(m0 + 4096 + idx) + 1.0f) + *(const f32x4*)(m0 + 3072 + idx);
                v2u h; h.x = cvtpk(hm.x, hm.y); h.y = cvtpk(hm.z, hm.w);
                v2u lo; lo.x = cvtpk(hm.x - bflo(h.x), hm.y - bfhi(h.x)); lo.y = cvtpk(hm.z - bflo(h.y), hm.w - bfhi(h.y));
                *(v2u*)(Hb + (size_t)row * 1024 + idx) = h;
                const int off = lr * 2048 + (((((lane + 64 * j) >> 1)) ^ (lr & 15)) << 4) + (lane & 1) * 8;
                *(LAS v2u*)(HI + off) = h; *(LAS v2u*)(LO + off) = lo; }
        }
        }
        __syncthreads();
        f32x16 acc[2];
#pragma unroll
        for (int r = 0; r < 16; ++r) { acc[0][r] = 0.f; acc[1][r] = 0.f; }
#pragma unroll
        for (int ks = 0; ks < 8; ++ks) { const int off = r32 * 2048 + (((wave * 16 + 2 * ks + hf) ^ (r32 & 15)) << 4);
            const bf16x8 Ah = *(const LAS bf16x8*)(HI + off), Al = *(const LAS bf16x8*)(LO + off);
#pragma unroll
            for (int ct = 0; ct < 2; ++ct) { const bf16x8 Bl = *(const bf16x8*)(wr + (size_t)(64 + ct * 32 + r32) * 1024 + wave * 128 + 16 * ks + 8 * hf);
                acc[ct] = MFMA32(Ah, Bh[ks][ct], acc[ct]); acc[ct] = MFMA32(Ah, Bl, acc[ct]); acc[ct] = MFMA32(Al, Bh[ks][ct], acc[ct]); } }
        __syncthreads();
#pragma unroll
        for (int ct = 0; ct < 2; ++ct)
#pragma unroll
            for (int r = 0; r < 16; ++r) PART[(wave * 32 + crow(r, hf)) * 64 + ct * 32 + r32] = acc[ct][r];
        __syncthreads();
        { const int row = tid >> 4, cg = tid & 15;
#pragma unroll
          for (int q = 0; q < 3; ++q) { const int col = cg + 16 * q; if (col < 36) { float sum = 0.f;
#pragma unroll
                  for (int w = 0; w < 8; ++w) sum += PART[(w * 32 + row) * 64 + col];
                  LG[row * 40 + col] = sum; } } }
        __syncthreads();
        if (tid < 32) { const int row = 32 * T + tid; const LAS float* lgp = LG + tid * 40;
            float lg[4];
#pragma unroll
            for (int g = 0; g < 4; ++g) lg[g] = lgp[g] + rgb[g];
            int gi = 0; float gm = lg[0];
#pragma unroll
            for (int g = 1; g < 4; ++g) if (lg[g] > gm) { gm = lg[g]; gi = g; }
            float gden = 0.f;
#pragma unroll
            for (int g = 0; g < 4; ++g) gden += expf(lg[g] - gm);
            const float gprob = 1.0f / gden;
            float le[8];
#pragma unroll
            for (int e = 0; e < 8; ++e) le[e] = lgp[4 + gi * 8 + e] + reb[gi * 8 + e];
            int i1 = 0; float m1 = le[0];
#pragma unroll
            for (int e = 1; e < 8; ++e) if (le[e] > m1) { m1 = le[e]; i1 = e; }
            int i2 = -1; float m2 = -3.0e38f;
#pragma unroll
            for (int e = 0; e < 8; ++e) if (e != i1 && le[e] > m2) { m2 = le[e]; i2 = e; }
            const float p2 = expf(m2 - m1), inv = 1.0f / (1.0f + p2);
            const float gate0 = gprob * inv, gate1 = gprob * p2 * inv;
            const int e0 = gi * 8 + i1, e1 = gi * 8 + i2;
            const int p0 = __hip_atomic_fetch_add(lcnt + e0, 1, __ATOMIC_RELAXED, __HIP_MEMORY_SCOPE_WORKGROUP);
            const int p1 = __hip_atomic_fetch_add(lcnt + e1, 1, __ATOMIC_RELAXED, __HIP_MEMORY_SCOPE_WORKGROUP);
            unsigned* t = tok + (size_t)row * 8; t[0] = (unsigned)e0 | ((unsigned)e1 << 8); t[1] = (unsigned)p0; t[2] = (unsigned)p1;
            t[4] = __builtin_bit_cast(unsigned, gate0); t[5] = __builtin_bit_cast(unsigned, gate1); }
    }
    __syncthreads();
    if (tid < 32) ((unsigned*)(a.ws + WS_CTL))[CW_WGCNT + (l * 256 + blockIdx.x) * 32 + tid] = (unsigned)lcnt[tid];
    __syncthreads();
}
#ifndef MK_PER_PHASE
#define MK_PER_PHASE 0
#endif
constexpr int N_PHASES = 22;

__global__ void __launch_bounds__(NTHR, 2) hybrid_fwd(Args args) {
    extern __shared__ __attribute__((aligned(16))) unsigned char lds_raw[];
    LAS unsigned char* lds = (LAS unsigned char*)lds_raw;
    const int tid0 = threadIdx.x;
    for (int u = tid0; u < (LDS_BYTES - LDSCTL_OFF) / 4; u += NTHR) ((LAS unsigned*)(lds + LDSCTL_OFF))[u] = 0u;
#define TIDS int tid = threadIdx.x; asm volatile("" : "+v"(tid)); const int lane = tid & 63, wave = __builtin_amdgcn_readfirstlane(tid >> 6); (void)lane; (void)wave
    __syncthreads();
    unsigned* ctl = (unsigned*)(args.ws + WS_CTL);
    XcdBarrier bar; bar.bar = ctl + CW_BAR; bar.x = 0; bar.st = nullptr;
    if (!MK_PER_PHASE) bar = xcd_barrier_post(ctl + CW_BAR, (volatile LAS unsigned*)(lds + MISC_OFF + 32));
    const int lo = args.ph_lo, hi = args.ph_hi;
#ifndef PHMASK
#define PHMASK 0xFFFFFFu
#endif
#define PHON(k) (((PHMASK) >> ((k) < 2 ? (k) : 2 + ((k) - 2) % 10)) & 1u)
#define IN(k) (PHON(k) && lo <= (k) && (k) < hi)
#ifndef REPMASK
#define REPMASK 0u
#endif
#define NREP(k) (1 + (int)(((REPMASK) >> ((k) < 2 ? (k) : 2 + ((k) - 2) % 10)) & 1u))
#define SEAM(k) do { if (IN(k) && IN((k) + 1)) xcd_barrier(bar); } while (0)

    if (IN(0)) for (int rep = 0; rep < NREP(0); ++rep) { TIDS; phase_p0(args, lds, tid, lane, wave); }
    SEAM(0);
    if (IN(1)) for (int rep = 0; rep < NREP(1); ++rep) { TIDS; phase_p1(args, lane, wave); }
    SEAM(1);
    for (int l = 0; l < 2; ++l) {
        const int pb = 2 + 10 * l;
        bf16* Hb = (bf16*)(args.ws + WS_HB);
        if (IN(pb + 0)) for (int rep = 0; rep < NREP(2); ++rep) {
            pg8::Gemm g{Hb, (const bf16*)(args.ws + WS_WIN) + (size_t)l * INC * 1024, NROWS, INC, 1024}; pg8::StaticOrder S; S.init(NROWS, INC, (int)gridDim.x, (int)blockIdx.x);
            pg8::EpiBf16<0> E{(bf16*)(args.ws + WS_P), INC, nullptr, 0, 0, 1.0f};
            pg8::gemm_phase<pg8::EpiBf16<0>, pg8::StaticOrder, true, true>(lds, g, S, E);
        }
        SEAM(pb + 0);
        if (IN(pb + 1)) for (int rep = 0; rep < NREP(3); ++rep) { TIDS; phase_b_mfma(args, l, lds, tid, lane, wave); }
        SEAM(pb + 1);
        if (IN(pb + 2)) { TIDS; phase_c(args, l, tid); }
        SEAM(pb + 2);
        if (IN(pb + 3)) for (int rep = 0; rep < NREP(5); ++rep) { TIDS; phase_d_mfma(args, l, lds, tid, lane, wave); }
        SEAM(pb + 3);
        if (IN(pb + 4)) for (int rep = 0; rep < (l == 0 ? NREP(6) : 1); ++rep) {
            const int M = l == 0 ? NROWS : NLAT;
            pg8::Gemm g{(const bf16*)(args.ws + WS_YMIX), (const bf16*)(args.ws + WS_WOUT) + (size_t)l * 1024 * 1024, M, 1024, 1024}; pg8::StaticOrder S; S.init(M, 1024, (int)gridDim.x, (int)blockIdx.x);
            pg8::EpiBf16<0> E{(bf16*)(args.ws + WS_YO), 1024, nullptr, 0, 0, 1.0f};
            pg8::gemm_phase<pg8::EpiBf16<0>, pg8::StaticOrder, true, true>(lds, g, S, E);
        }
        SEAM(pb + 4);
        if (IN(pb + 5)) { TIDS; phase_f2(args, l, lds, tid, lane, wave); }
        SEAM(pb + 5);
        if (IN(pb + 6)) for (int rep = 0; rep < NREP(8); ++rep) { TIDS; phase_g(args, l, lds, tid, lane, wave); }
        SEAM(pb + 6);
        if (IN(pb + 7)) for (int rep = 0; rep < NREP(9); ++rep) {
            int npan; { TIDS; npan = build_p2e(args, l, lds, tid); }
            pg8::Gemm g{Hb, (const bf16*)(args.ws + WS_WGU) + (size_t)l * 32 * 1024 * 1024, npan * 256, 1024, 1024};
            LAS int* arows = (LAS int*)(lds + AROWS_OFF);
            { TIDS; const int* rowof = (const int*)(args.ws + WS_ROWOF);
              for (int i = 0; i < 6; ++i) { const int L = i * (int)gridDim.x + (int)blockIdx.x; if (L < npan * 4 && tid < 256) arows[i * 256 + tid] = rowof[(L >> 2) * 256 + tid]; }
              __syncthreads(); }
            pg8::MoeOrder S{(const LAS unsigned char*)(lds + P2E_OFF), npan * 4, (int)gridDim.x, (int)blockIdx.x, arows};
            pg8::EpiGLU E{(bf16*)(args.ws + WS_HH)};
            pg8::gemm_phase_gather<pg8::EpiGLU, pg8::MoeOrder>(lds, g, S, E);
        }
        SEAM(pb + 7);
        if (IN(pb + 8)) for (int rep = 0; rep < NREP(10); ++rep) {
            int npan; { TIDS; npan = build_p2e(args, l, lds, tid); }
            pg8::Gemm g{(const bf16*)(args.ws + WS_HH), (const bf16*)(args.ws + WS_WD) + (size_t)l * 32 * 1024 * 512, npan * 256, 1024, 512};
            pg8::MoeOrder S{(const LAS unsigned char*)(lds + P2E_OFF), npan * 4, (int)gridDim.x, (int)blockIdx.x, nullptr};
            pg8::EpiY E{(bf16*)(args.ws + WS_Y)};
            pg8::gemm_phase<pg8::EpiY, pg8::MoeOrder, true, true>(lds, g, S, E);
        }
        SEAM(pb + 8);
        if (IN(pb + 9)) { if (NREP(11) > 1) { TIDS; phase_j(args, l, lane, wave, true); } TIDS; phase_j(args, l, lane, wave); }
        SEAM(pb + 9);
    }
#undef IN
#undef SEAM
}

extern "C" void kernel_launch(void* const* d_in, const int* in_sizes, int n_in, void* d_out, int out_size, void* d_ws, size_t ws_size, hipStream_t stream) {
    static int grid = 0;
    if (grid == 0) {
        if (n_in != 24 || in_sizes[0] != NLAT * DM || out_size != NLAT * DM || ws_size < WS_END) { fprintf(stderr, "kernel_launch: unexpected problem (n_in %d, ws %zu < %zu?)\n", n_in, ws_size, (size_t)WS_END); grid = -1; return; }
        int dev = 0, cus = 0, per_cu = 0;
        if (hipGetDevice(&dev) != hipSuccess || hipDeviceGetAttribute(&cus, hipDeviceAttributeMultiprocessorCount, dev) != hipSuccess) { grid = -1; return; }
        if (hipFuncSetAttribute((const void*)hybrid_fwd, hipFuncAttributeMaxDynamicSharedMemorySize, LDS_BYTES) != hipSuccess) { grid = -1; return; }
        if (hipOccupancyMaxActiveBlocksPerMultiprocessor(&per_cu, (const void*)hybrid_fwd, NTHR, LDS_BYTES) != hipSuccess || per_cu < 1) { fprintf(stderr, "kernel_launch: occupancy query says %d\n", per_cu); }
        (void)hipGetLastError();
        grid = cus;
        if (grid != 256) { fprintf(stderr, "kernel_launch: built for 256 CUs, device has %d\n", cus); grid = -1; return; }
    }
    if (grid < 0) return;
    if (hipMemsetAsync((char*)d_ws + WS_CTL, 0, CTL_ZERO_BYTES, stream) != hipSuccess) return;
    Args a{};
    for (int i = 0; i < 24; ++i) a.in[i] = (const float*)d_in[i];
    a.out = (float*)d_out; a.ws = (unsigned char*)d_ws;
#if MK_PER_PHASE
    for (int p = 0; p < N_PHASES; ++p) { a.ph_lo = p; a.ph_hi = p + 1; hipLaunchKernelGGL(hybrid_fwd, dim3(grid), dim3(NTHR), LDS_BYTES, stream, a); }
#else
    a.ph_lo = 0; a.ph_hi = N_PHASES;
    hipLaunchKernelGGL(hybrid_fwd, dim3(grid), dim3(NTHR), LDS_BYTES, stream, a);
#endif
}
```

```cpp
#include <hip/hip_runtime.h>
#include <cstdio>
#include <cstdint>
#include <cstddef>
namespace pg8 {
#define PG8_LAS __attribute__((address_space(3)))
typedef unsigned short bf16_t;
typedef short bf16x8 __attribute__((ext_vector_type(8)));
typedef float f32x4 __attribute__((ext_vector_type(4)));
typedef unsigned u32x4 __attribute__((ext_vector_type(4)));
constexpr int BM = 256, BK = 64, HALF = 128, HTB = HALF * BK * 2  , STAGE_BYTES = 8 * HTB, NXCD = 8, WGM = 8;

__host__ __device__ __forceinline__ int lds_byte(int r, int c) { const int st = (r >> 4) * 2 + (c >> 5), rr = r & 15, cc = c & 31, ob = rr * 64 + cc * 2; return st * 1024 + (ob ^ (((ob >> 9) & 1) << 5)); }
__host__ __device__ __forceinline__ void stage_rc(int b, int& R, int& C) { const int st = b / 1024, sb = b % 1024, swz = sb ^ (((sb >> 9) & 1) << 5); R = (st >> 1) * 16 + swz / 64; C = (st & 1) * 32 + (swz % 64) / 2; }
__host__ __device__ __forceinline__ int perm32(int rho) { const int n = rho >> 4, i = rho & 15; return 8 * (i >> 2) + 4 * n + (i & 3); }

struct Unit { int pm, pn; };
struct Gemm { const bf16_t* A; const bf16_t* Bt; int M, N, K; };

struct StaticOrder {
    int nM, nN, nwg, G, c;
    __host__ __device__ void init(int M, int N, int G_, int c_) { nM = M / BM; nN = N / BM; nwg = nM * nN; G = G_; c = c_; }
    __host__ __device__ bool next(int i, Unit& u) const {
        const long L = (long)i * G + c; if (L >= nwg) return false;
        int wgid = (int)L; { const int q = nwg / NXCD, r = nwg % NXCD, xcd = wgid % NXCD, off = wgid / NXCD; wgid = (xcd < r ? xcd * (q + 1) : r * (q + 1) + (xcd - r) * q) + off; }
        const int nig = WGM * nN, gid = wgid / nig, fm = gid * WGM, gsz = (nM - fm) < WGM ? (nM - fm) : WGM;
        u.pm = fm + ((wgid % nig) % gsz); u.pn = (wgid % nig) / gsz; return true;
    }
    __device__ __forceinline__ void a_ready(const Unit&) const {}
    __device__ __forceinline__ void done(const Unit&) const {}
};

__device__ __forceinline__ unsigned cvt_pk_bf16(float lo, float hi) { unsigned r; asm volatile("v_cvt_pk_bf16_f32 %0, %1, %2" : "=v"(r) : "v"(lo), "v"(hi)); return r; }
typedef float f32x2 __attribute__((ext_vector_type(2)));
__device__ __forceinline__ f32x2 gelu_pk(f32x2 v) {
    const f32x2 av = __builtin_elementwise_abs(v), d = av * 0.2316418882f + 1.0f;
    f32x2 t; t.x = __builtin_amdgcn_rcpf(d.x); t.y = __builtin_amdgcn_rcpf(d.y);
    f32x2 q = t * 0.5307027145f + (-0.7265760135f); q = q * t + 0.7107068705f; q = q * t + (-0.142248368f); q = q * t + 0.127414796f; q = q * t;
    const f32x2 s = (v * v) * (-0.72134752044f);
    f32x2 e; e.x = __builtin_amdgcn_exp2f(s.x); e.y = __builtin_amdgcn_exp2f(s.y);
    const f32x2 m = v * (q * e), r = v - m;
    f32x2 o; o.x = v.x < 0.f ? m.x : r.x; o.y = v.y < 0.f ? m.y : r.y; return o;
}

template <int ACT  > struct EpiBf16 {
    static constexpr bool PERM = true, AFTER_DRAIN = false; static_assert(ACT == 0 || ACT == 1, "EpiBf16: ACT is 0 (none) or 1 (gelu_pk)");
    bf16_t* O; int ldc; const float* bias; int split_cols; size_t split_stride; float scale0;
    __device__ __forceinline__ void operator()(const f32x4 (&acc)[2][2][4][2], const Unit& u, int wr, int wc, int fr, int fq) const {
        const int row0 = u.pm * BM + wr * 64 + fr; int colt = u.pn * BM; bf16_t* base = O;
        float sc = 1.f; if (split_cols) { const int t = colt / split_cols; base += (size_t)t * split_stride; colt -= t * split_cols; if (t == 0) sc = scale0; }
        const int col0 = colt + wc * 32 + 8 * fq, bcol0 = u.pn * BM + wc * 32 + 8 * fq;
        f32x4 bv[2][2];
#pragma unroll
        for (int bj = 0; bj < 2; ++bj)
#pragma unroll
            for (int n = 0; n < 2; ++n) bv[bj][n] = bias ? *(const f32x4*)(bias + bcol0 + bj * HALF + 4 * n) : (f32x4){0.f, 0.f, 0.f, 0.f};
#pragma unroll
        for (int ai = 0; ai < 2; ++ai)
#pragma unroll
            for (int m = 0; m < 4; ++m) { bf16_t* rowp = base + (size_t)(row0 + ai * HALF + m * 16) * ldc + col0;
#pragma unroll
                for (int bj = 0; bj < 2; ++bj) { f32x4 v0 = acc[ai][bj][m][0] + bv[bj][0], v1 = acc[ai][bj][m][1] + bv[bj][1];
                    if (ACT == 1) { f32x2 a = gelu_pk((f32x2){v0[0], v0[1]}), b = gelu_pk((f32x2){v0[2], v0[3]}), c = gelu_pk((f32x2){v1[0], v1[1]}), d = gelu_pk((f32x2){v1[2], v1[3]});
                        v0 = (f32x4){a.x, a.y, b.x, b.y}; v1 = (f32x4){c.x, c.y, d.x, d.y}; }
                    v0 = v0 * sc; v1 = v1 * sc; u32x4 w; w.x = cvt_pk_bf16(v0[0], v0[1]); w.y = cvt_pk_bf16(v0[2], v0[3]); w.z = cvt_pk_bf16(v1[0], v1[1]); w.w = cvt_pk_bf16(v1[2], v1[3]);
                    *(u32x4*)(rowp + bj * HALF) = w; } }
    }
};
__device__ __forceinline__ float silu_f(float x) { return x / (1.0f + __expf(-x)); }
struct EpiResid {
    static constexpr bool PERM = false, AFTER_DRAIN = false;
    const float* xin_lat; const float* xin_ctx; float* xo_lat; float* xo_ctx; const float* mod; float alpha;
    __device__ __forceinline__ void operator()(const f32x4 (&acc)[2][2][4][2], const Unit& u, int wr, int wc, int fr, int fq) const {
        const int prow0 = u.pm * BM; const bool isc = prow0 >= 32768;
        const float* xin = isc ? xin_ctx + (size_t)(prow0 - 32768) * 1024 : xin_lat + (size_t)prow0 * 1024;
        float* xo = isc ? xo_ctx + (size_t)(prow0 - 32768) * 1024 : xo_lat + (size_t)prow0 * 1024;
        const float* g1 = mod + (isc ? 8 : (prow0 >> 12)) * 6144 + 2048;
        const int col0 = u.pn * BM + wc * 32 + 4 * fq;
        f32x4 gv[2][2];
#pragma unroll
        for (int bj = 0; bj < 2; ++bj)
#pragma unroll
            for (int n = 0; n < 2; ++n) gv[bj][n] = *(const f32x4*)(g1 + col0 + bj * HALF + n * 16);
#pragma unroll
        for (int ai = 0; ai < 2; ++ai)
#pragma unroll
            for (int m = 0; m < 4; ++m) { const size_t off = (size_t)(ai * HALF + wr * 64 + m * 16 + fr) * 1024 + col0;
#pragma unroll
                for (int bj = 0; bj < 2; ++bj)
#pragma unroll
                    for (int n = 0; n < 2; ++n) { const f32x4 xv = *(const f32x4*)(xin + off + bj * HALF + n * 16);
                        *(f32x4*)(xo + off + bj * HALF + n * 16) = xv * alpha + gv[bj][n] * acc[ai][bj][m][n]; }
                if (m & 1) asm volatile("" ::: "memory"); }
    }
};
struct EpiGLU {
    static constexpr bool PERM = true, AFTER_DRAIN = false;
    bf16_t* Hh;
    __device__ __forceinline__ void operator()(const f32x4 (&acc)[2][2][4][2], const Unit& u, int wr, int wc, int fr, int fq) const {
        const int row0 = u.pm * BM + wr * 64 + fr; const int col0 = (u.pn & 3) * 128 + wc * 32 + 8 * fq;
#pragma unroll
        for (int ai = 0; ai < 2; ++ai)
#pragma unroll
            for (int m = 0; m < 4; ++m) { bf16_t* rowp = Hh + (size_t)(row0 + ai * HALF + m * 16) * 512 + col0;
                const f32x4 g0 = acc[ai][0][m][0], g1 = acc[ai][0][m][1], u0 = acc[ai][1][m][0], u1 = acc[ai][1][m][1];
                u32x4 w; w.x = cvt_pk_bf16(silu_f(g0[0]) * u0[0], silu_f(g0[1]) * u0[1]); w.y = cvt_pk_bf16(silu_f(g0[2]) * u0[2], silu_f(g0[3]) * u0[3]);
                w.z = cvt_pk_bf16(silu_f(g1[0]) * u1[0], silu_f(g1[1]) * u1[1]); w.w = cvt_pk_bf16(silu_f(g1[2]) * u1[2], silu_f(g1[3]) * u1[3]);
                *(u32x4*)rowp = w; }
    }
};
struct EpiY {
    static constexpr bool PERM = true, AFTER_DRAIN = false;
    bf16_t* O;
    __device__ __forceinline__ void operator()(const f32x4 (&acc)[2][2][4][2], const Unit& u, int wr, int wc, int fr, int fq) const {
        const int row0 = u.pm * BM + wr * 64 + fr; const int col0 = (u.pn & 3) * BM + wc * 32 + 8 * fq;
#pragma unroll
        for (int ai = 0; ai < 2; ++ai)
#pragma unroll
            for (int m = 0; m < 4; ++m) { bf16_t* rowp = O + (size_t)(row0 + ai * HALF + m * 16) * 1024 + col0;
#pragma unroll
                for (int bj = 0; bj < 2; ++bj) { const f32x4 v0 = acc[ai][bj][m][0], v1 = acc[ai][bj][m][1];
                    u32x4 w; w.x = cvt_pk_bf16(v0[0], v0[1]); w.y = cvt_pk_bf16(v0[2], v0[3]); w.z = cvt_pk_bf16(v1[0], v1[1]); w.w = cvt_pk_bf16(v1[2], v1[3]);
                    *(u32x4*)(rowp + bj * HALF) = w; } }
    }
};
struct MoeOrder {
    const PG8_LAS unsigned char* p2e; int nunits, G, c; const PG8_LAS int* rows;
    __device__ __forceinline__ const PG8_LAS int* arows(int i) const { return rows + i * 256; }
    __device__ __forceinline__ bool next(int i, Unit& u) const {
        const int L = i * G + c; if (L >= nunits) return false;
        u.pm = L >> 2; u.pn = (int)p2e[L >> 2] * 4 + (L & 3); return true;
    }
    __device__ __forceinline__ void a_ready(const Unit&) const {}
    __device__ __forceinline__ void done(const Unit&) const {}
};
template <class Epi, class Sched, bool ALIGN_EPI = false, bool SP2 = false>
__device__ __forceinline__ void gemm_phase(PG8_LAS unsigned char* lds, const Gemm g, const Sched& S, const Epi& E) {
    int tid_ = threadIdx.x; asm volatile("" : "+v"(tid_));
    const int tid = tid_, wid = __builtin_amdgcn_readfirstlane(tid >> 6), lane = tid & 63, wr = wid >> 2, wc = wid & 3, fr = lane & 15, fq = lane >> 4;
    const int K = g.K, nt = K / BK;
    unsigned voffA[2], voffB[2];
#pragma unroll
    for (int i = 0; i < 2; ++i) { int R, C; stage_rc(tid * 16 + i * 8192, R, C); const int Rb = Epi::PERM ? ((R & ~31) + perm32(R & 31)) : R;
        voffA[i] = (unsigned)(R * K + C) * 2u; voffB[i] = (unsigned)(Rb * K + C) * 2u; }
    const size_t kstep = (size_t)(BK * 2);
    const size_t hstep = (size_t)HALF * K * 2;
    const size_t tstep = 2 * hstep;
    const unsigned ldsw = (unsigned)wid * 1024u;
    const int aoff = lds_byte(wr * 64 + fr, fq * 8), boff = lds_byte(wc * 32 + fr, fq * 8);
#define PG8_SA(b, h) (((b) * 2 + (h)) * HTB)
#define PG8_SB(b, h) ((4 + (b) * 2 + (h)) * HTB)
#define PG8_STAGE(bufoff, gbase, voff) do { _Pragma("unroll") for (int _i = 0; _i < 2; ++_i) \
        __builtin_amdgcn_global_load_lds((const unsigned*)((const char*)(gbase) + (voff)[_i]), (PG8_LAS unsigned*)(lds + (bufoff) + ldsw + _i * 8192), 16, 0, 0); } while (0)
#define PG8_LDA(dst, b, h) do { _Pragma("unroll") for (int m = 0; m < 4; ++m) _Pragma("unroll") for (int k = 0; k < 2; ++k) dst[m][k] = *(const PG8_LAS bf16x8*)(lds + PG8_SA(b, h) + aoff + m * 2048 + k * 1024); } while (0)
#define PG8_LDB(dst, b, h) do { _Pragma("unroll") for (int n = 0; n < 2; ++n) _Pragma("unroll") for (int k = 0; k < 2; ++k) dst[n][k] = *(const PG8_LAS bf16x8*)(lds + PG8_SB(b, h) + boff + n * 2048 + k * 1024); } while (0)
#define PG8_MMA(ai, bj, At, Bt) do { __builtin_amdgcn_s_setprio(1); _Pragma("unroll") for (int m = 0; m < 4; ++m) _Pragma("unroll") for (int n = 0; n < 2; ++n) _Pragma("unroll") for (int k = 0; k < 2; ++k) \
        acc[ai][bj][m][n] = __builtin_amdgcn_mfma_f32_16x16x32_bf16(Bt[n][k], At[m][k], acc[ai][bj][m][n], 0, 0, 0); __builtin_amdgcn_s_setprio(0); } while (0)
#define PG8_WAIT_V(n) asm volatile("s_waitcnt vmcnt(" #n ")" ::: "memory")
#define PG8_WAIT_L(n) asm volatile("s_waitcnt lgkmcnt(" #n ")" ::: "memory")
#define PG8_BAR __builtin_amdgcn_s_barrier()
#define PG8_SCHED __builtin_amdgcn_sched_barrier(0)
    Unit cur, nxt; int ui = 0;
    if (!S.next(0, cur)) return;
    f32x4 acc[2][2][4][2];
#pragma unroll
    for (int a = 0; a < 2; ++a)
#pragma unroll
        for (int b = 0; b < 2; ++b)
#pragma unroll
            for (int m = 0; m < 4; ++m)
#pragma unroll
                for (int n = 0; n < 2; ++n) acc[a][b][m][n] = (f32x4){0.f, 0.f, 0.f, 0.f};
    bf16x8 At[4][2], B0[2][2], B1[2][2];
    const char* cA = (const char*)g.A + (size_t)cur.pm * tstep; const char* cB = (const char*)g.Bt + (size_t)cur.pn * tstep;
    S.a_ready(cur);
    if constexpr (SP2) {
        PG8_STAGE(PG8_SB(0, 0), cB, voffB); PG8_STAGE(PG8_SB(0, 1), cB + hstep, voffB); PG8_STAGE(PG8_SA(0, 0), cA, voffA); PG8_STAGE(PG8_SA(0, 1), cA + hstep, voffA);
        if (wr == 1) PG8_BAR;
        PG8_WAIT_V(2); PG8_BAR;
        PG8_STAGE(PG8_SB(1, 0), cB + kstep, voffB); PG8_STAGE(PG8_SA(1, 0), cA + kstep, voffA); PG8_STAGE(PG8_SB(1, 1), cB + hstep + kstep, voffB);
        PG8_WAIT_V(6); PG8_BAR;
    } else {
        PG8_STAGE(PG8_SB(0, 0), cB, voffB); PG8_STAGE(PG8_SA(0, 0), cA, voffA); PG8_STAGE(PG8_SB(0, 1), cB + hstep, voffB); PG8_STAGE(PG8_SA(0, 1), cA + hstep, voffA);
        if (wr == 1) PG8_BAR;
        PG8_WAIT_V(4); PG8_BAR;
        PG8_STAGE(PG8_SB(1, 0), cB + kstep, voffB); PG8_STAGE(PG8_SA(1, 0), cA + kstep, voffA); PG8_STAGE(PG8_SB(1, 1), cB + hstep + kstep, voffB);
        PG8_WAIT_V(6); PG8_BAR;
    }
    for (;;) {
        const bool has_next = S.next(ui + 1, nxt);
        const char* nA = has_next ? (const char*)g.A + (size_t)nxt.pm * tstep : cA; const char* nB = has_next ? (const char*)g.Bt + (size_t)nxt.pn * tstep : cB;
        for (int t = 0; t < nt; t += 2) {
            const bool last = (t == nt - 2);
            const char* a1 = cA + (size_t)(t + 1) * kstep;
            const char* a2 = last ? nA : cA + (size_t)(t + 2) * kstep; const char* b2 = last ? nB : cB + (size_t)(t + 2) * kstep;
            const char* a3 = a2 + kstep; const char* b3 = b2 + kstep;
            if (last && has_next) S.a_ready(nxt);
            if constexpr (SP2) {
            PG8_LDB(B0, 0, 0); PG8_LDB(B1, 0, 1); PG8_SCHED; PG8_LDA(At, 0, 0); PG8_STAGE(PG8_SA(1, 1), a1 + hstep, voffA);
            PG8_WAIT_V(8); PG8_WAIT_L(0); PG8_BAR; PG8_MMA(0, 0, At, B0); PG8_MMA(0, 1, At, B1); PG8_BAR; PG8_SCHED;
            PG8_LDA(At, 0, 1); PG8_STAGE(PG8_SB(0, 0), b2, voffB); PG8_STAGE(PG8_SB(0, 1), b2 + hstep, voffB); PG8_STAGE(PG8_SA(0, 0), a2, voffA);
            PG8_WAIT_V(8); PG8_WAIT_L(0); PG8_BAR; PG8_MMA(1, 0, At, B0); PG8_MMA(1, 1, At, B1); PG8_BAR; PG8_SCHED;
            PG8_LDB(B0, 1, 0); PG8_LDB(B1, 1, 1); PG8_SCHED; PG8_LDA(At, 1, 0); PG8_STAGE(PG8_SA(0, 1), a2 + hstep, voffA);
            PG8_WAIT_V(8); PG8_WAIT_L(0); PG8_BAR; PG8_MMA(0, 0, At, B0); PG8_MMA(0, 1, At, B1); PG8_BAR; PG8_SCHED;
            PG8_LDA(At, 1, 1); PG8_STAGE(PG8_SB(1, 0), b3, voffB); PG8_STAGE(PG8_SB(1, 1), b3 + hstep, voffB); PG8_STAGE(PG8_SA(1, 0), a3, voffA);
            PG8_WAIT_V(8); PG8_WAIT_L(0); PG8_BAR; PG8_MMA(1, 0, At, B0); PG8_MMA(1, 1, At, B1); PG8_BAR; PG8_SCHED;
            } else {
            PG8_LDB(B0, 0, 0); PG8_SCHED; PG8_LDA(At, 0, 0); PG8_STAGE(PG8_SA(1, 1), a1 + hstep, voffA);
            PG8_WAIT_L(8); PG8_BAR; PG8_WAIT_L(0); PG8_MMA(0, 0, At, B0); PG8_BAR; PG8_SCHED;
            PG8_LDB(B1, 0, 1); PG8_STAGE(PG8_SB(0, 0), b2, voffB);
            PG8_BAR; PG8_WAIT_L(0); PG8_MMA(0, 1, At, B1); PG8_BAR;
            PG8_LDA(At, 0, 1); PG8_STAGE(PG8_SA(0, 0), a2, voffA);
            PG8_BAR; PG8_WAIT_L(0); PG8_MMA(1, 0, At, B0); PG8_BAR; PG8_SCHED;
            PG8_STAGE(PG8_SB(0, 1), b2 + hstep, voffB);
            PG8_WAIT_V(6); PG8_BAR; PG8_MMA(1, 1, At, B1); PG8_BAR;
            PG8_LDB(B0, 1, 0); PG8_SCHED; PG8_LDA(At, 1, 0); PG8_STAGE(PG8_SA(0, 1), a2 + hstep, voffA);
            PG8_WAIT_L(8); PG8_BAR; PG8_WAIT_L(0); PG8_MMA(0, 0, At, B0); PG8_BAR; PG8_SCHED;
            PG8_LDB(B1, 1, 1); PG8_STAGE(PG8_SB(1, 0), b3, voffB);
            PG8_BAR; PG8_WAIT_L(0); PG8_MMA(0, 1, At, B1); PG8_BAR;
            PG8_LDA(At, 1, 1); PG8_STAGE(PG8_SA(1, 0), a3, voffA);
            PG8_BAR; PG8_WAIT_L(0); PG8_MMA(1, 0, At, B0); PG8_BAR; PG8_SCHED;
            PG8_STAGE(PG8_SB(1, 1), b3 + hstep, voffB);
            PG8_WAIT_V(6); PG8_BAR; PG8_MMA(1, 1, At, B1); PG8_BAR;
            }
        }
        if constexpr (ALIGN_EPI) { if (wr == 0) PG8_BAR; }
        if constexpr (!Epi::AFTER_DRAIN) { E(acc, cur, wr, wc, fr, fq); S.done(cur); }
        if (!has_next) break;
#pragma unroll
        for (int a = 0; a < 2; ++a)
#pragma unroll
            for (int b = 0; b < 2; ++b)
#pragma unroll
                for (int m = 0; m < 4; ++m)
#pragma unroll
                    for (int n = 0; n < 2; ++n) acc[a][b][m][n] = (f32x4){0.f, 0.f, 0.f, 0.f};
        cur = nxt; cA = nA; cB = nB; ++ui;
        if constexpr (ALIGN_EPI) { if (wr == 1) PG8_BAR; }
    }
    PG8_WAIT_V(0);
    if constexpr (!ALIGN_EPI) { if (wr == 0) PG8_BAR; }
    PG8_BAR;
    if constexpr (Epi::AFTER_DRAIN) { E.fused(acc, cur, wr, wc, fr, fq, lds, wid, lane); S.done(cur); }
#undef PG8_SA
#undef PG8_SB
#undef PG8_STAGE
#undef PG8_LDA
#undef PG8_LDB
#undef PG8_MMA
#undef PG8_WAIT_V
#undef PG8_WAIT_L
#undef PG8_BAR
#undef PG8_SCHED
}
template <class Epi, class Sched>
__device__ __forceinline__ void gemm_phase_gather(PG8_LAS unsigned char* lds, const Gemm g, const Sched& S, const Epi& E) {
    int tid_ = threadIdx.x; asm volatile("" : "+v"(tid_));
    const int tid = tid_, wid = __builtin_amdgcn_readfirstlane(tid >> 6), lane = tid & 63, wr = wid >> 2, wc = wid & 3, fr = lane & 15, fq = lane >> 4;
    const int K = g.K, nt = K / BK;
    constexpr bool ALIGN_EPI = true, SP2 = true;
    unsigned voffB[2]; unsigned vc[2][2], vn[2][2]; int RA[2], CA[2];
#pragma unroll
    for (int i = 0; i < 2; ++i) { int R, C; stage_rc(tid * 16 + i * 8192, R, C); const int Rb = Epi::PERM ? ((R & ~31) + perm32(R & 31)) : R;
        RA[i] = R; CA[i] = C; voffB[i] = (unsigned)(Rb * K + C) * 2u; }
    const size_t kstep = (size_t)(BK * 2);
    const size_t hstep = (size_t)HALF * K * 2;
    const size_t tstep = 2 * hstep;
    const unsigned ldsw = (unsigned)wid * 1024u;
    const int aoff = lds_byte(wr * 64 + fr, fq * 8), boff = lds_byte(wc * 32 + fr, fq * 8);
#define PG8_SA(b, h) (((b) * 2 + (h)) * HTB)
#define PG8_SB(b, h) ((4 + (b) * 2 + (h)) * HTB)
#define PG8_STAGE(bufoff, gbase, voff) do { _Pragma("unroll") for (int _i = 0; _i < 2; ++_i) \
        __builtin_amdgcn_global_load_lds((const unsigned*)((const char*)(gbase) + (voff)[_i]), (PG8_LAS unsigned*)(lds + (bufoff) + ldsw + _i * 8192), 16, 0, 0); } while (0)
#define PG8_LDA(dst, b, h) do { _Pragma("unroll") for (int m = 0; m < 4; ++m) _Pragma("unroll") for (int k = 0; k < 2; ++k) dst[m][k] = *(const PG8_LAS bf16x8*)(lds + PG8_SA(b, h) + aoff + m * 2048 + k * 1024); } while (0)
#define PG8_LDB(dst, b, h) do { _Pragma("unroll") for (int n = 0; n < 2; ++n) _Pragma("unroll") for (int k = 0; k < 2; ++k) dst[n][k] = *(const PG8_LAS bf16x8*)(lds + PG8_SB(b, h) + boff + n * 2048 + k * 1024); } while (0)
#define PG8_MMA(ai, bj, At, Bt) do { __builtin_amdgcn_s_setprio(1); _Pragma("unroll") for (int m = 0; m < 4; ++m) _Pragma("unroll") for (int n = 0; n < 2; ++n) _Pragma("unroll") for (int k = 0; k < 2; ++k) \
        acc[ai][bj][m][n] = __builtin_amdgcn_mfma_f32_16x16x32_bf16(Bt[n][k], At[m][k], acc[ai][bj][m][n], 0, 0, 0); __builtin_amdgcn_s_setprio(0); } while (0)
#define PG8_WAIT_V(n) asm volatile("s_waitcnt vmcnt(" #n ")" ::: "memory")
#define PG8_WAIT_L(n) asm volatile("s_waitcnt lgkmcnt(" #n ")" ::: "memory")
#define PG8_BAR __builtin_amdgcn_s_barrier()
#define PG8_SCHED __builtin_amdgcn_sched_barrier(0)
    Unit cur, nxt; int ui = 0;
    if (!S.next(0, cur)) return;
    f32x4 acc[2][2][4][2];
#pragma unroll
    for (int a = 0; a < 2; ++a)
#pragma unroll
        for (int b = 0; b < 2; ++b)
#pragma unroll
            for (int m = 0; m < 4; ++m)
#pragma unroll
                for (int n = 0; n < 2; ++n) acc[a][b][m][n] = (f32x4){0.f, 0.f, 0.f, 0.f};
    bf16x8 At[4][2], B0[2][2], B1[2][2];
    const char* kA = (const char*)g.A; const char* cB = (const char*)g.Bt + (size_t)cur.pn * tstep;
#define PG8_ROWS(dst, tab) do { _Pragma("unroll") for (int _h = 0; _h < 2; ++_h) _Pragma("unroll") for (int _i = 0; _i < 2; ++_i) \
        dst[_h][_i] = (unsigned)((tab)[_h * HALF + RA[_i]] * K + CA[_i]) * 2u; } while (0)
    { const PG8_LAS int* tab = S.arows(0); PG8_ROWS(vc, tab); }
    S.a_ready(cur);
    if constexpr (SP2) {
        PG8_STAGE(PG8_SB(0, 0), cB, voffB); PG8_STAGE(PG8_SB(0, 1), cB + hstep, voffB); PG8_STAGE(PG8_SA(0, 0), kA, vc[0]); PG8_STAGE(PG8_SA(0, 1), kA, vc[1]);
        if (wr == 1) PG8_BAR;
        PG8_WAIT_V(2); PG8_BAR;
        PG8_STAGE(PG8_SB(1, 0), cB + kstep, voffB); PG8_STAGE(PG8_SA(1, 0), kA + kstep, vc[0]); PG8_STAGE(PG8_SB(1, 1), cB + hstep + kstep, voffB);
        PG8_WAIT_V(6); PG8_BAR;
    }
    for (;;) {
        const bool has_next = S.next(ui + 1, nxt);
        const char* nB = has_next ? (const char*)g.Bt + (size_t)nxt.pn * tstep : cB;
        if (has_next) { const PG8_LAS int* tab = S.arows(ui + 1); PG8_ROWS(vn, tab); } else { _Pragma("unroll") for (int _h = 0; _h < 2; ++_h) { vn[_h][0] = vc[_h][0]; vn[_h][1] = vc[_h][1]; } }
        for (int t = 0; t < nt; t += 2) {
            const bool last = (t == nt - 2);
            const char* a1 = kA + (size_t)(t + 1) * kstep;
            const char* a2 = last ? kA : kA + (size_t)(t + 2) * kstep; const char* b2 = last ? nB : cB + (size_t)(t + 2) * kstep;
            unsigned v0[2], v1[2]; v0[0] = last ? vn[0][0] : vc[0][0]; v0[1] = last ? vn[0][1] : vc[0][1]; v1[0] = last ? vn[1][0] : vc[1][0]; v1[1] = last ? vn[1][1] : vc[1][1];
            const char* a3 = a2 + kstep; const char* b3 = b2 + kstep;
            if (last && has_next) S.a_ready(nxt);
            if constexpr (SP2) {
            PG8_LDB(B0, 0, 0); PG8_LDB(B1, 0, 1); PG8_SCHED; PG8_LDA(At, 0, 0); PG8_STAGE(PG8_SA(1, 1), a1, vc[1]);
            PG8_WAIT_V(8); PG8_WAIT_L(0); PG8_BAR; PG8_MMA(0, 0, At, B0); PG8_MMA(0, 1, At, B1); PG8_BAR; PG8_SCHED;
            PG8_LDA(At, 0, 1); PG8_STAGE(PG8_SB(0, 0), b2, voffB); PG8_STAGE(PG8_SB(0, 1), b2 + hstep, voffB); PG8_STAGE(PG8_SA(0, 0), a2, v0);
            PG8_WAIT_V(8); PG8_WAIT_L(0); PG8_BAR; PG8_MMA(1, 0, At, B0); PG8_MMA(1, 1, At, B1); PG8_BAR; PG8_SCHED;
            PG8_LDB(B0, 1, 0); PG8_LDB(B1, 1, 1); PG8_SCHED; PG8_LDA(At, 1, 0); PG8_STAGE(PG8_SA(0, 1), a2, v1);
            PG8_WAIT_V(8); PG8_WAIT_L(0); PG8_BAR; PG8_MMA(0, 0, At, B0); PG8_MMA(0, 1, At, B1); PG8_BAR; PG8_SCHED;
            PG8_LDA(At, 1, 1); PG8_STAGE(PG8_SB(1, 0), b3, voffB); PG8_STAGE(PG8_SB(1, 1), b3 + hstep, voffB); PG8_STAGE(PG8_SA(1, 0), a3, v0);
            PG8_WAIT_V(8); PG8_WAIT_L(0); PG8_BAR; PG8_MMA(1, 0, At, B0); PG8_MMA(1, 1, At, B1); PG8_BAR; PG8_SCHED;
            }
        }
        if constexpr (ALIGN_EPI) { if (wr == 0) PG8_BAR; }
        if constexpr (!Epi::AFTER_DRAIN) { E(acc, cur, wr, wc, fr, fq); S.done(cur); }
        if (!has_next) break;
#pragma unroll
        for (int a = 0; a < 2; ++a)
#pragma unroll
            for (int b = 0; b < 2; ++b)
#pragma unroll
                for (int m = 0; m < 4; ++m)
#pragma unroll
                    for (int n = 0; n < 2; ++n) acc[a][b][m][n] = (f32x4){0.f, 0.f, 0.f, 0.f};
        cur = nxt; cB = nB; ++ui;
#pragma unroll
        for (int _h = 0; _h < 2; ++_h) { vc[_h][0] = vn[_h][0]; vc[_h][1] = vn[_h][1]; }
        if constexpr (ALIGN_EPI) { if (wr == 1) PG8_BAR; }
    }
    PG8_WAIT_V(0);
    if constexpr (!ALIGN_EPI) { if (wr == 0) PG8_BAR; }
    PG8_BAR;
    if constexpr (Epi::AFTER_DRAIN) { E.fused(acc, cur, wr, wc, fr, fq, lds, wid, lane); S.done(cur); }
#undef PG8_ROWS
#undef PG8_SA
#undef PG8_SB
#undef PG8_STAGE
#undef PG8_LDA
#undef PG8_LDB
#undef PG8_MMA
#undef PG8_WAIT_V
#undef PG8_WAIT_L
#undef PG8_BAR
#undef PG8_SCHED
}
}
constexpr int NWAVES = 8, NTHR = 512;
constexpr int DM = 1024, NLAT = 32768, NCTX = 2048, NROWS = 34816, INC = 3328;
constexpr int OFF_CB = 0, OFF_CC = 256, OFF_CX = 512, OFF_Q = 768, OFF_K = 1280, OFF_V = 1792, OFF_G = 2304, OFF_U = 2816, OFF_VV = 3072;
constexpr int NCH = 34;
constexpr float LN_EPS = 1e-5f, ALPHA = 1.41421356237309515f;
constexpr size_t MiB = 1u << 20;
constexpr size_t WS_CTL = 0, CTL_ZERO_BYTES = MiB, WS_MOD = 1 * MiB, WS_LG = 1 * MiB + 480 * 1024, WS_WR = 1 * MiB + 512 * 1024, WS_TOK = 2 * MiB, WS_ROWOF = 3 * MiB + 512 * 1024, WS_WIN = 4 * MiB, WS_WOUT = 17 * MiB, WS_WGU = 21 * MiB, WS_WD = 149 * MiB,
                 WS_HB = 213 * MiB, WS_ST = WS_HB, WS_XCTX = 281 * MiB, WS_P = 289 * MiB, WS_YMIX = 510 * MiB, WS_XB = WS_P, WS_Y = WS_P, WS_YO = WS_P, WS_HH = WS_P + 152 * MiB, WS_END = 578 * MiB;
constexpr int CW_TMO = 0, CW_BAR = 4096, CW_WGCNT = 16384, CW_TOT = 32768, CW_DQ = 33024;
constexpr int RING_BYTES = 131072, LDSCTL_OFF = RING_BYTES, MISC_OFF = LDSCTL_OFF + 320, P2E_OFF = LDSCTL_OFF + 1024, PST_OFF = LDSCTL_OFF + 2048, LDS_BYTES = 147456;
constexpr int MAXPANELS = 304;
constexpr int LCNT_OFF = LDSCTL_OFF + 4096, LG_OFF = LDSCTL_OFF + 4352, DQ_OFF = LDSCTL_OFF + 9600, AROWS_OFF = LDSCTL_OFF + 9728;

#define GAS __attribute__((address_space(1)))
#define LAS __attribute__((address_space(3)))
typedef unsigned short bf16;
typedef unsigned v4u __attribute__((ext_vector_type(4)));
typedef unsigned v2u __attribute__((ext_vector_type(2)));
typedef float f32x4 __attribute__((ext_vector_type(4)));
#define LDS_WAIT() asm volatile("s_waitcnt lgkmcnt(0)" ::: "memory")
#define VM_WAIT() asm volatile("s_waitcnt vmcnt(0)" ::: "memory")
__device__ __forceinline__ unsigned f2bf(float f) { unsigned u = __builtin_bit_cast(unsigned, f); return (u + 0x7fffu + ((u >> 16) & 1u)) >> 16; }
__device__ __forceinline__ unsigned pk2(float lo, float hi) { return f2bf(lo) | (f2bf(hi) << 16); }
typedef float f32x2_t __attribute__((ext_vector_type(2))); typedef __bf16 bf16x2_t __attribute__((ext_vector_type(2)));
__device__ __forceinline__ unsigned cvtpk(float lo, float hi) { f32x2_t v = {lo, hi}; bf16x2_t b = __builtin_convertvector(v, bf16x2_t); return __builtin_bit_cast(unsigned, b); }
__device__ __forceinline__ float bflo(unsigned w) { return __builtin_bit_cast(float, w << 16); }
__device__ __forceinline__ float bfhi(unsigned w) { return __builtin_bit_cast(float, w & 0xffff0000u); }
__device__ __forceinline__ float wave_sum(float v) {
#pragma unroll
    for (int o = 1; o < 64; o <<= 1) v += __shfl_xor(v, o);
    return v;
}
__device__ __forceinline__ float log_sigmoid_f(float x) { return -(fmaxf(-x, 0.f) + log1pf(expf(-fabsf(x)))); }

struct Args { const float* in[24]; float* out; unsigned char* ws; int ph_lo, ph_hi; };
#define XB_TMO      128
#define XB_XCNT(j)  (256  + 64 * (j))
#define XB_XSUB(j)  (1280 + 64 * (j))
#define XB_XGEN(j)  (2304 + 64 * (j))
#define XB_TOP      3328
#define XB_TOPGEN   3392
#define XCD_BAR_WORDS 3456
#define XB_SPIN_CAP (1u << 18)

__device__ __forceinline__ unsigned xb_ld(unsigned* p)              { return __hip_atomic_load(p, __ATOMIC_RELAXED, __HIP_MEMORY_SCOPE_AGENT); }
__device__ __forceinline__ unsigned xb_add(unsigned* p, unsigned v) { return __hip_atomic_fetch_add(p, v, __ATOMIC_RELAXED, __HIP_MEMORY_SCOPE_AGENT); }
__device__ __forceinline__ unsigned xb_xcc_id() { return (unsigned)__builtin_amdgcn_s_getreg((3 << 11) | 20) & 0xFu; }
#define XB_SPIN(cond, bar) do { unsigned _sp = 0; while (cond) { __builtin_amdgcn_s_sleep(1); \
    if ((++_sp & 255u) == 0u) { if (xb_ld(&(bar)[XB_TMO])) break; if (_sp > XB_SPIN_CAP) { atomicAdd(&(bar)[XB_TMO], 1u); break; } } } } while (0)

struct XcdBarrier {
    unsigned* bar; unsigned x;
    volatile LAS unsigned* st;
};

__device__ __forceinline__ XcdBarrier xcd_barrier_post(unsigned* bar, volatile LAS unsigned* st) {
    XcdBarrier b; b.bar = bar; b.x = xb_xcc_id(); b.st = st;
    if (threadIdx.x == 0) (void)xb_add(&bar[XB_XCNT(b.x)], 1u);
    return b;
}
__device__ __forceinline__ void xcd_barrier_complete(unsigned* bar, unsigned x, unsigned& nloc, unsigned& nx) {
    const unsigned G = gridDim.x * gridDim.y * gridDim.z;
    unsigned sum, cnt, mine, sp = 0u;
    for (;;) {
        sum = 0u; cnt = 0u; mine = 0u;
#pragma unroll
        for (unsigned j = 0; j < 16; ++j) { const unsigned c = xb_ld(&bar[XB_XCNT(j)]); sum += c; cnt += (c > 0u) ? 1u : 0u; mine = (j == x) ? c : mine; }
        if (sum == G) break;
        __builtin_amdgcn_s_sleep(1);
        if ((++sp & 255u) == 0u) { if (xb_ld(&bar[XB_TMO])) break; if (sp > XB_SPIN_CAP) { atomicAdd(&bar[XB_TMO], 1u); break; } }
    }
    nloc = mine > 0u ? mine : 1u; nx = cnt > 0u ? cnt : 1u;
}

__device__ __forceinline__ void xcd_barrier(const XcdBarrier& b) {
    asm volatile("s_waitcnt vmcnt(0)" ::: "memory");
    __syncthreads();
    if (threadIdx.x == 0) {
        unsigned* bar = b.bar;
        __builtin_amdgcn_s_waitcnt(0);
        unsigned nloc = b.st[0], nx = b.st[1];
        if (nloc == 0u) { xcd_barrier_complete(bar, b.x, nloc, nx); b.st[0] = nloc; b.st[1] = nx; }
        const unsigned old = xb_add(&bar[XB_XSUB(b.x)], 1u);
        const unsigned gen = old / nloc;
        if (old + 1u == (gen + 1u) * nloc) {
            __builtin_amdgcn_fence(__ATOMIC_RELEASE, "agent");
            asm volatile("s_waitcnt vmcnt(0)" ::: "memory");
            const unsigned og = xb_add(&bar[XB_TOP], 1u);
            const unsigned tg = og / nx;
            if (og + 1u == (tg + 1u) * nx) xb_add(&bar[XB_TOPGEN], 1u);
            else XB_SPIN(xb_ld(&bar[XB_TOPGEN]) == tg, bar);
            __builtin_amdgcn_fence(__ATOMIC_ACQUIRE, "agent");
            xb_add(&bar[XB_XGEN(b.x)], 1u);
            asm volatile("s_waitcnt vmcnt(0)" ::: "memory");
        } else {
            XB_SPIN(xb_ld(&bar[XB_XGEN(b.x)]) == gen, bar);
            __builtin_amdgcn_fence(__ATOMIC_ACQUIRE, "agent");
            asm volatile("s_waitcnt vmcnt(0)" ::: "memory");
        }
    }
    __syncthreads();
}
__device__ __forceinline__ void transpose_tile(const float* Wsrc, int ldn, bf16* dst, int ldk, float scale, LAS float* scr, int lane) {
#pragma unroll 8
    for (int i = 0; i < 32; ++i) { const int kk = 2 * i + (lane >> 5); scr[kk * 33 + (lane & 31)] = Wsrc[(size_t)kk * ldn + (lane & 31)] * scale; }
    LDS_WAIT(); asm volatile("" ::: "memory");
    const int c = lane & 7;
#pragma unroll
    for (int j = 0; j < 4; ++j) { const int n = (lane >> 3) + 8 * j; const LAS float* s = scr + (8 * c) * 33 + n;
        v4u o; o.x = pk2(s[0 * 33], s[1 * 33]); o.y = pk2(s[2 * 33], s[3 * 33]); o.z = pk2(s[4 * 33], s[5 * 33]); o.w = pk2(s[6 * 33], s[7 * 33]);
        *(GAS v4u*)(dst + (size_t)n * ldk + 8 * c) = o; }
    LDS_WAIT(); asm volatile("" ::: "memory");
}

__device__ __forceinline__ void phase_p0(const Args& a, LAS unsigned char* lds, int tid, int lane, int wave) {
    const int G = gridDim.x;
    {
        LAS float* s = (LAS float*)lds; LAS float* red = (LAS float*)(lds + 36864);
        const float* c = a.in[1]; const float* cctx = a.in[3]; const float* wada = a.in[4]; const float* bada = a.in[5];
        float* mod = (float*)(a.ws + WS_MOD);
        for (int u = blockIdx.x; u < 192; u += G) {
            const int l = u / 96, j0 = (u % 96) * 64;
            for (int i = tid; i < 9 * 1024; i += NTHR) { const int r = i >> 10, k = i & 1023; const float v = r < 8 ? c[r * 1024 + k] : cctx[k]; s[i] = v / (1.0f + expf(-v)); }
            __syncthreads();
            const int jq = tid & 15, kg = tid >> 4;
            float acc[9][4];
#pragma unroll
            for (int r = 0; r < 9; ++r) { acc[r][0] = 0.f; acc[r][1] = 0.f; acc[r][2] = 0.f; acc[r][3] = 0.f; }
            const float* w = wada + (size_t)l * 1024 * 6144 + j0 + jq * 4;
            for (int k = kg; k < 1024; k += 32) { const f32x4 wv = *(const f32x4*)(w + (size_t)k * 6144);
#pragma unroll
                for (int r = 0; r < 9; ++r) { const float sr = s[r * 1024 + k]; acc[r][0] += sr * wv.x; acc[r][1] += sr * wv.y; acc[r][2] += sr * wv.z; acc[r][3] += sr * wv.w; } }
#pragma unroll
            for (int r = 0; r < 9; ++r)
#pragma unroll
                for (int i = 0; i < 4; ++i) red[(kg * 9 + r) * 64 + jq * 4 + i] = acc[r][i];
            __syncthreads();
            for (int o = tid; o < 576; o += NTHR) { const int r = o >> 6, j = o & 63; float sum = 0.f;
                for (int g2 = 0; g2 < 32; ++g2) sum += red[(g2 * 9 + r) * 64 + j];
                mod[(l * 9 + r) * 6144 + j0 + j] = sum + bada[l * 6144 + j0 + j]; }
            __syncthreads();
        }
    }
    {
        LAS float* scr = (LAS float*)(lds + wave * 16384);
        const int gw = blockIdx.x * NWAVES + wave, NGW = G * NWAVES;
        const float* w_in = a.in[6]; const float* w_out = a.in[12]; const float* w_gate = a.in[19]; const float* w_up = a.in[20]; const float* w_down = a.in[21];
        bf16* WIN = (bf16*)(a.ws + WS_WIN); bf16* WOUT = (bf16*)(a.ws + WS_WOUT); bf16* WGU = (bf16*)(a.ws + WS_WGU); bf16* WD = (bf16*)(a.ws + WS_WD);
        constexpr int I_IN = 2 * 16 * 104, I_OUT = 2 * 16 * 32, I_GU = 2 * 2 * 32 * 256, I_D = 2 * 32 * 256, NITEMS = I_IN + I_OUT + I_GU + I_D;
        for (int it = gw; it < NITEMS; it += NGW) {
            int r = it;
            if (r < I_IN) { const int l = r / 1664, q = r % 1664, k0 = 64 * (q / 104), n0 = 32 * (q % 104);
                const float sc = (n0 >= OFF_K && n0 < OFF_V) ? 0.125f : 1.0f;
                transpose_tile(w_in + ((size_t)l * 1024 + k0) * INC + n0, INC, WIN + ((size_t)l * INC + n0) * 1024 + k0, 1024, sc, scr, lane); continue; }
            r -= I_IN;
            if (r < I_OUT) { const int l = r / 512, q = r % 512, k0 = 64 * (q / 32), n0 = 32 * (q % 32);
                transpose_tile(w_out + ((size_t)l * 1024 + k0) * 1024 + n0, 1024, WOUT + ((size_t)l * 1024 + n0) * 1024 + k0, 1024, 1.0f, scr, lane); continue; }
            r -= I_OUT;
            if (r < I_GU) { const int isup = r >= (I_GU / 2) ? 1 : 0; r -= isup * (I_GU / 2);
                const int le = r / 256, q = r % 256, k0 = 64 * (q / 16), n0 = 32 * (q % 16);
                const float* src = (isup ? w_up : w_gate) + ((size_t)le * 1024 + k0) * 512 + n0;
                const int drow = (n0 >> 7) * 256 + (n0 & 127) + isup * 128;
                transpose_tile(src, 512, WGU + ((size_t)le * 1024 + drow) * 1024 + k0, 1024, 1.0f, scr, lane); continue; }
            r -= I_GU;
            { const int le = r / 256, q = r % 256, k0 = 64 * (q / 32), n0 = 32 * (q % 32);
                transpose_tile(w_down + ((size_t)le * 512 + k0) * 1024 + n0, 1024, WD + ((size_t)le * 1024 + n0) * 512 + k0, 512, 1.0f, scr, lane); }
        }
    }
    if (blockIdx.x == 0 && tid < 32) { const int dir = tid & 1, lh = tid >> 1; ((float*)(a.ws + WS_LG))[tid] = log_sigmoid_f(a.in[8 + dir][lh]); }
    {
        bf16* WR = (bf16*)(a.ws + WS_WR);
        for (int i = blockIdx.x * NTHR + tid; i < 2 * 64 * 1024; i += G * NTHR) { const int l = i >> 16, j = (i >> 10) & 63, k = i & 1023;
            float v = 0.f;
            if (j < 4) v = a.in[15][((size_t)l * 1024 + k) * 4 + j]; else if (j < 36) v = a.in[17][(((size_t)l * 4 + ((j - 4) >> 3)) * 1024 + k) * 8 + ((j - 4) & 7)];
            const unsigned hi = f2bf(v); const float r = v - __builtin_bit_cast(float, hi << 16);
            WR[((size_t)(l * 2) * 64 + j) * 1024 + k] = (bf16)hi; WR[((size_t)(l * 2 + 1) * 64 + j) * 1024 + k] = (bf16)f2bf(r); }
    }
    __syncthreads();
}

__device__ __forceinline__ void phase_p1(const Args& a, int lane, int wave) {
    const int gw = blockIdx.x * NWAVES + wave, NGW = gridDim.x * NWAVES;
    const float* mod = (const float*)(a.ws + WS_MOD); bf16* Hb = (bf16*)(a.ws + WS_HB);
    for (int row = gw; row < NROWS; row += NGW) {
        const float* src = row < NLAT ? a.in[0] + (size_t)row * 1024 : a.in[2] + (size_t)(row - NLAT) * 1024;
        const float* m0 = mod + (row < NLAT ? (row >> 12) : 8) * 6144;
#pragma unroll
        for (int j = 0; j < 4; ++j) { const int idx = (lane + 64 * j) * 4;
            const f32x4 v = *(const f32x4*)(src + idx), sh = *(const f32x4*)(m0 + idx), sc = *(const f32x4*)(m0 + 1024 + idx);
            const f32x4 o = v * (sc + 1.0f) + sh; v2u w; w.x = pk2(o.x, o.y); w.y = pk2(o.z, o.w);
            *(v2u*)(Hb + (size_t)row * 1024 + idx) = w; }
    }
}

__device__ __forceinline__ int chunk_row0(int b, int c) { return c < 2 ? NLAT + b * 256 + c * 128 : b * 4096 + (c - 2) * 128; }
__device__ __forceinline__ size_t st_off(int b, int c, int h, int dir) { return ((((size_t)b * NCH + c) * 8 + h) * 2 + dir) * 4096; }

__device__ __forceinline__ void phase_b(const Args& a, int l, LAS unsigned char* lds, int tid) {
    const bf16* P = (const bf16*)(a.ws + WS_P); float* ST = (float*)(a.ws + WS_ST);
    LAS float* Ks = (LAS float*)lds; LAS float* Vs = (LAS float*)(lds + 32768); LAS float* pf = (LAS float*)(lds + 65536); LAS float* pb = pf + 128;
    for (int u = blockIdx.x; u < 8 * NCH * 8; u += gridDim.x) {
        const int b = u / (NCH * 8), c = (u % (NCH * 8)) / 8, h = u % 8; const int row0 = chunk_row0(b, c);
        __syncthreads();
        if (tid < 128) { const float lgf = log_sigmoid_f(a.in[8][l * 8 + h]), lgb = log_sigmoid_f(a.in[9][l * 8 + h]);
            pf[tid] = expf(lgf * (float)(127 - tid)); pb[tid] = expf(lgb * (float)tid); }
        { const int j = tid >> 2, part = tid & 3; const bf16* kp = P + (size_t)(row0 + j) * INC + OFF_K + h * 64 + part * 16; const bf16* vp = kp + (OFF_V - OFF_K);
#pragma unroll
          for (int q = 0; q < 2; ++q) { const v4u kw = *(const v4u*)(kp + 8 * q), vw = *(const v4u*)(vp + 8 * q);
              LAS float* kd = Ks + j * 64 + part * 16 + 8 * q; LAS float* vd = Vs + j * 64 + part * 16 + 8 * q;
              kd[0] = bflo(kw.x); kd[1] = bfhi(kw.x); kd[2] = bflo(kw.y); kd[3] = bfhi(kw.y); kd[4] = bflo(kw.z); kd[5] = bfhi(kw.z); kd[6] = bflo(kw.w); kd[7] = bfhi(kw.w);
              vd[0] = bflo(vw.x); vd[1] = bfhi(vw.x); vd[2] = bflo(vw.y); vd[3] = bfhi(vw.y); vd[4] = bflo(vw.z); vd[5] = bfhi(vw.z); vd[6] = bflo(vw.w); vd[7] = bfhi(vw.w); } }
        __syncthreads();
        const int d = tid >> 3, e0 = (tid & 7) * 8;
        float af[8], ab[8];
#pragma unroll
        for (int i = 0; i < 8; ++i) { af[i] = 0.f; ab[i] = 0.f; }
        for (int j = 0; j < 128; ++j) { const float kd = Ks[j * 64 + d], kf = kd * pf[j], kb = kd * pb[j];
            const f32x4 v0 = *(const LAS f32x4*)(Vs + j * 64 + e0), v1 = *(const LAS f32x4*)(Vs + j * 64 + e0 + 4);
            af[0] += kf * v0.x; af[1] += kf * v0.y; af[2] += kf * v0.z; af[3] += kf * v0.w; af[4] += kf * v1.x; af[5] += kf * v1.y; af[6] += kf * v1.z; af[7] += kf * v1.w;
            ab[0] += kb * v0.x; ab[1] += kb * v0.y; ab[2] += kb * v0.z; ab[3] += kb * v0.w; ab[4] += kb * v1.x; ab[5] += kb * v1.y; ab[6] += kb * v1.z; ab[7] += kb * v1.w; }
        float* o0 = ST + st_off(b, c, h, 0) + d * 64 + e0; float* o1 = ST + st_off(b, c, h, 1) + d * 64 + e0;
        *(f32x4*)o0 = (f32x4){af[0], af[1], af[2], af[3]}; *(f32x4*)(o0 + 4) = (f32x4){af[4], af[5], af[6], af[7]};
        *(f32x4*)o1 = (f32x4){ab[0], ab[1], ab[2], ab[3]}; *(f32x4*)(o1 + 4) = (f32x4){ab[4], ab[5], ab[6], ab[7]};
    }
    __syncthreads();
}

__device__ __forceinline__ void phase_c(const Args& a, int l, int tid) {
    bf16* ST = (bf16*)(a.ws + WS_ST);
    for (int it = blockIdx.x * NTHR + tid; it < 8 * 8 * 2 * 1024; it += gridDim.x * NTHR) {
        const int q = it & 1023, dir = (it >> 10) & 1, h = (it >> 11) & 7, b = it >> 14;
        const float lg = ((const float*)(a.ws + WS_LG))[(l * 8 + h) * 2 + dir]; const float dec = __expf(128.0f * lg);
        v2u kv[NCH];
#pragma unroll
        for (int s = 0; s < NCH; ++s) { const int c = dir ? (s < 2 ? 1 - s : 35 - s) : s; kv[s] = *(const v2u*)(ST + st_off(b, c, h, dir) + q * 4); }
        f32x4 st = (f32x4){0.f, 0.f, 0.f, 0.f};
#pragma unroll
        for (int s = 0; s < NCH; ++s) { const int c = dir ? (s < 2 ? 1 - s : 35 - s) : s;
            v2u w; w.x = cvtpk(st.x, st.y); w.y = cvtpk(st.z, st.w); *(v2u*)(ST + st_off(b, c, h, dir) + q * 4) = w;
            st = st * dec + (f32x4){bflo(kv[s].x), bfhi(kv[s].x), bflo(kv[s].y), bfhi(kv[s].y)}; }
    }
}
__device__ __forceinline__ void unpack8(const v4u w, float* f) { f[0] = bflo(w.x); f[1] = bfhi(w.x); f[2] = bflo(w.y); f[3] = bfhi(w.y); f[4] = bflo(w.z); f[5] = bfhi(w.z); f[6] = bflo(w.w); f[7] = bfhi(w.w); }
__device__ __forceinline__ v4u pack8(const float* f) { v4u w; w.x = pk2(f[0], f[1]); w.y = pk2(f[2], f[3]); w.z = pk2(f[4], f[5]); w.w = pk2(f[6], f[7]); return w; }

__device__ __forceinline__ void phase_d(const Args& a, int l, LAS unsigned char* lds, int tid, int lane) {
    const bf16* P = (const bf16*)(a.ws + WS_P); const float* ST = (const float*)(a.ws + WS_ST); bf16* Y = (bf16*)(a.ws + WS_YMIX);
    const float* convw = a.in[7] + l * 3 * 256; const float* sguw = a.in[10] + (size_t)l * 4 * 128 * 128; const float* sgub = a.in[11] + l * 4 * 128;
    const int c_lo = l == 1 ? 2 : 0, cpb = NCH - c_lo, nunits = 8 * cpb;
    LAS float* Sf = (LAS float*)lds; LAS float* Sb = (LAS float*)(lds + 16384); LAS float* Ks = (LAS float*)(lds + 32768); LAS float* Vs = (LAS float*)(lds + 65536);
    LAS float* VN = (LAS float*)lds;
    for (int u = blockIdx.x; u < nunits; u += gridDim.x) {
        const int b = u / cpb, c = c_lo + u % cpb; const int row0 = chunk_row0(b, c); const bool isc = c < 2;
#ifndef NO_D1
        for (int idx = tid; idx < 128 * 32; idx += NTHR) {
            const int p = idx >> 5, ch0 = (idx & 31) * 8; const int row = row0 + p;
            int dprev = -1, dnext = 1; bool vprev, vnext;
            if (isc) { const int t = c * 128 + p; vprev = t > 0; vnext = t < 255; }
            else { const int t = (c - 2) * 128 + p;
                if (ch0 < 128) { const int col = t & 63; vprev = col > 0; vnext = col < 63; }
                else { const int rg = t >> 6; vprev = rg > 0; vnext = rg < 63; dprev = -64; dnext = 64; } }
            const bf16* pr = P + (size_t)row * INC;
            float cb[8], zc[8], zp[8], zn[8], t0[8], t1[8];
            unpack8(*(const v4u*)(pr + OFF_CB + ch0), cb);
            unpack8(*(const v4u*)(pr + OFF_CC + ch0), t0); unpack8(*(const v4u*)(pr + OFF_CX + ch0), t1);
#pragma unroll
            for (int i = 0; i < 8; ++i) { zc[i] = t0[i] * t1[i]; zp[i] = 0.f; zn[i] = 0.f; }
            if (vprev) { const bf16* q = pr + (ptrdiff_t)dprev * INC; unpack8(*(const v4u*)(q + OFF_CC + ch0), t0); unpack8(*(const v4u*)(q + OFF_CX + ch0), t1);
#pragma unroll
                for (int i = 0; i < 8; ++i) zp[i] = t0[i] * t1[i]; }
            if (vnext) { const bf16* q = pr + (ptrdiff_t)dnext * INC; unpack8(*(const v4u*)(q + OFF_CC + ch0), t0); unpack8(*(const v4u*)(q + OFF_CX + ch0), t1);
#pragma unroll
                for (int i = 0; i < 8; ++i) zn[i] = t0[i] * t1[i]; }
            float o[8];
#pragma unroll
            for (int i = 0; i < 8; ++i) o[i] = cb[i] * (convw[ch0 + i] * zp[i] + convw[256 + ch0 + i] * zc[i] + convw[512 + ch0 + i] * zn[i]);
            *(v4u*)(Y + (size_t)row * 1024 + ch0) = pack8(o);
        }
#endif
        const int i = tid >> 2, part = tid & 3;
#ifndef NO_D2
#pragma unroll 1
        for (int h = 0; h < 8; ++h) {
            __syncthreads();
            { const bf16* kp = P + (size_t)(row0 + i) * INC + OFF_K + h * 64 + part * 16; const bf16* vp = kp + (OFF_V - OFF_K);
#pragma unroll
              for (int q = 0; q < 2; ++q) { float kf[8], vf[8]; unpack8(*(const v4u*)(kp + 8 * q), kf); unpack8(*(const v4u*)(vp + 8 * q), vf);
                  LAS float* kd = Ks + i * 64 + part * 16 + 8 * q; LAS float* vd = Vs + i * 64 + part * 16 + 8 * q;
#pragma unroll
                  for (int e = 0; e < 8; ++e) { kd[e] = kf[e]; vd[e] = vf[e]; } }
              const float* sf = ST + st_off(b, c, h, 0); const float* sb = ST + st_off(b, c, h, 1);
#pragma unroll
              for (int q = 0; q < 2; ++q) { const int o4 = (tid + NTHR * q) * 4; *(LAS f32x4*)(Sf + o4) = *(const f32x4*)(sf + o4); *(LAS f32x4*)(Sb + o4) = *(const f32x4*)(sb + o4); } }
            float qv[16];
            { const bf16* qp = P + (size_t)(row0 + i) * INC + OFF_Q + h * 64 + part * 16; unpack8(*(const v4u*)qp, qv); unpack8(*(const v4u*)(qp + 8), qv + 8); }
            const float lgf = log_sigmoid_f(a.in[8][l * 8 + h]), lgb = log_sigmoid_f(a.in[9][l * 8 + h]);
            __syncthreads();
            float o[16];
#pragma unroll
            for (int e = 0; e < 16; ++e) o[e] = 0.f;
#pragma unroll 1
            for (int j = 0; j < 128; ++j) {
                const LAS f32x4* kr = (const LAS f32x4*)(Ks + j * 64 + part * 16);
                float s = 0.f;
#pragma unroll
                for (int q = 0; q < 4; ++q) { const f32x4 k4 = kr[q]; s += qv[4 * q] * k4.x + qv[4 * q + 1] * k4.y + qv[4 * q + 2] * k4.z + qv[4 * q + 3] * k4.w; }
                s += __shfl_xor(s, 1); s += __shfl_xor(s, 2);
                const int rel = i - j;
                const float dec = rel > 0 ? expf(lgf * (float)rel) : (rel < 0 ? expf(lgb * (float)(-rel)) : 2.0f);
                s *= dec;
                const LAS f32x4* vr = (const LAS f32x4*)(Vs + j * 64 + part * 16);
#pragma unroll
                for (int q = 0; q < 4; ++q) { const f32x4 v4 = vr[q]; o[4 * q] += s * v4.x; o[4 * q + 1] += s * v4.y; o[4 * q + 2] += s * v4.z; o[4 * q + 3] += s * v4.w; }
            }
            float of[16], ob[16];
#pragma unroll
            for (int e = 0; e < 16; ++e) { of[e] = 0.f; ob[e] = 0.f; }
            __syncthreads();
#pragma unroll
            for (int dd = 0; dd < 16; ++dd) Ks[i * 64 + ((part * 16 + dd + i) & 63)] = qv[dd];
            __syncthreads();
#pragma unroll 2
            for (int d = 0; d < 64; ++d) { const float qd = Ks[i * 64 + ((d + i) & 63)];
                const LAS f32x4* fr = (const LAS f32x4*)(Sf + d * 64 + part * 16); const LAS f32x4* br = (const LAS f32x4*)(Sb + d * 64 + part * 16);
#pragma unroll
                for (int q = 0; q < 4; ++q) { const f32x4 f4 = fr[q], b4 = br[q];
                    of[4 * q] += qd * f4.x; of[4 * q + 1] += qd * f4.y; of[4 * q + 2] += qd * f4.z; of[4 * q + 3] += qd * f4.w;
                    ob[4 * q] += qd * b4.x; ob[4 * q + 1] += qd * b4.y; ob[4 * q + 2] += qd * b4.z; ob[4 * q + 3] += qd * b4.w; } }
            const float df = expf(lgf * (float)(i + 1)), db = expf(lgb * (float)(128 - i));
            float sum = 0.f;
#pragma unroll
            for (int e = 0; e < 16; ++e) { o[e] += df * of[e] + db * ob[e]; sum += o[e]; }
            sum += __shfl_xor(sum, 1); sum += __shfl_xor(sum, 2);
            const float mu = sum * (1.0f / 64.0f); float vs = 0.f;
#pragma unroll
            for (int e = 0; e < 16; ++e) { o[e] -= mu; vs += o[e] * o[e]; }
            vs += __shfl_xor(vs, 1); vs += __shfl_xor(vs, 2);
            const float rs = 1.0f / sqrtf(vs * (1.0f / 64.0f) + LN_EPS);
            float gv[16];
            { const bf16* gp = P + (size_t)(row0 + i) * INC + OFF_G + h * 64 + part * 16; unpack8(*(const v4u*)gp, gv); unpack8(*(const v4u*)(gp + 8), gv + 8); }
#pragma unroll
            for (int e = 0; e < 16; ++e) o[e] = (gv[e] / (1.0f + expf(-gv[e]))) * (o[e] * rs);
            bf16* yp = Y + (size_t)(row0 + i) * 1024 + 256 + h * 64 + part * 16;
            *(v4u*)yp = pack8(o); *(v4u*)(yp + 8) = pack8(o + 8);
        }
#endif
#ifndef NO_D3
        __syncthreads();
        {
            const bf16* vp = P + (size_t)(row0 + i) * INC + OFF_VV + part * 64;
            float sum = 0.f;
#pragma unroll 2
            for (int q = 0; q < 8; ++q) { float t8[8]; unpack8(*(const v4u*)(vp + 8 * q), t8);
#pragma unroll
                for (int e = 0; e < 8; ++e) sum += t8[e]; }
            sum += __shfl_xor(sum, 1); sum += __shfl_xor(sum, 2);
            const float mu = sum * (1.0f / 256.0f); float vs = 0.f;
#pragma unroll 2
            for (int q = 0; q < 8; ++q) { float t8[8]; unpack8(*(const v4u*)(vp + 8 * q), t8);
#pragma unroll
                for (int e = 0; e < 8; ++e) { const float dlt = t8[e] - mu; vs += dlt * dlt; } }
            vs += __shfl_xor(vs, 1); vs += __shfl_xor(vs, 2);
            const float rs = 1.0f / sqrtf(vs * (1.0f / 256.0f) + LN_EPS);
            LAS float* dst = VN + (part * 128 + i) * 64;
#pragma unroll 2
            for (int q = 0; q < 8; ++q) { float t8[8]; unpack8(*(const v4u*)(vp + 8 * q), t8);
                *(LAS f32x4*)(dst + 8 * q) = (f32x4){(t8[0] - mu) * rs, (t8[1] - mu) * rs, (t8[2] - mu) * rs, (t8[3] - mu) * rs};
                *(LAS f32x4*)(dst + 8 * q + 4) = (f32x4){(t8[4] - mu) * rs, (t8[5] - mu) * rs, (t8[6] - mu) * rs, (t8[7] - mu) * rs}; }
        }
        __syncthreads();
        for (int g = 0; g < 4; ++g) {
            float acc[16];
#pragma unroll
            for (int e = 0; e < 16; ++e) acc[e] = 0.f;
            const float* wrow = sguw + ((size_t)g * 128 + i) * 128;
            for (int q = 0; q < 128; q += 4) { const f32x4 w4 = *(const f32x4*)(wrow + q);
#pragma unroll
                for (int qq = 0; qq < 4; ++qq) { const float w = w4[qq]; const LAS f32x4* vr = (const LAS f32x4*)(VN + (g * 128 + q + qq) * 64 + part * 16);
#pragma unroll
                    for (int t = 0; t < 4; ++t) { const f32x4 v4 = vr[t]; acc[4 * t] += w * v4.x; acc[4 * t + 1] += w * v4.y; acc[4 * t + 2] += w * v4.z; acc[4 * t + 3] += w * v4.w; } } }
            const float bias = sgub[g * 128 + i];
            float uv[16];
            { const bf16* up = P + (size_t)(row0 + i) * INC + OFF_U + g * 64 + part * 16; unpack8(*(const v4u*)up, uv); unpack8(*(const v4u*)(up + 8), uv + 8); }
#pragma unroll
            for (int e = 0; e < 16; ++e) acc[e] = uv[e] * (acc[e] + bias);
            bf16* yp = Y + (size_t)(row0 + i) * 1024 + 768 + g * 64 + part * 16;
            *(v4u*)yp = pack8(acc); *(v4u*)(yp + 8) = pack8(acc + 8);
        }
#endif
        __syncthreads();
    }
}

__device__ __forceinline__ void phase_f(const Args& a, int l, LAS unsigned char* lds, int tid, int lane, int wave, bool dry = false) {
    LAS int* lcnt = (LAS int*)lds;
    __syncthreads();
    if (tid < 32) lcnt[tid] = 0;
    __syncthreads();
    const int gw = blockIdx.x * NWAVES + wave, NGW = gridDim.x * NWAVES, nrows = l == 0 ? NROWS : NLAT;
    const float* mod = (const float*)(a.ws + WS_MOD) + l * 9 * 6144;
    const float* lng = a.in[13] + l * 1024; const float* lnb = a.in[14] + l * 1024;
    const float* rgw = a.in[15] + l * 1024 * 4; const float* rgb = a.in[16] + l * 4; const float* rew = a.in[17] + (size_t)l * 4 * 1024 * 8; const float* reb = a.in[18] + l * 32;
    bf16* Hb = (bf16*)(a.ws + (dry ? WS_P + 160 * MiB : WS_HB)); unsigned* tok = (unsigned*)(a.ws + (dry ? WS_P + 240 * MiB : WS_TOK)); float* xctx = (float*)(a.ws + WS_XCTX);
    for (int row = gw; row < nrows; row += NGW) {
        float* xr = row < NLAT ? a.out + (size_t)row * 1024 : xctx + (size_t)(row - NLAT) * 1024;
        float* xw = dry ? (float*)(a.ws + WS_P) + (size_t)row * 1024 : xr;
        const float* m0 = mod + (row < NLAT ? (row >> 12) : 8) * 6144;
        f32x4 v[4]; float s = 0.f;
#pragma unroll
        for (int j = 0; j < 4; ++j) { v[j] = *(const f32x4*)(xr + (lane + 64 * j) * 4); s += (v[j].x + v[j].y) + (v[j].z + v[j].w); }
        const float mean = wave_sum(s) * (1.0f / 1024.0f); float s2 = 0.f;
#pragma unroll
        for (int j = 0; j < 4; ++j) { v[j] = v[j] - mean; s2 += (v[j].x * v[j].x + v[j].y * v[j].y) + (v[j].z * v[j].z + v[j].w * v[j].w); }
        const float rstd = 1.0f / sqrtf(wave_sum(s2) * (1.0f / 1024.0f) + LN_EPS);
        float lg[4] = {0.f, 0.f, 0.f, 0.f};
#pragma unroll
        for (int j = 0; j < 4; ++j) { const int idx = (lane + 64 * j) * 4;
            const f32x4 x1 = v[j] * rstd * *(const f32x4*)(lng + idx) + *(const f32x4*)(lnb + idx);
            *(f32x4*)(xw + idx) = x1;
            const f32x4 hm = x1 * (*(const f32x4*)(m0 + 4096 + idx) + 1.0f) + *(const f32x4*)(m0 + 3072 + idx);
            v[j] = hm;
            v2u w; w.x = pk2(hm.x, hm.y); w.y = pk2(hm.z, hm.w); *(v2u*)(Hb + (size_t)row * 1024 + idx) = w;
#pragma unroll
            for (int t = 0; t < 4; ++t) { const f32x4 w4 = *(const f32x4*)(rgw + (idx + t) * 4); const float hv = hm[t];
                lg[0] += hv * w4.x; lg[1] += hv * w4.y; lg[2] += hv * w4.z; lg[3] += hv * w4.w; } }
#pragma unroll
        for (int g = 0; g < 4; ++g) lg[g] = wave_sum(lg[g]) + rgb[g];
        int gi = 0; float gm = lg[0];
#pragma unroll
        for (int g = 1; g < 4; ++g) if (lg[g] > gm) { gm = lg[g]; gi = g; }
        float gden = 0.f;
#pragma unroll
        for (int g = 0; g < 4; ++g) gden += expf(lg[g] - gm);
        const float gprob = 1.0f / gden;
        float le[8] = {0.f, 0.f, 0.f, 0.f, 0.f, 0.f, 0.f, 0.f};
        const float* rw = rew + (size_t)gi * 1024 * 8;
#pragma unroll
        for (int j = 0; j < 4; ++j) { const int idx = (lane + 64 * j) * 4;
#pragma unroll
            for (int t = 0; t < 4; ++t) { const f32x4 w0 = *(const f32x4*)(rw + (idx + t) * 8), w1 = *(const f32x4*)(rw + (idx + t) * 8 + 4); const float hv = v[j][t];
                le[0] += hv * w0.x; le[1] += hv * w0.y; le[2] += hv * w0.z; le[3] += hv * w0.w; le[4] += hv * w1.x; le[5] += hv * w1.y; le[6] += hv * w1.z; le[7] += hv * w1.w; } }
#pragma unroll
        for (int e = 0; e < 8; ++e) le[e] = wave_sum(le[e]) + reb[gi * 8 + e];
        int i1 = 0; float m1 = le[0];
#pragma unroll
        for (int e = 1; e < 8; ++e) if (le[e] > m1) { m1 = le[e]; i1 = e; }
        int i2 = -1; float m2 = -3.0e38f;
#pragma unroll
        for (int e = 0; e < 8; ++e) if (e != i1 && le[e] > m2) { m2 = le[e]; i2 = e; }
        const float p2 = expf(m2 - m1), inv = 1.0f / (1.0f + p2);
        const float gate0 = gprob * inv, gate1 = gprob * p2 * inv;
        if (lane == 0) { const int e0 = gi * 8 + i1, e1 = gi * 8 + i2;
            const int p0 = __hip_atomic_fetch_add(lcnt + e0, 1, __ATOMIC_RELAXED, __HIP_MEMORY_SCOPE_WORKGROUP);
            const int p1 = __hip_atomic_fetch_add(lcnt + e1, 1, __ATOMIC_RELAXED, __HIP_MEMORY_SCOPE_WORKGROUP);
            unsigned* t = tok + (size_t)row * 8; t[0] = (unsigned)e0 | ((unsigned)e1 << 8); t[1] = (unsigned)p0; t[2] = (unsigned)p1;
            t[4] = __builtin_bit_cast(unsigned, gate0); t[5] = __builtin_bit_cast(unsigned, gate1); }
    }
    __syncthreads();
    if (tid < 32 && !dry) ((unsigned*)(a.ws + WS_CTL))[CW_WGCNT + (l * 256 + blockIdx.x) * 32 + tid] = (unsigned)lcnt[tid];
    __syncthreads();
}

__device__ __forceinline__ void phase_g(const Args& a, int l, LAS unsigned char* lds, int tid, int lane, int wave) {
    LAS int* cn = (LAS int*)lds; LAS int* base = (LAS int*)(lds + 32768); LAS int* pst = base + 32; LAS int* totl = base + 80;
    unsigned* ctl = (unsigned*)(a.ws + WS_CTL);
    __syncthreads();
    for (int i = tid; i < 256 * 32; i += NTHR) cn[i] = (int)ctl[CW_WGCNT + l * 256 * 32 + i];
    __syncthreads();
    if (tid < 32) { int tot = 0, bs = 0; for (int w = 0; w < 256; ++w) { const int v = cn[w * 32 + tid]; if (w < (int)blockIdx.x) bs += v; tot += v; } base[tid] = bs; totl[tid] = tot; }
    __syncthreads();
    if (tid == 0) { int run = 0; for (int e = 0; e < 32; ++e) { pst[e] = run; run += ((totl[e] + 255) >> 8) << 8; } pst[32] = run; }
    __syncthreads();
    if (blockIdx.x == 0 && tid < 32) ctl[CW_TOT + l * 64 + tid] = (unsigned)totl[tid];
    const int gw = blockIdx.x * NWAVES + wave, NGW = gridDim.x * NWAVES, nrows = l == 0 ? NROWS : NLAT;
    const bf16* Hb = (const bf16*)(a.ws + WS_HB); bf16* XB = (bf16*)(a.ws + WS_XB); unsigned* tok = (unsigned*)(a.ws + WS_TOK);
    (void)gw; (void)NGW; (void)Hb; (void)XB;
    int* rowof = (int*)(a.ws + WS_ROWOF);
    if (blockIdx.x < 32 && tid < 256) { const int e = blockIdx.x, pad = pst[e + 1] - pst[e] - totl[e]; if (tid < pad) rowof[pst[e] + totl[e] + tid] = 0; }
    for (int T = blockIdx.x; T < (nrows >> 5); T += gridDim.x) {
        const int row = 32 * T + (tid >> 4);
        if ((tid & 15) == 0) { unsigned* t = tok + (size_t)row * 8; const unsigned ee = t[0]; const int e0 = ee & 255, e1 = (ee >> 8) & 255;
            const int s0 = pst[e0] + base[e0] + (int)t[1], s1 = pst[e1] + base[e1] + (int)t[2];
            t[6] = (unsigned)s0; t[7] = (unsigned)s1; rowof[s0] = row; rowof[s1] = row; }
    }
    __syncthreads();
}

__device__ __forceinline__ int build_p2e(const Args& a, int l, LAS unsigned char* lds, int tid) {
    LAS unsigned char* p2e = lds + P2E_OFF; LAS int* np = (LAS int*)(lds + PST_OFF);
    const unsigned* ctl = (const unsigned*)(a.ws + WS_CTL);
    __syncthreads();
    if (tid == 0) { int pm = 0; for (int e = 0; e < 32; ++e) { const int n = ((int)ctl[CW_TOT + l * 64 + e] + 255) >> 8; for (int k = 0; k < n && pm < MAXPANELS; ++k) p2e[pm++] = (unsigned char)e; } np[0] = pm; }
    __syncthreads();
    return np[0];
}

struct JRow { f32x4 x[4]; v2u y0[4], y1[4]; float g0, g1; };
__device__ __forceinline__ void j_issue(JRow& R, const float* xr, const bf16* Y, const v4u tk, int lane) {
    const unsigned gx = tk.x, gy = tk.y;
    R.g0 = __builtin_bit_cast(float, gx); R.g1 = __builtin_bit_cast(float, gy);
    const bf16* y0 = Y + (size_t)tk.z * 1024; const bf16* y1 = Y + (size_t)tk.w * 1024;
#pragma unroll
    for (int j = 0; j < 4; ++j) { const int idx = (lane + 64 * j) * 4; R.x[j] = *(const f32x4*)(xr + idx); R.y0[j] = *(const v2u*)(y0 + idx); R.y1[j] = *(const v2u*)(y1 + idx); }
}
__device__ __forceinline__ void j_finish(const JRow& R, float* xw, bf16* hrow, const float* m0, const float* m1, const float* lng, const float* lnb, int lane) {
    f32x4 v[4]; float s = 0.f;
#pragma unroll
    for (int j = 0; j < 4; ++j) { const int idx = (lane + 64 * j) * 4; const v2u w0 = R.y0[j], w1 = R.y1[j];
        const f32x4 ya = (f32x4){bflo(w0.x), bfhi(w0.x), bflo(w0.y), bfhi(w0.y)}, yb = (f32x4){bflo(w1.x), bfhi(w1.x), bflo(w1.y), bfhi(w1.y)};
        v[j] = R.x[j] * ALPHA + *(const f32x4*)(m0 + 5120 + idx) * (ya * R.g0 + yb * R.g1);
        s += (v[j].x + v[j].y) + (v[j].z + v[j].w); }
    const float mean = wave_sum(s) * (1.0f / 1024.0f); float s2 = 0.f;
#pragma unroll
    for (int j = 0; j < 4; ++j) { v[j] = v[j] - mean; s2 += (v[j].x * v[j].x + v[j].y * v[j].y) + (v[j].z * v[j].z + v[j].w * v[j].w); }
    const float rstd = 1.0f / sqrtf(wave_sum(s2) * (1.0f / 1024.0f) + LN_EPS);
#pragma unroll
    for (int j = 0; j < 4; ++j) { const int idx = (lane + 64 * j) * 4;
        const f32x4 x2 = v[j] * rstd * *(const f32x4*)(lng + idx) + *(const f32x4*)(lnb + idx);
        *(f32x4*)(xw + idx) = x2;
        if (hrow) { const f32x4 hh = x2 * (*(const f32x4*)(m1 + 1024 + idx) + 1.0f) + *(const f32x4*)(m1 + idx);
            v2u w; w.x = cvtpk(hh.x, hh.y); w.y = cvtpk(hh.z, hh.w); *(v2u*)(hrow + idx) = w; } }
}
__device__ __forceinline__ void phase_j(const Args& a, int l, int lane, int wave, bool dry = false) {
    const int gw = blockIdx.x * NWAVES + wave, NGW = gridDim.x * NWAVES, nrows = l == 0 ? NROWS : NLAT;
    const float* mod = (const float*)(a.ws + WS_MOD) + l * 9 * 6144; const float* modn = (const float*)(a.ws + WS_MOD) + 9 * 6144;
    const float* lng = a.in[22] + l * 1024; const float* lnb = a.in[23] + l * 1024;
    bf16* Hb = (bf16*)(a.ws + WS_HB); const bf16* Y = (const bf16*)(a.ws + WS_Y); const unsigned* tok = (const unsigned*)(a.ws + WS_TOK); float* xctx = (float*)(a.ws + WS_XCTX);
    for (int rowA = gw; rowA < nrows; rowA += 2 * NGW) {
        const int rowB = rowA + NGW; const bool hasB = rowB < nrows;
        const v4u tA = *(const v4u*)(tok + (size_t)rowA * 8 + 4); const v4u tB = hasB ? *(const v4u*)(tok + (size_t)rowB * 8 + 4) : tA;
        float* xrA = rowA < NLAT ? a.out + (size_t)rowA * 1024 : xctx + (size_t)(rowA - NLAT) * 1024;
        const int rB = hasB ? rowB : rowA;
        float* xrB = rB < NLAT ? a.out + (size_t)rB * 1024 : xctx + (size_t)(rB - NLAT) * 1024;
        JRow RA, RB;
        j_issue(RA, xrA, Y, tA, lane); j_issue(RB, xrB, Y, tB, lane);
        const int mA = rowA < NLAT ? (rowA >> 12) : 8, mB = rB < NLAT ? (rB >> 12) : 8;
        j_finish(RA, dry ? (float*)(a.ws + WS_HH) + (size_t)rowA * 1024 : xrA, (l == 0 && !dry) ? Hb + (size_t)rowA * 1024 : nullptr, mod + mA * 6144, modn + mA * 6144, lng, lnb, lane);
        if (hasB) j_finish(RB, dry ? (float*)(a.ws + WS_HH) + (size_t)rowB * 1024 : xrB, (l == 0 && !dry) ? Hb + (size_t)rowB * 1024 : nullptr, mod + mB * 6144, modn + mB * 6144, lng, lnb, lane);
    }
}
typedef short bf16x8 __attribute__((ext_vector_type(8)));
typedef short s16x4 __attribute__((ext_vector_type(4)));
typedef short v4i16_t __attribute__((ext_vector_type(4)));
typedef float f32x16 __attribute__((ext_vector_type(16)));
#define MFMA32(a, b, c) __builtin_amdgcn_mfma_f32_32x32x16_bf16((a), (b), (c), 0, 0, 0)
__device__ __forceinline__ int crow(int reg, int hf) { return (reg & 3) + 8 * (reg >> 2) + 4 * hf; }
__device__ __forceinline__ int tro(int r, int b) { return r * 128 + (b ^ (((r >> 1) & 1) << 6)); }
__device__ __forceinline__ int rro(int r, int c16) { return r * 128 + ((c16 ^ ((r >> 1) & 7)) << 4); }
__device__ __forceinline__ s16x4 tr4(const LAS unsigned char* p) { return __builtin_bit_cast(s16x4, __builtin_amdgcn_ds_read_tr16_b64_v4i16((LAS v4i16_t*)p)); }
__device__ __forceinline__ bf16x8 tr_frag(const LAS unsigned char* img, int rlo, int rhi, int colbyte) {
    const s16x4 lo = tr4(img + tro(rlo, colbyte)), hi = tr4(img + tro(rhi, colbyte));
    return (bf16x8){lo[0], lo[1], lo[2], lo[3], hi[0], hi[1], hi[2], hi[3]};
}

#ifndef ST_TRANSPOSED
#define ST_TRANSPOSED 1
#endif
__device__ __forceinline__ void phase_b_mfma(const Args& a, int l, LAS unsigned char* lds, int tid, int lane, int wave) {
    const bf16* P = (const bf16*)(a.ws + WS_P); bf16* ST = (bf16*)(a.ws + WS_ST);
    const int r32 = lane & 31, hf = lane >> 5, q4 = (lane & 15) >> 2, p4 = lane & 3, blk = (lane >> 4) & 1;
    for (int u = blockIdx.x; u < 8 * NCH * 4; u += gridDim.x) {
        const int b = u / (NCH * 4), c = (u % (NCH * 4)) >> 2, h0 = (u & 3) * 2; const int row0 = chunk_row0(b, c);
        __syncthreads();
#pragma unroll
        for (int k = 0; k < 4; ++k) {
            const int ci = tid + NTHR * k, hh = ci >> 10, row = (ci & 1023) >> 3, c16 = ci & 7, h = h0 + hh;
            const bf16* src = P + (size_t)(row0 + row) * INC + h * 64 + c16 * 8;
            const v4u kw = *(const v4u*)(src + OFF_K), vw = *(const v4u*)(src + OFF_V);
            LAS unsigned char* base = lds + hh * 49152;
            *(LAS v4u*)(base + tro(row, c16 * 16)) = kw;
            const float* lgt = (const float*)(a.ws + WS_LG) + (l * 8 + h) * 2; const float lgf = lgt[0], lgb = lgt[1];
            const float wf = __expf(lgf * (float)(127 - row)), wb = __expf(lgb * (float)row);
            float v[8]; unpack8(vw, v);
            v4u of, ob;
            of.x = cvtpk(v[0] * wf, v[1] * wf); of.y = cvtpk(v[2] * wf, v[3] * wf); of.z = cvtpk(v[4] * wf, v[5] * wf); of.w = cvtpk(v[6] * wf, v[7] * wf);
            ob.x = cvtpk(v[0] * wb, v[1] * wb); ob.y = cvtpk(v[2] * wb, v[3] * wb); ob.z = cvtpk(v[4] * wb, v[5] * wb); ob.w = cvtpk(v[6] * wb, v[7] * wb);
            *(LAS v4u*)(base + 16384 + tro(row, c16 * 16)) = of;
            *(LAS v4u*)(base + 32768 + tro(row, c16 * 16)) = ob;
        }
        __syncthreads();
        const int hh = wave >> 2, dir = (wave >> 1) & 1, et = wave & 1;
        const LAS unsigned char* kimg = lds + hh * 49152; const LAS unsigned char* vimg = kimg + 16384 + dir * 16384;
        f32x16 acc[2];
#pragma unroll
        for (int i = 0; i < 16; ++i) { acc[0][i] = 0.f; acc[1][i] = 0.f; }
#pragma unroll
        for (int ks = 0; ks < 8; ++ks) {
            const int rlo = 16 * ks + 8 * hf + q4;
            const bf16x8 Bv = tr_frag(vimg, rlo, rlo + 4, (et * 32 + 16 * blk + 4 * p4) * 2);
#pragma unroll
            for (int dt = 0; dt < 2; ++dt) { const bf16x8 Ak = tr_frag(kimg, rlo, rlo + 4, (dt * 32 + 16 * blk + 4 * p4) * 2); acc[dt] = MFMA32(Ak, Bv, acc[dt]); }
        }
        bf16* dst = ST + st_off(b, c, h0 + hh, dir) + (size_t)(et * 32 + r32) * 64;
#pragma unroll
        for (int dt = 0; dt < 2; ++dt)
#pragma unroll
            for (int g4 = 0; g4 < 4; ++g4) { v2u w; w.x = cvtpk(acc[dt][4 * g4], acc[dt][4 * g4 + 1]); w.y = cvtpk(acc[dt][4 * g4 + 2], acc[dt][4 * g4 + 3]);
                *(v2u*)(dst + dt * 32 + 8 * g4 + 4 * hf) = w; }
    }
    __syncthreads();
}
__device__ __forceinline__ bf16x8 scale_frag(const bf16x8 q, float sc) {
    const v4u w = __builtin_bit_cast(v4u, q); v4u o;
    o.x = cvtpk(bflo(w.x) * sc, bfhi(w.x) * sc); o.y = cvtpk(bflo(w.y) * sc, bfhi(w.y) * sc); o.z = cvtpk(bflo(w.z) * sc, bfhi(w.z) * sc); o.w = cvtpk(bflo(w.w) * sc, bfhi(w.w) * sc);
    return __builtin_bit_cast(bf16x8, o);
}
__device__ __forceinline__ bf16x8 f32x8_to_frag(const f32x4 a0, const f32x4 a1) {
    v4u o; o.x = cvtpk(a0.x, a0.y); o.y = cvtpk(a0.z, a0.w); o.z = cvtpk(a1.x, a1.y); o.w = cvtpk(a1.z, a1.w); return __builtin_bit_cast(bf16x8, o);
}
struct ConvIn { v4u cb, c0, x0, cp, xp, cn, xn; };
__device__ __forceinline__ void conv_load(ConvIn& I, const bf16* P, int row0, int c, bool isc, int idx) {
    const int p = idx >> 5, ch0 = (idx & 31) * 8; const int row = row0 + p;
    int dprev = -1, dnext = 1; bool vprev, vnext;
    if (isc) { const int t = c * 128 + p; vprev = t > 0; vnext = t < 255; }
    else { const int t = (c - 2) * 128 + p;
        if (ch0 < 128) { const int col = t & 63; vprev = col > 0; vnext = col < 63; }
        else { const int rg = t >> 6; vprev = rg > 0; vnext = rg < 63; dprev = -64; dnext = 64; } }
    const bf16* pr = P + (size_t)row * INC; const v4u z = (v4u){0u, 0u, 0u, 0u};
    I.cb = *(const v4u*)(pr + OFF_CB + ch0); I.c0 = *(const v4u*)(pr + OFF_CC + ch0); I.x0 = *(const v4u*)(pr + OFF_CX + ch0);
    I.cp = z; I.xp = z; I.cn = z; I.xn = z;
    if (vprev) { const bf16* q = pr + (ptrdiff_t)dprev * INC; I.cp = *(const v4u*)(q + OFF_CC + ch0); I.xp = *(const v4u*)(q + OFF_CX + ch0); }
    if (vnext) { const bf16* q = pr + (ptrdiff_t)dnext * INC; I.cn = *(const v4u*)(q + OFF_CC + ch0); I.xn = *(const v4u*)(q + OFF_CX + ch0); }
}
__device__ __forceinline__ void conv_store(const ConvIn& I, bf16* Y, const float* convw, int row0, int idx) {
    const int p = idx >> 5, ch0 = (idx & 31) * 8;
    float cb[8], a0[8], a1[8], o[8], zc, zp, zn;
    unpack8(I.cb, cb);
    unpack8(I.c0, a0); unpack8(I.x0, a1);
#pragma unroll
    for (int i = 0; i < 8; ++i) o[i] = convw[256 + ch0 + i] * (a0[i] * a1[i]);
    unpack8(I.cp, a0); unpack8(I.xp, a1);
#pragma unroll
    for (int i = 0; i < 8; ++i) o[i] += convw[ch0 + i] * (a0[i] * a1[i]);
    unpack8(I.cn, a0); unpack8(I.xn, a1);
#pragma unroll
    for (int i = 0; i < 8; ++i) o[i] = cb[i] * (o[i] + convw[512 + ch0 + i] * (a0[i] * a1[i]));
    (void)zc; (void)zp; (void)zn;
    *(v4u*)(Y + (size_t)(row0 + p) * 1024 + ch0) = pack8(o);
}
__device__ __forceinline__ void phase_d_mfma(const Args& a, int l, LAS unsigned char* lds, int tid, int lane, int wave) {
    const bf16* P = (const bf16*)(a.ws + WS_P); const bf16* ST = (const bf16*)(a.ws + WS_ST); bf16* Y = (bf16*)(a.ws + WS_YMIX);
    const float* convw = a.in[7] + l * 3 * 256; const float* sguw = a.in[10] + (size_t)l * 4 * 128 * 128; const float* sgub = a.in[11] + l * 4 * 128;
    const int c_lo = l == 1 ? 2 : 0, cpb = NCH - c_lo, nunits = 8 * cpb;
#define LANEC int ln_ = lane; asm volatile("" : "+v"(ln_)); const int r32 = ln_ & 31, hf = ln_ >> 5, q4 = (ln_ & 15) >> 2, p4 = ln_ & 3, blk = (ln_ >> 4) & 1; (void)q4; (void)p4; (void)blk
    unsigned* dq = (unsigned*)(a.ws + WS_CTL) + CW_DQ + l * 64; LAS int* dqw = (LAS int*)(lds + DQ_OFF);
    const int npass = 2 * nunits, total = 4 * nunits;
    __syncthreads();
    if (tid == 0) dqw[0] = (int)__hip_atomic_fetch_add(dq, 1u, __ATOMIC_RELAXED, __HIP_MEMORY_SCOPE_AGENT);
    __syncthreads();
    int item = __builtin_amdgcn_readfirstlane(dqw[0]);
    while (item < total) {
        int nxt = 0;
        if (tid == 0) nxt = (int)__hip_atomic_fetch_add(dq, 1u, __ATOMIC_RELAXED, __HIP_MEMORY_SCOPE_AGENT);
        const int type = item < npass ? 0 : (item < npass + nunits ? 1 : 2);
        const int u = type == 0 ? (item >> 1) : (type == 1 ? item - npass : item - npass - nunits), pass = item & 1;
        const int b = u / cpb, c = c_lo + u % cpb; const int row0 = chunk_row0(b, c); const bool isc = c < 2;
        if (type == 2) {
#pragma unroll 1
            for (int idx = tid; idx < 128 * 32; idx += 2 * NTHR) {
                ConvIn I0, I1;
                conv_load(I0, P, row0, c, isc, idx); conv_load(I1, P, row0, c, isc, idx + NTHR);
                conv_store(I0, Y, convw, row0, idx); conv_store(I1, Y, convw, row0, idx + NTHR);
            }
        }
#ifndef NO_D2
        if (type == 0) {
            LANEC;
            const int hd = wave >> 1, ih = wave & 1, h = pass * 4 + hd;
            const LAS unsigned char* kimg = lds + hd * 32768; const LAS unsigned char* vimg = kimg + 16384;
            const float* lgt = (const float*)(a.ws + WS_LG) + (l * 8 + h) * 2; const float lg2f = lgt[0] * 1.44269504088896f, lg2b = lgt[1] * 1.44269504088896f;
            bf16x8 qf[2][4];
#pragma unroll
            for (int t = 0; t < 2; ++t)
#pragma unroll
                for (int s = 0; s < 4; ++s) qf[t][s] = *(const bf16x8*)(P + (size_t)(row0 + (2 * ih + t) * 32 + r32) * INC + OFF_Q + h * 64 + 16 * s + 8 * hf);
#define D_SFR(dst, dir) do { const bf16* sp_ = ST + st_off(b, c, h, dir) + r32 * 64 + 8 * hf; _Pragma("unroll") for (int s = 0; s < 4; ++s) _Pragma("unroll") for (int et = 0; et < 2; ++et) dst[s][et] = *(const bf16x8*)(sp_ + et * 2048 + 16 * s); } while (0)
#define D_STG_LD(k0) do { _Pragma("unroll") for (int k = 0; k < 4; ++k) { int to_ = tid; asm volatile("" : "+v"(to_)); const int ci = to_ + NTHR * ((k0) + k), tile = ci >> 10, hdd = tile >> 1, isv = tile & 1, row = (ci & 1023) >> 3, c16 = ci & 7; \
                stg[k] = *(const v4u*)(P + (size_t)(row0 + row) * INC + (isv ? OFF_V : OFF_K) + (pass * 4 + hdd) * 64 + c16 * 8); } } while (0)
#define D_STG_ST(k0) do { _Pragma("unroll") for (int k = 0; k < 4; ++k) { int to_ = tid; asm volatile("" : "+v"(to_)); const int ci = to_ + NTHR * ((k0) + k), tile = ci >> 10, hdd = tile >> 1, isv = tile & 1, row = (ci & 1023) >> 3, c16 = ci & 7; \
                *(LAS v4u*)(lds + hdd * 32768 + isv * 16384 + (isv ? tro(row, c16 * 16) : rro(row, c16))) = stg[k]; } } while (0)
#define D_CROSS(sf, dir) do { const int i0 = 2 * ih * 32 + r32; \
                const float sc0 = (dir) == 0 ? __builtin_amdgcn_exp2f(lg2f * (float)(i0 + 1)) : __builtin_amdgcn_exp2f(lg2b * (float)(128 - i0)); \
                const float sc1 = (dir) == 0 ? __builtin_amdgcn_exp2f(lg2f * (float)(i0 + 33)) : __builtin_amdgcn_exp2f(lg2b * (float)(96 - i0)); \
                _Pragma("unroll") for (int s = 0; s < 4; ++s) { const bf16x8 qs0 = scale_frag(qf[0][s], sc0), qs1 = scale_frag(qf[1][s], sc1); \
                    _Pragma("unroll") for (int et = 0; et < 2; ++et) { acc[0][et] = MFMA32(sf[s][et], qs0, acc[0][et]); acc[1][et] = MFMA32(sf[s][et], qs1, acc[1][et]); } } } while (0)
            bf16x8 sf0[4][2]; v4u stg[4];
            D_SFR(sf0, 0);
            D_STG_LD(0);
            f32x16 acc[2][2];
#pragma unroll
            for (int t = 0; t < 2; ++t)
#pragma unroll
                for (int et = 0; et < 2; ++et)
#pragma unroll
                    for (int r = 0; r < 16; ++r) acc[t][et][r] = 0.f;
            asm volatile("" ::: "memory");
            D_CROSS(sf0, 0);
            asm volatile("" ::: "memory");
            bf16x8 sf1[4][2];
            D_SFR(sf1, 1);
            D_STG_ST(0);
            asm volatile("" ::: "memory");
            D_STG_LD(4);
            asm volatile("" ::: "memory");
            D_CROSS(sf1, 1);
            asm volatile("" ::: "memory");
            D_STG_ST(4);
            asm volatile("" ::: "memory");
            D_STG_LD(8); D_STG_ST(8);
            asm volatile("" ::: "memory");
            D_STG_LD(12); D_STG_ST(12);
#undef D_SFR
#undef D_STG_LD
#undef D_STG_ST
#undef D_CROSS
            __syncthreads();
#pragma unroll
            for (int t = 0; t < 2; ++t) {
                const int it = 2 * ih + t;
                bf16x8 qq[4];
                if (t == 0) {
#pragma unroll
                    for (int s = 0; s < 4; ++s) qq[s] = qf[0][s];
                } else {
                    asm volatile("" ::: "memory");
#pragma unroll
                    for (int s = 0; s < 4; ++s) qq[s] = *(const bf16x8*)(P + (size_t)(row0 + it * 32 + r32) * INC + OFF_Q + h * 64 + 16 * s + 8 * hf);
                }
#pragma unroll 1
                for (int jt = 0; jt < 4; ++jt) {
                    f32x16 X;
#pragma unroll
                    for (int r = 0; r < 16; ++r) X[r] = 0.f;
#pragma unroll
                    for (int s = 0; s < 4; ++s) { const bf16x8 Kf = *(const LAS bf16x8*)(kimg + rro(jt * 32 + r32, 2 * s + hf)); X = MFMA32(Kf, qq[s], X); }
                    const int rel0 = (it - jt) * 32 + r32 - 4 * hf;
#pragma unroll
                    for (int r = 0; r < 16; ++r) { const int rel = rel0 - ((r & 3) + 8 * (r >> 2));
                        const float x = rel > 0 ? lg2f * (float)rel : lg2b * (float)(-rel);
                        const float dcy = rel == 0 ? 2.0f : __builtin_amdgcn_exp2f(x);
                        X[r] *= dcy; }
#pragma unroll
                    for (int s2 = 0; s2 < 2; ++s2) {
                        v4u pk; pk.x = cvtpk(X[8 * s2], X[8 * s2 + 1]); pk.y = cvtpk(X[8 * s2 + 2], X[8 * s2 + 3]); pk.z = cvtpk(X[8 * s2 + 4], X[8 * s2 + 5]); pk.w = cvtpk(X[8 * s2 + 6], X[8 * s2 + 7]);
                        const bf16x8 Pk = __builtin_bit_cast(bf16x8, pk);
                        const int rlo = jt * 32 + 16 * s2 + 4 * hf + q4;
#pragma unroll
                        for (int et = 0; et < 2; ++et) { const bf16x8 Vt = tr_frag(vimg, rlo, rlo + 8, (et * 32 + 16 * blk + 4 * p4) * 2); acc[t][et] = MFMA32(Vt, Pk, acc[t][et]); }
                    }
                }
                const int row = row0 + (2 * ih + t) * 32 + r32;
                float sum = 0.f;
#pragma unroll
                for (int et = 0; et < 2; ++et)
#pragma unroll
                    for (int r = 0; r < 16; ++r) sum += acc[t][et][r];
                sum += __shfl_xor(sum, 32);
                const float mu = sum * (1.0f / 64.0f); float vs = 0.f;
#pragma unroll
                for (int et = 0; et < 2; ++et)
#pragma unroll
                    for (int r = 0; r < 16; ++r) { const float dlt = acc[t][et][r] - mu; vs += dlt * dlt; }
                vs += __shfl_xor(vs, 32);
                const float rs = 1.0f / sqrtf(vs * (1.0f / 64.0f) + LN_EPS);
#pragma unroll
                for (int et = 0; et < 2; ++et)
#pragma unroll
                    for (int g4 = 0; g4 < 4; ++g4) { const int e0 = et * 32 + 8 * g4 + 4 * hf;
                        const v2u gw = *(const v2u*)(P + (size_t)row * INC + OFF_G + h * 64 + e0);
                        const float g0 = bflo(gw.x), g1 = bfhi(gw.x), g2 = bflo(gw.y), g3 = bfhi(gw.y);
                        const float o0 = (acc[t][et][4 * g4] - mu) * rs, o1 = (acc[t][et][4 * g4 + 1] - mu) * rs, o2 = (acc[t][et][4 * g4 + 2] - mu) * rs, o3 = (acc[t][et][4 * g4 + 3] - mu) * rs;
                        v2u w; w.x = cvtpk(g0 / (1.0f + __expf(-g0)) * o0, g1 / (1.0f + __expf(-g1)) * o1); w.y = cvtpk(g2 / (1.0f + __expf(-g2)) * o2, g3 / (1.0f + __expf(-g3)) * o3);
                        *(v2u*)(Y + (size_t)row * 1024 + 256 + h * 64 + e0) = w; }
            }
        }
#endif
#ifndef NO_D3
        if (type == 1) {
        __syncthreads();
        {
            int tq_ = tid; asm volatile("" : "+v"(tq_));
            const int i = tq_ >> 2, part = tq_ & 3;
            const bf16* vp = P + (size_t)(row0 + i) * INC + OFF_VV + part * 64;
            float sum = 0.f;
#pragma unroll 2
            for (int q = 0; q < 8; ++q) { float t8[8]; unpack8(*(const v4u*)(vp + 8 * q), t8);
#pragma unroll
                for (int e = 0; e < 8; ++e) sum += t8[e]; }
            sum += __shfl_xor(sum, 1); sum += __shfl_xor(sum, 2);
            const float mu = sum * (1.0f / 256.0f); float vs = 0.f;
#pragma unroll 2
            for (int q = 0; q < 8; ++q) { float t8[8]; unpack8(*(const v4u*)(vp + 8 * q), t8);
#pragma unroll
                for (int e = 0; e < 8; ++e) { const float dlt = t8[e] - mu; vs += dlt * dlt; } }
            vs += __shfl_xor(vs, 1); vs += __shfl_xor(vs, 2);
            const float rs = 1.0f / sqrtf(vs * (1.0f / 256.0f) + LN_EPS);
#pragma unroll 2
            for (int q = 0; q < 8; ++q) { float t8[8]; unpack8(*(const v4u*)(vp + 8 * q), t8);
                v4u w; w.x = cvtpk((t8[0] - mu) * rs, (t8[1] - mu) * rs); w.y = cvtpk((t8[2] - mu) * rs, (t8[3] - mu) * rs); w.z = cvtpk((t8[4] - mu) * rs, (t8[5] - mu) * rs); w.w = cvtpk((t8[6] - mu) * rs, (t8[7] - mu) * rs);
                *(LAS v4u*)(lds + part * 16384 + tro(i, q * 16)) = w; }
        }
        __syncthreads();
        {
            LANEC;
            const int g = wave >> 1, ph = wave & 1;
            const LAS unsigned char* vn = lds + g * 16384;
            f32x16 acc[2][2];
#pragma unroll
            for (int ct = 0; ct < 2; ++ct)
#pragma unroll
                for (int pt = 0; pt < 2; ++pt)
#pragma unroll
                    for (int r = 0; r < 16; ++r) acc[ct][pt][r] = 0.f;
#pragma unroll 2
            for (int ks = 0; ks < 8; ++ks) {
                const int rlo = 16 * ks + 8 * hf + q4;
                bf16x8 A[2], B[2];
#pragma unroll
                for (int ct = 0; ct < 2; ++ct) A[ct] = tr_frag(vn, rlo, rlo + 4, (ct * 32 + 16 * blk + 4 * p4) * 2);
#pragma unroll
                for (int pt = 0; pt < 2; ++pt) { const float* wp = sguw + ((size_t)g * 128 + ph * 64 + pt * 32 + r32) * 128 + 16 * ks + 8 * hf; B[pt] = f32x8_to_frag(*(const f32x4*)wp, *(const f32x4*)(wp + 4)); }
#pragma unroll
                for (int ct = 0; ct < 2; ++ct)
#pragma unroll
                    for (int pt = 0; pt < 2; ++pt) acc[ct][pt] = MFMA32(A[ct], B[pt], acc[ct][pt]);
            }
#pragma unroll
            for (int pt = 0; pt < 2; ++pt) {
                const int p = ph * 64 + pt * 32 + r32; const int row = row0 + p; const float bias = sgub[g * 128 + p];
#pragma unroll
                for (int ct = 0; ct < 2; ++ct)
#pragma unroll
                    for (int g4 = 0; g4 < 4; ++g4) { const int c0 = ct * 32 + 8 * g4 + 4 * hf;
                        const v2u uw = *(const v2u*)(P + (size_t)row * INC + OFF_U + g * 64 + c0);
                        v2u w; w.x = cvtpk(bflo(uw.x) * (acc[ct][pt][4 * g4] + bias), bfhi(uw.x) * (acc[ct][pt][4 * g4 + 1] + bias));
                        w.y = cvtpk(bflo(uw.y) * (acc[ct][pt][4 * g4 + 2] + bias), bfhi(uw.y) * (acc[ct][pt][4 * g4 + 3] + bias));
                        *(v2u*)(Y + (size_t)row * 1024 + 768 + g * 64 + c0) = w; }
            }
        }
        }
#endif
        __syncthreads();
        if (tid == 0) dqw[0] = nxt;
        __syncthreads();
        item = __builtin_amdgcn_readfirstlane(dqw[0]);
    }
}

__device__ __forceinline__ void phase_f2(const Args& a, int l, LAS unsigned char* lds, int tid, int lane, int wave) {
    LAS int* lcnt = (LAS int*)(lds + LCNT_OFF); LAS float* LG = (LAS float*)(lds + LG_OFF);
    LAS unsigned char* HI = lds; LAS unsigned char* LO = lds + 65536; LAS float* PART = (LAS float*)lds;
    const int r32 = lane & 31, hf = lane >> 5;
    const int nrows = l == 0 ? NROWS : NLAT, ntiles = nrows >> 5;
    const float* mod = (const float*)(a.ws + WS_MOD) + l * 9 * 6144;
    const float* lng = a.in[13] + l * 1024; const float* lnb = a.in[14] + l * 1024;
    const float* rgb = a.in[16] + l * 4; const float* reb = a.in[18] + l * 32;
    bf16* Hb = (bf16*)(a.ws + WS_HB); unsigned* tok = (unsigned*)(a.ws + WS_TOK); float* xctx = (float*)(a.ws + WS_XCTX); const bf16* YO = (const bf16*)(a.ws + WS_YO);
    const bf16* wr = (const bf16*)(a.ws + WS_WR) + (size_t)l * 2 * 64 * 1024;
    bf16x8 Bh[8][2];
#pragma unroll
    for (int ks = 0; ks < 8; ++ks)
#pragma unroll
        for (int ct = 0; ct < 2; ++ct) { const bf16* p = wr + (size_t)(ct * 32 + r32) * 1024 + wave * 128 + 16 * ks + 8 * hf; Bh[ks][ct] = *(const bf16x8*)p; }
    __syncthreads();
    if (tid < 32) lcnt[tid] = 0;
    __syncthreads();
    for (int T = blockIdx.x; T < ntiles; T += gridDim.x) {
#pragma unroll 1
        for (int rh = 0; rh < 2; ++rh) {
        f32x4 vv[2][4];
#pragma unroll
        for (int rq = 0; rq < 2; ++rq) { const int row = 32 * T + 4 * wave + 2 * rh + rq;
            const float* xin = l == 0 ? (row < NLAT ? a.in[0] + (size_t)row * 1024 : a.in[2] + (size_t)(row - NLAT) * 1024)
                                      : (row < NLAT ? a.out + (size_t)row * 1024 : xctx + (size_t)(row - NLAT) * 1024);
            const float* g1p = mod + (row < NLAT ? (row >> 12) : 8) * 6144 + 2048;
#pragma unroll
            for (int j = 0; j < 4; ++j) { const int idx = (lane + 64 * j) * 4; const v2u yw = *(const v2u*)(YO + (size_t)row * 1024 + idx);
                vv[rq][j] = *(const f32x4*)(xin + idx) * ALPHA + *(const f32x4*)(g1p + idx) * (f32x4){bflo(yw.x), bfhi(yw.x), bflo(yw.y), bfhi(yw.y)}; } }
#pragma unroll
        for (int rq = 0; rq < 2; ++rq) {
            const int lr = 4 * wave + 2 * rh + rq, row = 32 * T + lr;
            float* xr = row < NLAT ? a.out + (size_t)row * 1024 : xctx + (size_t)(row - NLAT) * 1024;
            const float* m0 = mod + (row < NLAT ? (row >> 12) : 8) * 6144;
            f32x4 v[4]; float s = 0.f;
#pragma unroll
            for (int j = 0; j < 4; ++j) { v[j] = vv[rq][j]; s += (v[j].x + v[j].y) + (v[j].z + v[j].w); }
            const float mean = wave_sum(s) * (1.0f / 1024.0f); float s2 = 0.f;
#pragma unroll
            for (int j = 0; j < 4; ++j) { v[j] = v[j] - mean; s2 += (v[j].x * v[j].x + v[j].y * v[j].y) + (v[j].z * v[j].z + v[j].w * v[j].w); }
            const float rstd = 1.0f / sqrtf(wave_sum(s2) * (1.0f / 1024.0f) + LN_EPS);
#pragma unroll
            for (int j = 0; j < 4; ++j) { const int idx = (lane + 64 * j) * 4;
                const f32x4 x1 = v[j] * rstd * *(const f32x4*)(lng + idx) + *(const f32x4*)(lnb + idx);
                *(f32x4*)(xr + idx) = x1;
                const f32x4 hm = x1 * (*(const f32x4*)(m0 + 4096 + idx) + 1.0f) + *(const f32x4*)(m0 + 3072 + idx);
                v2u h; h.x = cvtpk(hm.x, hm.y); h.y = cvtpk(hm.z, hm.w);
                v2u lo; lo.x = cvtpk(hm.x - bflo(h.x), hm.y - bfhi(h.x)); lo.y = cvtpk(hm.z - bflo(h.y), hm.w - bfhi(h.y));
                *(v2u*)(Hb + (size_t)row * 1024 + idx) = h;
                const int off = lr * 2048 + (((((lane + 64 * j) >> 1)) ^ (lr & 15)) << 4) + (lane & 1) * 8;
                *(LAS v2u*)(HI + off) = h; *(LAS v2u*)(LO + off) = lo; }
        }
        }
        __syncthreads();
        f32x16 acc[2];
#pragma unroll
        for (int r = 0; r < 16; ++r) { acc[0][r] = 0.f; acc[1][r] = 0.f; }
#pragma unroll
        for (int ks = 0; ks < 8; ++ks) { const int off = r32 * 2048 + (((wave * 16 + 2 * ks + hf) ^ (r32 & 15)) << 4);
            const bf16x8 Ah = *(const LAS bf16x8*)(HI + off), Al = *(const LAS bf16x8*)(LO + off);
#pragma unroll
            for (int ct = 0; ct < 2; ++ct) { const bf16x8 Bl = *(const bf16x8*)(wr + (size_t)(64 + ct * 32 + r32) * 1024 + wave * 128 + 16 * ks + 8 * hf);
                acc[ct] = MFMA32(Ah, Bh[ks][ct], acc[ct]); acc[ct] = MFMA32(Ah, Bl, acc[ct]); acc[ct] = MFMA32(Al, Bh[ks][ct], acc[ct]); } }
        __syncthreads();
#pragma unroll
        for (int ct = 0; ct < 2; ++ct)
#pragma unroll
            for (int r = 0; r < 16; ++r) PART[(wave * 32 + crow(r, hf)) * 64 + ct * 32 + r32] = acc[ct][r];
        __syncthreads();
        { const int row = tid >> 4, cg = tid & 15;
#pragma unroll
          for (int q = 0; q < 3; ++q) { const int col = cg + 16 * q; if (col < 36) { float sum = 0.f;
#pragma unroll
                  for (int w = 0; w < 8; ++w) sum += PART[(w * 32 + row) * 64 + col];
                  LG[row * 40 + col] = sum; } } }
        __syncthreads();
        if (tid < 32) { const int row = 32 * T + tid; const LAS float* lgp = LG + tid * 40;
            float lg[4];
#pragma unroll
            for (int g = 0; g < 4; ++g) lg[g] = lgp[g] + rgb[g];
            int gi = 0; float gm = lg[0];
#pragma unroll
            for (int g = 1; g < 4; ++g) if (lg[g] > gm) { gm = lg[g]; gi = g; }
            float gden = 0.f;
#pragma unroll
            for (int g = 0; g < 4; ++g) gden += expf(lg[g] - gm);
            const float gprob = 1.0f / gden;
            float le[8];
#pragma unroll
            for (int e = 0; e < 8; ++e) le[e] = lgp[4 + gi * 8 + e] + reb[gi * 8 + e];
            int i1 = 0; float m1 = le[0];
#pragma unroll
            for (int e = 1; e < 8; ++e) if (le[e] > m1) { m1 = le[e]; i1 = e; }
            int i2 = -1; float m2 = -3.0e38f;
#pragma unroll
            for (int e = 0; e < 8; ++e) if (e != i1 && le[e] > m2) { m2 = le[e]; i2 = e; }
            const float p2 = expf(m2 - m1), inv = 1.0f / (1.0f + p2);
            const float gate0 = gprob * inv, gate1 = gprob * p2 * inv;
            const int e0 = gi * 8 + i1, e1 = gi * 8 + i2;
            const int p0 = __hip_atomic_fetch_add(lcnt + e0, 1, __ATOMIC_RELAXED, __HIP_MEMORY_SCOPE_WORKGROUP);
            const int p1 = __hip_atomic_fetch_add(lcnt + e1, 1, __ATOMIC_RELAXED, __HIP_MEMORY_SCOPE_WORKGROUP);
            unsigned* t = tok + (size_t)row * 8; t[0] = (unsigned)e0 | ((unsigned)e1 << 8); t[1] = (unsigned)p0; t[2] = (unsigned)p1;
            t[4] = __builtin_bit_cast(unsigned, gate0); t[5] = __builtin_bit_cast(unsigned, gate1); }
    }
    __syncthreads();
    if (tid < 32) ((unsigned*)(a.ws + WS_CTL))[CW_WGCNT + (l * 256 + blockIdx.x) * 32 + tid] = (unsigned)lcnt[tid];
    __syncthreads();
}
#ifndef MK_PER_PHASE
#define MK_PER_PHASE 0
#endif
constexpr int N_PHASES = 22;

__global__ void __launch_bounds__(NTHR, 2) hybrid_fwd(Args args) {
    extern __shared__ __attribute__((aligned(16))) unsigned char lds_raw[];
    LAS unsigned char* lds = (LAS unsigned char*)lds_raw;
    const int tid0 = threadIdx.x;
    for (int u = tid0; u < (LDS_BYTES - LDSCTL_OFF) / 4; u += NTHR) ((LAS unsigned*)(lds + LDSCTL_OFF))[u] = 0u;
#define TIDS int tid = threadIdx.x; asm volatile("" : "+v"(tid)); const int lane = tid & 63, wave = __builtin_amdgcn_readfirstlane(tid >> 6); (void)lane; (void)wave
    __syncthreads();
    unsigned* ctl = (unsigned*)(args.ws + WS_CTL);
    XcdBarrier bar; bar.bar = ctl + CW_BAR; bar.x = 0; bar.st = nullptr;
    if (!MK_PER_PHASE) bar = xcd_barrier_post(ctl + CW_BAR, (volatile LAS unsigned*)(lds + MISC_OFF + 32));
    const int lo = args.ph_lo, hi = args.ph_hi;
#ifndef PHMASK
#define PHMASK 0xFFFFFFu
#endif
#define PHON(k) (((PHMASK) >> ((k) < 2 ? (k) : 2 + ((k) - 2) % 10)) & 1u)
#define IN(k) (PHON(k) && lo <= (k) && (k) < hi)
#ifndef REPMASK
#define REPMASK 0u
#endif
#define NREP(k) (1 + (int)(((REPMASK) >> ((k) < 2 ? (k) : 2 + ((k) - 2) % 10)) & 1u))
#define SEAM(k) do { if (IN(k) && IN((k) + 1)) xcd_barrier(bar); } while (0)

    if (IN(0)) for (int rep = 0; rep < NREP(0); ++rep) { TIDS; phase_p0(args, lds, tid, lane, wave); }
    SEAM(0);
    if (IN(1)) for (int rep = 0; rep < NREP(1); ++rep) { TIDS; phase_p1(args, lane, wave); }
    SEAM(1);
    for (int l = 0; l < 2; ++l) {
        const int pb = 2 + 10 * l;
        bf16* Hb = (bf16*)(args.ws + WS_HB);
        if (IN(pb + 0)) for (int rep = 0; rep < NREP(2); ++rep) {
            pg8::Gemm g{Hb, (const bf16*)(args.ws + WS_WIN) + (size_t)l * INC * 1024, NROWS, INC, 1024}; pg8::StaticOrder S; S.init(NROWS, INC, (int)gridDim.x, (int)blockIdx.x);
            pg8::EpiBf16<0> E{(bf16*)(args.ws + WS_P), INC, nullptr, 0, 0, 1.0f};
            pg8::gemm_phase<pg8::EpiBf16<0>, pg8::StaticOrder, true, true>(lds, g, S, E);
        }
        SEAM(pb + 0);
        if (IN(pb + 1)) for (int rep = 0; rep < NREP(3); ++rep) { TIDS; phase_b_mfma(args, l, lds, tid, lane, wave); }
        SEAM(pb + 1);
        if (IN(pb + 2)) { TIDS; phase_c(args, l, tid); }
        SEAM(pb + 2);
        if (IN(pb + 3)) for (int rep = 0; rep < NREP(5); ++rep) { TIDS; phase_d_mfma(args, l, lds, tid, lane, wave); }
        SEAM(pb + 3);
        if (IN(pb + 4)) for (int rep = 0; rep < (l == 0 ? NREP(6) : 1); ++rep) {
            const int M = l == 0 ? NROWS : NLAT;
            pg8::Gemm g{(const bf16*)(args.ws + WS_YMIX), (const bf16*)(args.ws + WS_WOUT) + (size_t)l * 1024 * 1024, M, 1024, 1024}; pg8::StaticOrder S; S.init(M, 1024, (int)gridDim.x, (int)blockIdx.x);
            pg8::EpiBf16<0> E{(bf16*)(args.ws + WS_YO), 1024, nullptr, 0, 0, 1.0f};
            pg8::gemm_phase<pg8::EpiBf16<0>, pg8::StaticOrder, true, true>(lds, g, S, E);
        }
        SEAM(pb + 4);
        if (IN(pb + 5)) { TIDS; phase_f2(args, l, lds, tid, lane, wave); }
        SEAM(pb + 5);
        if (IN(pb + 6)) for (int rep = 0; rep < NREP(8); ++rep) { TIDS; phase_g(args, l, lds, tid, lane, wave); }
        SEAM(pb + 6);
        if (IN(pb + 7)) for (int rep = 0; rep < NREP(9); ++rep) {
            int npan; { TIDS; npan = build_p2e(args, l, lds, tid); }
            pg8::Gemm g{Hb, (const bf16*)(args.ws + WS_WGU) + (size_t)l * 32 * 1024 * 1024, npan * 256, 1024, 1024};
            LAS int* arows = (LAS int*)(lds + AROWS_OFF);
            { TIDS; const int* rowof = (const int*)(args.ws + WS_ROWOF);
              for (int i = 0; i < 6; ++i) { const int L = i * (int)gridDim.x + (int)blockIdx.x; if (L < npan * 4 && tid < 256) arows[i * 256 + tid] = rowof[(L >> 2) * 256 + tid]; }
              __syncthreads(); }
            pg8::MoeOrder S{(const LAS unsigned char*)(lds + P2E_OFF), npan * 4, (int)gridDim.x, (int)blockIdx.x, arows};
            pg8::EpiGLU E{(bf16*)(args.ws + WS_HH)};
            pg8::gemm_phase_gather<pg8::EpiGLU, pg8::MoeOrder>(lds, g, S, E);
        }
        SEAM(pb + 7);
        if (IN(pb + 8)) for (int rep = 0; rep < NREP(10); ++rep) {
            int npan; { TIDS; npan = build_p2e(args, l, lds, tid); }
            pg8::Gemm g{(const bf16*)(args.ws + WS_HH), (const bf16*)(args.ws + WS_WD) + (size_t)l * 32 * 1024 * 512, npan * 256, 1024, 512};
            pg8::MoeOrder S{(const LAS unsigned char*)(lds + P2E_OFF), npan * 4, (int)gridDim.x, (int)blockIdx.x, nullptr};
            pg8::EpiY E{(bf16*)(args.ws + WS_Y)};
            pg8::gemm_phase<pg8::EpiY, pg8::MoeOrder, true, true>(lds, g, S, E);
        }
        SEAM(pb + 8);
        if (IN(pb + 9)) { if (NREP(11) > 1) { TIDS; phase_j(args, l, lane, wave, true); } TIDS; phase_j(args, l, lane, wave); }
        SEAM(pb + 9);
    }
#undef IN
#undef SEAM
}

extern "C" void kernel_launch(void* const* d_in, const int* in_sizes, int n_in, void* d_out, int out_size, void* d_ws, size_t ws_size, hipStream_t stream) {
    static int grid = 0;
    if (grid == 0) {
        if (n_in != 24 || in_sizes[0] != NLAT * DM || out_size != NLAT * DM || ws_size < WS_END) { fprintf(stderr, "kernel_launch: unexpected problem (n_in %d, ws %zu < %zu?)\n", n_in, ws_size, (size_t)WS_END); grid = -1; return; }
        int dev = 0, cus = 0, per_cu = 0;
        if (hipGetDevice(&dev) != hipSuccess || hipDeviceGetAttribute(&cus, hipDeviceAttributeMultiprocessorCount, dev) != hipSuccess) { grid = -1; return; }
        if (hipFuncSetAttribute((const void*)hybrid_fwd, hipFuncAttributeMaxDynamicSharedMemorySize, LDS_BYTES) != hipSuccess) { grid = -1; return; }
        if (hipOccupancyMaxActiveBlocksPerMultiprocessor(&per_cu, (const void*)hybrid_fwd, NTHR, LDS_BYTES) != hipSuccess || per_cu < 1) { fprintf(stderr, "kernel_launch: occupancy query says %d\n", per_cu); }
        (void)hipGetLastError();
        grid = cus;
        if (grid != 256) { fprintf(stderr, "kernel_launch: built for 256 CUs, device has %d\n", cus); grid = -1; return; }
    }
    if (grid < 0) return;
    if (hipMemsetAsync((char*)d_ws + WS_CTL, 0, CTL_ZERO_BYTES, stream) != hipSuccess) return;
    Args a{};
    for (int i = 0; i < 24; ++i) a.in[i] = (const float*)d_in[i];
    a.out = (float*)d_out; a.ws = (unsigned char*)d_ws;
#if MK_PER_PHASE
    for (int p = 0; p < N_PHASES; ++p) { a.ph_lo = p; a.ph_hi = p + 1; hipLaunchKernelGGL(hybrid_fwd, dim3(grid), dim3(NTHR), LDS_BYTES, stream, a); }
#else
    a.ph_lo = 0; a.ph_hi = N_PHASES;
    hipLaunchKernelGGL(hybrid_fwd, dim3(grid), dim3(NTHR), LDS_BYTES, stream, a);
#endif
}
```

```cpp
#include <hip/hip_runtime.h>
#include <cstdio>
#include <cstdint>
#include <cstddef>
namespace pg8 {
#define PG8_LAS __attribute__((address_space(3)))
typedef unsigned short bf16_t;
typedef short bf16x8 __attribute__((ext_vector_type(8)));
typedef float f32x4 __attribute__((ext_vector_type(4)));
typedef unsigned u32x4 __attribute__((ext_vector_type(4)));
constexpr int BM = 256, BK = 64, HALF = 128, HTB = HALF * BK * 2  , STAGE_BYTES = 8 * HTB, NXCD = 8, WGM = 8;

__host__ __device__ __forceinline__ int lds_byte(int r, int c) { const int st = (r >> 4) * 2 + (c >> 5), rr = r & 15, cc = c & 31, ob = rr * 64 + cc * 2; return st * 1024 + (ob ^ (((ob >> 9) & 1) << 5)); }
__host__ __device__ __forceinline__ void stage_rc(int b, int& R, int& C) { const int st = b / 1024, sb = b % 1024, swz = sb ^ (((sb >> 9) & 1) << 5); R = (st >> 1) * 16 + swz / 64; C = (st & 1) * 32 + (swz % 64) / 2; }
__host__ __device__ __forceinline__ int perm32(int rho) { const int n = rho >> 4, i = rho & 15; return 8 * (i >> 2) + 4 * n + (i & 3); }

struct Unit { int pm, pn; };
struct Gemm { const bf16_t* A; const bf16_t* Bt; int M, N, K; };

struct StaticOrder {
    int nM, nN, nwg, G, c;
    __host__ __device__ void init(int M, int N, int G_, int c_) { nM = M / BM; nN = N / BM; nwg = nM * nN; G = G_; c = c_; }
    __host__ __device__ bool next(int i, Unit& u) const {
        const long L = (long)i * G + c; if (L >= nwg) return false;
        int wgid = (int)L; { const int q = nwg / NXCD, r = nwg % NXCD, xcd = wgid % NXCD, off = wgid / NXCD; wgid = (xcd < r ? xcd * (q + 1) : r * (q + 1) + (xcd - r) * q) + off; }
        const int nig = WGM * nN, gid = wgid / nig, fm = gid * WGM, gsz = (nM - fm) < WGM ? (nM - fm) : WGM;
        u.pm = fm + ((wgid % nig) % gsz); u.pn = (wgid % nig) / gsz; return true;
    }
    __device__ __forceinline__ void a_ready(const Unit&) const {}
    __device__ __forceinline__ void done(const Unit&) const {}
};

__device__ __forceinline__ unsigned cvt_pk_bf16(float lo, float hi) { unsigned r; asm volatile("v_cvt_pk_bf16_f32 %0, %1, %2" : "=v"(r) : "v"(lo), "v"(hi)); return r; }
typedef float f32x2 __attribute__((ext_vector_type(2)));
__device__ __forceinline__ f32x2 gelu_pk(f32x2 v) {
    const f32x2 av = __builtin_elementwise_abs(v), d = av * 0.2316418882f + 1.0f;
    f32x2 t; t.x = __builtin_amdgcn_rcpf(d.x); t.y = __builtin_amdgcn_rcpf(d.y);
    f32x2 q = t * 0.5307027145f + (-0.7265760135f); q = q * t + 0.7107068705f; q = q * t + (-0.142248368f); q = q * t + 0.127414796f; q = q * t;
    const f32x2 s = (v * v) * (-0.72134752044f);
    f32x2 e; e.x = __builtin_amdgcn_exp2f(s.x); e.y = __builtin_amdgcn_exp2f(s.y);
    const f32x2 m = v * (q * e), r = v - m;
    f32x2 o; o.x = v.x < 0.f ? m.x : r.x; o.y = v.y < 0.f ? m.y : r.y; return o;
}

template <int ACT  > struct EpiBf16 {
    static constexpr bool PERM = true, AFTER_DRAIN = false; static_assert(ACT == 0 || ACT == 1, "EpiBf16: ACT is 0 (none) or 1 (gelu_pk)");
    bf16_t* O; int ldc; const float* bias; int split_cols; size_t split_stride; float scale0;
    __device__ __forceinline__ void operator()(const f32x4 (&acc)[2][2][4][2], const Unit& u, int wr, int wc, int fr, int fq) const {
        const int row0 = u.pm * BM + wr * 64 + fr; int colt = u.pn * BM; bf16_t* base = O;
        float sc = 1.f; if (split_cols) { const int t = colt / split_cols; base += (size_t)t * split_stride; colt -= t * split_cols; if (t == 0) sc = scale0; }
        const int col0 = colt + wc * 32 + 8 * fq, bcol0 = u.pn * BM + wc * 32 + 8 * fq;
        f32x4 bv[2][2];
#pragma unroll
        for (int bj = 0; bj < 2; ++bj)
#pragma unroll
            for (int n = 0; n < 2; ++n) bv[bj][n] = bias ? *(const f32x4*)(bias + bcol0 + bj * HALF + 4 * n) : (f32x4){0.f, 0.f, 0.f, 0.f};
#pragma unroll
        for (int ai = 0; ai < 2; ++ai)
#pragma unroll
            for (int m = 0; m < 4; ++m) { bf16_t* rowp = base + (size_t)(row0 + ai * HALF + m * 16) * ldc + col0;
#pragma unroll
                for (int bj = 0; bj < 2; ++bj) { f32x4 v0 = acc[ai][bj][m][0] + bv[bj][0], v1 = acc[ai][bj][m][1] + bv[bj][1];
                    if (ACT == 1) { f32x2 a = gelu_pk((f32x2){v0[0], v0[1]}), b = gelu_pk((f32x2){v0[2], v0[3]}), c = gelu_pk((f32x2){v1[0], v1[1]}), d = gelu_pk((f32x2){v1[2], v1[3]});
                        v0 = (f32x4){a.x, a.y, b.x, b.y}; v1 = (f32x4){c.x, c.y, d.x, d.y}; }
                    v0 = v0 * sc; v1 = v1 * sc; u32x4 w; w.x = cvt_pk_bf16(v0[0], v0[1]); w.y = cvt_pk_bf16(v0[2], v0[3]); w.z = cvt_pk_bf16(v1[0], v1[1]); w.w = cvt_pk_bf16(v1[2], v1[3]);
                    *(u32x4*)(rowp + bj * HALF) = w; } }
    }
};
__device__ __forceinline__ float silu_f(float x) { return x / (1.0f + __expf(-x)); }
struct EpiResid {
    static constexpr bool PERM = false, AFTER_DRAIN = false;
    const float* xin_lat; const float* xin_ctx; float* xo_lat; float* xo_ctx; const float* mod; float alpha;
    __device__ __forceinline__ void operator()(const f32x4 (&acc)[2][2][4][2], const Unit& u, int wr, int wc, int fr, int fq) const {
        const int prow0 = u.pm * BM; const bool isc = prow0 >= 32768;
        const float* xin = isc ? xin_ctx + (size_t)(prow0 - 32768) * 1024 : xin_lat + (size_t)prow0 * 1024;
        float* xo = isc ? xo_ctx + (size_t)(prow0 - 32768) * 1024 : xo_lat + (size_t)prow0 * 1024;
        const float* g1 = mod + (isc ? 8 : (prow0 >> 12)) * 6144 + 2048;
        const int col0 = u.pn * BM + wc * 32 + 4 * fq;
        f32x4 gv[2][2];
#pragma unroll
        for (int bj = 0; bj < 2; ++bj)
#pragma unroll
            for (int n = 0; n < 2; ++n) gv[bj][n] = *(const f32x4*)(g1 + col0 + bj * HALF + n * 16);
#pragma unroll
        for (int ai = 0; ai < 2; ++ai)
#pragma unroll
            for (int m = 0; m < 4; ++m) { const size_t off = (size_t)(ai * HALF + wr * 64 + m * 16 + fr) * 1024 + col0;
#pragma unroll
                for (int bj = 0; bj < 2; ++bj)
#pragma unroll
                    for (int n = 0; n < 2; ++n) { const f32x4 xv = *(const f32x4*)(xin + off + bj * HALF + n * 16);
                        *(f32x4*)(xo + off + bj * HALF + n * 16) = xv * alpha + gv[bj][n] * acc[ai][bj][m][n]; }
                if (m & 1) asm volatile("" ::: "memory"); }
    }
};
struct EpiGLU {
    static constexpr bool PERM = true, AFTER_DRAIN = false;
    bf16_t* Hh;
    __device__ __forceinline__ void operator()(const f32x4 (&acc)[2][2][4][2], const Unit& u, int wr, int wc, int fr, int fq) const {
        const int row0 = u.pm * BM + wr * 64 + fr; const int col0 = (u.pn & 3) * 128 + wc * 32 + 8 * fq;
#pragma unroll
        for (int ai = 0; ai < 2; ++ai)
#pragma unroll
            for (int m = 0; m < 4; ++m) { bf16_t* rowp = Hh + (size_t)(row0 + ai * HALF + m * 16) * 512 + col0;
                const f32x4 g0 = acc[ai][0][m][0], g1 = acc[ai][0][m][1], u0 = acc[ai][1][m][0], u1 = acc[ai][1][m][1];
                u32x4 w; w.x = cvt_pk_bf16(silu_f(g0[0]) * u0[0], silu_f(g0[1]) * u0[1]); w.y = cvt_pk_bf16(silu_f(g0[2]) * u0[2], silu_f(g0[3]) * u0[3]);
                w.z = cvt_pk_bf16(silu_f(g1[0]) * u1[0], silu_f(g1[1]) * u1[1]); w.w = cvt_pk_bf16(silu_f(g1[2]) * u1[2], silu_f(g1[3]) * u1[3]);
                *(u32x4*)rowp = w; }
    }
};
struct EpiY {
    static constexpr bool PERM = true, AFTER_DRAIN = false;
    bf16_t* O;
    __device__ __forceinline__ void operator()(const f32x4 (&acc)[2][2][4][2], const Unit& u, int wr, int wc, int fr, int fq) const {
        const int row0 = u.pm * BM + wr * 64 + fr; const int col0 = (u.pn & 3) * BM + wc * 32 + 8 * fq;
#pragma unroll
        for (int ai = 0; ai < 2; ++ai)
#pragma unroll
            for (int m = 0; m < 4; ++m) { bf16_t* rowp = O + (size_t)(row0 + ai * HALF + m * 16) * 1024 + col0;
#pragma unroll
                for (int bj = 0; bj < 2; ++bj) { const f32x4 v0 = acc[ai][bj][m][0], v1 = acc[ai][bj][m][1];
                    u32x4 w; w.x = cvt_pk_bf16(v0[0], v0[1]); w.y = cvt_pk_bf16(v0[2], v0[3]); w.z = cvt_pk_bf16(v1[0], v1[1]); w.w = cvt_pk_bf16(v1[2], v1[3]);
                    *(u32x4*)(rowp + bj * HALF) = w; } }
    }
};
struct MoeOrder {
    const PG8_LAS unsigned char* p2e; int nunits, G, c; const PG8_LAS int* rows;
    __device__ __forceinline__ const PG8_LAS int* arows(int i) const { return rows + i * 256; }
    __device__ __forceinline__ bool next(int i, Unit& u) const {
        const int L = i * G + c; if (L >= nunits) return false;
        u.pm = L >> 2; u.pn = (int)p2e[L >> 2] * 4 + (L & 3); return true;
    }
    __device__ __forceinline__ void a_ready(const Unit&) const {}
    __device__ __forceinline__ void done(const Unit&) const {}
};
template <class Epi, class Sched, bool ALIGN_EPI = false, bool SP2 = false>
__device__ __forceinline__ void gemm_phase(PG8_LAS unsigned char* lds, const Gemm g, const Sched& S, const Epi& E) {
    int tid_ = threadIdx.x; asm volatile("" : "+v"(tid_));
    const int tid = tid_, wid = __builtin_amdgcn_readfirstlane(tid >> 6), lane = tid & 63, wr = wid >> 2, wc = wid & 3, fr = lane & 15, fq = lane >> 4;
    const int K = g.K, nt = K / BK;
    unsigned voffA[2], voffB[2];
#pragma unroll
    for (int i = 0; i < 2; ++i) { int R, C; stage_rc(tid * 16 + i * 8192, R, C); const int Rb = Epi::PERM ? ((R & ~31) + perm32(R & 31)) : R;
        voffA[i] = (unsigned)(R * K + C) * 2u; voffB[i] = (unsigned)(Rb * K + C) * 2u; }
    const size_t kstep = (size_t)(BK * 2);
    const size_t hstep = (size_t)HALF * K * 2;
    const size_t tstep = 2 * hstep;
    const unsigned ldsw = (unsigned)wid * 1024u;
    const int aoff = lds_byte(wr * 64 + fr, fq * 8), boff = lds_byte(wc * 32 + fr, fq * 8);
#define PG8_SA(b, h) (((b) * 2 + (h)) * HTB)
#define PG8_SB(b, h) ((4 + (b) * 2 + (h)) * HTB)
#define PG8_STAGE(bufoff, gbase, voff) do { _Pragma("unroll") for (int _i = 0; _i < 2; ++_i) \
        __builtin_amdgcn_global_load_lds((const unsigned*)((const char*)(gbase) + (voff)[_i]), (PG8_LAS unsigned*)(lds + (bufoff) + ldsw + _i * 8192), 16, 0, 0); } while (0)
#define PG8_LDA(dst, b, h) do { _Pragma("unroll") for (int m = 0; m < 4; ++m) _Pragma("unroll") for (int k = 0; k < 2; ++k) dst[m][k] = *(const PG8_LAS bf16x8*)(lds + PG8_SA(b, h) + aoff + m * 2048 + k * 1024); } while (0)
#define PG8_LDB(dst, b, h) do { _Pragma("unroll") for (int n = 0; n < 2; ++n) _Pragma("unroll") for (int k = 0; k < 2; ++k) dst[n][k] = *(const PG8_LAS bf16x8*)(lds + PG8_SB(b, h) + boff + n * 2048 + k * 1024); } while (0)
#define PG8_MMA(ai, bj, At, Bt) do { __builtin_amdgcn_s_setprio(1); _Pragma("unroll") for (int m = 0; m < 4; ++m) _Pragma("unroll") for (int n = 0; n < 2; ++n) _Pragma("unroll") for (int k = 0; k < 2; ++k) \
        acc[ai][bj][m][n] = __builtin_amdgcn_mfma_f32_16x16x32_bf16(Bt[n][k], At[m][k], acc[ai][bj][m][n], 0, 0, 0); __builtin_amdgcn_s_setprio(0); } while (0)
#define PG8_WAIT_V(n) asm volatile("s_waitcnt vmcnt(" #n ")" ::: "memory")
#define PG8_WAIT_L(n) asm volatile("s_waitcnt lgkmcnt(" #n ")" ::: "memory")
#define PG8_BAR __builtin_amdgcn_s_barrier()
#define PG8_SCHED __builtin_amdgcn_sched_barrier(0)
    Unit cur, nxt; int ui = 0;
    if (!S.next(0, cur)) return;
    f32x4 acc[2][2][4][2];
#pragma unroll
    for (int a = 0; a < 2; ++a)
#pragma unroll
        for (int b = 0; b < 2; ++b)
#pragma unroll
            for (int m = 0; m < 4; ++m)
#pragma unroll
                for (int n = 0; n < 2; ++n) acc[a][b][m][n] = (f32x4){0.f, 0.f, 0.f, 0.f};
    bf16x8 At[4][2], B0[2][2], B1[2][2];
    const char* cA = (const char*)g.A + (size_t)cur.pm * tstep; const char* cB = (const char*)g.Bt + (size_t)cur.pn * tstep;
    S.a_ready(cur);
    if constexpr (SP2) {
        PG8_STAGE(PG8_SB(0, 0), cB, voffB); PG8_STAGE(PG8_SB(0, 1), cB + hstep, voffB); PG8_STAGE(PG8_SA(0, 0), cA, voffA); PG8_STAGE(PG8_SA(0, 1), cA + hstep, voffA);
        if (wr == 1) PG8_BAR;
        PG8_WAIT_V(2); PG8_BAR;
        PG8_STAGE(PG8_SB(1, 0), cB + kstep, voffB); PG8_STAGE(PG8_SA(1, 0), cA + kstep, voffA); PG8_STAGE(PG8_SB(1, 1), cB + hstep + kstep, voffB);
        PG8_WAIT_V(6); PG8_BAR;
    } else {
        PG8_STAGE(PG8_SB(0, 0), cB, voffB); PG8_STAGE(PG8_SA(0, 0), cA, voffA); PG8_STAGE(PG8_SB(0, 1), cB + hstep, voffB); PG8_STAGE(PG8_SA(0, 1), cA + hstep, voffA);
        if (wr == 1) PG8_BAR;
        PG8_WAIT_V(4); PG8_BAR;
        PG8_STAGE(PG8_SB(1, 0), cB + kstep, voffB); PG8_STAGE(PG8_SA(1, 0), cA + kstep, voffA); PG8_STAGE(PG8_SB(1, 1), cB + hstep + kstep, voffB);
        PG8_WAIT_V(6); PG8_BAR;
    }
    for (;;) {
        const bool has_next = S.next(ui + 1, nxt);
        const char* nA = has_next ? (const char*)g.A + (size_t)nxt.pm * tstep : cA; const char* nB = has_next ? (const char*)g.Bt + (size_t)nxt.pn * tstep : cB;
        for (int t = 0; t < nt; t += 2) {
            const bool last = (t == nt - 2);
            const char* a1 = cA + (size_t)(t + 1) * kstep;
            const char* a2 = last ? nA : cA + (size_t)(t + 2) * kstep; const char* b2 = last ? nB : cB + (size_t)(t + 2) * kstep;
            const char* a3 = a2 + kstep; const char* b3 = b2 + kstep;
            if (last && has_next) S.a_ready(nxt);
            if constexpr (SP2) {
            PG8_LDB(B0, 0, 0); PG8_LDB(B1, 0, 1); PG8_SCHED; PG8_LDA(At, 0, 0); PG8_STAGE(PG8_SA(1, 1), a1 + hstep, voffA);
            PG8_WAIT_V(8); PG8_WAIT_L(0); PG8_BAR; PG8_MMA(0, 0, At, B0); PG8_MMA(0, 1, At, B1); PG8_BAR; PG8_SCHED;
            PG8_LDA(At, 0, 1); PG8_STAGE(PG8_SB(0, 0), b2, voffB); PG8_STAGE(PG8_SB(0, 1), b2 + hstep, voffB); PG8_STAGE(PG8_SA(0, 0), a2, voffA);
            PG8_WAIT_V(8); PG8_WAIT_L(0); PG8_BAR; PG8_MMA(1, 0, At, B0); PG8_MMA(1, 1, At, B1); PG8_BAR; PG8_SCHED;
            PG8_LDB(B0, 1, 0); PG8_LDB(B1, 1, 1); PG8_SCHED; PG8_LDA(At, 1, 0); PG8_STAGE(PG8_SA(0, 1), a2 + hstep, voffA);
            PG8_WAIT_V(8); PG8_WAIT_L(0); PG8_BAR; PG8_MMA(0, 0, At, B0); PG8_MMA(0, 1, At, B1); PG8_BAR; PG8_SCHED;
            PG8_LDA(At, 1, 1); PG8_STAGE(PG8_SB(1, 0), b3, voffB); PG8_STAGE(PG8_SB(1, 1), b3 + hstep, voffB); PG8_STAGE(PG8_SA(1, 0), a3, voffA);
            PG8_WAIT_V(8); PG8_WAIT_L(0); PG8_BAR; PG8_MMA(1, 0, At, B0); PG8_MMA(1, 1, At, B1); PG8_BAR; PG8_SCHED;
            } else {
            PG8_LDB(B0, 0, 0); PG8_SCHED; PG8_LDA(At, 0, 0); PG8_STAGE(PG8_SA(1, 1), a1 + hstep, voffA);
            PG8_WAIT_L(8); PG8_BAR; PG8_WAIT_L(0); PG8_MMA(0, 0, At, B0); PG8_BAR; PG8_SCHED;
            PG8_LDB(B1, 0, 1); PG8_STAGE(PG8_SB(0, 0), b2, voffB);
            PG8_BAR; PG8_WAIT_L(0); PG8_MMA(0, 1, At, B1); PG8_BAR;
            PG8_LDA(At, 0, 1); PG8_STAGE(PG8_SA(0, 0), a2, voffA);
            PG8_BAR; PG8_WAIT_L(0); PG8_MMA(1, 0, At, B0); PG8_BAR; PG8_SCHED;
            PG8_STAGE(PG8_SB(0, 1), b2 + hstep, voffB);
            PG8_WAIT_V(6); PG8_BAR; PG8_MMA(1, 1, At, B1); PG8_BAR;
            PG8_LDB(B0, 1, 0); PG8_SCHED; PG8_LDA(At, 1, 0); PG8_STAGE(PG8_SA(0, 1), a2 + hstep, voffA);
            PG8_WAIT_L(8); PG8_BAR; PG8_WAIT_L(0); PG8_MMA(0, 0, At, B0); PG8_BAR; PG8_SCHED;
            PG8_LDB(B1, 1, 1); PG8_STAGE(PG8_SB(1, 0), b3, voffB);
            PG8_BAR; PG8_WAIT_L(0); PG8_MMA(0, 1, At, B1); PG8_BAR;
            PG8_LDA(At, 1, 1); PG8_STAGE(PG8_SA(1, 0), a3, voffA);
            PG8_BAR; PG8_WAIT_L(0); PG8_MMA(1, 0, At, B0); PG8_BAR; PG8_SCHED;
            PG8_STAGE(PG8_SB(1, 1), b3 + hstep, voffB);
            PG8_WAIT_V(6); PG8_BAR; PG8_MMA(1, 1, At, B1); PG8_BAR;
            }
        }
        if constexpr (ALIGN_EPI) { if (wr == 0) PG8_BAR; }
        if constexpr (!Epi::AFTER_DRAIN) { E(acc, cur, wr, wc, fr, fq); S.done(cur); }
        if (!has_next) break;
#pragma unroll
        for (int a = 0; a < 2; ++a)
#pragma unroll
            for (int b = 0; b < 2; ++b)
#pragma unroll
                for (int m = 0; m < 4; ++m)
#pragma unroll
                    for (int n = 0; n < 2; ++n) acc[a][b][m][n] = (f32x4){0.f, 0.f, 0.f, 0.f};
        cur = nxt; cA = nA; cB = nB; ++ui;
        if constexpr (ALIGN_EPI) { if (wr == 1) PG8_BAR; }
    }
    PG8_WAIT_V(0);
    if constexpr (!ALIGN_EPI) { if (wr == 0) PG8_BAR; }
    PG8_BAR;
    if constexpr (Epi::AFTER_DRAIN) { E.fused(acc, cur, wr, wc, fr, fq, lds, wid, lane); S.done(cur); }
#undef PG8_SA
#undef PG8_SB
#undef PG8_STAGE
#undef PG8_LDA
#undef PG8_LDB
#undef PG8_MMA
#undef PG8_WAIT_V
#undef PG8_WAIT_L
#undef PG8_BAR
#undef PG8_SCHED
}
template <class Epi, class Sched>
__device__ __forceinline__ void gemm_phase_gather(PG8_LAS unsigned char* lds, const Gemm g, const Sched& S, const Epi& E) {
    int tid_ = threadIdx.x; asm volatile("" : "+v"(tid_));
    const int tid = tid_, wid = __builtin_amdgcn_readfirstlane(tid >> 6), lane = tid & 63, wr = wid >> 2, wc = wid & 3, fr = lane & 15, fq = lane >> 4;
    const int K = g.K, nt = K / BK;
    constexpr bool ALIGN_EPI = true, SP2 = true;
    unsigned voffB[2]; unsigned vc[2][2], vn[2][2]; int RA[2], CA[2];
#pragma unroll
    for (int i = 0; i < 2; ++i) { int R, C; stage_rc(tid * 16 + i * 8192, R, C); const int Rb = Epi::PERM ? ((R & ~31) + perm32(R & 31)) : R;
        RA[i] = R; CA[i] = C; voffB[i] = (unsigned)(Rb * K + C) * 2u; }
    const size_t kstep = (size_t)(BK * 2);
    const size_t hstep = (size_t)HALF * K * 2;
    const size_t tstep = 2 * hstep;
    const unsigned ldsw = (unsigned)wid * 1024u;
    const int aoff = lds_byte(wr * 64 + fr, fq * 8), boff = lds_byte(wc * 32 + fr, fq * 8);
#define PG8_SA(b, h) (((b) * 2 + (h)) * HTB)
#define PG8_SB(b, h) ((4 + (b) * 2 + (h)) * HTB)
#define PG8_STAGE(bufoff, gbase, voff) do { _Pragma("unroll") for (int _i = 0; _i < 2; ++_i) \
        __builtin_amdgcn_global_load_lds((const unsigned*)((const char*)(gbase) + (voff)[_i]), (PG8_LAS unsigned*)(lds + (bufoff) + ldsw + _i * 8192), 16, 0, 0); } while (0)
#define PG8_LDA(dst, b, h) do { _Pragma("unroll") for (int m = 0; m < 4; ++m) _Pragma("unroll") for (int k = 0; k < 2; ++k) dst[m][k] = *(const PG8_LAS bf16x8*)(lds + PG8_SA(b, h) + aoff + m * 2048 + k * 1024); } while (0)
#define PG8_LDB(dst, b, h) do { _Pragma("unroll") for (int n = 0; n < 2; ++n) _Pragma("unroll") for (int k = 0; k < 2; ++k) dst[n][k] = *(const PG8_LAS bf16x8*)(lds + PG8_SB(b, h) + boff + n * 2048 + k * 1024); } while (0)
#define PG8_MMA(ai, bj, At, Bt) do { __builtin_amdgcn_s_setprio(1); _Pragma("unroll") for (int m = 0; m < 4; ++m) _Pragma("unroll") for (int n = 0; n < 2; ++n) _Pragma("unroll") for (int k = 0; k < 2; ++k) \
        acc[ai][bj][m][n] = __builtin_amdgcn_mfma_f32_16x16x32_bf16(Bt[n][k], At[m][k], acc[ai][bj][m][n], 0, 0, 0); __builtin_amdgcn_s_setprio(0); } while (0)
#define PG8_WAIT_V(n) asm volatile("s_waitcnt vmcnt(" #n ")" ::: "memory")
#define PG8_WAIT_L(n) asm volatile("s_waitcnt lgkmcnt(" #n ")" ::: "memory")
#define PG8_BAR __builtin_amdgcn_s_barrier()
#define PG8_SCHED __builtin_amdgcn_sched_barrier(0)
    Unit cur, nxt; int ui = 0;
    if (!S.next(0, cur)) return;
    f32x4 acc[2][2][4][2];
#pragma unroll
    for (int a = 0; a < 2; ++a)
#pragma unroll
        for (int b = 0; b < 2; ++b)
#pragma unroll
            for (int m = 0; m < 4; ++m)
#pragma unroll
                for (int n = 0; n < 2; ++n) acc[a][b][m][n] = (f32x4){0.f, 0.f, 0.f, 0.f};
    bf16x8 At[4][2], B0[2][2], B1[2][2];
    const char* kA = (const char*)g.A; const char* cB = (const char*)g.Bt + (size_t)cur.pn * tstep;
#define PG8_ROWS(dst, tab) do { _Pragma("unroll") for (int _h = 0; _h < 2; ++_h) _Pragma("unroll") for (int _i = 0; _i < 2; ++_i) \
        dst[_h][_i] = (unsigned)((tab)[_h * HALF + RA[_i]] * K + CA[_i]) * 2u; } while (0)
    { const PG8_LAS int* tab = S.arows(0); PG8_ROWS(vc, tab); }
    S.a_ready(cur);
    if constexpr (SP2) {
        PG8_STAGE(PG8_SB(0, 0), cB, voffB); PG8_STAGE(PG8_SB(0, 1), cB + hstep, voffB); PG8_STAGE(PG8_SA(0, 0), kA, vc[0]); PG8_STAGE(PG8_SA(0, 1), kA, vc[1]);
        if (wr == 1) PG8_BAR;
        PG8_WAIT_V(2); PG8_BAR;
        PG8_STAGE(PG8_SB(1, 0), cB + kstep, voffB); PG8_STAGE(PG8_SA(1, 0), kA + kstep, vc[0]); PG8_STAGE(PG8_SB(1, 1), cB + hstep + kstep, voffB);
        PG8_WAIT_V(6); PG8_BAR;
    }
    for (;;) {
        const bool has_next = S.next(ui + 1, nxt);
        const char* nB = has_next ? (const char*)g.Bt + (size_t)nxt.pn * tstep : cB;
        if (has_next) { const PG8_LAS int* tab = S.arows(ui + 1); PG8_ROWS(vn, tab); } else { _Pragma("unroll") for (int _h = 0; _h < 2; ++_h) { vn[_h][0] = vc[_h][0]; vn[_h][1] = vc[_h][1]; } }
        for (int t = 0; t < nt; t += 2) {
            const bool last = (t == nt - 2);
            const char* a1 = kA + (size_t)(t + 1) * kstep;
            const char* a2 = last ? kA : kA + (size_t)(t + 2) * kstep; const char* b2 = last ? nB : cB + (size_t)(t + 2) * kstep;
            unsigned v0[2], v1[2]; v0[0] = last ? vn[0][0] : vc[0][0]; v0[1] = last ? vn[0][1] : vc[0][1]; v1[0] = last ? vn[1][0] : vc[1][0]; v1[1] = last ? vn[1][1] : vc[1][1];
            const char* a3 = a2 + kstep; const char* b3 = b2 + kstep;
            if (last && has_next) S.a_ready(nxt);
            if constexpr (SP2) {
            PG8_LDB(B0, 0, 0); PG8_LDB(B1, 0, 1); PG8_SCHED; PG8_LDA(At, 0, 0); PG8_STAGE(PG8_SA(1, 1), a1, vc[1]);
            PG8_WAIT_V(8); PG8_WAIT_L(0); PG8_BAR; PG8_MMA(0, 0, At, B0); PG8_MMA(0, 1, At, B1); PG8_BAR; PG8_SCHED;
            PG8_LDA(At, 0, 1); PG8_STAGE(PG8_SB(0, 0), b2, voffB); PG8_STAGE(PG8_SB(0, 1), b2 + hstep, voffB); PG8_STAGE(PG8_SA(0, 0), a2, v0);
            PG8_WAIT_V(8); PG8_WAIT_L(0); PG8_BAR; PG8_MMA(1, 0, At, B0); PG8_MMA(1, 1, At, B1); PG8_BAR; PG8_SCHED;
            PG8_LDB(B0, 1, 0); PG8_LDB(B1, 1, 1); PG8_SCHED; PG8_LDA(At, 1, 0); PG8_STAGE(PG8_SA(0, 1), a2, v1);
            PG8_WAIT_V(8); PG8_WAIT_L(0); PG8_BAR; PG8_MMA(0, 0, At, B0); PG8_MMA(0, 1, At, B1); PG8_BAR; PG8_SCHED;
            PG8_LDA(At, 1, 1); PG8_STAGE(PG8_SB(1, 0), b3, voffB); PG8_STAGE(PG8_SB(1, 1), b3 + hstep, voffB); PG8_STAGE(PG8_SA(1, 0), a3, v0);
            PG8_WAIT_V(8); PG8_WAIT_L(0); PG8_BAR; PG8_MMA(1, 0, At, B0); PG8_MMA(1, 1, At, B1); PG8_BAR; PG8_SCHED;
            }
        }
        if constexpr (ALIGN_EPI) { if (wr == 0) PG8_BAR; }
        if constexpr (!Epi::AFTER_DRAIN) { E(acc, cur, wr, wc, fr, fq); S.done(cur); }
        if (!has_next) break;
#pragma unroll
        for (int a = 0; a < 2; ++a)
#pragma unroll
            for (int b = 0; b < 2; ++b)
#pragma unroll
                for (int m = 0; m < 4; ++m)
#pragma unroll
                    for (int n = 0; n < 2; ++n) acc[a][b][m][n] = (f32x4){0.f, 0.f, 0.f, 0.f};
        cur = nxt; cB = nB; ++ui;
#pragma unroll
        for (int _h = 0; _h < 2; ++_h) { vc[_h][0] = vn[_h][0]; vc[_h][1] = vn[_h][1]; }
        if constexpr (ALIGN_EPI) { if (wr == 1) PG8_BAR; }
    }
    PG8_WAIT_V(0);
    if constexpr (!ALIGN_EPI) { if (wr == 0) PG8_BAR; }
    PG8_BAR;
    if constexpr (Epi::AFTER_DRAIN) { E.fused(acc, cur, wr, wc, fr, fq, lds, wid, lane); S.done(cur); }
#undef PG8_ROWS
#undef PG8_SA
#undef PG8_SB
#undef PG8_STAGE
#undef PG8_LDA
#undef PG8_LDB
#undef PG8_MMA
#undef PG8_WAIT_V
#undef PG8_WAIT_L
#undef PG8_BAR
#undef PG8_SCHED
}
}
constexpr int NWAVES = 8, NTHR = 512;
constexpr int DM = 1024, NLAT = 32768, NCTX = 2048, NROWS = 34816, INC = 3328;
constexpr int OFF_CB = 0, OFF_CC = 256, OFF_CX = 512, OFF_Q = 768, OFF_K = 1280, OFF_V = 1792, OFF_G = 2304, OFF_U = 2816, OFF_VV = 3072;
constexpr int NCH = 34;
constexpr float LN_EPS = 1e-5f, ALPHA = 1.41421356237309515f;
constexpr size_t MiB = 1u << 20;
constexpr size_t WS_CTL = 0, CTL_ZERO_BYTES = MiB, WS_MOD = 1 * MiB, WS_LG = 1 * MiB + 480 * 1024, WS_WR = 1 * MiB + 512 * 1024, WS_TOK = 2 * MiB, WS_SGUW = 3 * MiB + 256 * 1024, WS_ROWOF = 3 * MiB + 512 * 1024, WS_WIN = 4 * MiB, WS_WOUT = 17 * MiB, WS_WGU = 21 * MiB, WS_WD = 149 * MiB,
                 WS_HB = 213 * MiB, WS_ST = WS_HB, WS_XCTX = 281 * MiB, WS_P = 289 * MiB, WS_YMIX = 510 * MiB, WS_XB = WS_P, WS_Y = WS_P, WS_YO = WS_P, WS_HH = WS_P + 152 * MiB, WS_END = 578 * MiB;
constexpr int CW_TMO = 0, CW_BAR = 4096, CW_WGCNT = 16384, CW_TOT = 32768, CW_DQ = 33024;
constexpr int RING_BYTES = 131072, LDSCTL_OFF = RING_BYTES, MISC_OFF = LDSCTL_OFF + 320, P2E_OFF = LDSCTL_OFF + 1024, PST_OFF = LDSCTL_OFF + 2048, LDS_BYTES = 147456;
constexpr int MAXPANELS = 304;
constexpr int LCNT_OFF = LDSCTL_OFF + 4096, LG_OFF = LDSCTL_OFF + 4352, DQ_OFF = LDSCTL_OFF + 9600, AROWS_OFF = LDSCTL_OFF + 9728;

#define GAS __attribute__((address_space(1)))
#define LAS __attribute__((address_space(3)))
typedef unsigned short bf16;
typedef unsigned v4u __attribute__((ext_vector_type(4)));
typedef unsigned v2u __attribute__((ext_vector_type(2)));
typedef float f32x4 __attribute__((ext_vector_type(4)));
#define LDS_WAIT() asm volatile("s_waitcnt lgkmcnt(0)" ::: "memory")
#define VM_WAIT() asm volatile("s_waitcnt vmcnt(0)" ::: "memory")
__device__ __forceinline__ unsigned f2bf(float f) { unsigned u = __builtin_bit_cast(unsigned, f); return (u + 0x7fffu + ((u >> 16) & 1u)) >> 16; }
__device__ __forceinline__ unsigned pk2(float lo, float hi) { return f2bf(lo) | (f2bf(hi) << 16); }
typedef float f32x2_t __attribute__((ext_vector_type(2))); typedef __bf16 bf16x2_t __attribute__((ext_vector_type(2)));
__device__ __forceinline__ unsigned cvtpk(float lo, float hi) { f32x2_t v = {lo, hi}; bf16x2_t b = __builtin_convertvector(v, bf16x2_t); return __builtin_bit_cast(unsigned, b); }
__device__ __forceinline__ float bflo(unsigned w) { return __builtin_bit_cast(float, w << 16); }
__device__ __forceinline__ float bfhi(unsigned w) { return __builtin_bit_cast(float, w & 0xffff0000u); }
__device__ __forceinline__ float wave_sum(float v) {
#pragma unroll
    for (int o = 1; o < 64; o <<= 1) v += __shfl_xor(v, o);
    return v;
}
__device__ __forceinline__ float log_sigmoid_f(float x) { return -(fmaxf(-x, 0.f) + log1pf(expf(-fabsf(x)))); }

struct Args { const float* in[24]; float* out; unsigned char* ws; int ph_lo, ph_hi; };
#define XB_TMO      128
#define XB_XCNT(j)  (256  + 64 * (j))
#define XB_XSUB(j)  (1280 + 64 * (j))
#define XB_XGEN(j)  (2304 + 64 * (j))
#define XB_TOP      3328
#define XB_TOPGEN   3392
#define XCD_BAR_WORDS 3456
#define XB_SPIN_CAP (1u << 18)

__device__ __forceinline__ unsigned xb_ld(unsigned* p)              { return __hip_atomic_load(p, __ATOMIC_RELAXED, __HIP_MEMORY_SCOPE_AGENT); }
__device__ __forceinline__ unsigned xb_add(unsigned* p, unsigned v) { return __hip_atomic_fetch_add(p, v, __ATOMIC_RELAXED, __HIP_MEMORY_SCOPE_AGENT); }
__device__ __forceinline__ unsigned xb_xcc_id() { return (unsigned)__builtin_amdgcn_s_getreg((3 << 11) | 20) & 0xFu; }
#define XB_SPIN(cond, bar) do { unsigned _sp = 0; while (cond) { __builtin_amdgcn_s_sleep(1); \
    if ((++_sp & 255u) == 0u) { if (xb_ld(&(bar)[XB_TMO])) break; if (_sp > XB_SPIN_CAP) { atomicAdd(&(bar)[XB_TMO], 1u); break; } } } } while (0)

struct XcdBarrier {
    unsigned* bar; unsigned x;
    volatile LAS unsigned* st;
};

__device__ __forceinline__ XcdBarrier xcd_barrier_post(unsigned* bar, volatile LAS unsigned* st) {
    XcdBarrier b; b.bar = bar; b.x = xb_xcc_id(); b.st = st;
    if (threadIdx.x == 0) (void)xb_add(&bar[XB_XCNT(b.x)], 1u);
    return b;
}
__device__ __forceinline__ void xcd_barrier_complete(unsigned* bar, unsigned x, unsigned& nloc, unsigned& nx) {
    const unsigned G = gridDim.x * gridDim.y * gridDim.z;
    unsigned sum, cnt, mine, sp = 0u;
    for (;;) {
        sum = 0u; cnt = 0u; mine = 0u;
#pragma unroll
        for (unsigned j = 0; j < 16; ++j) { const unsigned c = xb_ld(&bar[XB_XCNT(j)]); sum += c; cnt += (c > 0u) ? 1u : 0u; mine = (j == x) ? c : mine; }
        if (sum == G) break;
        __builtin_amdgcn_s_sleep(1);
        if ((++sp & 255u) == 0u) { if (xb_ld(&bar[XB_TMO])) break; if (sp > XB_SPIN_CAP) { atomicAdd(&bar[XB_TMO], 1u); break; } }
    }
    nloc = mine > 0u ? mine : 1u; nx = cnt > 0u ? cnt : 1u;
}

__device__ __forceinline__ void xcd_barrier(const XcdBarrier& b) {
    asm volatile("s_waitcnt vmcnt(0)" ::: "memory");
    __syncthreads();
    if (threadIdx.x == 0) {
        unsigned* bar = b.bar;
        __builtin_amdgcn_s_waitcnt(0);
        unsigned nloc = b.st[0], nx = b.st[1];
        if (nloc == 0u) { xcd_barrier_complete(bar, b.x, nloc, nx); b.st[0] = nloc; b.st[1] = nx; }
        const unsigned old = xb_add(&bar[XB_XSUB(b.x)], 1u);
        const unsigned gen = old / nloc;
        if (old + 1u == (gen + 1u) * nloc) {
            __builtin_amdgcn_fence(__ATOMIC_RELEASE, "agent");
            asm volatile("s_waitcnt vmcnt(0)" ::: "memory");
            const unsigned og = xb_add(&bar[XB_TOP], 1u);
            const unsigned tg = og / nx;
            if (og + 1u == (tg + 1u) * nx) xb_add(&bar[XB_TOPGEN], 1u);
            else XB_SPIN(xb_ld(&bar[XB_TOPGEN]) == tg, bar);
            __builtin_amdgcn_fence(__ATOMIC_ACQUIRE, "agent");
            xb_add(&bar[XB_XGEN(b.x)], 1u);
            asm volatile("s_waitcnt vmcnt(0)" ::: "memory");
        } else {
            XB_SPIN(xb_ld(&bar[XB_XGEN(b.x)]) == gen, bar);
            __builtin_amdgcn_fence(__ATOMIC_ACQUIRE, "agent");
            asm volatile("s_waitcnt vmcnt(0)" ::: "memory");
        }
    }
    __syncthreads();
}
__device__ __forceinline__ void transpose_tile(const float* Wsrc, int ldn, bf16* dst, int ldk, float scale, LAS float* scr, int lane) {
#pragma unroll 8
    for (int i = 0; i < 32; ++i) { const int kk = 2 * i + (lane >> 5); scr[kk * 33 + (lane & 31)] = Wsrc[(size_t)kk * ldn + (lane & 31)] * scale; }
    LDS_WAIT(); asm volatile("" ::: "memory");
    const int c = lane & 7;
#pragma unroll
    for (int j = 0; j < 4; ++j) { const int n = (lane >> 3) + 8 * j; const LAS float* s = scr + (8 * c) * 33 + n;
        v4u o; o.x = pk2(s[0 * 33], s[1 * 33]); o.y = pk2(s[2 * 33], s[3 * 33]); o.z = pk2(s[4 * 33], s[5 * 33]); o.w = pk2(s[6 * 33], s[7 * 33]);
        *(GAS v4u*)(dst + (size_t)n * ldk + 8 * c) = o; }
    LDS_WAIT(); asm volatile("" ::: "memory");
}

__device__ __forceinline__ void phase_p0(const Args& a, LAS unsigned char* lds, int tid, int lane, int wave) {
    const int G = gridDim.x;
    {
        LAS float* s = (LAS float*)lds; LAS float* red = (LAS float*)(lds + 36864);
        const float* c = a.in[1]; const float* cctx = a.in[3]; const float* wada = a.in[4]; const float* bada = a.in[5];
        float* mod = (float*)(a.ws + WS_MOD);
        for (int u = blockIdx.x; u < 192; u += G) {
            const int l = u / 96, j0 = (u % 96) * 64;
            for (int i = tid; i < 9 * 1024; i += NTHR) { const int r = i >> 10, k = i & 1023; const float v = r < 8 ? c[r * 1024 + k] : cctx[k]; s[i] = v / (1.0f + expf(-v)); }
            __syncthreads();
            const int jq = tid & 15, kg = tid >> 4;
            float acc[9][4];
#pragma unroll
            for (int r = 0; r < 9; ++r) { acc[r][0] = 0.f; acc[r][1] = 0.f; acc[r][2] = 0.f; acc[r][3] = 0.f; }
            const float* w = wada + (size_t)l * 1024 * 6144 + j0 + jq * 4;
            for (int k = kg; k < 1024; k += 32) { const f32x4 wv = *(const f32x4*)(w + (size_t)k * 6144);
#pragma unroll
                for (int r = 0; r < 9; ++r) { const float sr = s[r * 1024 + k]; acc[r][0] += sr * wv.x; acc[r][1] += sr * wv.y; acc[r][2] += sr * wv.z; acc[r][3] += sr * wv.w; } }
#pragma unroll
            for (int r = 0; r < 9; ++r)
#pragma unroll
                for (int i = 0; i < 4; ++i) red[(kg * 9 + r) * 64 + jq * 4 + i] = acc[r][i];
            __syncthreads();
            for (int o = tid; o < 576; o += NTHR) { const int r = o >> 6, j = o & 63; float sum = 0.f;
                for (int g2 = 0; g2 < 32; ++g2) sum += red[(g2 * 9 + r) * 64 + j];
                mod[(l * 9 + r) * 6144 + j0 + j] = sum + bada[l * 6144 + j0 + j]; }
            __syncthreads();
        }
    }
    {
        LAS float* scr = (LAS float*)(lds + wave * 16384);
        const int gw = blockIdx.x * NWAVES + wave, NGW = G * NWAVES;
        const float* w_in = a.in[6]; const float* w_out = a.in[12]; const float* w_gate = a.in[19]; const float* w_up = a.in[20]; const float* w_down = a.in[21];
        bf16* WIN = (bf16*)(a.ws + WS_WIN); bf16* WOUT = (bf16*)(a.ws + WS_WOUT); bf16* WGU = (bf16*)(a.ws + WS_WGU); bf16* WD = (bf16*)(a.ws + WS_WD);
        constexpr int I_IN = 2 * 16 * 104, I_OUT = 2 * 16 * 32, I_GU = 2 * 2 * 32 * 256, I_D = 2 * 32 * 256, NITEMS = I_IN + I_OUT + I_GU + I_D;
        for (int it = gw; it < NITEMS; it += NGW) {
            int r = it;
            if (r < I_IN) { const int l = r / 1664, q = r % 1664, k0 = 64 * (q / 104), n0 = 32 * (q % 104);
                const float sc = (n0 >= OFF_K && n0 < OFF_V) ? 0.125f : 1.0f;
                transpose_tile(w_in + ((size_t)l * 1024 + k0) * INC + n0, INC, WIN + ((size_t)l * INC + n0) * 1024 + k0, 1024, sc, scr, lane); continue; }
            r -= I_IN;
            if (r < I_OUT) { const int l = r / 512, q = r % 512, k0 = 64 * (q / 32), n0 = 32 * (q % 32);
                transpose_tile(w_out + ((size_t)l * 1024 + k0) * 1024 + n0, 1024, WOUT + ((size_t)l * 1024 + n0) * 1024 + k0, 1024, 1.0f, scr, lane); continue; }
            r -= I_OUT;
            if (r < I_GU) { const int isup = r >= (I_GU / 2) ? 1 : 0; r -= isup * (I_GU / 2);
                const int le = r / 256, q = r % 256, k0 = 64 * (q / 16), n0 = 32 * (q % 16);
                const float* src = (isup ? w_up : w_gate) + ((size_t)le * 1024 + k0) * 512 + n0;
                const int drow = (n0 >> 7) * 256 + (n0 & 127) + isup * 128;
                transpose_tile(src, 512, WGU + ((size_t)le * 1024 + drow) * 1024 + k0, 1024, 1.0f, scr, lane); continue; }
            r -= I_GU;
            { const int le = r / 256, q = r % 256, k0 = 64 * (q / 32), n0 = 32 * (q % 32);
                transpose_tile(w_down + ((size_t)le * 512 + k0) * 1024 + n0, 1024, WD + ((size_t)le * 1024 + n0) * 512 + k0, 512, 1.0f, scr, lane); }
        }
    }
    { bf16* SW = (bf16*)(a.ws + WS_SGUW); const float* sw = a.in[10];
      for (int i = blockIdx.x * NTHR + tid; i < 2 * 4 * 128 * 128; i += G * NTHR) SW[i] = (bf16)f2bf(sw[i]); }
    if (blockIdx.x == 0 && tid < 32) { const int dir = tid & 1, lh = tid >> 1; ((float*)(a.ws + WS_LG))[tid] = log_sigmoid_f(a.in[8 + dir][lh]); }
    {
        bf16* WR = (bf16*)(a.ws + WS_WR);
        for (int i = blockIdx.x * NTHR + tid; i < 2 * 64 * 1024; i += G * NTHR) { const int l = i >> 16, j = (i >> 10) & 63, k = i & 1023;
            float v = 0.f;
            if (j < 4) v = a.in[15][((size_t)l * 1024 + k) * 4 + j]; else if (j < 36) v = a.in[17][(((size_t)l * 4 + ((j - 4) >> 3)) * 1024 + k) * 8 + ((j - 4) & 7)];
            const unsigned hi = f2bf(v); const float r = v - __builtin_bit_cast(float, hi << 16);
            WR[((size_t)(l * 2) * 64 + j) * 1024 + k] = (bf16)hi; WR[((size_t)(l * 2 + 1) * 64 + j) * 1024 + k] = (bf16)f2bf(r); }
    }
    __syncthreads();
}

__device__ __forceinline__ void phase_p1(const Args& a, int lane, int wave) {
    const int gw = blockIdx.x * NWAVES + wave, NGW = gridDim.x * NWAVES;
    const float* mod = (const float*)(a.ws + WS_MOD); bf16* Hb = (bf16*)(a.ws + WS_HB);
    for (int row = gw; row < NROWS; row += NGW) {
        const float* src = row < NLAT ? a.in[0] + (size_t)row * 1024 : a.in[2] + (size_t)(row - NLAT) * 1024;
        const float* m0 = mod + (row < NLAT ? (row >> 12) : 8) * 6144;
#pragma unroll
        for (int j = 0; j < 4; ++j) { const int idx = (lane + 64 * j) * 4;
            const f32x4 v = *(const f32x4*)(src + idx), sh = *(const f32x4*)(m0 + idx), sc = *(const f32x4*)(m0 + 1024 + idx);
            const f32x4 o = v * (sc + 1.0f) + sh; v2u w; w.x = pk2(o.x, o.y); w.y = pk2(o.z, o.w);
            *(v2u*)(Hb + (size_t)row * 1024 + idx) = w; }
    }
}

__device__ __forceinline__ int chunk_row0(int b, int c) { return c < 2 ? NLAT + b * 256 + c * 128 : b * 4096 + (c - 2) * 128; }
__device__ __forceinline__ size_t st_off(int b, int c, int h, int dir) { return ((((size_t)b * NCH + c) * 8 + h) * 2 + dir) * 4096; }

__device__ __forceinline__ void phase_b(const Args& a, int l, LAS unsigned char* lds, int tid) {
    const bf16* P = (const bf16*)(a.ws + WS_P); float* ST = (float*)(a.ws + WS_ST);
    LAS float* Ks = (LAS float*)lds; LAS float* Vs = (LAS float*)(lds + 32768); LAS float* pf = (LAS float*)(lds + 65536); LAS float* pb = pf + 128;
    for (int u = blockIdx.x; u < 8 * NCH * 8; u += gridDim.x) {
        const int b = u / (NCH * 8), c = (u % (NCH * 8)) / 8, h = u % 8; const int row0 = chunk_row0(b, c);
        __syncthreads();
        if (tid < 128) { const float lgf = log_sigmoid_f(a.in[8][l * 8 + h]), lgb = log_sigmoid_f(a.in[9][l * 8 + h]);
            pf[tid] = expf(lgf * (float)(127 - tid)); pb[tid] = expf(lgb * (float)tid); }
        { const int j = tid >> 2, part = tid & 3; const bf16* kp = P + (size_t)(row0 + j) * INC + OFF_K + h * 64 + part * 16; const bf16* vp = kp + (OFF_V - OFF_K);
#pragma unroll
          for (int q = 0; q < 2; ++q) { const v4u kw = *(const v4u*)(kp + 8 * q), vw = *(const v4u*)(vp + 8 * q);
              LAS float* kd = Ks + j * 64 + part * 16 + 8 * q; LAS float* vd = Vs + j * 64 + part * 16 + 8 * q;
              kd[0] = bflo(kw.x); kd[1] = bfhi(kw.x); kd[2] = bflo(kw.y); kd[3] = bfhi(kw.y); kd[4] = bflo(kw.z); kd[5] = bfhi(kw.z); kd[6] = bflo(kw.w); kd[7] = bfhi(kw.w);
              vd[0] = bflo(vw.x); vd[1] = bfhi(vw.x); vd[2] = bflo(vw.y); vd[3] = bfhi(vw.y); vd[4] = bflo(vw.z); vd[5] = bfhi(vw.z); vd[6] = bflo(vw.w); vd[7] = bfhi(vw.w); } }
        __syncthreads();
        const int d = tid >> 3, e0 = (tid & 7) * 8;
        float af[8], ab[8];
#pragma unroll
        for (int i = 0; i < 8; ++i) { af[i] = 0.f; ab[i] = 0.f; }
        for (int j = 0; j < 128; ++j) { const float kd = Ks[j * 64 + d], kf = kd * pf[j], kb = kd * pb[j];
            const f32x4 v0 = *(const LAS f32x4*)(Vs + j * 64 + e0), v1 = *(const LAS f32x4*)(Vs + j * 64 + e0 + 4);
            af[0] += kf * v0.x; af[1] += kf * v0.y; af[2] += kf * v0.z; af[3] += kf * v0.w; af[4] += kf * v1.x; af[5] += kf * v1.y; af[6] += kf * v1.z; af[7] += kf * v1.w;
            ab[0] += kb * v0.x; ab[1] += kb * v0.y; ab[2] += kb * v0.z; ab[3] += kb * v0.w; ab[4] += kb * v1.x; ab[5] += kb * v1.y; ab[6] += kb * v1.z; ab[7] += kb * v1.w; }
        float* o0 = ST + st_off(b, c, h, 0) + d * 64 + e0; float* o1 = ST + st_off(b, c, h, 1) + d * 64 + e0;
        *(f32x4*)o0 = (f32x4){af[0], af[1], af[2], af[3]}; *(f32x4*)(o0 + 4) = (f32x4){af[4], af[5], af[6], af[7]};
        *(f32x4*)o1 = (f32x4){ab[0], ab[1], ab[2], ab[3]}; *(f32x4*)(o1 + 4) = (f32x4){ab[4], ab[5], ab[6], ab[7]};
    }
    __syncthreads();
}

__device__ __forceinline__ void phase_c(const Args& a, int l, int tid) {
    bf16* ST = (bf16*)(a.ws + WS_ST);
    for (int it = blockIdx.x * NTHR + tid; it < 8 * 8 * 2 * 1024; it += gridDim.x * NTHR) {
        const int q = it & 1023, dir = (it >> 10) & 1, h = (it >> 11) & 7, b = it >> 14;
        const float lg = ((const float*)(a.ws + WS_LG))[(l * 8 + h) * 2 + dir]; const float dec = __expf(128.0f * lg);
        v2u kv[NCH];
#pragma unroll
        for (int s = 0; s < NCH; ++s) { const int c = dir ? (s < 2 ? 1 - s : 35 - s) : s; kv[s] = *(const v2u*)(ST + st_off(b, c, h, dir) + q * 4); }
        f32x4 st = (f32x4){0.f, 0.f, 0.f, 0.f};
#pragma unroll
        for (int s = 0; s < NCH; ++s) { const int c = dir ? (s < 2 ? 1 - s : 35 - s) : s;
            v2u w; w.x = cvtpk(st.x, st.y); w.y = cvtpk(st.z, st.w); *(v2u*)(ST + st_off(b, c, h, dir) + q * 4) = w;
            st = st * dec + (f32x4){bflo(kv[s].x), bfhi(kv[s].x), bflo(kv[s].y), bfhi(kv[s].y)}; }
    }
}
__device__ __forceinline__ void unpack8(const v4u w, float* f) { f[0] = bflo(w.x); f[1] = bfhi(w.x); f[2] = bflo(w.y); f[3] = bfhi(w.y); f[4] = bflo(w.z); f[5] = bfhi(w.z); f[6] = bflo(w.w); f[7] = bfhi(w.w); }
__device__ __forceinline__ v4u pack8(const float* f) { v4u w; w.x = pk2(f[0], f[1]); w.y = pk2(f[2], f[3]); w.z = pk2(f[4], f[5]); w.w = pk2(f[6], f[7]); return w; }

__device__ __forceinline__ void phase_d(const Args& a, int l, LAS unsigned char* lds, int tid, int lane) {
    const bf16* P = (const bf16*)(a.ws + WS_P); const float* ST = (const float*)(a.ws + WS_ST); bf16* Y = (bf16*)(a.ws + WS_YMIX);
    const float* convw = a.in[7] + l * 3 * 256; const float* sguw = a.in[10] + (size_t)l * 4 * 128 * 128; const float* sgub = a.in[11] + l * 4 * 128;
    const int c_lo = l == 1 ? 2 : 0, cpb = NCH - c_lo, nunits = 8 * cpb;
    LAS float* Sf = (LAS float*)lds; LAS float* Sb = (LAS float*)(lds + 16384); LAS float* Ks = (LAS float*)(lds + 32768); LAS float* Vs = (LAS float*)(lds + 65536);
    LAS float* VN = (LAS float*)lds;
    for (int u = blockIdx.x; u < nunits; u += gridDim.x) {
        const int b = u / cpb, c = c_lo + u % cpb; const int row0 = chunk_row0(b, c); const bool isc = c < 2;
#ifndef NO_D1
        for (int idx = tid; idx < 128 * 32; idx += NTHR) {
            const int p = idx >> 5, ch0 = (idx & 31) * 8; const int row = row0 + p;
            int dprev = -1, dnext = 1; bool vprev, vnext;
            if (isc) { const int t = c * 128 + p; vprev = t > 0; vnext = t < 255; }
            else { const int t = (c - 2) * 128 + p;
                if (ch0 < 128) { const int col = t & 63; vprev = col > 0; vnext = col < 63; }
                else { const int rg = t >> 6; vprev = rg > 0; vnext = rg < 63; dprev = -64; dnext = 64; } }
            const bf16* pr = P + (size_t)row * INC;
            float cb[8], zc[8], zp[8], zn[8], t0[8], t1[8];
            unpack8(*(const v4u*)(pr + OFF_CB + ch0), cb);
            unpack8(*(const v4u*)(pr + OFF_CC + ch0), t0); unpack8(*(const v4u*)(pr + OFF_CX + ch0), t1);
#pragma unroll
            for (int i = 0; i < 8; ++i) { zc[i] = t0[i] * t1[i]; zp[i] = 0.f; zn[i] = 0.f; }
            if (vprev) { const bf16* q = pr + (ptrdiff_t)dprev * INC; unpack8(*(const v4u*)(q + OFF_CC + ch0), t0); unpack8(*(const v4u*)(q + OFF_CX + ch0), t1);
#pragma unroll
                for (int i = 0; i < 8; ++i) zp[i] = t0[i] * t1[i]; }
            if (vnext) { const bf16* q = pr + (ptrdiff_t)dnext * INC; unpack8(*(const v4u*)(q + OFF_CC + ch0), t0); unpack8(*(const v4u*)(q + OFF_CX + ch0), t1);
#pragma unroll
                for (int i = 0; i < 8; ++i) zn[i] = t0[i] * t1[i]; }
            float o[8];
#pragma unroll
            for (int i = 0; i < 8; ++i) o[i] = cb[i] * (convw[ch0 + i] * zp[i] + convw[256 + ch0 + i] * zc[i] + convw[512 + ch0 + i] * zn[i]);
            *(v4u*)(Y + (size_t)row * 1024 + ch0) = pack8(o);
        }
#endif
        const int i = tid >> 2, part = tid & 3;
#ifndef NO_D2
#pragma unroll 1
        for (int h = 0; h < 8; ++h) {
            __syncthreads();
            { const bf16* kp = P + (size_t)(row0 + i) * INC + OFF_K + h * 64 + part * 16; const bf16* vp = kp + (OFF_V - OFF_K);
#pragma unroll
              for (int q = 0; q < 2; ++q) { float kf[8], vf[8]; unpack8(*(const v4u*)(kp + 8 * q), kf); unpack8(*(const v4u*)(vp + 8 * q), vf);
                  LAS float* kd = Ks + i * 64 + part * 16 + 8 * q; LAS float* vd = Vs + i * 64 + part * 16 + 8 * q;
#pragma unroll
                  for (int e = 0; e < 8; ++e) { kd[e] = kf[e]; vd[e] = vf[e]; } }
              const float* sf = ST + st_off(b, c, h, 0); const float* sb = ST + st_off(b, c, h, 1);
#pragma unroll
              for (int q = 0; q < 2; ++q) { const int o4 = (tid + NTHR * q) * 4; *(LAS f32x4*)(Sf + o4) = *(const f32x4*)(sf + o4); *(LAS f32x4*)(Sb + o4) = *(const f32x4*)(sb + o4); } }
            float qv[16];
            { const bf16* qp = P + (size_t)(row0 + i) * INC + OFF_Q + h * 64 + part * 16; unpack8(*(const v4u*)qp, qv); unpack8(*(const v4u*)(qp + 8), qv + 8); }
            const float lgf = log_sigmoid_f(a.in[8][l * 8 + h]), lgb = log_sigmoid_f(a.in[9][l * 8 + h]);
            __syncthreads();
            float o[16];
#pragma unroll
            for (int e = 0; e < 16; ++e) o[e] = 0.f;
#pragma unroll 1
            for (int j = 0; j < 128; ++j) {
                const LAS f32x4* kr = (const LAS f32x4*)(Ks + j * 64 + part * 16);
                float s = 0.f;
#pragma unroll
                for (int q = 0; q < 4; ++q) { const f32x4 k4 = kr[q]; s += qv[4 * q] * k4.x + qv[4 * q + 1] * k4.y + qv[4 * q + 2] * k4.z + qv[4 * q + 3] * k4.w; }
                s += __shfl_xor(s, 1); s += __shfl_xor(s, 2);
                const int rel = i - j;
                const float dec = rel > 0 ? expf(lgf * (float)rel) : (rel < 0 ? expf(lgb * (float)(-rel)) : 2.0f);
                s *= dec;
                const LAS f32x4* vr = (const LAS f32x4*)(Vs + j * 64 + part * 16);
#pragma unroll
                for (int q = 0; q < 4; ++q) { const f32x4 v4 = vr[q]; o[4 * q] += s * v4.x; o[4 * q + 1] += s * v4.y; o[4 * q + 2] += s * v4.z; o[4 * q + 3] += s * v4.w; }
            }
            float of[16], ob[16];
#pragma unroll
            for (int e = 0; e < 16; ++e) { of[e] = 0.f; ob[e] = 0.f; }
            __syncthreads();
#pragma unroll
            for (int dd = 0; dd < 16; ++dd) Ks[i * 64 + ((part * 16 + dd + i) & 63)] = qv[dd];
            __syncthreads();
#pragma unroll 2
            for (int d = 0; d < 64; ++d) { const float qd = Ks[i * 64 + ((d + i) & 63)];
                const LAS f32x4* fr = (const LAS f32x4*)(Sf + d * 64 + part * 16); const LAS f32x4* br = (const LAS f32x4*)(Sb + d * 64 + part * 16);
#pragma unroll
                for (int q = 0; q < 4; ++q) { const f32x4 f4 = fr[q], b4 = br[q];
                    of[4 * q] += qd * f4.x; of[4 * q + 1] += qd * f4.y; of[4 * q + 2] += qd * f4.z; of[4 * q + 3] += qd * f4.w;
                    ob[4 * q] += qd * b4.x; ob[4 * q + 1] += qd * b4.y; ob[4 * q + 2] += qd * b4.z; ob[4 * q + 3] += qd * b4.w; } }
            const float df = expf(lgf * (float)(i + 1)), db = expf(lgb * (float)(128 - i));
            float sum = 0.f;
#pragma unroll
            for (int e = 0; e < 16; ++e) { o[e] += df * of[e] + db * ob[e]; sum += o[e]; }
            sum += __shfl_xor(sum, 1); sum += __shfl_xor(sum, 2);
            const float mu = sum * (1.0f / 64.0f); float vs = 0.f;
#pragma unroll
            for (int e = 0; e < 16; ++e) { o[e] -= mu; vs += o[e] * o[e]; }
            vs += __shfl_xor(vs, 1); vs += __shfl_xor(vs, 2);
            const float rs = 1.0f / sqrtf(vs * (1.0f / 64.0f) + LN_EPS);
            float gv[16];
            { const bf16* gp = P + (size_t)(row0 + i) * INC + OFF_G + h * 64 + part * 16; unpack8(*(const v4u*)gp, gv); unpack8(*(const v4u*)(gp + 8), gv + 8); }
#pragma unroll
            for (int e = 0; e < 16; ++e) o[e] = (gv[e] / (1.0f + expf(-gv[e]))) * (o[e] * rs);
            bf16* yp = Y + (size_t)(row0 + i) * 1024 + 256 + h * 64 + part * 16;
            *(v4u*)yp = pack8(o); *(v4u*)(yp + 8) = pack8(o + 8);
        }
#endif
#ifndef NO_D3
        __syncthreads();
        {
            const bf16* vp = P + (size_t)(row0 + i) * INC + OFF_VV + part * 64;
            float sum = 0.f;
#pragma unroll 2
            for (int q = 0; q < 8; ++q) { float t8[8]; unpack8(*(const v4u*)(vp + 8 * q), t8);
#pragma unroll
                for (int e = 0; e < 8; ++e) sum += t8[e]; }
            sum += __shfl_xor(sum, 1); sum += __shfl_xor(sum, 2);
            const float mu = sum * (1.0f / 256.0f); float vs = 0.f;
#pragma unroll 2
            for (int q = 0; q < 8; ++q) { float t8[8]; unpack8(*(const v4u*)(vp + 8 * q), t8);
#pragma unroll
                for (int e = 0; e < 8; ++e) { const float dlt = t8[e] - mu; vs += dlt * dlt; } }
            vs += __shfl_xor(vs, 1); vs += __shfl_xor(vs, 2);
            const float rs = 1.0f / sqrtf(vs * (1.0f / 256.0f) + LN_EPS);
            LAS float* dst = VN + (part * 128 + i) * 64;
#pragma unroll 2
            for (int q = 0; q < 8; ++q) { float t8[8]; unpack8(*(const v4u*)(vp + 8 * q), t8);
                *(LAS f32x4*)(dst + 8 * q) = (f32x4){(t8[0] - mu) * rs, (t8[1] - mu) * rs, (t8[2] - mu) * rs, (t8[3] - mu) * rs};
                *(LAS f32x4*)(dst + 8 * q + 4) = (f32x4){(t8[4] - mu) * rs, (t8[5] - mu) * rs, (t8[6] - mu) * rs, (t8[7] - mu) * rs}; }
        }
        __syncthreads();
        for (int g = 0; g < 4; ++g) {
            float acc[16];
#pragma unroll
            for (int e = 0; e < 16; ++e) acc[e] = 0.f;
            const float* wrow = sguw + ((size_t)g * 128 + i) * 128;
            for (int q = 0; q < 128; q += 4) { const f32x4 w4 = *(const f32x4*)(wrow + q);
#pragma unroll
                for (int qq = 0; qq < 4; ++qq) { const float w = w4[qq]; const LAS f32x4* vr = (const LAS f32x4*)(VN + (g * 128 + q + qq) * 64 + part * 16);
#pragma unroll
                    for (int t = 0; t < 4; ++t) { const f32x4 v4 = vr[t]; acc[4 * t] += w * v4.x; acc[4 * t + 1] += w * v4.y; acc[4 * t + 2] += w * v4.z; acc[4 * t + 3] += w * v4.w; } } }
            const float bias = sgub[g * 128 + i];
            float uv[16];
            { const bf16* up = P + (size_t)(row0 + i) * INC + OFF_U + g * 64 + part * 16; unpack8(*(const v4u*)up, uv); unpack8(*(const v4u*)(up + 8), uv + 8); }
#pragma unroll
            for (int e = 0; e < 16; ++e) acc[e] = uv[e] * (acc[e] + bias);
            bf16* yp = Y + (size_t)(row0 + i) * 1024 + 768 + g * 64 + part * 16;
            *(v4u*)yp = pack8(acc); *(v4u*)(yp + 8) = pack8(acc + 8);
        }
#endif
        __syncthreads();
    }
}

__device__ __forceinline__ void phase_f(const Args& a, int l, LAS unsigned char* lds, int tid, int lane, int wave, bool dry = false) {
    LAS int* lcnt = (LAS int*)lds;
    __syncthreads();
    if (tid < 32) lcnt[tid] = 0;
    __syncthreads();
    const int gw = blockIdx.x * NWAVES + wave, NGW = gridDim.x * NWAVES, nrows = l == 0 ? NROWS : NLAT;
    const float* mod = (const float*)(a.ws + WS_MOD) + l * 9 * 6144;
    const float* lng = a.in[13] + l * 1024; const float* lnb = a.in[14] + l * 1024;
    const float* rgw = a.in[15] + l * 1024 * 4; const float* rgb = a.in[16] + l * 4; const float* rew = a.in[17] + (size_t)l * 4 * 1024 * 8; const float* reb = a.in[18] + l * 32;
    bf16* Hb = (bf16*)(a.ws + (dry ? WS_P + 160 * MiB : WS_HB)); unsigned* tok = (unsigned*)(a.ws + (dry ? WS_P + 240 * MiB : WS_TOK)); float* xctx = (float*)(a.ws + WS_XCTX);
    for (int row = gw; row < nrows; row += NGW) {
        float* xr = row < NLAT ? a.out + (size_t)row * 1024 : xctx + (size_t)(row - NLAT) * 1024;
        float* xw = dry ? (float*)(a.ws + WS_P) + (size_t)row * 1024 : xr;
        const float* m0 = mod + (row < NLAT ? (row >> 12) : 8) * 6144;
        f32x4 v[4]; float s = 0.f;
#pragma unroll
        for (int j = 0; j < 4; ++j) { v[j] = *(const f32x4*)(xr + (lane + 64 * j) * 4); s += (v[j].x + v[j].y) + (v[j].z + v[j].w); }
        const float mean = wave_sum(s) * (1.0f / 1024.0f); float s2 = 0.f;
#pragma unroll
        for (int j = 0; j < 4; ++j) { v[j] = v[j] - mean; s2 += (v[j].x * v[j].x + v[j].y * v[j].y) + (v[j].z * v[j].z + v[j].w * v[j].w); }
        const float rstd = 1.0f / sqrtf(wave_sum(s2) * (1.0f / 1024.0f) + LN_EPS);
        float lg[4] = {0.f, 0.f, 0.f, 0.f};
#pragma unroll
        for (int j = 0; j < 4; ++j) { const int idx = (lane + 64 * j) * 4;
            const f32x4 x1 = v[j] * rstd * *(const f32x4*)(lng + idx) + *(const f32x4*)(lnb + idx);
            *(f32x4*)(xw + idx) = x1;
            const f32x4 hm = x1 * (*(const f32x4*)(m0 + 4096 + idx) + 1.0f) + *(const f32x4*)(m0 + 3072 + idx);
            v[j] = hm;
            v2u w; w.x = pk2(hm.x, hm.y); w.y = pk2(hm.z, hm.w); *(v2u*)(Hb + (size_t)row * 1024 + idx) = w;
#pragma unroll
            for (int t = 0; t < 4; ++t) { const f32x4 w4 = *(const f32x4*)(rgw + (idx + t) * 4); const float hv = hm[t];
                lg[0] += hv * w4.x; lg[1] += hv * w4.y; lg[2] += hv * w4.z; lg[3] += hv * w4.w; } }
#pragma unroll
        for (int g = 0; g < 4; ++g) lg[g] = wave_sum(lg[g]) + rgb[g];
        int gi = 0; float gm = lg[0];
#pragma unroll
        for (int g = 1; g < 4; ++g) if (lg[g] > gm) { gm = lg[g]; gi = g; }
        float gden = 0.f;
#pragma unroll
        for (int g = 0; g < 4; ++g) gden += expf(lg[g] - gm);
        const float gprob = 1.0f / gden;
        float le[8] = {0.f, 0.f, 0.f, 0.f, 0.f, 0.f, 0.f, 0.f};
        const float* rw = rew + (size_t)gi * 1024 * 8;
#pragma unroll
        for (int j = 0; j < 4; ++j) { const int idx = (lane + 64 * j) * 4;
#pragma unroll
            for (int t = 0; t < 4; ++t) { const f32x4 w0 = *(const f32x4*)(rw + (idx + t) * 8), w1 = *(const f32x4*)(rw + (idx + t) * 8 + 4); const float hv = v[j][t];
                le[0] += hv * w0.x; le[1] += hv * w0.y; le[2] += hv * w0.z; le[3] += hv * w0.w; le[4] += hv * w1.x; le[5] += hv * w1.y; le[6] += hv * w1.z; le[7] += hv * w1.w; } }
#pragma unroll
        for (int e = 0; e < 8; ++e) le[e] = wave_sum(le[e]) + reb[gi * 8 + e];
        int i1 = 0; float m1 = le[0];
#pragma unroll
        for (int e = 1; e < 8; ++e) if (le[e] > m1) { m1 = le[e]; i1 = e; }
        int i2 = -1; float m2 = -3.0e38f;
#pragma unroll
        for (int e = 0; e < 8; ++e) if (e != i1 && le[e] > m2) { m2 = le[e]; i2 = e; }
        const float p2 = expf(m2 - m1), inv = 1.0f / (1.0f + p2);
        const float gate0 = gprob * inv, gate1 = gprob * p2 * inv;
        if (lane == 0) { const int e0 = gi * 8 + i1, e1 = gi * 8 + i2;
            const int p0 = __hip_atomic_fetch_add(lcnt + e0, 1, __ATOMIC_RELAXED, __HIP_MEMORY_SCOPE_WORKGROUP);
            const int p1 = __hip_atomic_fetch_add(lcnt + e1, 1, __ATOMIC_RELAXED, __HIP_MEMORY_SCOPE_WORKGROUP);
            unsigned* t = tok + (size_t)row * 8; t[0] = (unsigned)e0 | ((unsigned)e1 << 8); t[1] = (unsigned)p0; t[2] = (unsigned)p1;
            t[4] = __builtin_bit_cast(unsigned, gate0); t[5] = __builtin_bit_cast(unsigned, gate1); }
    }
    __syncthreads();
    if (tid < 32 && !dry) ((unsigned*)(a.ws + WS_CTL))[CW_WGCNT + (l * 256 + blockIdx.x) * 32 + tid] = (unsigned)lcnt[tid];
    __syncthreads();
}

__device__ __forceinline__ void phase_g(const Args& a, int l, LAS unsigned char* lds, int tid, int lane, int wave) {
    LAS int* cn = (LAS int*)lds; LAS int* base = (LAS int*)(lds + 32768); LAS int* pst = base + 32; LAS int* totl = base + 80;
    unsigned* ctl = (unsigned*)(a.ws + WS_CTL);
    __syncthreads();
    for (int i = tid; i < 256 * 32; i += NTHR) cn[i] = (int)ctl[CW_WGCNT + l * 256 * 32 + i];
    __syncthreads();
    if (tid < 32) { int tot = 0, bs = 0; for (int w = 0; w < 256; ++w) { const int v = cn[w * 32 + tid]; if (w < (int)blockIdx.x) bs += v; tot += v; } base[tid] = bs; totl[tid] = tot; }
    __syncthreads();
    if (tid == 0) { int run = 0; for (int e = 0; e < 32; ++e) { pst[e] = run; run += ((totl[e] + 255) >> 8) << 8; } pst[32] = run; }
    __syncthreads();
    if (blockIdx.x == 0 && tid < 32) ctl[CW_TOT + l * 64 + tid] = (unsigned)totl[tid];
    const int gw = blockIdx.x * NWAVES + wave, NGW = gridDim.x * NWAVES, nrows = l == 0 ? NROWS : NLAT;
    const bf16* Hb = (const bf16*)(a.ws + WS_HB); bf16* XB = (bf16*)(a.ws + WS_XB); unsigned* tok = (unsigned*)(a.ws + WS_TOK);
    (void)gw; (void)NGW; (void)Hb; (void)XB;
    int* rowof = (int*)(a.ws + WS_ROWOF);
    if (blockIdx.x < 32 && tid < 256) { const int e = blockIdx.x, pad = pst[e + 1] - pst[e] - totl[e]; if (tid < pad) rowof[pst[e] + totl[e] + tid] = 0; }
    for (int T = blockIdx.x; T < (nrows >> 5); T += gridDim.x) {
        const int row = 32 * T + (tid >> 4);
        if ((tid & 15) == 0) { unsigned* t = tok + (size_t)row * 8; const unsigned ee = t[0]; const int e0 = ee & 255, e1 = (ee >> 8) & 255;
            const int s0 = pst[e0] + base[e0] + (int)t[1], s1 = pst[e1] + base[e1] + (int)t[2];
            t[6] = (unsigned)s0; t[7] = (unsigned)s1; rowof[s0] = row; rowof[s1] = row; }
    }
    __syncthreads();
}

__device__ __forceinline__ int build_p2e(const Args& a, int l, LAS unsigned char* lds, int tid) {
    LAS unsigned char* p2e = lds + P2E_OFF; LAS int* np = (LAS int*)(lds + PST_OFF);
    const unsigned* ctl = (const unsigned*)(a.ws + WS_CTL);
    __syncthreads();
    if (tid == 0) { int pm = 0; for (int e = 0; e < 32; ++e) { const int n = ((int)ctl[CW_TOT + l * 64 + e] + 255) >> 8; for (int k = 0; k < n && pm < MAXPANELS; ++k) p2e[pm++] = (unsigned char)e; } np[0] = pm; }
    __syncthreads();
    return np[0];
}

struct JRow { f32x4 x[4]; v2u y0[4], y1[4]; float g0, g1; };
__device__ __forceinline__ void j_issue(JRow& R, const float* xr, const bf16* Y, const v4u tk, int lane) {
    const unsigned gx = tk.x, gy = tk.y;
    R.g0 = __builtin_bit_cast(float, gx); R.g1 = __builtin_bit_cast(float, gy);
    const bf16* y0 = Y + (size_t)tk.z * 1024; const bf16* y1 = Y + (size_t)tk.w * 1024;
#pragma unroll
    for (int j = 0; j < 4; ++j) { const int idx = (lane + 64 * j) * 4; R.x[j] = *(const f32x4*)(xr + idx); R.y0[j] = *(const v2u*)(y0 + idx); R.y1[j] = *(const v2u*)(y1 + idx); }
}
__device__ __forceinline__ void j_finish(const JRow& R, float* xw, bf16* hrow, const float* m0, const float* m1, const float* lng, const float* lnb, int lane) {
    f32x4 v[4]; float s = 0.f;
#pragma unroll
    for (int j = 0; j < 4; ++j) { const int idx = (lane + 64 * j) * 4; const v2u w0 = R.y0[j], w1 = R.y1[j];
        const f32x4 ya = (f32x4){bflo(w0.x), bfhi(w0.x), bflo(w0.y), bfhi(w0.y)}, yb = (f32x4){bflo(w1.x), bfhi(w1.x), bflo(w1.y), bfhi(w1.y)};
        v[j] = R.x[j] * ALPHA + *(const f32x4*)(m0 + 5120 + idx) * (ya * R.g0 + yb * R.g1);
        s += (v[j].x + v[j].y) + (v[j].z + v[j].w); }
    const float mean = wave_sum(s) * (1.0f / 1024.0f); float s2 = 0.f;
#pragma unroll
    for (int j = 0; j < 4; ++j) { v[j] = v[j] - mean; s2 += (v[j].x * v[j].x + v[j].y * v[j].y) + (v[j].z * v[j].z + v[j].w * v[j].w); }
    const float rstd = 1.0f / sqrtf(wave_sum(s2) * (1.0f / 1024.0f) + LN_EPS);
#pragma unroll
    for (int j = 0; j < 4; ++j) { const int idx = (lane + 64 * j) * 4;
        const f32x4 x2 = v[j] * rstd * *(const f32x4*)(lng + idx) + *(const f32x4*)(lnb + idx);
        *(f32x4*)(xw + idx) = x2;
        if (hrow) { const f32x4 hh = x2 * (*(const f32x4*)(m1 + 1024 + idx) + 1.0f) + *(const f32x4*)(m1 + idx);
            v2u w; w.x = cvtpk(hh.x, hh.y); w.y = cvtpk(hh.z, hh.w); *(v2u*)(hrow + idx) = w; } }
}
__device__ __forceinline__ void phase_j(const Args& a, int l, int lane, int wave, bool dry = false) {
    const int gw = blockIdx.x * NWAVES + wave, NGW = gridDim.x * NWAVES, nrows = l == 0 ? NROWS : NLAT;
    const float* mod = (const float*)(a.ws + WS_MOD) + l * 9 * 6144; const float* modn = (const float*)(a.ws + WS_MOD) + 9 * 6144;
    const float* lng = a.in[22] + l * 1024; const float* lnb = a.in[23] + l * 1024;
    bf16* Hb = (bf16*)(a.ws + WS_HB); const bf16* Y = (const bf16*)(a.ws + WS_Y); const unsigned* tok = (const unsigned*)(a.ws + WS_TOK); float* xctx = (float*)(a.ws + WS_XCTX);
    for (int rowA = gw; rowA < nrows; rowA += 2 * NGW) {
        const int rowB = rowA + NGW; const bool hasB = rowB < nrows;
        const v4u tA = *(const v4u*)(tok + (size_t)rowA * 8 + 4); const v4u tB = hasB ? *(const v4u*)(tok + (size_t)rowB * 8 + 4) : tA;
        float* xrA = rowA < NLAT ? a.out + (size_t)rowA * 1024 : xctx + (size_t)(rowA - NLAT) * 1024;
        const int rB = hasB ? rowB : rowA;
        float* xrB = rB < NLAT ? a.out + (size_t)rB * 1024 : xctx + (size_t)(rB - NLAT) * 1024;
        JRow RA, RB;
        j_issue(RA, xrA, Y, tA, lane); j_issue(RB, xrB, Y, tB, lane);
        const int mA = rowA < NLAT ? (rowA >> 12) : 8, mB = rB < NLAT ? (rB >> 12) : 8;
        j_finish(RA, dry ? (float*)(a.ws + WS_HH) + (size_t)rowA * 1024 : xrA, (l == 0 && !dry) ? Hb + (size_t)rowA * 1024 : nullptr, mod + mA * 6144, modn + mA * 6144, lng, lnb, lane);
        if (hasB) j_finish(RB, dry ? (float*)(a.ws + WS_HH) + (size_t)rowB * 1024 : xrB, (l == 0 && !dry) ? Hb + (size_t)rowB * 1024 : nullptr, mod + mB * 6144, modn + mB * 6144, lng, lnb, lane);
    }
}
typedef short bf16x8 __attribute__((ext_vector_type(8)));
typedef short s16x4 __attribute__((ext_vector_type(4)));
typedef short v4i16_t __attribute__((ext_vector_type(4)));
typedef float f32x16 __attribute__((ext_vector_type(16)));
#define MFMA32(a, b, c) __builtin_amdgcn_mfma_f32_32x32x16_bf16((a), (b), (c), 0, 0, 0)
__device__ __forceinline__ int crow(int reg, int hf) { return (reg & 3) + 8 * (reg >> 2) + 4 * hf; }
__device__ __forceinline__ int tro(int r, int b) { return r * 128 + (b ^ (((r >> 1) & 1) << 6)); }
__device__ __forceinline__ int rro(int r, int c16) { return r * 128 + ((c16 ^ ((r >> 1) & 7)) << 4); }
__device__ __forceinline__ s16x4 tr4(const LAS unsigned char* p) { return __builtin_bit_cast(s16x4, __builtin_amdgcn_ds_read_tr16_b64_v4i16((LAS v4i16_t*)p)); }
__device__ __forceinline__ bf16x8 tr_frag(const LAS unsigned char* img, int rlo, int rhi, int colbyte) {
    const s16x4 lo = tr4(img + tro(rlo, colbyte)), hi = tr4(img + tro(rhi, colbyte));
    return (bf16x8){lo[0], lo[1], lo[2], lo[3], hi[0], hi[1], hi[2], hi[3]};
}

#ifndef ST_TRANSPOSED
#define ST_TRANSPOSED 1
#endif
__device__ __forceinline__ void phase_b_mfma(const Args& a, int l, LAS unsigned char* lds, int tid, int lane, int wave) {
    const bf16* P = (const bf16*)(a.ws + WS_P); bf16* ST = (bf16*)(a.ws + WS_ST);
    const int r32 = lane & 31, hf = lane >> 5, q4 = (lane & 15) >> 2, p4 = lane & 3, blk = (lane >> 4) & 1;
    v4u kw[4], vw[4];
#define B_LOAD(uu) do { const int b_ = (uu) / (NCH * 4), c_ = ((uu) % (NCH * 4)) >> 2, h0_ = ((uu) & 3) * 2; const int r0_ = chunk_row0(b_, c_); \
        _Pragma("unroll") for (int k = 0; k < 4; ++k) { const int ci = tid + NTHR * k, hh = ci >> 10, row = (ci & 1023) >> 3, c16 = ci & 7; \
            const bf16* src = P + (size_t)(r0_ + row) * INC + (h0_ + hh) * 64 + c16 * 8; kw[k] = *(const v4u*)(src + OFF_K); vw[k] = *(const v4u*)(src + OFF_V); } } while (0)
    if ((int)blockIdx.x < 8 * NCH * 4) B_LOAD((int)blockIdx.x);
    for (int u = blockIdx.x; u < 8 * NCH * 4; u += gridDim.x) {
        const int b = u / (NCH * 4), c = (u % (NCH * 4)) >> 2, h0 = (u & 3) * 2;
        __syncthreads();
#pragma unroll
        for (int k = 0; k < 4; ++k) {
            const int ci = tid + NTHR * k, hh = ci >> 10, row = (ci & 1023) >> 3, c16 = ci & 7, h = h0 + hh;
            LAS unsigned char* base = lds + hh * 49152;
            *(LAS v4u*)(base + tro(row, c16 * 16)) = kw[k];
            const float* lgt = (const float*)(a.ws + WS_LG) + (l * 8 + h) * 2; const float lgf = lgt[0], lgb = lgt[1];
            const float wf = __expf(lgf * (float)(127 - row)), wb = __expf(lgb * (float)row);
            float v[8]; unpack8(vw[k], v);
            v4u of, ob;
            of.x = cvtpk(v[0] * wf, v[1] * wf); of.y = cvtpk(v[2] * wf, v[3] * wf); of.z = cvtpk(v[4] * wf, v[5] * wf); of.w = cvtpk(v[6] * wf, v[7] * wf);
            ob.x = cvtpk(v[0] * wb, v[1] * wb); ob.y = cvtpk(v[2] * wb, v[3] * wb); ob.z = cvtpk(v[4] * wb, v[5] * wb); ob.w = cvtpk(v[6] * wb, v[7] * wb);
            *(LAS v4u*)(base + 16384 + tro(row, c16 * 16)) = of;
            *(LAS v4u*)(base + 32768 + tro(row, c16 * 16)) = ob;
        }
        __syncthreads();
        if (u + (int)gridDim.x < 8 * NCH * 4) B_LOAD(u + (int)gridDim.x);
        const int hh = wave >> 2, dir = (wave >> 1) & 1, et = wave & 1;
        const LAS unsigned char* kimg = lds + hh * 49152; const LAS unsigned char* vimg = kimg + 16384 + dir * 16384;
        f32x16 acc[2];
#pragma unroll
        for (int i = 0; i < 16; ++i) { acc[0][i] = 0.f; acc[1][i] = 0.f; }
#pragma unroll
        for (int ks = 0; ks < 8; ++ks) {
            const int rlo = 16 * ks + 8 * hf + q4;
            const bf16x8 Bv = tr_frag(vimg, rlo, rlo + 4, (et * 32 + 16 * blk + 4 * p4) * 2);
#pragma unroll
            for (int dt = 0; dt < 2; ++dt) { const bf16x8 Ak = tr_frag(kimg, rlo, rlo + 4, (dt * 32 + 16 * blk + 4 * p4) * 2); acc[dt] = MFMA32(Ak, Bv, acc[dt]); }
        }
        bf16* dst = ST + st_off(b, c, h0 + hh, dir) + (size_t)(et * 32 + r32) * 64;
#pragma unroll
        for (int dt = 0; dt < 2; ++dt)
#pragma unroll
            for (int g4 = 0; g4 < 4; ++g4) { v2u w; w.x = cvtpk(acc[dt][4 * g4], acc[dt][4 * g4 + 1]); w.y = cvtpk(acc[dt][4 * g4 + 2], acc[dt][4 * g4 + 3]);
                *(v2u*)(dst + dt * 32 + 8 * g4 + 4 * hf) = w; }
    }
#undef B_LOAD
    __syncthreads();
}
__device__ __forceinline__ bf16x8 scale_frag(const bf16x8 q, float sc) {
    const v4u w = __builtin_bit_cast(v4u, q); v4u o;
    o.x = cvtpk(bflo(w.x) * sc, bfhi(w.x) * sc); o.y = cvtpk(bflo(w.y) * sc, bfhi(w.y) * sc); o.z = cvtpk(bflo(w.z) * sc, bfhi(w.z) * sc); o.w = cvtpk(bflo(w.w) * sc, bfhi(w.w) * sc);
    return __builtin_bit_cast(bf16x8, o);
}
__device__ __forceinline__ bf16x8 f32x8_to_frag(const f32x4 a0, const f32x4 a1) {
    v4u o; o.x = cvtpk(a0.x, a0.y); o.y = cvtpk(a0.z, a0.w); o.z = cvtpk(a1.x, a1.y); o.w = cvtpk(a1.z, a1.w); return __builtin_bit_cast(bf16x8, o);
}
struct ConvIn { v4u cb, c0, x0, cp, xp, cn, xn; };
__device__ __forceinline__ void conv_load(ConvIn& I, const bf16* P, int row0, int c, bool isc, int idx) {
    const int p = idx >> 5, ch0 = (idx & 31) * 8; const int row = row0 + p;
    int dprev = -1, dnext = 1; bool vprev, vnext;
    if (isc) { const int t = c * 128 + p; vprev = t > 0; vnext = t < 255; }
    else { const int t = (c - 2) * 128 + p;
        if (ch0 < 128) { const int col = t & 63; vprev = col > 0; vnext = col < 63; }
        else { const int rg = t >> 6; vprev = rg > 0; vnext = rg < 63; dprev = -64; dnext = 64; } }
    const bf16* pr = P + (size_t)row * INC; const v4u z = (v4u){0u, 0u, 0u, 0u};
    I.cb = *(const v4u*)(pr + OFF_CB + ch0); I.c0 = *(const v4u*)(pr + OFF_CC + ch0); I.x0 = *(const v4u*)(pr + OFF_CX + ch0);
    I.cp = z; I.xp = z; I.cn = z; I.xn = z;
    if (vprev) { const bf16* q = pr + (ptrdiff_t)dprev * INC; I.cp = *(const v4u*)(q + OFF_CC + ch0); I.xp = *(const v4u*)(q + OFF_CX + ch0); }
    if (vnext) { const bf16* q = pr + (ptrdiff_t)dnext * INC; I.cn = *(const v4u*)(q + OFF_CC + ch0); I.xn = *(const v4u*)(q + OFF_CX + ch0); }
}
__device__ __forceinline__ void conv_store(const ConvIn& I, bf16* Y, const float* convw, int row0, int idx) {
    const int p = idx >> 5, ch0 = (idx & 31) * 8;
    float cb[8], a0[8], a1[8], o[8], zc, zp, zn;
    unpack8(I.cb, cb);
    unpack8(I.c0, a0); unpack8(I.x0, a1);
#pragma unroll
    for (int i = 0; i < 8; ++i) o[i] = convw[256 + ch0 + i] * (a0[i] * a1[i]);
    unpack8(I.cp, a0); unpack8(I.xp, a1);
#pragma unroll
    for (int i = 0; i < 8; ++i) o[i] += convw[ch0 + i] * (a0[i] * a1[i]);
    unpack8(I.cn, a0); unpack8(I.xn, a1);
#pragma unroll
    for (int i = 0; i < 8; ++i) o[i] = cb[i] * (o[i] + convw[512 + ch0 + i] * (a0[i] * a1[i]));
    (void)zc; (void)zp; (void)zn;
    *(v4u*)(Y + (size_t)(row0 + p) * 1024 + ch0) = pack8(o);
}
__device__ __forceinline__ void phase_d_mfma(const Args& a, int l, LAS unsigned char* lds, int tid, int lane, int wave) {
    const bf16* P = (const bf16*)(a.ws + WS_P); const bf16* ST = (const bf16*)(a.ws + WS_ST); bf16* Y = (bf16*)(a.ws + WS_YMIX);
    const float* convw = a.in[7] + l * 3 * 256; const float* sguw = a.in[10] + (size_t)l * 4 * 128 * 128; const float* sgub = a.in[11] + l * 4 * 128;
    const int c_lo = l == 1 ? 2 : 0, cpb = NCH - c_lo, nunits = 8 * cpb;
#define LANEC int ln_ = lane; asm volatile("" : "+v"(ln_)); const int r32 = ln_ & 31, hf = ln_ >> 5, q4 = (ln_ & 15) >> 2, p4 = ln_ & 3, blk = (ln_ >> 4) & 1; (void)q4; (void)p4; (void)blk
    unsigned* dq = (unsigned*)(a.ws + WS_CTL) + CW_DQ + l * 64; LAS int* dqw = (LAS int*)(lds + DQ_OFF);
    const int npass = 2 * nunits, total = 4 * nunits;
    __syncthreads();
    if (tid == 0) dqw[0] = (int)__hip_atomic_fetch_add(dq, 1u, __ATOMIC_RELAXED, __HIP_MEMORY_SCOPE_AGENT);
    __syncthreads();
    int item = __builtin_amdgcn_readfirstlane(dqw[0]);
    while (item < total) {
        int nxt = 0;
        if (tid == 0) nxt = (int)__hip_atomic_fetch_add(dq, 1u, __ATOMIC_RELAXED, __HIP_MEMORY_SCOPE_AGENT);
        const int type = item < npass ? 0 : (item < npass + nunits ? 1 : 2);
        const int u = type == 0 ? (item >> 1) : (type == 1 ? item - npass : item - npass - nunits), pass = item & 1;
        const int b = u / cpb, c = c_lo + u % cpb; const int row0 = chunk_row0(b, c); const bool isc = c < 2;
        if (type == 2) {
#pragma unroll 1
            for (int idx = tid; idx < 128 * 32; idx += 2 * NTHR) {
                ConvIn I0, I1;
                conv_load(I0, P, row0, c, isc, idx); conv_load(I1, P, row0, c, isc, idx + NTHR);
                conv_store(I0, Y, convw, row0, idx); conv_store(I1, Y, convw, row0, idx + NTHR);
            }
        }
#ifndef NO_D2
        if (type == 0) {
            LANEC;
            const int hd = wave >> 1, ih = wave & 1, h = pass * 4 + hd;
            const LAS unsigned char* kimg = lds + hd * 32768; const LAS unsigned char* vimg = kimg + 16384;
            const float* lgt = (const float*)(a.ws + WS_LG) + (l * 8 + h) * 2; const float lg2f = lgt[0] * 1.44269504088896f, lg2b = lgt[1] * 1.44269504088896f;
            bf16x8 qf[2][4];
#pragma unroll
            for (int t = 0; t < 2; ++t)
#pragma unroll
                for (int s = 0; s < 4; ++s) qf[t][s] = *(const bf16x8*)(P + (size_t)(row0 + (2 * ih + t) * 32 + r32) * INC + OFF_Q + h * 64 + 16 * s + 8 * hf);
#define D_SFR(dst, dir) do { const bf16* sp_ = ST + st_off(b, c, h, dir) + r32 * 64 + 8 * hf; _Pragma("unroll") for (int s = 0; s < 4; ++s) _Pragma("unroll") for (int et = 0; et < 2; ++et) dst[s][et] = *(const bf16x8*)(sp_ + et * 2048 + 16 * s); } while (0)
#define D_STG_LD(k0) do { _Pragma("unroll") for (int k = 0; k < 4; ++k) { int to_ = tid; asm volatile("" : "+v"(to_)); const int ci = to_ + NTHR * ((k0) + k), tile = ci >> 10, hdd = tile >> 1, isv = tile & 1, row = (ci & 1023) >> 3, c16 = ci & 7; \
                stg[k] = *(const v4u*)(P + (size_t)(row0 + row) * INC + (isv ? OFF_V : OFF_K) + (pass * 4 + hdd) * 64 + c16 * 8); } } while (0)
#define D_STG_ST(k0) do { _Pragma("unroll") for (int k = 0; k < 4; ++k) { int to_ = tid; asm volatile("" : "+v"(to_)); const int ci = to_ + NTHR * ((k0) + k), tile = ci >> 10, hdd = tile >> 1, isv = tile & 1, row = (ci & 1023) >> 3, c16 = ci & 7; \
                *(LAS v4u*)(lds + hdd * 32768 + isv * 16384 + (isv ? tro(row, c16 * 16) : rro(row, c16))) = stg[k]; } } while (0)
#define D_CROSS(sf, dir) do { const int i0 = 2 * ih * 32 + r32; \
                const float sc0 = (dir) == 0 ? __builtin_amdgcn_exp2f(lg2f * (float)(i0 + 1)) : __builtin_amdgcn_exp2f(lg2b * (float)(128 - i0)); \
                const float sc1 = (dir) == 0 ? __builtin_amdgcn_exp2f(lg2f * (float)(i0 + 33)) : __builtin_amdgcn_exp2f(lg2b * (float)(96 - i0)); \
                _Pragma("unroll") for (int s = 0; s < 4; ++s) { const bf16x8 qs0 = scale_frag(qf[0][s], sc0), qs1 = scale_frag(qf[1][s], sc1); \
                    _Pragma("unroll") for (int et = 0; et < 2; ++et) { acc[0][et] = MFMA32(sf[s][et], qs0, acc[0][et]); acc[1][et] = MFMA32(sf[s][et], qs1, acc[1][et]); } } } while (0)
            bf16x8 sf0[4][2]; v4u stg[4];
            D_SFR(sf0, 0);
            D_STG_LD(0);
            f32x16 acc[2][2];
#pragma unroll
            for (int t = 0; t < 2; ++t)
#pragma unroll
                for (int et = 0; et < 2; ++et)
#pragma unroll
                    for (int r = 0; r < 16; ++r) acc[t][et][r] = 0.f;
            asm volatile("" ::: "memory");
            D_CROSS(sf0, 0);
            asm volatile("" ::: "memory");
            bf16x8 sf1[4][2];
            D_SFR(sf1, 1);
            D_STG_ST(0);
            asm volatile("" ::: "memory");
            D_STG_LD(4);
            asm volatile("" ::: "memory");
            D_CROSS(sf1, 1);
            asm volatile("" ::: "memory");
            D_STG_ST(4);
            asm volatile("" ::: "memory");
            D_STG_LD(8); D_STG_ST(8);
            asm volatile("" ::: "memory");
            D_STG_LD(12); D_STG_ST(12);
#undef D_SFR
#undef D_STG_LD
#undef D_STG_ST
#undef D_CROSS
            __syncthreads();
#pragma unroll
            for (int t = 0; t < 2; ++t) {
                const int it = 2 * ih + t;
                bf16x8 qq[4];
                if (t == 0) {
#pragma unroll
                    for (int s = 0; s < 4; ++s) qq[s] = qf[0][s];
                } else {
                    asm volatile("" ::: "memory");
#pragma unroll
                    for (int s = 0; s < 4; ++s) qq[s] = *(const bf16x8*)(P + (size_t)(row0 + it * 32 + r32) * INC + OFF_Q + h * 64 + 16 * s + 8 * hf);
                }
#pragma unroll 1
                for (int jt = 0; jt < 4; ++jt) {
                    f32x16 X;
#pragma unroll
                    for (int r = 0; r < 16; ++r) X[r] = 0.f;
#pragma unroll
                    for (int s = 0; s < 4; ++s) { const bf16x8 Kf = *(const LAS bf16x8*)(kimg + rro(jt * 32 + r32, 2 * s + hf)); X = MFMA32(Kf, qq[s], X); }
                    const int rel0 = (it - jt) * 32 + r32 - 4 * hf;
#pragma unroll
                    for (int r = 0; r < 16; ++r) { const int rel = rel0 - ((r & 3) + 8 * (r >> 2));
                        const float x = rel > 0 ? lg2f * (float)rel : lg2b * (float)(-rel);
                        const float dcy = rel == 0 ? 2.0f : __builtin_amdgcn_exp2f(x);
                        X[r] *= dcy; }
#pragma unroll
                    for (int s2 = 0; s2 < 2; ++s2) {
                        v4u pk; pk.x = cvtpk(X[8 * s2], X[8 * s2 + 1]); pk.y = cvtpk(X[8 * s2 + 2], X[8 * s2 + 3]); pk.z = cvtpk(X[8 * s2 + 4], X[8 * s2 + 5]); pk.w = cvtpk(X[8 * s2 + 6], X[8 * s2 + 7]);
                        const bf16x8 Pk = __builtin_bit_cast(bf16x8, pk);
                        const int rlo = jt * 32 + 16 * s2 + 4 * hf + q4;
#pragma unroll
                        for (int et = 0; et < 2; ++et) { const bf16x8 Vt = tr_frag(vimg, rlo, rlo + 8, (et * 32 + 16 * blk + 4 * p4) * 2); acc[t][et] = MFMA32(Vt, Pk, acc[t][et]); }
                    }
                }
                const int row = row0 + (2 * ih + t) * 32 + r32;
                float sum = 0.f;
#pragma unroll
                for (int et = 0; et < 2; ++et)
#pragma unroll
                    for (int r = 0; r < 16; ++r) sum += acc[t][et][r];
                sum += __shfl_xor(sum, 32);
                const float mu = sum * (1.0f / 64.0f); float vs = 0.f;
#pragma unroll
                for (int et = 0; et < 2; ++et)
#pragma unroll
                    for (int r = 0; r < 16; ++r) { const float dlt = acc[t][et][r] - mu; vs += dlt * dlt; }
                vs += __shfl_xor(vs, 32);
                const float rs = 1.0f / sqrtf(vs * (1.0f / 64.0f) + LN_EPS);
#pragma unroll
                for (int et = 0; et < 2; ++et)
#pragma unroll
                    for (int g4 = 0; g4 < 4; ++g4) { const int e0 = et * 32 + 8 * g4 + 4 * hf;
                        const v2u gw = *(const v2u*)(P + (size_t)row * INC + OFF_G + h * 64 + e0);
                        const float g0 = bflo(gw.x), g1 = bfhi(gw.x), g2 = bflo(gw.y), g3 = bfhi(gw.y);
                        const float o0 = (acc[t][et][4 * g4] - mu) * rs, o1 = (acc[t][et][4 * g4 + 1] - mu) * rs, o2 = (acc[t][et][4 * g4 + 2] - mu) * rs, o3 = (acc[t][et][4 * g4 + 3] - mu) * rs;
                        v2u w; w.x = cvtpk(g0 / (1.0f + __expf(-g0)) * o0, g1 / (1.0f + __expf(-g1)) * o1); w.y = cvtpk(g2 / (1.0f + __expf(-g2)) * o2, g3 / (1.0f + __expf(-g3)) * o3);
                        *(v2u*)(Y + (size_t)row * 1024 + 256 + h * 64 + e0) = w; }
            }
        }
#endif
#ifndef NO_D3
        if (type == 1) {
            LANEC;
            const int g = wave >> 1, ph = wave & 1;
            bf16x8 Bw[8][2];
            { const bf16* wp = (const bf16*)(a.ws + WS_SGUW) + ((size_t)(l * 4 + g) * 128 + ph * 64 + r32) * 128 + 8 * hf;
#pragma unroll
              for (int ks = 0; ks < 8; ++ks)
#pragma unroll
                  for (int pt = 0; pt < 2; ++pt) Bw[ks][pt] = *(const bf16x8*)(wp + pt * 32 * 128 + 16 * ks); }
            {
                int tq_ = tid; asm volatile("" : "+v"(tq_));
                const int i = tq_ >> 2, part = tq_ & 3;
                const bf16* vp = P + (size_t)(row0 + i) * INC + OFF_VV + part * 64;
                v4u raw[8];
#pragma unroll
                for (int q = 0; q < 8; ++q) raw[q] = *(const v4u*)(vp + 8 * q);
                float sum = 0.f;
#pragma unroll
                for (int q = 0; q < 8; ++q) { float t8[8]; unpack8(raw[q], t8);
#pragma unroll
                    for (int e2 = 0; e2 < 8; ++e2) sum += t8[e2]; }
                sum += __shfl_xor(sum, 1); sum += __shfl_xor(sum, 2);
                const float mu = sum * (1.0f / 256.0f); float vs = 0.f;
#pragma unroll
                for (int q = 0; q < 8; ++q) { float t8[8]; unpack8(raw[q], t8);
#pragma unroll
                    for (int e2 = 0; e2 < 8; ++e2) { const float dlt = t8[e2] - mu; vs += dlt * dlt; } }
                vs += __shfl_xor(vs, 1); vs += __shfl_xor(vs, 2);
                const float rs = 1.0f / sqrtf(vs * (1.0f / 256.0f) + LN_EPS);
#pragma unroll
                for (int q = 0; q < 8; ++q) { float t8[8]; unpack8(raw[q], t8);
                    v4u w; w.x = cvtpk((t8[0] - mu) * rs, (t8[1] - mu) * rs); w.y = cvtpk((t8[2] - mu) * rs, (t8[3] - mu) * rs); w.z = cvtpk((t8[4] - mu) * rs, (t8[5] - mu) * rs); w.w = cvtpk((t8[6] - mu) * rs, (t8[7] - mu) * rs);
                    *(LAS v4u*)(lds + part * 16384 + tro(i, q * 16)) = w; }
            }
            __syncthreads();
            const LAS unsigned char* vn = lds + g * 16384;
            f32x16 acc[2][2];
#pragma unroll
            for (int ct = 0; ct < 2; ++ct)
#pragma unroll
                for (int pt = 0; pt < 2; ++pt)
#pragma unroll
                    for (int r = 0; r < 16; ++r) acc[ct][pt][r] = 0.f;
#pragma unroll
            for (int ks = 0; ks < 8; ++ks) {
                const int rlo = 16 * ks + 8 * hf + q4;
                bf16x8 A[2];
#pragma unroll
                for (int ct = 0; ct < 2; ++ct) A[ct] = tr_frag(vn, rlo, rlo + 4, (ct * 32 + 16 * blk + 4 * p4) * 2);
#pragma unroll
                for (int ct = 0; ct < 2; ++ct)
#pragma unroll
                    for (int pt = 0; pt < 2; ++pt) acc[ct][pt] = MFMA32(A[ct], Bw[ks][pt], acc[ct][pt]);
            }
#pragma unroll
            for (int pt = 0; pt < 2; ++pt) {
                const int p = ph * 64 + pt * 32 + r32; const int row = row0 + p; const float bias = sgub[g * 128 + p];
#pragma unroll
                for (int ct = 0; ct < 2; ++ct)
#pragma unroll
                    for (int g4 = 0; g4 < 4; ++g4) { const int c0 = ct * 32 + 8 * g4 + 4 * hf;
                        const v2u uw = *(const v2u*)(P + (size_t)row * INC + OFF_U + g * 64 + c0);
                        v2u w; w.x = cvtpk(bflo(uw.x) * (acc[ct][pt][4 * g4] + bias), bfhi(uw.x) * (acc[ct][pt][4 * g4 + 1] + bias));
                        w.y = cvtpk(bflo(uw.y) * (acc[ct][pt][4 * g4 + 2] + bias), bfhi(uw.y) * (acc[ct][pt][4 * g4 + 3] + bias));
                        *(v2u*)(Y + (size_t)row * 1024 + 768 + g * 64 + c0) = w; }
            }
        }
#endif
        __syncthreads();
        if (tid == 0) dqw[0] = nxt;
        __syncthreads();
        item = __builtin_amdgcn_readfirstlane(dqw[0]);
    }
}

__device__ __forceinline__ void phase_f2(const Args& a, int l, LAS unsigned char* lds, int tid, int lane, int wave) {
    LAS int* lcnt = (LAS int*)(lds + LCNT_OFF); LAS float* LG = (LAS float*)(lds + LG_OFF);
    LAS unsigned char* HI = lds; LAS unsigned char* LO = lds + 65536; LAS float* PART = (LAS float*)lds;
    const int r32 = lane & 31, hf = lane >> 5;
    const int nrows = l == 0 ? NROWS : NLAT, ntiles = nrows >> 5;
    const float* mod = (const float*)(a.ws + WS_MOD) + l * 9 * 6144;
    const float* lng = a.in[13] + l * 1024; const float* lnb = a.in[14] + l * 1024;
    const float* rgb = a.in[16] + l * 4; const float* reb = a.in[18] + l * 32;
    bf16* Hb = (bf16*)(a.ws + WS_HB); unsigned* tok = (unsigned*)(a.ws + WS_TOK); float* xctx = (float*)(a.ws + WS_XCTX); const bf16* YO = (const bf16*)(a.ws + WS_YO);
    const bf16* wr = (const bf16*)(a.ws + WS_WR) + (size_t)l * 2 * 64 * 1024;
    bf16x8 Bh[8][2];
#pragma unroll
    for (int ks = 0; ks < 8; ++ks)
#pragma unroll
        for (int ct = 0; ct < 2; ++ct) { const bf16* p = wr + (size_t)(ct * 32 + r32) * 1024 + wave * 128 + 16 * ks + 8 * hf; Bh[ks][ct] = *(const bf16x8*)p; }
    __syncthreads();
    if (tid < 32) lcnt[tid] = 0;
    __syncthreads();
    for (int T = blockIdx.x; T < ntiles; T += gridDim.x) {
#pragma unroll 1
        for (int rh = 0; rh < 2; ++rh) {
        f32x4 vv[2][4];
#pragma unroll
        for (int rq = 0; rq < 2; ++rq) { const int row = 32 * T + 4 * wave + 2 * rh + rq;
            const float* xin = l == 0 ? (row < NLAT ? a.in[0] + (size_t)row * 1024 : a.in[2] + (size_t)(row - NLAT) * 1024)
                                      : (row < NLAT ? a.out + (size_t)row * 1024 : xctx + (size_t)(row - NLAT) * 1024);
            const float* g1p = mod + (row < NLAT ? (row >> 12) : 8) * 6144 + 2048;
#pragma unroll
            for (int j = 0; j < 4; ++j) { const int idx = (lane + 64 * j) * 4; const v2u yw = *(const v2u*)(YO + (size_t)row * 1024 + idx);
                vv[rq][j] = *(const f32x4*)(xin + idx) * ALPHA + *(const f32x4*)(g1p + idx) * (f32x4){bflo(yw.x), bfhi(yw.x), bflo(yw.y), bfhi(yw.y)}; } }
#pragma unroll
        for (int rq = 0; rq < 2; ++rq) {
            const int lr = 4 * wave + 2 * rh + rq, row = 32 * T + lr;
            float* xr = row < NLAT ? a.out + (size_t)row * 1024 : xctx + (size_t)(row - NLAT) * 1024;
            const float* m0 = mod + (row < NLAT ? (row >> 12) : 8) * 6144;
            f32x4 v[4]; float s = 0.f;
#pragma unroll
            for (int j = 0; j < 4; ++j) { v[j] = vv[rq][j]; s += (v[j].x + v[j].y) + (v[j].z + v[j].w); }
            const float mean = wave_sum(s) * (1.0f / 1024.0f); float s2 = 0.f;
#pragma unroll
            for (int j = 0; j < 4; ++j) { v[j] = v[j] - mean; s2 += (v[j].x * v[j].x + v[j].y * v[j].y) + (v[j].z * v[j].z + v[j].w * v[j].w); }
            const float rstd = 1.0f / sqrtf(wave_sum(s2) * (1.0f / 1024.0f) + LN_EPS);
#pragma unroll
            for (int j = 0; j < 4; ++j) { const int idx = (lane + 64 * j) * 4;
                const f32x4 x1 = v[j] * rstd * *(const f32x4*)(lng + idx) + *(const f32x4*)(lnb + idx);
                *(f32x4*)(xr + idx) = x1;
                const f32x4 hm = x1 * (*(const f32x4*)(m0 + 4096 + idx) + 1.0f) + *(const f32x4*)(m0 + 3072 + idx);
                v2u h; h.x = cvtpk(hm.x, hm.y); h.y = cvtpk(hm.z, hm.w);
                v2u lo; lo.x = cvtpk(hm.x - bflo(h.x), hm.y - bfhi(h.x)); lo.y = cvtpk(hm.z - bflo(h.y), hm.w - bfhi(h.y));
                *(v2u*)(Hb + (size_t)row * 1024 + idx) = h;
                const int off = lr * 2048 + (((((lane + 64 * j) >> 1)) ^ (lr & 15)) << 4) + (lane & 1) * 8;
                *(LAS v2u*)(HI + off) = h; *(LAS v2u*)(LO + off) = lo; }
        }
        }
        __syncthreads();
        f32x16 acc[2];
#pragma unroll
        for (int r = 0; r < 16; ++r) { acc[0][r] = 0.f; acc[1][r] = 0.f; }
#pragma unroll
        for (int ks = 0; ks < 8; ++ks) { const int off = r32 * 2048 + (((wave * 16 + 2 * ks + hf) ^ (r32 & 15)) << 4);
            const bf16x8 Ah = *(const LAS bf16x8*)(HI + off), Al = *(const LAS bf16x8*)(LO + off);
#pragma unroll
            for (int ct = 0; ct < 2; ++ct) { const bf16x8 Bl = *(const bf16x8*)(wr + (size_t)(64 + ct * 32 + r32) * 1024 + wave * 128 + 16 * ks + 8 * hf);
                acc[ct] = MFMA32(Ah, Bh[ks][ct], acc[ct]); acc[ct] = MFMA32(Ah, Bl, acc[ct]); acc[ct] = MFMA32(Al, Bh[ks][ct], acc[ct]); } }
        __syncthreads();
#pragma unroll
        for (int ct = 0; ct < 2; ++ct)
#pragma unroll
            for (int r = 0; r < 16; ++r) PART[(wave * 32 + crow(r, hf)) * 64 + ct * 32 + r32] = acc[ct][r];
        __syncthreads();
        { const int row = tid >> 4, cg = tid & 15;
#pragma unroll
          for (int q = 0; q < 3; ++q) { const int col = cg + 16 * q; if (col < 36) { float sum = 0.f;
#pragma unroll
                  for (int w = 0; w < 8; ++w) sum += PART[(w * 32 + row) * 64 + col];
                  LG[row * 40 + col] = sum; } } }
        __syncthreads();
        if (tid < 32) { const int row = 32 * T + tid; const LAS float* lgp = LG + tid * 40;
            float lg[4];
#pragma unroll
            for (int g = 0; g < 4; ++g) lg[g] = lgp[g] + rgb[g];
            int gi = 0; float gm = lg[0];
#pragma unroll
            for (int g = 1; g < 4; ++g) if (lg[g] > gm) { gm = lg[g]; gi = g; }
            float gden = 0.f;
#pragma unroll
            for (int g = 0; g < 4; ++g) gden += expf(lg[g] - gm);
            const float gprob = 1.0f / gden;
            float le[8];
#pragma unroll
            for (int e = 0; e < 8; ++e) le[e] = lgp[4 + gi * 8 + e] + reb[gi * 8 + e];
            int i1 = 0; float m1 = le[0];
#pragma unroll
            for (int e = 1; e < 8; ++e) if (le[e] > m1) { m1 = le[e]; i1 = e; }
            int i2 = -1; float m2 = -3.0e38f;
#pragma unroll
            for (int e = 0; e < 8; ++e) if (e != i1 && le[e] > m2) { m2 = le[e]; i2 = e; }
            const float p2 = expf(m2 - m1), inv = 1.0f / (1.0f + p2);
            const float gate0 = gprob * inv, gate1 = gprob * p2 * inv;
            const int e0 = gi * 8 + i1, e1 = gi * 8 + i2;
            const int p0 = __hip_atomic_fetch_add(lcnt + e0, 1, __ATOMIC_RELAXED, __HIP_MEMORY_SCOPE_WORKGROUP);
            const int p1 = __hip_atomic_fetch_add(lcnt + e1, 1, __ATOMIC_RELAXED, __HIP_MEMORY_SCOPE_WORKGROUP);
            unsigned* t = tok + (size_t)row * 8; t[0] = (unsigned)e0 | ((unsigned)e1 << 8); t[1] = (unsigned)p0; t[2] = (unsigned)p1;
            t[4] = __builtin_bit_cast(unsigned, gate0); t[5] = __builtin_bit_cast(unsigned, gate1); }
    }
    __syncthreads();
    if (tid < 32) ((unsigned*)(a.ws + WS_CTL))[CW_WGCNT + (l * 256 + blockIdx.x) * 32 + tid] = (unsigned)lcnt[tid];
    __syncthreads();
}
#ifndef MK_PER_PHASE
#define MK_PER_PHASE 0
#endif
constexpr int N_PHASES = 22;

__global__ void __launch_bounds__(NTHR, 2) hybrid_fwd(Args args) {
    extern __shared__ __attribute__((aligned(16))) unsigned char lds_raw[];
    LAS unsigned char* lds = (LAS unsigned char*)lds_raw;
    const int tid0 = threadIdx.x;
    for (int u = tid0; u < (LDS_BYTES - LDSCTL_OFF) / 4; u += NTHR) ((LAS unsigned*)(lds + LDSCTL_OFF))[u] = 0u;
#define TIDS int tid = threadIdx.x; asm volatile("" : "+v"(tid)); const int lane = tid & 63, wave = __builtin_amdgcn_readfirstlane(tid >> 6); (void)lane; (void)wave
    __syncthreads();
    unsigned* ctl = (unsigned*)(args.ws + WS_CTL);
    XcdBarrier bar; bar.bar = ctl + CW_BAR; bar.x = 0; bar.st = nullptr;
    if (!MK_PER_PHASE) bar = xcd_barrier_post(ctl + CW_BAR, (volatile LAS unsigned*)(lds + MISC_OFF + 32));
    const int lo = args.ph_lo, hi = args.ph_hi;
#ifndef PHMASK
#define PHMASK 0xFFFFFFu
#endif
#define PHON(k) (((PHMASK) >> ((k) < 2 ? (k) : 2 + ((k) - 2) % 10)) & 1u)
#define IN(k) (PHON(k) && lo <= (k) && (k) < hi)
#ifndef REPMASK
#define REPMASK 0u
#endif
#define NREP(k) (1 + (int)(((REPMASK) >> ((k) < 2 ? (k) : 2 + ((k) - 2) % 10)) & 1u))
#define SEAM(k) do { if (IN(k) && IN((k) + 1)) xcd_barrier(bar); } while (0)

    if (IN(0)) for (int rep = 0; rep < NREP(0); ++rep) { TIDS; phase_p0(args, lds, tid, lane, wave); }
    SEAM(0);
    if (IN(1)) for (int rep = 0; rep < NREP(1); ++rep) { TIDS; phase_p1(args, lane, wave); }
    SEAM(1);
    for (int l = 0; l < 2; ++l) {
        const int pb = 2 + 10 * l;
        bf16* Hb = (bf16*)(args.ws + WS_HB);
        if (IN(pb + 0)) for (int rep = 0; rep < NREP(2); ++rep) {
            pg8::Gemm g{Hb, (const bf16*)(args.ws + WS_WIN) + (size_t)l * INC * 1024, NROWS, INC, 1024}; pg8::StaticOrder S; S.init(NROWS, INC, (int)gridDim.x, (int)blockIdx.x);
            pg8::EpiBf16<0> E{(bf16*)(args.ws + WS_P), INC, nullptr, 0, 0, 1.0f};
            pg8::gemm_phase<pg8::EpiBf16<0>, pg8::StaticOrder, true, true>(lds, g, S, E);
        }
        SEAM(pb + 0);
        if (IN(pb + 1)) for (int rep = 0; rep < NREP(3); ++rep) { TIDS; phase_b_mfma(args, l, lds, tid, lane, wave); }
        SEAM(pb + 1);
        if (IN(pb + 2)) { TIDS; phase_c(args, l, tid); }
        SEAM(pb + 2);
        if (IN(pb + 3)) for (int rep = 0; rep < NREP(5); ++rep) { TIDS; phase_d_mfma(args, l, lds, tid, lane, wave); }
        SEAM(pb + 3);
        if (IN(pb + 4)) for (int rep = 0; rep < (l == 0 ? NREP(6) : 1); ++rep) {
            const int M = l == 0 ? NROWS : NLAT;
            pg8::Gemm g{(const bf16*)(args.ws + WS_YMIX), (const bf16*)(args.ws + WS_WOUT) + (size_t)l * 1024 * 1024, M, 1024, 1024}; pg8::StaticOrder S; S.init(M, 1024, (int)gridDim.x, (int)blockIdx.x);
            pg8::EpiBf16<0> E{(bf16*)(args.ws + WS_YO), 1024, nullptr, 0, 0, 1.0f};
            pg8::gemm_phase<pg8::EpiBf16<0>, pg8::StaticOrder, true, true>(lds, g, S, E);
        }
        SEAM(pb + 4);
        if (IN(pb + 5)) { TIDS; phase_f2(args, l, lds, tid, lane, wave); }
        SEAM(pb + 5);
        if (IN(pb + 6)) for (int rep = 0; rep < NREP(8); ++rep) { TIDS; phase_g(args, l, lds, tid, lane, wave); }
        SEAM(pb + 6);
        if (IN(pb + 7)) for (int rep = 0; rep < NREP(9); ++rep) {
            int npan; { TIDS; npan = build_p2e(args, l, lds, tid); }
            pg8::Gemm g{Hb, (const bf16*)(args.ws + WS_WGU) + (size_t)l * 32 * 1024 * 1024, npan * 256, 1024, 1024};
            LAS int* arows = (LAS int*)(lds + AROWS_OFF);
            { TIDS; const int* rowof = (const int*)(args.ws + WS_ROWOF);
              for (int i = 0; i < 6; ++i) { const int L = i * (int)gridDim.x + (int)blockIdx.x; if (L < npan * 4 && tid < 256) arows[i * 256 + tid] = rowof[(L >> 2) * 256 + tid]; }
              __syncthreads(); }
            pg8::MoeOrder S{(const LAS unsigned char*)(lds + P2E_OFF), npan * 4, (int)gridDim.x, (int)blockIdx.x, arows};
            pg8::EpiGLU E{(bf16*)(args.ws + WS_HH)};
            pg8::gemm_phase_gather<pg8::EpiGLU, pg8::MoeOrder>(lds, g, S, E);
        }
        SEAM(pb + 7);
        if (IN(pb + 8)) for (int rep = 0; rep < NREP(10); ++rep) {
            int npan; { TIDS; npan = build_p2e(args, l, lds, tid); }
            pg8::Gemm g{(const bf16*)(args.ws + WS_HH), (const bf16*)(args.ws + WS_WD) + (size_t)l * 32 * 1024 * 512, npan * 256, 1024, 512};
            pg8::MoeOrder S{(const LAS unsigned char*)(lds + P2E_OFF), npan * 4, (int)gridDim.x, (int)blockIdx.x, nullptr};
            pg8::EpiY E{(bf16*)(args.ws + WS_Y)};
            pg8::gemm_phase<pg8::EpiY, pg8::MoeOrder, true, true>(lds, g, S, E);
        }
        SEAM(pb + 8);
        if (IN(pb + 9)) { if (NREP(11) > 1) { TIDS; phase_j(args, l, lane, wave, true); } TIDS; phase_j(args, l, lane, wave); }
        SEAM(pb + 9);
    }
#undef IN
#undef SEAM
}

extern "C" void kernel_launch(void* const* d_in, const int* in_sizes, int n_in, void* d_out, int out_size, void* d_ws, size_t ws_size, hipStream_t stream) {
    static int grid = 0;
    if (grid == 0) {
        if (n_in != 24 || in_sizes[0] != NLAT * DM || out_size != NLAT * DM || ws_size < WS_END) { fprintf(stderr, "kernel_launch: unexpected problem (n_in %d, ws %zu < %zu?)\n", n_in, ws_size, (size_t)WS_END); grid = -1; return; }
        int dev = 0, cus = 0, per_cu = 0;
        if (hipGetDevice(&dev) != hipSuccess || hipDeviceGetAttribute(&cus, hipDeviceAttributeMultiprocessorCount, dev) != hipSuccess) { grid = -1; return; }
        if (hipFuncSetAttribute((const void*)hybrid_fwd, hipFuncAttributeMaxDynamicSharedMemorySize, LDS_BYTES) != hipSuccess) { grid = -1; return; }
        if (hipOccupancyMaxActiveBlocksPerMultiprocessor(&per_cu, (const void*)hybrid_fwd, NTHR, LDS_BYTES) != hipSuccess || per_cu < 1) { fprintf(stderr, "kernel_launch: occupancy query says %d\n", per_cu); }
        (void)hipGetLastError();
        grid = cus;
        if (grid != 256) { fprintf(stderr, "kernel_launch: built for 256 CUs, device has %d\n", cus); grid = -1; return; }
    }
    if (grid < 0) return;
    if (hipMemsetAsync((char*)d_ws + WS_CTL, 0, CTL_ZERO_BYTES, stream) != hipSuccess) return;
    Args a{};
    for (int i = 0; i < 24; ++i) a.in[i] = (const float*)d_in[i];
    a.out = (float*)d_out; a.ws = (unsigned char*)d_ws;
#if MK_PER_PHASE
    for (int p = 0; p < N_PHASES; ++p) { a.ph_lo = p; a.ph_hi = p + 1; hipLaunchKernelGGL(hybrid_fwd, dim3(grid), dim3(NTHR), LDS_BYTES, stream, a); }
#else
    a.ph_lo = 0; a.ph_hi = N_PHASES;
    hipLaunchKernelGGL(hybrid_fwd, dim3(grid), dim3(NTHR), LDS_BYTES, stream, a);
#endif
}
```

```cpp
#include <hip/hip_runtime.h>
#include <cstdio>
#include <cstdint>
#include <cstddef>
namespace pg8 {
#define PG8_LAS __attribute__((address_space(3)))
typedef unsigned short bf16_t;
typedef short bf16x8 __attribute__((ext_vector_type(8)));
typedef float f32x4 __attribute__((ext_vector_type(4)));
typedef unsigned u32x4 __attribute__((ext_vector_type(4)));
constexpr int BM = 256, BK = 64, HALF = 128, HTB = HALF * BK * 2  , STAGE_BYTES = 8 * HTB, NXCD = 8, WGM = 8;

__host__ __device__ __forceinline__ int lds_byte(int r, int c) { const int st = (r >> 4) * 2 + (c >> 5), rr = r & 15, cc = c & 31, ob = rr * 64 + cc * 2; return st * 1024 + (ob ^ (((ob >> 9) & 1) << 5)); }
__host__ __device__ __forceinline__ void stage_rc(int b, int& R, int& C) { const int st = b / 1024, sb = b % 1024, swz = sb ^ (((sb >> 9) & 1) << 5); R = (st >> 1) * 16 + swz / 64; C = (st & 1) * 32 + (swz % 64) / 2; }
__host__ __device__ __forceinline__ int perm32(int rho) { const int n = rho >> 4, i = rho & 15; return 8 * (i >> 2) + 4 * n + (i & 3); }

struct Unit { int pm, pn; };
struct Gemm { const bf16_t* A; const bf16_t* Bt; int M, N, K; };

struct StaticOrder {
    int nM, nN, nwg, G, c;
    __host__ __device__ void init(int M, int N, int G_, int c_) { nM = M / BM; nN = N / BM; nwg = nM * nN; G = G_; c = c_; }
    __host__ __device__ bool next(int i, Unit& u) const {
        const long L = (long)i * G + c; if (L >= nwg) return false;
        int wgid = (int)L; { const int q = nwg / NXCD, r = nwg % NXCD, xcd = wgid % NXCD, off = wgid / NXCD; wgid = (xcd < r ? xcd * (q + 1) : r * (q + 1) + (xcd - r) * q) + off; }
        const int nig = WGM * nN, gid = wgid / nig, fm = gid * WGM, gsz = (nM - fm) < WGM ? (nM - fm) : WGM;
        u.pm = fm + ((wgid % nig) % gsz); u.pn = (wgid % nig) / gsz; return true;
    }
    __device__ __forceinline__ void a_ready(const Unit&) const {}
    __device__ __forceinline__ void done(const Unit&) const {}
};

__device__ __forceinline__ unsigned cvt_pk_bf16(float lo, float hi) { unsigned r; asm volatile("v_cvt_pk_bf16_f32 %0, %1, %2" : "=v"(r) : "v"(lo), "v"(hi)); return r; }
typedef float f32x2 __attribute__((ext_vector_type(2)));
__device__ __forceinline__ f32x2 gelu_pk(f32x2 v) {
    const f32x2 av = __builtin_elementwise_abs(v), d = av * 0.2316418882f + 1.0f;
    f32x2 t; t.x = __builtin_amdgcn_rcpf(d.x); t.y = __builtin_amdgcn_rcpf(d.y);
    f32x2 q = t * 0.5307027145f + (-0.7265760135f); q = q * t + 0.7107068705f; q = q * t + (-0.142248368f); q = q * t + 0.127414796f; q = q * t;
    const f32x2 s = (v * v) * (-0.72134752044f);
    f32x2 e; e.x = __builtin_amdgcn_exp2f(s.x); e.y = __builtin_amdgcn_exp2f(s.y);
    const f32x2 m = v * (q * e), r = v - m;
    f32x2 o; o.x = v.x < 0.f ? m.x : r.x; o.y = v.y < 0.f ? m.y : r.y; return o;
}

template <int ACT  > struct EpiBf16 {
    static constexpr bool PERM = true, AFTER_DRAIN = false; static_assert(ACT == 0 || ACT == 1, "EpiBf16: ACT is 0 (none) or 1 (gelu_pk)");
    bf16_t* O; int ldc; const float* bias; int split_cols; size_t split_stride; float scale0;
    __device__ __forceinline__ void operator()(const f32x4 (&acc)[2][2][4][2], const Unit& u, int wr, int wc, int fr, int fq) const {
        const int row0 = u.pm * BM + wr * 64 + fr; int colt = u.pn * BM; bf16_t* base = O;
        float sc = 1.f; if (split_cols) { const int t = colt / split_cols; base += (size_t)t * split_stride; colt -= t * split_cols; if (t == 0) sc = scale0; }
        const int col0 = colt + wc * 32 + 8 * fq, bcol0 = u.pn * BM + wc * 32 + 8 * fq;
        f32x4 bv[2][2];
#pragma unroll
        for (int bj = 0; bj < 2; ++bj)
#pragma unroll
            for (int n = 0; n < 2; ++n) bv[bj][n] = bias ? *(const f32x4*)(bias + bcol0 + bj * HALF + 4 * n) : (f32x4){0.f, 0.f, 0.f, 0.f};
#pragma unroll
        for (int ai = 0; ai < 2; ++ai)
#pragma unroll
            for (int m = 0; m < 4; ++m) { bf16_t* rowp = base + (size_t)(row0 + ai * HALF + m * 16) * ldc + col0;
#pragma unroll
                for (int bj = 0; bj < 2; ++bj) { f32x4 v0 = acc[ai][bj][m][0] + bv[bj][0], v1 = acc[ai][bj][m][1] + bv[bj][1];
                    if (ACT == 1) { f32x2 a = gelu_pk((f32x2){v0[0], v0[1]}), b = gelu_pk((f32x2){v0[2], v0[3]}), c = gelu_pk((f32x2){v1[0], v1[1]}), d = gelu_pk((f32x2){v1[2], v1[3]});
                        v0 = (f32x4){a.x, a.y, b.x, b.y}; v1 = (f32x4){c.x, c.y, d.x, d.y}; }
                    v0 = v0 * sc; v1 = v1 * sc; u32x4 w; w.x = cvt_pk_bf16(v0[0], v0[1]); w.y = cvt_pk_bf16(v0[2], v0[3]); w.z = cvt_pk_bf16(v1[0], v1[1]); w.w = cvt_pk_bf16(v1[2], v1[3]);
                    *(u32x4*)(rowp + bj * HALF) = w; } }
    }
};
__device__ __forceinline__ float silu_f(float x) { return x / (1.0f + __expf(-x)); }
struct EpiResid {
    static constexpr bool PERM = false, AFTER_DRAIN = false;
    const float* xin_lat; const float* xin_ctx; float* xo_lat; float* xo_ctx; const float* mod; float alpha;
    __device__ __forceinline__ void operator()(const f32x4 (&acc)[2][2][4][2], const Unit& u, int wr, int wc, int fr, int fq) const {
        const int prow0 = u.pm * BM; const bool isc = prow0 >= 32768;
        const float* xin = isc ? xin_ctx + (size_t)(prow0 - 32768) * 1024 : xin_lat + (size_t)prow0 * 1024;
        float* xo = isc ? xo_ctx + (size_t)(prow0 - 32768) * 1024 : xo_lat + (size_t)prow0 * 1024;
        const float* g1 = mod + (isc ? 8 : (prow0 >> 12)) * 6144 + 2048;
        const int col0 = u.pn * BM + wc * 32 + 4 * fq;
        f32x4 gv[2][2];
#pragma unroll
        for (int bj = 0; bj < 2; ++bj)
#pragma unroll
            for (int n = 0; n < 2; ++n) gv[bj][n] = *(const f32x4*)(g1 + col0 + bj * HALF + n * 16);
#pragma unroll
        for (int ai = 0; ai < 2; ++ai)
#pragma unroll
            for (int m = 0; m < 4; ++m) { const size_t off = (size_t)(ai * HALF + wr * 64 + m * 16 + fr) * 1024 + col0;
#pragma unroll
                for (int bj = 0; bj < 2; ++bj)
#pragma unroll
                    for (int n = 0; n < 2; ++n) { const f32x4 xv = *(const f32x4*)(xin + off + bj * HALF + n * 16);
                        *(f32x4*)(xo + off + bj * HALF + n * 16) = xv * alpha + gv[bj][n] * acc[ai][bj][m][n]; }
                if (m & 1) asm volatile("" ::: "memory"); }
    }
};
struct EpiGLU {
    static constexpr bool PERM = true, AFTER_DRAIN = false;
    bf16_t* Hh;
    __device__ __forceinline__ void operator()(const f32x4 (&acc)[2][2][4][2], const Unit& u, int wr, int wc, int fr, int fq) const {
        const int row0 = u.pm * BM + wr * 64 + fr; const int col0 = (u.pn & 3) * 128 + wc * 32 + 8 * fq;
#pragma unroll
        for (int ai = 0; ai < 2; ++ai)
#pragma unroll
            for (int m = 0; m < 4; ++m) { bf16_t* rowp = Hh + (size_t)(row0 + ai * HALF + m * 16) * 512 + col0;
                const f32x4 g0 = acc[ai][0][m][0], g1 = acc[ai][0][m][1], u0 = acc[ai][1][m][0], u1 = acc[ai][1][m][1];
                u32x4 w; w.x = cvt_pk_bf16(silu_f(g0[0]) * u0[0], silu_f(g0[1]) * u0[1]); w.y = cvt_pk_bf16(silu_f(g0[2]) * u0[2], silu_f(g0[3]) * u0[3]);
                w.z = cvt_pk_bf16(silu_f(g1[0]) * u1[0], silu_f(g1[1]) * u1[1]); w.w = cvt_pk_bf16(silu_f(g1[2]) * u1[2], silu_f(g1[3]) * u1[3]);
                *(u32x4*)rowp = w; }
    }
};
struct EpiY {
    static constexpr bool PERM = true, AFTER_DRAIN = false;
    bf16_t* O;
    __device__ __forceinline__ void operator()(const f32x4 (&acc)[2][2][4][2], const Unit& u, int wr, int wc, int fr, int fq) const {
        const int row0 = u.pm * BM + wr * 64 + fr; const int col0 = (u.pn & 3) * BM + wc * 32 + 8 * fq;
#pragma unroll
        for (int ai = 0; ai < 2; ++ai)
#pragma unroll
            for (int m = 0; m < 4; ++m) { bf16_t* rowp = O + (size_t)(row0 + ai * HALF + m * 16) * 1024 + col0;
#pragma unroll
                for (int bj = 0; bj < 2; ++bj) { const f32x4 v0 = acc[ai][bj][m][0], v1 = acc[ai][bj][m][1];
                    u32x4 w; w.x = cvt_pk_bf16(v0[0], v0[1]); w.y = cvt_pk_bf16(v0[2], v0[3]); w.z = cvt_pk_bf16(v1[0], v1[1]); w.w = cvt_pk_bf16(v1[2], v1[3]);
                    *(u32x4*)(rowp + bj * HALF) = w; } }
    }
};
struct MoeOrder {
    const PG8_LAS unsigned char* p2e; int nunits, G, c; const PG8_LAS int* rows;
    __device__ __forceinline__ const PG8_LAS int* arows(int i) const { return rows + i * 256; }
    __device__ __forceinline__ bool next(int i, Unit& u) const {
        const int L = i * G + c; if (L >= nunits) return false;
        u.pm = L >> 2; u.pn = (int)p2e[L >> 2] * 4 + (L & 3); return true;
    }
    __device__ __forceinline__ void a_ready(const Unit&) const {}
    __device__ __forceinline__ void done(const Unit&) const {}
};
template <class Epi, class Sched, bool ALIGN_EPI = false, bool SP2 = false>
__device__ __forceinline__ void gemm_phase(PG8_LAS unsigned char* lds, const Gemm g, const Sched& S, const Epi& E) {
    int tid_ = threadIdx.x; asm volatile("" : "+v"(tid_));
    const int tid = tid_, wid = __builtin_amdgcn_readfirstlane(tid >> 6), lane = tid & 63, wr = wid >> 2, wc = wid & 3, fr = lane & 15, fq = lane >> 4;
    const int K = g.K, nt = K / BK;
    unsigned voffA[2], voffB[2];
#pragma unroll
    for (int i = 0; i < 2; ++i) { int R, C; stage_rc(tid * 16 + i * 8192, R, C); const int Rb = Epi::PERM ? ((R & ~31) + perm32(R & 31)) : R;
        voffA[i] = (unsigned)(R * K + C) * 2u; voffB[i] = (unsigned)(Rb * K + C) * 2u; }
    const size_t kstep = (size_t)(BK * 2);
    const size_t hstep = (size_t)HALF * K * 2;
    const size_t tstep = 2 * hstep;
    const unsigned ldsw = (unsigned)wid * 1024u;
    const int aoff = lds_byte(wr * 64 + fr, fq * 8), boff = lds_byte(wc * 32 + fr, fq * 8);
#define PG8_SA(b, h) (((b) * 2 + (h)) * HTB)
#define PG8_SB(b, h) ((4 + (b) * 2 + (h)) * HTB)
#define PG8_STAGE(bufoff, gbase, voff) do { _Pragma("unroll") for (int _i = 0; _i < 2; ++_i) \
        __builtin_amdgcn_global_load_lds((const unsigned*)((const char*)(gbase) + (voff)[_i]), (PG8_LAS unsigned*)(lds + (bufoff) + ldsw + _i * 8192), 16, 0, 0); } while (0)
#define PG8_LDA(dst, b, h) do { _Pragma("unroll") for (int m = 0; m < 4; ++m) _Pragma("unroll") for (int k = 0; k < 2; ++k) dst[m][k] = *(const PG8_LAS bf16x8*)(lds + PG8_SA(b, h) + aoff + m * 2048 + k * 1024); } while (0)
#define PG8_LDB(dst, b, h) do { _Pragma("unroll") for (int n = 0; n < 2; ++n) _Pragma("unroll") for (int k = 0; k < 2; ++k) dst[n][k] = *(const PG8_LAS bf16x8*)(lds + PG8_SB(b, h) + boff + n * 2048 + k * 1024); } while (0)
#define PG8_MMA(ai, bj, At, Bt) do { __builtin_amdgcn_s_setprio(1); _Pragma("unroll") for (int m = 0; m < 4; ++m) _Pragma("unroll") for (int n = 0; n < 2; ++n) _Pragma("unroll") for (int k = 0; k < 2; ++k) \
        acc[ai][bj][m][n] = __builtin_amdgcn_mfma_f32_16x16x32_bf16(Bt[n][k], At[m][k], acc[ai][bj][m][n], 0, 0, 0); __builtin_amdgcn_s_setprio(0); } while (0)
#define PG8_WAIT_V(n) asm volatile("s_waitcnt vmcnt(" #n ")" ::: "memory")
#define PG8_WAIT_L(n) asm volatile("s_waitcnt lgkmcnt(" #n ")" ::: "memory")
#define PG8_BAR __builtin_amdgcn_s_barrier()
#define PG8_SCHED __builtin_amdgcn_sched_barrier(0)
    Unit cur, nxt; int ui = 0;
    if (!S.next(0, cur)) return;
    f32x4 acc[2][2][4][2];
#pragma unroll
    for (int a = 0; a < 2; ++a)
#pragma unroll
        for (int b = 0; b < 2; ++b)
#pragma unroll
            for (int m = 0; m < 4; ++m)
#pragma unroll
                for (int n = 0; n < 2; ++n) acc[a][b][m][n] = (f32x4){0.f, 0.f, 0.f, 0.f};
    bf16x8 At[4][2], B0[2][2], B1[2][2];
    const char* cA = (const char*)g.A + (size_t)cur.pm * tstep; const char* cB = (const char*)g.Bt + (size_t)cur.pn * tstep;
    S.a_ready(cur);
    if constexpr (SP2) {
        PG8_STAGE(PG8_SB(0, 0), cB, voffB); PG8_STAGE(PG8_SB(0, 1), cB + hstep, voffB); PG8_STAGE(PG8_SA(0, 0), cA, voffA); PG8_STAGE(PG8_SA(0, 1), cA + hstep, voffA);
        if (wr == 1) PG8_BAR;
        PG8_WAIT_V(2); PG8_BAR;
        PG8_STAGE(PG8_SB(1, 0), cB + kstep, voffB); PG8_STAGE(PG8_SA(1, 0), cA + kstep, voffA); PG8_STAGE(PG8_SB(1, 1), cB + hstep + kstep, voffB);
        PG8_WAIT_V(6); PG8_BAR;
    } else {
        PG8_STAGE(PG8_SB(0, 0), cB, voffB); PG8_STAGE(PG8_SA(0, 0), cA, voffA); PG8_STAGE(PG8_SB(0, 1), cB + hstep, voffB); PG8_STAGE(PG8_SA(0, 1), cA + hstep, voffA);
        if (wr == 1) PG8_BAR;
        PG8_WAIT_V(4); PG8_BAR;
        PG8_STAGE(PG8_SB(1, 0), cB + kstep, voffB); PG8_STAGE(PG8_SA(1, 0), cA + kstep, voffA); PG8_STAGE(PG8_SB(1, 1), cB + hstep + kstep, voffB);
        PG8_WAIT_V(6); PG8_BAR;
    }
    for (;;) {
        const bool has_next = S.next(ui + 1, nxt);
        const char* nA = has_next ? (const char*)g.A + (size_t)nxt.pm * tstep : cA; const char* nB = has_next ? (const char*)g.Bt + (size_t)nxt.pn * tstep : cB;
        for (int t = 0; t < nt; t += 2) {
            const bool last = (t == nt - 2);
            const char* a1 = cA + (size_t)(t + 1) * kstep;
            const char* a2 = last ? nA : cA + (size_t)(t + 2) * kstep; const char* b2 = last ? nB : cB + (size_t)(t + 2) * kstep;
            const char* a3 = a2 + kstep; const char* b3 = b2 + kstep;
            if (last && has_next) S.a_ready(nxt);
            if constexpr (SP2) {
            PG8_LDB(B0, 0, 0); PG8_LDB(B1, 0, 1); PG8_SCHED; PG8_LDA(At, 0, 0); PG8_STAGE(PG8_SA(1, 1), a1 + hstep, voffA);
            PG8_WAIT_V(8); PG8_WAIT_L(0); PG8_BAR; PG8_MMA(0, 0, At, B0); PG8_MMA(0, 1, At, B1); PG8_BAR; PG8_SCHED;
            PG8_LDA(At, 0, 1); PG8_STAGE(PG8_SB(0, 0), b2, voffB); PG8_STAGE(PG8_SB(0, 1), b2 + hstep, voffB); PG8_STAGE(PG8_SA(0, 0), a2, voffA);
            PG8_WAIT_V(8); PG8_WAIT_L(0); PG8_BAR; PG8_MMA(1, 0, At, B0); PG8_MMA(1, 1, At, B1); PG8_BAR; PG8_SCHED;
            PG8_LDB(B0, 1, 0); PG8_LDB(B1, 1, 1); PG8_SCHED; PG8_LDA(At, 1, 0); PG8_STAGE(PG8_SA(0, 1), a2 + hstep, voffA);
            PG8_WAIT_V(8); PG8_WAIT_L(0); PG8_BAR; PG8_MMA(0, 0, At, B0); PG8_MMA(0, 1, At, B1); PG8_BAR; PG8_SCHED;
            PG8_LDA(At, 1, 1); PG8_STAGE(PG8_SB(1, 0), b3, voffB); PG8_STAGE(PG8_SB(1, 1), b3 + hstep, voffB); PG8_STAGE(PG8_SA(1, 0), a3, voffA);
            PG8_WAIT_V(8); PG8_WAIT_L(0); PG8_BAR; PG8_MMA(1, 0, At, B0); PG8_MMA(1, 1, At, B1); PG8_BAR; PG8_SCHED;
            } else {
            PG8_LDB(B0, 0, 0); PG8_SCHED; PG8_LDA(At, 0, 0); PG8_STAGE(PG8_SA(1, 1), a1 + hstep, voffA);
            PG8_WAIT_L(8); PG8_BAR; PG8_WAIT_L(0); PG8_MMA(0, 0, At, B0); PG8_BAR; PG8_SCHED;
            PG8_LDB(B1, 0, 1); PG8_STAGE(PG8_SB(0, 0), b2, voffB);
            PG8_BAR; PG8_WAIT_L(0); PG8_MMA(0, 1, At, B1); PG8_BAR;
            PG8_LDA(At, 0, 1); PG8_STAGE(PG8_SA(0, 0), a2, voffA);
            PG8_BAR; PG8_WAIT_L(0); PG8_MMA(1, 0, At, B0); PG8_BAR; PG8_SCHED;
            PG8_STAGE(PG8_SB(0, 1), b2 + hstep, voffB);
            PG8_WAIT_V(6); PG8_BAR; PG8_MMA(1, 1, At, B1); PG8_BAR;
            PG8_LDB(B0, 1, 0); PG8_SCHED; PG8_LDA(At, 1, 0); PG8_STAGE(PG8_SA(0, 1), a2 + hstep, voffA);
            PG8_WAIT_L(8); PG8_BAR; PG8_WAIT_L(0); PG8_MMA(0, 0, At, B0); PG8_BAR; PG8_SCHED;
            PG8_LDB(B1, 1, 1); PG8_STAGE(PG8_SB(1, 0), b3, voffB);
            PG8_BAR; PG8_WAIT_L(0); PG8_MMA(0, 1, At, B1); PG8_BAR;
            PG8_LDA(At, 1, 1); PG8_STAGE(PG8_SA(1, 0), a3, voffA);
            PG8_BAR; PG8_WAIT_L(0); PG8_MMA(1, 0, At, B0); PG8_BAR; PG8_SCHED;
            PG8_STAGE(PG8_SB(1, 1), b3 + hstep, voffB);
            PG8_WAIT_V(6); PG8_BAR; PG8_MMA(1, 1, At, B1); PG8_BAR;
            }
        }
        if constexpr (ALIGN_EPI) { if (wr == 0) PG8_BAR; }
        if constexpr (!Epi::AFTER_DRAIN) { E(acc, cur, wr, wc, fr, fq); S.done(cur); }
        if (!has_next) break;
#pragma unroll
        for (int a = 0; a < 2; ++a)
#pragma unroll
            for (int b = 0; b < 2; ++b)
#pragma unroll
                for (int m = 0; m < 4; ++m)
#pragma unroll
                    for (int n = 0; n < 2; ++n) acc[a][b][m][n] = (f32x4){0.f, 0.f, 0.f, 0.f};
        cur = nxt; cA = nA; cB = nB; ++ui;
        if constexpr (ALIGN_EPI) { if (wr == 1) PG8_BAR; }
    }
    PG8_WAIT_V(0);
    if constexpr (!ALIGN_EPI) { if (wr == 0) PG8_BAR; }
    PG8_BAR;
    if constexpr (Epi::AFTER_DRAIN) { E.fused(acc, cur, wr, wc, fr, fq, lds, wid, lane); S.done(cur); }
#undef PG8_SA
#undef PG8_SB
#undef PG8_STAGE
#undef PG8_LDA
#undef PG8_LDB
#undef PG8_MMA
#undef PG8_WAIT_V
#undef PG8_WAIT_L
#undef PG8_BAR
#undef PG8_SCHED
}
template <class Epi, class Sched>
__device__ __forceinline__ void gemm_phase_gather(PG8_LAS unsigned char* lds, const Gemm g, const Sched& S, const Epi& E) {
    int tid_ = threadIdx.x; asm volatile("" : "+v"(tid_));
    const int tid = tid_, wid = __builtin_amdgcn_readfirstlane(tid >> 6), lane = tid & 63, wr = wid >> 2, wc = wid & 3, fr = lane & 15, fq = lane >> 4;
    const int K = g.K, nt = K / BK;
    constexpr bool ALIGN_EPI = true, SP2 = true;
    unsigned voffB[2]; unsigned vc[2][2], vn[2][2]; int RA[2], CA[2];
#pragma unroll
    for (int i = 0; i < 2; ++i) { int R, C; stage_rc(tid * 16 + i * 8192, R, C); const int Rb = Epi::PERM ? ((R & ~31) + perm32(R & 31)) : R;
        RA[i] = R; CA[i] = C; voffB[i] = (unsigned)(Rb * K + C) * 2u; }
    const size_t kstep = (size_t)(BK * 2);
    const size_t hstep = (size_t)HALF * K * 2;
    const size_t tstep = 2 * hstep;
    const unsigned ldsw = (unsigned)wid * 1024u;
    const int aoff = lds_byte(wr * 64 + fr, fq * 8), boff = lds_byte(wc * 32 + fr, fq * 8);
#define PG8_SA(b, h) (((b) * 2 + (h)) * HTB)
#define PG8_SB(b, h) ((4 + (b) * 2 + (h)) * HTB)
#define PG8_STAGE(bufoff, gbase, voff) do { _Pragma("unroll") for (int _i = 0; _i < 2; ++_i) \
        __builtin_amdgcn_global_load_lds((const unsigned*)((const char*)(gbase) + (voff)[_i]), (PG8_LAS unsigned*)(lds + (bufoff) + ldsw + _i * 8192), 16, 0, 0); } while (0)
#define PG8_LDA(dst, b, h) do { _Pragma("unroll") for (int m = 0; m < 4; ++m) _Pragma("unroll") for (int k = 0; k < 2; ++k) dst[m][k] = *(const PG8_LAS bf16x8*)(lds + PG8_SA(b, h) + aoff + m * 2048 + k * 1024); } while (0)
#define PG8_LDB(dst, b, h) do { _Pragma("unroll") for (int n = 0; n < 2; ++n) _Pragma("unroll") for (int k = 0; k < 2; ++k) dst[n][k] = *(const PG8_LAS bf16x8*)(lds + PG8_SB(b, h) + boff + n * 2048 + k * 1024); } while (0)
#define PG8_MMA(ai, bj, At, Bt) do { __builtin_amdgcn_s_setprio(1); _Pragma("unroll") for (int m = 0; m < 4; ++m) _Pragma("unroll") for (int n = 0; n < 2; ++n) _Pragma("unroll") for (int k = 0; k < 2; ++k) \
        acc[ai][bj][m][n] = __builtin_amdgcn_mfma_f32_16x16x32_bf16(Bt[n][k], At[m][k], acc[ai][bj][m][n], 0, 0, 0); __builtin_amdgcn_s_setprio(0); } while (0)
#define PG8_WAIT_V(n) asm volatile("s_waitcnt vmcnt(" #n ")" ::: "memory")
#define PG8_WAIT_L(n) asm volatile("s_waitcnt lgkmcnt(" #n ")" ::: "memory")
#define PG8_BAR __builtin_amdgcn_s_barrier()
#define PG8_SCHED __builtin_amdgcn_sched_barrier(0)
    Unit cur, nxt; int ui = 0;
    if (!S.next(0, cur)) return;
    f32x4 acc[2][2][4][2];
#pragma unroll
    for (int a = 0; a < 2; ++a)
#pragma unroll
        for (int b = 0; b < 2; ++b)
#pragma unroll
            for (int m = 0; m < 4; ++m)
#pragma unroll
                for (int n = 0; n < 2; ++n) acc[a][b][m][n] = (f32x4){0.f, 0.f, 0.f, 0.f};
    bf16x8 At[4][2], B0[2][2], B1[2][2];
    const char* kA = (const char*)g.A; const char* cB = (const char*)g.Bt + (size_t)cur.pn * tstep;
#define PG8_ROWS(dst, tab) do { _Pragma("unroll") for (int _h = 0; _h < 2; ++_h) _Pragma("unroll") for (int _i = 0; _i < 2; ++_i) \
        dst[_h][_i] = (unsigned)((tab)[_h * HALF + RA[_i]] * K + CA[_i]) * 2u; } while (0)
    { const PG8_LAS int* tab = S.arows(0); PG8_ROWS(vc, tab); }
    S.a_ready(cur);
    if constexpr (SP2) {
        PG8_STAGE(PG8_SB(0, 0), cB, voffB); PG8_STAGE(PG8_SB(0, 1), cB + hstep, voffB); PG8_STAGE(PG8_SA(0, 0), kA, vc[0]); PG8_STAGE(PG8_SA(0, 1), kA, vc[1]);
        if (wr == 1) PG8_BAR;
        PG8_WAIT_V(2); PG8_BAR;
        PG8_STAGE(PG8_SB(1, 0), cB + kstep, voffB); PG8_STAGE(PG8_SA(1, 0), kA + kstep, vc[0]); PG8_STAGE(PG8_SB(1, 1), cB + hstep + kstep, voffB);
        PG8_WAIT_V(6); PG8_BAR;
    }
    for (;;) {
        const bool has_next = S.next(ui + 1, nxt);
        const char* nB = has_next ? (const char*)g.Bt + (size_t)nxt.pn * tstep : cB;
        if (has_next) { const PG8_LAS int* tab = S.arows(ui + 1); PG8_ROWS(vn, tab); } else { _Pragma("unroll") for (int _h = 0; _h < 2; ++_h) { vn[_h][0] = vc[_h][0]; vn[_h][1] = vc[_h][1]; } }
        for (int t = 0; t < nt; t += 2) {
            const bool last = (t == nt - 2);
            const char* a1 = kA + (size_t)(t + 1) * kstep;
            const char* a2 = last ? kA : kA + (size_t)(t + 2) * kstep; const char* b2 = last ? nB : cB + (size_t)(t + 2) * kstep;
            unsigned v0[2], v1[2]; v0[0] = last ? vn[0][0] : vc[0][0]; v0[1] = last ? vn[0][1] : vc[0][1]; v1[0] = last ? vn[1][0] : vc[1][0]; v1[1] = last ? vn[1][1] : vc[1][1];
            const char* a3 = a2 + kstep; const char* b3 = b2 + kstep;
            if (last && has_next) S.a_ready(nxt);
            if constexpr (SP2) {
            PG8_LDB(B0, 0, 0); PG8_LDB(B1, 0, 1); PG8_SCHED; PG8_LDA(At, 0, 0); PG8_STAGE(PG8_SA(1, 1), a1, vc[1]);
            PG8_WAIT_V(8); PG8_WAIT_L(0); PG8_BAR; PG8_MMA(0, 0, At, B0); PG8_MMA(0, 1, At, B1); PG8_BAR; PG8_SCHED;
            PG8_LDA(At, 0, 1); PG8_STAGE(PG8_SB(0, 0), b2, voffB); PG8_STAGE(PG8_SB(0, 1), b2 + hstep, voffB); PG8_STAGE(PG8_SA(0, 0), a2, v0);
            PG8_WAIT_V(8); PG8_WAIT_L(0); PG8_BAR; PG8_MMA(1, 0, At, B0); PG8_MMA(1, 1, At, B1); PG8_BAR; PG8_SCHED;
            PG8_LDB(B0, 1, 0); PG8_LDB(B1, 1, 1); PG8_SCHED; PG8_LDA(At, 1, 0); PG8_STAGE(PG8_SA(0, 1), a2, v1);
            PG8_WAIT_V(8); PG8_WAIT_L(0); PG8_BAR; PG8_MMA(0, 0, At, B0); PG8_MMA(0, 1, At, B1); PG8_BAR; PG8_SCHED;
            PG8_LDA(At, 1, 1); PG8_STAGE(PG8_SB(1, 0), b3, voffB); PG8_STAGE(PG8_SB(1, 1), b3 + hstep, voffB); PG8_STAGE(PG8_SA(1, 0), a3, v0);
            PG8_WAIT_V(8); PG8_WAIT_L(0); PG8_BAR; PG8_MMA(1, 0, At, B0); PG8_MMA(1, 1, At, B1); PG8_BAR; PG8_SCHED;
            }
        }
        if constexpr (ALIGN_EPI) { if (wr == 0) PG8_BAR; }
        if constexpr (!Epi::AFTER_DRAIN) { E(acc, cur, wr, wc, fr, fq); S.done(cur); }
        if (!has_next) break;
#pragma unroll
        for (int a = 0; a < 2; ++a)
#pragma unroll
            for (int b = 0; b < 2; ++b)
#pragma unroll
                for (int m = 0; m < 4; ++m)
#pragma unroll
                    for (int n = 0; n < 2; ++n) acc[a][b][m][n] = (f32x4){0.f, 0.f, 0.f, 0.f};
        cur = nxt; cB = nB; ++ui;
#pragma unroll
        for (int _h = 0; _h < 2; ++_h) { vc[_h][0] = vn[_h][0]; vc[_h][1] = vn[_h][1]; }
        if constexpr (ALIGN_EPI) { if (wr == 1) PG8_BAR; }
    }
    PG8_WAIT_V(0);
    if constexpr (!ALIGN_EPI) { if (wr == 0) PG8_BAR; }
    PG8_BAR;
    if constexpr (Epi::AFTER_DRAIN) { E.fused(acc, cur, wr, wc, fr, fq, lds, wid, lane); S.done(cur); }
#undef PG8_ROWS
#undef PG8_SA
#undef PG8_SB
#undef PG8_STAGE
#undef PG8_LDA
#undef PG8_LDB
#undef PG8_MMA
#undef PG8_WAIT_V
#undef PG8_WAIT_L
#undef PG8_BAR
#undef PG8_SCHED
}
}
constexpr int NWAVES = 8, NTHR = 512;
constexpr int DM = 1024, NLAT = 32768, NCTX = 2048, NROWS = 34816, INC = 3328;
constexpr int OFF_CB = 0, OFF_CC = 256, OFF_CX = 512, OFF_Q = 768, OFF_K = 1280, OFF_V = 1792, OFF_G = 2304, OFF_U = 2816, OFF_VV = 3072;
constexpr int NCH = 34;
constexpr float LN_EPS = 1e-5f, ALPHA = 1.41421356237309515f;
constexpr size_t MiB = 1u << 20;
constexpr size_t WS_CTL = 0, CTL_ZERO_BYTES = MiB, WS_MOD = 1 * MiB, WS_LG = 1 * MiB + 480 * 1024, WS_WR = 1 * MiB + 512 * 1024, WS_TOK = 2 * MiB, WS_SGUW = 3 * MiB + 256 * 1024, WS_ROWOF = 3 * MiB + 512 * 1024, WS_WIN = 4 * MiB, WS_WOUT = 17 * MiB, WS_WGU = 21 * MiB, WS_WD = 149 * MiB,
                 WS_HB = 213 * MiB, WS_ST = WS_HB, WS_XCTX = 281 * MiB, WS_P = 289 * MiB, WS_YMIX = 510 * MiB, WS_XB = WS_P, WS_Y = WS_P, WS_YO = WS_P, WS_HH = WS_P + 152 * MiB, WS_END = 578 * MiB;
constexpr int CW_TMO = 0, CW_BAR = 4096, CW_WGCNT = 16384, CW_TOT = 32768, CW_DQ = 33024;
constexpr int RING_BYTES = 131072, LDSCTL_OFF = RING_BYTES, MISC_OFF = LDSCTL_OFF + 320, P2E_OFF = LDSCTL_OFF + 1024, PST_OFF = LDSCTL_OFF + 2048, LDS_BYTES = 147456;
constexpr int MAXPANELS = 304;
constexpr int LCNT_OFF = LDSCTL_OFF + 4096, LG_OFF = LDSCTL_OFF + 4352, DQ_OFF = LDSCTL_OFF + 9600, AROWS_OFF = LDSCTL_OFF + 9728;

#define GAS __attribute__((address_space(1)))
#define LAS __attribute__((address_space(3)))
typedef unsigned short bf16;
typedef unsigned v4u __attribute__((ext_vector_type(4)));
typedef unsigned v2u __attribute__((ext_vector_type(2)));
typedef float f32x4 __attribute__((ext_vector_type(4)));
#define LDS_WAIT() asm volatile("s_waitcnt lgkmcnt(0)" ::: "memory")
#define VM_WAIT() asm volatile("s_waitcnt vmcnt(0)" ::: "memory")
__device__ __forceinline__ unsigned f2bf(float f) { unsigned u = __builtin_bit_cast(unsigned, f); return (u + 0x7fffu + ((u >> 16) & 1u)) >> 16; }
__device__ __forceinline__ unsigned pk2(float lo, float hi) { return f2bf(lo) | (f2bf(hi) << 16); }
typedef float f32x2_t __attribute__((ext_vector_type(2))); typedef __bf16 bf16x2_t __attribute__((ext_vector_type(2)));
__device__ __forceinline__ unsigned cvtpk(float lo, float hi) { f32x2_t v = {lo, hi}; bf16x2_t b = __builtin_convertvector(v, bf16x2_t); return __builtin_bit_cast(unsigned, b); }
__device__ __forceinline__ float bflo(unsigned w) { return __builtin_bit_cast(float, w << 16); }
__device__ __forceinline__ float bfhi(unsigned w) { return __builtin_bit_cast(float, w & 0xffff0000u); }
__device__ __forceinline__ float wave_sum(float v) {
#pragma unroll
    for (int o = 1; o < 64; o <<= 1) v += __shfl_xor(v, o);
    return v;
}
__device__ __forceinline__ float log_sigmoid_f(float x) { return -(fmaxf(-x, 0.f) + log1pf(expf(-fabsf(x)))); }

struct Args { const float* in[24]; float* out; unsigned char* ws; int ph_lo, ph_hi; };
#define XB_TMO      128
#define XB_XCNT(j)  (256  + 64 * (j))
#define XB_XSUB(j)  (1280 + 64 * (j))
#define XB_XGEN(j)  (2304 + 64 * (j))
#define XB_TOP      3328
#define XB_TOPGEN   3392
#define XCD_BAR_WORDS 3456
#define XB_SPIN_CAP (1u << 18)

__device__ __forceinline__ unsigned xb_ld(unsigned* p)              { return __hip_atomic_load(p, __ATOMIC_RELAXED, __HIP_MEMORY_SCOPE_AGENT); }
__device__ __forceinline__ unsigned xb_add(unsigned* p, unsigned v) { return __hip_atomic_fetch_add(p, v, __ATOMIC_RELAXED, __HIP_MEMORY_SCOPE_AGENT); }
__device__ __forceinline__ unsigned xb_xcc_id() { return (unsigned)__builtin_amdgcn_s_getreg((3 << 11) | 20) & 0xFu; }
#define XB_SPIN(cond, bar) do { unsigned _sp = 0; while (cond) { __builtin_amdgcn_s_sleep(1); \
    if ((++_sp & 255u) == 0u) { if (xb_ld(&(bar)[XB_TMO])) break; if (_sp > XB_SPIN_CAP) { atomicAdd(&(bar)[XB_TMO], 1u); break; } } } } while (0)

struct XcdBarrier {
    unsigned* bar; unsigned x;
    volatile LAS unsigned* st;
};

__device__ __forceinline__ XcdBarrier xcd_barrier_post(unsigned* bar, volatile LAS unsigned* st) {
    XcdBarrier b; b.bar = bar; b.x = xb_xcc_id(); b.st = st;
    if (threadIdx.x == 0) (void)xb_add(&bar[XB_XCNT(b.x)], 1u);
    return b;
}
__device__ __forceinline__ void xcd_barrier_complete(unsigned* bar, unsigned x, unsigned& nloc, unsigned& nx) {
    const unsigned G = gridDim.x * gridDim.y * gridDim.z;
    unsigned sum, cnt, mine, sp = 0u;
    for (;;) {
        sum = 0u; cnt = 0u; mine = 0u;
#pragma unroll
        for (unsigned j = 0; j < 16; ++j) { const unsigned c = xb_ld(&bar[XB_XCNT(j)]); sum += c; cnt += (c > 0u) ? 1u : 0u; mine = (j == x) ? c : mine; }
        if (sum == G) break;
        __builtin_amdgcn_s_sleep(1);
        if ((++sp & 255u) == 0u) { if (xb_ld(&bar[XB_TMO])) break; if (sp > XB_SPIN_CAP) { atomicAdd(&bar[XB_TMO], 1u); break; } }
    }
    nloc = mine > 0u ? mine : 1u; nx = cnt > 0u ? cnt : 1u;
}

__device__ __forceinline__ void xcd_barrier(const XcdBarrier& b) {
    asm volatile("s_waitcnt vmcnt(0)" ::: "memory");
    __syncthreads();
    if (threadIdx.x == 0) {
        unsigned* bar = b.bar;
        __builtin_amdgcn_s_waitcnt(0);
        unsigned nloc = b.st[0], nx = b.st[1];
        if (nloc == 0u) { xcd_barrier_complete(bar, b.x, nloc, nx); b.st[0] = nloc; b.st[1] = nx; }
        const unsigned old = xb_add(&bar[XB_XSUB(b.x)], 1u);
        const unsigned gen = old / nloc;
        if (old + 1u == (gen + 1u) * nloc) {
            __builtin_amdgcn_fence(__ATOMIC_RELEASE, "agent");
            asm volatile("s_waitcnt vmcnt(0)" ::: "memory");
            const unsigned og = xb_add(&bar[XB_TOP], 1u);
            const unsigned tg = og / nx;
            if (og + 1u == (tg + 1u) * nx) xb_add(&bar[XB_TOPGEN], 1u);
            else XB_SPIN(xb_ld(&bar[XB_TOPGEN]) == tg, bar);
            __builtin_amdgcn_fence(__ATOMIC_ACQUIRE, "agent");
            xb_add(&bar[XB_XGEN(b.x)], 1u);
            asm volatile("s_waitcnt vmcnt(0)" ::: "memory");
        } else {
            XB_SPIN(xb_ld(&bar[XB_XGEN(b.x)]) == gen, bar);
            __builtin_amdgcn_fence(__ATOMIC_ACQUIRE, "agent");
            asm volatile("s_waitcnt vmcnt(0)" ::: "memory");
        }
    }
    __syncthreads();
}
__device__ __forceinline__ void transpose_tile(const float* Wsrc, int ldn, bf16* dst, int ldk, float scale, LAS float* scr, int lane) {
#pragma unroll 8
    for (int i = 0; i < 32; ++i) { const int kk = 2 * i + (lane >> 5); scr[kk * 33 + (lane & 31)] = Wsrc[(size_t)kk * ldn + (lane & 31)] * scale; }
    LDS_WAIT(); asm volatile("" ::: "memory");
    const int c = lane & 7;
#pragma unroll
    for (int j = 0; j < 4; ++j) { const int n = (lane >> 3) + 8 * j; const LAS float* s = scr + (8 * c) * 33 + n;
        v4u o; o.x = pk2(s[0 * 33], s[1 * 33]); o.y = pk2(s[2 * 33], s[3 * 33]); o.z = pk2(s[4 * 33], s[5 * 33]); o.w = pk2(s[6 * 33], s[7 * 33]);
        *(GAS v4u*)(dst + (size_t)n * ldk + 8 * c) = o; }
    LDS_WAIT(); asm volatile("" ::: "memory");
}

__device__ __forceinline__ void phase_p0(const Args& a, LAS unsigned char* lds, int tid, int lane, int wave) {
    const int G = gridDim.x;
    {
        LAS float* s = (LAS float*)lds; LAS float* red = (LAS float*)(lds + 36864);
        const float* c = a.in[1]; const float* cctx = a.in[3]; const float* wada = a.in[4]; const float* bada = a.in[5];
        float* mod = (float*)(a.ws + WS_MOD);
        for (int u = blockIdx.x; u < 192; u += G) {
            const int l = u / 96, j0 = (u % 96) * 64;
            for (int i = tid; i < 9 * 1024; i += NTHR) { const int r = i >> 10, k = i & 1023; const float v = r < 8 ? c[r * 1024 + k] : cctx[k]; s[i] = v / (1.0f + expf(-v)); }
            __syncthreads();
            const int jq = tid & 15, kg = tid >> 4;
            float acc[9][4];
#pragma unroll
            for (int r = 0; r < 9; ++r) { acc[r][0] = 0.f; acc[r][1] = 0.f; acc[r][2] = 0.f; acc[r][3] = 0.f; }
            const float* w = wada + (size_t)l * 1024 * 6144 + j0 + jq * 4;
            for (int k = kg; k < 1024; k += 32) { const f32x4 wv = *(const f32x4*)(w + (size_t)k * 6144);
#pragma unroll
                for (int r = 0; r < 9; ++r) { const float sr = s[r * 1024 + k]; acc[r][0] += sr * wv.x; acc[r][1] += sr * wv.y; acc[r][2] += sr * wv.z; acc[r][3] += sr * wv.w; } }
#pragma unroll
            for (int r = 0; r < 9; ++r)
#pragma unroll
                for (int i = 0; i < 4; ++i) red[(kg * 9 + r) * 64 + jq * 4 + i] = acc[r][i];
            __syncthreads();
            for (int o = tid; o < 576; o += NTHR) { const int r = o >> 6, j = o & 63; float sum = 0.f;
                for (int g2 = 0; g2 < 32; ++g2) sum += red[(g2 * 9 + r) * 64 + j];
                mod[(l * 9 + r) * 6144 + j0 + j] = sum + bada[l * 6144 + j0 + j]; }
            __syncthreads();
        }
    }
    {
        LAS float* scr = (LAS float*)(lds + wave * 16384);
        const int gw = blockIdx.x * NWAVES + wave, NGW = G * NWAVES;
        const float* w_in = a.in[6]; const float* w_out = a.in[12]; const float* w_gate = a.in[19]; const float* w_up = a.in[20]; const float* w_down = a.in[21];
        bf16* WIN = (bf16*)(a.ws + WS_WIN); bf16* WOUT = (bf16*)(a.ws + WS_WOUT); bf16* WGU = (bf16*)(a.ws + WS_WGU); bf16* WD = (bf16*)(a.ws + WS_WD);
        constexpr int I_IN = 2 * 16 * 104, I_OUT = 2 * 16 * 32, I_GU = 2 * 2 * 32 * 256, I_D = 2 * 32 * 256, NITEMS = I_IN + I_OUT + I_GU + I_D;
        for (int it = gw; it < NITEMS; it += NGW) {
            int r = it;
            if (r < I_IN) { const int l = r / 1664, q = r % 1664, k0 = 64 * (q / 104), n0 = 32 * (q % 104);
                const float sc = (n0 >= OFF_K && n0 < OFF_V) ? 0.125f : 1.0f;
                transpose_tile(w_in + ((size_t)l * 1024 + k0) * INC + n0, INC, WIN + ((size_t)l * INC + n0) * 1024 + k0, 1024, sc, scr, lane); continue; }
            r -= I_IN;
            if (r < I_OUT) { const int l = r / 512, q = r % 512, k0 = 64 * (q / 32), n0 = 32 * (q % 32);
                transpose_tile(w_out + ((size_t)l * 1024 + k0) * 1024 + n0, 1024, WOUT + ((size_t)l * 1024 + n0) * 1024 + k0, 1024, 1.0f, scr, lane); continue; }
            r -= I_OUT;
            if (r < I_GU) { const int isup = r >= (I_GU / 2) ? 1 : 0; r -= isup * (I_GU / 2);
                const int le = r / 256, q = r % 256, k0 = 64 * (q / 16), n0 = 32 * (q % 16);
                const float* src = (isup ? w_up : w_gate) + ((size_t)le * 1024 + k0) * 512 + n0;
                const int drow = (n0 >> 7) * 256 + (n0 & 127) + isup * 128;
                transpose_tile(src, 512, WGU + ((size_t)le * 1024 + drow) * 1024 + k0, 1024, 1.0f, scr, lane); continue; }
            r -= I_GU;
            { const int le = r / 256, q = r % 256, k0 = 64 * (q / 32), n0 = 32 * (q % 32);
                transpose_tile(w_down + ((size_t)le * 512 + k0) * 1024 + n0, 1024, WD + ((size_t)le * 1024 + n0) * 512 + k0, 512, 1.0f, scr, lane); }
        }
    }
    { bf16* SW = (bf16*)(a.ws + WS_SGUW); const float* sw = a.in[10];
      for (int i = blockIdx.x * NTHR + tid; i < 2 * 4 * 128 * 128; i += G * NTHR) SW[i] = (bf16)f2bf(sw[i]); }
    if (blockIdx.x == 0 && tid < 32) { const int dir = tid & 1, lh = tid >> 1; ((float*)(a.ws + WS_LG))[tid] = log_sigmoid_f(a.in[8 + dir][lh]); }
    {
        bf16* WR = (bf16*)(a.ws + WS_WR);
        for (int i = blockIdx.x * NTHR + tid; i < 2 * 64 * 1024; i += G * NTHR) { const int l = i >> 16, j = (i >> 10) & 63, k = i & 1023;
            float v = 0.f;
            if (j < 4) v = a.in[15][((size_t)l * 1024 + k) * 4 + j]; else if (j < 36) v = a.in[17][(((size_t)l * 4 + ((j - 4) >> 3)) * 1024 + k) * 8 + ((j - 4) & 7)];
            const unsigned hi = f2bf(v); const float r = v - __builtin_bit_cast(float, hi << 16);
            WR[((size_t)(l * 2) * 64 + j) * 1024 + k] = (bf16)hi; WR[((size_t)(l * 2 + 1) * 64 + j) * 1024 + k] = (bf16)f2bf(r); }
    }
    __syncthreads();
}

__device__ __forceinline__ void phase_p1(const Args& a, int lane, int wave) {
    const int gw = blockIdx.x * NWAVES + wave, NGW = gridDim.x * NWAVES;
    const float* mod = (const float*)(a.ws + WS_MOD); bf16* Hb = (bf16*)(a.ws + WS_HB);
    for (int row = gw; row < NROWS; row += NGW) {
        const float* src = row < NLAT ? a.in[0] + (size_t)row * 1024 : a.in[2] + (size_t)(row - NLAT) * 1024;
        const float* m0 = mod + (row < NLAT ? (row >> 12) : 8) * 6144;
#pragma unroll
        for (int j = 0; j < 4; ++j) { const int idx = (lane + 64 * j) * 4;
            const f32x4 v = *(const f32x4*)(src + idx), sh = *(const f32x4*)(m0 + idx), sc = *(const f32x4*)(m0 + 1024 + idx);
            const f32x4 o = v * (sc + 1.0f) + sh; v2u w; w.x = pk2(o.x, o.y); w.y = pk2(o.z, o.w);
            *(v2u*)(Hb + (size_t)row * 1024 + idx) = w; }
    }
}

__device__ __forceinline__ int chunk_row0(int b, int c) { return c < 2 ? NLAT + b * 256 + c * 128 : b * 4096 + (c - 2) * 128; }
__device__ __forceinline__ size_t st_off(int b, int c, int h, int dir) { return ((((size_t)b * NCH + c) * 8 + h) * 2 + dir) * 4096; }

__device__ __forceinline__ void phase_b(const Args& a, int l, LAS unsigned char* lds, int tid) {
    const bf16* P = (const bf16*)(a.ws + WS_P); float* ST = (float*)(a.ws + WS_ST);
    LAS float* Ks = (LAS float*)lds; LAS float* Vs = (LAS float*)(lds + 32768); LAS float* pf = (LAS float*)(lds + 65536); LAS float* pb = pf + 128;
    for (int u = blockIdx.x; u < 8 * NCH * 8; u += gridDim.x) {
        const int b = u / (NCH * 8), c = (u % (NCH * 8)) / 8, h = u % 8; const int row0 = chunk_row0(b, c);
        __syncthreads();
        if (tid < 128) { const float lgf = log_sigmoid_f(a.in[8][l * 8 + h]), lgb = log_sigmoid_f(a.in[9][l * 8 + h]);
            pf[tid] = expf(lgf * (float)(127 - tid)); pb[tid] = expf(lgb * (float)tid); }
        { const int j = tid >> 2, part = tid & 3; const bf16* kp = P + (size_t)(row0 + j) * INC + OFF_K + h * 64 + part * 16; const bf16* vp = kp + (OFF_V - OFF_K);
#pragma unroll
          for (int q = 0; q < 2; ++q) { const v4u kw = *(const v4u*)(kp + 8 * q), vw = *(const v4u*)(vp + 8 * q);
              LAS float* kd = Ks + j * 64 + part * 16 + 8 * q; LAS float* vd = Vs + j * 64 + part * 16 + 8 * q;
              kd[0] = bflo(kw.x); kd[1] = bfhi(kw.x); kd[2] = bflo(kw.y); kd[3] = bfhi(kw.y); kd[4] = bflo(kw.z); kd[5] = bfhi(kw.z); kd[6] = bflo(kw.w); kd[7] = bfhi(kw.w);
              vd[0] = bflo(vw.x); vd[1] = bfhi(vw.x); vd[2] = bflo(vw.y); vd[3] = bfhi(vw.y); vd[4] = bflo(vw.z); vd[5] = bfhi(vw.z); vd[6] = bflo(vw.w); vd[7] = bfhi(vw.w); } }
        __syncthreads();
        const int d = tid >> 3, e0 = (tid & 7) * 8;
        float af[8], ab[8];
#pragma unroll
        for (int i = 0; i < 8; ++i) { af[i] = 0.f; ab[i] = 0.f; }
        for (int j = 0; j < 128; ++j) { const float kd = Ks[j * 64 + d], kf = kd * pf[j], kb = kd * pb[j];
            const f32x4 v0 = *(const LAS f32x4*)(Vs + j * 64 + e0), v1 = *(const LAS f32x4*)(Vs + j * 64 + e0 + 4);
            af[0] += kf * v0.x; af[1] += kf * v0.y; af[2] += kf * v0.z; af[3] += kf * v0.w; af[4] += kf * v1.x; af[5] += kf * v1.y; af[6] += kf * v1.z; af[7] += kf * v1.w;
            ab[0] += kb * v0.x; ab[1] += kb * v0.y; ab[2] += kb * v0.z; ab[3] += kb * v0.w; ab[4] += kb * v1.x; ab[5] += kb * v1.y; ab[6] += kb * v1.z; ab[7] += kb * v1.w; }
        float* o0 = ST + st_off(b, c, h, 0) + d * 64 + e0; float* o1 = ST + st_off(b, c, h, 1) + d * 64 + e0;
        *(f32x4*)o0 = (f32x4){af[0], af[1], af[2], af[3]}; *(f32x4*)(o0 + 4) = (f32x4){af[4], af[5], af[6], af[7]};
        *(f32x4*)o1 = (f32x4){ab[0], ab[1], ab[2], ab[3]}; *(f32x4*)(o1 + 4) = (f32x4){ab[4], ab[5], ab[6], ab[7]};
    }
    __syncthreads();
}

__device__ __forceinline__ void phase_c(const Args& a, int l, int tid) {
    bf16* ST = (bf16*)(a.ws + WS_ST);
    for (int it = blockIdx.x * NTHR + tid; it < 8 * 8 * 2 * 1024; it += gridDim.x * NTHR) {
        const int q = it & 1023, dir = (it >> 10) & 1, h = (it >> 11) & 7, b = it >> 14;
        const float lg = ((const float*)(a.ws + WS_LG))[(l * 8 + h) * 2 + dir]; const float dec = __expf(128.0f * lg);
        v2u kv[NCH];
#pragma unroll
        for (int s = 0; s < NCH; ++s) { const int c = dir ? (s < 2 ? 1 - s : 35 - s) : s; kv[s] = *(const v2u*)(ST + st_off(b, c, h, dir) + q * 4); }
        f32x4 st = (f32x4){0.f, 0.f, 0.f, 0.f};
#pragma unroll
        for (int s = 0; s < NCH; ++s) { const int c = dir ? (s < 2 ? 1 - s : 35 - s) : s;
            v2u w; w.x = cvtpk(st.x, st.y); w.y = cvtpk(st.z, st.w); *(v2u*)(ST + st_off(b, c, h, dir) + q * 4) = w;
            st = st * dec + (f32x4){bflo(kv[s].x), bfhi(kv[s].x), bflo(kv[s].y), bfhi(kv[s].y)}; }
    }
}
__device__ __forceinline__ void unpack8(const v4u w, float* f) { f[0] = bflo(w.x); f[1] = bfhi(w.x); f[2] = bflo(w.y); f[3] = bfhi(w.y); f[4] = bflo(w.z); f[5] = bfhi(w.z); f[6] = bflo(w.w); f[7] = bfhi(w.w); }
__device__ __forceinline__ v4u pack8(const float* f) { v4u w; w.x = pk2(f[0], f[1]); w.y = pk2(f[2], f[3]); w.z = pk2(f[4], f[5]); w.w = pk2(f[6], f[7]); return w; }

__device__ __forceinline__ void phase_d(const Args& a, int l, LAS unsigned char* lds, int tid, int lane) {
    const bf16* P = (const bf16*)(a.ws + WS_P); const float* ST = (const float*)(a.ws + WS_ST); bf16* Y = (bf16*)(a.ws + WS_YMIX);
    const float* convw = a.in[7] + l * 3 * 256; const float* sguw = a.in[10] + (size_t)l * 4 * 128 * 128; const float* sgub = a.in[11] + l * 4 * 128;
    const int c_lo = l == 1 ? 2 : 0, cpb = NCH - c_lo, nunits = 8 * cpb;
    LAS float* Sf = (LAS float*)lds; LAS float* Sb = (LAS float*)(lds + 16384); LAS float* Ks = (LAS float*)(lds + 32768); LAS float* Vs = (LAS float*)(lds + 65536);
    LAS float* VN = (LAS float*)lds;
    for (int u = blockIdx.x; u < nunits; u += gridDim.x) {
        const int b = u / cpb, c = c_lo + u % cpb; const int row0 = chunk_row0(b, c); const bool isc = c < 2;
#ifndef NO_D1
        for (int idx = tid; idx < 128 * 32; idx += NTHR) {
            const int p = idx >> 5, ch0 = (idx & 31) * 8; const int row = row0 + p;
            int dprev = -1, dnext = 1; bool vprev, vnext;
            if (isc) { const int t = c * 128 + p; vprev = t > 0; vnext = t < 255; }
            else { const int t = (c - 2) * 128 + p;
                if (ch0 < 128) { const int col = t & 63; vprev = col > 0; vnext = col < 63; }
                else { const int rg = t >> 6; vprev = rg > 0; vnext = rg < 63; dprev = -64; dnext = 64; } }
            const bf16* pr = P + (size_t)row * INC;
            float cb[8], zc[8], zp[8], zn[8], t0[8], t1[8];
            unpack8(*(const v4u*)(pr + OFF_CB + ch0), cb);
            unpack8(*(const v4u*)(pr + OFF_CC + ch0), t0); unpack8(*(const v4u*)(pr + OFF_CX + ch0), t1);
#pragma unroll
            for (int i = 0; i < 8; ++i) { zc[i] = t0[i] * t1[i]; zp[i] = 0.f; zn[i] = 0.f; }
            if (vprev) { const bf16* q = pr + (ptrdiff_t)dprev * INC; unpack8(*(const v4u*)(q + OFF_CC + ch0), t0); unpack8(*(const v4u*)(q + OFF_CX + ch0), t1);
#pragma unroll
                for (int i = 0; i < 8; ++i) zp[i] = t0[i] * t1[i]; }
            if (vnext) { const bf16* q = pr + (ptrdiff_t)dnext * INC; unpack8(*(const v4u*)(q + OFF_CC + ch0), t0); unpack8(*(const v4u*)(q + OFF_CX + ch0), t1);
#pragma unroll
                for (int i = 0; i < 8; ++i) zn[i] = t0[i] * t1[i]; }
            float o[8];
#pragma unroll
            for (int i = 0; i < 8; ++i) o[i] = cb[i] * (convw[ch0 + i] * zp[i] + convw[256 + ch0 + i] * zc[i] + convw[512 + ch0 + i] * zn[i]);
            *(v4u*)(Y + (size_t)row * 1024 + ch0) = pack8(o);
        }
#endif
        const int i = tid >> 2, part = tid & 3;
#ifndef NO_D2
#pragma unroll 1
        for (int h = 0; h < 8; ++h) {
            __syncthreads();
            { const bf16* kp = P + (size_t)(row0 + i) * INC + OFF_K + h * 64 + part * 16; const bf16* vp = kp + (OFF_V - OFF_K);
#pragma unroll
              for (int q = 0; q < 2; ++q) { float kf[8], vf[8]; unpack8(*(const v4u*)(kp + 8 * q), kf); unpack8(*(const v4u*)(vp + 8 * q), vf);
                  LAS float* kd = Ks + i * 64 + part * 16 + 8 * q; LAS float* vd = Vs + i * 64 + part * 16 + 8 * q;
#pragma unroll
                  for (int e = 0; e < 8; ++e) { kd[e] = kf[e]; vd[e] = vf[e]; } }
              const float* sf = ST + st_off(b, c, h, 0); const float* sb = ST + st_off(b, c, h, 1);
#pragma unroll
              for (int q = 0; q < 2; ++q) { const int o4 = (tid + NTHR * q) * 4; *(LAS f32x4*)(Sf + o4) = *(const f32x4*)(sf + o4); *(LAS f32x4*)(Sb + o4) = *(const f32x4*)(sb + o4); } }
            float qv[16];
            { const bf16* qp = P + (size_t)(row0 + i) * INC + OFF_Q + h * 64 + part * 16; unpack8(*(const v4u*)qp, qv); unpack8(*(const v4u*)(qp + 8), qv + 8); }
            const float lgf = log_sigmoid_f(a.in[8][l * 8 + h]), lgb = log_sigmoid_f(a.in[9][l * 8 + h]);
            __syncthreads();
            float o[16];
#pragma unroll
            for (int e = 0; e < 16; ++e) o[e] = 0.f;
#pragma unroll 1
            for (int j = 0; j < 128; ++j) {
                const LAS f32x4* kr = (const LAS f32x4*)(Ks + j * 64 + part * 16);
                float s = 0.f;
#pragma unroll
                for (int q = 0; q < 4; ++q) { const f32x4 k4 = kr[q]; s += qv[4 * q] * k4.x + qv[4 * q + 1] * k4.y + qv[4 * q + 2] * k4.z + qv[4 * q + 3] * k4.w; }
                s += __shfl_xor(s, 1); s += __shfl_xor(s, 2);
                const int rel = i - j;
                const float dec = rel > 0 ? expf(lgf * (float)rel) : (rel < 0 ? expf(lgb * (float)(-rel)) : 2.0f);
                s *= dec;
                const LAS f32x4* vr = (const LAS f32x4*)(Vs + j * 64 + part * 16);
#pragma unroll
                for (int q = 0; q < 4; ++q) { const f32x4 v4 = vr[q]; o[4 * q] += s * v4.x; o[4 * q + 1] += s * v4.y; o[4 * q + 2] += s * v4.z; o[4 * q + 3] += s * v4.w; }
            }
            float of[16], ob[16];
#pragma unroll
            for (int e = 0; e < 16; ++e) { of[e] = 0.f; ob[e] = 0.f; }
            __syncthreads();
#pragma unroll
            for (int dd = 0; dd < 16; ++dd) Ks[i * 64 + ((part * 16 + dd + i) & 63)] = qv[dd];
            __syncthreads();
#pragma unroll 2
            for (int d = 0; d < 64; ++d) { const float qd = Ks[i * 64 + ((d + i) & 63)];
                const LAS f32x4* fr = (const LAS f32x4*)(Sf + d * 64 + part * 16); const LAS f32x4* br = (const LAS f32x4*)(Sb + d * 64 + part * 16);
#pragma unroll
                for (int q = 0; q < 4; ++q) { const f32x4 f4 = fr[q], b4 = br[q];
                    of[4 * q] += qd * f4.x; of[4 * q + 1] += qd * f4.y; of[4 * q + 2] += qd * f4.z; of[4 * q + 3] += qd * f4.w;
                    ob[4 * q] += qd * b4.x; ob[4 * q + 1] += qd * b4.y; ob[4 * q + 2] += qd * b4.z; ob[4 * q + 3] += qd * b4.w; } }
            const float df = expf(lgf * (float)(i + 1)), db = expf(lgb * (float)(128 - i));
            float sum = 0.f;
#pragma unroll
            for (int e = 0; e < 16; ++e) { o[e] += df * of[e] + db * ob[e]; sum += o[e]; }
            sum += __shfl_xor(sum, 1); sum += __shfl_xor(sum, 2);
            const float mu = sum * (1.0f / 64.0f); float vs = 0.f;
#pragma unroll
            for (int e = 0; e < 16; ++e) { o[e] -= mu; vs += o[e] * o[e]; }
            vs += __shfl_xor(vs, 1); vs += __shfl_xor(vs, 2);
            const float rs = 1.0f / sqrtf(vs * (1.0f / 64.0f) + LN_EPS);
            float gv[16];
            { const bf16* gp = P + (size_t)(row0 + i) * INC + OFF_G + h * 64 + part * 16; unpack8(*(const v4u*)gp, gv); unpack8(*(const v4u*)(gp + 8), gv + 8); }
#pragma unroll
            for (int e = 0; e < 16; ++e) o[e] = (gv[e] / (1.0f + expf(-gv[e]))) * (o[e] * rs);
            bf16* yp = Y + (size_t)(row0 + i) * 1024 + 256 + h * 64 + part * 16;
            *(v4u*)yp = pack8(o); *(v4u*)(yp + 8) = pack8(o + 8);
        }
#endif
#ifndef NO_D3
        __syncthreads();
        {
            const bf16* vp = P + (size_t)(row0 + i) * INC + OFF_VV + part * 64;
            float sum = 0.f;
#pragma unroll 2
            for (int q = 0; q < 8; ++q) { float t8[8]; unpack8(*(const v4u*)(vp + 8 * q), t8);
#pragma unroll
                for (int e = 0; e < 8; ++e) sum += t8[e]; }
            sum += __shfl_xor(sum, 1); sum += __shfl_xor(sum, 2);
            const float mu = sum * (1.0f / 256.0f); float vs = 0.f;
#pragma unroll 2
            for (int q = 0; q < 8; ++q) { float t8[8]; unpack8(*(const v4u*)(vp + 8 * q), t8);
#pragma unroll
                for (int e = 0; e < 8; ++e) { const float dlt = t8[e] - mu; vs += dlt * dlt; } }
            vs += __shfl_xor(vs, 1); vs += __shfl_xor(vs, 2);
            const float rs = 1.0f / sqrtf(vs * (1.0f / 256.0f) + LN_EPS);
            LAS float* dst = VN + (part * 128 + i) * 64;
#pragma unroll 2
            for (int q = 0; q < 8; ++q) { float t8[8]; unpack8(*(const v4u*)(vp + 8 * q), t8);
                *(LAS f32x4*)(dst + 8 * q) = (f32x4){(t8[0] - mu) * rs, (t8[1] - mu) * rs, (t8[2] - mu) * rs, (t8[3] - mu) * rs};
                *(LAS f32x4*)(dst + 8 * q + 4) = (f32x4){(t8[4] - mu) * rs, (t8[5] - mu) * rs, (t8[6] - mu) * rs, (t8[7] - mu) * rs}; }
        }
        __syncthreads();
        for (int g = 0; g < 4; ++g) {
            float acc[16];
#pragma unroll
            for (int e = 0; e < 16; ++e) acc[e] = 0.f;
            const float* wrow = sguw + ((size_t)g * 128 + i) * 128;
            for (int q = 0; q < 128; q += 4) { const f32x4 w4 = *(const f32x4*)(wrow + q);
#pragma unroll
                for (int qq = 0; qq < 4; ++qq) { const float w = w4[qq]; const LAS f32x4* vr = (const LAS f32x4*)(VN + (g * 128 + q + qq) * 64 + part * 16);
#pragma unroll
                    for (int t = 0; t < 4; ++t) { const f32x4 v4 = vr[t]; acc[4 * t] += w * v4.x; acc[4 * t + 1] += w * v4.y; acc[4 * t + 2] += w * v4.z; acc[4 * t + 3] += w * v4.w; } } }
            const float bias = sgub[g * 128 + i];
            float uv[16];
            { const bf16* up = P + (size_t)(row0 + i) * INC + OFF_U + g * 64 + part * 16; unpack8(*(const v4u*)up, uv); unpack8(*(const v4u*)(up + 8), uv + 8); }
#pragma unroll
            for (int e = 0; e < 16; ++e) acc[e] = uv[e] * (acc[e] + bias);
            bf16* yp = Y + (size_t)(row0 + i) * 1024 + 768 + g * 64 + part * 16;
            *(v4u*)yp = pack8(acc); *(v4u*)(yp + 8) = pack8(acc + 8);
        }
#endif
        __syncthreads();
    }
}

__device__ __forceinline__ void phase_f(const Args& a, int l, LAS unsigned char* lds, int tid, int lane, int wave, bool dry = false) {
    LAS int* lcnt = (LAS int*)lds;
    __syncthreads();
    if (tid < 32) lcnt[tid] = 0;
    __syncthreads();
    const int gw = blockIdx.x * NWAVES + wave, NGW = gridDim.x * NWAVES, nrows = l == 0 ? NROWS : NLAT;
    const float* mod = (const float*)(a.ws + WS_MOD) + l * 9 * 6144;
    const float* lng = a.in[13] + l * 1024; const float* lnb = a.in[14] + l * 1024;
    const float* rgw = a.in[15] + l * 1024 * 4; const float* rgb = a.in[16] + l * 4; const float* rew = a.in[17] + (size_t)l * 4 * 1024 * 8; const float* reb = a.in[18] + l * 32;
    bf16* Hb = (bf16*)(a.ws + (dry ? WS_P + 160 * MiB : WS_HB)); unsigned* tok = (unsigned*)(a.ws + (dry ? WS_P + 240 * MiB : WS_TOK)); float* xctx = (float*)(a.ws + WS_XCTX);
    for (int row = gw; row < nrows; row += NGW) {
        float* xr = row < NLAT ? a.out + (size_t)row * 1024 : xctx + (size_t)(row - NLAT) * 1024;
        float* xw = dry ? (float*)(a.ws + WS_P) + (size_t)row * 1024 : xr;
        const float* m0 = mod + (row < NLAT ? (row >> 12) : 8) * 6144;
        f32x4 v[4]; float s = 0.f;
#pragma unroll
        for (int j = 0; j < 4; ++j) { v[j] = *(const f32x4*)(xr + (lane + 64 * j) * 4); s += (v[j].x + v[j].y) + (v[j].z + v[j].w); }
        const float mean = wave_sum(s) * (1.0f / 1024.0f); float s2 = 0.f;
#pragma unroll
        for (int j = 0; j < 4; ++j) { v[j] = v[j] - mean; s2 += (v[j].x * v[j].x + v[j].y * v[j].y) + (v[j].z * v[j].z + v[j].w * v[j].w); }
        const float rstd = 1.0f / sqrtf(wave_sum(s2) * (1.0f / 1024.0f) + LN_EPS);
        float lg[4] = {0.f, 0.f, 0.f, 0.f};
#pragma unroll
        for (int j = 0; j < 4; ++j) { const int idx = (lane + 64 * j) * 4;
            const f32x4 x1 = v[j] * rstd * *(const f32x4*)(lng + idx) + *(const f32x4*)(lnb + idx);
            *(f32x4*)(xw + idx) = x1;
            const f32x4 hm = x1 * (*(const f32x4*)(m0 + 4096 + idx) + 1.0f) + *(const f32x4*)(m0 + 3072 + idx);
            v[j] = hm;
            v2u w; w.x = pk2(hm.x, hm.y); w.y = pk2(hm.z, hm.w); *(v2u*)(Hb + (size_t)row * 1024 + idx) = w;
#pragma unroll
            for (int t = 0; t < 4; ++t) { const f32x4 w4 = *(const f32x4*)(rgw + (idx + t) * 4); const float hv = hm[t];
                lg[0] += hv * w4.x; lg[1] += hv * w4.y; lg[2] += hv * w4.z; lg[3] += hv * w4.w; } }
#pragma unroll
        for (int g = 0; g < 4; ++g) lg[g] = wave_sum(lg[g]) + rgb[g];
        int gi = 0; float gm = lg[0];
#pragma unroll
        for (int g = 1; g < 4; ++g) if (lg[g] > gm) { gm = lg[g]; gi = g; }
        float gden = 0.f;
#pragma unroll
        for (int g = 0; g < 4; ++g) gden += expf(lg[g] - gm);
        const float gprob = 1.0f / gden;
        float le[8] = {0.f, 0.f, 0.f, 0.f, 0.f, 0.f, 0.f, 0.f};
        const float* rw = rew + (size_t)gi * 1024 * 8;
#pragma unroll
        for (int j = 0; j < 4; ++j) { const int idx = (lane + 64 * j) * 4;
#pragma unroll
            for (int t = 0; t < 4; ++t) { const f32x4 w0 = *(const f32x4*)(rw + (idx + t) * 8), w1 = *(const f32x4*)(rw + (idx + t) * 8 + 4); const float hv = v[j][t];
                le[0] += hv * w0.x; le[1] += hv * w0.y; le[2] += hv * w0.z; le[3] += hv * w0.w; le[4] += hv * w1.x; le[5] += hv * w1.y; le[6] += hv * w1.z; le[7] += hv * w1.w; } }
#pragma unroll
        for (int e = 0; e < 8; ++e) le[e] = wave_sum(le[e]) + reb[gi * 8 + e];
        int i1 = 0; float m1 = le[0];
#pragma unroll
        for (int e = 1; e < 8; ++e) if (le[e] > m1) { m1 = le[e]; i1 = e; }
        int i2 = -1; float m2 = -3.0e38f;
#pragma unroll
        for (int e = 0; e < 8; ++e) if (e != i1 && le[e] > m2) { m2 = le[e]; i2 = e; }
        const float p2 = expf(m2 - m1), inv = 1.0f / (1.0f + p2);
        const float gate0 = gprob * inv, gate1 = gprob * p2 * inv;
        if (lane == 0) { const int e0 = gi * 8 + i1, e1 = gi * 8 + i2;
            const int p0 = __hip_atomic_fetch_add(lcnt + e0, 1, __ATOMIC_RELAXED, __HIP_MEMORY_SCOPE_WORKGROUP);
            const int p1 = __hip_atomic_fetch_add(lcnt + e1, 1, __ATOMIC_RELAXED, __HIP_MEMORY_SCOPE_WORKGROUP);
            unsigned* t = tok + (size_t)row * 8; t[0] = (unsigned)e0 | ((unsigned)e1 << 8); t[1] = (unsigned)p0; t[2] = (unsigned)p1;
            t[4] = __builtin_bit_cast(unsigned, gate0); t[5] = __builtin_bit_cast(unsigned, gate1); }
    }
    __syncthreads();
    if (tid < 32 && !dry) ((unsigned*)(a.ws + WS_CTL))[CW_WGCNT + (l * 256 + blockIdx.x) * 32 + tid] = (unsigned)lcnt[tid];
    __syncthreads();
}

__device__ __forceinline__ void phase_g(const Args& a, int l, LAS unsigned char* lds, int tid, int lane, int wave) {
    LAS int* cn = (LAS int*)lds; LAS int* base = (LAS int*)(lds + 32768); LAS int* pst = base + 32; LAS int* totl = base + 80;
    unsigned* ctl = (unsigned*)(a.ws + WS_CTL);
    __syncthreads();
    for (int i = tid; i < 256 * 32; i += NTHR) cn[i] = (int)ctl[CW_WGCNT + l * 256 * 32 + i];
    __syncthreads();
    if (tid < 32) { int tot = 0, bs = 0; for (int w = 0; w < 256; ++w) { const int v = cn[w * 32 + tid]; if (w < (int)blockIdx.x) bs += v; tot += v; } base[tid] = bs; totl[tid] = tot; }
    __syncthreads();
    if (tid == 0) { int run = 0; for (int e = 0; e < 32; ++e) { pst[e] = run; run += ((totl[e] + 255) >> 8) << 8; } pst[32] = run; }
    __syncthreads();
    if (blockIdx.x == 0 && tid < 32) ctl[CW_TOT + l * 64 + tid] = (unsigned)totl[tid];
    const int gw = blockIdx.x * NWAVES + wave, NGW = gridDim.x * NWAVES, nrows = l == 0 ? NROWS : NLAT;
    const bf16* Hb = (const bf16*)(a.ws + WS_HB); bf16* XB = (bf16*)(a.ws + WS_XB); unsigned* tok = (unsigned*)(a.ws + WS_TOK);
    (void)gw; (void)NGW; (void)Hb; (void)XB;
    int* rowof = (int*)(a.ws + WS_ROWOF);
    if (blockIdx.x < 32 && tid < 256) { const int e = blockIdx.x, pad = pst[e + 1] - pst[e] - totl[e]; if (tid < pad) rowof[pst[e] + totl[e] + tid] = 0; }
    for (int T = blockIdx.x; T < (nrows >> 5); T += gridDim.x) {
        const int row = 32 * T + (tid >> 4);
        if ((tid & 15) == 0) { unsigned* t = tok + (size_t)row * 8; const unsigned ee = t[0]; const int e0 = ee & 255, e1 = (ee >> 8) & 255;
            const int s0 = pst[e0] + base[e0] + (int)t[1], s1 = pst[e1] + base[e1] + (int)t[2];
            t[6] = (unsigned)s0; t[7] = (unsigned)s1; rowof[s0] = row; rowof[s1] = row; }
    }
    __syncthreads();
}

__device__ __forceinline__ int build_p2e(const Args& a, int l, LAS unsigned char* lds, int tid) {
    LAS unsigned char* p2e = lds + P2E_OFF; LAS int* np = (LAS int*)(lds + PST_OFF);
    const unsigned* ctl = (const unsigned*)(a.ws + WS_CTL);
    __syncthreads();
    if (tid == 0) { int pm = 0; for (int e = 0; e < 32; ++e) { const int n = ((int)ctl[CW_TOT + l * 64 + e] + 255) >> 8; for (int k = 0; k < n && pm < MAXPANELS; ++k) p2e[pm++] = (unsigned char)e; } np[0] = pm; }
    __syncthreads();
    return np[0];
}

struct JRow { v2u x[4]; v2u y0[4], y1[4]; float g0, g1; };
__device__ __forceinline__ void j_issue(JRow& R, const float* xr, const bf16* Y, const v4u tk, int lane) {
    const unsigned gx = tk.x, gy = tk.y;
    R.g0 = __builtin_bit_cast(float, gx); R.g1 = __builtin_bit_cast(float, gy);
    const bf16* y0 = Y + (size_t)tk.z * 1024; const bf16* y1 = Y + (size_t)tk.w * 1024;
#pragma unroll
    for (int j = 0; j < 4; ++j) { const int idx = (lane + 64 * j) * 4; R.x[j] = *(const v2u*)((const bf16*)xr + 1024 + idx); R.y0[j] = *(const v2u*)(y0 + idx); R.y1[j] = *(const v2u*)(y1 + idx); }
}
__device__ __forceinline__ void j_finish(const JRow& R, float* xw, bf16* hrow, const float* m0, const float* m1, const float* lng, const float* lnb, int lane) {
    f32x4 v[4]; float s = 0.f;
#pragma unroll
    for (int j = 0; j < 4; ++j) { const int idx = (lane + 64 * j) * 4; const v2u w0 = R.y0[j], w1 = R.y1[j];
        const f32x4 ya = (f32x4){bflo(w0.x), bfhi(w0.x), bflo(w0.y), bfhi(w0.y)}, yb = (f32x4){bflo(w1.x), bfhi(w1.x), bflo(w1.y), bfhi(w1.y)};
        const v2u xw = R.x[j]; const f32x4 x1 = (f32x4){bflo(xw.x), bfhi(xw.x), bflo(xw.y), bfhi(xw.y)};
        v[j] = x1 * ALPHA + *(const f32x4*)(m0 + 5120 + idx) * (ya * R.g0 + yb * R.g1);
        s += (v[j].x + v[j].y) + (v[j].z + v[j].w); }
    const float mean = wave_sum(s) * (1.0f / 1024.0f); float s2 = 0.f;
#pragma unroll
    for (int j = 0; j < 4; ++j) { v[j] = v[j] - mean; s2 += (v[j].x * v[j].x + v[j].y * v[j].y) + (v[j].z * v[j].z + v[j].w * v[j].w); }
    const float rstd = 1.0f / sqrtf(wave_sum(s2) * (1.0f / 1024.0f) + LN_EPS);
#pragma unroll
    for (int j = 0; j < 4; ++j) { const int idx = (lane + 64 * j) * 4;
        const f32x4 x2 = v[j] * rstd * *(const f32x4*)(lng + idx) + *(const f32x4*)(lnb + idx);
        if (hrow) { v2u sw; sw.x = cvtpk(x2.x, x2.y); sw.y = cvtpk(x2.z, x2.w); *(v2u*)((bf16*)xw + 1024 + idx) = sw; }
        else *(f32x4*)(xw + idx) = x2;
        if (hrow) { const f32x4 hh = x2 * (*(const f32x4*)(m1 + 1024 + idx) + 1.0f) + *(const f32x4*)(m1 + idx);
            v2u w; w.x = cvtpk(hh.x, hh.y); w.y = cvtpk(hh.z, hh.w); *(v2u*)(hrow + idx) = w; } }
}
__device__ __forceinline__ void phase_j(const Args& a, int l, int lane, int wave, bool dry = false) {
    const int gw = blockIdx.x * NWAVES + wave, NGW = gridDim.x * NWAVES, nrows = l == 0 ? NROWS : NLAT;
    const float* mod = (const float*)(a.ws + WS_MOD) + l * 9 * 6144; const float* modn = (const float*)(a.ws + WS_MOD) + 9 * 6144;
    const float* lng = a.in[22] + l * 1024; const float* lnb = a.in[23] + l * 1024;
    bf16* Hb = (bf16*)(a.ws + WS_HB); const bf16* Y = (const bf16*)(a.ws + WS_Y); const unsigned* tok = (const unsigned*)(a.ws + WS_TOK); float* xctx = (float*)(a.ws + WS_XCTX);
    for (int rowA = gw; rowA < nrows; rowA += 2 * NGW) {
        const int rowB = rowA + NGW; const bool hasB = rowB < nrows;
        const v4u tA = *(const v4u*)(tok + (size_t)rowA * 8 + 4); const v4u tB = hasB ? *(const v4u*)(tok + (size_t)rowB * 8 + 4) : tA;
        float* xrA = rowA < NLAT ? a.out + (size_t)rowA * 1024 : xctx + (size_t)(rowA - NLAT) * 1024;
        const int rB = hasB ? rowB : rowA;
        float* xrB = rB < NLAT ? a.out + (size_t)rB * 1024 : xctx + (size_t)(rB - NLAT) * 1024;
        JRow RA, RB;
        j_issue(RA, xrA, Y, tA, lane); j_issue(RB, xrB, Y, tB, lane);
        const int mA = rowA < NLAT ? (rowA >> 12) : 8, mB = rB < NLAT ? (rB >> 12) : 8;
        j_finish(RA, dry ? (float*)(a.ws + WS_HH) + (size_t)rowA * 1024 : xrA, (l == 0 && !dry) ? Hb + (size_t)rowA * 1024 : nullptr, mod + mA * 6144, modn + mA * 6144, lng, lnb, lane);
        if (hasB) j_finish(RB, dry ? (float*)(a.ws + WS_HH) + (size_t)rowB * 1024 : xrB, (l == 0 && !dry) ? Hb + (size_t)rowB * 1024 : nullptr, mod + mB * 6144, modn + mB * 6144, lng, lnb, lane);
    }
}
typedef short bf16x8 __attribute__((ext_vector_type(8)));
typedef short s16x4 __attribute__((ext_vector_type(4)));
typedef short v4i16_t __attribute__((ext_vector_type(4)));
typedef float f32x16 __attribute__((ext_vector_type(16)));
#define MFMA32(a, b, c) __builtin_amdgcn_mfma_f32_32x32x16_bf16((a), (b), (c), 0, 0, 0)
__device__ __forceinline__ int crow(int reg, int hf) { return (reg & 3) + 8 * (reg >> 2) + 4 * hf; }
__device__ __forceinline__ int tro(int r, int b) { return r * 128 + (b ^ (((r >> 1) & 1) << 6)); }
__device__ __forceinline__ int rro(int r, int c16) { return r * 128 + ((c16 ^ ((r >> 1) & 7)) << 4); }
__device__ __forceinline__ s16x4 tr4(const LAS unsigned char* p) { return __builtin_bit_cast(s16x4, __builtin_amdgcn_ds_read_tr16_b64_v4i16((LAS v4i16_t*)p)); }
__device__ __forceinline__ bf16x8 tr_frag(const LAS unsigned char* img, int rlo, int rhi, int colbyte) {
    const s16x4 lo = tr4(img + tro(rlo, colbyte)), hi = tr4(img + tro(rhi, colbyte));
    return (bf16x8){lo[0], lo[1], lo[2], lo[3], hi[0], hi[1], hi[2], hi[3]};
}

#ifndef ST_TRANSPOSED
#define ST_TRANSPOSED 1
#endif
__device__ __forceinline__ void phase_b_mfma(const Args& a, int l, LAS unsigned char* lds, int tid, int lane, int wave) {
    const bf16* P = (const bf16*)(a.ws + WS_P); bf16* ST = (bf16*)(a.ws + WS_ST);
    const int r32 = lane & 31, hf = lane >> 5, q4 = (lane & 15) >> 2, p4 = lane & 3, blk = (lane >> 4) & 1;
    v4u kw[4], vw[4];
#define B_LOAD(uu) do { const int b_ = (uu) / (NCH * 4), c_ = ((uu) % (NCH * 4)) >> 2, h0_ = ((uu) & 3) * 2; const int r0_ = chunk_row0(b_, c_); \
        _Pragma("unroll") for (int k = 0; k < 4; ++k) { const int ci = tid + NTHR * k, hh = ci >> 10, row = (ci & 1023) >> 3, c16 = ci & 7; \
            const bf16* src = P + (size_t)(r0_ + row) * INC + (h0_ + hh) * 64 + c16 * 8; kw[k] = *(const v4u*)(src + OFF_K); vw[k] = *(const v4u*)(src + OFF_V); } } while (0)
    if ((int)blockIdx.x < 8 * NCH * 4) B_LOAD((int)blockIdx.x);
    for (int u = blockIdx.x; u < 8 * NCH * 4; u += gridDim.x) {
        const int b = u / (NCH * 4), c = (u % (NCH * 4)) >> 2, h0 = (u & 3) * 2;
        __syncthreads();
#pragma unroll
        for (int k = 0; k < 4; ++k) {
            const int ci = tid + NTHR * k, hh = ci >> 10, row = (ci & 1023) >> 3, c16 = ci & 7, h = h0 + hh;
            LAS unsigned char* base = lds + hh * 49152;
            *(LAS v4u*)(base + tro(row, c16 * 16)) = kw[k];
            const float* lgt = (const float*)(a.ws + WS_LG) + (l * 8 + h) * 2; const float lgf = lgt[0], lgb = lgt[1];
            const float wf = __expf(lgf * (float)(127 - row)), wb = __expf(lgb * (float)row);
            float v[8]; unpack8(vw[k], v);
            v4u of, ob;
            of.x = cvtpk(v[0] * wf, v[1] * wf); of.y = cvtpk(v[2] * wf, v[3] * wf); of.z = cvtpk(v[4] * wf, v[5] * wf); of.w = cvtpk(v[6] * wf, v[7] * wf);
            ob.x = cvtpk(v[0] * wb, v[1] * wb); ob.y = cvtpk(v[2] * wb, v[3] * wb); ob.z = cvtpk(v[4] * wb, v[5] * wb); ob.w = cvtpk(v[6] * wb, v[7] * wb);
            *(LAS v4u*)(base + 16384 + tro(row, c16 * 16)) = of;
            *(LAS v4u*)(base + 32768 + tro(row, c16 * 16)) = ob;
        }
        __syncthreads();
        if (u + (int)gridDim.x < 8 * NCH * 4) B_LOAD(u + (int)gridDim.x);
        const int hh = wave >> 2, dir = (wave >> 1) & 1, et = wave & 1;
        const LAS unsigned char* kimg = lds + hh * 49152; const LAS unsigned char* vimg = kimg + 16384 + dir * 16384;
        f32x16 acc[2];
#pragma unroll
        for (int i = 0; i < 16; ++i) { acc[0][i] = 0.f; acc[1][i] = 0.f; }
#pragma unroll
        for (int ks = 0; ks < 8; ++ks) {
            const int rlo = 16 * ks + 8 * hf + q4;
            const bf16x8 Bv = tr_frag(vimg, rlo, rlo + 4, (et * 32 + 16 * blk + 4 * p4) * 2);
#pragma unroll
            for (int dt = 0; dt < 2; ++dt) { const bf16x8 Ak = tr_frag(kimg, rlo, rlo + 4, (dt * 32 + 16 * blk + 4 * p4) * 2); acc[dt] = MFMA32(Ak, Bv, acc[dt]); }
        }
        bf16* dst = ST + st_off(b, c, h0 + hh, dir) + (size_t)(et * 32 + r32) * 64;
#pragma unroll
        for (int dt = 0; dt < 2; ++dt)
#pragma unroll
            for (int g4 = 0; g4 < 4; ++g4) { v2u w; w.x = cvtpk(acc[dt][4 * g4], acc[dt][4 * g4 + 1]); w.y = cvtpk(acc[dt][4 * g4 + 2], acc[dt][4 * g4 + 3]);
                *(v2u*)(dst + dt * 32 + 8 * g4 + 4 * hf) = w; }
    }
#undef B_LOAD
    __syncthreads();
}
__device__ __forceinline__ bf16x8 scale_frag(const bf16x8 q, float sc) {
    const v4u w = __builtin_bit_cast(v4u, q); v4u o;
    o.x = cvtpk(bflo(w.x) * sc, bfhi(w.x) * sc); o.y = cvtpk(bflo(w.y) * sc, bfhi(w.y) * sc); o.z = cvtpk(bflo(w.z) * sc, bfhi(w.z) * sc); o.w = cvtpk(bflo(w.w) * sc, bfhi(w.w) * sc);
    return __builtin_bit_cast(bf16x8, o);
}
__device__ __forceinline__ bf16x8 f32x8_to_frag(const f32x4 a0, const f32x4 a1) {
    v4u o; o.x = cvtpk(a0.x, a0.y); o.y = cvtpk(a0.z, a0.w); o.z = cvtpk(a1.x, a1.y); o.w = cvtpk(a1.z, a1.w); return __builtin_bit_cast(bf16x8, o);
}
struct ConvIn { v4u cb, c0, x0, cp, xp, cn, xn; };
__device__ __forceinline__ void conv_load(ConvIn& I, const bf16* P, int row0, int c, bool isc, int idx) {
    const int p = idx >> 5, ch0 = (idx & 31) * 8; const int row = row0 + p;
    int dprev = -1, dnext = 1; bool vprev, vnext;
    if (isc) { const int t = c * 128 + p; vprev = t > 0; vnext = t < 255; }
    else { const int t = (c - 2) * 128 + p;
        if (ch0 < 128) { const int col = t & 63; vprev = col > 0; vnext = col < 63; }
        else { const int rg = t >> 6; vprev = rg > 0; vnext = rg < 63; dprev = -64; dnext = 64; } }
    const bf16* pr = P + (size_t)row * INC; const v4u z = (v4u){0u, 0u, 0u, 0u};
    I.cb = *(const v4u*)(pr + OFF_CB + ch0); I.c0 = *(const v4u*)(pr + OFF_CC + ch0); I.x0 = *(const v4u*)(pr + OFF_CX + ch0);
    I.cp = z; I.xp = z; I.cn = z; I.xn = z;
    if (vprev) { const bf16* q = pr + (ptrdiff_t)dprev * INC; I.cp = *(const v4u*)(q + OFF_CC + ch0); I.xp = *(const v4u*)(q + OFF_CX + ch0); }
    if (vnext) { const bf16* q = pr + (ptrdiff_t)dnext * INC; I.cn = *(const v4u*)(q + OFF_CC + ch0); I.xn = *(const v4u*)(q + OFF_CX + ch0); }
}
__device__ __forceinline__ void conv_store(const ConvIn& I, bf16* Y, const float* convw, int row0, int idx) {
    const int p = idx >> 5, ch0 = (idx & 31) * 8;
    float cb[8], a0[8], a1[8], o[8], zc, zp, zn;
    unpack8(I.cb, cb);
    unpack8(I.c0, a0); unpack8(I.x0, a1);
#pragma unroll
    for (int i = 0; i < 8; ++i) o[i] = convw[256 + ch0 + i] * (a0[i] * a1[i]);
    unpack8(I.cp, a0); unpack8(I.xp, a1);
#pragma unroll
    for (int i = 0; i < 8; ++i) o[i] += convw[ch0 + i] * (a0[i] * a1[i]);
    unpack8(I.cn, a0); unpack8(I.xn, a1);
#pragma unroll
    for (int i = 0; i < 8; ++i) o[i] = cb[i] * (o[i] + convw[512 + ch0 + i] * (a0[i] * a1[i]));
    (void)zc; (void)zp; (void)zn;
    *(v4u*)(Y + (size_t)(row0 + p) * 1024 + ch0) = pack8(o);
}
__device__ __forceinline__ void phase_d_mfma(const Args& a, int l, LAS unsigned char* lds, int tid, int lane, int wave) {
    const bf16* P = (const bf16*)(a.ws + WS_P); const bf16* ST = (const bf16*)(a.ws + WS_ST); bf16* Y = (bf16*)(a.ws + WS_YMIX);
    const float* convw = a.in[7] + l * 3 * 256; const float* sguw = a.in[10] + (size_t)l * 4 * 128 * 128; const float* sgub = a.in[11] + l * 4 * 128;
    const int c_lo = l == 1 ? 2 : 0, cpb = NCH - c_lo, nunits = 8 * cpb;
#define LANEC int ln_ = lane; asm volatile("" : "+v"(ln_)); const int r32 = ln_ & 31, hf = ln_ >> 5, q4 = (ln_ & 15) >> 2, p4 = ln_ & 3, blk = (ln_ >> 4) & 1; (void)q4; (void)p4; (void)blk
    unsigned* dq = (unsigned*)(a.ws + WS_CTL) + CW_DQ + l * 64; LAS int* dqw = (LAS int*)(lds + DQ_OFF);
    const int npass = 2 * nunits, total = 4 * nunits;
    __syncthreads();
    if (tid == 0) dqw[0] = (int)__hip_atomic_fetch_add(dq, 1u, __ATOMIC_RELAXED, __HIP_MEMORY_SCOPE_AGENT);
    __syncthreads();
    int item = __builtin_amdgcn_readfirstlane(dqw[0]);
    while (item < total) {
        int nxt = 0;
        if (tid == 0) nxt = (int)__hip_atomic_fetch_add(dq, 1u, __ATOMIC_RELAXED, __HIP_MEMORY_SCOPE_AGENT);
        const int type = item < npass ? 0 : (item < npass + nunits ? 1 : 2);
        const int u = type == 0 ? (item >> 1) : (type == 1 ? item - npass : item - npass - nunits), pass = item & 1;
        const int b = u / cpb, c = c_lo + u % cpb; const int row0 = chunk_row0(b, c); const bool isc = c < 2;
        if (type == 2) {
#pragma unroll 1
            for (int idx = tid; idx < 128 * 32; idx += 2 * NTHR) {
                ConvIn I0, I1;
                conv_load(I0, P, row0, c, isc, idx); conv_load(I1, P, row0, c, isc, idx + NTHR);
                conv_store(I0, Y, convw, row0, idx); conv_store(I1, Y, convw, row0, idx + NTHR);
            }
        }
#ifndef NO_D2
        if (type == 0) {
            LANEC;
            const int hd = wave >> 1, ih = wave & 1, h = pass * 4 + hd;
            const LAS unsigned char* kimg = lds + hd * 32768; const LAS unsigned char* vimg = kimg + 16384;
            const float* lgt = (const float*)(a.ws + WS_LG) + (l * 8 + h) * 2; const float lg2f = lgt[0] * 1.44269504088896f, lg2b = lgt[1] * 1.44269504088896f;
            bf16x8 qf[2][4];
#pragma unroll
            for (int t = 0; t < 2; ++t)
#pragma unroll
                for (int s = 0; s < 4; ++s) qf[t][s] = *(const bf16x8*)(P + (size_t)(row0 + (2 * ih + t) * 32 + r32) * INC + OFF_Q + h * 64 + 16 * s + 8 * hf);
#define D_SFR(dst, dir) do { const bf16* sp_ = ST + st_off(b, c, h, dir) + r32 * 64 + 8 * hf; _Pragma("unroll") for (int s = 0; s < 4; ++s) _Pragma("unroll") for (int et = 0; et < 2; ++et) dst[s][et] = *(const bf16x8*)(sp_ + et * 2048 + 16 * s); } while (0)
#define D_STG_LD(k0) do { _Pragma("unroll") for (int k = 0; k < 4; ++k) { int to_ = tid; asm volatile("" : "+v"(to_)); const int ci = to_ + NTHR * ((k0) + k), tile = ci >> 10, hdd = tile >> 1, isv = tile & 1, row = (ci & 1023) >> 3, c16 = ci & 7; \
                stg[k] = *(const v4u*)(P + (size_t)(row0 + row) * INC + (isv ? OFF_V : OFF_K) + (pass * 4 + hdd) * 64 + c16 * 8); } } while (0)
#define D_STG_ST(k0) do { _Pragma("unroll") for (int k = 0; k < 4; ++k) { int to_ = tid; asm volatile("" : "+v"(to_)); const int ci = to_ + NTHR * ((k0) + k), tile = ci >> 10, hdd = tile >> 1, isv = tile & 1, row = (ci & 1023) >> 3, c16 = ci & 7; \
                *(LAS v4u*)(lds + hdd * 32768 + isv * 16384 + (isv ? tro(row, c16 * 16) : rro(row, c16))) = stg[k]; } } while (0)
#define D_CROSS(sf, dir) do { const int i0 = 2 * ih * 32 + r32; \
                const float sc0 = (dir) == 0 ? __builtin_amdgcn_exp2f(lg2f * (float)(i0 + 1)) : __builtin_amdgcn_exp2f(lg2b * (float)(128 - i0)); \
                const float sc1 = (dir) == 0 ? __builtin_amdgcn_exp2f(lg2f * (float)(i0 + 33)) : __builtin_amdgcn_exp2f(lg2b * (float)(96 - i0)); \
                _Pragma("unroll") for (int s = 0; s < 4; ++s) { const bf16x8 qs0 = scale_frag(qf[0][s], sc0), qs1 = scale_frag(qf[1][s], sc1); \
                    _Pragma("unroll") for (int et = 0; et < 2; ++et) { acc[0][et] = MFMA32(sf[s][et], qs0, acc[0][et]); acc[1][et] = MFMA32(sf[s][et], qs1, acc[1][et]); } } } while (0)
            bf16x8 sf0[4][2]; v4u stg[4];
            D_SFR(sf0, 0);
            D_STG_LD(0);
            f32x16 acc[2][2];
#pragma unroll
            for (int t = 0; t < 2; ++t)
#pragma unroll
                for (int et = 0; et < 2; ++et)
#pragma unroll
                    for (int r = 0; r < 16; ++r) acc[t][et][r] = 0.f;
            asm volatile("" ::: "memory");
            D_CROSS(sf0, 0);
            asm volatile("" ::: "memory");
            bf16x8 sf1[4][2];
            D_SFR(sf1, 1);
            D_STG_ST(0);
            asm volatile("" ::: "memory");
            D_STG_LD(4);
            asm volatile("" ::: "memory");
            D_CROSS(sf1, 1);
            asm volatile("" ::: "memory");
            D_STG_ST(4);
            asm volatile("" ::: "memory");
            D_STG_LD(8); D_STG_ST(8);
            asm volatile("" ::: "memory");
            D_STG_LD(12); D_STG_ST(12);
#undef D_SFR
#undef D_STG_LD
#undef D_STG_ST
#undef D_CROSS
            __syncthreads();
#pragma unroll
            for (int t = 0; t < 2; ++t) {
                const int it = 2 * ih + t;
                bf16x8 qq[4];
                if (t == 0) {
#pragma unroll
                    for (int s = 0; s < 4; ++s) qq[s] = qf[0][s];
                } else {
                    asm volatile("" ::: "memory");
#pragma unroll
                    for (int s = 0; s < 4; ++s) qq[s] = *(const bf16x8*)(P + (size_t)(row0 + it * 32 + r32) * INC + OFF_Q + h * 64 + 16 * s + 8 * hf);
                }
#pragma unroll 1
                for (int jt = 0; jt < 4; ++jt) {
                    f32x16 X;
#pragma unroll
                    for (int r = 0; r < 16; ++r) X[r] = 0.f;
#pragma unroll
                    for (int s = 0; s < 4; ++s) { const bf16x8 Kf = *(const LAS bf16x8*)(kimg + rro(jt * 32 + r32, 2 * s + hf)); X = MFMA32(Kf, qq[s], X); }
                    const int rel0 = (it - jt) * 32 + r32 - 4 * hf;
#pragma unroll
                    for (int r = 0; r < 16; ++r) { const int rel = rel0 - ((r & 3) + 8 * (r >> 2));
                        const float x = rel > 0 ? lg2f * (float)rel : lg2b * (float)(-rel);
                        const float dcy = rel == 0 ? 2.0f : __builtin_amdgcn_exp2f(x);
                        X[r] *= dcy; }
#pragma unroll
                    for (int s2 = 0; s2 < 2; ++s2) {
                        v4u pk; pk.x = cvtpk(X[8 * s2], X[8 * s2 + 1]); pk.y = cvtpk(X[8 * s2 + 2], X[8 * s2 + 3]); pk.z = cvtpk(X[8 * s2 + 4], X[8 * s2 + 5]); pk.w = cvtpk(X[8 * s2 + 6], X[8 * s2 + 7]);
                        const bf16x8 Pk = __builtin_bit_cast(bf16x8, pk);
                        const int rlo = jt * 32 + 16 * s2 + 4 * hf + q4;
#pragma unroll
                        for (int et = 0; et < 2; ++et) { const bf16x8 Vt = tr_frag(vimg, rlo, rlo + 8, (et * 32 + 16 * blk + 4 * p4) * 2); acc[t][et] = MFMA32(Vt, Pk, acc[t][et]); }
                    }
                }
                const int row = row0 + (2 * ih + t) * 32 + r32;
                float sum = 0.f;
#pragma unroll
                for (int et = 0; et < 2; ++et)
#pragma unroll
                    for (int r = 0; r < 16; ++r) sum += acc[t][et][r];
                sum += __shfl_xor(sum, 32);
                const float mu = sum * (1.0f / 64.0f); float vs = 0.f;
#pragma unroll
                for (int et = 0; et < 2; ++et)
#pragma unroll
                    for (int r = 0; r < 16; ++r) { const float dlt = acc[t][et][r] - mu; vs += dlt * dlt; }
                vs += __shfl_xor(vs, 32);
                const float rs = 1.0f / sqrtf(vs * (1.0f / 64.0f) + LN_EPS);
#pragma unroll
                for (int et = 0; et < 2; ++et)
#pragma unroll
                    for (int g4 = 0; g4 < 4; ++g4) { const int e0 = et * 32 + 8 * g4 + 4 * hf;
                        const v2u gw = *(const v2u*)(P + (size_t)row * INC + OFF_G + h * 64 + e0);
                        const float g0 = bflo(gw.x), g1 = bfhi(gw.x), g2 = bflo(gw.y), g3 = bfhi(gw.y);
                        const float o0 = (acc[t][et][4 * g4] - mu) * rs, o1 = (acc[t][et][4 * g4 + 1] - mu) * rs, o2 = (acc[t][et][4 * g4 + 2] - mu) * rs, o3 = (acc[t][et][4 * g4 + 3] - mu) * rs;
                        v2u w; w.x = cvtpk(g0 / (1.0f + __expf(-g0)) * o0, g1 / (1.0f + __expf(-g1)) * o1); w.y = cvtpk(g2 / (1.0f + __expf(-g2)) * o2, g3 / (1.0f + __expf(-g3)) * o3);
                        *(v2u*)(Y + (size_t)row * 1024 + 256 + h * 64 + e0) = w; }
            }
        }
#endif
#ifndef NO_D3
        if (type == 1) {
            LANEC;
            const int g = wave >> 1, ph = wave & 1;
            bf16x8 Bw[8][2];
            { const bf16* wp = (const bf16*)(a.ws + WS_SGUW) + ((size_t)(l * 4 + g) * 128 + ph * 64 + r32) * 128 + 8 * hf;
#pragma unroll
              for (int ks = 0; ks < 8; ++ks)
#pragma unroll
                  for (int pt = 0; pt < 2; ++pt) Bw[ks][pt] = *(const bf16x8*)(wp + pt * 32 * 128 + 16 * ks); }
            {
                int tq_ = tid; asm volatile("" : "+v"(tq_));
                const int i = tq_ >> 2, part = tq_ & 3;
                const bf16* vp = P + (size_t)(row0 + i) * INC + OFF_VV + part * 64;
                v4u raw[8];
#pragma unroll
                for (int q = 0; q < 8; ++q) raw[q] = *(const v4u*)(vp + 8 * q);
                float sum = 0.f;
#pragma unroll
                for (int q = 0; q < 8; ++q) { float t8[8]; unpack8(raw[q], t8);
#pragma unroll
                    for (int e2 = 0; e2 < 8; ++e2) sum += t8[e2]; }
                sum += __shfl_xor(sum, 1); sum += __shfl_xor(sum, 2);
                const float mu = sum * (1.0f / 256.0f); float vs = 0.f;
#pragma unroll
                for (int q = 0; q < 8; ++q) { float t8[8]; unpack8(raw[q], t8);
#pragma unroll
                    for (int e2 = 0; e2 < 8; ++e2) { const float dlt = t8[e2] - mu; vs += dlt * dlt; } }
                vs += __shfl_xor(vs, 1); vs += __shfl_xor(vs, 2);
                const float rs = 1.0f / sqrtf(vs * (1.0f / 256.0f) + LN_EPS);
#pragma unroll
                for (int q = 0; q < 8; ++q) { float t8[8]; unpack8(raw[q], t8);
                    v4u w; w.x = cvtpk((t8[0] - mu) * rs, (t8[1] - mu) * rs); w.y = cvtpk((t8[2] - mu) * rs, (t8[3] - mu) * rs); w.z = cvtpk((t8[4] - mu) * rs, (t8[5] - mu) * rs); w.w = cvtpk((t8[6] - mu) * rs, (t8[7] - mu) * rs);
                    *(LAS v4u*)(lds + part * 16384 + tro(i, q * 16)) = w; }
            }
            __syncthreads();
            const LAS unsigned char* vn = lds + g * 16384;
            f32x16 acc[2][2];
#pragma unroll
            for (int ct = 0; ct < 2; ++ct)
#pragma unroll
                for (int pt = 0; pt < 2; ++pt)
#pragma unroll
                    for (int r = 0; r < 16; ++r) acc[ct][pt][r] = 0.f;
#pragma unroll
            for (int ks = 0; ks < 8; ++ks) {
                const int rlo = 16 * ks + 8 * hf + q4;
                bf16x8 A[2];
#pragma unroll
                for (int ct = 0; ct < 2; ++ct) A[ct] = tr_frag(vn, rlo, rlo + 4, (ct * 32 + 16 * blk + 4 * p4) * 2);
#pragma unroll
                for (int ct = 0; ct < 2; ++ct)
#pragma unroll
                    for (int pt = 0; pt < 2; ++pt) acc[ct][pt] = MFMA32(A[ct], Bw[ks][pt], acc[ct][pt]);
            }
#pragma unroll
            for (int pt = 0; pt < 2; ++pt) {
                const int p = ph * 64 + pt * 32 + r32; const int row = row0 + p; const float bias = sgub[g * 128 + p];
#pragma unroll
                for (int ct = 0; ct < 2; ++ct)
#pragma unroll
                    for (int g4 = 0; g4 < 4; ++g4) { const int c0 = ct * 32 + 8 * g4 + 4 * hf;
                        const v2u uw = *(const v2u*)(P + (size_t)row * INC + OFF_U + g * 64 + c0);
                        v2u w; w.x = cvtpk(bflo(uw.x) * (acc[ct][pt][4 * g4] + bias), bfhi(uw.x) * (acc[ct][pt][4 * g4 + 1] + bias));
                        w.y = cvtpk(bflo(uw.y) * (acc[ct][pt][4 * g4 + 2] + bias), bfhi(uw.y) * (acc[ct][pt][4 * g4 + 3] + bias));
                        *(v2u*)(Y + (size_t)row * 1024 + 768 + g * 64 + c0) = w; }
            }
        }
#endif
        __syncthreads();
        if (tid == 0) dqw[0] = nxt;
        __syncthreads();
        item = __builtin_amdgcn_readfirstlane(dqw[0]);
    }
}

__device__ __forceinline__ void phase_f2(const Args& a, int l, LAS unsigned char* lds, int tid, int lane, int wave) {
    LAS int* lcnt = (LAS int*)(lds + LCNT_OFF); LAS float* LG = (LAS float*)(lds + LG_OFF);
    LAS unsigned char* HI = lds; LAS unsigned char* LO = lds + 65536; LAS float* PART = (LAS float*)lds;
    const int r32 = lane & 31, hf = lane >> 5;
    const int nrows = l == 0 ? NROWS : NLAT, ntiles = nrows >> 5;
    const float* mod = (const float*)(a.ws + WS_MOD) + l * 9 * 6144;
    const float* lng = a.in[13] + l * 1024; const float* lnb = a.in[14] + l * 1024;
    const float* rgb = a.in[16] + l * 4; const float* reb = a.in[18] + l * 32;
    bf16* Hb = (bf16*)(a.ws + WS_HB); unsigned* tok = (unsigned*)(a.ws + WS_TOK); float* xctx = (float*)(a.ws + WS_XCTX); const bf16* YO = (const bf16*)(a.ws + WS_YO);
    const bf16* wr = (const bf16*)(a.ws + WS_WR) + (size_t)l * 2 * 64 * 1024;
    bf16x8 Bh[8][2];
#pragma unroll
    for (int ks = 0; ks < 8; ++ks)
#pragma unroll
        for (int ct = 0; ct < 2; ++ct) { const bf16* p = wr + (size_t)(ct * 32 + r32) * 1024 + wave * 128 + 16 * ks + 8 * hf; Bh[ks][ct] = *(const bf16x8*)p; }
    __syncthreads();
    if (tid < 32) lcnt[tid] = 0;
    __syncthreads();
    for (int T = blockIdx.x; T < ntiles; T += gridDim.x) {
#pragma unroll 1
        for (int rh = 0; rh < 2; ++rh) {
        f32x4 vv[2][4];
#pragma unroll
        for (int rq = 0; rq < 2; ++rq) { const int row = 32 * T + 4 * wave + 2 * rh + rq;
            const float* xin = row < NLAT ? a.in[0] + (size_t)row * 1024 : a.in[2] + (size_t)(row - NLAT) * 1024;
            const bf16* xsb = (const bf16*)(row < NLAT ? a.out + (size_t)row * 1024 : xctx + (size_t)(row - NLAT) * 1024) + 1024;
            const float* g1p = mod + (row < NLAT ? (row >> 12) : 8) * 6144 + 2048;
#pragma unroll
            for (int j = 0; j < 4; ++j) { const int idx = (lane + 64 * j) * 4; const v2u yw = *(const v2u*)(YO + (size_t)row * 1024 + idx);
                f32x4 xv; if (l == 0) xv = *(const f32x4*)(xin + idx); else { const v2u xw = *(const v2u*)(xsb + idx); xv = (f32x4){bflo(xw.x), bfhi(xw.x), bflo(xw.y), bfhi(xw.y)}; }
                vv[rq][j] = xv * ALPHA + *(const f32x4*)(g1p + idx) * (f32x4){bflo(yw.x), bfhi(yw.x), bflo(yw.y), bfhi(yw.y)}; } }
#pragma unroll
        for (int rq = 0; rq < 2; ++rq) {
            const int lr = 4 * wave + 2 * rh + rq, row = 32 * T + lr;
            bf16* xsw = (bf16*)(row < NLAT ? a.out + (size_t)row * 1024 : xctx + (size_t)(row - NLAT) * 1024) + 1024;
            const float* m0 = mod + (row < NLAT ? (row >> 12) : 8) * 6144;
            f32x4 v[4]; float s = 0.f;
#pragma unroll
            for (int j = 0; j < 4; ++j) { v[j] = vv[rq][j]; s += (v[j].x + v[j].y) + (v[j].z + v[j].w); }
            const float mean = wave_sum(s) * (1.0f / 1024.0f); float s2 = 0.f;
#pragma unroll
            for (int j = 0; j < 4; ++j) { v[j] = v[j] - mean; s2 += (v[j].x * v[j].x + v[j].y * v[j].y) + (v[j].z * v[j].z + v[j].w * v[j].w); }
            const float rstd = 1.0f / sqrtf(wave_sum(s2) * (1.0f / 1024.0f) + LN_EPS);
#pragma unroll
            for (int j = 0; j < 4; ++j) { const int idx = (lane + 64 * j) * 4;
                const f32x4 x1 = v[j] * rstd * *(const f32x4*)(lng + idx) + *(const f32x4*)(lnb + idx);
                { v2u xw; xw.x = cvtpk(x1.x, x1.y); xw.y = cvtpk(x1.z, x1.w); *(v2u*)(xsw + idx) = xw; }
                const f32x4 hm = x1 * (*(const f32x4*)(m0 + 4096 + idx) + 1.0f) + *(const f32x4*)(m0 + 3072 + idx);
                v2u h; h.x = cvtpk(hm.x, hm.y); h.y = cvtpk(hm.z, hm.w);
                v2u lo; lo.x = cvtpk(hm.x - bflo(h.x), hm.y - bfhi(h.x)); lo.y = cvtpk(hm.z - bflo(h.y), hm.w - bfhi(h.y));
                *(v2u*)(Hb + (size_t)row * 1024 + idx) = h;
                const int off = lr * 2048 + (((((lane + 64 * j) >> 1)) ^ (lr & 15)) << 4) + (lane & 1) * 8;
                *(LAS v2u*)(HI + off) = h; *(LAS v2u*)(LO + off) = lo; }
        }
        }
        __syncthreads();
        f32x16 acc[2];
#pragma unroll
        for (int r = 0; r < 16; ++r) { acc[0][r] = 0.f; acc[1][r] = 0.f; }
#pragma unroll
        for (int ks = 0; ks < 8; ++ks) { const int off = r32 * 2048 + (((wave * 16 + 2 * ks + hf) ^ (r32 & 15)) << 4);
            const bf16x8 Ah = *(const LAS bf16x8*)(HI + off), Al = *(const LAS bf16x8*)(LO + off);
#pragma unroll
            for (int ct = 0; ct < 2; ++ct) { const bf16x8 Bl = *(const bf16x8*)(wr + (size_t)(64 + ct * 32 + r32) * 1024 + wave * 128 + 16 * ks + 8 * hf);
                acc[ct] = MFMA32(Ah, Bh[ks][ct], acc[ct]); acc[ct] = MFMA32(Ah, Bl, acc[ct]); acc[ct] = MFMA32(Al, Bh[ks][ct], acc[ct]); } }
        __syncthreads();
#pragma unroll
        for (int ct = 0; ct < 2; ++ct)
#pragma unroll
            for (int r = 0; r < 16; ++r) PART[(wave * 32 + crow(r, hf)) * 64 + ct * 32 + r32] = acc[ct][r];
        __syncthreads();
        { const int row = tid >> 4, cg = tid & 15;
#pragma unroll
          for (int q = 0; q < 3; ++q) { const int col = cg + 16 * q; if (col < 36) { float sum = 0.f;
#pragma unroll
                  for (int w = 0; w < 8; ++w) sum += PART[(w * 32 + row) * 64 + col];
                  LG[row * 40 + col] = sum; } } }
        __syncthreads();
        if (tid < 32) { const int row = 32 * T + tid; const LAS float* lgp = LG + tid * 40;
            float lg[4];
#pragma unroll
            for (int g = 0; g < 4; ++g) lg[g] = lgp[g] + rgb[g];
            int gi = 0; float gm = lg[0];
#pragma unroll
            for (int g = 1; g < 4; ++g) if (lg[g] > gm) { gm = lg[g]; gi = g; }
            float gden = 0.f;
#pragma unroll
            for (int g = 0; g < 4; ++g) gden += expf(lg[g] - gm);
            const float gprob = 1.0f / gden;
            float le[8];
#pragma unroll
            for (int e = 0; e < 8; ++e) le[e] = lgp[4 + gi * 8 + e] + reb[gi * 8 + e];
            int i1 = 0; float m1 = le[0];
#pragma unroll
            for (int e = 1; e < 8; ++e) if (le[e] > m1) { m1 = le[e]; i1 = e; }
            int i2 = -1; float m2 = -3.0e38f;
#pragma unroll
            for (int e = 0; e < 8; ++e) if (e != i1 && le[e] > m2) { m2 = le[e]; i2 = e; }
            const float p2 = expf(m2 - m1), inv = 1.0f / (1.0f + p2);
            const float gate0 = gprob * inv, gate1 = gprob * p2 * inv;
            const int e0 = gi * 8 + i1, e1 = gi * 8 + i2;
            const int p0 = __hip_atomic_fetch_add(lcnt + e0, 1, __ATOMIC_RELAXED, __HIP_MEMORY_SCOPE_WORKGROUP);
            const int p1 = __hip_atomic_fetch_add(lcnt + e1, 1, __ATOMIC_RELAXED, __HIP_MEMORY_SCOPE_WORKGROUP);
            unsigned* t = tok + (size_t)row * 8; t[0] = (unsigned)e0 | ((unsigned)e1 << 8); t[1] = (unsigned)p0; t[2] = (unsigned)p1;
            t[4] = __builtin_bit_cast(unsigned, gate0); t[5] = __builtin_bit_cast(unsigned, gate1); }
    }
    __syncthreads();
    if (tid < 32) ((unsigned*)(a.ws + WS_CTL))[CW_WGCNT + (l * 256 + blockIdx.x) * 32 + tid] = (unsigned)lcnt[tid];
    __syncthreads();
}
#ifndef MK_PER_PHASE
#define MK_PER_PHASE 0
#endif
constexpr int N_PHASES = 22;

__global__ void __launch_bounds__(NTHR, 2) hybrid_fwd(Args args) {
    extern __shared__ __attribute__((aligned(16))) unsigned char lds_raw[];
    LAS unsigned char* lds = (LAS unsigned char*)lds_raw;
    const int tid0 = threadIdx.x;
    for (int u = tid0; u < (LDS_BYTES - LDSCTL_OFF) / 4; u += NTHR) ((LAS unsigned*)(lds + LDSCTL_OFF))[u] = 0u;
#define TIDS int tid = threadIdx.x; asm volatile("" : "+v"(tid)); const int lane = tid & 63, wave = __builtin_amdgcn_readfirstlane(tid >> 6); (void)lane; (void)wave
    __syncthreads();
    unsigned* ctl = (unsigned*)(args.ws + WS_CTL);
    XcdBarrier bar; bar.bar = ctl + CW_BAR; bar.x = 0; bar.st = nullptr;
    if (!MK_PER_PHASE) bar = xcd_barrier_post(ctl + CW_BAR, (volatile LAS unsigned*)(lds + MISC_OFF + 32));
    const int lo = args.ph_lo, hi = args.ph_hi;
#ifndef PHMASK
#define PHMASK 0xFFFFFFu
#endif
#define PHON(k) (((PHMASK) >> ((k) < 2 ? (k) : 2 + ((k) - 2) % 10)) & 1u)
#define IN(k) (PHON(k) && lo <= (k) && (k) < hi)
#ifndef REPMASK
#define REPMASK 0u
#endif
#define NREP(k) (1 + (int)(((REPMASK) >> ((k) < 2 ? (k) : 2 + ((k) - 2) % 10)) & 1u))
#define SEAM(k) do { if (IN(k) && IN((k) + 1)) xcd_barrier(bar); } while (0)

    if (IN(0)) for (int rep = 0; rep < NREP(0); ++rep) { TIDS; phase_p0(args, lds, tid, lane, wave); }
    SEAM(0);
    if (IN(1)) for (int rep = 0; rep < NREP(1); ++rep) { TIDS; phase_p1(args, lane, wave); }
    SEAM(1);
    for (int l = 0; l < 2; ++l) {
        const int pb = 2 + 10 * l;
        bf16* Hb = (bf16*)(args.ws + WS_HB);
        if (IN(pb + 0)) for (int rep = 0; rep < NREP(2); ++rep) {
            pg8::Gemm g{Hb, (const bf16*)(args.ws + WS_WIN) + (size_t)l * INC * 1024, NROWS, INC, 1024}; pg8::StaticOrder S; S.init(NROWS, INC, (int)gridDim.x, (int)blockIdx.x);
            pg8::EpiBf16<0> E{(bf16*)(args.ws + WS_P), INC, nullptr, 0, 0, 1.0f};
            pg8::gemm_phase<pg8::EpiBf16<0>, pg8::StaticOrder, true, true>(lds, g, S, E);
        }
        SEAM(pb + 0);
        if (IN(pb + 1)) for (int rep = 0; rep < NREP(3); ++rep) { TIDS; phase_b_mfma(args, l, lds, tid, lane, wave); }
        SEAM(pb + 1);
        if (IN(pb + 2)) { TIDS; phase_c(args, l, tid); }
        SEAM(pb + 2);
        if (IN(pb + 3)) for (int rep = 0; rep < NREP(5); ++rep) { TIDS; phase_d_mfma(args, l, lds, tid, lane, wave); }
        SEAM(pb + 3);
        if (IN(pb + 4)) for (int rep = 0; rep < (l == 0 ? NREP(6) : 1); ++rep) {
            const int M = l == 0 ? NROWS : NLAT;
            pg8::Gemm g{(const bf16*)(args.ws + WS_YMIX), (const bf16*)(args.ws + WS_WOUT) + (size_t)l * 1024 * 1024, M, 1024, 1024}; pg8::StaticOrder S; S.init(M, 1024, (int)gridDim.x, (int)blockIdx.x);
            pg8::EpiBf16<0> E{(bf16*)(args.ws + WS_YO), 1024, nullptr, 0, 0, 1.0f};
            pg8::gemm_phase<pg8::EpiBf16<0>, pg8::StaticOrder, true, true>(lds, g, S, E);
        }
        SEAM(pb + 4);
        if (IN(pb + 5)) { TIDS; phase_f2(args, l, lds, tid, lane, wave); }
        SEAM(pb + 5);
        if (IN(pb + 6)) for (int rep = 0; rep < NREP(8); ++rep) { TIDS; phase_g(args, l, lds, tid, lane, wave); }
        SEAM(pb + 6);
        if (IN(pb + 7)) for (int rep = 0; rep < NREP(9); ++rep) {
            int npan; { TIDS; npan = build_p2e(args, l, lds, tid); }
            pg8::Gemm g{Hb, (const bf16*)(args.ws + WS_WGU) + (size_t)l * 32 * 1024 * 1024, npan * 256, 1024, 1024};
            LAS int* arows = (LAS int*)(lds + AROWS_OFF);
            { TIDS; const int* rowof = (const int*)(args.ws + WS_ROWOF);
              for (int i = 0; i < 6; ++i) { const int L = i * (int)gridDim.x + (int)blockIdx.x; if (L < npan * 4 && tid < 256) arows[i * 256 + tid] = rowof[(L >> 2) * 256 + tid]; }
              __syncthreads(); }
            pg8::MoeOrder S{(const LAS unsigned char*)(lds + P2E_OFF), npan * 4, (int)gridDim.x, (int)blockIdx.x, arows};
            pg8::EpiGLU E{(bf16*)(args.ws + WS_HH)};
            pg8::gemm_phase_gather<pg8::EpiGLU, pg8::MoeOrder>(lds, g, S, E);
        }
        SEAM(pb + 7);
        if (IN(pb + 8)) for (int rep = 0; rep < NREP(10); ++rep) {
            int npan; { TIDS; npan = build_p2e(args, l, lds, tid); }
            pg8::Gemm g{(const bf16*)(args.ws + WS_HH), (const bf16*)(args.ws + WS_WD) + (size_t)l * 32 * 1024 * 512, npan * 256, 1024, 512};
            pg8::MoeOrder S{(const LAS unsigned char*)(lds + P2E_OFF), npan * 4, (int)gridDim.x, (int)blockIdx.x, nullptr};
            pg8::EpiY E{(bf16*)(args.ws + WS_Y)};
            pg8::gemm_phase<pg8::EpiY, pg8::MoeOrder, true, true>(lds, g, S, E);
        }
        SEAM(pb + 8);
        if (IN(pb + 9)) { if (NREP(11) > 1) { TIDS; phase_j(args, l, lane, wave, true); } TIDS; phase_j(args, l, lane, wave); }
        SEAM(pb + 9);
    }
#undef IN
#undef SEAM
}

extern "C" void kernel_launch(void* const* d_in, const int* in_sizes, int n_in, void* d_out, int out_size, void* d_ws, size_t ws_size, hipStream_t stream) {
    static int grid = 0;
    if (grid == 0) {
        if (n_in != 24 || in_sizes[0] != NLAT * DM || out_size != NLAT * DM || ws_size < WS_END) { fprintf(stderr, "kernel_launch: unexpected problem (n_in %d, ws %zu < %zu?)\n", n_in, ws_size, (size_t)WS_END); grid = -1; return; }
        int dev = 0, cus = 0, per_cu = 0;
        if (hipGetDevice(&dev) != hipSuccess || hipDeviceGetAttribute(&cus, hipDeviceAttributeMultiprocessorCount, dev) != hipSuccess) { grid = -1; return; }
        if (hipFuncSetAttribute((const void*)hybrid_fwd, hipFuncAttributeMaxDynamicSharedMemorySize, LDS_BYTES) != hipSuccess) { grid = -1; return; }
        if (hipOccupancyMaxActiveBlocksPerMultiprocessor(&per_cu, (const void*)hybrid_fwd, NTHR, LDS_BYTES) != hipSuccess || per_cu < 1) { fprintf(stderr, "kernel_launch: occupancy query says %d\n", per_cu); }
        (void)hipGetLastError();
        grid = cus;
        if (grid != 256) { fprintf(stderr, "kernel_launch: built for 256 CUs, device has %d\n", cus); grid = -1; return; }
    }
    if (grid < 0) return;
    if (hipMemsetAsync((char*)d_ws + WS_CTL, 0, CTL_ZERO_BYTES, stream) != hipSuccess) return;
    Args a{};
    for (int i = 0; i < 24; ++i) a.in[i] = (const float*)d_in[i];
    a.out = (float*)d_out; a.ws = (unsigned char*)d_ws;
#if MK_PER_PHASE
    for (int p = 0; p < N_PHASES; ++p) { a.ph_lo = p; a.ph_hi = p + 1; hipLaunchKernelGGL(hybrid_fwd, dim3(grid), dim3(NTHR), LDS_BYTES, stream, a); }
#else
    a.ph_lo = 0; a.ph_hi = N_PHASES;
    hipLaunchKernelGGL(hybrid_fwd, dim3(grid), dim3(NTHR), LDS_BYTES, stream, a);
#endif
}
```

```cpp
#include <hip/hip_runtime.h>
#include <cstdio>
#include <cstdint>
#include <cstddef>
namespace pg8 {
#define PG8_LAS __attribute__((address_space(3)))
typedef unsigned short bf16_t;
typedef short bf16x8 __attribute__((ext_vector_type(8)));
typedef float f32x4 __attribute__((ext_vector_type(4)));
typedef unsigned u32x4 __attribute__((ext_vector_type(4)));
constexpr int BM = 256, BK = 64, HALF = 128, HTB = HALF * BK * 2  , STAGE_BYTES = 8 * HTB, NXCD = 8, WGM = 8;

__host__ __device__ __forceinline__ int lds_byte(int r, int c) { const int st = (r >> 4) * 2 + (c >> 5), rr = r & 15, cc = c & 31, ob = rr * 64 + cc * 2; return st * 1024 + (ob ^ (((ob >> 9) & 1) << 5)); }
__host__ __device__ __forceinline__ void stage_rc(int b, int& R, int& C) { const int st = b / 1024, sb = b % 1024, swz = sb ^ (((sb >> 9) & 1) << 5); R = (st >> 1) * 16 + swz / 64; C = (st & 1) * 32 + (swz % 64) / 2; }
__host__ __device__ __forceinline__ int perm32(int rho) { const int n = rho >> 4, i = rho & 15; return 8 * (i >> 2) + 4 * n + (i & 3); }

struct Unit { int pm, pn; };
struct Gemm { const bf16_t* A; const bf16_t* Bt; int M, N, K; };

struct StaticOrder {
    int nM, nN, nwg, G, c;
    __host__ __device__ void init(int M, int N, int G_, int c_) { nM = M / BM; nN = N / BM; nwg = nM * nN; G = G_; c = c_; }
    __host__ __device__ bool next(int i, Unit& u) const {
        const long L = (long)i * G + c; if (L >= nwg) return false;
        int wgid = (int)L; { const int q = nwg / NXCD, r = nwg % NXCD, xcd = wgid % NXCD, off = wgid / NXCD; wgid = (xcd < r ? xcd * (q + 1) : r * (q + 1) + (xcd - r) * q) + off; }
        const int nig = WGM * nN, gid = wgid / nig, fm = gid * WGM, gsz = (nM - fm) < WGM ? (nM - fm) : WGM;
        u.pm = fm + ((wgid % nig) % gsz); u.pn = (wgid % nig) / gsz; return true;
    }
    __device__ __forceinline__ void a_ready(const Unit&) const {}
    __device__ __forceinline__ void done(const Unit&) const {}
};

__device__ __forceinline__ unsigned cvt_pk_bf16(float lo, float hi) { unsigned r; asm volatile("v_cvt_pk_bf16_f32 %0, %1, %2" : "=v"(r) : "v"(lo), "v"(hi)); return r; }
typedef float f32x2 __attribute__((ext_vector_type(2)));
__device__ __forceinline__ f32x2 gelu_pk(f32x2 v) {
    const f32x2 av = __builtin_elementwise_abs(v), d = av * 0.2316418882f + 1.0f;
    f32x2 t; t.x = __builtin_amdgcn_rcpf(d.x); t.y = __builtin_amdgcn_rcpf(d.y);
    f32x2 q = t * 0.5307027145f + (-0.7265760135f); q = q * t + 0.7107068705f; q = q * t + (-0.142248368f); q = q * t + 0.127414796f; q = q * t;
    const f32x2 s = (v * v) * (-0.72134752044f);
    f32x2 e; e.x = __builtin_amdgcn_exp2f(s.x); e.y = __builtin_amdgcn_exp2f(s.y);
    const f32x2 m = v * (q * e), r = v - m;
    f32x2 o; o.x = v.x < 0.f ? m.x : r.x; o.y = v.y < 0.f ? m.y : r.y; return o;
}

template <int ACT  > struct EpiBf16 {
    static constexpr bool PERM = true, AFTER_DRAIN = false; static_assert(ACT == 0 || ACT == 1, "EpiBf16: ACT is 0 (none) or 1 (gelu_pk)");
    bf16_t* O; int ldc; const float* bias; int split_cols; size_t split_stride; float scale0;
    __device__ __forceinline__ void operator()(const f32x4 (&acc)[2][2][4][2], const Unit& u, int wr, int wc, int fr, int fq) const {
        const int row0 = u.pm * BM + wr * 64 + fr; int colt = u.pn * BM; bf16_t* base = O;
        float sc = 1.f; if (split_cols) { const int t = colt / split_cols; base += (size_t)t * split_stride; colt -= t * split_cols; if (t == 0) sc = scale0; }
        const int col0 = colt + wc * 32 + 8 * fq, bcol0 = u.pn * BM + wc * 32 + 8 * fq;
        f32x4 bv[2][2];
#pragma unroll
        for (int bj = 0; bj < 2; ++bj)
#pragma unroll
            for (int n = 0; n < 2; ++n) bv[bj][n] = bias ? *(const f32x4*)(bias + bcol0 + bj * HALF + 4 * n) : (f32x4){0.f, 0.f, 0.f, 0.f};
#pragma unroll
        for (int ai = 0; ai < 2; ++ai)
#pragma unroll
            for (int m = 0; m < 4; ++m) { bf16_t* rowp = base + (size_t)(row0 + ai * HALF + m * 16) * ldc + col0;
#pragma unroll
                for (int bj = 0; bj < 2; ++bj) { f32x4 v0 = acc[ai][bj][m][0] + bv[bj][0], v1 = acc[ai][bj][m][1] + bv[bj][1];
                    if (ACT == 1) { f32x2 a = gelu_pk((f32x2){v0[0], v0[1]}), b = gelu_pk((f32x2){v0[2], v0[3]}), c = gelu_pk((f32x2){v1[0], v1[1]}), d = gelu_pk((f32x2){v1[2], v1[3]});
                        v0 = (f32x4){a.x, a.y, b.x, b.y}; v1 = (f32x4){c.x, c.y, d.x, d.y}; }
                    v0 = v0 * sc; v1 = v1 * sc; u32x4 w; w.x = cvt_pk_bf16(v0[0], v0[1]); w.y = cvt_pk_bf16(v0[2], v0[3]); w.z = cvt_pk_bf16(v1[0], v1[1]); w.w = cvt_pk_bf16(v1[2], v1[3]);
                    *(u32x4*)(rowp + bj * HALF) = w; } }
    }
};
__device__ __forceinline__ float silu_f(float x) { return x / (1.0f + __expf(-x)); }
struct EpiResid {
    static constexpr bool PERM = false, AFTER_DRAIN = false;
    const float* xin_lat; const float* xin_ctx; float* xo_lat; float* xo_ctx; const float* mod; float alpha;
    __device__ __forceinline__ void operator()(const f32x4 (&acc)[2][2][4][2], const Unit& u, int wr, int wc, int fr, int fq) const {
        const int prow0 = u.pm * BM; const bool isc = prow0 >= 32768;
        const float* xin = isc ? xin_ctx + (size_t)(prow0 - 32768) * 1024 : xin_lat + (size_t)prow0 * 1024;
        float* xo = isc ? xo_ctx + (size_t)(prow0 - 32768) * 1024 : xo_lat + (size_t)prow0 * 1024;
        const float* g1 = mod + (isc ? 8 : (prow0 >> 12)) * 6144 + 2048;
        const int col0 = u.pn * BM + wc * 32 + 4 * fq;
        f32x4 gv[2][2];
#pragma unroll
        for (int bj = 0; bj < 2; ++bj)
#pragma unroll
            for (int n = 0; n < 2; ++n) gv[bj][n] = *(const f32x4*)(g1 + col0 + bj * HALF + n * 16);
#pragma unroll
        for (int ai = 0; ai < 2; ++ai)
#pragma unroll
            for (int m = 0; m < 4; ++m) { const size_t off = (size_t)(ai * HALF + wr * 64 + m * 16 + fr) * 1024 + col0;
#pragma unroll
                for (int bj = 0; bj < 2; ++bj)
#pragma unroll
                    for (int n = 0; n < 2; ++n) { const f32x4 xv = *(const f32x4*)(xin + off + bj * HALF + n * 16);
                        *(f32x4*)(xo + off + bj * HALF + n * 16) = xv * alpha + gv[bj][n] * acc[ai][bj][m][n]; }
                if (m & 1) asm volatile("" ::: "memory"); }
    }
};
struct EpiGLU {
    static constexpr bool PERM = true, AFTER_DRAIN = false;
    bf16_t* Hh;
    __device__ __forceinline__ void operator()(const f32x4 (&acc)[2][2][4][2], const Unit& u, int wr, int wc, int fr, int fq) const {
        const int row0 = u.pm * BM + wr * 64 + fr; const int col0 = (u.pn & 3) * 128 + wc * 32 + 8 * fq;
#pragma unroll
        for (int ai = 0; ai < 2; ++ai)
#pragma unroll
            for (int m = 0; m < 4; ++m) { bf16_t* rowp = Hh + (size_t)(row0 + ai * HALF + m * 16) * 512 + col0;
                const f32x4 g0 = acc[ai][0][m][0], g1 = acc[ai][0][m][1], u0 = acc[ai][1][m][0], u1 = acc[ai][1][m][1];
                u32x4 w; w.x = cvt_pk_bf16(silu_f(g0[0]) * u0[0], silu_f(g0[1]) * u0[1]); w.y = cvt_pk_bf16(silu_f(g0[2]) * u0[2], silu_f(g0[3]) * u0[3]);
                w.z = cvt_pk_bf16(silu_f(g1[0]) * u1[0], silu_f(g1[1]) * u1[1]); w.w = cvt_pk_bf16(silu_f(g1[2]) * u1[2], silu_f(g1[3]) * u1[3]);
                *(u32x4*)rowp = w; }
    }
};
struct EpiY {
    static constexpr bool PERM = true, AFTER_DRAIN = false;
    bf16_t* O;
    __device__ __forceinline__ void operator()(const f32x4 (&acc)[2][2][4][2], const Unit& u, int wr, int wc, int fr, int fq) const {
        const int row0 = u.pm * BM + wr * 64 + fr; const int col0 = (u.pn & 3) * BM + wc * 32 + 8 * fq;
#pragma unroll
        for (int ai = 0; ai < 2; ++ai)
#pragma unroll
            for (int m = 0; m < 4; ++m) { bf16_t* rowp = O + (size_t)(row0 + ai * HALF + m * 16) * 1024 + col0;
#pragma unroll
                for (int bj = 0; bj < 2; ++bj) { const f32x4 v0 = acc[ai][bj][m][0], v1 = acc[ai][bj][m][1];
                    u32x4 w; w.x = cvt_pk_bf16(v0[0], v0[1]); w.y = cvt_pk_bf16(v0[2], v0[3]); w.z = cvt_pk_bf16(v1[0], v1[1]); w.w = cvt_pk_bf16(v1[2], v1[3]);
                    *(u32x4*)(rowp + bj * HALF) = w; } }
    }
};
struct MoeOrder {
    const PG8_LAS unsigned char* p2e; int nunits, G, c; const PG8_LAS int* rows;
    __device__ __forceinline__ const PG8_LAS int* arows(int i) const { return rows + i * 256; }
    __device__ __forceinline__ bool next(int i, Unit& u) const {
        const int L = i * G + c; if (L >= nunits) return false;
        u.pm = L >> 2; u.pn = (int)p2e[L >> 2] * 4 + (L & 3); return true;
    }
    __device__ __forceinline__ void a_ready(const Unit&) const {}
    __device__ __forceinline__ void done(const Unit&) const {}
};
template <class Epi, class Sched, bool ALIGN_EPI = false, bool SP2 = false>
__device__ __forceinline__ void gemm_phase(PG8_LAS unsigned char* lds, const Gemm g, const Sched& S, const Epi& E) {
    int tid_ = threadIdx.x; asm volatile("" : "+v"(tid_));
    const int tid = tid_, wid = __builtin_amdgcn_readfirstlane(tid >> 6), lane = tid & 63, wr = wid >> 2, wc = wid & 3, fr = lane & 15, fq = lane >> 4;
    const int K = g.K, nt = K / BK;
    unsigned voffA[2], voffB[2];
#pragma unroll
    for (int i = 0; i < 2; ++i) { int R, C; stage_rc(tid * 16 + i * 8192, R, C); const int Rb = Epi::PERM ? ((R & ~31) + perm32(R & 31)) : R;
        voffA[i] = (unsigned)(R * K + C) * 2u; voffB[i] = (unsigned)(Rb * K + C) * 2u; }
    const size_t kstep = (size_t)(BK * 2);
    const size_t hstep = (size_t)HALF * K * 2;
    const size_t tstep = 2 * hstep;
    const unsigned ldsw = (unsigned)wid * 1024u;
    const int aoff = lds_byte(wr * 64 + fr, fq * 8), boff = lds_byte(wc * 32 + fr, fq * 8);
#define PG8_SA(b, h) (((b) * 2 + (h)) * HTB)
#define PG8_SB(b, h) ((4 + (b) * 2 + (h)) * HTB)
#define PG8_STAGE(bufoff, gbase, voff) do { _Pragma("unroll") for (int _i = 0; _i < 2; ++_i) \
        __builtin_amdgcn_global_load_lds((const unsigned*)((const char*)(gbase) + (voff)[_i]), (PG8_LAS unsigned*)(lds + (bufoff) + ldsw + _i * 8192), 16, 0, 0); } while (0)
#define PG8_LDA(dst, b, h) do { _Pragma("unroll") for (int m = 0; m < 4; ++m) _Pragma("unroll") for (int k = 0; k < 2; ++k) dst[m][k] = *(const PG8_LAS bf16x8*)(lds + PG8_SA(b, h) + aoff + m * 2048 + k * 1024); } while (0)
#define PG8_LDB(dst, b, h) do { _Pragma("unroll") for (int n = 0; n < 2; ++n) _Pragma("unroll") for (int k = 0; k < 2; ++k) dst[n][k] = *(const PG8_LAS bf16x8*)(lds + PG8_SB(b, h) + boff + n * 2048 + k * 1024); } while (0)
#define PG8_MMA(ai, bj, At, Bt) do { __builtin_amdgcn_s_setprio(1); _Pragma("unroll") for (int m = 0; m < 4; ++m) _Pragma("unroll") for (int n = 0; n < 2; ++n) _Pragma("unroll") for (int k = 0; k < 2; ++k) \
        acc[ai][bj][m][n] = __builtin_amdgcn_mfma_f32_16x16x32_bf16(Bt[n][k], At[m][k], acc[ai][bj][m][n], 0, 0, 0); __builtin_amdgcn_s_setprio(0); } while (0)
#define PG8_WAIT_V(n) asm volatile("s_waitcnt vmcnt(" #n ")" ::: "memory")
#define PG8_WAIT_L(n) asm volatile("s_waitcnt lgkmcnt(" #n ")" ::: "memory")
#define PG8_BAR __builtin_amdgcn_s_barrier()
#define PG8_SCHED __builtin_amdgcn_sched_barrier(0)
    Unit cur, nxt; int ui = 0;
    if (!S.next(0, cur)) return;
    f32x4 acc[2][2][4][2];
#pragma unroll
    for (int a = 0; a < 2; ++a)
#pragma unroll
        for (int b = 0; b < 2; ++b)
#pragma unroll
            for (int m = 0; m < 4; ++m)
#pragma unroll
                for (int n = 0; n < 2; ++n) acc[a][b][m][n] = (f32x4){0.f, 0.f, 0.f, 0.f};
    bf16x8 At[4][2], B0[2][2], B1[2][2];
    const char* cA = (const char*)g.A + (size_t)cur.pm * tstep; const char* cB = (const char*)g.Bt + (size_t)cur.pn * tstep;
    S.a_ready(cur);
    if constexpr (SP2) {
        PG8_STAGE(PG8_SB(0, 0), cB, voffB); PG8_STAGE(PG8_SB(0, 1), cB + hstep, voffB); PG8_STAGE(PG8_SA(0, 0), cA, voffA); PG8_STAGE(PG8_SA(0, 1), cA + hstep, voffA);
        if (wr == 1) PG8_BAR;
        PG8_WAIT_V(2); PG8_BAR;
        PG8_STAGE(PG8_SB(1, 0), cB + kstep, voffB); PG8_STAGE(PG8_SA(1, 0), cA + kstep, voffA); PG8_STAGE(PG8_SB(1, 1), cB + hstep + kstep, voffB);
        PG8_WAIT_V(6); PG8_BAR;
    } else {
        PG8_STAGE(PG8_SB(0, 0), cB, voffB); PG8_STAGE(PG8_SA(0, 0), cA, voffA); PG8_STAGE(PG8_SB(0, 1), cB + hstep, voffB); PG8_STAGE(PG8_SA(0, 1), cA + hstep, voffA);
        if (wr == 1) PG8_BAR;
        PG8_WAIT_V(4); PG8_BAR;
        PG8_STAGE(PG8_SB(1, 0), cB + kstep, voffB); PG8_STAGE(PG8_SA(1, 0), cA + kstep, voffA); PG8_STAGE(PG8_SB(1, 1), cB + hstep + kstep, voffB);
        PG8_WAIT_V(6); PG8_BAR;
    }
    for (;;) {
        const bool has_next = S.next(ui + 1, nxt);
        const char* nA = has_next ? (const char*)g.A + (size_t)nxt.pm * tstep : cA; const char* nB = has_next ? (const char*)g.Bt + (size_t)nxt.pn * tstep : cB;
        for (int t = 0; t < nt; t += 2) {
            const bool last = (t == nt - 2);
            const char* a1 = cA + (size_t)(t + 1) * kstep;
            const char* a2 = last ? nA : cA + (size_t)(t + 2) * kstep; const char* b2 = last ? nB : cB + (size_t)(t + 2) * kstep;
            const char* a3 = a2 + kstep; const char* b3 = b2 + kstep;
            if (last && has_next) S.a_ready(nxt);
            if constexpr (SP2) {
            PG8_LDB(B0, 0, 0); PG8_LDB(B1, 0, 1); PG8_SCHED; PG8_LDA(At, 0, 0); PG8_STAGE(PG8_SA(1, 1), a1 + hstep, voffA);
            PG8_WAIT_V(8); PG8_WAIT_L(0); PG8_BAR; PG8_MMA(0, 0, At, B0); PG8_MMA(0, 1, At, B1); PG8_BAR; PG8_SCHED;
            PG8_LDA(At, 0, 1); PG8_STAGE(PG8_SB(0, 0), b2, voffB); PG8_STAGE(PG8_SB(0, 1), b2 + hstep, voffB); PG8_STAGE(PG8_SA(0, 0), a2, voffA);
            PG8_WAIT_V(8); PG8_WAIT_L(0); PG8_BAR; PG8_MMA(1, 0, At, B0); PG8_MMA(1, 1, At, B1); PG8_BAR; PG8_SCHED;
            PG8_LDB(B0, 1, 0); PG8_LDB(B1, 1, 1); PG8_SCHED; PG8_LDA(At, 1, 0); PG8_STAGE(PG8_SA(0, 1), a2 + hstep, voffA);
            PG8_WAIT_V(8); PG8_WAIT_L(0); PG8_BAR; PG8_MMA(0, 0, At, B0); PG8_MMA(0, 1, At, B1); PG8_BAR; PG8_SCHED;
            PG8_LDA(At, 1, 1); PG8_STAGE(PG8_SB(1, 0), b3, voffB); PG8_STAGE(PG8_SB(1, 1), b3 + hstep, voffB); PG8_STAGE(PG8_SA(1, 0), a3, voffA);
            PG8_WAIT_V(8); PG8_WAIT_L(0); PG8_BAR; PG8_MMA(1, 0, At, B0); PG8_MMA(1, 1, At, B1); PG8_BAR; PG8_SCHED;
            } else {
            PG8_LDB(B0, 0, 0); PG8_SCHED; PG8_LDA(At, 0, 0); PG8_STAGE(PG8_SA(1, 1), a1 + hstep, voffA);
            PG8_WAIT_L(8); PG8_BAR; PG8_WAIT_L(0); PG8_MMA(0, 0, At, B0); PG8_BAR; PG8_SCHED;
            PG8_LDB(B1, 0, 1); PG8_STAGE(PG8_SB(0, 0), b2, voffB);
            PG8_BAR; PG8_WAIT_L(0); PG8_MMA(0, 1, At, B1); PG8_BAR;
            PG8_LDA(At, 0, 1); PG8_STAGE(PG8_SA(0, 0), a2, voffA);
            PG8_BAR; PG8_WAIT_L(0); PG8_MMA(1, 0, At, B0); PG8_BAR; PG8_SCHED;
            PG8_STAGE(PG8_SB(0, 1), b2 + hstep, voffB);
            PG8_WAIT_V(6); PG8_BAR; PG8_MMA(1, 1, At, B1); PG8_BAR;
            PG8_LDB(B0, 1, 0); PG8_SCHED; PG8_LDA(At, 1, 0); PG8_STAGE(PG8_SA(0, 1), a2 + hstep, voffA);
            PG8_WAIT_L(8); PG8_BAR; PG8_WAIT_L(0); PG8_MMA(0, 0, At, B0); PG8_BAR; PG8_SCHED;
            PG8_LDB(B1, 1, 1); PG8_STAGE(PG8_SB(1, 0), b3, voffB);
            PG8_BAR; PG8_WAIT_L(0); PG8_MMA(0, 1, At, B1); PG8_BAR;
            PG8_LDA(At, 1, 1); PG8_STAGE(PG8_SA(1, 0), a3, voffA);
            PG8_BAR; PG8_WAIT_L(0); PG8_MMA(1, 0, At, B0); PG8_BAR; PG8_SCHED;
            PG8_STAGE(PG8_SB(1, 1), b3 + hstep, voffB);
            PG8_WAIT_V(6); PG8_BAR; PG8_MMA(1, 1, At, B1); PG8_BAR;
            }
        }
        if constexpr (ALIGN_EPI) { if (wr == 0) PG8_BAR; }
        if constexpr (!Epi::AFTER_DRAIN) { E(acc, cur, wr, wc, fr, fq); S.done(cur); }
        if (!has_next) break;
#pragma unroll
        for (int a = 0; a < 2; ++a)
#pragma unroll
            for (int b = 0; b < 2; ++b)
#pragma unroll
                for (int m = 0; m < 4; ++m)
#pragma unroll
                    for (int n = 0; n < 2; ++n) acc[a][b][m][n] = (f32x4){0.f, 0.f, 0.f, 0.f};
        cur = nxt; cA = nA; cB = nB; ++ui;
        if constexpr (ALIGN_EPI) { if (wr == 1) PG8_BAR; }
    }
    PG8_WAIT_V(0);
    if constexpr (!ALIGN_EPI) { if (wr == 0) PG8_BAR; }
    PG8_BAR;
    if constexpr (Epi::AFTER_DRAIN) { E.fused(acc, cur, wr, wc, fr, fq, lds, wid, lane); S.done(cur); }
#undef PG8_SA
#undef PG8_SB
#undef PG8_STAGE
#undef PG8_LDA
#undef PG8_LDB
#undef PG8_MMA
#undef PG8_WAIT_V
#undef PG8_WAIT_L
#undef PG8_BAR
#undef PG8_SCHED
}
template <class Epi, class Sched>
__device__ __forceinline__ void gemm_phase_gather(PG8_LAS unsigned char* lds, const Gemm g, const Sched& S, const Epi& E) {
    int tid_ = threadIdx.x; asm volatile("" : "+v"(tid_));
    const int tid = tid_, wid = __builtin_amdgcn_readfirstlane(tid >> 6), lane = tid & 63, wr = wid >> 2, wc = wid & 3, fr = lane & 15, fq = lane >> 4;
    const int K = g.K, nt = K / BK;
    constexpr bool ALIGN_EPI = true, SP2 = true;
    unsigned voffB[2]; unsigned vc[2][2], vn[2][2]; int RA[2], CA[2];
#pragma unroll
    for (int i = 0; i < 2; ++i) { int R, C; stage_rc(tid * 16 + i * 8192, R, C); const int Rb = Epi::PERM ? ((R & ~31) + perm32(R & 31)) : R;
        RA[i] = R; CA[i] = C; voffB[i] = (unsigned)(Rb * K + C) * 2u; }
    const size_t kstep = (size_t)(BK * 2);
    const size_t hstep = (size_t)HALF * K * 2;
    const size_t tstep = 2 * hstep;
    const unsigned ldsw = (unsigned)wid * 1024u;
    const int aoff = lds_byte(wr * 64 + fr, fq * 8), boff = lds_byte(wc * 32 + fr, fq * 8);
#define PG8_SA(b, h) (((b) * 2 + (h)) * HTB)
#define PG8_SB(b, h) ((4 + (b) * 2 + (h)) * HTB)
#define PG8_STAGE(bufoff, gbase, voff) do { _Pragma("unroll") for (int _i = 0; _i < 2; ++_i) \
        __builtin_amdgcn_global_load_lds((const unsigned*)((const char*)(gbase) + (voff)[_i]), (PG8_LAS unsigned*)(lds + (bufoff) + ldsw + _i * 8192), 16, 0, 0); } while (0)
#define PG8_LDA(dst, b, h) do { _Pragma("unroll") for (int m = 0; m < 4; ++m) _Pragma("unroll") for (int k = 0; k < 2; ++k) dst[m][k] = *(const PG8_LAS bf16x8*)(lds + PG8_SA(b, h) + aoff + m * 2048 + k * 1024); } while (0)
#define PG8_LDB(dst, b, h) do { _Pragma("unroll") for (int n = 0; n < 2; ++n) _Pragma("unroll") for (int k = 0; k < 2; ++k) dst[n][k] = *(const PG8_LAS bf16x8*)(lds + PG8_SB(b, h) + boff + n * 2048 + k * 1024); } while (0)
#define PG8_MMA(ai, bj, At, Bt) do { __builtin_amdgcn_s_setprio(1); _Pragma("unroll") for (int m = 0; m < 4; ++m) _Pragma("unroll") for (int n = 0; n < 2; ++n) _Pragma("unroll") for (int k = 0; k < 2; ++k) \
        acc[ai][bj][m][n] = __builtin_amdgcn_mfma_f32_16x16x32_bf16(Bt[n][k], At[m][k], acc[ai][bj][m][n], 0, 0, 0); __builtin_amdgcn_s_setprio(0); } while (0)
#define PG8_WAIT_V(n) asm volatile("s_waitcnt vmcnt(" #n ")" ::: "memory")
#define PG8_WAIT_L(n) asm volatile("s_waitcnt lgkmcnt(" #n ")" ::: "memory")
#define PG8_BAR __builtin_amdgcn_s_barrier()
#define PG8_SCHED __builtin_amdgcn_sched_barrier(0)
    Unit cur, nxt; int ui = 0;
    if (!S.next(0, cur)) return;
    f32x4 acc[2][2][4][2];
#pragma unroll
    for (int a = 0; a < 2; ++a)
#pragma unroll
        for (int b = 0; b < 2; ++b)
#pragma unroll
            for (int m = 0; m < 4; ++m)
#pragma unroll
                for (int n = 0; n < 2; ++n) acc[a][b][m][n] = (f32x4){0.f, 0.f, 0.f, 0.f};
    bf16x8 At[4][2], B0[2][2], B1[2][2];
    const char* kA = (const char*)g.A; const char* cB = (const char*)g.Bt + (size_t)cur.pn * tstep;
#define PG8_ROWS(dst, tab) do { _Pragma("unroll") for (int _h = 0; _h < 2; ++_h) _Pragma("unroll") for (int _i = 0; _i < 2; ++_i) \
        dst[_h][_i] = (unsigned)((tab)[_h * HALF + RA[_i]] * K + CA[_i]) * 2u; } while (0)
    { const PG8_LAS int* tab = S.arows(0); PG8_ROWS(vc, tab); }
    S.a_ready(cur);
    if constexpr (SP2) {
        PG8_STAGE(PG8_SB(0, 0), cB, voffB); PG8_STAGE(PG8_SB(0, 1), cB + hstep, voffB); PG8_STAGE(PG8_SA(0, 0), kA, vc[0]); PG8_STAGE(PG8_SA(0, 1), kA, vc[1]);
        if (wr == 1) PG8_BAR;
        PG8_WAIT_V(2); PG8_BAR;
        PG8_STAGE(PG8_SB(1, 0), cB + kstep, voffB); PG8_STAGE(PG8_SA(1, 0), kA + kstep, vc[0]); PG8_STAGE(PG8_SB(1, 1), cB + hstep + kstep, voffB);
        PG8_WAIT_V(6); PG8_BAR;
    }
    for (;;) {
        const bool has_next = S.next(ui + 1, nxt);
        const char* nB = has_next ? (const char*)g.Bt + (size_t)nxt.pn * tstep : cB;
        if (has_next) { const PG8_LAS int* tab = S.arows(ui + 1); PG8_ROWS(vn, tab); } else { _Pragma("unroll") for (int _h = 0; _h < 2; ++_h) { vn[_h][0] = vc[_h][0]; vn[_h][1] = vc[_h][1]; } }
        for (int t = 0; t < nt; t += 2) {
            const bool last = (t == nt - 2);
            const char* a1 = kA + (size_t)(t + 1) * kstep;
            const char* a2 = last ? kA : kA + (size_t)(t + 2) * kstep; const char* b2 = last ? nB : cB + (size_t)(t + 2) * kstep;
            unsigned v0[2], v1[2]; v0[0] = last ? vn[0][0] : vc[0][0]; v0[1] = last ? vn[0][1] : vc[0][1]; v1[0] = last ? vn[1][0] : vc[1][0]; v1[1] = last ? vn[1][1] : vc[1][1];
            const char* a3 = a2 + kstep; const char* b3 = b2 + kstep;
            if (last && has_next) S.a_ready(nxt);
            if constexpr (SP2) {
            PG8_LDB(B0, 0, 0); PG8_LDB(B1, 0, 1); PG8_SCHED; PG8_LDA(At, 0, 0); PG8_STAGE(PG8_SA(1, 1), a1, vc[1]);
            PG8_WAIT_V(8); PG8_WAIT_L(0); PG8_BAR; PG8_MMA(0, 0, At, B0); PG8_MMA(0, 1, At, B1); PG8_BAR; PG8_SCHED;
            PG8_LDA(At, 0, 1); PG8_STAGE(PG8_SB(0, 0), b2, voffB); PG8_STAGE(PG8_SB(0, 1), b2 + hstep, voffB); PG8_STAGE(PG8_SA(0, 0), a2, v0);
            PG8_WAIT_V(8); PG8_WAIT_L(0); PG8_BAR; PG8_MMA(1, 0, At, B0); PG8_MMA(1, 1, At, B1); PG8_BAR; PG8_SCHED;
            PG8_LDB(B0, 1, 0); PG8_LDB(B1, 1, 1); PG8_SCHED; PG8_LDA(At, 1, 0); PG8_STAGE(PG8_SA(0, 1), a2, v1);
            PG8_WAIT_V(8); PG8_WAIT_L(0); PG8_BAR; PG8_MMA(0, 0, At, B0); PG8_MMA(0, 1, At, B1); PG8_BAR; PG8_SCHED;
            PG8_LDA(At, 1, 1); PG8_STAGE(PG8_SB(1, 0), b3, voffB); PG8_STAGE(PG8_SB(1, 1), b3 + hstep, voffB); PG8_STAGE(PG8_SA(1, 0), a3, v0);
            PG8_WAIT_V(8); PG8_WAIT_L(0); PG8_BAR; PG8_MMA(1, 0, At, B0); PG8_MMA(1, 1, At, B1); PG8_BAR; PG8_SCHED;
            }
        }
        if constexpr (ALIGN_EPI) { if (wr == 0) PG8_BAR; }
        if constexpr (!Epi::AFTER_DRAIN) { E(acc, cur, wr, wc, fr, fq); S.done(cur); }
        if (!has_next) break;
#pragma unroll
        for (int a = 0; a < 2; ++a)
#pragma unroll
            for (int b = 0; b < 2; ++b)
#pragma unroll
                for (int m = 0; m < 4; ++m)
#pragma unroll
                    for (int n = 0; n < 2; ++n) acc[a][b][m][n] = (f32x4){0.f, 0.f, 0.f, 0.f};
        cur = nxt; cB = nB; ++ui;
#pragma unroll
        for (int _h = 0; _h < 2; ++_h) { vc[_h][0] = vn[_h][0]; vc[_h][1] = vn[_h][1]; }
        if constexpr (ALIGN_EPI) { if (wr == 1) PG8_BAR; }
    }
    PG8_WAIT_V(0);
    if constexpr (!ALIGN_EPI) { if (wr == 0) PG8_BAR; }
    PG8_BAR;
    if constexpr (Epi::AFTER_DRAIN) { E.fused(acc, cur, wr, wc, fr, fq, lds, wid, lane); S.done(cur); }
#undef PG8_ROWS
#undef PG8_SA
#undef PG8_SB
#undef PG8_STAGE
#undef PG8_LDA
#undef PG8_LDB
#undef PG8_MMA
#undef PG8_WAIT_V
#undef PG8_WAIT_L
#undef PG8_BAR
#undef PG8_SCHED
}
}
constexpr int NWAVES = 8, NTHR = 512;
constexpr int DM = 1024, NLAT = 32768, NCTX = 2048, NROWS = 34816, INC = 3328;
constexpr int OFF_CB = 0, OFF_CC = 256, OFF_CX = 512, OFF_Q = 768, OFF_K = 1280, OFF_V = 1792, OFF_G = 2304, OFF_U = 2816, OFF_VV = 3072;
constexpr int NCH = 34;
constexpr float LN_EPS = 1e-5f, ALPHA = 1.41421356237309515f;
constexpr size_t MiB = 1u << 20;
constexpr size_t WS_CTL = 0, CTL_ZERO_BYTES = MiB, WS_MOD = 1 * MiB, WS_LG = 1 * MiB + 480 * 1024, WS_WR = 1 * MiB + 512 * 1024, WS_TOK = 2 * MiB, WS_SGUW = 3 * MiB + 256 * 1024, WS_ROWOF = 3 * MiB + 512 * 1024, WS_WIN = 4 * MiB, WS_WOUT = 17 * MiB, WS_WGU = 21 * MiB, WS_WD = 149 * MiB,
                 WS_HB = 213 * MiB, WS_ST = WS_HB, WS_XCTX = 281 * MiB, WS_P = 289 * MiB, WS_YMIX = 510 * MiB, WS_XB = WS_P, WS_Y = WS_P, WS_YO = WS_P, WS_HH = WS_P + 152 * MiB, WS_END = 578 * MiB;
constexpr int CW_TMO = 0, CW_BAR = 4096, CW_WGCNT = 16384, CW_TOT = 32768, CW_DQ = 33024;
constexpr int RING_BYTES = 131072, LDSCTL_OFF = RING_BYTES, MISC_OFF = LDSCTL_OFF + 320, P2E_OFF = LDSCTL_OFF + 1024, PST_OFF = LDSCTL_OFF + 2048, LDS_BYTES = 147456;
constexpr int MAXPANELS = 304;
constexpr int LCNT_OFF = LDSCTL_OFF + 4096, LG_OFF = LDSCTL_OFF + 4352, DQ_OFF = LDSCTL_OFF + 9600, AROWS_OFF = LDSCTL_OFF + 9728;

#define GAS __attribute__((address_space(1)))
#define LAS __attribute__((address_space(3)))
typedef unsigned short bf16;
typedef unsigned v4u __attribute__((ext_vector_type(4)));
typedef unsigned v2u __attribute__((ext_vector_type(2)));
typedef float f32x4 __attribute__((ext_vector_type(4)));
#define LDS_WAIT() asm volatile("s_waitcnt lgkmcnt(0)" ::: "memory")
#define VM_WAIT() asm volatile("s_waitcnt vmcnt(0)" ::: "memory")
__device__ __forceinline__ unsigned f2bf(float f) { unsigned u = __builtin_bit_cast(unsigned, f); return (u + 0x7fffu + ((u >> 16) & 1u)) >> 16; }
__device__ __forceinline__ unsigned pk2(float lo, float hi) { return f2bf(lo) | (f2bf(hi) << 16); }
typedef float f32x2_t __attribute__((ext_vector_type(2))); typedef __bf16 bf16x2_t __attribute__((ext_vector_type(2)));
__device__ __forceinline__ unsigned cvtpk(float lo, float hi) { f32x2_t v = {lo, hi}; bf16x2_t b = __builtin_convertvector(v, bf16x2_t); return __builtin_bit_cast(unsigned, b); }
__device__ __forceinline__ float bflo(unsigned w) { return __builtin_bit_cast(float, w << 16); }
__device__ __forceinline__ float bfhi(unsigned w) { return __builtin_bit_cast(float, w & 0xffff0000u); }
__device__ __forceinline__ float wave_sum(float v) {
#pragma unroll
    for (int o = 1; o < 64; o <<= 1) v += __shfl_xor(v, o);
    return v;
}
__device__ __forceinline__ float log_sigmoid_f(float x) { return -(fmaxf(-x, 0.f) + log1pf(expf(-fabsf(x)))); }

struct Args { const float* in[24]; float* out; unsigned char* ws; int ph_lo, ph_hi; };
#define XB_TMO      128
#define XB_XCNT(j)  (256  + 64 * (j))
#define XB_XSUB(j)  (1280 + 64 * (j))
#define XB_XGEN(j)  (2304 + 64 * (j))
#define XB_TOP      3328
#define XB_TOPGEN   3392
#define XCD_BAR_WORDS 3456
#define XB_SPIN_CAP (1u << 18)

__device__ __forceinline__ unsigned xb_ld(unsigned* p)              { return __hip_atomic_load(p, __ATOMIC_RELAXED, __HIP_MEMORY_SCOPE_AGENT); }
__device__ __forceinline__ unsigned xb_add(unsigned* p, unsigned v) { return __hip_atomic_fetch_add(p, v, __ATOMIC_RELAXED, __HIP_MEMORY_SCOPE_AGENT); }
__device__ __forceinline__ unsigned xb_xcc_id() { return (unsigned)__builtin_amdgcn_s_getreg((3 << 11) | 20) & 0xFu; }
#define XB_SPIN(cond, bar) do { unsigned _sp = 0; while (cond) { __builtin_amdgcn_s_sleep(1); \
    if ((++_sp & 255u) == 0u) { if (xb_ld(&(bar)[XB_TMO])) break; if (_sp > XB_SPIN_CAP) { atomicAdd(&(bar)[XB_TMO], 1u); break; } } } } while (0)

struct XcdBarrier {
    unsigned* bar; unsigned x;
    volatile LAS unsigned* st;
};

__device__ __forceinline__ XcdBarrier xcd_barrier_post(unsigned* bar, volatile LAS unsigned* st) {
    XcdBarrier b; b.bar = bar; b.x = xb_xcc_id(); b.st = st;
    if (threadIdx.x == 0) (void)xb_add(&bar[XB_XCNT(b.x)], 1u);
    return b;
}
__device__ __forceinline__ void xcd_barrier_complete(unsigned* bar, unsigned x, unsigned& nloc, unsigned& nx) {
    const unsigned G = gridDim.x * gridDim.y * gridDim.z;
    unsigned sum, cnt, mine, sp = 0u;
    for (;;) {
        sum = 0u; cnt = 0u; mine = 0u;
#pragma unroll
        for (unsigned j = 0; j < 16; ++j) { const unsigned c = xb_ld(&bar[XB_XCNT(j)]); sum += c; cnt += (c > 0u) ? 1u : 0u; mine = (j == x) ? c : mine; }
        if (sum == G) break;
        __builtin_amdgcn_s_sleep(1);
        if ((++sp & 255u) == 0u) { if (xb_ld(&bar[XB_TMO])) break; if (sp > XB_SPIN_CAP) { atomicAdd(&bar[XB_TMO], 1u); break; } }
    }
    nloc = mine > 0u ? mine : 1u; nx = cnt > 0u ? cnt : 1u;
}

__device__ __forceinline__ void xcd_barrier(const XcdBarrier& b) {
    asm volatile("s_waitcnt vmcnt(0)" ::: "memory");
    __syncthreads();
    if (threadIdx.x == 0) {
        unsigned* bar = b.bar;
        __builtin_amdgcn_s_waitcnt(0);
        unsigned nloc = b.st[0], nx = b.st[1];
        if (nloc == 0u) { xcd_barrier_complete(bar, b.x, nloc, nx); b.st[0] = nloc; b.st[1] = nx; }
        const unsigned old = xb_add(&bar[XB_XSUB(b.x)], 1u);
        const unsigned gen = old / nloc;
        if (old + 1u == (gen + 1u) * nloc) {
            __builtin_amdgcn_fence(__ATOMIC_RELEASE, "agent");
            asm volatile("s_waitcnt vmcnt(0)" ::: "memory");
            const unsigned og = xb_add(&bar[XB_TOP], 1u);
            const unsigned tg = og / nx;
            if (og + 1u == (tg + 1u) * nx) xb_add(&bar[XB_TOPGEN], 1u);
            else XB_SPIN(xb_ld(&bar[XB_TOPGEN]) == tg, bar);
            __builtin_amdgcn_fence(__ATOMIC_ACQUIRE, "agent");
            xb_add(&bar[XB_XGEN(b.x)], 1u);
            asm volatile("s_waitcnt vmcnt(0)" ::: "memory");
        } else {
            XB_SPIN(xb_ld(&bar[XB_XGEN(b.x)]) == gen, bar);
            __builtin_amdgcn_fence(__ATOMIC_ACQUIRE, "agent");
            asm volatile("s_waitcnt vmcnt(0)" ::: "memory");
        }
    }
    __syncthreads();
}
__device__ __forceinline__ void transpose_tile(const float* Wsrc, int ldn, bf16* dst, int ldk, float scale, LAS float* scr, int lane) {
#pragma unroll 8
    for (int i = 0; i < 32; ++i) { const int kk = 2 * i + (lane >> 5); scr[kk * 33 + (lane & 31)] = Wsrc[(size_t)kk * ldn + (lane & 31)] * scale; }
    LDS_WAIT(); asm volatile("" ::: "memory");
    const int c = lane & 7;
#pragma unroll
    for (int j = 0; j < 4; ++j) { const int n = (lane >> 3) + 8 * j; const LAS float* s = scr + (8 * c) * 33 + n;
        v4u o; o.x = pk2(s[0 * 33], s[1 * 33]); o.y = pk2(s[2 * 33], s[3 * 33]); o.z = pk2(s[4 * 33], s[5 * 33]); o.w = pk2(s[6 * 33], s[7 * 33]);
        *(GAS v4u*)(dst + (size_t)n * ldk + 8 * c) = o; }
    LDS_WAIT(); asm volatile("" ::: "memory");
}

__device__ __forceinline__ void phase_p0(const Args& a, LAS unsigned char* lds, int tid, int lane, int wave) {
    const int G = gridDim.x;
    {
        LAS float* s = (LAS float*)lds; LAS float* red = (LAS float*)(lds + 36864);
        const float* c = a.in[1]; const float* cctx = a.in[3]; const float* wada = a.in[4]; const float* bada = a.in[5];
        float* mod = (float*)(a.ws + WS_MOD);
        for (int u = blockIdx.x; u < 192; u += G) {
            const int l = u / 96, j0 = (u % 96) * 64;
            for (int i = tid; i < 9 * 1024; i += NTHR) { const int r = i >> 10, k = i & 1023; const float v = r < 8 ? c[r * 1024 + k] : cctx[k]; s[i] = v / (1.0f + expf(-v)); }
            __syncthreads();
            const int jq = tid & 15, kg = tid >> 4;
            float acc[9][4];
#pragma unroll
            for (int r = 0; r < 9; ++r) { acc[r][0] = 0.f; acc[r][1] = 0.f; acc[r][2] = 0.f; acc[r][3] = 0.f; }
            const float* w = wada + (size_t)l * 1024 * 6144 + j0 + jq * 4;
            for (int k = kg; k < 1024; k += 32) { const f32x4 wv = *(const f32x4*)(w + (size_t)k * 6144);
#pragma unroll
                for (int r = 0; r < 9; ++r) { const float sr = s[r * 1024 + k]; acc[r][0] += sr * wv.x; acc[r][1] += sr * wv.y; acc[r][2] += sr * wv.z; acc[r][3] += sr * wv.w; } }
#pragma unroll
            for (int r = 0; r < 9; ++r)
#pragma unroll
                for (int i = 0; i < 4; ++i) red[(kg * 9 + r) * 64 + jq * 4 + i] = acc[r][i];
            __syncthreads();
            for (int o = tid; o < 576; o += NTHR) { const int r = o >> 6, j = o & 63; float sum = 0.f;
                for (int g2 = 0; g2 < 32; ++g2) sum += red[(g2 * 9 + r) * 64 + j];
                mod[(l * 9 + r) * 6144 + j0 + j] = sum + bada[l * 6144 + j0 + j]; }
            __syncthreads();
        }
    }
    {
        LAS float* scr = (LAS float*)(lds + wave * 16384);
        const int gw = blockIdx.x * NWAVES + wave, NGW = G * NWAVES;
        const float* w_in = a.in[6]; const float* w_out = a.in[12]; const float* w_gate = a.in[19]; const float* w_up = a.in[20]; const float* w_down = a.in[21];
        bf16* WIN = (bf16*)(a.ws + WS_WIN); bf16* WOUT = (bf16*)(a.ws + WS_WOUT); bf16* WGU = (bf16*)(a.ws + WS_WGU); bf16* WD = (bf16*)(a.ws + WS_WD);
        constexpr int I_IN = 2 * 16 * 104, I_OUT = 2 * 16 * 32, I_GU = 2 * 2 * 32 * 256, I_D = 2 * 32 * 256, NITEMS = I_IN + I_OUT + I_GU + I_D;
        for (int it = gw; it < NITEMS; it += NGW) {
            int r = it;
            if (r < I_IN) { const int l = r / 1664, q = r % 1664, k0 = 64 * (q / 104), n0 = 32 * (q % 104);
                const float sc = (n0 >= OFF_K && n0 < OFF_V) ? 0.125f : 1.0f;
                transpose_tile(w_in + ((size_t)l * 1024 + k0) * INC + n0, INC, WIN + ((size_t)l * INC + n0) * 1024 + k0, 1024, sc, scr, lane); continue; }
            r -= I_IN;
            if (r < I_OUT) { const int l = r / 512, q = r % 512, k0 = 64 * (q / 32), n0 = 32 * (q % 32);
                transpose_tile(w_out + ((size_t)l * 1024 + k0) * 1024 + n0, 1024, WOUT + ((size_t)l * 1024 + n0) * 1024 + k0, 1024, 1.0f, scr, lane); continue; }
            r -= I_OUT;
            if (r < I_GU) { const int isup = r >= (I_GU / 2) ? 1 : 0; r -= isup * (I_GU / 2);
                const int le = r / 256, q = r % 256, k0 = 64 * (q / 16), n0 = 32 * (q % 16);
                const float* src = (isup ? w_up : w_gate) + ((size_t)le * 1024 + k0) * 512 + n0;
                const int drow = (n0 >> 7) * 256 + (n0 & 127) + isup * 128;
                transpose_tile(src, 512, WGU + ((size_t)le * 1024 + drow) * 1024 + k0, 1024, 1.0f, scr, lane); continue; }
            r -= I_GU;
            { const int le = r / 256, q = r % 256, k0 = 64 * (q / 32), n0 = 32 * (q % 32);
                transpose_tile(w_down + ((size_t)le * 512 + k0) * 1024 + n0, 1024, WD + ((size_t)le * 1024 + n0) * 512 + k0, 512, 1.0f, scr, lane); }
        }
    }
    { bf16* SW = (bf16*)(a.ws + WS_SGUW); const float* sw = a.in[10];
      for (int i = blockIdx.x * NTHR + tid; i < 2 * 4 * 128 * 128; i += G * NTHR) SW[i] = (bf16)f2bf(sw[i]); }
    if (blockIdx.x == 0 && tid < 32) { const int dir = tid & 1, lh = tid >> 1; ((float*)(a.ws + WS_LG))[tid] = log_sigmoid_f(a.in[8 + dir][lh]); }
    {
        bf16* WR = (bf16*)(a.ws + WS_WR);
        for (int i = blockIdx.x * NTHR + tid; i < 2 * 64 * 1024; i += G * NTHR) { const int l = i >> 16, j = (i >> 10) & 63, k = i & 1023;
            float v = 0.f;
            if (j < 4) v = a.in[15][((size_t)l * 1024 + k) * 4 + j]; else if (j < 36) v = a.in[17][(((size_t)l * 4 + ((j - 4) >> 3)) * 1024 + k) * 8 + ((j - 4) & 7)];
            const unsigned hi = f2bf(v); const float r = v - __builtin_bit_cast(float, hi << 16);
            WR[((size_t)(l * 2) * 64 + j) * 1024 + k] = (bf16)hi; WR[((size_t)(l * 2 + 1) * 64 + j) * 1024 + k] = (bf16)f2bf(r); }
    }
    __syncthreads();
}

__device__ __forceinline__ void phase_p1(const Args& a, int lane, int wave) {
    const int gw = blockIdx.x * NWAVES + wave, NGW = gridDim.x * NWAVES;
    const float* mod = (const float*)(a.ws + WS_MOD); bf16* Hb = (bf16*)(a.ws + WS_HB);
    for (int row = gw; row < NROWS; row += NGW) {
        const float* src = row < NLAT ? a.in[0] + (size_t)row * 1024 : a.in[2] + (size_t)(row - NLAT) * 1024;
        const float* m0 = mod + (row < NLAT ? (row >> 12) : 8) * 6144;
#pragma unroll
        for (int j = 0; j < 4; ++j) { const int idx = (lane + 64 * j) * 4;
            const f32x4 v = *(const f32x4*)(src + idx), sh = *(const f32x4*)(m0 + idx), sc = *(const f32x4*)(m0 + 1024 + idx);
            const f32x4 o = v * (sc + 1.0f) + sh; v2u w; w.x = pk2(o.x, o.y); w.y = pk2(o.z, o.w);
            *(v2u*)(Hb + (size_t)row * 1024 + idx) = w; }
    }
}

__device__ __forceinline__ int chunk_row0(int b, int c) { return c < 2 ? NLAT + b * 256 + c * 128 : b * 4096 + (c - 2) * 128; }
__device__ __forceinline__ size_t st_off(int b, int c, int h, int dir) { return ((((size_t)b * NCH + c) * 8 + h) * 2 + dir) * 4096; }

__device__ __forceinline__ void phase_b(const Args& a, int l, LAS unsigned char* lds, int tid) {
    const bf16* P = (const bf16*)(a.ws + WS_P); float* ST = (float*)(a.ws + WS_ST);
    LAS float* Ks = (LAS float*)lds; LAS float* Vs = (LAS float*)(lds + 32768); LAS float* pf = (LAS float*)(lds + 65536); LAS float* pb = pf + 128;
    for (int u = blockIdx.x; u < 8 * NCH * 8; u += gridDim.x) {
        const int b = u / (NCH * 8), c = (u % (NCH * 8)) / 8, h = u % 8; const int row0 = chunk_row0(b, c);
        __syncthreads();
        if (tid < 128) { const float lgf = log_sigmoid_f(a.in[8][l * 8 + h]), lgb = log_sigmoid_f(a.in[9][l * 8 + h]);
            pf[tid] = expf(lgf * (float)(127 - tid)); pb[tid] = expf(lgb * (float)tid); }
        { const int j = tid >> 2, part = tid & 3; const bf16* kp = P + (size_t)(row0 + j) * INC + OFF_K + h * 64 + part * 16; const bf16* vp = kp + (OFF_V - OFF_K);
#pragma unroll
          for (int q = 0; q < 2; ++q) { const v4u kw = *(const v4u*)(kp + 8 * q), vw = *(const v4u*)(vp + 8 * q);
              LAS float* kd = Ks + j * 64 + part * 16 + 8 * q; LAS float* vd = Vs + j * 64 + part * 16 + 8 * q;
              kd[0] = bflo(kw.x); kd[1] = bfhi(kw.x); kd[2] = bflo(kw.y); kd[3] = bfhi(kw.y); kd[4] = bflo(kw.z); kd[5] = bfhi(kw.z); kd[6] = bflo(kw.w); kd[7] = bfhi(kw.w);
              vd[0] = bflo(vw.x); vd[1] = bfhi(vw.x); vd[2] = bflo(vw.y); vd[3] = bfhi(vw.y); vd[4] = bflo(vw.z); vd[5] = bfhi(vw.z); vd[6] = bflo(vw.w); vd[7] = bfhi(vw.w); } }
        __syncthreads();
        const int d = tid >> 3, e0 = (tid & 7) * 8;
        float af[8], ab[8];
#pragma unroll
        for (int i = 0; i < 8; ++i) { af[i] = 0.f; ab[i] = 0.f; }
        for (int j = 0; j < 128; ++j) { const float kd = Ks[j * 64 + d], kf = kd * pf[j], kb = kd * pb[j];
            const f32x4 v0 = *(const LAS f32x4*)(Vs + j * 64 + e0), v1 = *(const LAS f32x4*)(Vs + j * 64 + e0 + 4);
            af[0] += kf * v0.x; af[1] += kf * v0.y; af[2] += kf * v0.z; af[3] += kf * v0.w; af[4] += kf * v1.x; af[5] += kf * v1.y; af[6] += kf * v1.z; af[7] += kf * v1.w;
            ab[0] += kb * v0.x; ab[1] += kb * v0.y; ab[2] += kb * v0.z; ab[3] += kb * v0.w; ab[4] += kb * v1.x; ab[5] += kb * v1.y; ab[6] += kb * v1.z; ab[7] += kb * v1.w; }
        float* o0 = ST + st_off(b, c, h, 0) + d * 64 + e0; float* o1 = ST + st_off(b, c, h, 1) + d * 64 + e0;
        *(f32x4*)o0 = (f32x4){af[0], af[1], af[2], af[3]}; *(f32x4*)(o0 + 4) = (f32x4){af[4], af[5], af[6], af[7]};
        *(f32x4*)o1 = (f32x4){ab[0], ab[1], ab[2], ab[3]}; *(f32x4*)(o1 + 4) = (f32x4){ab[4], ab[5], ab[6], ab[7]};
    }
    __syncthreads();
}

__device__ __forceinline__ void phase_c(const Args& a, int l, int tid) {
    bf16* ST = (bf16*)(a.ws + WS_ST);
    for (int it = blockIdx.x * NTHR + tid; it < 8 * 8 * 2 * 1024; it += gridDim.x * NTHR) {
        const int q = it & 1023, dir = (it >> 10) & 1, h = (it >> 11) & 7, b = it >> 14;
        const float lg = ((const float*)(a.ws + WS_LG))[(l * 8 + h) * 2 + dir]; const float dec = __expf(128.0f * lg);
        v2u kv[NCH];
#pragma unroll
        for (int s = 0; s < NCH; ++s) { const int c = dir ? (s < 2 ? 1 - s : 35 - s) : s; kv[s] = *(const v2u*)(ST + st_off(b, c, h, dir) + q * 4); }
        f32x4 st = (f32x4){0.f, 0.f, 0.f, 0.f};
#pragma unroll
        for (int s = 0; s < NCH; ++s) { const int c = dir ? (s < 2 ? 1 - s : 35 - s) : s;
            v2u w; w.x = cvtpk(st.x, st.y); w.y = cvtpk(st.z, st.w); *(v2u*)(ST + st_off(b, c, h, dir) + q * 4) = w;
            st = st * dec + (f32x4){bflo(kv[s].x), bfhi(kv[s].x), bflo(kv[s].y), bfhi(kv[s].y)}; }
    }
}
__device__ __forceinline__ void unpack8(const v4u w, float* f) { f[0] = bflo(w.x); f[1] = bfhi(w.x); f[2] = bflo(w.y); f[3] = bfhi(w.y); f[4] = bflo(w.z); f[5] = bfhi(w.z); f[6] = bflo(w.w); f[7] = bfhi(w.w); }
__device__ __forceinline__ v4u pack8(const float* f) { v4u w; w.x = pk2(f[0], f[1]); w.y = pk2(f[2], f[3]); w.z = pk2(f[4], f[5]); w.w = pk2(f[6], f[7]); return w; }

__device__ __forceinline__ void phase_d(const Args& a, int l, LAS unsigned char* lds, int tid, int lane) {
    const bf16* P = (const bf16*)(a.ws + WS_P); const float* ST = (const float*)(a.ws + WS_ST); bf16* Y = (bf16*)(a.ws + WS_YMIX);
    const float* convw = a.in[7] + l * 3 * 256; const float* sguw = a.in[10] + (size_t)l * 4 * 128 * 128; const float* sgub = a.in[11] + l * 4 * 128;
    const int c_lo = l == 1 ? 2 : 0, cpb = NCH - c_lo, nunits = 8 * cpb;
    LAS float* Sf = (LAS float*)lds; LAS float* Sb = (LAS float*)(lds + 16384); LAS float* Ks = (LAS float*)(lds + 32768); LAS float* Vs = (LAS float*)(lds + 65536);
    LAS float* VN = (LAS float*)lds;
    for (int u = blockIdx.x; u < nunits; u += gridDim.x) {
        const int b = u / cpb, c = c_lo + u % cpb; const int row0 = chunk_row0(b, c); const bool isc = c < 2;
#ifndef NO_D1
        for (int idx = tid; idx < 128 * 32; idx += NTHR) {
            const int p = idx >> 5, ch0 = (idx & 31) * 8; const int row = row0 + p;
            int dprev = -1, dnext = 1; bool vprev, vnext;
            if (isc) { const int t = c * 128 + p; vprev = t > 0; vnext = t < 255; }
            else { const int t = (c - 2) * 128 + p;
                if (ch0 < 128) { const int col = t & 63; vprev = col > 0; vnext = col < 63; }
                else { const int rg = t >> 6; vprev = rg > 0; vnext = rg < 63; dprev = -64; dnext = 64; } }
            const bf16* pr = P + (size_t)row * INC;
            float cb[8], zc[8], zp[8], zn[8], t0[8], t1[8];
            unpack8(*(const v4u*)(pr + OFF_CB + ch0), cb);
            unpack8(*(const v4u*)(pr + OFF_CC + ch0), t0); unpack8(*(const v4u*)(pr + OFF_CX + ch0), t1);
#pragma unroll
            for (int i = 0; i < 8; ++i) { zc[i] = t0[i] * t1[i]; zp[i] = 0.f; zn[i] = 0.f; }
            if (vprev) { const bf16* q = pr + (ptrdiff_t)dprev * INC; unpack8(*(const v4u*)(q + OFF_CC + ch0), t0); unpack8(*(const v4u*)(q + OFF_CX + ch0), t1);
#pragma unroll
                for (int i = 0; i < 8; ++i) zp[i] = t0[i] * t1[i]; }
            if (vnext) { const bf16* q = pr + (ptrdiff_t)dnext * INC; unpack8(*(const v4u*)(q + OFF_CC + ch0), t0); unpack8(*(const v4u*)(q + OFF_CX + ch0), t1);
#pragma unroll
                for (int i = 0; i < 8; ++i) zn[i] = t0[i] * t1[i]; }
            float o[8];
#pragma unroll
            for (int i = 0; i < 8; ++i) o[i] = cb[i] * (convw[ch0 + i] * zp[i] + convw[256 + ch0 + i] * zc[i] + convw[512 + ch0 + i] * zn[i]);
            *(v4u*)(Y + (size_t)row * 1024 + ch0) = pack8(o);
        }
#endif
        const int i = tid >> 2, part = tid & 3;
#ifndef NO_D2
#pragma unroll 1
        for (int h = 0; h < 8; ++h) {
            __syncthreads();
            { const bf16* kp = P + (size_t)(row0 + i) * INC + OFF_K + h * 64 + part * 16; const bf16* vp = kp + (OFF_V - OFF_K);
#pragma unroll
              for (int q = 0; q < 2; ++q) { float kf[8], vf[8]; unpack8(*(const v4u*)(kp + 8 * q), kf); unpack8(*(const v4u*)(vp + 8 * q), vf);
                  LAS float* kd = Ks + i * 64 + part * 16 + 8 * q; LAS float* vd = Vs + i * 64 + part * 16 + 8 * q;
#pragma unroll
                  for (int e = 0; e < 8; ++e) { kd[e] = kf[e]; vd[e] = vf[e]; } }
              const float* sf = ST + st_off(b, c, h, 0); const float* sb = ST + st_off(b, c, h, 1);
#pragma unroll
              for (int q = 0; q < 2; ++q) { const int o4 = (tid + NTHR * q) * 4; *(LAS f32x4*)(Sf + o4) = *(const f32x4*)(sf + o4); *(LAS f32x4*)(Sb + o4) = *(const f32x4*)(sb + o4); } }
            float qv[16];
            { const bf16* qp = P + (size_t)(row0 + i) * INC + OFF_Q + h * 64 + part * 16; unpack8(*(const v4u*)qp, qv); unpack8(*(const v4u*)(qp + 8), qv + 8); }
            const float lgf = log_sigmoid_f(a.in[8][l * 8 + h]), lgb = log_sigmoid_f(a.in[9][l * 8 + h]);
            __syncthreads();
            float o[16];
#pragma unroll
            for (int e = 0; e < 16; ++e) o[e] = 0.f;
#pragma unroll 1
            for (int j = 0; j < 128; ++j) {
                const LAS f32x4* kr = (const LAS f32x4*)(Ks + j * 64 + part * 16);
                float s = 0.f;
#pragma unroll
                for (int q = 0; q < 4; ++q) { const f32x4 k4 = kr[q]; s += qv[4 * q] * k4.x + qv[4 * q + 1] * k4.y + qv[4 * q + 2] * k4.z + qv[4 * q + 3] * k4.w; }
                s += __shfl_xor(s, 1); s += __shfl_xor(s, 2);
                const int rel = i - j;
                const float dec = rel > 0 ? expf(lgf * (float)rel) : (rel < 0 ? expf(lgb * (float)(-rel)) : 2.0f);
                s *= dec;
                const LAS f32x4* vr = (const LAS f32x4*)(Vs + j * 64 + part * 16);
#pragma unroll
                for (int q = 0; q < 4; ++q) { const f32x4 v4 = vr[q]; o[4 * q] += s * v4.x; o[4 * q + 1] += s * v4.y; o[4 * q + 2] += s * v4.z; o[4 * q + 3] += s * v4.w; }
            }
            float of[16], ob[16];
#pragma unroll
            for (int e = 0; e < 16; ++e) { of[e] = 0.f; ob[e] = 0.f; }
            __syncthreads();
#pragma unroll
            for (int dd = 0; dd < 16; ++dd) Ks[i * 64 + ((part * 16 + dd + i) & 63)] = qv[dd];
            __syncthreads();
#pragma unroll 2
            for (int d = 0; d < 64; ++d) { const float qd = Ks[i * 64 + ((d + i) & 63)];
                const LAS f32x4* fr = (const LAS f32x4*)(Sf + d * 64 + part * 16); const LAS f32x4* br = (const LAS f32x4*)(Sb + d * 64 + part * 16);
#pragma unroll
                for (int q = 0; q < 4; ++q) { const f32x4 f4 = fr[q], b4 = br[q];
                    of[4 * q] += qd * f4.x; of[4 * q + 1] += qd * f4.y; of[4 * q + 2] += qd * f4.z; of[4 * q + 3] += qd * f4.w;
                    ob[4 * q] += qd * b4.x; ob[4 * q + 1] += qd * b4.y; ob[4 * q + 2] += qd * b4.z; ob[4 * q + 3] += qd * b4.w; } }
            const float df = expf(lgf * (float)(i + 1)), db = expf(lgb * (float)(128 - i));
            float sum = 0.f;
#pragma unroll
            for (int e = 0; e < 16; ++e) { o[e] += df * of[e] + db * ob[e]; sum += o[e]; }
            sum += __shfl_xor(sum, 1); sum += __shfl_xor(sum, 2);
            const float mu = sum * (1.0f / 64.0f); float vs = 0.f;
#pragma unroll
            for (int e = 0; e < 16; ++e) { o[e] -= mu; vs += o[e] * o[e]; }
            vs += __shfl_xor(vs, 1); vs += __shfl_xor(vs, 2);
            const float rs = 1.0f / sqrtf(vs * (1.0f / 64.0f) + LN_EPS);
            float gv[16];
            { const bf16* gp = P + (size_t)(row0 + i) * INC + OFF_G + h * 64 + part * 16; unpack8(*(const v4u*)gp, gv); unpack8(*(const v4u*)(gp + 8), gv + 8); }
#pragma unroll
            for (int e = 0; e < 16; ++e) o[e] = (gv[e] / (1.0f + expf(-gv[e]))) * (o[e] * rs);
            bf16* yp = Y + (size_t)(row0 + i) * 1024 + 256 + h * 64 + part * 16;
            *(v4u*)yp = pack8(o); *(v4u*)(yp + 8) = pack8(o + 8);
        }
#endif
#ifndef NO_D3
        __syncthreads();
        {
            const bf16* vp = P + (size_t)(row0 + i) * INC + OFF_VV + part * 64;
            float sum = 0.f;
#pragma unroll 2
            for (int q = 0; q < 8; ++q) { float t8[8]; unpack8(*(const v4u*)(vp + 8 * q), t8);
#pragma unroll
                for (int e = 0; e < 8; ++e) sum += t8[e]; }
            sum += __shfl_xor(sum, 1); sum += __shfl_xor(sum, 2);
            const float mu = sum * (1.0f / 256.0f); float vs = 0.f;
#pragma unroll 2
            for (int q = 0; q < 8; ++q) { float t8[8]; unpack8(*(const v4u*)(vp + 8 * q), t8);
#pragma unroll
                for (int e = 0; e < 8; ++e) { const float dlt = t8[e] - mu; vs += dlt * dlt; } }
            vs += __shfl_xor(vs, 1); vs += __shfl_xor(vs, 2);
            const float rs = 1.0f / sqrtf(vs * (1.0f / 256.0f) + LN_EPS);
            LAS float* dst = VN + (part * 128 + i) * 64;
#pragma unroll 2
            for (int q = 0; q < 8; ++q) { float t8[8]; unpack8(*(const v4u*)(vp + 8 * q), t8);
                *(LAS f32x4*)(dst + 8 * q) = (f32x4){(t8[0] - mu) * rs, (t8[1] - mu) * rs, (t8[2] - mu) * rs, (t8[3] - mu) * rs};
                *(LAS f32x4*)(dst + 8 * q + 4) = (f32x4){(t8[4] - mu) * rs, (t8[5] - mu) * rs, (t8[6] - mu) * rs, (t8[7] - mu) * rs}; }
        }
        __syncthreads();
        for (int g = 0; g < 4; ++g) {
            float acc[16];
#pragma unroll
            for (int e = 0; e < 16; ++e) acc[e] = 0.f;
            const float* wrow = sguw + ((size_t)g * 128 + i) * 128;
            for (int q = 0; q < 128; q += 4) { const f32x4 w4 = *(const f32x4*)(wrow + q);
#pragma unroll
                for (int qq = 0; qq < 4; ++qq) { const float w = w4[qq]; const LAS f32x4* vr = (const LAS f32x4*)(VN + (g * 128 + q + qq) * 64 + part * 16);
#pragma unroll
                    for (int t = 0; t < 4; ++t) { const f32x4 v4 = vr[t]; acc[4 * t] += w * v4.x; acc[4 * t + 1] += w * v4.y; acc[4 * t + 2] += w * v4.z; acc[4 * t + 3] += w * v4.w; } } }
            const float bias = sgub[g * 128 + i];
            float uv[16];
            { const bf16* up = P + (size_t)(row0 + i) * INC + OFF_U + g * 64 + part * 16; unpack8(*(const v4u*)up, uv); unpack8(*(const v4u*)(up + 8), uv + 8); }
#pragma unroll
            for (int e = 0; e < 16; ++e) acc[e] = uv[e] * (acc[e] + bias);
            bf16* yp = Y + (size_t)(row0 + i) * 1024 + 768 + g * 64 + part * 16;
            *(v4u*)yp = pack8(acc); *(v4u*)(yp + 8) = pack8(acc + 8);
        }
#endif
        __syncthreads();
    }
}

__device__ __forceinline__ void phase_f(const Args& a, int l, LAS unsigned char* lds, int tid, int lane, int wave, bool dry = false) {
    LAS int* lcnt = (LAS int*)lds;
    __syncthreads();
    if (tid < 32) lcnt[tid] = 0;
    __syncthreads();
    const int gw = blockIdx.x * NWAVES + wave, NGW = gridDim.x * NWAVES, nrows = l == 0 ? NROWS : NLAT;
    const float* mod = (const float*)(a.ws + WS_MOD) + l * 9 * 6144;
    const float* lng = a.in[13] + l * 1024; const float* lnb = a.in[14] + l * 1024;
    const float* rgw = a.in[15] + l * 1024 * 4; const float* rgb = a.in[16] + l * 4; const float* rew = a.in[17] + (size_t)l * 4 * 1024 * 8; const float* reb = a.in[18] + l * 32;
    bf16* Hb = (bf16*)(a.ws + (dry ? WS_P + 160 * MiB : WS_HB)); unsigned* tok = (unsigned*)(a.ws + (dry ? WS_P + 240 * MiB : WS_TOK)); float* xctx = (float*)(a.ws + WS_XCTX);
    for (int row = gw; row < nrows; row += NGW) {
        float* xr = row < NLAT ? a.out + (size_t)row * 1024 : xctx + (size_t)(row - NLAT) * 1024;
        float* xw = dry ? (float*)(a.ws + WS_P) + (size_t)row * 1024 : xr;
        const float* m0 = mod + (row < NLAT ? (row >> 12) : 8) * 6144;
        f32x4 v[4]; float s = 0.f;
#pragma unroll
        for (int j = 0; j < 4; ++j) { v[j] = *(const f32x4*)(xr + (lane + 64 * j) * 4); s += (v[j].x + v[j].y) + (v[j].z + v[j].w); }
        const float mean = wave_sum(s) * (1.0f / 1024.0f); float s2 = 0.f;
#pragma unroll
        for (int j = 0; j < 4; ++j) { v[j] = v[j] - mean; s2 += (v[j].x * v[j].x + v[j].y * v[j].y) + (v[j].z * v[j].z + v[j].w * v[j].w); }
        const float rstd = 1.0f / sqrtf(wave_sum(s2) * (1.0f / 1024.0f) + LN_EPS);
        float lg[4] = {0.f, 0.f, 0.f, 0.f};
#pragma unroll
        for (int j = 0; j < 4; ++j) { const int idx = (lane + 64 * j) * 4;
            const f32x4 x1 = v[j] * rstd * *(const f32x4*)(lng + idx) + *(const f32x4*)(lnb + idx);
            *(f32x4*)(xw + idx) = x1;
            const f32x4 hm = x1 * (*(const f32x4*)(m0 + 4096 + idx) + 1.0f) + *(const f32x4*)(m0 + 3072 + idx);
            v[j] = hm;
            v2u w; w.x = pk2(hm.x, hm.y); w.y = pk2(hm.z, hm.w); *(v2u*)(Hb + (size_t)row * 1024 + idx) = w;
#pragma unroll
            for (int t = 0; t < 4; ++t) { const f32x4 w4 = *(const f32x4*)(rgw + (idx + t) * 4); const float hv = hm[t];
                lg[0] += hv * w4.x; lg[1] += hv * w4.y; lg[2] += hv * w4.z; lg[3] += hv * w4.w; } }
#pragma unroll
        for (int g = 0; g < 4; ++g) lg[g] = wave_sum(lg[g]) + rgb[g];
        int gi = 0; float gm = lg[0];
#pragma unroll
        for (int g = 1; g < 4; ++g) if (lg[g] > gm) { gm = lg[g]; gi = g; }
        float gden = 0.f;
#pragma unroll
        for (int g = 0; g < 4; ++g) gden += expf(lg[g] - gm);
        const float gprob = 1.0f / gden;
        float le[8] = {0.f, 0.f, 0.f, 0.f, 0.f, 0.f, 0.f, 0.f};
        const float* rw = rew + (size_t)gi * 1024 * 8;
#pragma unroll
        for (int j = 0; j < 4; ++j) { const int idx = (lane + 64 * j) * 4;
#pragma unroll
            for (int t = 0; t < 4; ++t) { const f32x4 w0 = *(const f32x4*)(rw + (idx + t) * 8), w1 = *(const f32x4*)(rw + (idx + t) * 8 + 4); const float hv = v[j][t];
                le[0] += hv * w0.x; le[1] += hv * w0.y; le[2] += hv * w0.z; le[3] += hv * w0.w; le[4] += hv * w1.x; le[5] += hv * w1.y; le[6] += hv * w1.z; le[7] += hv * w1.w; } }
#pragma unroll
        for (int e = 0; e < 8; ++e) le[e] = wave_sum(le[e]) + reb[gi * 8 + e];
        int i1 = 0; float m1 = le[0];
#pragma unroll
        for (int e = 1; e < 8; ++e) if (le[e] > m1) { m1 = le[e]; i1 = e; }
        int i2 = -1; float m2 = -3.0e38f;
#pragma unroll
        for (int e = 0; e < 8; ++e) if (e != i1 && le[e] > m2) { m2 = le[e]; i2 = e; }
        const float p2 = expf(m2 - m1), inv = 1.0f / (1.0f + p2);
        const float gate0 = gprob * inv, gate1 = gprob * p2 * inv;
        if (lane == 0) { const int e0 = gi * 8 + i1, e1 = gi * 8 + i2;
            const int p0 = __hip_atomic_fetch_add(lcnt + e0, 1, __ATOMIC_RELAXED, __HIP_MEMORY_SCOPE_WORKGROUP);
            const int p1 = __hip_atomic_fetch_add(lcnt + e1, 1, __ATOMIC_RELAXED, __HIP_MEMORY_SCOPE_WORKGROUP);
            unsigned* t = tok + (size_t)row * 8; t[0] = (unsigned)e0 | ((unsigned)e1 << 8); t[1] = (unsigned)p0; t[2] = (unsigned)p1;
            t[4] = __builtin_bit_cast(unsigned, gate0); t[5] = __builtin_bit_cast(unsigned, gate1); }
    }
    __syncthreads();
    if (tid < 32 && !dry) ((unsigned*)(a.ws + WS_CTL))[CW_WGCNT + (l * 256 + blockIdx.x) * 32 + tid] = (unsigned)lcnt[tid];
    __syncthreads();
}

__device__ __forceinline__ void phase_g(const Args& a, int l, LAS unsigned char* lds, int tid, int lane, int wave) {
    LAS int* cn = (LAS int*)lds; LAS int* base = (LAS int*)(lds + 32768); LAS int* pst = base + 32; LAS int* totl = base + 80;
    unsigned* ctl = (unsigned*)(a.ws + WS_CTL);
    __syncthreads();
    for (int i = tid; i < 256 * 32; i += NTHR) cn[i] = (int)ctl[CW_WGCNT + l * 256 * 32 + i];
    __syncthreads();
    if (tid < 32) { int tot = 0, bs = 0; for (int w = 0; w < 256; ++w) { const int v = cn[w * 32 + tid]; if (w < (int)blockIdx.x) bs += v; tot += v; } base[tid] = bs; totl[tid] = tot; }
    __syncthreads();
    if (tid == 0) { int run = 0; for (int e = 0; e < 32; ++e) { pst[e] = run; run += ((totl[e] + 255) >> 8) << 8; } pst[32] = run; }
    __syncthreads();
    if (blockIdx.x == 0 && tid < 32) ctl[CW_TOT + l * 64 + tid] = (unsigned)totl[tid];
    const int gw = blockIdx.x * NWAVES + wave, NGW = gridDim.x * NWAVES, nrows = l == 0 ? NROWS : NLAT;
    const bf16* Hb = (const bf16*)(a.ws + WS_HB); bf16* XB = (bf16*)(a.ws + WS_XB); unsigned* tok = (unsigned*)(a.ws + WS_TOK);
    (void)gw; (void)NGW; (void)Hb; (void)XB;
    int* rowof = (int*)(a.ws + WS_ROWOF);
    if (blockIdx.x < 32 && tid < 256) { const int e = blockIdx.x, pad = pst[e + 1] - pst[e] - totl[e]; if (tid < pad) rowof[pst[e] + totl[e] + tid] = 0; }
    for (int T = blockIdx.x; T < (nrows >> 5); T += gridDim.x) {
        const int row = 32 * T + (tid >> 4);
        if ((tid & 15) == 0) { unsigned* t = tok + (size_t)row * 8; const unsigned ee = t[0]; const int e0 = ee & 255, e1 = (ee >> 8) & 255;
            const int s0 = pst[e0] + base[e0] + (int)t[1], s1 = pst[e1] + base[e1] + (int)t[2];
            t[6] = (unsigned)s0; t[7] = (unsigned)s1; rowof[s0] = row; rowof[s1] = row; }
    }
    __syncthreads();
}

__device__ __forceinline__ int build_p2e(const Args& a, int l, LAS unsigned char* lds, int tid) {
    LAS unsigned char* p2e = lds + P2E_OFF; LAS int* np = (LAS int*)(lds + PST_OFF);
    const unsigned* ctl = (const unsigned*)(a.ws + WS_CTL);
    __syncthreads();
    if (tid == 0) { int pm = 0; for (int e = 0; e < 32; ++e) { const int n = ((int)ctl[CW_TOT + l * 64 + e] + 255) >> 8; for (int k = 0; k < n && pm < MAXPANELS; ++k) p2e[pm++] = (unsigned char)e; } np[0] = pm; }
    __syncthreads();
    return np[0];
}

struct JRow { v2u x[4]; v2u y0[4], y1[4]; float g0, g1; };
__device__ __forceinline__ void j_issue(JRow& R, const float* xr, const bf16* Y, const v4u tk, int lane) {
    const unsigned gx = tk.x, gy = tk.y;
    R.g0 = __builtin_bit_cast(float, gx); R.g1 = __builtin_bit_cast(float, gy);
    const bf16* y0 = Y + (size_t)tk.z * 1024; const bf16* y1 = Y + (size_t)tk.w * 1024;
#pragma unroll
    for (int j = 0; j < 4; ++j) { const int idx = (lane + 64 * j) * 4; R.x[j] = *(const v2u*)((const bf16*)xr + 1024 + idx); R.y0[j] = *(const v2u*)(y0 + idx); R.y1[j] = *(const v2u*)(y1 + idx); }
}
__device__ __forceinline__ void j_finish(const JRow& R, float* xw, bf16* hrow, const float* m0, const float* m1, const float* lng, const float* lnb, int lane) {
    f32x4 v[4]; float s = 0.f;
#pragma unroll
    for (int j = 0; j < 4; ++j) { const int idx = (lane + 64 * j) * 4; const v2u w0 = R.y0[j], w1 = R.y1[j];
        const f32x4 ya = (f32x4){bflo(w0.x), bfhi(w0.x), bflo(w0.y), bfhi(w0.y)}, yb = (f32x4){bflo(w1.x), bfhi(w1.x), bflo(w1.y), bfhi(w1.y)};
        const v2u xw = R.x[j]; const f32x4 x1 = (f32x4){bflo(xw.x), bfhi(xw.x), bflo(xw.y), bfhi(xw.y)};
        v[j] = x1 * ALPHA + *(const f32x4*)(m0 + 5120 + idx) * (ya * R.g0 + yb * R.g1);
        s += (v[j].x + v[j].y) + (v[j].z + v[j].w); }
    const float mean = wave_sum(s) * (1.0f / 1024.0f); float s2 = 0.f;
#pragma unroll
    for (int j = 0; j < 4; ++j) { v[j] = v[j] - mean; s2 += (v[j].x * v[j].x + v[j].y * v[j].y) + (v[j].z * v[j].z + v[j].w * v[j].w); }
    const float rstd = 1.0f / sqrtf(wave_sum(s2) * (1.0f / 1024.0f) + LN_EPS);
#pragma unroll
    for (int j = 0; j < 4; ++j) { const int idx = (lane + 64 * j) * 4;
        const f32x4 x2 = v[j] * rstd * *(const f32x4*)(lng + idx) + *(const f32x4*)(lnb + idx);
        *(f32x4*)(xw + idx) = x2;
        if (hrow) { const f32x4 hh = x2 * (*(const f32x4*)(m1 + 1024 + idx) + 1.0f) + *(const f32x4*)(m1 + idx);
            v2u w; w.x = cvtpk(hh.x, hh.y); w.y = cvtpk(hh.z, hh.w); *(v2u*)(hrow + idx) = w; } }
}
__device__ __forceinline__ void phase_j(const Args& a, int l, int lane, int wave, bool dry = false) {
    const int gw = blockIdx.x * NWAVES + wave, NGW = gridDim.x * NWAVES, nrows = l == 0 ? NROWS : NLAT;
    const float* mod = (const float*)(a.ws + WS_MOD) + l * 9 * 6144; const float* modn = (const float*)(a.ws + WS_MOD) + 9 * 6144;
    const float* lng = a.in[22] + l * 1024; const float* lnb = a.in[23] + l * 1024;
    bf16* Hb = (bf16*)(a.ws + WS_HB); const bf16* Y = (const bf16*)(a.ws + WS_Y); const unsigned* tok = (const unsigned*)(a.ws + WS_TOK); float* xctx = (float*)(a.ws + WS_XCTX);
    for (int rowA = gw; rowA < nrows; rowA += 2 * NGW) {
        const int rowB = rowA + NGW; const bool hasB = rowB < nrows;
        const v4u tA = *(const v4u*)(tok + (size_t)rowA * 8 + 4); const v4u tB = hasB ? *(const v4u*)(tok + (size_t)rowB * 8 + 4) : tA;
        float* xrA = rowA < NLAT ? a.out + (size_t)rowA * 1024 : xctx + (size_t)(rowA - NLAT) * 1024;
        const int rB = hasB ? rowB : rowA;
        float* xrB = rB < NLAT ? a.out + (size_t)rB * 1024 : xctx + (size_t)(rB - NLAT) * 1024;
        JRow RA, RB;
        j_issue(RA, xrA, Y, tA, lane); j_issue(RB, xrB, Y, tB, lane);
        const int mA = rowA < NLAT ? (rowA >> 12) : 8, mB = rB < NLAT ? (rB >> 12) : 8;
        j_finish(RA, dry ? (float*)(a.ws + WS_HH) + (size_t)rowA * 1024 : xrA, (l == 0 && !dry) ? Hb + (size_t)rowA * 1024 : nullptr, mod + mA * 6144, modn + mA * 6144, lng, lnb, lane);
        if (hasB) j_finish(RB, dry ? (float*)(a.ws + WS_HH) + (size_t)rowB * 1024 : xrB, (l == 0 && !dry) ? Hb + (size_t)rowB * 1024 : nullptr, mod + mB * 6144, modn + mB * 6144, lng, lnb, lane);
    }
}
typedef short bf16x8 __attribute__((ext_vector_type(8)));
typedef short s16x4 __attribute__((ext_vector_type(4)));
typedef short v4i16_t __attribute__((ext_vector_type(4)));
typedef float f32x16 __attribute__((ext_vector_type(16)));
#define MFMA32(a, b, c) __builtin_amdgcn_mfma_f32_32x32x16_bf16((a), (b), (c), 0, 0, 0)
__device__ __forceinline__ int crow(int reg, int hf) { return (reg & 3) + 8 * (reg >> 2) + 4 * hf; }
__device__ __forceinline__ int tro(int r, int b) { return r * 128 + (b ^ (((r >> 1) & 1) << 6)); }
__device__ __forceinline__ int rro(int r, int c16) { return r * 128 + ((c16 ^ ((r >> 1) & 7)) << 4); }
__device__ __forceinline__ s16x4 tr4(const LAS unsigned char* p) { return __builtin_bit_cast(s16x4, __builtin_amdgcn_ds_read_tr16_b64_v4i16((LAS v4i16_t*)p)); }
__device__ __forceinline__ bf16x8 tr_frag(const LAS unsigned char* img, int rlo, int rhi, int colbyte) {
    const s16x4 lo = tr4(img + tro(rlo, colbyte)), hi = tr4(img + tro(rhi, colbyte));
    return (bf16x8){lo[0], lo[1], lo[2], lo[3], hi[0], hi[1], hi[2], hi[3]};
}

#ifndef ST_TRANSPOSED
#define ST_TRANSPOSED 1
#endif
__device__ __forceinline__ void phase_b_mfma(const Args& a, int l, LAS unsigned char* lds, int tid, int lane, int wave) {
    const bf16* P = (const bf16*)(a.ws + WS_P); bf16* ST = (bf16*)(a.ws + WS_ST);
    const int r32 = lane & 31, hf = lane >> 5, q4 = (lane & 15) >> 2, p4 = lane & 3, blk = (lane >> 4) & 1;
    v4u kw[4], vw[4];
#define B_LOAD(uu) do { const int b_ = (uu) / (NCH * 4), c_ = ((uu) % (NCH * 4)) >> 2, h0_ = ((uu) & 3) * 2; const int r0_ = chunk_row0(b_, c_); \
        _Pragma("unroll") for (int k = 0; k < 4; ++k) { const int ci = tid + NTHR * k, hh = ci >> 10, row = (ci & 1023) >> 3, c16 = ci & 7; \
            const bf16* src = P + (size_t)(r0_ + row) * INC + (h0_ + hh) * 64 + c16 * 8; kw[k] = *(const v4u*)(src + OFF_K); vw[k] = *(const v4u*)(src + OFF_V); } } while (0)
    if ((int)blockIdx.x < 8 * NCH * 4) B_LOAD((int)blockIdx.x);
    for (int u = blockIdx.x; u < 8 * NCH * 4; u += gridDim.x) {
        const int b = u / (NCH * 4), c = (u % (NCH * 4)) >> 2, h0 = (u & 3) * 2;
        __syncthreads();
#pragma unroll
        for (int k = 0; k < 4; ++k) {
            const int ci = tid + NTHR * k, hh = ci >> 10, row = (ci & 1023) >> 3, c16 = ci & 7, h = h0 + hh;
            LAS unsigned char* base = lds + hh * 49152;
            *(LAS v4u*)(base + tro(row, c16 * 16)) = kw[k];
            const float* lgt = (const float*)(a.ws + WS_LG) + (l * 8 + h) * 2; const float lgf = lgt[0], lgb = lgt[1];
            const float wf = __expf(lgf * (float)(127 - row)), wb = __expf(lgb * (float)row);
            float v[8]; unpack8(vw[k], v);
            v4u of, ob;
            of.x = cvtpk(v[0] * wf, v[1] * wf); of.y = cvtpk(v[2] * wf, v[3] * wf); of.z = cvtpk(v[4] * wf, v[5] * wf); of.w = cvtpk(v[6] * wf, v[7] * wf);
            ob.x = cvtpk(v[0] * wb, v[1] * wb); ob.y = cvtpk(v[2] * wb, v[3] * wb); ob.z = cvtpk(v[4] * wb, v[5] * wb); ob.w = cvtpk(v[6] * wb, v[7] * wb);
            *(LAS v4u*)(base + 16384 + tro(row, c16 * 16)) = of;
            *(LAS v4u*)(base + 32768 + tro(row, c16 * 16)) = ob;
        }
        __syncthreads();
        if (u + (int)gridDim.x < 8 * NCH * 4) B_LOAD(u + (int)gridDim.x);
        const int hh = wave >> 2, dir = (wave >> 1) & 1, et = wave & 1;
        const LAS unsigned char* kimg = lds + hh * 49152; const LAS unsigned char* vimg = kimg + 16384 + dir * 16384;
        f32x16 acc[2];
#pragma unroll
        for (int i = 0; i < 16; ++i) { acc[0][i] = 0.f; acc[1][i] = 0.f; }
#pragma unroll
        for (int ks = 0; ks < 8; ++ks) {
            const int rlo = 16 * ks + 8 * hf + q4;
            const bf16x8 Bv = tr_frag(vimg, rlo, rlo + 4, (et * 32 + 16 * blk + 4 * p4) * 2);
#pragma unroll
            for (int dt = 0; dt < 2; ++dt) { const bf16x8 Ak = tr_frag(kimg, rlo, rlo + 4, (dt * 32 + 16 * blk + 4 * p4) * 2); acc[dt] = MFMA32(Ak, Bv, acc[dt]); }
        }
        bf16* dst = ST + st_off(b, c, h0 + hh, dir) + (size_t)(et * 32 + r32) * 64;
#pragma unroll
        for (int dt = 0; dt < 2; ++dt)
#pragma unroll
            for (int g4 = 0; g4 < 4; ++g4) { v2u w; w.x = cvtpk(acc[dt][4 * g4], acc[dt][4 * g4 + 1]); w.y = cvtpk(acc[dt][4 * g4 + 2], acc[dt][4 * g4 + 3]);
                *(v2u*)(dst + dt * 32 + 8 * g4 + 4 * hf) = w; }
    }
#undef B_LOAD
    __syncthreads();
}
__device__ __forceinline__ bf16x8 scale_frag(const bf16x8 q, float sc) {
    const v4u w = __builtin_bit_cast(v4u, q); v4u o;
    o.x = cvtpk(bflo(w.x) * sc, bfhi(w.x) * sc); o.y = cvtpk(bflo(w.y) * sc, bfhi(w.y) * sc); o.z = cvtpk(bflo(w.z) * sc, bfhi(w.z) * sc); o.w = cvtpk(bflo(w.w) * sc, bfhi(w.w) * sc);
    return __builtin_bit_cast(bf16x8, o);
}
__device__ __forceinline__ bf16x8 f32x8_to_frag(const f32x4 a0, const f32x4 a1) {
    v4u o; o.x = cvtpk(a0.x, a0.y); o.y = cvtpk(a0.z, a0.w); o.z = cvtpk(a1.x, a1.y); o.w = cvtpk(a1.z, a1.w); return __builtin_bit_cast(bf16x8, o);
}
struct ConvIn { v4u cb, c0, x0, cp, xp, cn, xn; };
__device__ __forceinline__ void conv_load(ConvIn& I, const bf16* P, int row0, int c, bool isc, int idx) {
    const int p = idx >> 5, ch0 = (idx & 31) * 8; const int row = row0 + p;
    int dprev = -1, dnext = 1; bool vprev, vnext;
    if (isc) { const int t = c * 128 + p; vprev = t > 0; vnext = t < 255; }
    else { const int t = (c - 2) * 128 + p;
        if (ch0 < 128) { const int col = t & 63; vprev = col > 0; vnext = col < 63; }
        else { const int rg = t >> 6; vprev = rg > 0; vnext = rg < 63; dprev = -64; dnext = 64; } }
    const bf16* pr = P + (size_t)row * INC; const v4u z = (v4u){0u, 0u, 0u, 0u};
    I.cb = *(const v4u*)(pr + OFF_CB + ch0); I.c0 = *(const v4u*)(pr + OFF_CC + ch0); I.x0 = *(const v4u*)(pr + OFF_CX + ch0);
    I.cp = z; I.xp = z; I.cn = z; I.xn = z;
    if (vprev) { const bf16* q = pr + (ptrdiff_t)dprev * INC; I.cp = *(const v4u*)(q + OFF_CC + ch0); I.xp = *(const v4u*)(q + OFF_CX + ch0); }
    if (vnext) { const bf16* q = pr + (ptrdiff_t)dnext * INC; I.cn = *(const v4u*)(q + OFF_CC + ch0); I.xn = *(const v4u*)(q + OFF_CX + ch0); }
}
__device__ __forceinline__ void conv_store(const ConvIn& I, bf16* Y, const float* convw, int row0, int idx) {
    const int p = idx >> 5, ch0 = (idx & 31) * 8;
    float cb[8], a0[8], a1[8], o[8], zc, zp, zn;
    unpack8(I.cb, cb);
    unpack8(I.c0, a0); unpack8(I.x0, a1);
#pragma unroll
    for (int i = 0; i < 8; ++i) o[i] = convw[256 + ch0 + i] * (a0[i] * a1[i]);
    unpack8(I.cp, a0); unpack8(I.xp, a1);
#pragma unroll
    for (int i = 0; i < 8; ++i) o[i] += convw[ch0 + i] * (a0[i] * a1[i]);
    unpack8(I.cn, a0); unpack8(I.xn, a1);
#pragma unroll
    for (int i = 0; i < 8; ++i) o[i] = cb[i] * (o[i] + convw[512 + ch0 + i] * (a0[i] * a1[i]));
    (void)zc; (void)zp; (void)zn;
    *(v4u*)(Y + (size_t)(row0 + p) * 1024 + ch0) = pack8(o);
}
__device__ __forceinline__ void phase_d_mfma(const Args& a, int l, LAS unsigned char* lds, int tid, int lane, int wave) {
    const bf16* P = (const bf16*)(a.ws + WS_P); const bf16* ST = (const bf16*)(a.ws + WS_ST); bf16* Y = (bf16*)(a.ws + WS_YMIX);
    const float* convw = a.in[7] + l * 3 * 256; const float* sguw = a.in[10] + (size_t)l * 4 * 128 * 128; const float* sgub = a.in[11] + l * 4 * 128;
    const int c_lo = l == 1 ? 2 : 0, cpb = NCH - c_lo, nunits = 8 * cpb;
#define LANEC int ln_ = lane; asm volatile("" : "+v"(ln_)); const int r32 = ln_ & 31, hf = ln_ >> 5, q4 = (ln_ & 15) >> 2, p4 = ln_ & 3, blk = (ln_ >> 4) & 1; (void)q4; (void)p4; (void)blk
    unsigned* dq = (unsigned*)(a.ws + WS_CTL) + CW_DQ + l * 64; LAS int* dqw = (LAS int*)(lds + DQ_OFF);
    const int npass = 2 * nunits, total = 4 * nunits;
    __syncthreads();
    if (tid == 0) dqw[0] = (int)__hip_atomic_fetch_add(dq, 1u, __ATOMIC_RELAXED, __HIP_MEMORY_SCOPE_AGENT);
    __syncthreads();
    int item = __builtin_amdgcn_readfirstlane(dqw[0]);
    while (item < total) {
        int nxt = 0;
        if (tid == 0) nxt = (int)__hip_atomic_fetch_add(dq, 1u, __ATOMIC_RELAXED, __HIP_MEMORY_SCOPE_AGENT);
        const int type = item < npass ? 0 : (item < npass + nunits ? 1 : 2);
        const int u = type == 0 ? (item >> 1) : (type == 1 ? item - npass : item - npass - nunits), pass = item & 1;
        const int b = u / cpb, c = c_lo + u % cpb; const int row0 = chunk_row0(b, c); const bool isc = c < 2;
        if (type == 2) {
#pragma unroll 1
            for (int idx = tid; idx < 128 * 32; idx += 2 * NTHR) {
                ConvIn I0, I1;
                conv_load(I0, P, row0, c, isc, idx); conv_load(I1, P, row0, c, isc, idx + NTHR);
                conv_store(I0, Y, convw, row0, idx); conv_store(I1, Y, convw, row0, idx + NTHR);
            }
        }
#ifndef NO_D2
        if (type == 0) {
            LANEC;
            const int hd = wave >> 1, ih = wave & 1, h = pass * 4 + hd;
            const LAS unsigned char* kimg = lds + hd * 32768; const LAS unsigned char* vimg = kimg + 16384;
            const float* lgt = (const float*)(a.ws + WS_LG) + (l * 8 + h) * 2; const float lg2f = lgt[0] * 1.44269504088896f, lg2b = lgt[1] * 1.44269504088896f;
            bf16x8 qf[2][4];
#pragma unroll
            for (int t = 0; t < 2; ++t)
#pragma unroll
                for (int s = 0; s < 4; ++s) qf[t][s] = *(const bf16x8*)(P + (size_t)(row0 + (2 * ih + t) * 32 + r32) * INC + OFF_Q + h * 64 + 16 * s + 8 * hf);
#define D_SFR(dst, dir) do { const bf16* sp_ = ST + st_off(b, c, h, dir) + r32 * 64 + 8 * hf; _Pragma("unroll") for (int s = 0; s < 4; ++s) _Pragma("unroll") for (int et = 0; et < 2; ++et) dst[s][et] = *(const bf16x8*)(sp_ + et * 2048 + 16 * s); } while (0)
#define D_STG_LD(k0) do { _Pragma("unroll") for (int k = 0; k < 4; ++k) { int to_ = tid; asm volatile("" : "+v"(to_)); const int ci = to_ + NTHR * ((k0) + k), tile = ci >> 10, hdd = tile >> 1, isv = tile & 1, row = (ci & 1023) >> 3, c16 = ci & 7; \
                stg[k] = *(const v4u*)(P + (size_t)(row0 + row) * INC + (isv ? OFF_V : OFF_K) + (pass * 4 + hdd) * 64 + c16 * 8); } } while (0)
#define D_STG_ST(k0) do { _Pragma("unroll") for (int k = 0; k < 4; ++k) { int to_ = tid; asm volatile("" : "+v"(to_)); const int ci = to_ + NTHR * ((k0) + k), tile = ci >> 10, hdd = tile >> 1, isv = tile & 1, row = (ci & 1023) >> 3, c16 = ci & 7; \
                *(LAS v4u*)(lds + hdd * 32768 + isv * 16384 + (isv ? tro(row, c16 * 16) : rro(row, c16))) = stg[k]; } } while (0)
#define D_CROSS(sf, dir) do { const int i0 = 2 * ih * 32 + r32; \
                const float sc0 = (dir) == 0 ? __builtin_amdgcn_exp2f(lg2f * (float)(i0 + 1)) : __builtin_amdgcn_exp2f(lg2b * (float)(128 - i0)); \
                const float sc1 = (dir) == 0 ? __builtin_amdgcn_exp2f(lg2f * (float)(i0 + 33)) : __builtin_amdgcn_exp2f(lg2b * (float)(96 - i0)); \
                _Pragma("unroll") for (int s = 0; s < 4; ++s) { const bf16x8 qs0 = scale_frag(qf[0][s], sc0), qs1 = scale_frag(qf[1][s], sc1); \
                    _Pragma("unroll") for (int et = 0; et < 2; ++et) { acc[0][et] = MFMA32(sf[s][et], qs0, acc[0][et]); acc[1][et] = MFMA32(sf[s][et], qs1, acc[1][et]); } } } while (0)
            bf16x8 sf0[4][2]; v4u stg[4];
            D_SFR(sf0, 0);
            D_STG_LD(0);
            f32x16 acc[2][2];
#pragma unroll
            for (int t = 0; t < 2; ++t)
#pragma unroll
                for (int et = 0; et < 2; ++et)
#pragma unroll
                    for (int r = 0; r < 16; ++r) acc[t][et][r] = 0.f;
            asm volatile("" ::: "memory");
            D_CROSS(sf0, 0);
            asm volatile("" ::: "memory");
            bf16x8 sf1[4][2];
            D_SFR(sf1, 1);
            D_STG_ST(0);
            asm volatile("" ::: "memory");
            D_STG_LD(4);
            asm volatile("" ::: "memory");
            D_CROSS(sf1, 1);
            asm volatile("" ::: "memory");
            D_STG_ST(4);
            asm volatile("" ::: "memory");
            D_STG_LD(8); D_STG_ST(8);
            asm volatile("" ::: "memory");
            D_STG_LD(12); D_STG_ST(12);
#undef D_SFR
#undef D_STG_LD
#undef D_STG_ST
#undef D_CROSS
            __syncthreads();
#pragma unroll
            for (int t = 0; t < 2; ++t) {
                const int it = 2 * ih + t;
                bf16x8 qq[4];
                if (t == 0) {
#pragma unroll
                    for (int s = 0; s < 4; ++s) qq[s] = qf[0][s];
                } else {
                    asm volatile("" ::: "memory");
#pragma unroll
                    for (int s = 0; s < 4; ++s) qq[s] = *(const bf16x8*)(P + (size_t)(row0 + it * 32 + r32) * INC + OFF_Q + h * 64 + 16 * s + 8 * hf);
                }
#pragma unroll 1
                for (int jt = 0; jt < 4; ++jt) {
                    f32x16 X;
#pragma unroll
                    for (int r = 0; r < 16; ++r) X[r] = 0.f;
#pragma unroll
                    for (int s = 0; s < 4; ++s) { const bf16x8 Kf = *(const LAS bf16x8*)(kimg + rro(jt * 32 + r32, 2 * s + hf)); X = MFMA32(Kf, qq[s], X); }
                    const int rel0 = (it - jt) * 32 + r32 - 4 * hf;
#pragma unroll
                    for (int r = 0; r < 16; ++r) { const int rel = rel0 - ((r & 3) + 8 * (r >> 2));
                        const float x = rel > 0 ? lg2f * (float)rel : lg2b * (float)(-rel);
                        const float dcy = rel == 0 ? 2.0f : __builtin_amdgcn_exp2f(x);
                        X[r] *= dcy; }
#pragma unroll
                    for (int s2 = 0; s2 < 2; ++s2) {
                        v4u pk; pk.x = cvtpk(X[8 * s2], X[8 * s2 + 1]); pk.y = cvtpk(X[8 * s2 + 2], X[8 * s2 + 3]); pk.z = cvtpk(X[8 * s2 + 4], X[8 * s2 + 5]); pk.w = cvtpk(X[8 * s2 + 6], X[8 * s2 + 7]);
                        const bf16x8 Pk = __builtin_bit_cast(bf16x8, pk);
                        const int rlo = jt * 32 + 16 * s2 + 4 * hf + q4;
#pragma unroll
                        for (int et = 0; et < 2; ++et) { const bf16x8 Vt = tr_frag(vimg, rlo, rlo + 8, (et * 32 + 16 * blk + 4 * p4) * 2); acc[t][et] = MFMA32(Vt, Pk, acc[t][et]); }
                    }
                }
                const int row = row0 + (2 * ih + t) * 32 + r32;
                float sum = 0.f;
#pragma unroll
                for (int et = 0; et < 2; ++et)
#pragma unroll
                    for (int r = 0; r < 16; ++r) sum += acc[t][et][r];
                sum += __shfl_xor(sum, 32);
                const float mu = sum * (1.0f / 64.0f); float vs = 0.f;
#pragma unroll
                for (int et = 0; et < 2; ++et)
#pragma unroll
                    for (int r = 0; r < 16; ++r) { const float dlt = acc[t][et][r] - mu; vs += dlt * dlt; }
                vs += __shfl_xor(vs, 32);
                const float rs = 1.0f / sqrtf(vs * (1.0f / 64.0f) + LN_EPS);
#pragma unroll
                for (int et = 0; et < 2; ++et)
#pragma unroll
                    for (int g4 = 0; g4 < 4; ++g4) { const int e0 = et * 32 + 8 * g4 + 4 * hf;
                        const v2u gw = *(const v2u*)(P + (size_t)row * INC + OFF_G + h * 64 + e0);
                        const float g0 = bflo(gw.x), g1 = bfhi(gw.x), g2 = bflo(gw.y), g3 = bfhi(gw.y);
                        const float o0 = (acc[t][et][4 * g4] - mu) * rs, o1 = (acc[t][et][4 * g4 + 1] - mu) * rs, o2 = (acc[t][et][4 * g4 + 2] - mu) * rs, o3 = (acc[t][et][4 * g4 + 3] - mu) * rs;
                        v2u w; w.x = cvtpk(g0 / (1.0f + __expf(-g0)) * o0, g1 / (1.0f + __expf(-g1)) * o1); w.y = cvtpk(g2 / (1.0f + __expf(-g2)) * o2, g3 / (1.0f + __expf(-g3)) * o3);
                        *(v2u*)(Y + (size_t)row * 1024 + 256 + h * 64 + e0) = w; }
            }
        }
#endif
#ifndef NO_D3
        if (type == 1) {
            LANEC;
            const int g = wave >> 1, ph = wave & 1;
            bf16x8 Bw[8][2];
            { const bf16* wp = (const bf16*)(a.ws + WS_SGUW) + ((size_t)(l * 4 + g) * 128 + ph * 64 + r32) * 128 + 8 * hf;
#pragma unroll
              for (int ks = 0; ks < 8; ++ks)
#pragma unroll
                  for (int pt = 0; pt < 2; ++pt) Bw[ks][pt] = *(const bf16x8*)(wp + pt * 32 * 128 + 16 * ks); }
            {
                int tq_ = tid; asm volatile("" : "+v"(tq_));
                const int i = tq_ >> 2, part = tq_ & 3;
                const bf16* vp = P + (size_t)(row0 + i) * INC + OFF_VV + part * 64;
                v4u raw[8];
#pragma unroll
                for (int q = 0; q < 8; ++q) raw[q] = *(const v4u*)(vp + 8 * q);
                float sum = 0.f;
#pragma unroll
                for (int q = 0; q < 8; ++q) { float t8[8]; unpack8(raw[q], t8);
#pragma unroll
                    for (int e2 = 0; e2 < 8; ++e2) sum += t8[e2]; }
                sum += __shfl_xor(sum, 1); sum += __shfl_xor(sum, 2);
                const float mu = sum * (1.0f / 256.0f); float vs = 0.f;
#pragma unroll
                for (int q = 0; q < 8; ++q) { float t8[8]; unpack8(raw[q], t8);
#pragma unroll
                    for (int e2 = 0; e2 < 8; ++e2) { const float dlt = t8[e2] - mu; vs += dlt * dlt; } }
                vs += __shfl_xor(vs, 1); vs += __shfl_xor(vs, 2);
                const float rs = 1.0f / sqrtf(vs * (1.0f / 256.0f) + LN_EPS);
#pragma unroll
                for (int q = 0; q < 8; ++q) { float t8[8]; unpack8(raw[q], t8);
                    v4u w; w.x = cvtpk((t8[0] - mu) * rs, (t8[1] - mu) * rs); w.y = cvtpk((t8[2] - mu) * rs, (t8[3] - mu) * rs); w.z = cvtpk((t8[4] - mu) * rs, (t8[5] - mu) * rs); w.w = cvtpk((t8[6] - mu) * rs, (t8[7] - mu) * rs);
                    *(LAS v4u*)(lds + part * 16384 + tro(i, q * 16)) = w; }
            }
            __syncthreads();
            const LAS unsigned char* vn = lds + g * 16384;
            f32x16 acc[2][2];
#pragma unroll
            for (int ct = 0; ct < 2; ++ct)
#pragma unroll
                for (int pt = 0; pt < 2; ++pt)
#pragma unroll
                    for (int r = 0; r < 16; ++r) acc[ct][pt][r] = 0.f;
#pragma unroll
            for (int ks = 0; ks < 8; ++ks) {
                const int rlo = 16 * ks + 8 * hf + q4;
                bf16x8 A[2];
#pragma unroll
                for (int ct = 0; ct < 2; ++ct) A[ct] = tr_frag(vn, rlo, rlo + 4, (ct * 32 + 16 * blk + 4 * p4) * 2);
#pragma unroll
                for (int ct = 0; ct < 2; ++ct)
#pragma unroll
                    for (int pt = 0; pt < 2; ++pt) acc[ct][pt] = MFMA32(A[ct], Bw[ks][pt], acc[ct][pt]);
            }
#pragma unroll
            for (int pt = 0; pt < 2; ++pt) {
                const int p = ph * 64 + pt * 32 + r32; const int row = row0 + p; const float bias = sgub[g * 128 + p];
#pragma unroll
                for (int ct = 0; ct < 2; ++ct)
#pragma unroll
                    for (int g4 = 0; g4 < 4; ++g4) { const int c0 = ct * 32 + 8 * g4 + 4 * hf;
                        const v2u uw = *(const v2u*)(P + (size_t)row * INC + OFF_U + g * 64 + c0);
                        v2u w; w.x = cvtpk(bflo(uw.x) * (acc[ct][pt][4 * g4] + bias), bfhi(uw.x) * (acc[ct][pt][4 * g4 + 1] + bias));
                        w.y = cvtpk(bflo(uw.y) * (acc[ct][pt][4 * g4 + 2] + bias), bfhi(uw.y) * (acc[ct][pt][4 * g4 + 3] + bias));
                        *(v2u*)(Y + (size_t)row * 1024 + 768 + g * 64 + c0) = w; }
            }
        }
#endif
        __syncthreads();
        if (tid == 0) dqw[0] = nxt;
        __syncthreads();
        item = __builtin_amdgcn_readfirstlane(dqw[0]);
    }
}

__device__ __forceinline__ void phase_f2(const Args& a, int l, LAS unsigned char* lds, int tid, int lane, int wave) {
    LAS int* lcnt = (LAS int*)(lds + LCNT_OFF); LAS float* LG = (LAS float*)(lds + LG_OFF);
    LAS unsigned char* HI = lds; LAS unsigned char* LO = lds + 65536; LAS float* PART = (LAS float*)lds;
    const int r32 = lane & 31, hf = lane >> 5;
    const int nrows = l == 0 ? NROWS : NLAT, ntiles = nrows >> 5;
    const float* mod = (const float*)(a.ws + WS_MOD) + l * 9 * 6144;
    const float* lng = a.in[13] + l * 1024; const float* lnb = a.in[14] + l * 1024;
    const float* rgb = a.in[16] + l * 4; const float* reb = a.in[18] + l * 32;
    bf16* Hb = (bf16*)(a.ws + WS_HB); unsigned* tok = (unsigned*)(a.ws + WS_TOK); float* xctx = (float*)(a.ws + WS_XCTX); const bf16* YO = (const bf16*)(a.ws + WS_YO);
    const bf16* wr = (const bf16*)(a.ws + WS_WR) + (size_t)l * 2 * 64 * 1024;
    bf16x8 Bh[8][2];
#pragma unroll
    for (int ks = 0; ks < 8; ++ks)
#pragma unroll
        for (int ct = 0; ct < 2; ++ct) { const bf16* p = wr + (size_t)(ct * 32 + r32) * 1024 + wave * 128 + 16 * ks + 8 * hf; Bh[ks][ct] = *(const bf16x8*)p; }
    __syncthreads();
    if (tid < 32) lcnt[tid] = 0;
    __syncthreads();
    for (int T = blockIdx.x; T < ntiles; T += gridDim.x) {
#pragma unroll 1
        for (int rh = 0; rh < 2; ++rh) {
        f32x4 vv[2][4];
#pragma unroll
        for (int rq = 0; rq < 2; ++rq) { const int row = 32 * T + 4 * wave + 2 * rh + rq;
            const float* xin = row < NLAT ? a.in[0] + (size_t)row * 1024 : a.in[2] + (size_t)(row - NLAT) * 1024;
            const float* xs = row < NLAT ? a.out + (size_t)row * 1024 : xctx + (size_t)(row - NLAT) * 1024;
            const float* g1p = mod + (row < NLAT ? (row >> 12) : 8) * 6144 + 2048;
#pragma unroll
            for (int j = 0; j < 4; ++j) { const int idx = (lane + 64 * j) * 4; const v2u yw = *(const v2u*)(YO + (size_t)row * 1024 + idx);
                const f32x4 xv = *(const f32x4*)((l == 0 ? xin : xs) + idx);
                vv[rq][j] = xv * ALPHA + *(const f32x4*)(g1p + idx) * (f32x4){bflo(yw.x), bfhi(yw.x), bflo(yw.y), bfhi(yw.y)}; } }
#pragma unroll
        for (int rq = 0; rq < 2; ++rq) {
            const int lr = 4 * wave + 2 * rh + rq, row = 32 * T + lr;
            bf16* xsw = (bf16*)(row < NLAT ? a.out + (size_t)row * 1024 : xctx + (size_t)(row - NLAT) * 1024) + 1024;
            const float* m0 = mod + (row < NLAT ? (row >> 12) : 8) * 6144;
            f32x4 v[4]; float s = 0.f;
#pragma unroll
            for (int j = 0; j < 4; ++j) { v[j] = vv[rq][j]; s += (v[j].x + v[j].y) + (v[j].z + v[j].w); }
            const float mean = wave_sum(s) * (1.0f / 1024.0f); float s2 = 0.f;
#pragma unroll
            for (int j = 0; j < 4; ++j) { v[j] = v[j] - mean; s2 += (v[j].x * v[j].x + v[j].y * v[j].y) + (v[j].z * v[j].z + v[j].w * v[j].w); }
            const float rstd = 1.0f / sqrtf(wave_sum(s2) * (1.0f / 1024.0f) + LN_EPS);
#pragma unroll
            for (int j = 0; j < 4; ++j) { const int idx = (lane + 64 * j) * 4;
                const f32x4 x1 = v[j] * rstd * *(const f32x4*)(lng + idx) + *(const f32x4*)(lnb + idx);
                { v2u xw; xw.x = cvtpk(x1.x, x1.y); xw.y = cvtpk(x1.z, x1.w); *(v2u*)(xsw + idx) = xw; }
                const f32x4 hm = x1 * (*(const f32x4*)(m0 + 4096 + idx) + 1.0f) + *(const f32x4*)(m0 + 3072 + idx);
                v2u h; h.x = cvtpk(hm.x, hm.y); h.y = cvtpk(hm.z, hm.w);
                v2u lo; lo.x = cvtpk(hm.x - bflo(h.x), hm.y - bfhi(h.x)); lo.y = cvtpk(hm.z - bflo(h.y), hm.w - bfhi(h.y));
                *(v2u*)(Hb + (size_t)row * 1024 + idx) = h;
                const int off = lr * 2048 + (((((lane + 64 * j) >> 1)) ^ (lr & 15)) << 4) + (lane & 1) * 8;
                *(LAS v2u*)(HI + off) = h; *(LAS v2u*)(LO + off) = lo; }
        }
        }
        __syncthreads();
        f32x16 acc[2];
#pragma unroll
        for (int r = 0; r < 16; ++r) { acc[0][r] = 0.f; acc[1][r] = 0.f; }
#pragma unroll
        for (int ks = 0; ks < 8; ++ks) { const int off = r32 * 2048 + (((wave * 16 + 2 * ks + hf) ^ (r32 & 15)) << 4);
            const bf16x8 Ah = *(const LAS bf16x8*)(HI + off), Al = *(const LAS bf16x8*)(LO + off);
#pragma unroll
            for (int ct = 0; ct < 2; ++ct) { const bf16x8 Bl = *(const bf16x8*)(wr + (size_t)(64 + ct * 32 + r32) * 1024 + wave * 128 + 16 * ks + 8 * hf);
                acc[ct] = MFMA32(Ah, Bh[ks][ct], acc[ct]); acc[ct] = MFMA32(Ah, Bl, acc[ct]); acc[ct] = MFMA32(Al, Bh[ks][ct], acc[ct]); } }
        __syncthreads();
#pragma unroll
        for (int ct = 0; ct < 2; ++ct)
#pragma unroll
            for (int r = 0; r < 16; ++r) PART[(wave * 32 + crow(r, hf)) * 64 + ct * 32 + r32] = acc[ct][r];
        __syncthreads();
        { const int row = tid >> 4, cg = tid & 15;
#pragma unroll
          for (int q = 0; q < 3; ++q) { const int col = cg + 16 * q; if (col < 36) { float sum = 0.f;
#pragma unroll
                  for (int w = 0; w < 8; ++w) sum += PART[(w * 32 + row) * 64 + col];
                  LG[row * 40 + col] = sum; } } }
        __syncthreads();
        if (tid < 32) { const int row = 32 * T + tid; const LAS float* lgp = LG + tid * 40;
            float lg[4];
#pragma unroll
            for (int g = 0; g < 4; ++g) lg[g] = lgp[g] + rgb[g];
            int gi = 0; float gm = lg[0];
#pragma unroll
            for (int g = 1; g < 4; ++g) if (lg[g] > gm) { gm = lg[g]; gi = g; }
            float gden = 0.f;
#pragma unroll
            for (int g = 0; g < 4; ++g) gden += expf(lg[g] - gm);
            const float gprob = 1.0f / gden;
            float le[8];
#pragma unroll
            for (int e = 0; e < 8; ++e) le[e] = lgp[4 + gi * 8 + e] + reb[gi * 8 + e];
            int i1 = 0; float m1 = le[0];
#pragma unroll
            for (int e = 1; e < 8; ++e) if (le[e] > m1) { m1 = le[e]; i1 = e; }
            int i2 = -1; float m2 = -3.0e38f;
#pragma unroll
            for (int e = 0; e < 8; ++e) if (e != i1 && le[e] > m2) { m2 = le[e]; i2 = e; }
            const float p2 = expf(m2 - m1), inv = 1.0f / (1.0f + p2);
            const float gate0 = gprob * inv, gate1 = gprob * p2 * inv;
            const int e0 = gi * 8 + i1, e1 = gi * 8 + i2;
            const int p0 = __hip_atomic_fetch_add(lcnt + e0, 1, __ATOMIC_RELAXED, __HIP_MEMORY_SCOPE_WORKGROUP);
            const int p1 = __hip_atomic_fetch_add(lcnt + e1, 1, __ATOMIC_RELAXED, __HIP_MEMORY_SCOPE_WORKGROUP);
            unsigned* t = tok + (size_t)row * 8; t[0] = (unsigned)e0 | ((unsigned)e1 << 8); t[1] = (unsigned)p0; t[2] = (unsigned)p1;
            t[4] = __builtin_bit_cast(unsigned, gate0); t[5] = __builtin_bit_cast(unsigned, gate1); }
    }
    __syncthreads();
    if (tid < 32) ((unsigned*)(a.ws + WS_CTL))[CW_WGCNT + (l * 256 + blockIdx.x) * 32 + tid] = (unsigned)lcnt[tid];
    __syncthreads();
}
#ifndef MK_PER_PHASE
#define MK_PER_PHASE 0
#endif
constexpr int N_PHASES = 22;

__global__ void __launch_bounds__(NTHR, 2) hybrid_fwd(Args args) {
    extern __shared__ __attribute__((aligned(16))) unsigned char lds_raw[];
    LAS unsigned char* lds = (LAS unsigned char*)lds_raw;
    const int tid0 = threadIdx.x;
    for (int u = tid0; u < (LDS_BYTES - LDSCTL_OFF) / 4; u += NTHR) ((LAS unsigned*)(lds + LDSCTL_OFF))[u] = 0u;
#define TIDS int tid = threadIdx.x; asm volatile("" : "+v"(tid)); const int lane = tid & 63, wave = __builtin_amdgcn_readfirstlane(tid >> 6); (void)lane; (void)wave
    __syncthreads();
    unsigned* ctl = (unsigned*)(args.ws + WS_CTL);
    XcdBarrier bar; bar.bar = ctl + CW_BAR; bar.x = 0; bar.st = nullptr;
    if (!MK_PER_PHASE) bar = xcd_barrier_post(ctl + CW_BAR, (volatile LAS unsigned*)(lds + MISC_OFF + 32));
    const int lo = args.ph_lo, hi = args.ph_hi;
#ifndef PHMASK
#define PHMASK 0xFFFFFFu
#endif
#define PHON(k) (((PHMASK) >> ((k) < 2 ? (k) : 2 + ((k) - 2) % 10)) & 1u)
#define IN(k) (PHON(k) && lo <= (k) && (k) < hi)
#ifndef REPMASK
#define REPMASK 0u
#endif
#define NREP(k) (1 + (int)(((REPMASK) >> ((k) < 2 ? (k) : 2 + ((k) - 2) % 10)) & 1u))
#define SEAM(k) do { if (IN(k) && IN((k) + 1)) xcd_barrier(bar); } while (0)

    if (IN(0)) for (int rep = 0; rep < NREP(0); ++rep) { TIDS; phase_p0(args, lds, tid, lane, wave); }
    SEAM(0);
    if (IN(1)) for (int rep = 0; rep < NREP(1); ++rep) { TIDS; phase_p1(args, lane, wave); }
    SEAM(1);
    for (int l = 0; l < 2; ++l) {
        const int pb = 2 + 10 * l;
        bf16* Hb = (bf16*)(args.ws + WS_HB);
        if (IN(pb + 0)) for (int rep = 0; rep < NREP(2); ++rep) {
            pg8::Gemm g{Hb, (const bf16*)(args.ws + WS_WIN) + (size_t)l * INC * 1024, NROWS, INC, 1024}; pg8::StaticOrder S; S.init(NROWS, INC, (int)gridDim.x, (int)blockIdx.x);
            pg8::EpiBf16<0> E{(bf16*)(args.ws + WS_P), INC, nullptr, 0, 0, 1.0f};
            pg8::gemm_phase<pg8::EpiBf16<0>, pg8::StaticOrder, true, true>(lds, g, S, E);
        }
        SEAM(pb + 0);
        if (IN(pb + 1)) for (int rep = 0; rep < NREP(3); ++rep) { TIDS; phase_b_mfma(args, l, lds, tid, lane, wave); }
        SEAM(pb + 1);
        if (IN(pb + 2)) { TIDS; phase_c(args, l, tid); }
        SEAM(pb + 2);
        if (IN(pb + 3)) for (int rep = 0; rep < NREP(5); ++rep) { TIDS; phase_d_mfma(args, l, lds, tid, lane, wave); }
        SEAM(pb + 3);
        if (IN(pb + 4)) for (int rep = 0; rep < (l == 0 ? NREP(6) : 1); ++rep) {
            const int M = l == 0 ? NROWS : NLAT;
            pg8::Gemm g{(const bf16*)(args.ws + WS_YMIX), (const bf16*)(args.ws + WS_WOUT) + (size_t)l * 1024 * 1024, M, 1024, 1024}; pg8::StaticOrder S; S.init(M, 1024, (int)gridDim.x, (int)blockIdx.x);
            pg8::EpiBf16<0> E{(bf16*)(args.ws + WS_YO), 1024, nullptr, 0, 0, 1.0f};
            pg8::gemm_phase<pg8::EpiBf16<0>, pg8::StaticOrder, true, true>(lds, g, S, E);
        }
        SEAM(pb + 4);
        if (IN(pb + 5)) { TIDS; phase_f2(args, l, lds, tid, lane, wave); }
        SEAM(pb + 5);
        if (IN(pb + 6)) for (int rep = 0; rep < NREP(8); ++rep) { TIDS; phase_g(args, l, lds, tid, lane, wave); }
        SEAM(pb + 6);
        if (IN(pb + 7)) for (int rep = 0; rep < NREP(9); ++rep) {
            int npan; { TIDS; npan = build_p2e(args, l, lds, tid); }
            pg8::Gemm g{Hb, (const bf16*)(args.ws + WS_WGU) + (size_t)l * 32 * 1024 * 1024, npan * 256, 1024, 1024};
            LAS int* arows = (LAS int*)(lds + AROWS_OFF);
            { TIDS; const int* rowof = (const int*)(args.ws + WS_ROWOF);
              for (int i = 0; i < 6; ++i) { const int L = i * (int)gridDim.x + (int)blockIdx.x; if (L < npan * 4 && tid < 256) arows[i * 256 + tid] = rowof[(L >> 2) * 256 + tid]; }
              __syncthreads(); }
            pg8::MoeOrder S{(const LAS unsigned char*)(lds + P2E_OFF), npan * 4, (int)gridDim.x, (int)blockIdx.x, arows};
            pg8::EpiGLU E{(bf16*)(args.ws + WS_HH)};
            pg8::gemm_phase_gather<pg8::EpiGLU, pg8::MoeOrder>(lds, g, S, E);
        }
        SEAM(pb + 7);
        if (IN(pb + 8)) for (int rep = 0; rep < NREP(10); ++rep) {
            int npan; { TIDS; npan = build_p2e(args, l, lds, tid); }
            pg8::Gemm g{(const bf16*)(args.ws + WS_HH), (const bf16*)(args.ws + WS_WD) + (size_t)l * 32 * 1024 * 512, npan * 256, 1024, 512};
            pg8::MoeOrder S{(const LAS unsigned char*)(lds + P2E_OFF), npan * 4, (int)gridDim.x, (int)blockIdx.x, nullptr};
            pg8::EpiY E{(bf16*)(args.ws + WS_Y)};
            pg8::gemm_phase<pg8::EpiY, pg8::MoeOrder, true, true>(lds, g, S, E);
        }
        SEAM(pb + 8);
        if (IN(pb + 9)) { if (NREP(11) > 1) { TIDS; phase_j(args, l, lane, wave, true); } TIDS; phase_j(args, l, lane, wave); }
        SEAM(pb + 9);
    }
#undef IN
#undef SEAM
}

extern "C" void kernel_launch(void* const* d_in, const int* in_sizes, int n_in, void* d_out, int out_size, void* d_ws, size_t ws_size, hipStream_t stream) {
    static int grid = 0;
    if (grid == 0) {
        if (n_in != 24 || in_sizes[0] != NLAT * DM || out_size != NLAT * DM || ws_size < WS_END) { fprintf(stderr, "kernel_launch: unexpected problem (n_in %d, ws %zu < %zu?)\n", n_in, ws_size, (size_t)WS_END); grid = -1; return; }
        int dev = 0, cus = 0, per_cu = 0;
        if (hipGetDevice(&dev) != hipSuccess || hipDeviceGetAttribute(&cus, hipDeviceAttributeMultiprocessorCount, dev) != hipSuccess) { grid = -1; return; }
        if (hipFuncSetAttribute((const void*)hybrid_fwd, hipFuncAttributeMaxDynamicSharedMemorySize, LDS_BYTES) != hipSuccess) { grid = -1; return; }
        if (hipOccupancyMaxActiveBlocksPerMultiprocessor(&per_cu, (const void*)hybrid_fwd, NTHR, LDS_BYTES) != hipSuccess || per_cu < 1) { fprintf(stderr, "kernel_launch: occupancy query says %d\n", per_cu); }
        (void)hipGetLastError();
        grid = cus;
        if (grid != 256) { fprintf(stderr, "kernel_launch: built for 256 CUs, device has %d\n", cus); grid = -1; return; }
    }
    if (grid < 0) return;
    if (hipMemsetAsync((char*)d_ws + WS_CTL, 0, CTL_ZERO_BYTES, stream) != hipSuccess) return;
    Args a{};
    for (int i = 0; i < 24; ++i) a.in[i] = (const float*)d_in[i];
    a.out = (float*)d_out; a.ws = (unsigned char*)d_ws;
#if MK_PER_PHASE
    for (int p = 0; p < N_PHASES; ++p) { a.ph_lo = p; a.ph_hi = p + 1; hipLaunchKernelGGL(hybrid_fwd, dim3(grid), dim3(NTHR), LDS_BYTES, stream, a); }
#else
    a.ph_lo = 0; a.ph_hi = N_PHASES;
    hipLaunchKernelGGL(hybrid_fwd, dim3(grid), dim3(NTHR), LDS_BYTES, stream, a);
#endif
}
```
